# Optimizing an MI355X kernel written in HIP

```python
import jax
import jax.numpy as jnp
from jax import lax
import numpy as np

D_MODEL = 1024
BATCH = 8
SEQ = 2048
DEPTH = 1

MEM_LEN = 256
EPS = 1e-5

GLA_HEADS = 4
GLA_WIDTH_V = D_MODEL // 2
GLA_DV = GLA_WIDTH_V // GLA_HEADS
GLA_DK = GLA_DV // 2
GLA_WIDTH_K = GLA_HEADS * GLA_DK
GLA_GATE_RANK = 16
GLA_TAU = 16.0
GLA_CHUNK = 64

SGU_WIDTH = D_MODEL // 2
SGU_GROUPS = 4
SGU_GROUP_DIM = SGU_WIDTH // SGU_GROUPS
SGU_CHUNK = 128

N_BRANCH = 2

OFF_Q = 0
OFF_K = OFF_Q + GLA_WIDTH_K
OFF_V = OFF_K + GLA_WIDTH_K
OFF_R = OFF_V + GLA_WIDTH_V
OFF_A = OFF_R + GLA_WIDTH_V
OFF_U = OFF_A + GLA_GATE_RANK
OFF_SV = OFF_U + SGU_WIDTH
OFF_G = OFF_SV + SGU_WIDTH
IN_COLS = OFF_G + N_BRANCH * D_MODEL

XATTN_HEADS = 4
XATTN_DH = D_MODEL // XATTN_HEADS

N_EXPERTS = 32
TOP_K = 4
D_FF_EXPERT = D_MODEL
SWIGLU_ALPHA = 1.702
SWIGLU_LIMIT = 7.0
MOE_BLOCK = 128

kernel_name = 'hybrid_gla_sgu_xattn_moe_layer'


def _rmsnorm(x, g):
    xf = x.astype(jnp.float32)
    y = xf * lax.rsqrt(jnp.mean(xf * xf, axis=-1, keepdims=True) + EPS)
    return (y * g.astype(jnp.float32)).astype(x.dtype)


def _layernorm(x, g, b):
    xf = x.astype(jnp.float32)
    mu = jnp.mean(xf, axis=-1, keepdims=True)
    var = jnp.mean(jnp.square(xf - mu), axis=-1, keepdims=True)
    y = (xf - mu) * lax.rsqrt(var + EPS)
    return (y * g.astype(jnp.float32) + b.astype(jnp.float32)).astype(x.dtype)


def _gla(q, k, v, r, a_low, w_a2, b_a, out_g):
    B, S, _ = q.shape
    H, C = GLA_HEADS, GLA_CHUNK
    NC = S // C
    f32 = jnp.float32

    def to_chunks(t, d):
        return t.astype(f32).reshape(B, NC, C, H, d).transpose(0, 3, 1, 2, 4)

    log_a = jax.nn.log_sigmoid(a_low.astype(f32) @ w_a2.astype(f32) + b_a.astype(f32)) / GLA_TAU
    qc = to_chunks(q, GLA_DK) * (GLA_DK ** -0.5)
    kc = to_chunks(k, GLA_DK)
    vc = to_chunks(v, GLA_DV)
    cum = jnp.cumsum(to_chunks(log_a, GLA_DK), axis=3)
    cum_last = cum[:, :, :, -1:, :]
    q_in = qc * jnp.exp(cum)
    k_in = kc * jnp.exp(-cum)
    k_out = kc * jnp.exp(cum_last - cum)
    causal = jnp.tril(jnp.ones((C, C), dtype=bool))
    att = jnp.where(causal, jnp.einsum('bhncd,bhnsd->bhncs', q_in, k_in), 0.0)
    o_intra = jnp.einsum('bhncs,bhnse->bhnce', att, vc)
    kv = jnp.einsum('bhncd,bhnce->bhnde', k_out, vc)
    decay = jnp.exp(cum_last[:, :, :, 0, :])

    def step(state, inp):
        dec, kv_n = inp
        return dec[..., None] * state + kv_n, state

    s0 = jnp.zeros((B, H, GLA_DK, GLA_DV), f32)
    _, s_prev = lax.scan(step, s0, (jnp.moveaxis(decay, 2, 0), jnp.moveaxis(kv, 2, 0)))
    o_inter = jnp.einsum('bhncd,nbhde->bhnce', q_in, s_prev)
    o = (o_intra + o_inter).transpose(0, 2, 3, 1, 4).reshape(B, S, H, GLA_DV)
    o = o * lax.rsqrt(jnp.mean(o * o, axis=-1, keepdims=True) + EPS) * out_g.astype(f32).reshape(H, GLA_DV)
    o = o.reshape(B, S, GLA_WIDTH_V) * jax.nn.silu(r.astype(f32))
    return o.astype(q.dtype)


def _sgu(u_pre, v_pre, norm_g, norm_b, w_s, b_s):
    B, S, _ = u_pre.shape
    NC = S // SGU_CHUNK
    u = jax.nn.gelu(u_pre, approximate=False)
    v = _layernorm(jax.nn.gelu(v_pre, approximate=False), norm_g, norm_b)
    v = v.reshape(B, NC, SGU_CHUNK, SGU_GROUPS, SGU_GROUP_DIM)
    causal = jnp.tril(jnp.ones((SGU_CHUNK, SGU_CHUNK), dtype=bool))
    w = jnp.where(causal[None], w_s, 0.0).astype(v.dtype)
    mixed = jnp.einsum('gts,bnsgc->bntgc', w, v) + b_s.T[:, :, None].astype(v.dtype)
    return u * mixed.reshape(B, S, SGU_WIDTH)


def _cross_attn(h, mem_n, wq, wk, wv, wo):
    B, S, _ = h.shape
    M = mem_n.shape[1]
    q = (h @ wq).reshape(B, S, XATTN_HEADS, XATTN_DH)
    k = (mem_n @ wk).reshape(B, M, XATTN_HEADS, XATTN_DH)
    v = (mem_n @ wv).reshape(B, M, XATTN_HEADS, XATTN_DH)
    s = jnp.einsum('bshd,bmhd->bhsm', q, k).astype(jnp.float32) * (XATTN_DH ** -0.5)
    p = jax.nn.softmax(s, axis=-1).astype(v.dtype)
    o = jnp.einsum('bhsm,bmhd->bshd', p, v).reshape(B, S, D_MODEL)
    return o @ wo


def _moe(h, w_router, b_router, w1, b1, w2, b2):
    B, S, D = h.shape
    T = B * S
    xf = h.reshape(T, D)
    logits = (xf @ w_router + b_router).astype(jnp.float32)
    top_v, top_i = lax.top_k(logits, TOP_K)
    gates = jax.nn.softmax(top_v, axis=-1)
    n_assign = T * TOP_K
    flat_e = top_i.reshape(-1)
    flat_tok = jnp.arange(n_assign, dtype=jnp.int32) // TOP_K
    order = jnp.argsort(flat_e, stable=True)
    sorted_e = flat_e[order]
    counts = jnp.bincount(flat_e, length=N_EXPERTS)
    padded = ((counts + MOE_BLOCK - 1) // MOE_BLOCK) * MOE_BLOCK
    pad_end = jnp.cumsum(padded)
    pad_start = pad_end - padded
    start = jnp.cumsum(counts) - counts
    rank = jnp.arange(n_assign, dtype=jnp.int32) - start[sorted_e]
    dest = pad_start[sorted_e] + rank
    n_blocks = -(-n_assign // MOE_BLOCK) + N_EXPERTS
    tok_buf = jnp.full((n_blocks * MOE_BLOCK,), T, jnp.int32).at[dest].set(flat_tok[order])
    block_e = jnp.minimum(
        jnp.searchsorted(pad_end, jnp.arange(n_blocks, dtype=jnp.int32) * MOE_BLOCK, side='right'),
        N_EXPERTS - 1)
    x_pad = jnp.concatenate([xf, jnp.zeros((1, D), xf.dtype)], axis=0)
    xb = x_pad[tok_buf].reshape(n_blocks, MOE_BLOCK, D)

    def expert_block(args):
        xblk, e = args
        hcat = xblk @ w1[e] + b1[e]
        glu = jnp.minimum(hcat[:, :D_FF_EXPERT], SWIGLU_LIMIT)
        lin = jnp.clip(hcat[:, D_FF_EXPERT:], -SWIGLU_LIMIT, SWIGLU_LIMIT)
        act = (lin + 1.0) * glu * jax.nn.sigmoid(SWIGLU_ALPHA * glu)
        return act @ w2[e] + b2[e]

    yb = lax.map(expert_block, (xb, block_e)).reshape(n_blocks * MOE_BLOCK, D)
    y_assign = jnp.zeros((n_assign, D), yb.dtype).at[order].set(yb[dest])
    y = jnp.einsum('tkd,tk->td', y_assign.reshape(T, TOP_K, D), gates.astype(yb.dtype))
    return y.reshape(B, S, D)


def setup_inputs(seed: int = 0) -> dict:
    key = jax.random.key(seed)
    keys = iter(jax.random.split(key, 40))
    f32 = jnp.float32

    def nrm(shape, scale):
        return jax.random.normal(next(keys), shape, f32) * scale

    L = DEPTH
    return {
        'x': nrm((BATCH, SEQ, D_MODEL), 1.0),
        'mem': nrm((BATCH, MEM_LEN, D_MODEL), 1.0),
        'norm_mix_g': 1.0 + nrm((L, D_MODEL), 0.02),
        'w_in': nrm((L, D_MODEL, IN_COLS), D_MODEL ** -0.5),
        'gla_w_a2': nrm((L, GLA_GATE_RANK, GLA_WIDTH_K), GLA_GATE_RANK ** -0.5),
        'gla_b_a': nrm((L, GLA_WIDTH_K), 0.1),
        'gla_out_g': 1.0 + nrm((L, GLA_WIDTH_V), 0.02),
        'sgu_norm_g': 1.0 + nrm((L, SGU_WIDTH), 0.02),
        'sgu_norm_b': nrm((L, SGU_WIDTH), 0.02),
        'sgu_w': nrm((L, SGU_GROUPS, SGU_CHUNK, SGU_CHUNK), SGU_CHUNK ** -0.5),
        'sgu_b': 1.0 + nrm((L, SGU_GROUPS, SGU_CHUNK), 0.1),
        'w_proj_a': nrm((L, GLA_WIDTH_V, D_MODEL), GLA_WIDTH_V ** -0.5),
        'w_proj_b': nrm((L, SGU_WIDTH, D_MODEL), SGU_WIDTH ** -0.5),
        'w_mix_out': nrm((L, D_MODEL, D_MODEL), D_MODEL ** -0.5),
        'norm_x_g': 1.0 + nrm((L, D_MODEL), 0.02),
        'norm_mem_g': 1.0 + nrm((L, D_MODEL), 0.02),
        'w_xq': nrm((L, D_MODEL, D_MODEL), D_MODEL ** -0.5),
        'w_xk': nrm((L, D_MODEL, D_MODEL), D_MODEL ** -0.5),
        'w_xv': nrm((L, D_MODEL, D_MODEL), D_MODEL ** -0.5),
        'w_xo': nrm((L, D_MODEL, D_MODEL), D_MODEL ** -0.5),
        'norm_ffn_g': 1.0 + nrm((L, D_MODEL), 0.02),
        'w_router': nrm((L, D_MODEL, N_EXPERTS), D_MODEL ** -0.5),
        'b_router': nrm((L, N_EXPERTS), 0.01),
        'w_e1': nrm((L, N_EXPERTS, D_MODEL, 2 * D_FF_EXPERT), D_MODEL ** -0.5),
        'b_e1': nrm((L, N_EXPERTS, 2 * D_FF_EXPERT), 0.01),
        'w_e2': nrm((L, N_EXPERTS, D_FF_EXPERT, D_MODEL), D_FF_EXPERT ** -0.5),
        'b_e2': nrm((L, N_EXPERTS, D_MODEL), 0.01),
        'norm_final_g': 1.0 + nrm((D_MODEL,), 0.02),
    }


def reference(x, mem, norm_mix_g, w_in, gla_w_a2, gla_b_a, gla_out_g, sgu_norm_g, sgu_norm_b,
              sgu_w, sgu_b, w_proj_a, w_proj_b, w_mix_out, norm_x_g, norm_mem_g, w_xq, w_xk,
              w_xv, w_xo, norm_ffn_g, w_router, b_router, w_e1, b_e1, w_e2, b_e2, norm_final_g):
    for l in range(DEPTH):
        h = _rmsnorm(x, norm_mix_g[l])
        p = h @ w_in[l]
        y_a = _gla(p[..., OFF_Q:OFF_K], p[..., OFF_K:OFF_V], p[..., OFF_V:OFF_R],
                   p[..., OFF_R:OFF_A], p[..., OFF_A:OFF_U],
                   gla_w_a2[l], gla_b_a[l], gla_out_g[l]) @ w_proj_a[l]
        y_b = _sgu(p[..., OFF_U:OFF_SV], p[..., OFF_SV:OFF_G],
                   sgu_norm_g[l], sgu_norm_b[l], sgu_w[l], sgu_b[l]) @ w_proj_b[l]
        gate_a = jax.nn.sigmoid(p[..., OFF_G:OFF_G + D_MODEL])
        gate_b = jax.nn.sigmoid(p[..., OFF_G + D_MODEL:OFF_G + 2 * D_MODEL])
        x = x + (gate_a * y_a + gate_b * y_b) @ w_mix_out[l]
        mem_n = _rmsnorm(mem, norm_mem_g[l])
        x = x + _cross_attn(_rmsnorm(x, norm_x_g[l]), mem_n, w_xq[l], w_xk[l], w_xv[l], w_xo[l])
        x = x + _moe(_rmsnorm(x, norm_ffn_g[l]), w_router[l], b_router[l],
                     w_e1[l], b_e1[l], w_e2[l], b_e2[l])
    return _rmsnorm(x, norm_final_g)
```

```cpp
#include <hip/hip_runtime.h>
#include <cstdio>
#include <cstdint>

#ifndef P1_FP8
#define P1_FP8 0
#endif
#ifndef MK_PER_PHASE
#define MK_PER_PHASE 0
#endif

#define LAS __attribute__((address_space(3)))
#define GAS __attribute__((address_space(1)))
typedef unsigned short bf16_t;
typedef short bf16x8 __attribute__((ext_vector_type(8)));
typedef float f32x4 __attribute__((ext_vector_type(4)));
typedef float f32x2 __attribute__((ext_vector_type(2)));
typedef unsigned u32x4 __attribute__((ext_vector_type(4)));
typedef unsigned u32x2 __attribute__((ext_vector_type(2)));
typedef int i32x4 __attribute__((ext_vector_type(4)));
typedef int i32x8 __attribute__((ext_vector_type(8)));
#define FP8_WSCALE 0x79797979
constexpr float FP8_WMUL = 64.0f;
typedef GAS unsigned gu32;

constexpr int T = 16384, D = 1024, NBATCH = 8, SEQ = 2048, MEMLEN = 256, TM = NBATCH * MEMLEN;
constexpr int INC = 4624;
constexpr int PN = 4864;
constexpr int PC_Q = 0, PC_K = 256, PC_V = 512, PC_R = 1024, PC_U = 1536, PC_SV = 2048, PC_GA = 2560, PC_GB = 3584, PC_A = 4608;
constexpr int OFF_A = 1536;
constexpr int NE = 32, NASG = T * 4, ECAP = 16384;
constexpr float EPS = 1e-5f;
constexpr int NPHASE = 14;

constexpr size_t MiB = 1u << 20;
constexpr size_t WS_CTL = 0, CTL_ZERO_BYTES = 1 * MiB;
constexpr size_t WS_WR = 1 * MiB, WS_SGUW = 1 * MiB + 256 * 1024, WS_DECAY = 1 * MiB + 512 * 1024;
constexpr size_t WS_WIN = 2 * MiB, WS_WK = 12 * MiB, WS_WV = 14 * MiB, WS_WPAB = 16 * MiB, WS_WMO = 18 * MiB, WS_WQ = 20 * MiB, WS_WO = 22 * MiB;
constexpr size_t WS_SSQ1 = 24 * MiB, WS_SSQ2 = 25 * MiB, WS_LIST = 26 * MiB, WS_LSCALE = 28 * MiB, WS_GATES = 30 * MiB;
constexpr size_t WS_W1 = 32 * MiB, WS_W2 = 160 * MiB, WS_H = 224 * MiB, WS_MEMN = 256 * MiB, WS_KMEM = 260 * MiB, WS_VT = 264 * MiB, WS_QIN = 268 * MiB;
constexpr size_t WS_OINTRA = 276 * MiB, WS_KVT = 308 * MiB, WS_OAB = 340 * MiB, WS_MIX = 372 * MiB, WS_X1B = 404 * MiB, WS_Q = 436 * MiB, WS_AO = 468 * MiB, WS_X2B = 500 * MiB;
constexpr size_t WS_P = 532 * MiB, WS_ACT = 684 * MiB, WS_YB = 828 * MiB, WS_SPT = 956 * MiB, WS_X2Q = 972 * MiB, WS_X1Q = 988 * MiB, WS_SVS = 1004 * MiB, WS_END = 1005 * MiB;
static_assert(WS_P + (size_t)T * PN * 2 <= WS_ACT && WS_ACT + (size_t)(NASG + NE * 256) * 1024 * 2 <= WS_YB && WS_YB + (size_t)NASG * 1024 * 2 <= WS_END, "ws map");
constexpr int CW_CNT = 64;
constexpr int CW_BAR = 4096;

constexpr int RING_BYTES = 131072;
constexpr int TAB_OFF = 139264, MISC_OFF = 141312, LDS_BYTES = 147456;

typedef __bf16 bf16x2_t __attribute__((ext_vector_type(2)));
__device__ __forceinline__ unsigned cvt_pk_bf16(float lo, float hi) { const f32x2 v = {lo, hi}; const bf16x2_t b = __builtin_convertvector(v, bf16x2_t); return __builtin_bit_cast(unsigned, b); }
__device__ __forceinline__ bf16_t f2bf(float f) { return (bf16_t)(cvt_pk_bf16(f, 0.f) & 0xffffu); }
__device__ __forceinline__ float bflo(unsigned w) { return __uint_as_float(w << 16); }
__device__ __forceinline__ float bfhi(unsigned w) { return __uint_as_float(w & 0xffff0000u); }
__device__ __forceinline__ float bf2f(bf16_t v) { return __uint_as_float((unsigned)v << 16); }
__device__ __forceinline__ void unpack8(const u32x4 w, float (&f)[8]) { f[0] = bflo(w.x); f[1] = bfhi(w.x); f[2] = bflo(w.y); f[3] = bfhi(w.y); f[4] = bflo(w.z); f[5] = bfhi(w.z); f[6] = bflo(w.w); f[7] = bfhi(w.w); }
__device__ __forceinline__ u32x4 pack8(const float (&f)[8]) { u32x4 w; w.x = cvt_pk_bf16(f[0], f[1]); w.y = cvt_pk_bf16(f[2], f[3]); w.z = cvt_pk_bf16(f[4], f[5]); w.w = cvt_pk_bf16(f[6], f[7]); return w; }
__device__ __forceinline__ u32x2 pack8_fp8(const float (&f)[8]) { int a = 0, b = 0;
    a = __builtin_amdgcn_cvt_pk_fp8_f32(f[0], f[1], a, false); a = __builtin_amdgcn_cvt_pk_fp8_f32(f[2], f[3], a, true);
    b = __builtin_amdgcn_cvt_pk_fp8_f32(f[4], f[5], b, false); b = __builtin_amdgcn_cvt_pk_fp8_f32(f[6], f[7], b, true);
    return (u32x2){(unsigned)a, (unsigned)b}; }
__device__ __forceinline__ void unpack8_fp8(const u32x2 w, float (&f)[8]) {
    const f32x2 a = __builtin_amdgcn_cvt_pk_f32_fp8((int)w.x, false), b = __builtin_amdgcn_cvt_pk_f32_fp8((int)w.x, true), c = __builtin_amdgcn_cvt_pk_f32_fp8((int)w.y, false), d = __builtin_amdgcn_cvt_pk_f32_fp8((int)w.y, true);
    f[0] = a.x; f[1] = a.y; f[2] = b.x; f[3] = b.y; f[4] = c.x; f[5] = c.y; f[6] = d.x; f[7] = d.y; }
__device__ __forceinline__ f32x4 mma16(bf16x8 a, bf16x8 b, f32x4 c) { return __builtin_amdgcn_mfma_f32_16x16x32_bf16(a, b, c, 0, 0, 0); }
__device__ __forceinline__ float wave_sum(float v) {
#pragma unroll
    for (int o = 1; o < 64; o <<= 1) v += __shfl_xor(v, o);
    return v;
}
__device__ __forceinline__ float sigmoidf_(float x) { return __builtin_amdgcn_rcpf(1.0f + __expf(-x)); }
__device__ __forceinline__ float gelu_erf(float v) {
    const float av = fabsf(v), t = __builtin_amdgcn_rcpf(av * 0.2316418882f + 1.0f);
    float q = t * 0.5307027145f + (-0.7265760135f); q = q * t + 0.7107068705f; q = q * t + (-0.142248368f); q = q * t + 0.127414796f; q = q * t;
    const float e = __builtin_amdgcn_exp2f((v * v) * (-0.72134752044f));
    const float m = v * (q * e);
    return v < 0.f ? m : v - m;
}
__device__ __forceinline__ f32x2 gelu_pk(f32x2 v) {
    const f32x2 av = __builtin_elementwise_abs(v), d = av * 0.2316418882f + 1.0f;
    f32x2 t; t.x = __builtin_amdgcn_rcpf(d.x); t.y = __builtin_amdgcn_rcpf(d.y);
    f32x2 q = t * 0.5307027145f + (-0.7265760135f); q = q * t + 0.7107068705f; q = q * t + (-0.142248368f); q = q * t + 0.127414796f; q = q * t;
    const f32x2 s = (v * v) * (-0.72134752044f);
    f32x2 e; e.x = __builtin_amdgcn_exp2f(s.x); e.y = __builtin_amdgcn_exp2f(s.y);
    const f32x2 m = v * (q * e), r = v - m;
    f32x2 o; o.x = v.x < 0.f ? m.x : r.x; o.y = v.y < 0.f ? m.y : r.y; return o;
}
__device__ __forceinline__ f32x2 sigmoid_pk(f32x2 v) {
    const f32x2 t = v * (-1.4426950408889634f); const f32x2 d = (f32x2){__builtin_amdgcn_exp2f(t.x), __builtin_amdgcn_exp2f(t.y)} + 1.0f;
    return (f32x2){__builtin_amdgcn_rcpf(d.x), __builtin_amdgcn_rcpf(d.y)};
}
#define LDS_WAIT() asm volatile("s_waitcnt lgkmcnt(0)" ::: "memory")
#define VM_WAIT() asm volatile("s_waitcnt vmcnt(0)" ::: "memory")

#define XB_TMO      128
#define XB_XCNT(j)  (256  + 64 * (j))
#define XB_XSUB(j)  (1280 + 64 * (j))
#define XB_XGEN(j)  (2304 + 64 * (j))
#define XB_TOP      3328
#define XB_TOPGEN   3392
#define XCD_BAR_WORDS 3456
#define XB_SPIN_CAP (1u << 22)
__device__ __forceinline__ unsigned xb_ld(unsigned* p)              { return __hip_atomic_load(p, __ATOMIC_RELAXED, __HIP_MEMORY_SCOPE_AGENT); }
__device__ __forceinline__ unsigned xb_add(unsigned* p, unsigned v) { return __hip_atomic_fetch_add(p, v, __ATOMIC_RELAXED, __HIP_MEMORY_SCOPE_AGENT); }
__device__ __forceinline__ unsigned xb_xcc_id() { return (unsigned)__builtin_amdgcn_s_getreg((3 << 11) | 20) & 0xFu; }
#define XB_SPIN(cond, bar) do { unsigned _sp = 0; while (cond) { __builtin_amdgcn_s_sleep(1); \
    if ((++_sp & 255u) == 0u) { if (xb_ld(&(bar)[XB_TMO])) break; if (_sp > XB_SPIN_CAP) { atomicAdd(&(bar)[XB_TMO], 1u); break; } } } } while (0)
struct XcdBarrier { unsigned* bar; unsigned x; volatile LAS unsigned* st; };
__device__ __forceinline__ XcdBarrier xcd_barrier_post(unsigned* bar, volatile LAS unsigned* st) {
    XcdBarrier b; b.bar = bar; b.x = xb_xcc_id(); b.st = st;
    if (threadIdx.x == 0) (void)xb_add(&bar[XB_XCNT(b.x)], 1u);
    return b;
}
__device__ __forceinline__ void xcd_barrier_complete(unsigned* bar, unsigned x, unsigned& nloc, unsigned& nx) {
    const unsigned G = gridDim.x * gridDim.y * gridDim.z;
    unsigned sum, cnt, mine, sp = 0u;
    for (;;) {
        sum = 0u; cnt = 0u; mine = 0u;
#pragma unroll
        for (unsigned j = 0; j < 16; ++j) { const unsigned c = xb_ld(&bar[XB_XCNT(j)]); sum += c; cnt += (c > 0u) ? 1u : 0u; mine = (j == x) ? c : mine; }
        if (sum == G) break;
        __builtin_amdgcn_s_sleep(1);
        if ((++sp & 255u) == 0u) { if (xb_ld(&bar[XB_TMO])) break; if (sp > XB_SPIN_CAP) { atomicAdd(&bar[XB_TMO], 1u); break; } }
    }
    nloc = mine > 0u ? mine : 1u; nx = cnt > 0u ? cnt : 1u;
}
__device__ __forceinline__ void xcd_barrier(const XcdBarrier& b) {
    asm volatile("s_waitcnt vmcnt(0)" ::: "memory");
    __syncthreads();
    if (threadIdx.x == 0) {
        unsigned* bar = b.bar;
        __builtin_amdgcn_s_waitcnt(0);
        unsigned nloc = b.st[0], nx = b.st[1];
        if (nloc == 0u) { xcd_barrier_complete(bar, b.x, nloc, nx); b.st[0] = nloc; b.st[1] = nx; }
        const unsigned old = xb_add(&bar[XB_XSUB(b.x)], 1u);
        const unsigned gen = old / nloc;
        if (old + 1u == (gen + 1u) * nloc) {
            __builtin_amdgcn_fence(__ATOMIC_RELEASE, "agent");
            asm volatile("s_waitcnt vmcnt(0)" ::: "memory");
            const unsigned og = xb_add(&bar[XB_TOP], 1u);
            const unsigned tg = og / nx;
            if (og + 1u == (tg + 1u) * nx) xb_add(&bar[XB_TOPGEN], 1u);
            else XB_SPIN(xb_ld(&bar[XB_TOPGEN]) == tg, bar);
            __builtin_amdgcn_fence(__ATOMIC_ACQUIRE, "agent");
            xb_add(&bar[XB_XGEN(b.x)], 1u);
            asm volatile("s_waitcnt vmcnt(0)" ::: "memory");
        } else {
            XB_SPIN(xb_ld(&bar[XB_XGEN(b.x)]) == gen, bar);
            __builtin_amdgcn_fence(__ATOMIC_ACQUIRE, "agent");
            asm volatile("s_waitcnt vmcnt(0)" ::: "memory");
        }
    }
    __syncthreads();
}

namespace pg8 {
constexpr int BM = 256, BK = 64, HALF = 128, HTB = HALF * BK * 2, NXCD = 8, WGM = 8;
__host__ __device__ __forceinline__ int lds_byte(int r, int c) { const int st = (r >> 4) * 2 + (c >> 5), rr = r & 15, cc = c & 31, ob = rr * 64 + cc * 2; return st * 1024 + (ob ^ (((ob >> 9) & 1) << 5)); }
__host__ __device__ __forceinline__ void stage_rc(int b, int& R, int& C) { const int st = b / 1024, sb = b % 1024, swz = sb ^ (((sb >> 9) & 1) << 5); R = (st >> 1) * 16 + swz / 64; C = (st & 1) * 32 + (swz % 64) / 2; }
__host__ __device__ __forceinline__ int perm32(int rho) { const int n = rho >> 4, i = rho & 15; return 8 * (i >> 2) + 4 * n + (i & 3); }
struct Unit { int pm, pn, aux; };
__device__ __forceinline__ void map_tile(int L, int nM, int nN, int& pm, int& pn) {
    const int nwg = nM * nN; int wgid = L;
    { const int q = nwg / NXCD, r = nwg % NXCD, xcd = wgid % NXCD, off = wgid / NXCD; wgid = (xcd < r ? xcd * (q + 1) : r * (q + 1) + (xcd - r) * q) + off; }
    const int nig = WGM * nN, gid = wgid / nig, fm = gid * WGM, gsz = (nM - fm) < WGM ? (nM - fm) : WGM;
    pm = fm + ((wgid % nig) % gsz); pn = (wgid % nig) / gsz;
}
template <class Epi, class Prob>
__device__ __forceinline__ void gemm_phase(LAS unsigned char* lds, const Prob& P, const Epi& E) {
    const int tid = threadIdx.x, wid = __builtin_amdgcn_readfirstlane(tid >> 6), lane = tid & 63, wr = wid >> 2, wc = wid & 3, fr = lane & 15, fq = lane >> 4;
    const int nt = P.K / (Prob::FP8 ? 128 : BK);
    unsigned voffB[2];
#pragma unroll
    for (int i = 0; i < 2; ++i) { int R_, C_; stage_rc(tid * 16 + i * 8192, R_, C_); const int Rb = (R_ & ~31) + perm32(R_ & 31); voffB[i] = (unsigned)(Rb * P.ldb + C_ * 2); }
#define PG8_AOFF(dst0, dst1, unit) do { _Pragma("unroll") for (int _i = 0; _i < 2; ++_i) { int R_, C_; stage_rc(tid * 16 + _i * 8192, R_, C_); dst0[_i] = P.a_off(unit, R_, C_); dst1[_i] = P.a_off(unit, R_ + HALF, C_); } } while (0)
    const size_t kstep = (size_t)(BK * 2);
    const size_t hstepB = (size_t)HALF * P.ldb;
    const unsigned ldsw = (unsigned)wid * 1024u;
    const int aoff = lds_byte(wr * 64 + fr, fq * 8), boff = lds_byte(wc * 32 + fr, fq * 8);
#define PG8_SA(b, h) (((b) * 2 + (h)) * HTB)
#define PG8_SB(b, h) ((4 + (b) * 2 + (h)) * HTB)
#define PG8_STAGE(bufoff, gbase, voff) do { _Pragma("unroll") for (int _i = 0; _i < 2; ++_i) \
        __builtin_amdgcn_global_load_lds((const unsigned*)((const char*)(gbase) + (voff)[_i]), (LAS unsigned*)(lds + (bufoff) + ldsw + _i * 8192), 16, 0, 0); } while (0)
#define PG8_LD8(addr) __builtin_shufflevector(*(const LAS i32x4*)(addr), *(const LAS i32x4*)((addr) + 1024), 0, 1, 2, 3, 4, 5, 6, 7)
#define PG8_LDA(dst, b, h) do { _Pragma("unroll") for (int m = 0; m < 4; ++m) dst[m] = PG8_LD8(lds + PG8_SA(b, h) + aoff + m * 2048); } while (0)
#define PG8_LDB(dst, b, h) do { _Pragma("unroll") for (int n = 0; n < 2; ++n) dst[n] = PG8_LD8(lds + PG8_SB(b, h) + boff + n * 2048); } while (0)
#define PG8_LO(x) __builtin_bit_cast(bf16x8, __builtin_shufflevector(x, x, 0, 1, 2, 3))
#define PG8_HI(x) __builtin_bit_cast(bf16x8, __builtin_shufflevector(x, x, 4, 5, 6, 7))
#define PG8_MMA(ai, bj, At, Bt) do { __builtin_amdgcn_s_setprio(1); _Pragma("unroll") for (int m = 0; m < 4; ++m) _Pragma("unroll") for (int n = 0; n < 2; ++n) { \
        if constexpr (Prob::FP8) asm volatile("v_mfma_scale_f32_16x16x128_f8f6f4 %0, %1, %2, %0, %3, %4 op_sel_hi:[0,0,0]" : "+v"(acc[ai][bj][m][n]) : "v"(Bt[n]), "v"(At[m]), "v"(scl_w), "v"(scl_1)); \
        else { acc[ai][bj][m][n] = __builtin_amdgcn_mfma_f32_16x16x32_bf16(PG8_LO(Bt[n]), PG8_LO(At[m]), acc[ai][bj][m][n], 0, 0, 0); \
               acc[ai][bj][m][n] = __builtin_amdgcn_mfma_f32_16x16x32_bf16(PG8_HI(Bt[n]), PG8_HI(At[m]), acc[ai][bj][m][n], 0, 0, 0); } } \
        __builtin_amdgcn_s_setprio(0); } while (0)
#define PG8_WAIT_V(n) asm volatile("s_waitcnt vmcnt(" #n ")" ::: "memory")
#define PG8_WAIT_L(n) asm volatile("s_waitcnt lgkmcnt(" #n ")" ::: "memory")
#define PG8_BAR __builtin_amdgcn_s_barrier()
#define PG8_SCHED __builtin_amdgcn_sched_barrier(0)
    Unit cur, nxt; int ui = 0;
    if (!P.next(0, cur)) return;
    f32x4 acc[2][2][4][2];
#pragma unroll
    for (int a = 0; a < 2; ++a)
#pragma unroll
        for (int b = 0; b < 2; ++b)
#pragma unroll
            for (int m = 0; m < 4; ++m)
#pragma unroll
                for (int n = 0; n < 2; ++n) acc[a][b][m][n] = (f32x4){0.f, 0.f, 0.f, 0.f};
    i32x8 At[4], B0[2], B1[2];
    int scl_w = Prob::WSCALE, scl_1 = 0x7f7f7f7f; asm volatile("" : "+v"(scl_w), "+v"(scl_1));
    unsigned cO0[2], cO1[2], nO0[2], nO1[2];
    PG8_AOFF(cO0, cO1, cur);
    const char* cA = P.a_base(cur); const char* cB = P.b_base(cur);
    PG8_STAGE(PG8_SB(0, 0), cB, voffB); PG8_STAGE(PG8_SB(0, 1), cB + hstepB, voffB); PG8_STAGE(PG8_SA(0, 0), cA, cO0); PG8_STAGE(PG8_SA(0, 1), cA, cO1);
    if (wr == 1) PG8_BAR;
    PG8_WAIT_V(2); PG8_BAR;
    PG8_STAGE(PG8_SB(1, 0), cB + kstep, voffB); PG8_STAGE(PG8_SA(1, 0), cA + kstep, cO0); PG8_STAGE(PG8_SB(1, 1), cB + hstepB + kstep, voffB);
    PG8_WAIT_V(6); PG8_BAR;
    for (;;) {
        const bool has_next = P.next(ui + 1, nxt);
        const char* nA = cA; const char* nB = cB;
        if constexpr (Prob::GATHER) {
#pragma unroll
            for (int i = 0; i < 2; ++i) { nO0[i] = cO0[i]; nO1[i] = cO1[i]; } }
        if (has_next) { nA = P.a_base(nxt); nB = P.b_base(nxt); if constexpr (Prob::GATHER) PG8_AOFF(nO0, nO1, nxt); }
        for (int t = 0; t < nt; t += 2) {
            const bool last = (t == nt - 2);
            const char* a1 = cA + (size_t)(t + 1) * kstep;
            const char* a2 = last ? nA : cA + (size_t)(t + 2) * kstep; const char* b2 = last ? nB : cB + (size_t)(t + 2) * kstep;
            const char* a3 = a2 + kstep; const char* b3 = b2 + kstep;
            unsigned o20[2], o21[2];
#pragma unroll
            for (int i = 0; i < 2; ++i) { if constexpr (Prob::GATHER) { o20[i] = last ? nO0[i] : cO0[i]; o21[i] = last ? nO1[i] : cO1[i]; } else { o20[i] = cO0[i]; o21[i] = cO1[i]; } }
            PG8_LDB(B0, 0, 0); PG8_LDB(B1, 0, 1); PG8_SCHED; PG8_LDA(At, 0, 0); PG8_STAGE(PG8_SA(1, 1), a1, cO1);
            PG8_WAIT_V(8); PG8_WAIT_L(0); PG8_BAR; PG8_MMA(0, 0, At, B0); PG8_MMA(0, 1, At, B1); PG8_BAR; PG8_SCHED;
            PG8_LDA(At, 0, 1); PG8_STAGE(PG8_SB(0, 0), b2, voffB); PG8_STAGE(PG8_SB(0, 1), b2 + hstepB, voffB); PG8_STAGE(PG8_SA(0, 0), a2, o20);
            PG8_WAIT_V(8); PG8_WAIT_L(0); PG8_BAR; PG8_MMA(1, 0, At, B0); PG8_MMA(1, 1, At, B1); PG8_BAR; PG8_SCHED;
            PG8_LDB(B0, 1, 0); PG8_LDB(B1, 1, 1); PG8_SCHED; PG8_LDA(At, 1, 0); PG8_STAGE(PG8_SA(0, 1), a2, o21);
            PG8_WAIT_V(8); PG8_WAIT_L(0); PG8_BAR; PG8_MMA(0, 0, At, B0); PG8_MMA(0, 1, At, B1); PG8_BAR; PG8_SCHED;
            PG8_LDA(At, 1, 1); PG8_STAGE(PG8_SB(1, 0), b3, voffB); PG8_STAGE(PG8_SB(1, 1), b3 + hstepB, voffB); PG8_STAGE(PG8_SA(1, 0), a3, o20);
            PG8_WAIT_V(8); PG8_WAIT_L(0); PG8_BAR; PG8_MMA(1, 0, At, B0); PG8_MMA(1, 1, At, B1); PG8_BAR; PG8_SCHED;
            if constexpr (Epi::MID) { if (t + 2 == nt / 2) E.mid(acc, cur, wr, wc, fr, fq); }
        }
        if (wr == 0) PG8_BAR;
        if constexpr (Prob::FP8) asm volatile("s_nop 15\n\ts_nop 15" ::: "memory");
        E(acc, cur, wr, wc, fr, fq);
        if (!has_next) break;
#pragma unroll
        for (int a = 0; a < 2; ++a)
#pragma unroll
            for (int b = 0; b < 2; ++b)
#pragma unroll
                for (int m = 0; m < 4; ++m)
#pragma unroll
                    for (int n = 0; n < 2; ++n) acc[a][b][m][n] = (f32x4){0.f, 0.f, 0.f, 0.f};
        cur = nxt; cA = nA; cB = nB; ++ui;
        if constexpr (Prob::GATHER) {
#pragma unroll
            for (int i = 0; i < 2; ++i) { cO0[i] = nO0[i]; cO1[i] = nO1[i]; } }
        if (wr == 1) PG8_BAR;
    }
    PG8_WAIT_V(0);
    PG8_BAR;
#undef PG8_AOFF
#undef PG8_SA
#undef PG8_SB
#undef PG8_STAGE
#undef PG8_LDA
#undef PG8_LD8
#undef PG8_LO
#undef PG8_HI
#undef PG8_LDB
#undef PG8_MMA
#undef PG8_WAIT_V
#undef PG8_WAIT_L
#undef PG8_BAR
#undef PG8_SCHED
}
}
using pg8::Unit;

struct Args { const float* in[28]; float* out; unsigned char* ws; int ph_lo, ph_hi; };
struct Frame {
    LAS unsigned char* lds;
    volatile LAS unsigned* MISC;
    unsigned* ctl;
    int tid, lane, wave, vcu, G;
    const Args* A;
    __device__ __forceinline__ bf16_t* Win_t() const { return (bf16_t*)(A->ws + WS_WIN); }
    __device__ __forceinline__ bf16_t* Wk_t() const { return (bf16_t*)(A->ws + WS_WK); }
    __device__ __forceinline__ bf16_t* Wv_t() const { return (bf16_t*)(A->ws + WS_WV); }
    __device__ __forceinline__ bf16_t* Wpab_t() const { return (bf16_t*)(A->ws + WS_WPAB); }
    __device__ __forceinline__ bf16_t* Wmo_t() const { return (bf16_t*)(A->ws + WS_WMO); }
    __device__ __forceinline__ bf16_t* Wq_t() const { return (bf16_t*)(A->ws + WS_WQ); }
    __device__ __forceinline__ bf16_t* Wo_t() const { return (bf16_t*)(A->ws + WS_WO); }
    __device__ __forceinline__ bf16_t* Wr_t() const { return (bf16_t*)(A->ws + WS_WR); }
    __device__ __forceinline__ bf16_t* W1_t() const { return (bf16_t*)(A->ws + WS_W1); }
    __device__ __forceinline__ bf16_t* W2_t() const { return (bf16_t*)(A->ws + WS_W2); }
    __device__ __forceinline__ bf16_t* sguw() const { return (bf16_t*)(A->ws + WS_SGUW); }
    __device__ __forceinline__ bf16_t* h() const { return (bf16_t*)(A->ws + WS_H); }
    __device__ __forceinline__ bf16_t* memn() const { return (bf16_t*)(A->ws + WS_MEMN); }
    __device__ __forceinline__ bf16_t* kmem() const { return (bf16_t*)(A->ws + WS_KMEM); }
    __device__ __forceinline__ bf16_t* vt() const { return (bf16_t*)(A->ws + WS_VT); }
    __device__ __forceinline__ bf16_t* qin() const { return (bf16_t*)(A->ws + WS_QIN); }
    __device__ __forceinline__ bf16_t* oab() const { return (bf16_t*)(A->ws + WS_OAB); }
    __device__ __forceinline__ bf16_t* mix() const { return (bf16_t*)(A->ws + WS_MIX); }
    __device__ __forceinline__ bf16_t* x1b() const { return (bf16_t*)(A->ws + WS_X1B); }
    __device__ __forceinline__ bf16_t* q() const { return (bf16_t*)(A->ws + WS_Q); }
    __device__ __forceinline__ bf16_t* ao() const { return (bf16_t*)(A->ws + WS_AO); }
    __device__ __forceinline__ bf16_t* x2b() const { return (bf16_t*)(A->ws + WS_X2B); }
    __device__ __forceinline__ bf16_t* p() const { return (bf16_t*)(A->ws + WS_P); }
    __device__ __forceinline__ bf16_t* act() const { return (bf16_t*)(A->ws + WS_ACT); }
    __device__ __forceinline__ bf16_t* yb() const { return (bf16_t*)(A->ws + WS_YB); }
    __device__ __forceinline__ bf16_t* ointra() const { return (bf16_t*)(A->ws + WS_OINTRA); }
    __device__ __forceinline__ bf16_t* kvT() const { return (bf16_t*)(A->ws + WS_KVT); }
    __device__ __forceinline__ float* decay() const { return (float*)(A->ws + WS_DECAY); }
    __device__ __forceinline__ float* ssq1() const { return (float*)(A->ws + WS_SSQ1); }
    __device__ __forceinline__ float* ssq2() const { return (float*)(A->ws + WS_SSQ2); }
    __device__ __forceinline__ float* lscale() const { return (float*)(A->ws + WS_LSCALE); }
    __device__ __forceinline__ float* gates() const { return (float*)(A->ws + WS_GATES); }
    __device__ __forceinline__ int* list() const { return (int*)(A->ws + WS_LIST); }
    __device__ __forceinline__ bf16_t* spT() const { return (bf16_t*)(A->ws + WS_SPT); }
    __device__ __forceinline__ unsigned char* x2q() const { return (unsigned char*)(A->ws + WS_X2Q); }
    __device__ __forceinline__ unsigned char* x1q() const { return (unsigned char*)(A->ws + WS_X1Q); }
};
enum { I_X = 0, I_MEM, I_NMIXG, I_WIN, I_WA2, I_BA, I_GOUTG, I_SNG, I_SNB, I_SW, I_SB, I_WPA, I_WPB, I_WMO, I_NXG, I_NMEMG, I_WXQ, I_WXK, I_WXV, I_WXO, I_NFFNG, I_WR, I_BR, I_WE1, I_BE1, I_WE2, I_BE2, I_NFING };

struct CvtItem { const float* src; size_t ldw; unsigned char* dst; const float* kscale; float mul; int fp8; };
__device__ __forceinline__ void cvt_load(const CvtItem& c, float (&v)[64]) {
#pragma unroll
    for (int i = 0; i < 64; ++i) v[i] = __builtin_nontemporal_load(c.src + (size_t)i * c.ldw);
}
__device__ __forceinline__ void cvt_finish(const CvtItem& c, float (&v)[64]) {
    if (c.kscale) {
#pragma unroll
        for (int i = 0; i < 64; ++i) v[i] *= c.kscale[i] * c.mul; }
    else {
#pragma unroll
        for (int i = 0; i < 64; ++i) v[i] *= c.mul; }
    if (c.fp8) {
#pragma unroll
        for (int q = 0; q < 4; ++q) { const float f0[8] = {v[16 * q], v[16 * q + 1], v[16 * q + 2], v[16 * q + 3], v[16 * q + 4], v[16 * q + 5], v[16 * q + 6], v[16 * q + 7]};
            const float f1[8] = {v[16 * q + 8], v[16 * q + 9], v[16 * q + 10], v[16 * q + 11], v[16 * q + 12], v[16 * q + 13], v[16 * q + 14], v[16 * q + 15]};
            const u32x2 lo = pack8_fp8(f0), hi = pack8_fp8(f1); *(u32x4*)(c.dst + 16 * q) = (u32x4){lo.x, lo.y, hi.x, hi.y}; } }
    else {
#pragma unroll
        for (int q = 0; q < 8; ++q) { const float f[8] = {v[8 * q], v[8 * q + 1], v[8 * q + 2], v[8 * q + 3], v[8 * q + 4], v[8 * q + 5], v[8 * q + 6], v[8 * q + 7]}; *(u32x4*)(c.dst + 16 * q) = pack8(f); } }
}
__device__ __forceinline__ CvtItem cvt_desc(const float* W, int ldw, int src_col0, int k0, void* WT, int ldt, int dst_row0, int dst_k0, const float* kscale, float mul, int fp8, int lane) {
    CvtItem c; const int eb = fp8 ? 1 : 2;
    c.src = W + (size_t)k0 * ldw + src_col0 + lane; c.ldw = (size_t)ldw; c.dst = (unsigned char*)WT + ((size_t)(dst_row0 + lane) * ldt + dst_k0 + k0) * eb;
    c.kscale = kscale ? kscale + k0 : nullptr; c.mul = mul; c.fp8 = fp8; return c;
}
template <bool Q8>
__device__ __forceinline__ void rms_row_to_bf16(const float* xrow, const float* g, bf16_t* orow, int lane) {
    f32x4 v[4]; float s = 0.f;
#pragma unroll
    for (int j = 0; j < 4; ++j) { v[j] = *(const f32x4*)(xrow + 256 * j + 4 * lane); s += (v[j].x * v[j].x + v[j].y * v[j].y) + (v[j].z * v[j].z + v[j].w * v[j].w); }
    const float rs = rsqrtf(wave_sum(s) * (1.f / D) + EPS);
#pragma unroll
    for (int j = 0; j < 4; ++j) { const f32x4 gg = *(const f32x4*)(g + 256 * j + 4 * lane);
        if constexpr (Q8) { int w = 0; w = __builtin_amdgcn_cvt_pk_fp8_f32(v[j].x * rs * gg.x, v[j].y * rs * gg.y, w, false); w = __builtin_amdgcn_cvt_pk_fp8_f32(v[j].z * rs * gg.z, v[j].w * rs * gg.w, w, true);
            *(int*)((unsigned char*)orow + 256 * j + 4 * lane) = w; }
        else { u32x2 o; o.x = cvt_pk_bf16(v[j].x * rs * gg.x, v[j].y * rs * gg.y); o.y = cvt_pk_bf16(v[j].z * rs * gg.z, v[j].w * rs * gg.w);
            *(u32x2*)(orow + 256 * j + 4 * lane) = o; } }
}
__device__ __forceinline__ void p0_prologue(Frame& F, int rep) {
    const int gw = F.vcu * 8 + F.wave, NGW = F.G * 8, lane = F.lane;
    constexpr int N_WIN = 16 * 72, N_SQ = 256, N_PA = 8 * 16, N_E1 = 512, N_E2 = 256;
    constexpr int S_WIN = 0, S_WK = S_WIN + N_WIN, S_WV = S_WK + N_SQ, S_PA = S_WV + N_SQ, S_PB = S_PA + N_PA, S_MO = S_PB + N_PA, S_Q = S_MO + N_SQ, S_O = S_Q + N_SQ, S_E1 = S_O + N_SQ, S_E2 = S_E1 + NE * N_E1, S_END = S_E2 + NE * N_E2;
    const int IEND = rep ? S_E1 : S_END;
    auto desc = [&](int it) -> CvtItem {
        if (it < S_WK) { const int r = it - S_WIN, kb = r / 72, nb = r % 72, n0 = nb * 64; return cvt_desc(F.A->in[I_WIN], INC, n0 < 1536 ? n0 : n0 + 16, kb * 64, F.Win_t(), D, n0, 0, nullptr, P1_FP8 ? FP8_WMUL : 1.f, P1_FP8, lane); }
        if (it < S_WV) { const int r = it - S_WK; return cvt_desc(F.A->in[I_WXK], D, (r & 15) * 64, (r >> 4) * 64, F.Wk_t(), D, (r & 15) * 64, 0, nullptr, P1_FP8 ? FP8_WMUL : 1.f, P1_FP8, lane); }
        if (it < S_PA) { const int r = it - S_WV; return cvt_desc(F.A->in[I_WXV], D, (r & 15) * 64, (r >> 4) * 64, F.Wv_t(), D, (r & 15) * 64, 0, nullptr, P1_FP8 ? FP8_WMUL : 1.f, P1_FP8, lane); }
        if (it < S_PB) { const int r = it - S_PA; return cvt_desc(F.A->in[I_WPA], D, (r & 15) * 64, (r >> 4) * 64, F.Wpab_t(), D, (r & 15) * 64, 0, nullptr, 1.f, 0, lane); }
        if (it < S_MO) { const int r = it - S_PB; return cvt_desc(F.A->in[I_WPB], D, (r & 15) * 64, (r >> 4) * 64, F.Wpab_t(), D, (r & 15) * 64, 512, nullptr, 1.f, 0, lane); }
        if (it < S_Q)  { const int r = it - S_MO; return cvt_desc(F.A->in[I_WMO], D, (r & 15) * 64, (r >> 4) * 64, F.Wmo_t(), D, (r & 15) * 64, 0, nullptr, 1.f, 0, lane); }
        if (it < S_O)  { const int r = it - S_Q;  return cvt_desc(F.A->in[I_WXQ], D, (r & 15) * 64, (r >> 4) * 64, F.Wq_t(), D, (r & 15) * 64, 0, F.A->in[I_NXG], FP8_WMUL, 1, lane); }
        if (it < S_E1) { const int r = it - S_O;  return cvt_desc(F.A->in[I_WXO], D, (r & 15) * 64, (r >> 4) * 64, F.Wo_t(), D, (r & 15) * 64, 0, nullptr, FP8_WMUL, 1, lane); }
        if (it < S_E2) { const int r = it - S_E1, e = r / N_E1, q = r % N_E1, kb = q >> 5, nb = q & 31, nd = nb * 64;
            const int src = ((nd & 128) ? 1024 : 0) + 128 * (nd >> 8) + (nd & 127);
            return cvt_desc(F.A->in[I_WE1] + (size_t)e * D * 2048, 2048, src, kb * 64, (unsigned char*)F.W1_t() + (size_t)e * 2048 * D, D, nd, 0, F.A->in[I_NFFNG], FP8_WMUL, 1, lane); }
        const int r = it - S_E2, e = r / N_E2, q = r % N_E2;
        return cvt_desc(F.A->in[I_WE2] + (size_t)e * D * D, D, (q & 15) * 64, (q >> 4) * 64, (unsigned char*)F.W2_t() + (size_t)e * D * D, D, (q & 15) * 64, 0, nullptr, FP8_WMUL, 1, lane); };
    if (gw < IEND) {
        float va[64], vb[64]; CvtItem ca = desc(gw), cb = ca; cvt_load(ca, va);
        for (int it = gw;;) {
            const bool hb = it + NGW < IEND; if (hb) { cb = desc(it + NGW); cvt_load(cb, vb); }
            cvt_finish(ca, va); if (!hb) break;
            const bool ha = it + 2 * NGW < IEND; if (ha) { ca = desc(it + 2 * NGW); cvt_load(ca, va); }
            cvt_finish(cb, vb); if (!ha) break;
            it += 2 * NGW; }
    }
    for (int m = gw; m < T; m += NGW) rms_row_to_bf16<P1_FP8 != 0>(F.A->in[I_X] + (size_t)m * D, F.A->in[I_NMIXG], (bf16_t*)((unsigned char*)F.h() + (size_t)m * D * (P1_FP8 ? 1 : 2)), lane);
    for (int m = gw; m < TM; m += NGW) rms_row_to_bf16<P1_FP8 != 0>(F.A->in[I_MEM] + (size_t)m * D, F.A->in[I_NMEMG], (bf16_t*)((unsigned char*)F.memn() + (size_t)m * D * (P1_FP8 ? 1 : 2)), lane);
    const int gt = F.vcu * 512 + F.tid, NGT = F.G * 512;
    for (int i = gt; i < 256 * D; i += NGT) { const int j = i >> 10, k = i & 1023; const float* wr_ = F.A->in[I_WIN] + (size_t)k * INC + OFF_A; float s = 0.f;
#pragma unroll
        for (int r = 0; r < 16; ++r) s += wr_[r] * F.A->in[I_WA2][r * 256 + j];
        if (P1_FP8) { int w = __builtin_amdgcn_cvt_pk_fp8_f32(s * FP8_WMUL, 0.f, 0, false); ((unsigned char*)F.Win_t())[(size_t)(PC_A + j) * D + k] = (unsigned char)(w & 0xff); }
        else F.Win_t()[(size_t)(PC_A + j) * D + k] = f2bf(s); }
    for (int i = gt; i < NE * D; i += NGT) { const int e = i >> 10, k = i & 1023; F.Wr_t()[i] = f2bf(F.A->in[I_WR][k * NE + e] * F.A->in[I_NFFNG][k]); }
    for (int i = gt; i < 4 * 128 * 128; i += NGT) { const int t = (i >> 7) & 127, s = i & 127; F.sguw()[i] = f2bf(s <= t ? F.A->in[I_SW][i] : 0.f); }
}

struct ProbP1 {
    static constexpr bool GATHER = false, FP8 = (P1_FP8 != 0); static constexpr int EB = P1_FP8 ? 1 : 2, WSCALE = FP8_WSCALE;
    int K, lda, ldb, G, c; const unsigned char* ws;
    __device__ __forceinline__ bool next(int i, Unit& u) const {
        const int L = i * G + c;
        if (L < 1216) { u.aux = 0; pg8::map_tile(L, 64, 19, u.pm, u.pn); return true; }
        if (L < 1248) { u.aux = 1; u.pm = (L - 1216) >> 2; u.pn = (L - 1216) & 3; return true; }
        if (L < 1280) { u.aux = 2; u.pm = (L - 1248) >> 3; u.pn = (L - 1248) & 7; return true; }
        return false;
    }
    __device__ __forceinline__ const char* a_base(const Unit& u) const { const size_t o = u.aux == 0 ? WS_H : (u.aux == 1 ? WS_MEMN : WS_WV); return (const char*)(ws + o + (size_t)u.pm * 256 * D * EB); }
    __device__ __forceinline__ const char* b_base(const Unit& u) const { const size_t o = u.aux == 0 ? WS_WIN : (u.aux == 1 ? WS_WK : WS_MEMN); return (const char*)(ws + o + (size_t)u.pn * 256 * D * EB); }
    __device__ __forceinline__ unsigned a_off(const Unit&, int row, int C) const { return (unsigned)(row * D * EB + C * 2); }
};
struct EpiP1 {
    static constexpr bool MID = false;
    unsigned char* ws;
    __device__ __forceinline__ void operator()(const f32x4 (&acc)[2][2][4][2], const Unit& u, int wr, int wc, int fr, int fq) const {
        asm volatile("" : "+v"(fr), "+v"(fq));
        const size_t oo = u.aux == 0 ? WS_P : (u.aux == 1 ? WS_KMEM : WS_VT);
        bf16_t* O = (bf16_t*)(ws + oo); const int ldc = u.aux == 0 ? PN : (u.aux == 1 ? D : TM);
        const int act = (u.aux == 0) ? ((u.pn >= 6 && u.pn < 10) ? 1 : ((u.pn >= 10 && u.pn < 18) ? 2 : 0)) : 0;
        const int row0 = u.pm * 256 + wr * 64 + fr, col0 = u.pn * 256 + wc * 32 + 8 * fq; const bool svstat = (u.aux == 0) && (u.pn == 8 || u.pn == 9);
#pragma unroll
        for (int ai = 0; ai < 2; ++ai)
#pragma unroll
            for (int m = 0; m < 4; ++m) { bf16_t* rowp = O + (size_t)(row0 + ai * 128 + m * 16) * ldc + col0; float s1 = 0.f, s2 = 0.f;
#pragma unroll
                for (int bj = 0; bj < 2; ++bj) { float v[8];
#pragma unroll
                    for (int j = 0; j < 4; ++j) { v[j] = acc[ai][bj][m][0][j]; v[4 + j] = acc[ai][bj][m][1][j]; }
                    if (act == 1) {
#pragma unroll
                        for (int j = 0; j < 8; j += 2) { const f32x2 o = gelu_pk((f32x2){v[j], v[j + 1]}); v[j] = o.x; v[j + 1] = o.y; }
#pragma unroll
                        for (int j = 0; j < 8; ++j) { s1 += v[j]; s2 += v[j] * v[j]; } }
                    else if (act == 2) {
#pragma unroll
                        for (int j = 0; j < 8; j += 2) { const f32x2 o = sigmoid_pk((f32x2){v[j], v[j + 1]}); v[j] = o.x; v[j + 1] = o.y; } }
                    *(u32x4*)(rowp + bj * 128) = pack8(v); }
                if (svstat) {
                    s1 += __shfl_xor(s1, 16); s1 += __shfl_xor(s1, 32); s2 += __shfl_xor(s2, 16); s2 += __shfl_xor(s2, 32);
                    if (fq == 0) *(f32x2*)((float*)(ws + WS_SVS) + (size_t)(row0 + ai * 128 + m * 16) * 16 + (u.pn - 8) * 8 + wc * 2) = (f32x2){s1, s2}; } }
    }
};

__device__ __forceinline__ void gla_a_unit(Frame& F, int unit) {
    const int tid = F.tid, lane = F.lane, w = F.wave, fr = lane & 15, fq = lane >> 4;
    const int bh = unit >> 5, n = unit & 31, b = bh >> 2, h = bh & 3;
    const int t0 = b * SEQ + n * 64;
    LAS float* cum = (LAS float*)(F.lds); LAS float* tot = (LAS float*)(F.lds + 16640);
    LAS bf16_t* QIN = (LAS bf16_t*)(F.lds + 18688); LAS bf16_t* KIN = (LAS bf16_t*)(F.lds + 27904); LAS bf16_t* KOT = (LAS bf16_t*)(F.lds + 37120);
    LAS bf16_t* ATT = (LAS bf16_t*)(F.lds + 46336); LAS bf16_t* VT = (LAS bf16_t*)(F.lds + 55552);
    const int c = tid >> 3, d8 = (tid & 7) * 8;
    {
        float g[8]; unpack8(*(const u32x4*)(F.p() + (size_t)(t0 + c) * PN + PC_A + h * 64 + d8), g);
        const f32x4 b0 = *(const f32x4*)(F.A->in[I_BA] + h * 64 + d8), b1 = *(const f32x4*)(F.A->in[I_BA] + h * 64 + d8 + 4);
        const float bb[8] = {b0.x, b0.y, b0.z, b0.w, b1.x, b1.y, b1.z, b1.w};
#pragma unroll
        for (int j = 0; j < 8; ++j) { const float x = g[j] + bb[j]; const float ls = fminf(x, 0.f) - __logf(1.f + __expf(-fabsf(x))); cum[c * 65 + d8 + j] = ls * 0.0625f; }
    }
    __syncthreads();
    { const int d = tid & 63, seg = tid >> 6; float run = 0.f;
#pragma unroll
        for (int i = 0; i < 8; ++i) { run += cum[(seg * 8 + i) * 65 + d]; cum[(seg * 8 + i) * 65 + d] = run; }
        tot[seg * 64 + d] = run; }
    __syncthreads();
    { const int d = tid & 63, seg = tid >> 6; float off = 0.f;
#pragma unroll
        for (int s = 0; s < 7; ++s) if (s < seg) off += tot[s * 64 + d];
#pragma unroll
        for (int i = 0; i < 8; ++i) cum[(seg * 8 + i) * 65 + d] += off; }
    __syncthreads();
    {
        float qv[8], kv[8], qi[8], ki[8];
        unpack8(*(const u32x4*)(F.p() + (size_t)(t0 + c) * PN + PC_Q + h * 64 + d8), qv);
        unpack8(*(const u32x4*)(F.p() + (size_t)(t0 + c) * PN + PC_K + h * 64 + d8), kv);
#pragma unroll
        for (int j = 0; j < 8; ++j) { const float cm = cum[c * 65 + d8 + j], cl = cum[63 * 65 + d8 + j];
            qi[j] = qv[j] * 0.125f * __expf(cm); ki[j] = kv[j] * __expf(-cm);
            KOT[(d8 + j) * 72 + c] = f2bf(kv[j] * __expf(cl - cm));
            if (c == 63) F.decay()[unit * 64 + d8 + j] = __expf(cl); }
        const u32x4 qp = pack8(qi), kp = pack8(ki);
        *(LAS u32x4*)(QIN + c * 72 + d8) = qp; *(LAS u32x4*)(KIN + c * 72 + d8) = kp;
        *(u32x4*)(F.qin() + (size_t)(t0 + c) * 256 + h * 64 + d8) = qp;
        const int e16 = (tid & 7) * 16;
#pragma unroll
        for (int hh = 0; hh < 2; ++hh) { const u32x4 vv = *(const u32x4*)(F.p() + (size_t)(t0 + c) * PN + PC_V + h * 128 + e16 + 8 * hh);
            const unsigned ww[4] = {vv.x, vv.y, vv.z, vv.w};
#pragma unroll
            for (int j = 0; j < 4; ++j) { VT[(e16 + 8 * hh + 2 * j) * 72 + c] = (bf16_t)(ww[j] & 0xffffu); VT[(e16 + 8 * hh + 2 * j + 1) * 72 + c] = (bf16_t)(ww[j] >> 16); } }
    }
    __syncthreads();
    {
        const int mt = w >> 1;
        bf16x8 a[2];
#pragma unroll
        for (int ks = 0; ks < 2; ++ks) a[ks] = *(const LAS bf16x8*)(QIN + (16 * mt + fr) * 72 + 32 * ks + 8 * fq);
#pragma unroll
        for (int q = 0; q < 2; ++q) { const int nt = (w & 1) * 2 + q; f32x4 s = {0.f, 0.f, 0.f, 0.f};
#pragma unroll
            for (int ks = 0; ks < 2; ++ks) s = mma16(a[ks], *(const LAS bf16x8*)(KIN + (16 * nt + fr) * 72 + 32 * ks + 8 * fq), s);
#pragma unroll
            for (int r = 0; r < 4; ++r) { const int cc = 16 * mt + 4 * fq + r, ss = 16 * nt + fr; ATT[cc * 72 + ss] = f2bf(ss <= cc ? s[r] : 0.f); } }
    }
    __syncthreads();
    {
        const int mt = w >> 1, nt0 = (w & 1) * 4;
        bf16x8 aa[2], ak[2];
#pragma unroll
        for (int ks = 0; ks < 2; ++ks) { aa[ks] = *(const LAS bf16x8*)(ATT + (16 * mt + fr) * 72 + 32 * ks + 8 * fq); ak[ks] = *(const LAS bf16x8*)(KOT + (16 * mt + fr) * 72 + 32 * ks + 8 * fq); }
#pragma unroll
        for (int q = 0; q < 4; ++q) { const int nt = nt0 + q; f32x4 o = {0.f, 0.f, 0.f, 0.f}, kvv = {0.f, 0.f, 0.f, 0.f};
#pragma unroll
            for (int ks = 0; ks < 2; ++ks) { const bf16x8 bv = *(const LAS bf16x8*)(VT + (16 * nt + fr) * 72 + 32 * ks + 8 * fq); o = mma16(bv, aa[ks], o); kvv = mma16(ak[ks], bv, kvv); }
            *(u32x2*)(F.ointra() + (size_t)(t0 + 16 * mt + fr) * 512 + h * 128 + 16 * nt + 4 * fq) = (u32x2){cvt_pk_bf16(o[0], o[1]), cvt_pk_bf16(o[2], o[3])};
            *(u32x2*)(F.kvT() + ((size_t)unit * 128 + 16 * nt + fr) * 64 + 16 * mt + 4 * fq) = (u32x2){cvt_pk_bf16(kvv[0], kvv[1]), cvt_pk_bf16(kvv[2], kvv[3])}; }
    }
    __syncthreads();
}

__device__ __forceinline__ void gla_sscan_item(Frame& F, int item) {
    const int lane = F.lane, idx = item * 64 + lane, d4 = idx & 15, e = (idx >> 4) & 127, bh = idx >> 11;
    const bf16_t* kvp = F.kvT() + ((size_t)(bh * 32) * 128 + e) * 64 + d4 * 4; const float* dcp = F.decay() + (size_t)(bh * 32) * 64 + d4 * 4;
    bf16_t* sp = F.spT() + ((size_t)(bh * 32) * 128 + e) * 64 + d4 * 4;
    f32x4 S = {0.f, 0.f, 0.f, 0.f};
    for (int n0 = 0; n0 < 32; n0 += 8) { f32x4 kv[8], dc[8];
#pragma unroll
        for (int i = 0; i < 8; ++i) { const u32x2 kw = *(const u32x2*)(kvp + (size_t)(n0 + i) * 128 * 64); kv[i] = (f32x4){bflo(kw.x), bfhi(kw.x), bflo(kw.y), bfhi(kw.y)}; dc[i] = *(const f32x4*)(dcp + (size_t)(n0 + i) * 64); }
#pragma unroll
        for (int i = 0; i < 8; ++i) { u32x2 o; o.x = cvt_pk_bf16(S.x, S.y); o.y = cvt_pk_bf16(S.z, S.w); *(u32x2*)(sp + (size_t)(n0 + i) * 128 * 64) = o; S = dc[i] * S + kv[i]; } }
}
__device__ __forceinline__ void sgu_unit(Frame& F, int unit) {
    const int tid = F.tid, w = F.wave, lane = F.lane, fr = lane & 15, fq = lane >> 4, ch = unit >> 2, g = unit & 3, t0 = ch * 128;
    LAS f32x2* stat = (LAS f32x2*)F.lds; LAS bf16_t* vnT = (LAS bf16_t*)(F.lds + 1024);
    if (tid < 128) { const float* sp = (const float*)(F.A->ws + WS_SVS) + (size_t)(t0 + tid) * 16;
        const f32x4 a = *(const f32x4*)sp, b = *(const f32x4*)(sp + 4), c4 = *(const f32x4*)(sp + 8), d = *(const f32x4*)(sp + 12);
        const float s = (a.x + a.z) + (b.x + b.z) + (c4.x + c4.z) + (d.x + d.z), s2 = (a.y + a.w) + (b.y + b.w) + (c4.y + c4.w) + (d.y + d.w);
        const float mean = s * (1.f / 512.f), var = fmaxf(s2 * (1.f / 512.f) - mean * mean, 0.f);
        stat[tid] = (f32x2){mean, rsqrtf(var + EPS)}; }
    __syncthreads();
    { const int s = tid >> 2, c32 = (tid & 3) * 32; const f32x2 ms = stat[s];
#pragma unroll
        for (int q = 0; q < 4; ++q) { float v[8]; unpack8(*(const u32x4*)(F.p() + (size_t)(t0 + s) * PN + PC_SV + g * 128 + c32 + 8 * q), v);
#pragma unroll
            for (int j = 0; j < 8; ++j) { const int cidx = g * 128 + c32 + 8 * q + j; vnT[(c32 + 8 * q + j) * 136 + s] = f2bf((v[j] - ms.x) * ms.y * F.A->in[I_SNG][cidx] + F.A->in[I_SNB][cidx]); } } }
    __syncthreads();
    f32x4 acc[8];
#pragma unroll
    for (int ct = 0; ct < 8; ++ct) acc[ct] = (f32x4){0.f, 0.f, 0.f, 0.f};
    const int nks = (16 * w + 15) / 32 + 1;
    for (int ks = 0; ks < nks; ++ks) { const bf16x8 bw = *(const bf16x8*)(F.sguw() + (size_t)(g * 128 + 16 * w + fr) * 128 + 32 * ks + 8 * fq);
#pragma unroll
        for (int ct = 0; ct < 8; ++ct) acc[ct] = mma16(*(const LAS bf16x8*)(vnT + (16 * ct + fr) * 136 + 32 * ks + 8 * fq), bw, acc[ct]); }
    {
        const int t = 16 * w + fr; const float bias = F.A->in[I_SB][g * 128 + t];
        u32x2 uv[8];
#pragma unroll
        for (int ct = 0; ct < 8; ++ct) uv[ct] = *(const u32x2*)(F.p() + (size_t)(t0 + t) * PN + PC_U + g * 128 + 16 * ct + 4 * fq);
#pragma unroll
        for (int ct = 0; ct < 8; ++ct) { const int cidx = g * 128 + 16 * ct + 4 * fq; const u32x2 uu = uv[ct];
            u32x2 o; o.x = cvt_pk_bf16(bflo(uu.x) * (acc[ct][0] + bias), bfhi(uu.x) * (acc[ct][1] + bias)); o.y = cvt_pk_bf16(bflo(uu.y) * (acc[ct][2] + bias), bfhi(uu.y) * (acc[ct][3] + bias));
            *(u32x2*)(F.oab() + (size_t)(t0 + t) * D + 512 + cidx) = o; } }
    __syncthreads();
}
__device__ __forceinline__ void gla_out_item(Frame& F, int item) {
    const int lane = F.lane, fr = lane & 15, fq = lane >> 4, unit = item >> 2, mt = item & 3;
    const int bh = unit >> 5, n = unit & 31, b = bh >> 2, h = bh & 3; const size_t t = (size_t)b * SEQ + n * 64 + 16 * mt + fr;
    bf16x8 qf[2];
#pragma unroll
    for (int ks = 0; ks < 2; ++ks) qf[ks] = *(const bf16x8*)(F.qin() + t * 256 + h * 64 + 32 * ks + 8 * fq);
    const bf16_t* sp = F.spT() + (size_t)unit * 128 * 64;
    f32x4 o[8]; float ss = 0.f;
#pragma unroll
    for (int et = 0; et < 8; ++et) { const u32x2 ow = *(const u32x2*)(F.ointra() + t * 512 + h * 128 + 16 * et + 4 * fq); f32x4 acc = {bflo(ow.x), bfhi(ow.x), bflo(ow.y), bfhi(ow.y)};
#pragma unroll
        for (int ks = 0; ks < 2; ++ks) acc = mma16(*(const bf16x8*)(sp + (size_t)(16 * et + fr) * 64 + 32 * ks + 8 * fq), qf[ks], acc);
        o[et] = acc; ss += (acc[0] * acc[0] + acc[1] * acc[1]) + (acc[2] * acc[2] + acc[3] * acc[3]); }
    ss += __shfl_xor(ss, 16); ss += __shfl_xor(ss, 32);
    const float rstd = rsqrtf(ss * (1.f / 128.f) + EPS);
    f32x4 gv[8]; u32x2 rv[8];
#pragma unroll
    for (int et = 0; et < 8; ++et) { const int e = h * 128 + 16 * et + 4 * fq; gv[et] = *(const f32x4*)(F.A->in[I_GOUTG] + e); rv[et] = *(const u32x2*)(F.p() + t * PN + PC_R + e); }
#pragma unroll
    for (int et = 0; et < 8; ++et) { const int e = h * 128 + 16 * et + 4 * fq; const f32x4 g = gv[et];
        const u32x2 rr = rv[et]; const float r0 = bflo(rr.x), r1 = bfhi(rr.x), r2 = bflo(rr.y), r3 = bfhi(rr.y);
        u32x2 ov; ov.x = cvt_pk_bf16(o[et][0] * rstd * g.x * r0 * sigmoidf_(r0), o[et][1] * rstd * g.y * r1 * sigmoidf_(r1));
        ov.y = cvt_pk_bf16(o[et][2] * rstd * g.z * r2 * sigmoidf_(r2), o[et][3] * rstd * g.w * r3 * sigmoidf_(r3));
        *(u32x2*)(F.oab() + t * D + e) = ov; }
}

struct ProbSeg {
    static constexpr bool GATHER = false, FP8 = false; static constexpr int WSCALE = FP8_WSCALE;
    int K, lda, ldb, G, c; const bf16_t *oab, *Wpab_t;
    __device__ __forceinline__ bool next(int i, Unit& u) const { const int L = (i >> 1) * G + c; if (L >= 256) return false; pg8::map_tile(L, 64, 4, u.pm, u.pn); u.aux = i & 1; return true; }
    __device__ __forceinline__ const char* a_base(const Unit& u) const { return (const char*)(oab + (size_t)u.pm * 256 * D + u.aux * 512); }
    __device__ __forceinline__ const char* b_base(const Unit& u) const { return (const char*)(Wpab_t + (size_t)u.pn * 256 * D + u.aux * 512); }
    __device__ __forceinline__ unsigned a_off(const Unit&, int row, int C) const { return (unsigned)(row * D + C) * 2u; }
};
struct EpiMix {
    static constexpr bool MID = false;
    const bf16_t* p; bf16_t* mix;
    __device__ __forceinline__ void operator()(const f32x4 (&acc)[2][2][4][2], const Unit& u, int wr, int wc, int fr, int fq) const {
        asm volatile("" : "+v"(fr), "+v"(fq));
        const int row0 = u.pm * 256 + wr * 64 + fr, col0 = u.pn * 256 + wc * 32 + 8 * fq, gc = u.aux ? PC_GB : PC_GA;
#pragma unroll
        for (int ai = 0; ai < 2; ++ai) {
            u32x4 gw[4][2], pw[4][2];
#pragma unroll
            for (int m = 0; m < 4; ++m)
#pragma unroll
                for (int bj = 0; bj < 2; ++bj) { const size_t row = (size_t)(row0 + ai * 128 + m * 16);
                    gw[m][bj] = *(const u32x4*)(p + row * PN + gc + col0 + bj * 128);
                    pw[m][bj] = u.aux ? *(const u32x4*)(mix + row * D + col0 + bj * 128) : (u32x4){0u, 0u, 0u, 0u}; }
#pragma unroll
            for (int m = 0; m < 4; ++m)
#pragma unroll
                for (int bj = 0; bj < 2; ++bj) { const size_t row = (size_t)(row0 + ai * 128 + m * 16); float g[8], pv[8], v[8]; unpack8(gw[m][bj], g); unpack8(pw[m][bj], pv);
#pragma unroll
                    for (int j = 0; j < 4; ++j) { v[j] = acc[ai][bj][m][0][j] * g[j] + pv[j]; v[4 + j] = acc[ai][bj][m][1][j] * g[4 + j] + pv[4 + j]; }
                    *(u32x4*)(mix + row * D + col0 + bj * 128) = pack8(v); } }
    }
};

struct EpiMix2 {
    static constexpr bool MID = true;
    const bf16_t* p; bf16_t* mix;
    __device__ __forceinline__ void mid(f32x4 (&acc)[2][2][4][2], const Unit& u, int wr, int wc, int fr, int fq) const {
        asm volatile("" : "+v"(fr), "+v"(fq));
        const int row0 = u.pm * 256 + wr * 64 + fr, col0 = u.pn * 256 + wc * 32 + 8 * fq;
#pragma unroll
        for (int ai = 0; ai < 2; ++ai) { u32x4 ga[4][2], gb[4][2];
#pragma unroll
            for (int m = 0; m < 4; ++m)
#pragma unroll
                for (int bj = 0; bj < 2; ++bj) { const size_t row = (size_t)(row0 + ai * 128 + m * 16); ga[m][bj] = *(const u32x4*)(p + row * PN + PC_GA + col0 + bj * 128); gb[m][bj] = *(const u32x4*)(p + row * PN + PC_GB + col0 + bj * 128); }
#pragma unroll
            for (int m = 0; m < 4; ++m)
#pragma unroll
                for (int bj = 0; bj < 2; ++bj) { float a[8], b[8]; unpack8(ga[m][bj], a); unpack8(gb[m][bj], b);
#pragma unroll
                    for (int j = 0; j < 4; ++j) { acc[ai][bj][m][0][j] *= a[j] * __builtin_amdgcn_rcpf(fmaxf(b[j], 1e-20f)); acc[ai][bj][m][1][j] *= a[4 + j] * __builtin_amdgcn_rcpf(fmaxf(b[4 + j], 1e-20f)); } } }
    }
    __device__ __forceinline__ void operator()(const f32x4 (&acc)[2][2][4][2], const Unit& u, int wr, int wc, int fr, int fq) const {
        asm volatile("" : "+v"(fr), "+v"(fq));
        const int row0 = u.pm * 256 + wr * 64 + fr, col0 = u.pn * 256 + wc * 32 + 8 * fq;
#pragma unroll
        for (int ai = 0; ai < 2; ++ai) { u32x4 gb[4][2];
#pragma unroll
            for (int m = 0; m < 4; ++m)
#pragma unroll
                for (int bj = 0; bj < 2; ++bj) gb[m][bj] = *(const u32x4*)(p + (size_t)(row0 + ai * 128 + m * 16) * PN + PC_GB + col0 + bj * 128);
#pragma unroll
            for (int m = 0; m < 4; ++m)
#pragma unroll
                for (int bj = 0; bj < 2; ++bj) { float b[8], v[8]; unpack8(gb[m][bj], b);
#pragma unroll
                    for (int j = 0; j < 4; ++j) { v[j] = acc[ai][bj][m][0][j] * fmaxf(b[j], 1e-20f); v[4 + j] = acc[ai][bj][m][1][j] * fmaxf(b[4 + j], 1e-20f); }
                    *(u32x4*)(mix + (size_t)(row0 + ai * 128 + m * 16) * D + col0 + bj * 128) = pack8(v); } }
    }
};

template <bool Q8 = false, int WS_ = FP8_WSCALE> struct ProbStdT {
    static constexpr bool GATHER = false, FP8 = Q8; static constexpr int WSCALE = WS_, EB = Q8 ? 1 : 2;
    int K, lda, ldb, G, c; const void *A, *Bt;
    __device__ __forceinline__ bool next(int i, Unit& u) const { const int L = i * G + c; if (L >= 256) return false; pg8::map_tile(L, 64, 4, u.pm, u.pn); u.aux = 0; return true; }
    __device__ __forceinline__ const char* a_base(const Unit& u) const { return (const char*)A + (size_t)u.pm * 256 * D * EB; }
    __device__ __forceinline__ const char* b_base(const Unit& u) const { return (const char*)Bt + (size_t)u.pn * 256 * D * EB; }
    __device__ __forceinline__ unsigned a_off(const Unit&, int row, int C) const { return (unsigned)(row * D * EB + C * 2); }
};
typedef ProbStdT<false> ProbStd;
template <bool RESF32> struct EpiRes {
    static constexpr bool MID = false;
    const void* res; bf16_t* outb; float* ssq; unsigned char* outq;
    __device__ __forceinline__ void operator()(const f32x4 (&acc)[2][2][4][2], const Unit& u, int wr, int wc, int fr, int fq) const {
        asm volatile("" : "+v"(fr), "+v"(fq));
        const int row0 = u.pm * 256 + wr * 64 + fr, col0 = u.pn * 256 + wc * 32 + 8 * fq;
#pragma unroll
        for (int ai = 0; ai < 2; ++ai) {
            f32x4 rf[4][2][2]; u32x4 rb[4][2];
#pragma unroll
            for (int m = 0; m < 4; ++m)
#pragma unroll
                for (int bj = 0; bj < 2; ++bj) { const size_t off = (size_t)(row0 + ai * 128 + m * 16) * D + col0 + bj * 128;
                    if (RESF32) { rf[m][bj][0] = *(const f32x4*)((const float*)res + off); rf[m][bj][1] = *(const f32x4*)((const float*)res + off + 4); }
                    else rb[m][bj] = *(const u32x4*)((const bf16_t*)res + off); }
#pragma unroll
            for (int m = 0; m < 4; ++m) { const size_t row = (size_t)(row0 + ai * 128 + m * 16); float sq = 0.f;
#pragma unroll
                for (int bj = 0; bj < 2; ++bj) { float r[8], v[8];
                    if (RESF32) { r[0] = rf[m][bj][0].x; r[1] = rf[m][bj][0].y; r[2] = rf[m][bj][0].z; r[3] = rf[m][bj][0].w; r[4] = rf[m][bj][1].x; r[5] = rf[m][bj][1].y; r[6] = rf[m][bj][1].z; r[7] = rf[m][bj][1].w; }
                    else unpack8(rb[m][bj], r);
#pragma unroll
                    for (int j = 0; j < 4; ++j) { v[j] = acc[ai][bj][m][0][j] + r[j]; v[4 + j] = acc[ai][bj][m][1][j] + r[4 + j]; }
#pragma unroll
                    for (int j = 0; j < 8; ++j) sq += v[j] * v[j];
                    *(u32x4*)(outb + row * D + col0 + bj * 128) = pack8(v);
                    *(u32x2*)(outq + row * D + col0 + bj * 128) = pack8_fp8(v); }
                sq += __shfl_xor(sq, 16); sq += __shfl_xor(sq, 32);
                if (fq == 0) ssq[row * 16 + u.pn * 4 + wc] = sq; } }
    }
};
__device__ __forceinline__ float row_rs(const float* ssq, size_t row) {
    const f32x4 a = *(const f32x4*)(ssq + row * 16), b = *(const f32x4*)(ssq + row * 16 + 4), c = *(const f32x4*)(ssq + row * 16 + 8), d = *(const f32x4*)(ssq + row * 16 + 12);
    const float s = ((a.x + a.y) + (a.z + a.w)) + ((b.x + b.y) + (b.z + b.w)) + ((c.x + c.y) + (c.z + c.w)) + ((d.x + d.y) + (d.z + d.w));
    return rsqrtf(s * (1.f / D) + EPS);
}
struct EpiScale {
    static constexpr bool MID = false;
    const float* ssq; bf16_t* outb;
    __device__ __forceinline__ void operator()(const f32x4 (&acc)[2][2][4][2], const Unit& u, int wr, int wc, int fr, int fq) const {
        asm volatile("" : "+v"(fr), "+v"(fq));
        const int row0 = u.pm * 256 + wr * 64 + fr, col0 = u.pn * 256 + wc * 32 + 8 * fq;
        float rs[2][4];
#pragma unroll
        for (int ai = 0; ai < 2; ++ai)
#pragma unroll
            for (int m = 0; m < 4; ++m) rs[ai][m] = row_rs(ssq, (size_t)(row0 + ai * 128 + m * 16));
#pragma unroll
        for (int ai = 0; ai < 2; ++ai)
#pragma unroll
            for (int m = 0; m < 4; ++m) { const size_t row = (size_t)(row0 + ai * 128 + m * 16);
#pragma unroll
                for (int bj = 0; bj < 2; ++bj) { float v[8];
#pragma unroll
                    for (int j = 0; j < 4; ++j) { v[j] = acc[ai][bj][m][0][j] * rs[ai][m]; v[4 + j] = acc[ai][bj][m][1][j] * rs[ai][m]; }
                    *(u32x4*)(outb + row * D + col0 + bj * 128) = pack8(v); } }
    }
};

__device__ __forceinline__ void attn_unit(Frame& F, int unit) {
    const int tid = F.tid, w = F.wave, lane = F.lane, fr = lane & 15, fq = lane >> 4;
    const int b = unit >> 5, h = (unit >> 3) & 3, qb = unit & 7;
    const size_t tq = (size_t)b * SEQ + qb * 256 + 32 * w;
    LAS unsigned char* const bufs[2] = {F.lds, F.lds + 36864};
    const bf16_t* kg = F.kmem() + (size_t)(b * 256 + (tid >> 1)) * D + h * 256 + (tid & 1) * 32;
    const int kls = (tid >> 1) * 144 + (tid & 1) * 64;
    const bf16_t* vg = F.vt() + (size_t)(h * 256 + (tid >> 3)) * TM + b * 256 + (tid & 7) * 32;
    const int vls = (tid >> 3) * 528 + (tid & 7) * 64;
    u32x4 st[4];
#pragma unroll
    for (int i = 0; i < 4; ++i) st[i] = *(const u32x4*)(kg + 8 * i);
#pragma unroll
    for (int i = 0; i < 4; ++i) *(LAS u32x4*)(bufs[0] + kls + 16 * i) = st[i];
    __syncthreads();
    f32x4 s[16][2];
#pragma unroll
    for (int nt = 0; nt < 16; ++nt) { s[nt][0] = (f32x4){0.f, 0.f, 0.f, 0.f}; s[nt][1] = (f32x4){0.f, 0.f, 0.f, 0.f}; }
#pragma unroll
    for (int c = 0; c < 4; ++c) {
        if (c < 3) {
#pragma unroll
            for (int i = 0; i < 4; ++i) st[i] = *(const u32x4*)(kg + 64 * (c + 1) + 8 * i); }
        else {
#pragma unroll
            for (int i = 0; i < 4; ++i) st[i] = *(const u32x4*)(vg + 8 * i); }
        LAS unsigned char* kb = bufs[c & 1];
        bf16x8 qf[2][2];
#pragma unroll
        for (int qt = 0; qt < 2; ++qt)
#pragma unroll
            for (int ks = 0; ks < 2; ++ks) qf[qt][ks] = *(const bf16x8*)(F.q() + (tq + 16 * qt + fr) * D + h * 256 + 64 * c + 32 * ks + 8 * fq);
#pragma unroll
        for (int nt = 0; nt < 16; ++nt)
#pragma unroll
            for (int ks = 0; ks < 2; ++ks) { const bf16x8 a = *(const LAS bf16x8*)(kb + (16 * nt + fr) * 144 + (32 * ks + 8 * fq) * 2);
                s[nt][0] = mma16(a, qf[0][ks], s[nt][0]); s[nt][1] = mma16(a, qf[1][ks], s[nt][1]); }
        if (c < 3) {
#pragma unroll
            for (int i = 0; i < 4; ++i) *(LAS u32x4*)(bufs[(c + 1) & 1] + kls + 16 * i) = st[i]; }
        __syncthreads();
    }
#pragma unroll
    for (int i = 0; i < 4; ++i) *(LAS u32x4*)(bufs[0] + vls + 16 * i) = st[i];
    float inv[2]; bf16x8 pb[2][8];
#pragma unroll
    for (int qt = 0; qt < 2; ++qt) { float mx = s[0][qt][0];
#pragma unroll
        for (int nt = 0; nt < 16; ++nt)
#pragma unroll
            for (int r = 0; r < 4; ++r) mx = fmaxf(mx, s[nt][qt][r]);
        mx = fmaxf(mx, __shfl_xor(mx, 16)); mx = fmaxf(mx, __shfl_xor(mx, 32));
        float sum = 0.f;
#pragma unroll
        for (int nt = 0; nt < 16; ++nt)
#pragma unroll
            for (int r = 0; r < 4; ++r) { const float e = __expf(s[nt][qt][r] - mx); s[nt][qt][r] = e; sum += e; }
        sum += __shfl_xor(sum, 16); sum += __shfl_xor(sum, 32);
        inv[qt] = __builtin_amdgcn_rcpf(sum);
#pragma unroll
        for (int sk = 0; sk < 8; ++sk) { const float pv[8] = {s[2 * sk][qt][0], s[2 * sk][qt][1], s[2 * sk][qt][2], s[2 * sk][qt][3], s[2 * sk + 1][qt][0], s[2 * sk + 1][qt][1], s[2 * sk + 1][qt][2], s[2 * sk + 1][qt][3]};
            const u32x4 pk = pack8(pv); pb[qt][sk] = __builtin_bit_cast(bf16x8, pk); } }
    __syncthreads();
#pragma unroll
    for (int c = 0; c < 4; ++c) {
        if (c < 3) {
#pragma unroll
            for (int i = 0; i < 4; ++i) st[i] = *(const u32x4*)(vg + (size_t)64 * (c + 1) * TM + 8 * i); }
        LAS unsigned char* vb = bufs[c & 1];
#pragma unroll
        for (int dt = 0; dt < 4; ++dt) { f32x4 o0 = {0.f, 0.f, 0.f, 0.f}, o1 = {0.f, 0.f, 0.f, 0.f};
#pragma unroll
            for (int sk = 0; sk < 8; ++sk) { const LAS unsigned char* vp = vb + (16 * dt + fr) * 528 + (32 * sk + 4 * fq) * 2;
                const u32x2 lo = *(const LAS u32x2*)vp, hi = *(const LAS u32x2*)(vp + 32);
                const u32x4 av = {lo.x, lo.y, hi.x, hi.y}; const bf16x8 a = __builtin_bit_cast(bf16x8, av);
                o0 = mma16(a, pb[0][sk], o0); o1 = mma16(a, pb[1][sk], o1); }
            const int col = h * 256 + 64 * c + 16 * dt + 4 * fq;
            int w0 = 0, w1 = 0;
            w0 = __builtin_amdgcn_cvt_pk_fp8_f32(o0[0] * inv[0], o0[1] * inv[0], w0, false); w0 = __builtin_amdgcn_cvt_pk_fp8_f32(o0[2] * inv[0], o0[3] * inv[0], w0, true);
            w1 = __builtin_amdgcn_cvt_pk_fp8_f32(o1[0] * inv[1], o1[1] * inv[1], w1, false); w1 = __builtin_amdgcn_cvt_pk_fp8_f32(o1[2] * inv[1], o1[3] * inv[1], w1, true);
            *(int*)((unsigned char*)F.ao() + (tq + fr) * D + col) = w0; *(int*)((unsigned char*)F.ao() + (tq + 16 + fr) * D + col) = w1; }
        if (c < 3) {
#pragma unroll
            for (int i = 0; i < 4; ++i) *(LAS u32x4*)(bufs[(c + 1) & 1] + vls + 16 * i) = st[i]; }
        __syncthreads();
    }
}

__device__ __forceinline__ void router_item(Frame& F, int item) {
    const int w = F.wave, lane = F.lane, fr = lane & 15, fq = lane >> 4;
    const size_t t0 = (size_t)item * 16;
    LAS float* lg = (LAS float*)F.lds + w * (16 * 33 + 64);
    LAS int* ex = (LAS int*)(lg + 16 * 33);
    f32x4 acc[2] = {{0.f, 0.f, 0.f, 0.f}, {0.f, 0.f, 0.f, 0.f}};
    for (int k0 = 0; k0 < 32; k0 += 8) { bf16x8 a[8], b0[8], b1[8];
#pragma unroll
        for (int i = 0; i < 8; ++i) { a[i] = *(const bf16x8*)(F.x2b() + (t0 + fr) * D + 32 * (k0 + i) + 8 * fq);
            b0[i] = *(const bf16x8*)(F.Wr_t() + (size_t)fr * D + 32 * (k0 + i) + 8 * fq); b1[i] = *(const bf16x8*)(F.Wr_t() + (size_t)(16 + fr) * D + 32 * (k0 + i) + 8 * fq); }
#pragma unroll
        for (int i = 0; i < 8; ++i) { acc[0] = mma16(a[i], b0[i], acc[0]); acc[1] = mma16(a[i], b1[i], acc[1]); } }
#pragma unroll
    for (int r = 0; r < 4; ++r)
#pragma unroll
        for (int nt = 0; nt < 2; ++nt) lg[(4 * fq + r) * 33 + 16 * nt + fr] = acc[nt][r];
    LDS_WAIT();
    float rs = 0.f, gk[4] = {0.f, 0.f, 0.f, 0.f};
    if (lane < 16) { const size_t t = t0 + lane; rs = row_rs(F.ssq2(), t);
        float v[32];
#pragma unroll
        for (int e = 0; e < 32; ++e) v[e] = lg[lane * 33 + e] * rs + F.A->in[I_BR][e];
        unsigned taken = 0u; float tv[4];
#pragma unroll
        for (int k = 0; k < 4; ++k) { float best = -INFINITY; int bi = 0;
#pragma unroll
            for (int e = 0; e < 32; ++e) { const bool ok = !((taken >> e) & 1u) && (v[e] > best); best = ok ? v[e] : best; bi = ok ? e : bi; }
            taken |= 1u << bi; tv[k] = best; ex[lane * 4 + k] = bi; }
        float sum = 0.f;
#pragma unroll
        for (int k = 0; k < 4; ++k) { gk[k] = __expf(tv[k] - tv[0]); sum += gk[k]; }
        const float inv = 1.f / sum;
        *(f32x4*)(F.gates() + t * 4) = (f32x4){gk[0] * inv, gk[1] * inv, gk[2] * inv, gk[3] * inv}; }
    LDS_WAIT();
    const int me = ex[lane]; const float my_rs = __shfl(rs, lane >> 2);
    int rank = 0, mytot = 0;
#pragma unroll
    for (int e = 0; e < 32; ++e) { const unsigned long long m = __ballot(me == e); const int below = __builtin_popcountll(m & ((1ull << lane) - 1ull));
        rank = (me == e) ? below : rank; mytot = (lane == e) ? __builtin_popcountll(m) : mytot; }
    unsigned base = 0u;
    if (lane < 32 && mytot > 0) base = atomicAdd(F.ctl + CW_CNT + lane, (unsigned)mytot);
    const unsigned slot = (unsigned)__shfl((int)base, me) + (unsigned)rank;
    F.list()[me * ECAP + slot] = (int)(t0 * 4 + lane); F.lscale()[me * ECAP + slot] = my_rs;
    LDS_WAIT();
}

__device__ __forceinline__ void expert_tables(Frame& F) {
    LAS int* tab = (LAS int*)(F.lds + TAB_OFF);
    if (F.tid < 32) tab[F.tid] = (int)__hip_atomic_load(F.ctl + CW_CNT + F.tid, __ATOMIC_RELAXED, __HIP_MEMORY_SCOPE_AGENT);
    __syncthreads();
    if (F.tid == 0) { int s = 0; for (int e = 0; e < 32; ++e) { tab[32 + e] = s; s += (tab[e] + 255) >> 8; } tab[64] = s; }
    __syncthreads();
}
template <int NTN, bool GATH> struct ProbExp {
    static constexpr bool GATHER = GATH, gather = GATH, FP8 = true; static constexpr int WSCALE = FP8_WSCALE;
    int K, lda, ldb, G, c; const LAS int* tab; const unsigned char* A; const unsigned char* Bt; const int* list; mutable int ehint;
    __device__ __forceinline__ bool next(int i, Unit& u) const {
        const int L = i * G + c; if (L >= NTN * tab[64]) return false;
        int e = ehint;
#pragma unroll 1
        while (e < 31 && L >= NTN * tab[32 + e + 1]) ++e;
        ehint = e;
        const int r = L - NTN * tab[32 + e], mte = tab[32 + e + 1] - tab[32 + e];
        u.aux = e; u.pn = r / mte; u.pm = r % mte; return true;
    }
    __device__ __forceinline__ const char* a_base(const Unit& u) const { return gather ? (const char*)A : (const char*)(A + (size_t)(tab[32 + u.aux] + u.pm) * 256 * D); }
    __device__ __forceinline__ const char* b_base(const Unit& u) const { return (const char*)(Bt + ((size_t)u.aux * NTN + u.pn) * 256 * D); }
    __device__ __forceinline__ unsigned a_off(const Unit& u, int row, int C) const {
        if (!gather) return (unsigned)(row * D + C * 2);
        const int slot = u.pm * 256 + row; const int av = list[u.aux * ECAP + slot];
        const int a = slot < tab[u.aux] ? av : 0;
        return (unsigned)((a >> 2) * D + C * 2);
    }
};
struct EpiE1 {
    static constexpr bool MID = false;
    const LAS int* tab; const float* lscale; const float* b1; unsigned char* act;
    __device__ __forceinline__ void operator()(const f32x4 (&acc)[2][2][4][2], const Unit& u, int wr, int wc, int fr, int fq) const {
        asm volatile("" : "+v"(fr), "+v"(fq));
        const int e = u.aux; const size_t rbase = (size_t)(tab[32 + e] + u.pm) * 256;
        const int j0 = u.pn * 128 + wc * 32 + 8 * fq;
        const float* bp = b1 + (size_t)e * 2048 + j0;
        const f32x4 bg0 = *(const f32x4*)bp, bg1 = *(const f32x4*)(bp + 4), bl0 = *(const f32x4*)(bp + 1024), bl1 = *(const f32x4*)(bp + 1028);
        const float bg[8] = {bg0.x, bg0.y, bg0.z, bg0.w, bg1.x, bg1.y, bg1.z, bg1.w}, bl[8] = {bl0.x, bl0.y, bl0.z, bl0.w, bl1.x, bl1.y, bl1.z, bl1.w};
        float sc[2][4];
#pragma unroll
        for (int ai = 0; ai < 2; ++ai)
#pragma unroll
            for (int m = 0; m < 4; ++m) sc[ai][m] = lscale[e * ECAP + u.pm * 256 + ai * 128 + wr * 64 + m * 16 + fr];
#pragma unroll
        for (int ai = 0; ai < 2; ++ai)
#pragma unroll
            for (int m = 0; m < 4; ++m) { const int rt = ai * 128 + wr * 64 + m * 16 + fr; float v[8];
                const f32x2 s2 = {sc[ai][m], sc[ai][m]};
#pragma unroll
                for (int jp = 0; jp < 4; ++jp) {
                    const f32x2 ag = {acc[ai][0][m][jp >> 1][2 * (jp & 1)], acc[ai][0][m][jp >> 1][2 * (jp & 1) + 1]}, al = {acc[ai][1][m][jp >> 1][2 * (jp & 1)], acc[ai][1][m][jp >> 1][2 * (jp & 1) + 1]};
                    const f32x2 bg2 = {bg[2 * jp], bg[2 * jp + 1]}, bl2 = {bl[2 * jp], bl[2 * jp + 1]};
                    const f32x2 ga = ag * s2 + bg2, la = al * s2 + bl2;
                    const f32x2 glu = {fminf(ga.x, 7.0f), fminf(ga.y, 7.0f)}, lin = {fminf(fmaxf(la.x, -7.0f), 7.0f), fminf(fmaxf(la.y, -7.0f), 7.0f)};
                    const f32x2 t = glu * (-1.702f * 1.4426950408889634f);
                    const f32x2 d = (f32x2){__builtin_amdgcn_exp2f(t.x), __builtin_amdgcn_exp2f(t.y)} + 1.0f;
                    const f32x2 r = {__builtin_amdgcn_rcpf(d.x), __builtin_amdgcn_rcpf(d.y)};
                    const f32x2 o = ((lin + 1.0f) * glu) * r;
                    v[2 * jp] = o.x; v[2 * jp + 1] = o.y; }
                *(u32x2*)(act + (rbase + rt) * D + j0) = pack8_fp8(v); }
    }
};
struct EpiE2 {
    static constexpr bool MID = false;
    const LAS int* tab; const int* list; const float* b2; unsigned char* yb; unsigned char* dummy;
    __device__ __forceinline__ void operator()(const f32x4 (&acc)[2][2][4][2], const Unit& u, int wr, int wc, int fr, int fq) const {
        asm volatile("" : "+v"(fr), "+v"(fq));
        const int e = u.aux, cnt = tab[e]; const int col0 = u.pn * 256 + wc * 32 + 8 * fq;
        float bb[2][8];
#pragma unroll
        for (int bj = 0; bj < 2; ++bj) { const f32x4 x0 = *(const f32x4*)(b2 + (size_t)e * D + col0 + bj * 128), x1 = *(const f32x4*)(b2 + (size_t)e * D + col0 + bj * 128 + 4);
            bb[bj][0] = x0.x; bb[bj][1] = x0.y; bb[bj][2] = x0.z; bb[bj][3] = x0.w; bb[bj][4] = x1.x; bb[bj][5] = x1.y; bb[bj][6] = x1.z; bb[bj][7] = x1.w; }
        int aidx[2][4];
#pragma unroll
        for (int ai = 0; ai < 2; ++ai)
#pragma unroll
            for (int m = 0; m < 4; ++m) aidx[ai][m] = list[e * ECAP + u.pm * 256 + ai * 128 + wr * 64 + m * 16 + fr];
#pragma unroll
        for (int ai = 0; ai < 2; ++ai)
#pragma unroll
            for (int m = 0; m < 4; ++m) { const int slot = u.pm * 256 + ai * 128 + wr * 64 + m * 16 + fr;
                unsigned char* rowp = (slot < cnt) ? yb + (size_t)aidx[ai][m] * D : dummy;
#pragma unroll
                for (int bj = 0; bj < 2; ++bj) { float v[8];
#pragma unroll
                    for (int j = 0; j < 4; ++j) { v[j] = acc[ai][bj][m][0][j] + bb[bj][j]; v[4 + j] = acc[ai][bj][m][1][j] + bb[bj][4 + j]; }
                    *(u32x2*)(rowp + col0 + bj * 128) = pack8_fp8(v); } }
    }
};

struct CombTok { u32x4 x[2]; u32x2 y[2][4]; f32x4 g; };
__device__ __forceinline__ void comb_load(Frame& F, int t, int lane, CombTok& c) {
    c.g = *(const f32x4*)(F.gates() + (size_t)t * 4);
#pragma unroll
    for (int hf = 0; hf < 2; ++hf) { const int col = hf * 512 + lane * 8; c.x[hf] = *(const u32x4*)(F.x2b() + (size_t)t * D + col);
#pragma unroll
        for (int k = 0; k < 4; ++k) c.y[hf][k] = *(const u32x2*)((const unsigned char*)F.yb() + ((size_t)t * 4 + k) * D + col); }
}
__device__ __forceinline__ void comb_finish(Frame& F, int t, int lane, const CombTok& c) {
    const float gk[4] = {c.g.x, c.g.y, c.g.z, c.g.w}; float x[2][8]; float ss = 0.f;
#pragma unroll
    for (int hf = 0; hf < 2; ++hf) { unpack8(c.x[hf], x[hf]);
#pragma unroll
        for (int k = 0; k < 4; ++k) { float y[8]; unpack8_fp8(c.y[hf][k], y);
#pragma unroll
            for (int j = 0; j < 8; ++j) x[hf][j] += gk[k] * y[j]; }
#pragma unroll
        for (int j = 0; j < 8; ++j) ss += x[hf][j] * x[hf][j]; }
    const float rs = rsqrtf(wave_sum(ss) * (1.f / D) + EPS);
#pragma unroll
    for (int hf = 0; hf < 2; ++hf) { const int col = hf * 512 + lane * 8; const f32x4 g0 = *(const f32x4*)(F.A->in[I_NFING] + col), g1 = *(const f32x4*)(F.A->in[I_NFING] + col + 4);
        *(f32x4*)(F.A->out + (size_t)t * D + col) = (f32x4){x[hf][0] * rs * g0.x, x[hf][1] * rs * g0.y, x[hf][2] * rs * g0.z, x[hf][3] * rs * g0.w};
        *(f32x4*)(F.A->out + (size_t)t * D + col + 4) = (f32x4){x[hf][4] * rs * g1.x, x[hf][5] * rs * g1.y, x[hf][6] * rs * g1.z, x[hf][7] * rs * g1.w}; }
}
__device__ __forceinline__ void combine_rows(Frame& F) {
    const int gw = F.vcu * 8 + F.wave, NGW = F.G * 8, lane = F.lane;
    if (gw >= T) return;
    CombTok ca, cb; comb_load(F, gw, lane, ca);
    for (int t = gw;;) {
        const bool hb = t + NGW < T; if (hb) comb_load(F, t + NGW, lane, cb);
        comb_finish(F, t, lane, ca); if (!hb) break;
        const bool ha = t + 2 * NGW < T; if (ha) comb_load(F, t + 2 * NGW, lane, ca);
        comb_finish(F, t + NGW, lane, cb); if (!ha) break;
        t += 2 * NGW; }
}

#ifndef DBG_OUT
#define DBG_OUT 0
#endif
#if DBG_OUT
__device__ __forceinline__ void dbg_rows(Frame& F) {
    const int gw = F.vcu * 8 + F.wave, NGW = F.G * 8, lane = F.lane;
    for (int t = gw; t < T; t += NGW) {
#pragma unroll
        for (int hf = 0; hf < 2; ++hf) { const int col = hf * 512 + lane * 8; float x[8];
#pragma unroll
            for (int j = 0; j < 8; ++j) x[j] = 0.f;
            if (DBG_OUT == 1) { for (int m = 0; m < 5; ++m) { if (col + 1024 * m < PN) { float y[8]; unpack8(*(const u32x4*)(F.p() + (size_t)t * PN + col + 1024 * m), y);
#pragma unroll
                for (int j = 0; j < 8; ++j) x[j] += y[j]; } } }
            else if (DBG_OUT == 8) { for (int k = 0; k < 4; ++k) { float y[8]; unpack8_fp8(*(const u32x2*)((const unsigned char*)F.yb() + ((size_t)t * 4 + k) * D + col), y); const float g = F.gates()[t * 4 + k];
#pragma unroll
                for (int j = 0; j < 8; ++j) x[j] += g * y[j]; } }
            else { const bf16_t* B = DBG_OUT == 2 ? F.oab() : DBG_OUT == 3 ? F.mix() : DBG_OUT == 4 ? F.x1b() : DBG_OUT == 5 ? F.q() : DBG_OUT == 6 ? F.ao() : F.x2b();
                unpack8(*(const u32x4*)(B + (size_t)t * D + col), x); }
#pragma unroll
            for (int j = 0; j < 8; ++j) if (!(fabsf(x[j]) < 1e30f)) x[j] = 1e6f;
            *(f32x4*)(F.A->out + (size_t)t * D + col) = (f32x4){x[0], x[1], x[2], x[3]};
            *(f32x4*)(F.A->out + (size_t)t * D + col + 4) = (f32x4){x[4], x[5], x[6], x[7]}; }
    }
}
#endif

__global__ void __launch_bounds__(512, 2) fwd_kernel(Args args) {
    extern __shared__ __attribute__((aligned(16))) unsigned char lds[];
    Frame F;
    F.lds = (LAS unsigned char*)lds; F.MISC = (volatile LAS unsigned*)(F.lds + MISC_OFF);
    F.tid = threadIdx.x; F.lane = F.tid & 63; F.wave = __builtin_amdgcn_readfirstlane(F.tid >> 6);
    F.G = gridDim.x; { const int bx = blockIdx.x; F.vcu = (F.G % 8 == 0) ? (bx % 8) * (F.G / 8) + bx / 8 : bx; }
    F.ctl = (unsigned*)(args.ws + WS_CTL);
    F.A = &args;
    for (int u = F.tid; u < 64; u += 512) ((LAS unsigned*)(F.lds + MISC_OFF))[u] = 0u;
    __syncthreads();
    XcdBarrier bar; bar.bar = F.ctl + CW_BAR; bar.x = 0; bar.st = nullptr;
    if (!MK_PER_PHASE) bar = xcd_barrier_post(F.ctl + CW_BAR, F.MISC + 8);
    const int lo = args.ph_lo, hi = args.ph_hi;
#ifndef PH_MASK
#define PH_MASK 0x3fff
#endif
#define IN(k) (((PH_MASK >> (k)) & 1) && lo <= (k) && (k) < hi)
#ifndef DOUBLE_MASK
#define DOUBLE_MASK 0
#endif
#define REP(k) for (int _rep = 0; _rep < ((((DOUBLE_MASK) >> (k)) & 1) ? 2 : 1); ++_rep, ((((DOUBLE_MASK) >> (k)) & 1) && _rep == 1 ? xcd_barrier(bar) : (void)0))
#define SEAM(k) do { if (IN(k) && IN((k) + 1)) xcd_barrier(bar); } while (0)
    const int c = (int)blockIdx.x;

    if (IN(0)) REP(0) { p0_prologue(F, _rep); } SEAM(0);
    if (IN(1)) REP(1) { ProbP1 P{D, D, ProbP1::EB * D, F.G, c, args.ws}; EpiP1 E{args.ws}; pg8::gemm_phase(F.lds, P, E); } SEAM(1);
    if (IN(2)) REP(2) { for (int u = F.vcu; u < 1024; u += F.G) gla_a_unit(F, u); } SEAM(2);
    if (IN(3)) REP(3) { if (F.wave < 4) for (int it = F.vcu * 4 + F.wave; it < 1024; it += F.G * 4) gla_sscan_item(F, it);
                        for (int u = F.vcu; u < 512; u += F.G) sgu_unit(F, u); } SEAM(3);
    if (IN(4)) REP(4) { for (int it = F.vcu * 8 + F.wave; it < 4096; it += F.G * 8) gla_out_item(F, it); } SEAM(4);
    if (IN(5)) REP(5) { ProbStd P{D, D, 2 * D, F.G, c, F.oab(), F.Wpab_t()}; EpiMix2 E{F.p(), F.mix()}; pg8::gemm_phase(F.lds, P, E); } SEAM(5);
    if (IN(6)) REP(6) { ProbStd P{D, D, 2 * D, F.G, c, F.mix(), F.Wmo_t()}; EpiRes<true> E{(const void*)F.A->in[I_X], F.x1b(), F.ssq1(), F.x1q()}; pg8::gemm_phase(F.lds, P, E); } SEAM(6);
    if (IN(7)) REP(7) { ProbStdT<true, 0x75757575> P{D, D, D, F.G, c, F.x1q(), F.Wq_t()}; EpiScale E{F.ssq1(), F.q()};     pg8::gemm_phase(F.lds, P, E); } SEAM(7);
    if (IN(8)) REP(8) { for (int u = F.vcu; u < 256; u += F.G) attn_unit(F, u); } SEAM(8);
    if (IN(9)) REP(9) { ProbStdT<true> P{D, D, D, F.G, c, F.ao(), F.Wo_t()}; EpiRes<false> E{(const void*)F.x1b(), F.x2b(), F.ssq2(), F.x2q()}; pg8::gemm_phase(F.lds, P, E); } SEAM(9);
    if (IN(10)) REP(10) { for (int it = F.wave * F.G + F.vcu; it < 1024; it += 8 * F.G) router_item(F, it); } SEAM(10);
    if (IN(11)) REP(11) { expert_tables(F); const LAS int* tab = (const LAS int*)(F.lds + TAB_OFF);
        ProbExp<8, true> P{D, D, D, F.G, F.vcu, tab, F.x2q(), (const unsigned char*)F.W1_t(), F.list(), 0}; EpiE1 E{tab, F.lscale(), F.A->in[I_BE1], (unsigned char*)F.act()}; pg8::gemm_phase(F.lds, P, E); } SEAM(11);
    if (IN(12)) REP(12) { expert_tables(F); const LAS int* tab = (const LAS int*)(F.lds + TAB_OFF);
        ProbExp<4, false> P{D, D, D, F.G, F.vcu, tab, (const unsigned char*)F.act(), (const unsigned char*)F.W2_t(), F.list(), 0}; EpiE2 E{tab, F.list(), F.A->in[I_BE2], (unsigned char*)F.yb(), (unsigned char*)(args.ws + WS_CTL + 512 * 1024)}; pg8::gemm_phase(F.lds, P, E); } SEAM(12);
#if DBG_OUT
    if (lo <= 13 && 13 < hi) { dbg_rows(F); }
#else
    if (IN(13)) REP(13) { combine_rows(F); }
#endif
#undef IN
#undef SEAM
}

extern "C" void kernel_launch(void* const* d_in, const int* in_sizes, int n_in, void* d_out, int out_size, void* d_ws, size_t ws_size, hipStream_t stream) {
    static int grid = 0;
    if (grid == 0) {
        if (n_in != 28 || in_sizes[0] != T * D || out_size != T * D || ws_size < WS_END) { fprintf(stderr, "kernel_launch: unexpected problem (n_in %d, in0 %d, out %d, ws %zu); nothing launched\n", n_in, n_in > 0 ? in_sizes[0] : -1, out_size, ws_size); grid = -1; return; }
        int dev = 0, cus = 0, per_cu = 0;
        if (hipGetDevice(&dev) != hipSuccess || hipDeviceGetAttribute(&cus, hipDeviceAttributeMultiprocessorCount, dev) != hipSuccess) { grid = -1; return; }
        if (hipFuncSetAttribute((const void*)fwd_kernel, hipFuncAttributeMaxDynamicSharedMemorySize, LDS_BYTES) != hipSuccess) { fprintf(stderr, "kernel_launch: hipFuncSetAttribute failed\n"); grid = -1; return; }
        if (hipOccupancyMaxActiveBlocksPerMultiprocessor(&per_cu, (const void*)fwd_kernel, 512, LDS_BYTES) != hipSuccess || per_cu < 1) fprintf(stderr, "kernel_launch: occupancy query reports %d blocks per CU\n", per_cu);
        (void)hipGetLastError();
        grid = cus;
    }
    if (grid < 0) return;
    if (hipMemsetAsync((char*)d_ws + WS_CTL, 0, CTL_ZERO_BYTES, stream) != hipSuccess) { fprintf(stderr, "kernel_launch: memset failed\n"); return; }
    Args a{};
    for (int i = 0; i < 28; ++i) a.in[i] = (const float*)d_in[i];
    a.out = (float*)d_out; a.ws = (unsigned char*)d_ws;
#if MK_PER_PHASE
    for (int ph = 0; ph < NPHASE; ++ph) { a.ph_lo = ph; a.ph_hi = ph + 1; hipLaunchKernelGGL(fwd_kernel, dim3(grid), dim3(512), LDS_BYTES, stream, a); }
#else
    a.ph_lo = 0; a.ph_hi = NPHASE;
    hipLaunchKernelGGL(fwd_kernel, dim3(grid), dim3(512), LDS_BYTES, stream, a);
#endif
}
```

```cpp
#include <hip/hip_runtime.h>
#include <cstdio>
#include <cstdint>

#ifndef P1_FP8
#define P1_FP8 0
#endif
#ifndef MK_PER_PHASE
#define MK_PER_PHASE 0
#endif

#define LAS __attribute__((address_space(3)))
#define GAS __attribute__((address_space(1)))
typedef unsigned short bf16_t;
typedef short bf16x8 __attribute__((ext_vector_type(8)));
typedef float f32x4 __attribute__((ext_vector_type(4)));
typedef float f32x2 __attribute__((ext_vector_type(2)));
typedef unsigned u32x4 __attribute__((ext_vector_type(4)));
typedef unsigned u32x2 __attribute__((ext_vector_type(2)));
typedef int i32x4 __attribute__((ext_vector_type(4)));
typedef int i32x8 __attribute__((ext_vector_type(8)));
#define FP8_WSCALE 0x79797979
constexpr float FP8_WMUL = 64.0f;
typedef GAS unsigned gu32;

constexpr int T = 16384, D = 1024, NBATCH = 8, SEQ = 2048, MEMLEN = 256, TM = NBATCH * MEMLEN;
constexpr int INC = 4624;
constexpr int PN = 4864;
constexpr int PC_Q = 0, PC_K = 256, PC_V = 512, PC_R = 1024, PC_U = 1536, PC_SV = 2048, PC_GA = 2560, PC_GB = 3584, PC_A = 4608;
constexpr int OFF_A = 1536;
constexpr int NE = 32, NASG = T * 4, ECAP = 16384;
constexpr float EPS = 1e-5f;
constexpr int NPHASE = 14;

constexpr size_t MiB = 1u << 20;
constexpr size_t WS_CTL = 0, CTL_ZERO_BYTES = 1 * MiB;
constexpr size_t WS_WR = 1 * MiB, WS_SGUW = 1 * MiB + 256 * 1024, WS_DECAY = 1 * MiB + 512 * 1024;
constexpr size_t WS_WIN = 2 * MiB, WS_WK = 12 * MiB, WS_WV = 14 * MiB, WS_WPAB = 16 * MiB, WS_WMO = 18 * MiB, WS_WQ = 20 * MiB, WS_WO = 22 * MiB;
constexpr size_t WS_SSQ1 = 24 * MiB, WS_SSQ2 = 25 * MiB, WS_LIST = 26 * MiB, WS_LSCALE = 28 * MiB, WS_GATES = 30 * MiB;
constexpr size_t WS_W1 = 32 * MiB, WS_W2 = 160 * MiB, WS_H = 224 * MiB, WS_MEMN = 256 * MiB, WS_KMEM = 260 * MiB, WS_VT = 264 * MiB, WS_QIN = 268 * MiB;
constexpr size_t WS_OINTRA = 276 * MiB, WS_KVT = 308 * MiB, WS_OAB = 340 * MiB, WS_MIX = 372 * MiB, WS_X1B = 404 * MiB, WS_Q = 436 * MiB, WS_AO = 468 * MiB, WS_X2B = 500 * MiB;
constexpr size_t WS_P = 532 * MiB, WS_ACT = 684 * MiB, WS_YB = 828 * MiB, WS_SPT = 956 * MiB, WS_X2Q = 972 * MiB, WS_X1Q = 988 * MiB, WS_SVS = 1004 * MiB, WS_END = 1005 * MiB;
static_assert(WS_P + (size_t)T * PN * 2 <= WS_ACT && WS_ACT + (size_t)(NASG + NE * 256) * 1024 * 2 <= WS_YB && WS_YB + (size_t)NASG * 1024 * 2 <= WS_END, "ws map");
constexpr int CW_CNT = 64;
constexpr int CW_BAR = 4096;

constexpr int RING_BYTES = 131072;
constexpr int TAB_OFF = 139264, MISC_OFF = 141312, LDS_BYTES = 147456;

typedef __bf16 bf16x2_t __attribute__((ext_vector_type(2)));
__device__ __forceinline__ unsigned cvt_pk_bf16(float lo, float hi) { const f32x2 v = {lo, hi}; const bf16x2_t b = __builtin_convertvector(v, bf16x2_t); return __builtin_bit_cast(unsigned, b); }
__device__ __forceinline__ bf16_t f2bf(float f) { return (bf16_t)(cvt_pk_bf16(f, 0.f) & 0xffffu); }
__device__ __forceinline__ float bflo(unsigned w) { return __uint_as_float(w << 16); }
__device__ __forceinline__ float bfhi(unsigned w) { return __uint_as_float(w & 0xffff0000u); }
__device__ __forceinline__ float bf2f(bf16_t v) { return __uint_as_float((unsigned)v << 16); }
__device__ __forceinline__ void unpack8(const u32x4 w, float (&f)[8]) { f[0] = bflo(w.x); f[1] = bfhi(w.x); f[2] = bflo(w.y); f[3] = bfhi(w.y); f[4] = bflo(w.z); f[5] = bfhi(w.z); f[6] = bflo(w.w); f[7] = bfhi(w.w); }
__device__ __forceinline__ u32x4 pack8(const float (&f)[8]) { u32x4 w; w.x = cvt_pk_bf16(f[0], f[1]); w.y = cvt_pk_bf16(f[2], f[3]); w.z = cvt_pk_bf16(f[4], f[5]); w.w = cvt_pk_bf16(f[6], f[7]); return w; }
__device__ __forceinline__ u32x2 pack8_fp8(const float (&f)[8]) { int a = 0, b = 0;
    a = __builtin_amdgcn_cvt_pk_fp8_f32(f[0], f[1], a, false); a = __builtin_amdgcn_cvt_pk_fp8_f32(f[2], f[3], a, true);
    b = __builtin_amdgcn_cvt_pk_fp8_f32(f[4], f[5], b, false); b = __builtin_amdgcn_cvt_pk_fp8_f32(f[6], f[7], b, true);
    return (u32x2){(unsigned)a, (unsigned)b}; }
__device__ __forceinline__ void unpack8_fp8(const u32x2 w, float (&f)[8]) {
    const f32x2 a = __builtin_amdgcn_cvt_pk_f32_fp8((int)w.x, false), b = __builtin_amdgcn_cvt_pk_f32_fp8((int)w.x, true), c = __builtin_amdgcn_cvt_pk_f32_fp8((int)w.y, false), d = __builtin_amdgcn_cvt_pk_f32_fp8((int)w.y, true);
    f[0] = a.x; f[1] = a.y; f[2] = b.x; f[3] = b.y; f[4] = c.x; f[5] = c.y; f[6] = d.x; f[7] = d.y; }
__device__ __forceinline__ f32x4 mma16(bf16x8 a, bf16x8 b, f32x4 c) { return __builtin_amdgcn_mfma_f32_16x16x32_bf16(a, b, c, 0, 0, 0); }
__device__ __forceinline__ float wave_sum(float v) {
#pragma unroll
    for (int o = 1; o < 64; o <<= 1) v += __shfl_xor(v, o);
    return v;
}
__device__ __forceinline__ float sigmoidf_(float x) { return __builtin_amdgcn_rcpf(1.0f + __expf(-x)); }
__device__ __forceinline__ float gelu_erf(float v) {
    const float av = fabsf(v), t = __builtin_amdgcn_rcpf(av * 0.2316418882f + 1.0f);
    float q = t * 0.5307027145f + (-0.7265760135f); q = q * t + 0.7107068705f; q = q * t + (-0.142248368f); q = q * t + 0.127414796f; q = q * t;
    const float e = __builtin_amdgcn_exp2f((v * v) * (-0.72134752044f));
    const float m = v * (q * e);
    return v < 0.f ? m : v - m;
}
__device__ __forceinline__ f32x2 gelu_pk(f32x2 v) {
    const f32x2 av = __builtin_elementwise_abs(v), d = av * 0.2316418882f + 1.0f;
    f32x2 t; t.x = __builtin_amdgcn_rcpf(d.x); t.y = __builtin_amdgcn_rcpf(d.y);
    f32x2 q = t * 0.5307027145f + (-0.7265760135f); q = q * t + 0.7107068705f; q = q * t + (-0.142248368f); q = q * t + 0.127414796f; q = q * t;
    const f32x2 s = (v * v) * (-0.72134752044f);
    f32x2 e; e.x = __builtin_amdgcn_exp2f(s.x); e.y = __builtin_amdgcn_exp2f(s.y);
    const f32x2 m = v * (q * e), r = v - m;
    f32x2 o; o.x = v.x < 0.f ? m.x : r.x; o.y = v.y < 0.f ? m.y : r.y; return o;
}
__device__ __forceinline__ f32x2 sigmoid_pk(f32x2 v) {
    const f32x2 t = v * (-1.4426950408889634f); const f32x2 d = (f32x2){__builtin_amdgcn_exp2f(t.x), __builtin_amdgcn_exp2f(t.y)} + 1.0f;
    return (f32x2){__builtin_amdgcn_rcpf(d.x), __builtin_amdgcn_rcpf(d.y)};
}
#define LDS_WAIT() asm volatile("s_waitcnt lgkmcnt(0)" ::: "memory")
#define VM_WAIT() asm volatile("s_waitcnt vmcnt(0)" ::: "memory")

#define XB_TMO      128
#define XB_XCNT(j)  (256  + 64 * (j))
#define XB_XSUB(j)  (1280 + 64 * (j))
#define XB_XGEN(j)  (2304 + 64 * (j))
#define XB_TOP      3328
#define XB_TOPGEN   3392
#define XCD_BAR_WORDS 3456
#define XB_SPIN_CAP (1u << 22)
__device__ __forceinline__ unsigned xb_ld(unsigned* p)              { return __hip_atomic_load(p, __ATOMIC_RELAXED, __HIP_MEMORY_SCOPE_AGENT); }
__device__ __forceinline__ unsigned xb_add(unsigned* p, unsigned v) { return __hip_atomic_fetch_add(p, v, __ATOMIC_RELAXED, __HIP_MEMORY_SCOPE_AGENT); }
__device__ __forceinline__ unsigned xb_xcc_id() { return (unsigned)__builtin_amdgcn_s_getreg((3 << 11) | 20) & 0xFu; }
#define XB_SPIN(cond, bar) do { unsigned _sp = 0; while (cond) { __builtin_amdgcn_s_sleep(1); \
    if ((++_sp & 255u) == 0u) { if (xb_ld(&(bar)[XB_TMO])) break; if (_sp > XB_SPIN_CAP) { atomicAdd(&(bar)[XB_TMO], 1u); break; } } } } while (0)
struct XcdBarrier { unsigned* bar; unsigned x; volatile LAS unsigned* st; };
__device__ __forceinline__ XcdBarrier xcd_barrier_post(unsigned* bar, volatile LAS unsigned* st) {
    XcdBarrier b; b.bar = bar; b.x = xb_xcc_id(); b.st = st;
    if (threadIdx.x == 0) (void)xb_add(&bar[XB_XCNT(b.x)], 1u);
    return b;
}
__device__ __forceinline__ void xcd_barrier_complete(unsigned* bar, unsigned x, unsigned& nloc, unsigned& nx) {
    const unsigned G = gridDim.x * gridDim.y * gridDim.z;
    unsigned sum, cnt, mine, sp = 0u;
    for (;;) {
        sum = 0u; cnt = 0u; mine = 0u;
#pragma unroll
        for (unsigned j = 0; j < 16; ++j) { const unsigned c = xb_ld(&bar[XB_XCNT(j)]); sum += c; cnt += (c > 0u) ? 1u : 0u; mine = (j == x) ? c : mine; }
        if (sum == G) break;
        __builtin_amdgcn_s_sleep(1);
        if ((++sp & 255u) == 0u) { if (xb_ld(&bar[XB_TMO])) break; if (sp > XB_SPIN_CAP) { atomicAdd(&bar[XB_TMO], 1u); break; } }
    }
    nloc = mine > 0u ? mine : 1u; nx = cnt > 0u ? cnt : 1u;
}
__device__ __forceinline__ void xcd_barrier(const XcdBarrier& b) {
    asm volatile("s_waitcnt vmcnt(0)" ::: "memory");
    __syncthreads();
    if (threadIdx.x == 0) {
        unsigned* bar = b.bar;
        __builtin_amdgcn_s_waitcnt(0);
        unsigned nloc = b.st[0], nx = b.st[1];
        if (nloc == 0u) { xcd_barrier_complete(bar, b.x, nloc, nx); b.st[0] = nloc; b.st[1] = nx; }
        const unsigned old = xb_add(&bar[XB_XSUB(b.x)], 1u);
        const unsigned gen = old / nloc;
        if (old + 1u == (gen + 1u) * nloc) {
            __builtin_amdgcn_fence(__ATOMIC_RELEASE, "agent");
            asm volatile("s_waitcnt vmcnt(0)" ::: "memory");
            const unsigned og = xb_add(&bar[XB_TOP], 1u);
            const unsigned tg = og / nx;
            if (og + 1u == (tg + 1u) * nx) xb_add(&bar[XB_TOPGEN], 1u);
            else XB_SPIN(xb_ld(&bar[XB_TOPGEN]) == tg, bar);
            __builtin_amdgcn_fence(__ATOMIC_ACQUIRE, "agent");
            xb_add(&bar[XB_XGEN(b.x)], 1u);
            asm volatile("s_waitcnt vmcnt(0)" ::: "memory");
        } else {
            __builtin_amdgcn_fence(__ATOMIC_ACQUIRE, "agent");
            XB_SPIN(xb_ld(&bar[XB_XGEN(b.x)]) == gen, bar);
            asm volatile("s_waitcnt vmcnt(0)" ::: "memory");
        }
    }
    __syncthreads();
}

namespace pg8 {
constexpr int BM = 256, BK = 64, HALF = 128, HTB = HALF * BK * 2, NXCD = 8, WGM = 8;
__host__ __device__ __forceinline__ int lds_byte(int r, int c) { const int st = (r >> 4) * 2 + (c >> 5), rr = r & 15, cc = c & 31, ob = rr * 64 + cc * 2; return st * 1024 + (ob ^ (((ob >> 9) & 1) << 5)); }
__host__ __device__ __forceinline__ void stage_rc(int b, int& R, int& C) { const int st = b / 1024, sb = b % 1024, swz = sb ^ (((sb >> 9) & 1) << 5); R = (st >> 1) * 16 + swz / 64; C = (st & 1) * 32 + (swz % 64) / 2; }
__host__ __device__ __forceinline__ int perm32(int rho) { const int n = rho >> 4, i = rho & 15; return 8 * (i >> 2) + 4 * n + (i & 3); }
struct Unit { int pm, pn, aux; };
__device__ __forceinline__ void map_tile(int L, int nM, int nN, int& pm, int& pn) {
    const int nwg = nM * nN; int wgid = L;
    { const int q = nwg / NXCD, r = nwg % NXCD, xcd = wgid % NXCD, off = wgid / NXCD; wgid = (xcd < r ? xcd * (q + 1) : r * (q + 1) + (xcd - r) * q) + off; }
    const int nig = WGM * nN, gid = wgid / nig, fm = gid * WGM, gsz = (nM - fm) < WGM ? (nM - fm) : WGM;
    pm = fm + ((wgid % nig) % gsz); pn = (wgid % nig) / gsz;
}
template <class Epi, class Prob>
__device__ __forceinline__ void gemm_phase(LAS unsigned char* lds, const Prob& P, const Epi& E) {
    const int tid = threadIdx.x, wid = __builtin_amdgcn_readfirstlane(tid >> 6), lane = tid & 63, wr = wid >> 2, wc = wid & 3, fr = lane & 15, fq = lane >> 4;
    const int nt = P.K / (Prob::FP8 ? 128 : BK);
    unsigned voffB[2];
#pragma unroll
    for (int i = 0; i < 2; ++i) { int R_, C_; stage_rc(tid * 16 + i * 8192, R_, C_); const int Rb = (R_ & ~31) + perm32(R_ & 31); voffB[i] = (unsigned)(Rb * P.ldb + C_ * 2); }
#define PG8_AOFF(dst0, dst1, unit) do { _Pragma("unroll") for (int _i = 0; _i < 2; ++_i) { int R_, C_; stage_rc(tid * 16 + _i * 8192, R_, C_); dst0[_i] = P.a_off(unit, R_, C_); dst1[_i] = P.a_off(unit, R_ + HALF, C_); } } while (0)
    const size_t kstep = (size_t)(BK * 2);
    const size_t hstepB = (size_t)HALF * P.ldb;
    const unsigned ldsw = (unsigned)wid * 1024u;
    const int aoff = lds_byte(wr * 64 + fr, fq * 8), boff = lds_byte(wc * 32 + fr, fq * 8);
#define PG8_SA(b, h) (((b) * 2 + (h)) * HTB)
#define PG8_SB(b, h) ((4 + (b) * 2 + (h)) * HTB)
#define PG8_STAGE(bufoff, gbase, voff) do { _Pragma("unroll") for (int _i = 0; _i < 2; ++_i) \
        __builtin_amdgcn_global_load_lds((const unsigned*)((const char*)(gbase) + (voff)[_i]), (LAS unsigned*)(lds + (bufoff) + ldsw + _i * 8192), 16, 0, 0); } while (0)
#define PG8_LD8(addr) __builtin_shufflevector(*(const LAS i32x4*)(addr), *(const LAS i32x4*)((addr) + 1024), 0, 1, 2, 3, 4, 5, 6, 7)
#define PG8_LDA(dst, b, h) do { _Pragma("unroll") for (int m = 0; m < 4; ++m) dst[m] = PG8_LD8(lds + PG8_SA(b, h) + aoff + m * 2048); } while (0)
#define PG8_LDB(dst, b, h) do { _Pragma("unroll") for (int n = 0; n < 2; ++n) dst[n] = PG8_LD8(lds + PG8_SB(b, h) + boff + n * 2048); } while (0)
#define PG8_LO(x) __builtin_bit_cast(bf16x8, __builtin_shufflevector(x, x, 0, 1, 2, 3))
#define PG8_HI(x) __builtin_bit_cast(bf16x8, __builtin_shufflevector(x, x, 4, 5, 6, 7))
#define PG8_MMA(ai, bj, At, Bt) do { __builtin_amdgcn_s_setprio(1); _Pragma("unroll") for (int m = 0; m < 4; ++m) _Pragma("unroll") for (int n = 0; n < 2; ++n) { \
        if constexpr (Prob::FP8) asm volatile("v_mfma_scale_f32_16x16x128_f8f6f4 %0, %1, %2, %0, %3, %4 op_sel_hi:[0,0,0]" : "+v"(acc[ai][bj][m][n]) : "v"(Bt[n]), "v"(At[m]), "v"(scl_w), "v"(scl_1)); \
        else { acc[ai][bj][m][n] = __builtin_amdgcn_mfma_f32_16x16x32_bf16(PG8_LO(Bt[n]), PG8_LO(At[m]), acc[ai][bj][m][n], 0, 0, 0); \
               acc[ai][bj][m][n] = __builtin_amdgcn_mfma_f32_16x16x32_bf16(PG8_HI(Bt[n]), PG8_HI(At[m]), acc[ai][bj][m][n], 0, 0, 0); } } \
        __builtin_amdgcn_s_setprio(0); } while (0)
#define PG8_WAIT_V(n) asm volatile("s_waitcnt vmcnt(" #n ")" ::: "memory")
#define PG8_WAIT_L(n) asm volatile("s_waitcnt lgkmcnt(" #n ")" ::: "memory")
#define PG8_BAR __builtin_amdgcn_s_barrier()
#define PG8_SCHED __builtin_amdgcn_sched_barrier(0)
    Unit cur, nxt; int ui = 0;
    if (!P.next(0, cur)) return;
    f32x4 acc[2][2][4][2];
#pragma unroll
    for (int a = 0; a < 2; ++a)
#pragma unroll
        for (int b = 0; b < 2; ++b)
#pragma unroll
            for (int m = 0; m < 4; ++m)
#pragma unroll
                for (int n = 0; n < 2; ++n) acc[a][b][m][n] = (f32x4){0.f, 0.f, 0.f, 0.f};
    i32x8 At[4], B0[2], B1[2];
    int scl_w = Prob::WSCALE, scl_1 = 0x7f7f7f7f; asm volatile("" : "+v"(scl_w), "+v"(scl_1));
    unsigned cO0[2], cO1[2], nO0[2], nO1[2];
    PG8_AOFF(cO0, cO1, cur);
    const char* cA = P.a_base(cur); const char* cB = P.b_base(cur);
    PG8_STAGE(PG8_SB(0, 0), cB, voffB); PG8_STAGE(PG8_SB(0, 1), cB + hstepB, voffB); PG8_STAGE(PG8_SA(0, 0), cA, cO0); PG8_STAGE(PG8_SA(0, 1), cA, cO1);
    if (wr == 1) PG8_BAR;
    PG8_WAIT_V(2); PG8_BAR;
    PG8_STAGE(PG8_SB(1, 0), cB + kstep, voffB); PG8_STAGE(PG8_SA(1, 0), cA + kstep, cO0); PG8_STAGE(PG8_SB(1, 1), cB + hstepB + kstep, voffB);
    PG8_WAIT_V(6); PG8_BAR;
    for (;;) {
        const bool has_next = P.next(ui + 1, nxt);
        const char* nA = cA; const char* nB = cB;
        if constexpr (Prob::GATHER) {
#pragma unroll
            for (int i = 0; i < 2; ++i) { nO0[i] = cO0[i]; nO1[i] = cO1[i]; } }
        if (has_next) { nA = P.a_base(nxt); nB = P.b_base(nxt); if constexpr (Prob::GATHER) PG8_AOFF(nO0, nO1, nxt); }
        for (int t = 0; t < nt; t += 2) {
            const bool last = (t == nt - 2);
            const char* a1 = cA + (size_t)(t + 1) * kstep;
            const char* a2 = last ? nA : cA + (size_t)(t + 2) * kstep; const char* b2 = last ? nB : cB + (size_t)(t + 2) * kstep;
            const char* a3 = a2 + kstep; const char* b3 = b2 + kstep;
            unsigned o20[2], o21[2];
#pragma unroll
            for (int i = 0; i < 2; ++i) { if constexpr (Prob::GATHER) { o20[i] = last ? nO0[i] : cO0[i]; o21[i] = last ? nO1[i] : cO1[i]; } else { o20[i] = cO0[i]; o21[i] = cO1[i]; } }
            PG8_LDB(B0, 0, 0); PG8_LDB(B1, 0, 1); PG8_SCHED; PG8_LDA(At, 0, 0); PG8_STAGE(PG8_SA(1, 1), a1, cO1);
            PG8_WAIT_V(8); PG8_WAIT_L(0); PG8_BAR; PG8_MMA(0, 0, At, B0); PG8_MMA(0, 1, At, B1); PG8_BAR; PG8_SCHED;
            PG8_LDA(At, 0, 1); PG8_STAGE(PG8_SB(0, 0), b2, voffB); PG8_STAGE(PG8_SB(0, 1), b2 + hstepB, voffB); PG8_STAGE(PG8_SA(0, 0), a2, o20);
            PG8_WAIT_V(8); PG8_WAIT_L(0); PG8_BAR; PG8_MMA(1, 0, At, B0); PG8_MMA(1, 1, At, B1); PG8_BAR; PG8_SCHED;
            PG8_LDB(B0, 1, 0); PG8_LDB(B1, 1, 1); PG8_SCHED; PG8_LDA(At, 1, 0); PG8_STAGE(PG8_SA(0, 1), a2, o21);
            PG8_WAIT_V(8); PG8_WAIT_L(0); PG8_BAR; PG8_MMA(0, 0, At, B0); PG8_MMA(0, 1, At, B1); PG8_BAR; PG8_SCHED;
            PG8_LDA(At, 1, 1); PG8_STAGE(PG8_SB(1, 0), b3, voffB); PG8_STAGE(PG8_SB(1, 1), b3 + hstepB, voffB); PG8_STAGE(PG8_SA(1, 0), a3, o20);
            PG8_WAIT_V(8); PG8_WAIT_L(0); PG8_BAR; PG8_MMA(1, 0, At, B0); PG8_MMA(1, 1, At, B1); PG8_BAR; PG8_SCHED;
            if constexpr (Epi::MID) { if (t + 2 == nt / 2) E.mid(acc, cur, wr, wc, fr, fq); }
        }
        if (wr == 0) PG8_BAR;
        if constexpr (Prob::FP8) asm volatile("s_nop 15\n\ts_nop 15" ::: "memory");
        E(acc, cur, wr, wc, fr, fq);
        if (!has_next) break;
#pragma unroll
        for (int a = 0; a < 2; ++a)
#pragma unroll
            for (int b = 0; b < 2; ++b)
#pragma unroll
                for (int m = 0; m < 4; ++m)
#pragma unroll
                    for (int n = 0; n < 2; ++n) acc[a][b][m][n] = (f32x4){0.f, 0.f, 0.f, 0.f};
        cur = nxt; cA = nA; cB = nB; ++ui;
        if constexpr (Prob::GATHER) {
#pragma unroll
            for (int i = 0; i < 2; ++i) { cO0[i] = nO0[i]; cO1[i] = nO1[i]; } }
        if (wr == 1) PG8_BAR;
    }
    PG8_WAIT_V(0);
    PG8_BAR;
#undef PG8_AOFF
#undef PG8_SA
#undef PG8_SB
#undef PG8_STAGE
#undef PG8_LDA
#undef PG8_LD8
#undef PG8_LO
#undef PG8_HI
#undef PG8_LDB
#undef PG8_MMA
#undef PG8_WAIT_V
#undef PG8_WAIT_L
#undef PG8_BAR
#undef PG8_SCHED
}
}
using pg8::Unit;

struct Args { const float* in[28]; float* out; unsigned char* ws; int ph_lo, ph_hi; };
struct Frame {
    LAS unsigned char* lds;
    volatile LAS unsigned* MISC;
    unsigned* ctl;
    int tid, lane, wave, vcu, G;
    const Args* A;
    __device__ __forceinline__ bf16_t* Win_t() const { return (bf16_t*)(A->ws + WS_WIN); }
    __device__ __forceinline__ bf16_t* Wk_t() const { return (bf16_t*)(A->ws + WS_WK); }
    __device__ __forceinline__ bf16_t* Wv_t() const { return (bf16_t*)(A->ws + WS_WV); }
    __device__ __forceinline__ bf16_t* Wpab_t() const { return (bf16_t*)(A->ws + WS_WPAB); }
    __device__ __forceinline__ bf16_t* Wmo_t() const { return (bf16_t*)(A->ws + WS_WMO); }
    __device__ __forceinline__ bf16_t* Wq_t() const { return (bf16_t*)(A->ws + WS_WQ); }
    __device__ __forceinline__ bf16_t* Wo_t() const { return (bf16_t*)(A->ws + WS_WO); }
    __device__ __forceinline__ bf16_t* Wr_t() const { return (bf16_t*)(A->ws + WS_WR); }
    __device__ __forceinline__ bf16_t* W1_t() const { return (bf16_t*)(A->ws + WS_W1); }
    __device__ __forceinline__ bf16_t* W2_t() const { return (bf16_t*)(A->ws + WS_W2); }
    __device__ __forceinline__ bf16_t* sguw() const { return (bf16_t*)(A->ws + WS_SGUW); }
    __device__ __forceinline__ bf16_t* h() const { return (bf16_t*)(A->ws + WS_H); }
    __device__ __forceinline__ bf16_t* memn() const { return (bf16_t*)(A->ws + WS_MEMN); }
    __device__ __forceinline__ bf16_t* kmem() const { return (bf16_t*)(A->ws + WS_KMEM); }
    __device__ __forceinline__ bf16_t* vt() const { return (bf16_t*)(A->ws + WS_VT); }
    __device__ __forceinline__ bf16_t* qin() const { return (bf16_t*)(A->ws + WS_QIN); }
    __device__ __forceinline__ bf16_t* oab() const { return (bf16_t*)(A->ws + WS_OAB); }
    __device__ __forceinline__ bf16_t* mix() const { return (bf16_t*)(A->ws + WS_MIX); }
    __device__ __forceinline__ bf16_t* x1b() const { return (bf16_t*)(A->ws + WS_X1B); }
    __device__ __forceinline__ bf16_t* q() const { return (bf16_t*)(A->ws + WS_Q); }
    __device__ __forceinline__ bf16_t* ao() const { return (bf16_t*)(A->ws + WS_AO); }
    __device__ __forceinline__ bf16_t* x2b() const { return (bf16_t*)(A->ws + WS_X2B); }
    __device__ __forceinline__ bf16_t* p() const { return (bf16_t*)(A->ws + WS_P); }
    __device__ __forceinline__ bf16_t* act() const { return (bf16_t*)(A->ws + WS_ACT); }
    __device__ __forceinline__ bf16_t* yb() const { return (bf16_t*)(A->ws + WS_YB); }
    __device__ __forceinline__ bf16_t* ointra() const { return (bf16_t*)(A->ws + WS_OINTRA); }
    __device__ __forceinline__ bf16_t* kvT() const { return (bf16_t*)(A->ws + WS_KVT); }
    __device__ __forceinline__ float* decay() const { return (float*)(A->ws + WS_DECAY); }
    __device__ __forceinline__ float* ssq1() const { return (float*)(A->ws + WS_SSQ1); }
    __device__ __forceinline__ float* ssq2() const { return (float*)(A->ws + WS_SSQ2); }
    __device__ __forceinline__ float* lscale() const { return (float*)(A->ws + WS_LSCALE); }
    __device__ __forceinline__ float* gates() const { return (float*)(A->ws + WS_GATES); }
    __device__ __forceinline__ int* list() const { return (int*)(A->ws + WS_LIST); }
    __device__ __forceinline__ bf16_t* spT() const { return (bf16_t*)(A->ws + WS_SPT); }
    __device__ __forceinline__ unsigned char* x2q() const { return (unsigned char*)(A->ws + WS_X2Q); }
    __device__ __forceinline__ unsigned char* x1q() const { return (unsigned char*)(A->ws + WS_X1Q); }
};
enum { I_X = 0, I_MEM, I_NMIXG, I_WIN, I_WA2, I_BA, I_GOUTG, I_SNG, I_SNB, I_SW, I_SB, I_WPA, I_WPB, I_WMO, I_NXG, I_NMEMG, I_WXQ, I_WXK, I_WXV, I_WXO, I_NFFNG, I_WR, I_BR, I_WE1, I_BE1, I_WE2, I_BE2, I_NFING };

struct CvtItem { const float* src; size_t ldw; unsigned char* dst; const float* kscale; float mul; int fp8; };
__device__ __forceinline__ void cvt_load(const CvtItem& c, float (&v)[64]) {
#pragma unroll
    for (int i = 0; i < 64; ++i) v[i] = __builtin_nontemporal_load(c.src + (size_t)i * c.ldw);
}
__device__ __forceinline__ void cvt_finish(const CvtItem& c, float (&v)[64]) {
    if (c.kscale) {
#pragma unroll
        for (int i = 0; i < 64; ++i) v[i] *= c.kscale[i] * c.mul; }
    else {
#pragma unroll
        for (int i = 0; i < 64; ++i) v[i] *= c.mul; }
    if (c.fp8) {
#pragma unroll
        for (int q = 0; q < 4; ++q) { const float f0[8] = {v[16 * q], v[16 * q + 1], v[16 * q + 2], v[16 * q + 3], v[16 * q + 4], v[16 * q + 5], v[16 * q + 6], v[16 * q + 7]};
            const float f1[8] = {v[16 * q + 8], v[16 * q + 9], v[16 * q + 10], v[16 * q + 11], v[16 * q + 12], v[16 * q + 13], v[16 * q + 14], v[16 * q + 15]};
            const u32x2 lo = pack8_fp8(f0), hi = pack8_fp8(f1); *(u32x4*)(c.dst + 16 * q) = (u32x4){lo.x, lo.y, hi.x, hi.y}; } }
    else {
#pragma unroll
        for (int q = 0; q < 8; ++q) { const float f[8] = {v[8 * q], v[8 * q + 1], v[8 * q + 2], v[8 * q + 3], v[8 * q + 4], v[8 * q + 5], v[8 * q + 6], v[8 * q + 7]}; *(u32x4*)(c.dst + 16 * q) = pack8(f); } }
}
__device__ __forceinline__ CvtItem cvt_desc(const float* W, int ldw, int src_col0, int k0, void* WT, int ldt, int dst_row0, int dst_k0, const float* kscale, float mul, int fp8, int lane) {
    CvtItem c; const int eb = fp8 ? 1 : 2;
    c.src = W + (size_t)k0 * ldw + src_col0 + lane; c.ldw = (size_t)ldw; c.dst = (unsigned char*)WT + ((size_t)(dst_row0 + lane) * ldt + dst_k0 + k0) * eb;
    c.kscale = kscale ? kscale + k0 : nullptr; c.mul = mul; c.fp8 = fp8; return c;
}
template <bool Q8>
__device__ __forceinline__ void rms_row_to_bf16(const float* xrow, const float* g, bf16_t* orow, int lane) {
    f32x4 v[4]; float s = 0.f;
#pragma unroll
    for (int j = 0; j < 4; ++j) { v[j] = *(const f32x4*)(xrow + 256 * j + 4 * lane); s += (v[j].x * v[j].x + v[j].y * v[j].y) + (v[j].z * v[j].z + v[j].w * v[j].w); }
    const float rs = rsqrtf(wave_sum(s) * (1.f / D) + EPS);
#pragma unroll
    for (int j = 0; j < 4; ++j) { const f32x4 gg = *(const f32x4*)(g + 256 * j + 4 * lane);
        if constexpr (Q8) { int w = 0; w = __builtin_amdgcn_cvt_pk_fp8_f32(v[j].x * rs * gg.x, v[j].y * rs * gg.y, w, false); w = __builtin_amdgcn_cvt_pk_fp8_f32(v[j].z * rs * gg.z, v[j].w * rs * gg.w, w, true);
            *(int*)((unsigned char*)orow + 256 * j + 4 * lane) = w; }
        else { u32x2 o; o.x = cvt_pk_bf16(v[j].x * rs * gg.x, v[j].y * rs * gg.y); o.y = cvt_pk_bf16(v[j].z * rs * gg.z, v[j].w * rs * gg.w);
            *(u32x2*)(orow + 256 * j + 4 * lane) = o; } }
}
__device__ __forceinline__ void p0_prologue(Frame& F, int rep) {
    const int gw = F.vcu * 8 + F.wave, NGW = F.G * 8, lane = F.lane;
    constexpr int N_WIN = 16 * 72, N_SQ = 256, N_PA = 8 * 16, N_E1 = 512, N_E2 = 256;
    constexpr int S_WIN = 0, S_WK = S_WIN + N_WIN, S_WV = S_WK + N_SQ, S_PA = S_WV + N_SQ, S_PB = S_PA + N_PA, S_MO = S_PB + N_PA, S_Q = S_MO + N_SQ, S_O = S_Q + N_SQ, S_E1 = S_O + N_SQ, S_E2 = S_E1 + NE * N_E1, S_END = S_E2 + NE * N_E2;
    const int IEND = rep ? S_E1 : S_END;
    auto desc = [&](int it) -> CvtItem {
        if (it < S_WK) { const int r = it - S_WIN, kb = r / 72, nb = r % 72, n0 = nb * 64; return cvt_desc(F.A->in[I_WIN], INC, n0 < 1536 ? n0 : n0 + 16, kb * 64, F.Win_t(), D, n0, 0, nullptr, P1_FP8 ? FP8_WMUL : 1.f, P1_FP8, lane); }
        if (it < S_WV) { const int r = it - S_WK; return cvt_desc(F.A->in[I_WXK], D, (r & 15) * 64, (r >> 4) * 64, F.Wk_t(), D, (r & 15) * 64, 0, nullptr, P1_FP8 ? FP8_WMUL : 1.f, P1_FP8, lane); }
        if (it < S_PA) { const int r = it - S_WV; return cvt_desc(F.A->in[I_WXV], D, (r & 15) * 64, (r >> 4) * 64, F.Wv_t(), D, (r & 15) * 64, 0, nullptr, P1_FP8 ? FP8_WMUL : 1.f, P1_FP8, lane); }
        if (it < S_PB) { const int r = it - S_PA; return cvt_desc(F.A->in[I_WPA], D, (r & 15) * 64, (r >> 4) * 64, F.Wpab_t(), D, (r & 15) * 64, 0, nullptr, 1.f, 0, lane); }
        if (it < S_MO) { const int r = it - S_PB; return cvt_desc(F.A->in[I_WPB], D, (r & 15) * 64, (r >> 4) * 64, F.Wpab_t(), D, (r & 15) * 64, 512, nullptr, 1.f, 0, lane); }
        if (it < S_Q)  { const int r = it - S_MO; return cvt_desc(F.A->in[I_WMO], D, (r & 15) * 64, (r >> 4) * 64, F.Wmo_t(), D, (r & 15) * 64, 0, nullptr, 1.f, 0, lane); }
        if (it < S_O)  { const int r = it - S_Q;  return cvt_desc(F.A->in[I_WXQ], D, (r & 15) * 64, (r >> 4) * 64, F.Wq_t(), D, (r & 15) * 64, 0, F.A->in[I_NXG], FP8_WMUL, 1, lane); }
        if (it < S_E1) { const int r = it - S_O;  return cvt_desc(F.A->in[I_WXO], D, (r & 15) * 64, (r >> 4) * 64, F.Wo_t(), D, (r & 15) * 64, 0, nullptr, FP8_WMUL, 1, lane); }
        if (it < S_E2) { const int r = it - S_E1, e = r / N_E1, q = r % N_E1, kb = q >> 5, nb = q & 31, nd = nb * 64;
            const int src = ((nd & 128) ? 1024 : 0) + 128 * (nd >> 8) + (nd & 127);
            return cvt_desc(F.A->in[I_WE1] + (size_t)e * D * 2048, 2048, src, kb * 64, (unsigned char*)F.W1_t() + (size_t)e * 2048 * D, D, nd, 0, F.A->in[I_NFFNG], FP8_WMUL, 1, lane); }
        const int r = it - S_E2, e = r / N_E2, q = r % N_E2;
        return cvt_desc(F.A->in[I_WE2] + (size_t)e * D * D, D, (q & 15) * 64, (q >> 4) * 64, (unsigned char*)F.W2_t() + (size_t)e * D * D, D, (q & 15) * 64, 0, nullptr, FP8_WMUL, 1, lane); };
    if (gw < IEND) {
        float va[64], vb[64]; CvtItem ca = desc(gw), cb = ca; cvt_load(ca, va);
        for (int it = gw;;) {
            const bool hb = it + NGW < IEND; if (hb) { cb = desc(it + NGW); cvt_load(cb, vb); }
            cvt_finish(ca, va); if (!hb) break;
            const bool ha = it + 2 * NGW < IEND; if (ha) { ca = desc(it + 2 * NGW); cvt_load(ca, va); }
            cvt_finish(cb, vb); if (!ha) break;
            it += 2 * NGW; }
    }
    for (int m = gw; m < T; m += NGW) rms_row_to_bf16<P1_FP8 != 0>(F.A->in[I_X] + (size_t)m * D, F.A->in[I_NMIXG], (bf16_t*)((unsigned char*)F.h() + (size_t)m * D * (P1_FP8 ? 1 : 2)), lane);
    for (int m = gw; m < TM; m += NGW) rms_row_to_bf16<P1_FP8 != 0>(F.A->in[I_MEM] + (size_t)m * D, F.A->in[I_NMEMG], (bf16_t*)((unsigned char*)F.memn() + (size_t)m * D * (P1_FP8 ? 1 : 2)), lane);
    const int gt = F.vcu * 512 + F.tid, NGT = F.G * 512;
    for (int i = gt; i < 256 * D; i += NGT) { const int j = i >> 10, k = i & 1023; const float* wr_ = F.A->in[I_WIN] + (size_t)k * INC + OFF_A; float s = 0.f;
#pragma unroll
        for (int r = 0; r < 16; ++r) s += wr_[r] * F.A->in[I_WA2][r * 256 + j];
        if (P1_FP8) { int w = __builtin_amdgcn_cvt_pk_fp8_f32(s * FP8_WMUL, 0.f, 0, false); ((unsigned char*)F.Win_t())[(size_t)(PC_A + j) * D + k] = (unsigned char)(w & 0xff); }
        else F.Win_t()[(size_t)(PC_A + j) * D + k] = f2bf(s); }
    for (int i = gt; i < NE * D; i += NGT) { const int e = i >> 10, k = i & 1023; F.Wr_t()[i] = f2bf(F.A->in[I_WR][k * NE + e] * F.A->in[I_NFFNG][k]); }
    for (int i = gt; i < 4 * 128 * 128; i += NGT) { const int t = (i >> 7) & 127, s = i & 127; F.sguw()[i] = f2bf(s <= t ? F.A->in[I_SW][i] : 0.f); }
}

struct ProbP1 {
    static constexpr bool GATHER = false, FP8 = (P1_FP8 != 0); static constexpr int EB = P1_FP8 ? 1 : 2, WSCALE = FP8_WSCALE;
    int K, lda, ldb, G, c; const unsigned char* ws;
    __device__ __forceinline__ bool next(int i, Unit& u) const {
        const int L = i * G + c;
        if (L < 1216) { u.aux = 0; pg8::map_tile(L, 64, 19, u.pm, u.pn); return true; }
        if (L < 1248) { u.aux = 1; u.pm = (L - 1216) >> 2; u.pn = (L - 1216) & 3; return true; }
        if (L < 1280) { u.aux = 2; u.pm = (L - 1248) >> 3; u.pn = (L - 1248) & 7; return true; }
        return false;
    }
    __device__ __forceinline__ const char* a_base(const Unit& u) const { const size_t o = u.aux == 0 ? WS_H : (u.aux == 1 ? WS_MEMN : WS_WV); return (const char*)(ws + o + (size_t)u.pm * 256 * D * EB); }
    __device__ __forceinline__ const char* b_base(const Unit& u) const { const size_t o = u.aux == 0 ? WS_WIN : (u.aux == 1 ? WS_WK : WS_MEMN); return (const char*)(ws + o + (size_t)u.pn * 256 * D * EB); }
    __device__ __forceinline__ unsigned a_off(const Unit&, int row, int C) const { return (unsigned)(row * D * EB + C * 2); }
};
struct EpiP1 {
    static constexpr bool MID = false;
    unsigned char* ws;
    __device__ __forceinline__ void operator()(const f32x4 (&acc)[2][2][4][2], const Unit& u, int wr, int wc, int fr, int fq) const {
        asm volatile("" : "+v"(fr), "+v"(fq));
        const size_t oo = u.aux == 0 ? WS_P : (u.aux == 1 ? WS_KMEM : WS_VT);
        bf16_t* O = (bf16_t*)(ws + oo); const int ldc = u.aux == 0 ? PN : (u.aux == 1 ? D : TM);
        const int act = (u.aux == 0) ? ((u.pn >= 6 && u.pn < 10) ? 1 : ((u.pn >= 10 && u.pn < 18) ? 2 : 0)) : 0;
        const int row0 = u.pm * 256 + wr * 64 + fr, col0 = u.pn * 256 + wc * 32 + 8 * fq; const bool svstat = (u.aux == 0) && (u.pn == 8 || u.pn == 9);
#pragma unroll
        for (int ai = 0; ai < 2; ++ai)
#pragma unroll
            for (int m = 0; m < 4; ++m) { bf16_t* rowp = O + (size_t)(row0 + ai * 128 + m * 16) * ldc + col0; float s1 = 0.f, s2 = 0.f;
#pragma unroll
                for (int bj = 0; bj < 2; ++bj) { float v[8];
#pragma unroll
                    for (int j = 0; j < 4; ++j) { v[j] = acc[ai][bj][m][0][j]; v[4 + j] = acc[ai][bj][m][1][j]; }
                    if (act == 1) {
#pragma unroll
                        for (int j = 0; j < 8; j += 2) { const f32x2 o = gelu_pk((f32x2){v[j], v[j + 1]}); v[j] = o.x; v[j + 1] = o.y; }
#pragma unroll
                        for (int j = 0; j < 8; ++j) { s1 += v[j]; s2 += v[j] * v[j]; } }
                    else if (act == 2) {
#pragma unroll
                        for (int j = 0; j < 8; j += 2) { const f32x2 o = sigmoid_pk((f32x2){v[j], v[j + 1]}); v[j] = o.x; v[j + 1] = o.y; } }
                    *(u32x4*)(rowp + bj * 128) = pack8(v); }
                if (svstat) {
                    s1 += __shfl_xor(s1, 16); s1 += __shfl_xor(s1, 32); s2 += __shfl_xor(s2, 16); s2 += __shfl_xor(s2, 32);
                    if (fq == 0) *(f32x2*)((float*)(ws + WS_SVS) + (size_t)(row0 + ai * 128 + m * 16) * 16 + (u.pn - 8) * 8 + wc * 2) = (f32x2){s1, s2}; } }
    }
};

__device__ __forceinline__ void gla_a_unit(Frame& F, int unit) {
    const int tid = F.tid, lane = F.lane, w = F.wave, fr = lane & 15, fq = lane >> 4;
    const int bh = unit >> 5, n = unit & 31, b = bh >> 2, h = bh & 3;
    const int t0 = b * SEQ + n * 64;
    LAS float* cum = (LAS float*)(F.lds); LAS float* tot = (LAS float*)(F.lds + 16640);
    LAS bf16_t* QIN = (LAS bf16_t*)(F.lds + 18688); LAS bf16_t* KIN = (LAS bf16_t*)(F.lds + 27904); LAS bf16_t* KOT = (LAS bf16_t*)(F.lds + 37120);
    LAS bf16_t* ATT = (LAS bf16_t*)(F.lds + 46336); LAS bf16_t* VT = (LAS bf16_t*)(F.lds + 55552);
    const int c = tid >> 3, d8 = (tid & 7) * 8;
    {
        float g[8]; unpack8(*(const u32x4*)(F.p() + (size_t)(t0 + c) * PN + PC_A + h * 64 + d8), g);
        const f32x4 b0 = *(const f32x4*)(F.A->in[I_BA] + h * 64 + d8), b1 = *(const f32x4*)(F.A->in[I_BA] + h * 64 + d8 + 4);
        const float bb[8] = {b0.x, b0.y, b0.z, b0.w, b1.x, b1.y, b1.z, b1.w};
#pragma unroll
        for (int j = 0; j < 8; ++j) { const float x = g[j] + bb[j]; const float ls = fminf(x, 0.f) - __logf(1.f + __expf(-fabsf(x))); cum[c * 65 + d8 + j] = ls * 0.0625f; }
    }
    __syncthreads();
    { const int d = tid & 63, seg = tid >> 6; float run = 0.f;
#pragma unroll
        for (int i = 0; i < 8; ++i) { run += cum[(seg * 8 + i) * 65 + d]; cum[(seg * 8 + i) * 65 + d] = run; }
        tot[seg * 64 + d] = run; }
    __syncthreads();
    { const int d = tid & 63, seg = tid >> 6; float off = 0.f;
#pragma unroll
        for (int s = 0; s < 7; ++s) if (s < seg) off += tot[s * 64 + d];
#pragma unroll
        for (int i = 0; i < 8; ++i) cum[(seg * 8 + i) * 65 + d] += off; }
    __syncthreads();
    {
        float qv[8], kv[8], qi[8], ki[8];
        unpack8(*(const u32x4*)(F.p() + (size_t)(t0 + c) * PN + PC_Q + h * 64 + d8), qv);
        unpack8(*(const u32x4*)(F.p() + (size_t)(t0 + c) * PN + PC_K + h * 64 + d8), kv);
#pragma unroll
        for (int j = 0; j < 8; ++j) { const float cm = cum[c * 65 + d8 + j], cl = cum[63 * 65 + d8 + j];
            qi[j] = qv[j] * 0.125f * __expf(cm); ki[j] = kv[j] * __expf(-cm);
            KOT[(d8 + j) * 72 + c] = f2bf(kv[j] * __expf(cl - cm));
            if (c == 63) F.decay()[unit * 64 + d8 + j] = __expf(cl); }
        const u32x4 qp = pack8(qi), kp = pack8(ki);
        *(LAS u32x4*)(QIN + c * 72 + d8) = qp; *(LAS u32x4*)(KIN + c * 72 + d8) = kp;
        *(u32x4*)(F.qin() + (size_t)(t0 + c) * 256 + h * 64 + d8) = qp;
        const int e16 = (tid & 7) * 16;
#pragma unroll
        for (int hh = 0; hh < 2; ++hh) { const u32x4 vv = *(const u32x4*)(F.p() + (size_t)(t0 + c) * PN + PC_V + h * 128 + e16 + 8 * hh);
            const unsigned ww[4] = {vv.x, vv.y, vv.z, vv.w};
#pragma unroll
            for (int j = 0; j < 4; ++j) { VT[(e16 + 8 * hh + 2 * j) * 72 + c] = (bf16_t)(ww[j] & 0xffffu); VT[(e16 + 8 * hh + 2 * j + 1) * 72 + c] = (bf16_t)(ww[j] >> 16); } }
    }
    __syncthreads();
    {
        const int mt = w >> 1;
        bf16x8 a[2];
#pragma unroll
        for (int ks = 0; ks < 2; ++ks) a[ks] = *(const LAS bf16x8*)(QIN + (16 * mt + fr) * 72 + 32 * ks + 8 * fq);
#pragma unroll
        for (int q = 0; q < 2; ++q) { const int nt = (w & 1) * 2 + q; f32x4 s = {0.f, 0.f, 0.f, 0.f};
#pragma unroll
            for (int ks = 0; ks < 2; ++ks) s = mma16(a[ks], *(const LAS bf16x8*)(KIN + (16 * nt + fr) * 72 + 32 * ks + 8 * fq), s);
#pragma unroll
            for (int r = 0; r < 4; ++r) { const int cc = 16 * mt + 4 * fq + r, ss = 16 * nt + fr; ATT[cc * 72 + ss] = f2bf(ss <= cc ? s[r] : 0.f); } }
    }
    __syncthreads();
    {
        const int mt = w >> 1, nt0 = (w & 1) * 4;
        bf16x8 aa[2], ak[2];
#pragma unroll
        for (int ks = 0; ks < 2; ++ks) { aa[ks] = *(const LAS bf16x8*)(ATT + (16 * mt + fr) * 72 + 32 * ks + 8 * fq); ak[ks] = *(const LAS bf16x8*)(KOT + (16 * mt + fr) * 72 + 32 * ks + 8 * fq); }
#pragma unroll
        for (int q = 0; q < 4; ++q) { const int nt = nt0 + q; f32x4 o = {0.f, 0.f, 0.f, 0.f}, kvv = {0.f, 0.f, 0.f, 0.f};
#pragma unroll
            for (int ks = 0; ks < 2; ++ks) { const bf16x8 bv = *(const LAS bf16x8*)(VT + (16 * nt + fr) * 72 + 32 * ks + 8 * fq); o = mma16(bv, aa[ks], o); kvv = mma16(ak[ks], bv, kvv); }
            *(u32x2*)(F.ointra() + (size_t)(t0 + 16 * mt + fr) * 512 + h * 128 + 16 * nt + 4 * fq) = (u32x2){cvt_pk_bf16(o[0], o[1]), cvt_pk_bf16(o[2], o[3])};
            *(u32x2*)(F.kvT() + ((size_t)unit * 128 + 16 * nt + fr) * 64 + 16 * mt + 4 * fq) = (u32x2){cvt_pk_bf16(kvv[0], kvv[1]), cvt_pk_bf16(kvv[2], kvv[3])}; }
    }
    __syncthreads();
}

__device__ __forceinline__ void gla_sscan_item(Frame& F, int item) {
    const int lane = F.lane, idx = item * 64 + lane, d4 = idx & 15, e = (idx >> 4) & 127, bh = idx >> 11;
    const bf16_t* kvp = F.kvT() + ((size_t)(bh * 32) * 128 + e) * 64 + d4 * 4; const float* dcp = F.decay() + (size_t)(bh * 32) * 64 + d4 * 4;
    bf16_t* sp = F.spT() + ((size_t)(bh * 32) * 128 + e) * 64 + d4 * 4;
    f32x4 S = {0.f, 0.f, 0.f, 0.f};
    for (int n0 = 0; n0 < 32; n0 += 8) { f32x4 kv[8], dc[8];
#pragma unroll
        for (int i = 0; i < 8; ++i) { const u32x2 kw = *(const u32x2*)(kvp + (size_t)(n0 + i) * 128 * 64); kv[i] = (f32x4){bflo(kw.x), bfhi(kw.x), bflo(kw.y), bfhi(kw.y)}; dc[i] = *(const f32x4*)(dcp + (size_t)(n0 + i) * 64); }
#pragma unroll
        for (int i = 0; i < 8; ++i) { u32x2 o; o.x = cvt_pk_bf16(S.x, S.y); o.y = cvt_pk_bf16(S.z, S.w); *(u32x2*)(sp + (size_t)(n0 + i) * 128 * 64) = o; S = dc[i] * S + kv[i]; } }
}
__device__ __forceinline__ void sgu_unit(Frame& F, int unit) {
    const int tid = F.tid, w = F.wave, lane = F.lane, fr = lane & 15, fq = lane >> 4, ch = unit >> 2, g = unit & 3, t0 = ch * 128;
    LAS f32x2* stat = (LAS f32x2*)F.lds; LAS bf16_t* vnT = (LAS bf16_t*)(F.lds + 1024);
    if (tid < 128) { const float* sp = (const float*)(F.A->ws + WS_SVS) + (size_t)(t0 + tid) * 16;
        const f32x4 a = *(const f32x4*)sp, b = *(const f32x4*)(sp + 4), c4 = *(const f32x4*)(sp + 8), d = *(const f32x4*)(sp + 12);
        const float s = (a.x + a.z) + (b.x + b.z) + (c4.x + c4.z) + (d.x + d.z), s2 = (a.y + a.w) + (b.y + b.w) + (c4.y + c4.w) + (d.y + d.w);
        const float mean = s * (1.f / 512.f), var = fmaxf(s2 * (1.f / 512.f) - mean * mean, 0.f);
        stat[tid] = (f32x2){mean, rsqrtf(var + EPS)}; }
    __syncthreads();
    { const int s = tid >> 2, c32 = (tid & 3) * 32; const f32x2 ms = stat[s];
#pragma unroll
        for (int q = 0; q < 4; ++q) { float v[8]; unpack8(*(const u32x4*)(F.p() + (size_t)(t0 + s) * PN + PC_SV + g * 128 + c32 + 8 * q), v);
#pragma unroll
            for (int j = 0; j < 8; ++j) { const int cidx = g * 128 + c32 + 8 * q + j; vnT[(c32 + 8 * q + j) * 136 + s] = f2bf((v[j] - ms.x) * ms.y * F.A->in[I_SNG][cidx] + F.A->in[I_SNB][cidx]); } } }
    __syncthreads();
    f32x4 acc[8];
#pragma unroll
    for (int ct = 0; ct < 8; ++ct) acc[ct] = (f32x4){0.f, 0.f, 0.f, 0.f};
    const int nks = (16 * w + 15) / 32 + 1;
    for (int ks = 0; ks < nks; ++ks) { const bf16x8 bw = *(const bf16x8*)(F.sguw() + (size_t)(g * 128 + 16 * w + fr) * 128 + 32 * ks + 8 * fq);
#pragma unroll
        for (int ct = 0; ct < 8; ++ct) acc[ct] = mma16(*(const LAS bf16x8*)(vnT + (16 * ct + fr) * 136 + 32 * ks + 8 * fq), bw, acc[ct]); }
    {
        const int t = 16 * w + fr; const float bias = F.A->in[I_SB][g * 128 + t];
        u32x2 uv[8];
#pragma unroll
        for (int ct = 0; ct < 8; ++ct) uv[ct] = *(const u32x2*)(F.p() + (size_t)(t0 + t) * PN + PC_U + g * 128 + 16 * ct + 4 * fq);
#pragma unroll
        for (int ct = 0; ct < 8; ++ct) { const int cidx = g * 128 + 16 * ct + 4 * fq; const u32x2 uu = uv[ct];
            u32x2 o; o.x = cvt_pk_bf16(bflo(uu.x) * (acc[ct][0] + bias), bfhi(uu.x) * (acc[ct][1] + bias)); o.y = cvt_pk_bf16(bflo(uu.y) * (acc[ct][2] + bias), bfhi(uu.y) * (acc[ct][3] + bias));
            *(u32x2*)(F.oab() + (size_t)(t0 + t) * D + 512 + cidx) = o; } }
    __syncthreads();
}
__device__ __forceinline__ void gla_out_item(Frame& F, int item) {
    const int lane = F.lane, fr = lane & 15, fq = lane >> 4, unit = item >> 2, mt = item & 3;
    const int bh = unit >> 5, n = unit & 31, b = bh >> 2, h = bh & 3; const size_t t = (size_t)b * SEQ + n * 64 + 16 * mt + fr;
    bf16x8 qf[2];
#pragma unroll
    for (int ks = 0; ks < 2; ++ks) qf[ks] = *(const bf16x8*)(F.qin() + t * 256 + h * 64 + 32 * ks + 8 * fq);
    const bf16_t* sp = F.spT() + (size_t)unit * 128 * 64;
    f32x4 o[8]; float ss = 0.f;
#pragma unroll
    for (int et = 0; et < 8; ++et) { const u32x2 ow = *(const u32x2*)(F.ointra() + t * 512 + h * 128 + 16 * et + 4 * fq); f32x4 acc = {bflo(ow.x), bfhi(ow.x), bflo(ow.y), bfhi(ow.y)};
#pragma unroll
        for (int ks = 0; ks < 2; ++ks) acc = mma16(*(const bf16x8*)(sp + (size_t)(16 * et + fr) * 64 + 32 * ks + 8 * fq), qf[ks], acc);
        o[et] = acc; ss += (acc[0] * acc[0] + acc[1] * acc[1]) + (acc[2] * acc[2] + acc[3] * acc[3]); }
    ss += __shfl_xor(ss, 16); ss += __shfl_xor(ss, 32);
    const float rstd = rsqrtf(ss * (1.f / 128.f) + EPS);
    f32x4 gv[8]; u32x2 rv[8];
#pragma unroll
    for (int et = 0; et < 8; ++et) { const int e = h * 128 + 16 * et + 4 * fq; gv[et] = *(const f32x4*)(F.A->in[I_GOUTG] + e); rv[et] = *(const u32x2*)(F.p() + t * PN + PC_R + e); }
#pragma unroll
    for (int et = 0; et < 8; ++et) { const int e = h * 128 + 16 * et + 4 * fq; const f32x4 g = gv[et];
        const u32x2 rr = rv[et]; const float r0 = bflo(rr.x), r1 = bfhi(rr.x), r2 = bflo(rr.y), r3 = bfhi(rr.y);
        u32x2 ov; ov.x = cvt_pk_bf16(o[et][0] * rstd * g.x * r0 * sigmoidf_(r0), o[et][1] * rstd * g.y * r1 * sigmoidf_(r1));
        ov.y = cvt_pk_bf16(o[et][2] * rstd * g.z * r2 * sigmoidf_(r2), o[et][3] * rstd * g.w * r3 * sigmoidf_(r3));
        *(u32x2*)(F.oab() + t * D + e) = ov; }
}

struct ProbSeg {
    static constexpr bool GATHER = false, FP8 = false; static constexpr int WSCALE = FP8_WSCALE;
    int K, lda, ldb, G, c; const bf16_t *oab, *Wpab_t;
    __device__ __forceinline__ bool next(int i, Unit& u) const { const int L = (i >> 1) * G + c; if (L >= 256) return false; pg8::map_tile(L, 64, 4, u.pm, u.pn); u.aux = i & 1; return true; }
    __device__ __forceinline__ const char* a_base(const Unit& u) const { return (const char*)(oab + (size_t)u.pm * 256 * D + u.aux * 512); }
    __device__ __forceinline__ const char* b_base(const Unit& u) const { return (const char*)(Wpab_t + (size_t)u.pn * 256 * D + u.aux * 512); }
    __device__ __forceinline__ unsigned a_off(const Unit&, int row, int C) const { return (unsigned)(row * D + C) * 2u; }
};
struct EpiMix {
    static constexpr bool MID = false;
    const bf16_t* p; bf16_t* mix;
    __device__ __forceinline__ void operator()(const f32x4 (&acc)[2][2][4][2], const Unit& u, int wr, int wc, int fr, int fq) const {
        asm volatile("" : "+v"(fr), "+v"(fq));
        const int row0 = u.pm * 256 + wr * 64 + fr, col0 = u.pn * 256 + wc * 32 + 8 * fq, gc = u.aux ? PC_GB : PC_GA;
#pragma unroll
        for (int ai = 0; ai < 2; ++ai) {
            u32x4 gw[4][2], pw[4][2];
#pragma unroll
            for (int m = 0; m < 4; ++m)
#pragma unroll
                for (int bj = 0; bj < 2; ++bj) { const size_t row = (size_t)(row0 + ai * 128 + m * 16);
                    gw[m][bj] = *(const u32x4*)(p + row * PN + gc + col0 + bj * 128);
                    pw[m][bj] = u.aux ? *(const u32x4*)(mix + row * D + col0 + bj * 128) : (u32x4){0u, 0u, 0u, 0u}; }
#pragma unroll
            for (int m = 0; m < 4; ++m)
#pragma unroll
                for (int bj = 0; bj < 2; ++bj) { const size_t row = (size_t)(row0 + ai * 128 + m * 16); float g[8], pv[8], v[8]; unpack8(gw[m][bj], g); unpack8(pw[m][bj], pv);
#pragma unroll
                    for (int j = 0; j < 4; ++j) { v[j] = acc[ai][bj][m][0][j] * g[j] + pv[j]; v[4 + j] = acc[ai][bj][m][1][j] * g[4 + j] + pv[4 + j]; }
                    *(u32x4*)(mix + row * D + col0 + bj * 128) = pack8(v); } }
    }
};

struct EpiMix2 {
    static constexpr bool MID = true;
    const bf16_t* p; bf16_t* mix;
    __device__ __forceinline__ void mid(f32x4 (&acc)[2][2][4][2], const Unit& u, int wr, int wc, int fr, int fq) const {
        asm volatile("" : "+v"(fr), "+v"(fq));
        const int row0 = u.pm * 256 + wr * 64 + fr, col0 = u.pn * 256 + wc * 32 + 8 * fq;
#pragma unroll
        for (int ai = 0; ai < 2; ++ai) { u32x4 ga[4][2], gb[4][2];
#pragma unroll
            for (int m = 0; m < 4; ++m)
#pragma unroll
                for (int bj = 0; bj < 2; ++bj) { const size_t row = (size_t)(row0 + ai * 128 + m * 16); ga[m][bj] = *(const u32x4*)(p + row * PN + PC_GA + col0 + bj * 128); gb[m][bj] = *(const u32x4*)(p + row * PN + PC_GB + col0 + bj * 128); }
#pragma unroll
            for (int m = 0; m < 4; ++m)
#pragma unroll
                for (int bj = 0; bj < 2; ++bj) { float a[8], b[8]; unpack8(ga[m][bj], a); unpack8(gb[m][bj], b);
#pragma unroll
                    for (int j = 0; j < 4; ++j) { acc[ai][bj][m][0][j] *= a[j] * __builtin_amdgcn_rcpf(fmaxf(b[j], 1e-20f)); acc[ai][bj][m][1][j] *= a[4 + j] * __builtin_amdgcn_rcpf(fmaxf(b[4 + j], 1e-20f)); } } }
    }
    __device__ __forceinline__ void operator()(const f32x4 (&acc)[2][2][4][2], const Unit& u, int wr, int wc, int fr, int fq) const {
        asm volatile("" : "+v"(fr), "+v"(fq));
        const int row0 = u.pm * 256 + wr * 64 + fr, col0 = u.pn * 256 + wc * 32 + 8 * fq;
#pragma unroll
        for (int ai = 0; ai < 2; ++ai) { u32x4 gb[4][2];
#pragma unroll
            for (int m = 0; m < 4; ++m)
#pragma unroll
                for (int bj = 0; bj < 2; ++bj) gb[m][bj] = *(const u32x4*)(p + (size_t)(row0 + ai * 128 + m * 16) * PN + PC_GB + col0 + bj * 128);
#pragma unroll
            for (int m = 0; m < 4; ++m)
#pragma unroll
                for (int bj = 0; bj < 2; ++bj) { float b[8], v[8]; unpack8(gb[m][bj], b);
#pragma unroll
                    for (int j = 0; j < 4; ++j) { v[j] = acc[ai][bj][m][0][j] * fmaxf(b[j], 1e-20f); v[4 + j] = acc[ai][bj][m][1][j] * fmaxf(b[4 + j], 1e-20f); }
                    *(u32x4*)(mix + (size_t)(row0 + ai * 128 + m * 16) * D + col0 + bj * 128) = pack8(v); } }
    }
};

template <bool Q8 = false, int WS_ = FP8_WSCALE> struct ProbStdT {
    static constexpr bool GATHER = false, FP8 = Q8; static constexpr int WSCALE = WS_, EB = Q8 ? 1 : 2;
    int K, lda, ldb, G, c; const void *A, *Bt;
    __device__ __forceinline__ bool next(int i, Unit& u) const { const int L = i * G + c; if (L >= 256) return false; pg8::map_tile(L, 64, 4, u.pm, u.pn); u.aux = 0; return true; }
    __device__ __forceinline__ const char* a_base(const Unit& u) const { return (const char*)A + (size_t)u.pm * 256 * D * EB; }
    __device__ __forceinline__ const char* b_base(const Unit& u) const { return (const char*)Bt + (size_t)u.pn * 256 * D * EB; }
    __device__ __forceinline__ unsigned a_off(const Unit&, int row, int C) const { return (unsigned)(row * D * EB + C * 2); }
};
typedef ProbStdT<false> ProbStd;
template <bool RESF32> struct EpiRes {
    static constexpr bool MID = false;
    const void* res; bf16_t* outb; float* ssq; unsigned char* outq;
    __device__ __forceinline__ void operator()(const f32x4 (&acc)[2][2][4][2], const Unit& u, int wr, int wc, int fr, int fq) const {
        asm volatile("" : "+v"(fr), "+v"(fq));
        const int row0 = u.pm * 256 + wr * 64 + fr, col0 = u.pn * 256 + wc * 32 + 8 * fq;
#pragma unroll
        for (int ai = 0; ai < 2; ++ai) {
            f32x4 rf[4][2][2]; u32x4 rb[4][2];
#pragma unroll
            for (int m = 0; m < 4; ++m)
#pragma unroll
                for (int bj = 0; bj < 2; ++bj) { const size_t off = (size_t)(row0 + ai * 128 + m * 16) * D + col0 + bj * 128;
                    if (RESF32) { rf[m][bj][0] = *(const f32x4*)((const float*)res + off); rf[m][bj][1] = *(const f32x4*)((const float*)res + off + 4); }
                    else rb[m][bj] = *(const u32x4*)((const bf16_t*)res + off); }
#pragma unroll
            for (int m = 0; m < 4; ++m) { const size_t row = (size_t)(row0 + ai * 128 + m * 16); float sq = 0.f;
#pragma unroll
                for (int bj = 0; bj < 2; ++bj) { float r[8], v[8];
                    if (RESF32) { r[0] = rf[m][bj][0].x; r[1] = rf[m][bj][0].y; r[2] = rf[m][bj][0].z; r[3] = rf[m][bj][0].w; r[4] = rf[m][bj][1].x; r[5] = rf[m][bj][1].y; r[6] = rf[m][bj][1].z; r[7] = rf[m][bj][1].w; }
                    else unpack8(rb[m][bj], r);
#pragma unroll
                    for (int j = 0; j < 4; ++j) { v[j] = acc[ai][bj][m][0][j] + r[j]; v[4 + j] = acc[ai][bj][m][1][j] + r[4 + j]; }
#pragma unroll
                    for (int j = 0; j < 8; ++j) sq += v[j] * v[j];
                    *(u32x4*)(outb + row * D + col0 + bj * 128) = pack8(v);
                    *(u32x2*)(outq + row * D + col0 + bj * 128) = pack8_fp8(v); }
                sq += __shfl_xor(sq, 16); sq += __shfl_xor(sq, 32);
                if (fq == 0) ssq[row * 16 + u.pn * 4 + wc] = sq; } }
    }
};
__device__ __forceinline__ float row_rs(const float* ssq, size_t row) {
    const f32x4 a = *(const f32x4*)(ssq + row * 16), b = *(const f32x4*)(ssq + row * 16 + 4), c = *(const f32x4*)(ssq + row * 16 + 8), d = *(const f32x4*)(ssq + row * 16 + 12);
    const float s = ((a.x + a.y) + (a.z + a.w)) + ((b.x + b.y) + (b.z + b.w)) + ((c.x + c.y) + (c.z + c.w)) + ((d.x + d.y) + (d.z + d.w));
    return rsqrtf(s * (1.f / D) + EPS);
}
struct EpiScale {
    static constexpr bool MID = false;
    const float* ssq; bf16_t* outb;
    __device__ __forceinline__ void operator()(const f32x4 (&acc)[2][2][4][2], const Unit& u, int wr, int wc, int fr, int fq) const {
        asm volatile("" : "+v"(fr), "+v"(fq));
        const int row0 = u.pm * 256 + wr * 64 + fr, col0 = u.pn * 256 + wc * 32 + 8 * fq;
        float rs[2][4];
#pragma unroll
        for (int ai = 0; ai < 2; ++ai)
#pragma unroll
            for (int m = 0; m < 4; ++m) rs[ai][m] = row_rs(ssq, (size_t)(row0 + ai * 128 + m * 16));
#pragma unroll
        for (int ai = 0; ai < 2; ++ai)
#pragma unroll
            for (int m = 0; m < 4; ++m) { const size_t row = (size_t)(row0 + ai * 128 + m * 16);
#pragma unroll
                for (int bj = 0; bj < 2; ++bj) { float v[8];
#pragma unroll
                    for (int j = 0; j < 4; ++j) { v[j] = acc[ai][bj][m][0][j] * rs[ai][m]; v[4 + j] = acc[ai][bj][m][1][j] * rs[ai][m]; }
                    *(u32x4*)(outb + row * D + col0 + bj * 128) = pack8(v); } }
    }
};

__device__ __forceinline__ void attn_unit(Frame& F, int unit) {
    const int tid = F.tid, w = F.wave, lane = F.lane, fr = lane & 15, fq = lane >> 4;
    const int b = unit >> 5, h = (unit >> 3) & 3, qb = unit & 7;
    const size_t tq = (size_t)b * SEQ + qb * 256 + 32 * w;
    LAS unsigned char* const bufs[2] = {F.lds, F.lds + 36864};
    const bf16_t* kg = F.kmem() + (size_t)(b * 256 + (tid >> 1)) * D + h * 256 + (tid & 1) * 32;
    const int kls = (tid >> 1) * 144 + (tid & 1) * 64;
    const bf16_t* vg = F.vt() + (size_t)(h * 256 + (tid >> 3)) * TM + b * 256 + (tid & 7) * 32;
    const int vls = (tid >> 3) * 528 + (tid & 7) * 64;
    u32x4 st[4];
#pragma unroll
    for (int i = 0; i < 4; ++i) st[i] = *(const u32x4*)(kg + 8 * i);
#pragma unroll
    for (int i = 0; i < 4; ++i) *(LAS u32x4*)(bufs[0] + kls + 16 * i) = st[i];
    __syncthreads();
    f32x4 s[16][2];
#pragma unroll
    for (int nt = 0; nt < 16; ++nt) { s[nt][0] = (f32x4){0.f, 0.f, 0.f, 0.f}; s[nt][1] = (f32x4){0.f, 0.f, 0.f, 0.f}; }
#pragma unroll
    for (int c = 0; c < 4; ++c) {
        if (c < 3) {
#pragma unroll
            for (int i = 0; i < 4; ++i) st[i] = *(const u32x4*)(kg + 64 * (c + 1) + 8 * i); }
        else {
#pragma unroll
            for (int i = 0; i < 4; ++i) st[i] = *(const u32x4*)(vg + 8 * i); }
        LAS unsigned char* kb = bufs[c & 1];
        bf16x8 qf[2][2];
#pragma unroll
        for (int qt = 0; qt < 2; ++qt)
#pragma unroll
            for (int ks = 0; ks < 2; ++ks) qf[qt][ks] = *(const bf16x8*)(F.q() + (tq + 16 * qt + fr) * D + h * 256 + 64 * c + 32 * ks + 8 * fq);
#pragma unroll
        for (int nt = 0; nt < 16; ++nt)
#pragma unroll
            for (int ks = 0; ks < 2; ++ks) { const bf16x8 a = *(const LAS bf16x8*)(kb + (16 * nt + fr) * 144 + (32 * ks + 8 * fq) * 2);
                s[nt][0] = mma16(a, qf[0][ks], s[nt][0]); s[nt][1] = mma16(a, qf[1][ks], s[nt][1]); }
        if (c < 3) {
#pragma unroll
            for (int i = 0; i < 4; ++i) *(LAS u32x4*)(bufs[(c + 1) & 1] + kls + 16 * i) = st[i]; }
        __syncthreads();
    }
#pragma unroll
    for (int i = 0; i < 4; ++i) *(LAS u32x4*)(bufs[0] + vls + 16 * i) = st[i];
    float inv[2]; bf16x8 pb[2][8];
#pragma unroll
    for (int qt = 0; qt < 2; ++qt) { float mx = s[0][qt][0];
#pragma unroll
        for (int nt = 0; nt < 16; ++nt)
#pragma unroll
            for (int r = 0; r < 4; ++r) mx = fmaxf(mx, s[nt][qt][r]);
        mx = fmaxf(mx, __shfl_xor(mx, 16)); mx = fmaxf(mx, __shfl_xor(mx, 32));
        float sum = 0.f;
#pragma unroll
        for (int nt = 0; nt < 16; ++nt)
#pragma unroll
            for (int r = 0; r < 4; ++r) { const float e = __expf(s[nt][qt][r] - mx); s[nt][qt][r] = e; sum += e; }
        sum += __shfl_xor(sum, 16); sum += __shfl_xor(sum, 32);
        inv[qt] = __builtin_amdgcn_rcpf(sum);
#pragma unroll
        for (int sk = 0; sk < 8; ++sk) { const float pv[8] = {s[2 * sk][qt][0], s[2 * sk][qt][1], s[2 * sk][qt][2], s[2 * sk][qt][3], s[2 * sk + 1][qt][0], s[2 * sk + 1][qt][1], s[2 * sk + 1][qt][2], s[2 * sk + 1][qt][3]};
            const u32x4 pk = pack8(pv); pb[qt][sk] = __builtin_bit_cast(bf16x8, pk); } }
    __syncthreads();
#pragma unroll
    for (int c = 0; c < 4; ++c) {
        if (c < 3) {
#pragma unroll
            for (int i = 0; i < 4; ++i) st[i] = *(const u32x4*)(vg + (size_t)64 * (c + 1) * TM + 8 * i); }
        LAS unsigned char* vb = bufs[c & 1];
#pragma unroll
        for (int dt = 0; dt < 4; ++dt) { f32x4 o0 = {0.f, 0.f, 0.f, 0.f}, o1 = {0.f, 0.f, 0.f, 0.f};
#pragma unroll
            for (int sk = 0; sk < 8; ++sk) { const LAS unsigned char* vp = vb + (16 * dt + fr) * 528 + (32 * sk + 4 * fq) * 2;
                const u32x2 lo = *(const LAS u32x2*)vp, hi = *(const LAS u32x2*)(vp + 32);
                const u32x4 av = {lo.x, lo.y, hi.x, hi.y}; const bf16x8 a = __builtin_bit_cast(bf16x8, av);
                o0 = mma16(a, pb[0][sk], o0); o1 = mma16(a, pb[1][sk], o1); }
            const int col = h * 256 + 64 * c + 16 * dt + 4 * fq;
            int w0 = 0, w1 = 0;
            w0 = __builtin_amdgcn_cvt_pk_fp8_f32(o0[0] * inv[0], o0[1] * inv[0], w0, false); w0 = __builtin_amdgcn_cvt_pk_fp8_f32(o0[2] * inv[0], o0[3] * inv[0], w0, true);
            w1 = __builtin_amdgcn_cvt_pk_fp8_f32(o1[0] * inv[1], o1[1] * inv[1], w1, false); w1 = __builtin_amdgcn_cvt_pk_fp8_f32(o1[2] * inv[1], o1[3] * inv[1], w1, true);
            *(int*)((unsigned char*)F.ao() + (tq + fr) * D + col) = w0; *(int*)((unsigned char*)F.ao() + (tq + 16 + fr) * D + col) = w1; }
        if (c < 3) {
#pragma unroll
            for (int i = 0; i < 4; ++i) *(LAS u32x4*)(bufs[(c + 1) & 1] + vls + 16 * i) = st[i]; }
        __syncthreads();
    }
}

__device__ __forceinline__ void router_item(Frame& F, int item) {
    const int w = F.wave, lane = F.lane, fr = lane & 15, fq = lane >> 4;
    const size_t t0 = (size_t)item * 16;
    LAS float* lg = (LAS float*)F.lds + w * (16 * 33 + 64);
    LAS int* ex = (LAS int*)(lg + 16 * 33);
    f32x4 acc[2] = {{0.f, 0.f, 0.f, 0.f}, {0.f, 0.f, 0.f, 0.f}};
    for (int k0 = 0; k0 < 32; k0 += 8) { bf16x8 a[8], b0[8], b1[8];
#pragma unroll
        for (int i = 0; i < 8; ++i) { a[i] = *(const bf16x8*)(F.x2b() + (t0 + fr) * D + 32 * (k0 + i) + 8 * fq);
            b0[i] = *(const bf16x8*)(F.Wr_t() + (size_t)fr * D + 32 * (k0 + i) + 8 * fq); b1[i] = *(const bf16x8*)(F.Wr_t() + (size_t)(16 + fr) * D + 32 * (k0 + i) + 8 * fq); }
#pragma unroll
        for (int i = 0; i < 8; ++i) { acc[0] = mma16(a[i], b0[i], acc[0]); acc[1] = mma16(a[i], b1[i], acc[1]); } }
#pragma unroll
    for (int r = 0; r < 4; ++r)
#pragma unroll
        for (int nt = 0; nt < 2; ++nt) lg[(4 * fq + r) * 33 + 16 * nt + fr] = acc[nt][r];
    LDS_WAIT();
    float rs = 0.f, gk[4] = {0.f, 0.f, 0.f, 0.f};
    if (lane < 16) { const size_t t = t0 + lane; rs = row_rs(F.ssq2(), t);
        float v[32];
#pragma unroll
        for (int e = 0; e < 32; ++e) v[e] = lg[lane * 33 + e] * rs + F.A->in[I_BR][e];
        unsigned taken = 0u; float tv[4];
#pragma unroll
        for (int k = 0; k < 4; ++k) { float best = -INFINITY; int bi = 0;
#pragma unroll
            for (int e = 0; e < 32; ++e) { const bool ok = !((taken >> e) & 1u) && (v[e] > best); best = ok ? v[e] : best; bi = ok ? e : bi; }
            taken |= 1u << bi; tv[k] = best; ex[lane * 4 + k] = bi; }
        float sum = 0.f;
#pragma unroll
        for (int k = 0; k < 4; ++k) { gk[k] = __expf(tv[k] - tv[0]); sum += gk[k]; }
        const float inv = 1.f / sum;
        *(f32x4*)(F.gates() + t * 4) = (f32x4){gk[0] * inv, gk[1] * inv, gk[2] * inv, gk[3] * inv}; }
    LDS_WAIT();
    const int me = ex[lane]; const float my_rs = __shfl(rs, lane >> 2);
    int rank = 0, mytot = 0;
#pragma unroll
    for (int e = 0; e < 32; ++e) { const unsigned long long m = __ballot(me == e); const int below = __builtin_popcountll(m & ((1ull << lane) - 1ull));
        rank = (me == e) ? below : rank; mytot = (lane == e) ? __builtin_popcountll(m) : mytot; }
    unsigned base = 0u;
    if (lane < 32 && mytot > 0) base = atomicAdd(F.ctl + CW_CNT + lane, (unsigned)mytot);
    const unsigned slot = (unsigned)__shfl((int)base, me) + (unsigned)rank;
    F.list()[me * ECAP + slot] = (int)(t0 * 4 + lane); F.lscale()[me * ECAP + slot] = my_rs;
    LDS_WAIT();
}

__device__ __forceinline__ void expert_tables(Frame& F) {
    LAS int* tab = (LAS int*)(F.lds + TAB_OFF);
    if (F.tid < 32) tab[F.tid] = (int)__hip_atomic_load(F.ctl + CW_CNT + F.tid, __ATOMIC_RELAXED, __HIP_MEMORY_SCOPE_AGENT);
    __syncthreads();
    if (F.tid == 0) { int s = 0; for (int e = 0; e < 32; ++e) { tab[32 + e] = s; s += (tab[e] + 255) >> 8; } tab[64] = s; }
    __syncthreads();
}
template <int NTN, bool GATH> struct ProbExp {
    static constexpr bool GATHER = GATH, gather = GATH, FP8 = true; static constexpr int WSCALE = FP8_WSCALE;
    int K, lda, ldb, G, c; const LAS int* tab; const unsigned char* A; const unsigned char* Bt; const int* list; mutable int ehint;
    __device__ __forceinline__ bool next(int i, Unit& u) const {
        const int L = i * G + c; if (L >= NTN * tab[64]) return false;
        int e = ehint;
#pragma unroll 1
        while (e < 31 && L >= NTN * tab[32 + e + 1]) ++e;
        ehint = e;
        const int r = L - NTN * tab[32 + e], mte = tab[32 + e + 1] - tab[32 + e];
        u.aux = e; u.pn = r / mte; u.pm = r % mte; return true;
    }
    __device__ __forceinline__ const char* a_base(const Unit& u) const { return gather ? (const char*)A : (const char*)(A + (size_t)(tab[32 + u.aux] + u.pm) * 256 * D); }
    __device__ __forceinline__ const char* b_base(const Unit& u) const { return (const char*)(Bt + ((size_t)u.aux * NTN + u.pn) * 256 * D); }
    __device__ __forceinline__ unsigned a_off(const Unit& u, int row, int C) const {
        if (!gather) return (unsigned)(row * D + C * 2);
        const int slot = u.pm * 256 + row; const int av = list[u.aux * ECAP + slot];
        const int a = slot < tab[u.aux] ? av : 0;
        return (unsigned)((a >> 2) * D + C * 2);
    }
};
struct EpiE1 {
    static constexpr bool MID = false;
    const LAS int* tab; const float* lscale; const float* b1; unsigned char* act;
    __device__ __forceinline__ void operator()(const f32x4 (&acc)[2][2][4][2], const Unit& u, int wr, int wc, int fr, int fq) const {
        asm volatile("" : "+v"(fr), "+v"(fq));
        const int e = u.aux; const size_t rbase = (size_t)(tab[32 + e] + u.pm) * 256;
        const int j0 = u.pn * 128 + wc * 32 + 8 * fq;
        const float* bp = b1 + (size_t)e * 2048 + j0;
        const f32x4 bg0 = *(const f32x4*)bp, bg1 = *(const f32x4*)(bp + 4), bl0 = *(const f32x4*)(bp + 1024), bl1 = *(const f32x4*)(bp + 1028);
        const float bg[8] = {bg0.x, bg0.y, bg0.z, bg0.w, bg1.x, bg1.y, bg1.z, bg1.w}, bl[8] = {bl0.x, bl0.y, bl0.z, bl0.w, bl1.x, bl1.y, bl1.z, bl1.w};
        float sc[2][4];
#pragma unroll
        for (int ai = 0; ai < 2; ++ai)
#pragma unroll
            for (int m = 0; m < 4; ++m) sc[ai][m] = lscale[e * ECAP + u.pm * 256 + ai * 128 + wr * 64 + m * 16 + fr];
#pragma unroll
        for (int ai = 0; ai < 2; ++ai)
#pragma unroll
            for (int m = 0; m < 4; ++m) { const int rt = ai * 128 + wr * 64 + m * 16 + fr; float v[8];
                const f32x2 s2 = {sc[ai][m], sc[ai][m]};
#pragma unroll
                for (int jp = 0; jp < 4; ++jp) {
                    const f32x2 ag = {acc[ai][0][m][jp >> 1][2 * (jp & 1)], acc[ai][0][m][jp >> 1][2 * (jp & 1) + 1]}, al = {acc[ai][1][m][jp >> 1][2 * (jp & 1)], acc[ai][1][m][jp >> 1][2 * (jp & 1) + 1]};
                    const f32x2 bg2 = {bg[2 * jp], bg[2 * jp + 1]}, bl2 = {bl[2 * jp], bl[2 * jp + 1]};
                    const f32x2 ga = ag * s2 + bg2, la = al * s2 + bl2;
                    const f32x2 glu = {fminf(ga.x, 7.0f), fminf(ga.y, 7.0f)}, lin = {fminf(fmaxf(la.x, -7.0f), 7.0f), fminf(fmaxf(la.y, -7.0f), 7.0f)};
                    const f32x2 t = glu * (-1.702f * 1.4426950408889634f);
                    const f32x2 d = (f32x2){__builtin_amdgcn_exp2f(t.x), __builtin_amdgcn_exp2f(t.y)} + 1.0f;
                    const f32x2 r = {__builtin_amdgcn_rcpf(d.x), __builtin_amdgcn_rcpf(d.y)};
                    const f32x2 o = ((lin + 1.0f) * glu) * r;
                    v[2 * jp] = o.x; v[2 * jp + 1] = o.y; }
                *(u32x2*)(act + (rbase + rt) * D + j0) = pack8_fp8(v); }
    }
};
struct EpiE2 {
    static constexpr bool MID = false;
    const LAS int* tab; const int* list; const float* b2; unsigned char* yb; unsigned char* dummy;
    __device__ __forceinline__ void operator()(const f32x4 (&acc)[2][2][4][2], const Unit& u, int wr, int wc, int fr, int fq) const {
        asm volatile("" : "+v"(fr), "+v"(fq));
        const int e = u.aux, cnt = tab[e]; const int col0 = u.pn * 256 + wc * 32 + 8 * fq;
        float bb[2][8];
#pragma unroll
        for (int bj = 0; bj < 2; ++bj) { const f32x4 x0 = *(const f32x4*)(b2 + (size_t)e * D + col0 + bj * 128), x1 = *(const f32x4*)(b2 + (size_t)e * D + col0 + bj * 128 + 4);
            bb[bj][0] = x0.x; bb[bj][1] = x0.y; bb[bj][2] = x0.z; bb[bj][3] = x0.w; bb[bj][4] = x1.x; bb[bj][5] = x1.y; bb[bj][6] = x1.z; bb[bj][7] = x1.w; }
        int aidx[2][4];
#pragma unroll
        for (int ai = 0; ai < 2; ++ai)
#pragma unroll
            for (int m = 0; m < 4; ++m) aidx[ai][m] = list[e * ECAP + u.pm * 256 + ai * 128 + wr * 64 + m * 16 + fr];
#pragma unroll
        for (int ai = 0; ai < 2; ++ai)
#pragma unroll
            for (int m = 0; m < 4; ++m) { const int slot = u.pm * 256 + ai * 128 + wr * 64 + m * 16 + fr;
                unsigned char* rowp = (slot < cnt) ? yb + (size_t)aidx[ai][m] * D : dummy;
#pragma unroll
                for (int bj = 0; bj < 2; ++bj) { float v[8];
#pragma unroll
                    for (int j = 0; j < 4; ++j) { v[j] = acc[ai][bj][m][0][j] + bb[bj][j]; v[4 + j] = acc[ai][bj][m][1][j] + bb[bj][4 + j]; }
                    *(u32x2*)(rowp + col0 + bj * 128) = pack8_fp8(v); } }
    }
};

struct CombTok { u32x4 x[2]; u32x2 y[2][4]; f32x4 g; };
__device__ __forceinline__ void comb_load(Frame& F, int t, int lane, CombTok& c) {
    c.g = *(const f32x4*)(F.gates() + (size_t)t * 4);
#pragma unroll
    for (int hf = 0; hf < 2; ++hf) { const int col = hf * 512 + lane * 8; c.x[hf] = *(const u32x4*)(F.x2b() + (size_t)t * D + col);
#pragma unroll
        for (int k = 0; k < 4; ++k) c.y[hf][k] = *(const u32x2*)((const unsigned char*)F.yb() + ((size_t)t * 4 + k) * D + col); }
}
__device__ __forceinline__ void comb_finish(Frame& F, int t, int lane, const CombTok& c) {
    const float gk[4] = {c.g.x, c.g.y, c.g.z, c.g.w}; float x[2][8]; float ss = 0.f;
#pragma unroll
    for (int hf = 0; hf < 2; ++hf) { unpack8(c.x[hf], x[hf]);
#pragma unroll
        for (int k = 0; k < 4; ++k) { float y[8]; unpack8_fp8(c.y[hf][k], y);
#pragma unroll
            for (int j = 0; j < 8; ++j) x[hf][j] += gk[k] * y[j]; }
#pragma unroll
        for (int j = 0; j < 8; ++j) ss += x[hf][j] * x[hf][j]; }
    const float rs = rsqrtf(wave_sum(ss) * (1.f / D) + EPS);
#pragma unroll
    for (int hf = 0; hf < 2; ++hf) { const int col = hf * 512 + lane * 8; const f32x4 g0 = *(const f32x4*)(F.A->in[I_NFING] + col), g1 = *(const f32x4*)(F.A->in[I_NFING] + col + 4);
        *(f32x4*)(F.A->out + (size_t)t * D + col) = (f32x4){x[hf][0] * rs * g0.x, x[hf][1] * rs * g0.y, x[hf][2] * rs * g0.z, x[hf][3] * rs * g0.w};
        *(f32x4*)(F.A->out + (size_t)t * D + col + 4) = (f32x4){x[hf][4] * rs * g1.x, x[hf][5] * rs * g1.y, x[hf][6] * rs * g1.z, x[hf][7] * rs * g1.w}; }
}
__device__ __forceinline__ void combine_rows(Frame& F) {
    const int gw = F.vcu * 8 + F.wave, NGW = F.G * 8, lane = F.lane;
    if (gw >= T) return;
    CombTok ca, cb; comb_load(F, gw, lane, ca);
    for (int t = gw;;) {
        const bool hb = t + NGW < T; if (hb) comb_load(F, t + NGW, lane, cb);
        comb_finish(F, t, lane, ca); if (!hb) break;
        const bool ha = t + 2 * NGW < T; if (ha) comb_load(F, t + 2 * NGW, lane, ca);
        comb_finish(F, t + NGW, lane, cb); if (!ha) break;
        t += 2 * NGW; }
}

#ifndef DBG_OUT
#define DBG_OUT 0
#endif
#if DBG_OUT
__device__ __forceinline__ void dbg_rows(Frame& F) {
    const int gw = F.vcu * 8 + F.wave, NGW = F.G * 8, lane = F.lane;
    for (int t = gw; t < T; t += NGW) {
#pragma unroll
        for (int hf = 0; hf < 2; ++hf) { const int col = hf * 512 + lane * 8; float x[8];
#pragma unroll
            for (int j = 0; j < 8; ++j) x[j] = 0.f;
            if (DBG_OUT == 1) { for (int m = 0; m < 5; ++m) { if (col + 1024 * m < PN) { float y[8]; unpack8(*(const u32x4*)(F.p() + (size_t)t * PN + col + 1024 * m), y);
#pragma unroll
                for (int j = 0; j < 8; ++j) x[j] += y[j]; } } }
            else if (DBG_OUT == 8) { for (int k = 0; k < 4; ++k) { float y[8]; unpack8_fp8(*(const u32x2*)((const unsigned char*)F.yb() + ((size_t)t * 4 + k) * D + col), y); const float g = F.gates()[t * 4 + k];
#pragma unroll
                for (int j = 0; j < 8; ++j) x[j] += g * y[j]; } }
            else { const bf16_t* B = DBG_OUT == 2 ? F.oab() : DBG_OUT == 3 ? F.mix() : DBG_OUT == 4 ? F.x1b() : DBG_OUT == 5 ? F.q() : DBG_OUT == 6 ? F.ao() : F.x2b();
                unpack8(*(const u32x4*)(B + (size_t)t * D + col), x); }
#pragma unroll
            for (int j = 0; j < 8; ++j) if (!(fabsf(x[j]) < 1e30f)) x[j] = 1e6f;
            *(f32x4*)(F.A->out + (size_t)t * D + col) = (f32x4){x[0], x[1], x[2], x[3]};
            *(f32x4*)(F.A->out + (size_t)t * D + col + 4) = (f32x4){x[4], x[5], x[6], x[7]}; }
    }
}
#endif

__global__ void __launch_bounds__(512, 2) fwd_kernel(Args args) {
    extern __shared__ __attribute__((aligned(16))) unsigned char lds[];
    Frame F;
    F.lds = (LAS unsigned char*)lds; F.MISC = (volatile LAS unsigned*)(F.lds + MISC_OFF);
    F.tid = threadIdx.x; F.lane = F.tid & 63; F.wave = __builtin_amdgcn_readfirstlane(F.tid >> 6);
    F.G = gridDim.x; { const int bx = blockIdx.x; F.vcu = (F.G % 8 == 0) ? (bx % 8) * (F.G / 8) + bx / 8 : bx; }
    F.ctl = (unsigned*)(args.ws + WS_CTL);
    F.A = &args;
    for (int u = F.tid; u < 64; u += 512) ((LAS unsigned*)(F.lds + MISC_OFF))[u] = 0u;
    __syncthreads();
    XcdBarrier bar; bar.bar = F.ctl + CW_BAR; bar.x = 0; bar.st = nullptr;
    if (!MK_PER_PHASE) bar = xcd_barrier_post(F.ctl + CW_BAR, F.MISC + 8);
    const int lo = args.ph_lo, hi = args.ph_hi;
#ifndef PH_MASK
#define PH_MASK 0x3fff
#endif
#define IN(k) (((PH_MASK >> (k)) & 1) && lo <= (k) && (k) < hi)
#ifndef DOUBLE_MASK
#define DOUBLE_MASK 0
#endif
#define REP(k) for (int _rep = 0; _rep < ((((DOUBLE_MASK) >> (k)) & 1) ? 2 : 1); ++_rep, ((((DOUBLE_MASK) >> (k)) & 1) && _rep == 1 ? xcd_barrier(bar) : (void)0))
#define SEAM(k) do { if (IN(k) && IN((k) + 1)) xcd_barrier(bar); } while (0)
    const int c = (int)blockIdx.x;

    if (IN(0)) REP(0) { p0_prologue(F, _rep); } SEAM(0);
    if (IN(1)) REP(1) { ProbP1 P{D, D, ProbP1::EB * D, F.G, c, args.ws}; EpiP1 E{args.ws}; pg8::gemm_phase(F.lds, P, E); } SEAM(1);
    if (IN(2)) REP(2) { for (int u = F.vcu; u < 1024; u += F.G) gla_a_unit(F, u); } SEAM(2);
    if (IN(3)) REP(3) { if (F.wave < 4) for (int it = F.vcu * 4 + F.wave; it < 1024; it += F.G * 4) gla_sscan_item(F, it);
                        for (int u = F.vcu; u < 512; u += F.G) sgu_unit(F, u); } SEAM(3);
    if (IN(4)) REP(4) { for (int it = F.vcu * 8 + F.wave; it < 4096; it += F.G * 8) gla_out_item(F, it); } SEAM(4);
    if (IN(5)) REP(5) { ProbStd P{D, D, 2 * D, F.G, c, F.oab(), F.Wpab_t()}; EpiMix2 E{F.p(), F.mix()}; pg8::gemm_phase(F.lds, P, E); } SEAM(5);
    if (IN(6)) REP(6) { ProbStd P{D, D, 2 * D, F.G, c, F.mix(), F.Wmo_t()}; EpiRes<true> E{(const void*)F.A->in[I_X], F.x1b(), F.ssq1(), F.x1q()}; pg8::gemm_phase(F.lds, P, E); } SEAM(6);
    if (IN(7)) REP(7) { ProbStdT<true, 0x75757575> P{D, D, D, F.G, c, F.x1q(), F.Wq_t()}; EpiScale E{F.ssq1(), F.q()};     pg8::gemm_phase(F.lds, P, E); } SEAM(7);
    if (IN(8)) REP(8) { for (int u = F.vcu; u < 256; u += F.G) attn_unit(F, u); } SEAM(8);
    if (IN(9)) REP(9) { ProbStdT<true> P{D, D, D, F.G, c, F.ao(), F.Wo_t()}; EpiRes<false> E{(const void*)F.x1b(), F.x2b(), F.ssq2(), F.x2q()}; pg8::gemm_phase(F.lds, P, E); } SEAM(9);
    if (IN(10)) REP(10) { for (int it = F.wave * F.G + F.vcu; it < 1024; it += 8 * F.G) router_item(F, it); } SEAM(10);
    if (IN(11)) REP(11) { expert_tables(F); const LAS int* tab = (const LAS int*)(F.lds + TAB_OFF);
        ProbExp<8, true> P{D, D, D, F.G, F.vcu, tab, F.x2q(), (const unsigned char*)F.W1_t(), F.list(), 0}; EpiE1 E{tab, F.lscale(), F.A->in[I_BE1], (unsigned char*)F.act()}; pg8::gemm_phase(F.lds, P, E); } SEAM(11);
    if (IN(12)) REP(12) { expert_tables(F); const LAS int* tab = (const LAS int*)(F.lds + TAB_OFF);
        ProbExp<4, false> P{D, D, D, F.G, F.vcu, tab, (const unsigned char*)F.act(), (const unsigned char*)F.W2_t(), F.list(), 0}; EpiE2 E{tab, F.list(), F.A->in[I_BE2], (unsigned char*)F.yb(), (unsigned char*)(args.ws + WS_CTL + 512 * 1024)}; pg8::gemm_phase(F.lds, P, E); } SEAM(12);
#if DBG_OUT
    if (lo <= 13 && 13 < hi) { dbg_rows(F); }
#else
    if (IN(13)) REP(13) { combine_rows(F); }
#endif
#undef IN
#undef SEAM
}

extern "C" void kernel_launch(void* const* d_in, const int* in_sizes, int n_in, void* d_out, int out_size, void* d_ws, size_t ws_size, hipStream_t stream) {
    static int grid = 0;
    if (grid == 0) {
        if (n_in != 28 || in_sizes[0] != T * D || out_size != T * D || ws_size < WS_END) { fprintf(stderr, "kernel_launch: unexpected problem (n_in %d, in0 %d, out %d, ws %zu); nothing launched\n", n_in, n_in > 0 ? in_sizes[0] : -1, out_size, ws_size); grid = -1; return; }
        int dev = 0, cus = 0, per_cu = 0;
        if (hipGetDevice(&dev) != hipSuccess || hipDeviceGetAttribute(&cus, hipDeviceAttributeMultiprocessorCount, dev) != hipSuccess) { grid = -1; return; }
        if (hipFuncSetAttribute((const void*)fwd_kernel, hipFuncAttributeMaxDynamicSharedMemorySize, LDS_BYTES) != hipSuccess) { fprintf(stderr, "kernel_launch: hipFuncSetAttribute failed\n"); grid = -1; return; }
        if (hipOccupancyMaxActiveBlocksPerMultiprocessor(&per_cu, (const void*)fwd_kernel, 512, LDS_BYTES) != hipSuccess || per_cu < 1) fprintf(stderr, "kernel_launch: occupancy query reports %d blocks per CU\n", per_cu);
        (void)hipGetLastError();
        grid = cus;
    }
    if (grid < 0) return;
    if (hipMemsetAsync((char*)d_ws + WS_CTL, 0, CTL_ZERO_BYTES, stream) != hipSuccess) { fprintf(stderr, "kernel_launch: memset failed\n"); return; }
    Args a{};
    for (int i = 0; i < 28; ++i) a.in[i] = (const float*)d_in[i];
    a.out = (float*)d_out; a.ws = (unsigned char*)d_ws;
#if MK_PER_PHASE
    for (int ph = 0; ph < NPHASE; ++ph) { a.ph_lo = ph; a.ph_hi = ph + 1; hipLaunchKernelGGL(fwd_kernel, dim3(grid), dim3(512), LDS_BYTES, stream, a); }
#else
    a.ph_lo = 0; a.ph_hi = NPHASE;
    hipLaunchKernelGGL(fwd_kernel, dim3(grid), dim3(512), LDS_BYTES, stream, a);
#endif
}
```

```cpp
#include <hip/hip_runtime.h>
#include <cstdio>
#include <cstdint>

#ifndef P1_FP8
#define P1_FP8 0
#endif
#ifndef MK_PER_PHASE
#define MK_PER_PHASE 0
#endif

#define LAS __attribute__((address_space(3)))
#define GAS __attribute__((address_space(1)))
typedef unsigned short bf16_t;
typedef short bf16x8 __attribute__((ext_vector_type(8)));
typedef float f32x4 __attribute__((ext_vector_type(4)));
typedef float f32x2 __attribute__((ext_vector_type(2)));
typedef unsigned u32x4 __attribute__((ext_vector_type(4)));
typedef unsigned u32x2 __attribute__((ext_vector_type(2)));
typedef int i32x4 __attribute__((ext_vector_type(4)));
typedef int i32x8 __attribute__((ext_vector_type(8)));
#define FP8_WSCALE 0x79797979
constexpr float FP8_WMUL = 64.0f;
typedef GAS unsigned gu32;

constexpr int T = 16384, D = 1024, NBATCH = 8, SEQ = 2048, MEMLEN = 256, TM = NBATCH * MEMLEN;
constexpr int INC = 4624;
constexpr int PN = 4864;
constexpr int PC_Q = 0, PC_K = 256, PC_V = 512, PC_R = 1024, PC_U = 1536, PC_SV = 2048, PC_GA = 2560, PC_GB = 3584, PC_A = 4608;
constexpr int OFF_A = 1536;
constexpr int NE = 32, NASG = T * 4, ECAP = 16384;
constexpr float EPS = 1e-5f;
constexpr int NPHASE = 14;

constexpr size_t MiB = 1u << 20;
constexpr size_t WS_CTL = 0, CTL_ZERO_BYTES = 1 * MiB;
constexpr size_t WS_WR = 1 * MiB, WS_SGUW = 1 * MiB + 256 * 1024, WS_DECAY = 1 * MiB + 512 * 1024;
constexpr size_t WS_WIN = 2 * MiB, WS_WK = 12 * MiB, WS_WV = 14 * MiB, WS_WPAB = 16 * MiB, WS_WMO = 18 * MiB, WS_WQ = 20 * MiB, WS_WO = 22 * MiB;
constexpr size_t WS_SSQ1 = 24 * MiB, WS_SSQ2 = 25 * MiB, WS_LIST = 26 * MiB, WS_LSCALE = 28 * MiB, WS_GATES = 30 * MiB;
constexpr size_t WS_W1 = 32 * MiB, WS_W2 = 160 * MiB, WS_H = 224 * MiB, WS_MEMN = 256 * MiB, WS_KMEM = 260 * MiB, WS_VT = 264 * MiB, WS_QIN = 268 * MiB;
constexpr size_t WS_OINTRA = 276 * MiB, WS_KVT = 308 * MiB, WS_OAB = 340 * MiB, WS_MIX = 372 * MiB, WS_X1B = 404 * MiB, WS_Q = 436 * MiB, WS_AO = 468 * MiB, WS_X2B = 500 * MiB;
constexpr size_t WS_P = 532 * MiB, WS_ACT = 684 * MiB, WS_YB = 828 * MiB, WS_SPT = 956 * MiB, WS_X2Q = 972 * MiB, WS_X1Q = 988 * MiB, WS_SVS = 1004 * MiB, WS_END = 1005 * MiB;
static_assert(WS_P + (size_t)T * PN * 2 <= WS_ACT && WS_ACT + (size_t)(NASG + NE * 256) * 1024 * 2 <= WS_YB && WS_YB + (size_t)NASG * 1024 * 2 <= WS_END, "ws map");
constexpr int CW_CNT = 64;
constexpr int CW_BAR = 4096;

constexpr int RING_BYTES = 131072;
constexpr int TAB_OFF = 139264, MISC_OFF = 141312, LDS_BYTES = 147456;

typedef __bf16 bf16x2_t __attribute__((ext_vector_type(2)));
__device__ __forceinline__ unsigned cvt_pk_bf16(float lo, float hi) { const f32x2 v = {lo, hi}; const bf16x2_t b = __builtin_convertvector(v, bf16x2_t); return __builtin_bit_cast(unsigned, b); }
__device__ __forceinline__ bf16_t f2bf(float f) { return (bf16_t)(cvt_pk_bf16(f, 0.f) & 0xffffu); }
__device__ __forceinline__ float bflo(unsigned w) { return __uint_as_float(w << 16); }
__device__ __forceinline__ float bfhi(unsigned w) { return __uint_as_float(w & 0xffff0000u); }
__device__ __forceinline__ float bf2f(bf16_t v) { return __uint_as_float((unsigned)v << 16); }
__device__ __forceinline__ void unpack8(const u32x4 w, float (&f)[8]) { f[0] = bflo(w.x); f[1] = bfhi(w.x); f[2] = bflo(w.y); f[3] = bfhi(w.y); f[4] = bflo(w.z); f[5] = bfhi(w.z); f[6] = bflo(w.w); f[7] = bfhi(w.w); }
__device__ __forceinline__ u32x4 pack8(const float (&f)[8]) { u32x4 w; w.x = cvt_pk_bf16(f[0], f[1]); w.y = cvt_pk_bf16(f[2], f[3]); w.z = cvt_pk_bf16(f[4], f[5]); w.w = cvt_pk_bf16(f[6], f[7]); return w; }
__device__ __forceinline__ u32x2 pack8_fp8(const float (&f)[8]) { int a = 0, b = 0;
    a = __builtin_amdgcn_cvt_pk_fp8_f32(f[0], f[1], a, false); a = __builtin_amdgcn_cvt_pk_fp8_f32(f[2], f[3], a, true);
    b = __builtin_amdgcn_cvt_pk_fp8_f32(f[4], f[5], b, false); b = __builtin_amdgcn_cvt_pk_fp8_f32(f[6], f[7], b, true);
    return (u32x2){(unsigned)a, (unsigned)b}; }
__device__ __forceinline__ void unpack8_fp8(const u32x2 w, float (&f)[8]) {
    const f32x2 a = __builtin_amdgcn_cvt_pk_f32_fp8((int)w.x, false), b = __builtin_amdgcn_cvt_pk_f32_fp8((int)w.x, true), c = __builtin_amdgcn_cvt_pk_f32_fp8((int)w.y, false), d = __builtin_amdgcn_cvt_pk_f32_fp8((int)w.y, true);
    f[0] = a.x; f[1] = a.y; f[2] = b.x; f[3] = b.y; f[4] = c.x; f[5] = c.y; f[6] = d.x; f[7] = d.y; }
__device__ __forceinline__ f32x4 mma16(bf16x8 a, bf16x8 b, f32x4 c) { return __builtin_amdgcn_mfma_f32_16x16x32_bf16(a, b, c, 0, 0, 0); }
__device__ __forceinline__ float wave_sum(float v) {
#pragma unroll
    for (int o = 1; o < 64; o <<= 1) v += __shfl_xor(v, o);
    return v;
}
__device__ __forceinline__ float sigmoidf_(float x) { return __builtin_amdgcn_rcpf(1.0f + __expf(-x)); }
__device__ __forceinline__ float gelu_erf(float v) {
    const float av = fabsf(v), t = __builtin_amdgcn_rcpf(av * 0.2316418882f + 1.0f);
    float q = t * 0.5307027145f + (-0.7265760135f); q = q * t + 0.7107068705f; q = q * t + (-0.142248368f); q = q * t + 0.127414796f; q = q * t;
    const float e = __builtin_amdgcn_exp2f((v * v) * (-0.72134752044f));
    const float m = v * (q * e);
    return v < 0.f ? m : v - m;
}
__device__ __forceinline__ f32x2 gelu_pk(f32x2 v) {
    const f32x2 av = __builtin_elementwise_abs(v), d = av * 0.2316418882f + 1.0f;
    f32x2 t; t.x = __builtin_amdgcn_rcpf(d.x); t.y = __builtin_amdgcn_rcpf(d.y);
    f32x2 q = t * 0.5307027145f + (-0.7265760135f); q = q * t + 0.7107068705f; q = q * t + (-0.142248368f); q = q * t + 0.127414796f; q = q * t;
    const f32x2 s = (v * v) * (-0.72134752044f);
    f32x2 e; e.x = __builtin_amdgcn_exp2f(s.x); e.y = __builtin_amdgcn_exp2f(s.y);
    const f32x2 m = v * (q * e), r = v - m;
    f32x2 o; o.x = v.x < 0.f ? m.x : r.x; o.y = v.y < 0.f ? m.y : r.y; return o;
}
__device__ __forceinline__ f32x2 sigmoid_pk(f32x2 v) {
    const f32x2 t = v * (-1.4426950408889634f); const f32x2 d = (f32x2){__builtin_amdgcn_exp2f(t.x), __builtin_amdgcn_exp2f(t.y)} + 1.0f;
    return (f32x2){__builtin_amdgcn_rcpf(d.x), __builtin_amdgcn_rcpf(d.y)};
}
#define LDS_WAIT() asm volatile("s_waitcnt lgkmcnt(0)" ::: "memory")
#define VM_WAIT() asm volatile("s_waitcnt vmcnt(0)" ::: "memory")

#define XB_TMO      128
#define XB_XCNT(j)  (256  + 64 * (j))
#define XB_XSUB(j)  (1280 + 64 * (j))
#define XB_XGEN(j)  (2304 + 64 * (j))
#define XB_TOP      3328
#define XB_TOPGEN   3392
#define XCD_BAR_WORDS 3456
#define XB_SPIN_CAP (1u << 22)
__device__ __forceinline__ unsigned xb_ld(unsigned* p)              { return __hip_atomic_load(p, __ATOMIC_RELAXED, __HIP_MEMORY_SCOPE_AGENT); }
__device__ __forceinline__ unsigned xb_add(unsigned* p, unsigned v) { return __hip_atomic_fetch_add(p, v, __ATOMIC_RELAXED, __HIP_MEMORY_SCOPE_AGENT); }
__device__ __forceinline__ unsigned xb_xcc_id() { return (unsigned)__builtin_amdgcn_s_getreg((3 << 11) | 20) & 0xFu; }
#define XB_SPIN(cond, bar) do { unsigned _sp = 0; while (cond) { __builtin_amdgcn_s_sleep(1); \
    if ((++_sp & 255u) == 0u) { if (xb_ld(&(bar)[XB_TMO])) break; if (_sp > XB_SPIN_CAP) { atomicAdd(&(bar)[XB_TMO], 1u); break; } } } } while (0)
struct XcdBarrier { unsigned* bar; unsigned x; volatile LAS unsigned* st; };
__device__ __forceinline__ XcdBarrier xcd_barrier_post(unsigned* bar, volatile LAS unsigned* st) {
    XcdBarrier b; b.bar = bar; b.x = xb_xcc_id(); b.st = st;
    if (threadIdx.x == 0) (void)xb_add(&bar[XB_XCNT(b.x)], 1u);
    return b;
}
__device__ __forceinline__ void xcd_barrier_complete(unsigned* bar, unsigned x, unsigned& nloc, unsigned& nx) {
    const unsigned G = gridDim.x * gridDim.y * gridDim.z;
    unsigned sum, cnt, mine, sp = 0u;
    for (;;) {
        sum = 0u; cnt = 0u; mine = 0u;
#pragma unroll
        for (unsigned j = 0; j < 16; ++j) { const unsigned c = xb_ld(&bar[XB_XCNT(j)]); sum += c; cnt += (c > 0u) ? 1u : 0u; mine = (j == x) ? c : mine; }
        if (sum == G) break;
        __builtin_amdgcn_s_sleep(1);
        if ((++sp & 255u) == 0u) { if (xb_ld(&bar[XB_TMO])) break; if (sp > XB_SPIN_CAP) { atomicAdd(&bar[XB_TMO], 1u); break; } }
    }
    nloc = mine > 0u ? mine : 1u; nx = cnt > 0u ? cnt : 1u;
}
__device__ __forceinline__ void xcd_barrier(const XcdBarrier& b) {
    asm volatile("s_waitcnt vmcnt(0)" ::: "memory");
    __syncthreads();
    if (threadIdx.x == 0) {
        unsigned* bar = b.bar;
        __builtin_amdgcn_s_waitcnt(0);
        unsigned nloc = b.st[0], nx = b.st[1];
        if (nloc == 0u) { xcd_barrier_complete(bar, b.x, nloc, nx); b.st[0] = nloc; b.st[1] = nx; }
        const unsigned old = xb_add(&bar[XB_XSUB(b.x)], 1u);
        const unsigned gen = old / nloc;
        if (old + 1u == (gen + 1u) * nloc) {
            __builtin_amdgcn_fence(__ATOMIC_RELEASE, "agent");
            asm volatile("s_waitcnt vmcnt(0)" ::: "memory");
            const unsigned og = xb_add(&bar[XB_TOP], 1u);
            const unsigned tg = og / nx;
            if (og + 1u == (tg + 1u) * nx) xb_add(&bar[XB_TOPGEN], 1u);
            else XB_SPIN(xb_ld(&bar[XB_TOPGEN]) == tg, bar);
            __builtin_amdgcn_fence(__ATOMIC_ACQUIRE, "agent");
            xb_add(&bar[XB_XGEN(b.x)], 1u);
            asm volatile("s_waitcnt vmcnt(0)" ::: "memory");
        } else {
            __builtin_amdgcn_fence(__ATOMIC_ACQUIRE, "agent");
            XB_SPIN(xb_ld(&bar[XB_XGEN(b.x)]) == gen, bar);
            asm volatile("s_waitcnt vmcnt(0)" ::: "memory");
        }
    }
    __syncthreads();
}

namespace pg8 {
constexpr int BM = 256, BK = 64, HALF = 128, HTB = HALF * BK * 2, NXCD = 8, WGM = 8;
__host__ __device__ __forceinline__ int lds_byte(int r, int c) { const int st = (r >> 4) * 2 + (c >> 5), rr = r & 15, cc = c & 31, ob = rr * 64 + cc * 2; return st * 1024 + (ob ^ (((ob >> 9) & 1) << 5)); }
__host__ __device__ __forceinline__ void stage_rc(int b, int& R, int& C) { const int st = b / 1024, sb = b % 1024, swz = sb ^ (((sb >> 9) & 1) << 5); R = (st >> 1) * 16 + swz / 64; C = (st & 1) * 32 + (swz % 64) / 2; }
__host__ __device__ __forceinline__ int perm32(int rho) { const int n = rho >> 4, i = rho & 15; return 8 * (i >> 2) + 4 * n + (i & 3); }
struct Unit { int pm, pn, aux; };
__device__ __forceinline__ void map_tile(int L, int nM, int nN, int& pm, int& pn) {
    const int nwg = nM * nN; int wgid = L;
    { const int q = nwg / NXCD, r = nwg % NXCD, xcd = wgid % NXCD, off = wgid / NXCD; wgid = (xcd < r ? xcd * (q + 1) : r * (q + 1) + (xcd - r) * q) + off; }
    const int nig = WGM * nN, gid = wgid / nig, fm = gid * WGM, gsz = (nM - fm) < WGM ? (nM - fm) : WGM;
    pm = fm + ((wgid % nig) % gsz); pn = (wgid % nig) / gsz;
}
template <class Epi, class Prob>
__device__ __forceinline__ void gemm_phase(LAS unsigned char* lds, const Prob& P, const Epi& E) {
    const int tid = threadIdx.x, wid = __builtin_amdgcn_readfirstlane(tid >> 6), lane = tid & 63, wr = wid >> 2, wc = wid & 3, fr = lane & 15, fq = lane >> 4;
    const int nt = P.K / (Prob::FP8 ? 128 : BK);
    unsigned voffB[2];
#pragma unroll
    for (int i = 0; i < 2; ++i) { int R_, C_; stage_rc(tid * 16 + i * 8192, R_, C_); const int Rb = (R_ & ~31) + perm32(R_ & 31); voffB[i] = (unsigned)(Rb * P.ldb + C_ * 2); }
#define PG8_AOFF(dst0, dst1, unit) do { _Pragma("unroll") for (int _i = 0; _i < 2; ++_i) { int R_, C_; stage_rc(tid * 16 + _i * 8192, R_, C_); dst0[_i] = P.a_off(unit, R_, C_); dst1[_i] = P.a_off(unit, R_ + HALF, C_); } } while (0)
    const size_t kstep = (size_t)(BK * 2);
    const size_t hstepB = (size_t)HALF * P.ldb;
    const unsigned ldsw = (unsigned)wid * 1024u;
    const int aoff = lds_byte(wr * 64 + fr, fq * 8), boff = lds_byte(wc * 32 + fr, fq * 8);
#define PG8_SA(b, h) (((b) * 2 + (h)) * HTB)
#define PG8_SB(b, h) ((4 + (b) * 2 + (h)) * HTB)
#define PG8_STAGE(bufoff, gbase, voff) do { _Pragma("unroll") for (int _i = 0; _i < 2; ++_i) \
        __builtin_amdgcn_global_load_lds((const unsigned*)((const char*)(gbase) + (voff)[_i]), (LAS unsigned*)(lds + (bufoff) + ldsw + _i * 8192), 16, 0, 0); } while (0)
#define PG8_LD8(addr) __builtin_shufflevector(*(const LAS i32x4*)(addr), *(const LAS i32x4*)((addr) + 1024), 0, 1, 2, 3, 4, 5, 6, 7)
#define PG8_LDA(dst, b, h) do { _Pragma("unroll") for (int m = 0; m < 4; ++m) dst[m] = PG8_LD8(lds + PG8_SA(b, h) + aoff + m * 2048); } while (0)
#define PG8_LDB(dst, b, h) do { _Pragma("unroll") for (int n = 0; n < 2; ++n) dst[n] = PG8_LD8(lds + PG8_SB(b, h) + boff + n * 2048); } while (0)
#define PG8_LO(x) __builtin_bit_cast(bf16x8, __builtin_shufflevector(x, x, 0, 1, 2, 3))
#define PG8_HI(x) __builtin_bit_cast(bf16x8, __builtin_shufflevector(x, x, 4, 5, 6, 7))
#define PG8_MMA(ai, bj, At, Bt) do { __builtin_amdgcn_s_setprio(1); _Pragma("unroll") for (int m = 0; m < 4; ++m) _Pragma("unroll") for (int n = 0; n < 2; ++n) { \
        if constexpr (Prob::FP8) asm volatile("v_mfma_scale_f32_16x16x128_f8f6f4 %0, %1, %2, %0, %3, %4 op_sel_hi:[0,0,0]" : "+v"(acc[ai][bj][m][n]) : "v"(Bt[n]), "v"(At[m]), "v"(scl_w), "v"(scl_1)); \
        else { acc[ai][bj][m][n] = __builtin_amdgcn_mfma_f32_16x16x32_bf16(PG8_LO(Bt[n]), PG8_LO(At[m]), acc[ai][bj][m][n], 0, 0, 0); \
               acc[ai][bj][m][n] = __builtin_amdgcn_mfma_f32_16x16x32_bf16(PG8_HI(Bt[n]), PG8_HI(At[m]), acc[ai][bj][m][n], 0, 0, 0); } } \
        __builtin_amdgcn_s_setprio(0); } while (0)
#define PG8_WAIT_V(n) asm volatile("s_waitcnt vmcnt(" #n ")" ::: "memory")
#define PG8_WAIT_L(n) asm volatile("s_waitcnt lgkmcnt(" #n ")" ::: "memory")
#define PG8_BAR __builtin_amdgcn_s_barrier()
#define PG8_SCHED __builtin_amdgcn_sched_barrier(0)
    Unit cur, nxt; int ui = 0;
    if (!P.next(0, cur)) return;
    f32x4 acc[2][2][4][2];
#pragma unroll
    for (int a = 0; a < 2; ++a)
#pragma unroll
        for (int b = 0; b < 2; ++b)
#pragma unroll
            for (int m = 0; m < 4; ++m)
#pragma unroll
                for (int n = 0; n < 2; ++n) acc[a][b][m][n] = (f32x4){0.f, 0.f, 0.f, 0.f};
    i32x8 At[4], B0[2], B1[2];
    int scl_w = Prob::WSCALE, scl_1 = 0x7f7f7f7f; asm volatile("" : "+v"(scl_w), "+v"(scl_1));
    unsigned cO0[2], cO1[2], nO0[2], nO1[2];
    PG8_AOFF(cO0, cO1, cur);
    const char* cA = P.a_base(cur); const char* cB = P.b_base(cur);
    PG8_STAGE(PG8_SB(0, 0), cB, voffB); PG8_STAGE(PG8_SB(0, 1), cB + hstepB, voffB); PG8_STAGE(PG8_SA(0, 0), cA, cO0); PG8_STAGE(PG8_SA(0, 1), cA, cO1);
    if (wr == 1) PG8_BAR;
    PG8_WAIT_V(2); PG8_BAR;
    PG8_STAGE(PG8_SB(1, 0), cB + kstep, voffB); PG8_STAGE(PG8_SA(1, 0), cA + kstep, cO0); PG8_STAGE(PG8_SB(1, 1), cB + hstepB + kstep, voffB);
    PG8_WAIT_V(6); PG8_BAR;
    for (;;) {
        const bool has_next = P.next(ui + 1, nxt);
        const char* nA = cA; const char* nB = cB;
        if constexpr (Prob::GATHER) {
#pragma unroll
            for (int i = 0; i < 2; ++i) { nO0[i] = cO0[i]; nO1[i] = cO1[i]; } }
        if (has_next) { nA = P.a_base(nxt); nB = P.b_base(nxt); if constexpr (Prob::GATHER) PG8_AOFF(nO0, nO1, nxt); }
        for (int t = 0; t < nt; t += 2) {
            const bool last = (t == nt - 2);
            const char* a1 = cA + (size_t)(t + 1) * kstep;
            const char* a2 = last ? nA : cA + (size_t)(t + 2) * kstep; const char* b2 = last ? nB : cB + (size_t)(t + 2) * kstep;
            const char* a3 = a2 + kstep; const char* b3 = b2 + kstep;
            unsigned o20[2], o21[2];
#pragma unroll
            for (int i = 0; i < 2; ++i) { if constexpr (Prob::GATHER) { o20[i] = last ? nO0[i] : cO0[i]; o21[i] = last ? nO1[i] : cO1[i]; } else { o20[i] = cO0[i]; o21[i] = cO1[i]; } }
            PG8_LDB(B0, 0, 0); PG8_LDB(B1, 0, 1); PG8_SCHED; PG8_LDA(At, 0, 0); PG8_STAGE(PG8_SA(1, 1), a1, cO1);
            PG8_WAIT_V(8); PG8_WAIT_L(0); PG8_BAR; PG8_MMA(0, 0, At, B0); PG8_MMA(0, 1, At, B1); PG8_BAR; PG8_SCHED;
            PG8_LDA(At, 0, 1); PG8_STAGE(PG8_SB(0, 0), b2, voffB); PG8_STAGE(PG8_SB(0, 1), b2 + hstepB, voffB); PG8_STAGE(PG8_SA(0, 0), a2, o20);
            PG8_WAIT_V(8); PG8_WAIT_L(0); PG8_BAR; PG8_MMA(1, 0, At, B0); PG8_MMA(1, 1, At, B1); PG8_BAR; PG8_SCHED;
            PG8_LDB(B0, 1, 0); PG8_LDB(B1, 1, 1); PG8_SCHED; PG8_LDA(At, 1, 0); PG8_STAGE(PG8_SA(0, 1), a2, o21);
            PG8_WAIT_V(8); PG8_WAIT_L(0); PG8_BAR; PG8_MMA(0, 0, At, B0); PG8_MMA(0, 1, At, B1); PG8_BAR; PG8_SCHED;
            PG8_LDA(At, 1, 1); PG8_STAGE(PG8_SB(1, 0), b3, voffB); PG8_STAGE(PG8_SB(1, 1), b3 + hstepB, voffB); PG8_STAGE(PG8_SA(1, 0), a3, o20);
            PG8_WAIT_V(8); PG8_WAIT_L(0); PG8_BAR; PG8_MMA(1, 0, At, B0); PG8_MMA(1, 1, At, B1); PG8_BAR; PG8_SCHED;
            if constexpr (Epi::MID) { if (t + 2 == nt / 2) E.mid(acc, cur, wr, wc, fr, fq); }
        }
        if (wr == 0) PG8_BAR;
        if constexpr (Prob::FP8) asm volatile("s_nop 15\n\ts_nop 15" ::: "memory");
        E(acc, cur, wr, wc, fr, fq);
        if (!has_next) break;
#pragma unroll
        for (int a = 0; a < 2; ++a)
#pragma unroll
            for (int b = 0; b < 2; ++b)
#pragma unroll
                for (int m = 0; m < 4; ++m)
#pragma unroll
                    for (int n = 0; n < 2; ++n) acc[a][b][m][n] = (f32x4){0.f, 0.f, 0.f, 0.f};
        cur = nxt; cA = nA; cB = nB; ++ui;
        if constexpr (Prob::GATHER) {
#pragma unroll
            for (int i = 0; i < 2; ++i) { cO0[i] = nO0[i]; cO1[i] = nO1[i]; } }
        if (wr == 1) PG8_BAR;
    }
    PG8_WAIT_V(0);
    PG8_BAR;
#undef PG8_AOFF
#undef PG8_SA
#undef PG8_SB
#undef PG8_STAGE
#undef PG8_LDA
#undef PG8_LD8
#undef PG8_LO
#undef PG8_HI
#undef PG8_LDB
#undef PG8_MMA
#undef PG8_WAIT_V
#undef PG8_WAIT_L
#undef PG8_BAR
#undef PG8_SCHED
}
}
using pg8::Unit;

struct Args { const float* in[28]; float* out; unsigned char* ws; int ph_lo, ph_hi; };
struct Frame {
    LAS unsigned char* lds;
    volatile LAS unsigned* MISC;
    unsigned* ctl;
    int tid, lane, wave, vcu, G;
    const Args* A;
    __device__ __forceinline__ bf16_t* Win_t() const { return (bf16_t*)(A->ws + WS_WIN); }
    __device__ __forceinline__ bf16_t* Wk_t() const { return (bf16_t*)(A->ws + WS_WK); }
    __device__ __forceinline__ bf16_t* Wv_t() const { return (bf16_t*)(A->ws + WS_WV); }
    __device__ __forceinline__ bf16_t* Wpab_t() const { return (bf16_t*)(A->ws + WS_WPAB); }
    __device__ __forceinline__ bf16_t* Wmo_t() const { return (bf16_t*)(A->ws + WS_WMO); }
    __device__ __forceinline__ bf16_t* Wq_t() const { return (bf16_t*)(A->ws + WS_WQ); }
    __device__ __forceinline__ bf16_t* Wo_t() const { return (bf16_t*)(A->ws + WS_WO); }
    __device__ __forceinline__ bf16_t* Wr_t() const { return (bf16_t*)(A->ws + WS_WR); }
    __device__ __forceinline__ bf16_t* W1_t() const { return (bf16_t*)(A->ws + WS_W1); }
    __device__ __forceinline__ bf16_t* W2_t() const { return (bf16_t*)(A->ws + WS_W2); }
    __device__ __forceinline__ bf16_t* sguw() const { return (bf16_t*)(A->ws + WS_SGUW); }
    __device__ __forceinline__ bf16_t* h() const { return (bf16_t*)(A->ws + WS_H); }
    __device__ __forceinline__ bf16_t* memn() const { return (bf16_t*)(A->ws + WS_MEMN); }
    __device__ __forceinline__ bf16_t* kmem() const { return (bf16_t*)(A->ws + WS_KMEM); }
    __device__ __forceinline__ bf16_t* vt() const { return (bf16_t*)(A->ws + WS_VT); }
    __device__ __forceinline__ bf16_t* qin() const { return (bf16_t*)(A->ws + WS_QIN); }
    __device__ __forceinline__ bf16_t* oab() const { return (bf16_t*)(A->ws + WS_OAB); }
    __device__ __forceinline__ bf16_t* mix() const { return (bf16_t*)(A->ws + WS_MIX); }
    __device__ __forceinline__ bf16_t* x1b() const { return (bf16_t*)(A->ws + WS_X1B); }
    __device__ __forceinline__ bf16_t* q() const { return (bf16_t*)(A->ws + WS_Q); }
    __device__ __forceinline__ bf16_t* ao() const { return (bf16_t*)(A->ws + WS_AO); }
    __device__ __forceinline__ bf16_t* x2b() const { return (bf16_t*)(A->ws + WS_X2B); }
    __device__ __forceinline__ bf16_t* p() const { return (bf16_t*)(A->ws + WS_P); }
    __device__ __forceinline__ bf16_t* act() const { return (bf16_t*)(A->ws + WS_ACT); }
    __device__ __forceinline__ bf16_t* yb() const { return (bf16_t*)(A->ws + WS_YB); }
    __device__ __forceinline__ bf16_t* ointra() const { return (bf16_t*)(A->ws + WS_OINTRA); }
    __device__ __forceinline__ bf16_t* kvT() const { return (bf16_t*)(A->ws + WS_KVT); }
    __device__ __forceinline__ float* decay() const { return (float*)(A->ws + WS_DECAY); }
    __device__ __forceinline__ float* ssq1() const { return (float*)(A->ws + WS_SSQ1); }
    __device__ __forceinline__ float* ssq2() const { return (float*)(A->ws + WS_SSQ2); }
    __device__ __forceinline__ float* lscale() const { return (float*)(A->ws + WS_LSCALE); }
    __device__ __forceinline__ float* gates() const { return (float*)(A->ws + WS_GATES); }
    __device__ __forceinline__ int* list() const { return (int*)(A->ws + WS_LIST); }
    __device__ __forceinline__ bf16_t* spT() const { return (bf16_t*)(A->ws + WS_SPT); }
    __device__ __forceinline__ unsigned char* x2q() const { return (unsigned char*)(A->ws + WS_X2Q); }
    __device__ __forceinline__ unsigned char* x1q() const { return (unsigned char*)(A->ws + WS_X1Q); }
};
enum { I_X = 0, I_MEM, I_NMIXG, I_WIN, I_WA2, I_BA, I_GOUTG, I_SNG, I_SNB, I_SW, I_SB, I_WPA, I_WPB, I_WMO, I_NXG, I_NMEMG, I_WXQ, I_WXK, I_WXV, I_WXO, I_NFFNG, I_WR, I_BR, I_WE1, I_BE1, I_WE2, I_BE2, I_NFING };

struct CvtItem { const float* src; size_t ldw; unsigned char* dst; const float* kscale; float mul; int fp8; };
__device__ __forceinline__ void cvt_load(const CvtItem& c, float (&v)[64]) {
#pragma unroll
    for (int i = 0; i < 64; ++i) v[i] = __builtin_nontemporal_load(c.src + (size_t)i * c.ldw);
}
__device__ __forceinline__ void cvt_finish(const CvtItem& c, float (&v)[64]) {
    if (c.kscale) {
#pragma unroll
        for (int i = 0; i < 64; ++i) v[i] *= c.kscale[i] * c.mul; }
    else {
#pragma unroll
        for (int i = 0; i < 64; ++i) v[i] *= c.mul; }
    if (c.fp8) {
#pragma unroll
        for (int q = 0; q < 4; ++q) { const float f0[8] = {v[16 * q], v[16 * q + 1], v[16 * q + 2], v[16 * q + 3], v[16 * q + 4], v[16 * q + 5], v[16 * q + 6], v[16 * q + 7]};
            const float f1[8] = {v[16 * q + 8], v[16 * q + 9], v[16 * q + 10], v[16 * q + 11], v[16 * q + 12], v[16 * q + 13], v[16 * q + 14], v[16 * q + 15]};
            const u32x2 lo = pack8_fp8(f0), hi = pack8_fp8(f1); *(u32x4*)(c.dst + 16 * q) = (u32x4){lo.x, lo.y, hi.x, hi.y}; } }
    else {
#pragma unroll
        for (int q = 0; q < 8; ++q) { const float f[8] = {v[8 * q], v[8 * q + 1], v[8 * q + 2], v[8 * q + 3], v[8 * q + 4], v[8 * q + 5], v[8 * q + 6], v[8 * q + 7]}; *(u32x4*)(c.dst + 16 * q) = pack8(f); } }
}
__device__ __forceinline__ CvtItem cvt_desc(const float* W, int ldw, int src_col0, int k0, void* WT, int ldt, int dst_row0, int dst_k0, const float* kscale, float mul, int fp8, int lane) {
    CvtItem c; const int eb = fp8 ? 1 : 2;
    c.src = W + (size_t)k0 * ldw + src_col0 + lane; c.ldw = (size_t)ldw; c.dst = (unsigned char*)WT + ((size_t)(dst_row0 + lane) * ldt + dst_k0 + k0) * eb;
    c.kscale = kscale ? kscale + k0 : nullptr; c.mul = mul; c.fp8 = fp8; return c;
}
template <bool Q8>
__device__ __forceinline__ void rms_row_to_bf16(const float* xrow, const float* g, bf16_t* orow, int lane) {
    f32x4 v[4]; float s = 0.f;
#pragma unroll
    for (int j = 0; j < 4; ++j) { v[j] = *(const f32x4*)(xrow + 256 * j + 4 * lane); s += (v[j].x * v[j].x + v[j].y * v[j].y) + (v[j].z * v[j].z + v[j].w * v[j].w); }
    const float rs = rsqrtf(wave_sum(s) * (1.f / D) + EPS);
#pragma unroll
    for (int j = 0; j < 4; ++j) { const f32x4 gg = *(const f32x4*)(g + 256 * j + 4 * lane);
        if constexpr (Q8) { int w = 0; w = __builtin_amdgcn_cvt_pk_fp8_f32(v[j].x * rs * gg.x, v[j].y * rs * gg.y, w, false); w = __builtin_amdgcn_cvt_pk_fp8_f32(v[j].z * rs * gg.z, v[j].w * rs * gg.w, w, true);
            *(int*)((unsigned char*)orow + 256 * j + 4 * lane) = w; }
        else { u32x2 o; o.x = cvt_pk_bf16(v[j].x * rs * gg.x, v[j].y * rs * gg.y); o.y = cvt_pk_bf16(v[j].z * rs * gg.z, v[j].w * rs * gg.w);
            *(u32x2*)(orow + 256 * j + 4 * lane) = o; } }
}
__device__ __forceinline__ void cvt_range(Frame& F, int ibeg, int iend) {
    const int gw = F.vcu * 8 + F.wave, NGW = F.G * 8, lane = F.lane;
    constexpr int N_WIN = 16 * 72, N_SQ = 256, N_PA = 8 * 16, N_E1 = 512, N_E2 = 256;
    constexpr int S_WIN = 0, S_WK = S_WIN + N_WIN, S_WV = S_WK + N_SQ, S_PA = S_WV + N_SQ, S_PB = S_PA + N_PA, S_MO = S_PB + N_PA, S_Q = S_MO + N_SQ, S_O = S_Q + N_SQ, S_E1 = S_O + N_SQ, S_E2 = S_E1 + NE * N_E1, S_END = S_E2 + NE * N_E2;
    static_assert(S_E1 == 16 * 72 + 256 * 2 + 8 * 16 * 2 + 256 * 3 && S_END == S_E1 + NE * 512 + NE * 256, "item ranges");
    const int IEND = iend < S_END ? iend : S_END;
    auto desc = [&](int it) -> CvtItem {
        if (it < S_WK) { const int r = it - S_WIN, kb = r / 72, nb = r % 72, n0 = nb * 64; return cvt_desc(F.A->in[I_WIN], INC, n0 < 1536 ? n0 : n0 + 16, kb * 64, F.Win_t(), D, n0, 0, nullptr, P1_FP8 ? FP8_WMUL : 1.f, P1_FP8, lane); }
        if (it < S_WV) { const int r = it - S_WK; return cvt_desc(F.A->in[I_WXK], D, (r & 15) * 64, (r >> 4) * 64, F.Wk_t(), D, (r & 15) * 64, 0, nullptr, P1_FP8 ? FP8_WMUL : 1.f, P1_FP8, lane); }
        if (it < S_PA) { const int r = it - S_WV; return cvt_desc(F.A->in[I_WXV], D, (r & 15) * 64, (r >> 4) * 64, F.Wv_t(), D, (r & 15) * 64, 0, nullptr, P1_FP8 ? FP8_WMUL : 1.f, P1_FP8, lane); }
        if (it < S_PB) { const int r = it - S_PA; return cvt_desc(F.A->in[I_WPA], D, (r & 15) * 64, (r >> 4) * 64, F.Wpab_t(), D, (r & 15) * 64, 0, nullptr, 1.f, 0, lane); }
        if (it < S_MO) { const int r = it - S_PB; return cvt_desc(F.A->in[I_WPB], D, (r & 15) * 64, (r >> 4) * 64, F.Wpab_t(), D, (r & 15) * 64, 512, nullptr, 1.f, 0, lane); }
        if (it < S_Q)  { const int r = it - S_MO; return cvt_desc(F.A->in[I_WMO], D, (r & 15) * 64, (r >> 4) * 64, F.Wmo_t(), D, (r & 15) * 64, 0, nullptr, 1.f, 0, lane); }
        if (it < S_O)  { const int r = it - S_Q;  return cvt_desc(F.A->in[I_WXQ], D, (r & 15) * 64, (r >> 4) * 64, F.Wq_t(), D, (r & 15) * 64, 0, F.A->in[I_NXG], FP8_WMUL, 1, lane); }
        if (it < S_E1) { const int r = it - S_O;  return cvt_desc(F.A->in[I_WXO], D, (r & 15) * 64, (r >> 4) * 64, F.Wo_t(), D, (r & 15) * 64, 0, nullptr, FP8_WMUL, 1, lane); }
        if (it < S_E2) { const int r = it - S_E1, e = r / N_E1, q = r % N_E1, kb = q >> 5, nb = q & 31, nd = nb * 64;
            const int src = ((nd & 128) ? 1024 : 0) + 128 * (nd >> 8) + (nd & 127);
            return cvt_desc(F.A->in[I_WE1] + (size_t)e * D * 2048, 2048, src, kb * 64, (unsigned char*)F.W1_t() + (size_t)e * 2048 * D, D, nd, 0, F.A->in[I_NFFNG], FP8_WMUL, 1, lane); }
        const int r = it - S_E2, e = r / N_E2, q = r % N_E2;
        return cvt_desc(F.A->in[I_WE2] + (size_t)e * D * D, D, (q & 15) * 64, (q >> 4) * 64, (unsigned char*)F.W2_t() + (size_t)e * D * D, D, (q & 15) * 64, 0, nullptr, FP8_WMUL, 1, lane); };
    if (ibeg + gw < IEND) {
        float va[64], vb[64]; CvtItem ca = desc(ibeg + gw), cb = ca; cvt_load(ca, va);
        for (int it = ibeg + gw;;) {
            const bool hb = it + NGW < IEND; if (hb) { cb = desc(it + NGW); cvt_load(cb, vb); }
            cvt_finish(ca, va); if (!hb) break;
            const bool ha = it + 2 * NGW < IEND; if (ha) { ca = desc(it + 2 * NGW); cvt_load(ca, va); }
            cvt_finish(cb, vb); if (!ha) break;
            it += 2 * NGW; }
    }
}
constexpr int CVT_LATE = 16 * 72 + 256 * 2, CVT_EXPERT = 16 * 72 + 256 * 2 + 8 * 16 * 2 + 256 * 3, CVT_END = CVT_EXPERT + NE * 512 + NE * 256;
__device__ __forceinline__ void p0_prologue(Frame& F) {
    const int gw = F.vcu * 8 + F.wave, NGW = F.G * 8, lane = F.lane;
    cvt_range(F, 0, CVT_LATE);
    for (int m = gw; m < T; m += NGW) rms_row_to_bf16<P1_FP8 != 0>(F.A->in[I_X] + (size_t)m * D, F.A->in[I_NMIXG], (bf16_t*)((unsigned char*)F.h() + (size_t)m * D * (P1_FP8 ? 1 : 2)), lane);
    for (int m = gw; m < TM; m += NGW) rms_row_to_bf16<P1_FP8 != 0>(F.A->in[I_MEM] + (size_t)m * D, F.A->in[I_NMEMG], (bf16_t*)((unsigned char*)F.memn() + (size_t)m * D * (P1_FP8 ? 1 : 2)), lane);
    const int gt = F.vcu * 512 + F.tid, NGT = F.G * 512;
    for (int i = gt; i < 256 * D; i += NGT) { const int j = i >> 10, k = i & 1023; const float* wr_ = F.A->in[I_WIN] + (size_t)k * INC + OFF_A; float s = 0.f;
#pragma unroll
        for (int r = 0; r < 16; ++r) s += wr_[r] * F.A->in[I_WA2][r * 256 + j];
        if (P1_FP8) { int w = __builtin_amdgcn_cvt_pk_fp8_f32(s * FP8_WMUL, 0.f, 0, false); ((unsigned char*)F.Win_t())[(size_t)(PC_A + j) * D + k] = (unsigned char)(w & 0xff); }
        else F.Win_t()[(size_t)(PC_A + j) * D + k] = f2bf(s); }
    for (int i = gt; i < NE * D; i += NGT) { const int e = i >> 10, k = i & 1023; F.Wr_t()[i] = f2bf(F.A->in[I_WR][k * NE + e] * F.A->in[I_NFFNG][k]); }
    for (int i = gt; i < 4 * 128 * 128; i += NGT) { const int t = (i >> 7) & 127, s = i & 127; F.sguw()[i] = f2bf(s <= t ? F.A->in[I_SW][i] : 0.f); }
}

struct ProbP1 {
    static constexpr bool GATHER = false, FP8 = (P1_FP8 != 0); static constexpr int EB = P1_FP8 ? 1 : 2, WSCALE = FP8_WSCALE;
    int K, lda, ldb, G, c; const unsigned char* ws;
    __device__ __forceinline__ bool next(int i, Unit& u) const {
        const int L = i * G + c;
        if (L < 1216) { u.aux = 0; pg8::map_tile(L, 64, 19, u.pm, u.pn); return true; }
        if (L < 1248) { u.aux = 1; u.pm = (L - 1216) >> 2; u.pn = (L - 1216) & 3; return true; }
        if (L < 1280) { u.aux = 2; u.pm = (L - 1248) >> 3; u.pn = (L - 1248) & 7; return true; }
        return false;
    }
    __device__ __forceinline__ const char* a_base(const Unit& u) const { const size_t o = u.aux == 0 ? WS_H : (u.aux == 1 ? WS_MEMN : WS_WV); return (const char*)(ws + o + (size_t)u.pm * 256 * D * EB); }
    __device__ __forceinline__ const char* b_base(const Unit& u) const { const size_t o = u.aux == 0 ? WS_WIN : (u.aux == 1 ? WS_WK : WS_MEMN); return (const char*)(ws + o + (size_t)u.pn * 256 * D * EB); }
    __device__ __forceinline__ unsigned a_off(const Unit&, int row, int C) const { return (unsigned)(row * D * EB + C * 2); }
};
struct EpiP1 {
    static constexpr bool MID = false;
    unsigned char* ws;
    __device__ __forceinline__ void operator()(const f32x4 (&acc)[2][2][4][2], const Unit& u, int wr, int wc, int fr, int fq) const {
        asm volatile("" : "+v"(fr), "+v"(fq));
        const size_t oo = u.aux == 0 ? WS_P : (u.aux == 1 ? WS_KMEM : WS_VT);
        bf16_t* O = (bf16_t*)(ws + oo); const int ldc = u.aux == 0 ? PN : (u.aux == 1 ? D : TM);
        const int act = (u.aux == 0) ? ((u.pn >= 6 && u.pn < 10) ? 1 : ((u.pn >= 10 && u.pn < 18) ? 2 : 0)) : 0;
        const int row0 = u.pm * 256 + wr * 64 + fr, col0 = u.pn * 256 + wc * 32 + 8 * fq; const bool svstat = (u.aux == 0) && (u.pn == 8 || u.pn == 9);
#pragma unroll
        for (int ai = 0; ai < 2; ++ai)
#pragma unroll
            for (int m = 0; m < 4; ++m) { bf16_t* rowp = O + (size_t)(row0 + ai * 128 + m * 16) * ldc + col0; float s1 = 0.f, s2 = 0.f;
#pragma unroll
                for (int bj = 0; bj < 2; ++bj) { float v[8];
#pragma unroll
                    for (int j = 0; j < 4; ++j) { v[j] = acc[ai][bj][m][0][j]; v[4 + j] = acc[ai][bj][m][1][j]; }
                    if (act == 1) {
#pragma unroll
                        for (int j = 0; j < 8; j += 2) { const f32x2 o = gelu_pk((f32x2){v[j], v[j + 1]}); v[j] = o.x; v[j + 1] = o.y; }
#pragma unroll
                        for (int j = 0; j < 8; ++j) { s1 += v[j]; s2 += v[j] * v[j]; } }
                    else if (act == 2) {
#pragma unroll
                        for (int j = 0; j < 8; j += 2) { const f32x2 o = sigmoid_pk((f32x2){v[j], v[j + 1]}); v[j] = o.x; v[j + 1] = o.y; } }
                    *(u32x4*)(rowp + bj * 128) = pack8(v); }
                if (svstat) {
                    s1 += __shfl_xor(s1, 16); s1 += __shfl_xor(s1, 32); s2 += __shfl_xor(s2, 16); s2 += __shfl_xor(s2, 32);
                    if (fq == 0) *(f32x2*)((float*)(ws + WS_SVS) + (size_t)(row0 + ai * 128 + m * 16) * 16 + (u.pn - 8) * 8 + wc * 2) = (f32x2){s1, s2}; } }
    }
};

__device__ __forceinline__ void gla_a_unit(Frame& F, int unit) {
    const int tid = F.tid, lane = F.lane, w = F.wave, fr = lane & 15, fq = lane >> 4;
    const int bh = unit >> 5, n = unit & 31, b = bh >> 2, h = bh & 3;
    const int t0 = b * SEQ + n * 64;
    LAS float* cum = (LAS float*)(F.lds); LAS float* tot = (LAS float*)(F.lds + 16640);
    LAS bf16_t* QIN = (LAS bf16_t*)(F.lds + 18688); LAS bf16_t* KIN = (LAS bf16_t*)(F.lds + 27904); LAS bf16_t* KOT = (LAS bf16_t*)(F.lds + 37120);
    LAS bf16_t* ATT = (LAS bf16_t*)(F.lds + 46336); LAS bf16_t* VT = (LAS bf16_t*)(F.lds + 55552);
    const int c = tid >> 3, d8 = (tid & 7) * 8;
    {
        float g[8]; unpack8(*(const u32x4*)(F.p() + (size_t)(t0 + c) * PN + PC_A + h * 64 + d8), g);
        const f32x4 b0 = *(const f32x4*)(F.A->in[I_BA] + h * 64 + d8), b1 = *(const f32x4*)(F.A->in[I_BA] + h * 64 + d8 + 4);
        const float bb[8] = {b0.x, b0.y, b0.z, b0.w, b1.x, b1.y, b1.z, b1.w};
#pragma unroll
        for (int j = 0; j < 8; ++j) { const float x = g[j] + bb[j]; const float ls = fminf(x, 0.f) - __logf(1.f + __expf(-fabsf(x))); cum[c * 65 + d8 + j] = ls * 0.0625f; }
    }
    __syncthreads();
    { const int d = tid & 63, seg = tid >> 6; float run = 0.f;
#pragma unroll
        for (int i = 0; i < 8; ++i) { run += cum[(seg * 8 + i) * 65 + d]; cum[(seg * 8 + i) * 65 + d] = run; }
        tot[seg * 64 + d] = run; }
    __syncthreads();
    { const int d = tid & 63, seg = tid >> 6; float off = 0.f;
#pragma unroll
        for (int s = 0; s < 7; ++s) if (s < seg) off += tot[s * 64 + d];
#pragma unroll
        for (int i = 0; i < 8; ++i) cum[(seg * 8 + i) * 65 + d] += off; }
    __syncthreads();
    {
        float qv[8], kv[8], qi[8], ki[8];
        unpack8(*(const u32x4*)(F.p() + (size_t)(t0 + c) * PN + PC_Q + h * 64 + d8), qv);
        unpack8(*(const u32x4*)(F.p() + (size_t)(t0 + c) * PN + PC_K + h * 64 + d8), kv);
#pragma unroll
        for (int j = 0; j < 8; ++j) { const float cm = cum[c * 65 + d8 + j], cl = cum[63 * 65 + d8 + j];
            qi[j] = qv[j] * 0.125f * __expf(cm); ki[j] = kv[j] * __expf(-cm);
            KOT[(d8 + j) * 72 + c] = f2bf(kv[j] * __expf(cl - cm));
            if (c == 63) F.decay()[unit * 64 + d8 + j] = __expf(cl); }
        const u32x4 qp = pack8(qi), kp = pack8(ki);
        *(LAS u32x4*)(QIN + c * 72 + d8) = qp; *(LAS u32x4*)(KIN + c * 72 + d8) = kp;
        *(u32x4*)(F.qin() + (size_t)(t0 + c) * 256 + h * 64 + d8) = qp;
        const int e16 = (tid & 7) * 16;
#pragma unroll
        for (int hh = 0; hh < 2; ++hh) { const u32x4 vv = *(const u32x4*)(F.p() + (size_t)(t0 + c) * PN + PC_V + h * 128 + e16 + 8 * hh);
            const unsigned ww[4] = {vv.x, vv.y, vv.z, vv.w};
#pragma unroll
            for (int j = 0; j < 4; ++j) { VT[(e16 + 8 * hh + 2 * j) * 72 + c] = (bf16_t)(ww[j] & 0xffffu); VT[(e16 + 8 * hh + 2 * j + 1) * 72 + c] = (bf16_t)(ww[j] >> 16); } }
    }
    __syncthreads();
    {
        const int mt = w >> 1;
        bf16x8 a[2];
#pragma unroll
        for (int ks = 0; ks < 2; ++ks) a[ks] = *(const LAS bf16x8*)(QIN + (16 * mt + fr) * 72 + 32 * ks + 8 * fq);
#pragma unroll
        for (int q = 0; q < 2; ++q) { const int nt = (w & 1) * 2 + q; f32x4 s = {0.f, 0.f, 0.f, 0.f};
#pragma unroll
            for (int ks = 0; ks < 2; ++ks) s = mma16(a[ks], *(const LAS bf16x8*)(KIN + (16 * nt + fr) * 72 + 32 * ks + 8 * fq), s);
#pragma unroll
            for (int r = 0; r < 4; ++r) { const int cc = 16 * mt + 4 * fq + r, ss = 16 * nt + fr; ATT[cc * 72 + ss] = f2bf(ss <= cc ? s[r] : 0.f); } }
    }
    __syncthreads();
    {
        const int mt = w >> 1, nt0 = (w & 1) * 4;
        bf16x8 aa[2], ak[2];
#pragma unroll
        for (int ks = 0; ks < 2; ++ks) { aa[ks] = *(const LAS bf16x8*)(ATT + (16 * mt + fr) * 72 + 32 * ks + 8 * fq); ak[ks] = *(const LAS bf16x8*)(KOT + (16 * mt + fr) * 72 + 32 * ks + 8 * fq); }
#pragma unroll
        for (int q = 0; q < 4; ++q) { const int nt = nt0 + q; f32x4 o = {0.f, 0.f, 0.f, 0.f}, kvv = {0.f, 0.f, 0.f, 0.f};
#pragma unroll
            for (int ks = 0; ks < 2; ++ks) { const bf16x8 bv = *(const LAS bf16x8*)(VT + (16 * nt + fr) * 72 + 32 * ks + 8 * fq); o = mma16(bv, aa[ks], o); kvv = mma16(ak[ks], bv, kvv); }
            *(u32x2*)(F.ointra() + (size_t)(t0 + 16 * mt + fr) * 512 + h * 128 + 16 * nt + 4 * fq) = (u32x2){cvt_pk_bf16(o[0], o[1]), cvt_pk_bf16(o[2], o[3])};
            *(u32x2*)(F.kvT() + ((size_t)unit * 128 + 16 * nt + fr) * 64 + 16 * mt + 4 * fq) = (u32x2){cvt_pk_bf16(kvv[0], kvv[1]), cvt_pk_bf16(kvv[2], kvv[3])}; }
    }
    __syncthreads();
}

__device__ __forceinline__ void gla_sscan_item(Frame& F, int item) {
    const int lane = F.lane, idx = item * 64 + lane, d4 = idx & 15, e = (idx >> 4) & 127, bh = idx >> 11;
    const bf16_t* kvp = F.kvT() + ((size_t)(bh * 32) * 128 + e) * 64 + d4 * 4; const float* dcp = F.decay() + (size_t)(bh * 32) * 64 + d4 * 4;
    bf16_t* sp = F.spT() + ((size_t)(bh * 32) * 128 + e) * 64 + d4 * 4;
    f32x4 S = {0.f, 0.f, 0.f, 0.f};
    for (int n0 = 0; n0 < 32; n0 += 8) { f32x4 kv[8], dc[8];
#pragma unroll
        for (int i = 0; i < 8; ++i) { const u32x2 kw = *(const u32x2*)(kvp + (size_t)(n0 + i) * 128 * 64); kv[i] = (f32x4){bflo(kw.x), bfhi(kw.x), bflo(kw.y), bfhi(kw.y)}; dc[i] = *(const f32x4*)(dcp + (size_t)(n0 + i) * 64); }
#pragma unroll
        for (int i = 0; i < 8; ++i) { u32x2 o; o.x = cvt_pk_bf16(S.x, S.y); o.y = cvt_pk_bf16(S.z, S.w); *(u32x2*)(sp + (size_t)(n0 + i) * 128 * 64) = o; S = dc[i] * S + kv[i]; } }
}
__device__ __forceinline__ void sgu_unit(Frame& F, int unit) {
    const int tid = F.tid, w = F.wave, lane = F.lane, fr = lane & 15, fq = lane >> 4, ch = unit >> 2, g = unit & 3, t0 = ch * 128;
    LAS f32x2* stat = (LAS f32x2*)F.lds; LAS bf16_t* vnT = (LAS bf16_t*)(F.lds + 1024);
    if (tid < 128) { const float* sp = (const float*)(F.A->ws + WS_SVS) + (size_t)(t0 + tid) * 16;
        const f32x4 a = *(const f32x4*)sp, b = *(const f32x4*)(sp + 4), c4 = *(const f32x4*)(sp + 8), d = *(const f32x4*)(sp + 12);
        const float s = (a.x + a.z) + (b.x + b.z) + (c4.x + c4.z) + (d.x + d.z), s2 = (a.y + a.w) + (b.y + b.w) + (c4.y + c4.w) + (d.y + d.w);
        const float mean = s * (1.f / 512.f), var = fmaxf(s2 * (1.f / 512.f) - mean * mean, 0.f);
        stat[tid] = (f32x2){mean, rsqrtf(var + EPS)}; }
    __syncthreads();
    { const int s = tid >> 2, c32 = (tid & 3) * 32; const f32x2 ms = stat[s];
#pragma unroll
        for (int q = 0; q < 4; ++q) { float v[8]; unpack8(*(const u32x4*)(F.p() + (size_t)(t0 + s) * PN + PC_SV + g * 128 + c32 + 8 * q), v);
#pragma unroll
            for (int j = 0; j < 8; ++j) { const int cidx = g * 128 + c32 + 8 * q + j; vnT[(c32 + 8 * q + j) * 136 + s] = f2bf((v[j] - ms.x) * ms.y * F.A->in[I_SNG][cidx] + F.A->in[I_SNB][cidx]); } } }
    __syncthreads();
    f32x4 acc[8];
#pragma unroll
    for (int ct = 0; ct < 8; ++ct) acc[ct] = (f32x4){0.f, 0.f, 0.f, 0.f};
    const int nks = (16 * w + 15) / 32 + 1;
    for (int ks = 0; ks < nks; ++ks) { const bf16x8 bw = *(const bf16x8*)(F.sguw() + (size_t)(g * 128 + 16 * w + fr) * 128 + 32 * ks + 8 * fq);
#pragma unroll
        for (int ct = 0; ct < 8; ++ct) acc[ct] = mma16(*(const LAS bf16x8*)(vnT + (16 * ct + fr) * 136 + 32 * ks + 8 * fq), bw, acc[ct]); }
    {
        const int t = 16 * w + fr; const float bias = F.A->in[I_SB][g * 128 + t];
        u32x2 uv[8];
#pragma unroll
        for (int ct = 0; ct < 8; ++ct) uv[ct] = *(const u32x2*)(F.p() + (size_t)(t0 + t) * PN + PC_U + g * 128 + 16 * ct + 4 * fq);
#pragma unroll
        for (int ct = 0; ct < 8; ++ct) { const int cidx = g * 128 + 16 * ct + 4 * fq; const u32x2 uu = uv[ct];
            u32x2 o; o.x = cvt_pk_bf16(bflo(uu.x) * (acc[ct][0] + bias), bfhi(uu.x) * (acc[ct][1] + bias)); o.y = cvt_pk_bf16(bflo(uu.y) * (acc[ct][2] + bias), bfhi(uu.y) * (acc[ct][3] + bias));
            *(u32x2*)(F.oab() + (size_t)(t0 + t) * D + 512 + cidx) = o; } }
    __syncthreads();
}
__device__ __forceinline__ void gla_out_item(Frame& F, int item) {
    const int lane = F.lane, fr = lane & 15, fq = lane >> 4, unit = item >> 2, mt = item & 3;
    const int bh = unit >> 5, n = unit & 31, b = bh >> 2, h = bh & 3; const size_t t = (size_t)b * SEQ + n * 64 + 16 * mt + fr;
    bf16x8 qf[2];
#pragma unroll
    for (int ks = 0; ks < 2; ++ks) qf[ks] = *(const bf16x8*)(F.qin() + t * 256 + h * 64 + 32 * ks + 8 * fq);
    const bf16_t* sp = F.spT() + (size_t)unit * 128 * 64;
    f32x4 o[8]; float ss = 0.f;
#pragma unroll
    for (int et = 0; et < 8; ++et) { const u32x2 ow = *(const u32x2*)(F.ointra() + t * 512 + h * 128 + 16 * et + 4 * fq); f32x4 acc = {bflo(ow.x), bfhi(ow.x), bflo(ow.y), bfhi(ow.y)};
#pragma unroll
        for (int ks = 0; ks < 2; ++ks) acc = mma16(*(const bf16x8*)(sp + (size_t)(16 * et + fr) * 64 + 32 * ks + 8 * fq), qf[ks], acc);
        o[et] = acc; ss += (acc[0] * acc[0] + acc[1] * acc[1]) + (acc[2] * acc[2] + acc[3] * acc[3]); }
    ss += __shfl_xor(ss, 16); ss += __shfl_xor(ss, 32);
    const float rstd = rsqrtf(ss * (1.f / 128.f) + EPS);
    f32x4 gv[8]; u32x2 rv[8];
#pragma unroll
    for (int et = 0; et < 8; ++et) { const int e = h * 128 + 16 * et + 4 * fq; gv[et] = *(const f32x4*)(F.A->in[I_GOUTG] + e); rv[et] = *(const u32x2*)(F.p() + t * PN + PC_R + e); }
#pragma unroll
    for (int et = 0; et < 8; ++et) { const int e = h * 128 + 16 * et + 4 * fq; const f32x4 g = gv[et];
        const u32x2 rr = rv[et]; const float r0 = bflo(rr.x), r1 = bfhi(rr.x), r2 = bflo(rr.y), r3 = bfhi(rr.y);
        u32x2 ov; ov.x = cvt_pk_bf16(o[et][0] * rstd * g.x * r0 * sigmoidf_(r0), o[et][1] * rstd * g.y * r1 * sigmoidf_(r1));
        ov.y = cvt_pk_bf16(o[et][2] * rstd * g.z * r2 * sigmoidf_(r2), o[et][3] * rstd * g.w * r3 * sigmoidf_(r3));
        *(u32x2*)(F.oab() + t * D + e) = ov; }
}

struct ProbSeg {
    static constexpr bool GATHER = false, FP8 = false; static constexpr int WSCALE = FP8_WSCALE;
    int K, lda, ldb, G, c; const bf16_t *oab, *Wpab_t;
    __device__ __forceinline__ bool next(int i, Unit& u) const { const int L = (i >> 1) * G + c; if (L >= 256) return false; pg8::map_tile(L, 64, 4, u.pm, u.pn); u.aux = i & 1; return true; }
    __device__ __forceinline__ const char* a_base(const Unit& u) const { return (const char*)(oab + (size_t)u.pm * 256 * D + u.aux * 512); }
    __device__ __forceinline__ const char* b_base(const Unit& u) const { return (const char*)(Wpab_t + (size_t)u.pn * 256 * D + u.aux * 512); }
    __device__ __forceinline__ unsigned a_off(const Unit&, int row, int C) const { return (unsigned)(row * D + C) * 2u; }
};
struct EpiMix {
    static constexpr bool MID = false;
    const bf16_t* p; bf16_t* mix;
    __device__ __forceinline__ void operator()(const f32x4 (&acc)[2][2][4][2], const Unit& u, int wr, int wc, int fr, int fq) const {
        asm volatile("" : "+v"(fr), "+v"(fq));
        const int row0 = u.pm * 256 + wr * 64 + fr, col0 = u.pn * 256 + wc * 32 + 8 * fq, gc = u.aux ? PC_GB : PC_GA;
#pragma unroll
        for (int ai = 0; ai < 2; ++ai) {
            u32x4 gw[4][2], pw[4][2];
#pragma unroll
            for (int m = 0; m < 4; ++m)
#pragma unroll
                for (int bj = 0; bj < 2; ++bj) { const size_t row = (size_t)(row0 + ai * 128 + m * 16);
                    gw[m][bj] = *(const u32x4*)(p + row * PN + gc + col0 + bj * 128);
                    pw[m][bj] = u.aux ? *(const u32x4*)(mix + row * D + col0 + bj * 128) : (u32x4){0u, 0u, 0u, 0u}; }
#pragma unroll
            for (int m = 0; m < 4; ++m)
#pragma unroll
                for (int bj = 0; bj < 2; ++bj) { const size_t row = (size_t)(row0 + ai * 128 + m * 16); float g[8], pv[8], v[8]; unpack8(gw[m][bj], g); unpack8(pw[m][bj], pv);
#pragma unroll
                    for (int j = 0; j < 4; ++j) { v[j] = acc[ai][bj][m][0][j] * g[j] + pv[j]; v[4 + j] = acc[ai][bj][m][1][j] * g[4 + j] + pv[4 + j]; }
                    *(u32x4*)(mix + row * D + col0 + bj * 128) = pack8(v); } }
    }
};

struct EpiMix2 {
    static constexpr bool MID = true;
    const bf16_t* p; bf16_t* mix;
    __device__ __forceinline__ void mid(f32x4 (&acc)[2][2][4][2], const Unit& u, int wr, int wc, int fr, int fq) const {
        asm volatile("" : "+v"(fr), "+v"(fq));
        const int row0 = u.pm * 256 + wr * 64 + fr, col0 = u.pn * 256 + wc * 32 + 8 * fq;
#pragma unroll
        for (int ai = 0; ai < 2; ++ai) { u32x4 ga[4][2], gb[4][2];
#pragma unroll
            for (int m = 0; m < 4; ++m)
#pragma unroll
                for (int bj = 0; bj < 2; ++bj) { const size_t row = (size_t)(row0 + ai * 128 + m * 16); ga[m][bj] = *(const u32x4*)(p + row * PN + PC_GA + col0 + bj * 128); gb[m][bj] = *(const u32x4*)(p + row * PN + PC_GB + col0 + bj * 128); }
#pragma unroll
            for (int m = 0; m < 4; ++m)
#pragma unroll
                for (int bj = 0; bj < 2; ++bj) { float a[8], b[8]; unpack8(ga[m][bj], a); unpack8(gb[m][bj], b);
#pragma unroll
                    for (int j = 0; j < 4; ++j) { acc[ai][bj][m][0][j] *= a[j] * __builtin_amdgcn_rcpf(fmaxf(b[j], 1e-20f)); acc[ai][bj][m][1][j] *= a[4 + j] * __builtin_amdgcn_rcpf(fmaxf(b[4 + j], 1e-20f)); } } }
    }
    __device__ __forceinline__ void operator()(const f32x4 (&acc)[2][2][4][2], const Unit& u, int wr, int wc, int fr, int fq) const {
        asm volatile("" : "+v"(fr), "+v"(fq));
        const int row0 = u.pm * 256 + wr * 64 + fr, col0 = u.pn * 256 + wc * 32 + 8 * fq;
#pragma unroll
        for (int ai = 0; ai < 2; ++ai) { u32x4 gb[4][2];
#pragma unroll
            for (int m = 0; m < 4; ++m)
#pragma unroll
                for (int bj = 0; bj < 2; ++bj) gb[m][bj] = *(const u32x4*)(p + (size_t)(row0 + ai * 128 + m * 16) * PN + PC_GB + col0 + bj * 128);
#pragma unroll
            for (int m = 0; m < 4; ++m)
#pragma unroll
                for (int bj = 0; bj < 2; ++bj) { float b[8], v[8]; unpack8(gb[m][bj], b);
#pragma unroll
                    for (int j = 0; j < 4; ++j) { v[j] = acc[ai][bj][m][0][j] * fmaxf(b[j], 1e-20f); v[4 + j] = acc[ai][bj][m][1][j] * fmaxf(b[4 + j], 1e-20f); }
                    *(u32x4*)(mix + (size_t)(row0 + ai * 128 + m * 16) * D + col0 + bj * 128) = pack8(v); } }
    }
};

template <bool Q8 = false, int WS_ = FP8_WSCALE> struct ProbStdT {
    static constexpr bool GATHER = false, FP8 = Q8; static constexpr int WSCALE = WS_, EB = Q8 ? 1 : 2;
    int K, lda, ldb, G, c; const void *A, *Bt;
    __device__ __forceinline__ bool next(int i, Unit& u) const { const int L = i * G + c; if (L >= 256) return false; pg8::map_tile(L, 64, 4, u.pm, u.pn); u.aux = 0; return true; }
    __device__ __forceinline__ const char* a_base(const Unit& u) const { return (const char*)A + (size_t)u.pm * 256 * D * EB; }
    __device__ __forceinline__ const char* b_base(const Unit& u) const { return (const char*)Bt + (size_t)u.pn * 256 * D * EB; }
    __device__ __forceinline__ unsigned a_off(const Unit&, int row, int C) const { return (unsigned)(row * D * EB + C * 2); }
};
typedef ProbStdT<false> ProbStd;
template <bool RESF32> struct EpiRes {
    static constexpr bool MID = false;
    const void* res; bf16_t* outb; float* ssq; unsigned char* outq;
    __device__ __forceinline__ void operator()(const f32x4 (&acc)[2][2][4][2], const Unit& u, int wr, int wc, int fr, int fq) const {
        asm volatile("" : "+v"(fr), "+v"(fq));
        const int row0 = u.pm * 256 + wr * 64 + fr, col0 = u.pn * 256 + wc * 32 + 8 * fq;
#pragma unroll
        for (int ai = 0; ai < 2; ++ai) {
            f32x4 rf[4][2][2]; u32x4 rb[4][2];
#pragma unroll
            for (int m = 0; m < 4; ++m)
#pragma unroll
                for (int bj = 0; bj < 2; ++bj) { const size_t off = (size_t)(row0 + ai * 128 + m * 16) * D + col0 + bj * 128;
                    if (RESF32) { rf[m][bj][0] = *(const f32x4*)((const float*)res + off); rf[m][bj][1] = *(const f32x4*)((const float*)res + off + 4); }
                    else rb[m][bj] = *(const u32x4*)((const bf16_t*)res + off); }
#pragma unroll
            for (int m = 0; m < 4; ++m) { const size_t row = (size_t)(row0 + ai * 128 + m * 16); float sq = 0.f;
#pragma unroll
                for (int bj = 0; bj < 2; ++bj) { float r[8], v[8];
                    if (RESF32) { r[0] = rf[m][bj][0].x; r[1] = rf[m][bj][0].y; r[2] = rf[m][bj][0].z; r[3] = rf[m][bj][0].w; r[4] = rf[m][bj][1].x; r[5] = rf[m][bj][1].y; r[6] = rf[m][bj][1].z; r[7] = rf[m][bj][1].w; }
                    else unpack8(rb[m][bj], r);
#pragma unroll
                    for (int j = 0; j < 4; ++j) { v[j] = acc[ai][bj][m][0][j] + r[j]; v[4 + j] = acc[ai][bj][m][1][j] + r[4 + j]; }
#pragma unroll
                    for (int j = 0; j < 8; ++j) sq += v[j] * v[j];
                    *(u32x4*)(outb + row * D + col0 + bj * 128) = pack8(v);
                    *(u32x2*)(outq + row * D + col0 + bj * 128) = pack8_fp8(v); }
                sq += __shfl_xor(sq, 16); sq += __shfl_xor(sq, 32);
                if (fq == 0) ssq[row * 16 + u.pn * 4 + wc] = sq; } }
    }
};
__device__ __forceinline__ float row_rs(const float* ssq, size_t row) {
    const f32x4 a = *(const f32x4*)(ssq + row * 16), b = *(const f32x4*)(ssq + row * 16 + 4), c = *(const f32x4*)(ssq + row * 16 + 8), d = *(const f32x4*)(ssq + row * 16 + 12);
    const float s = ((a.x + a.y) + (a.z + a.w)) + ((b.x + b.y) + (b.z + b.w)) + ((c.x + c.y) + (c.z + c.w)) + ((d.x + d.y) + (d.z + d.w));
    return rsqrtf(s * (1.f / D) + EPS);
}
struct EpiScale {
    static constexpr bool MID = false;
    const float* ssq; bf16_t* outb;
    __device__ __forceinline__ void operator()(const f32x4 (&acc)[2][2][4][2], const Unit& u, int wr, int wc, int fr, int fq) const {
        asm volatile("" : "+v"(fr), "+v"(fq));
        const int row0 = u.pm * 256 + wr * 64 + fr, col0 = u.pn * 256 + wc * 32 + 8 * fq;
        float rs[2][4];
#pragma unroll
        for (int ai = 0; ai < 2; ++ai)
#pragma unroll
            for (int m = 0; m < 4; ++m) rs[ai][m] = row_rs(ssq, (size_t)(row0 + ai * 128 + m * 16));
#pragma unroll
        for (int ai = 0; ai < 2; ++ai)
#pragma unroll
            for (int m = 0; m < 4; ++m) { const size_t row = (size_t)(row0 + ai * 128 + m * 16);
#pragma unroll
                for (int bj = 0; bj < 2; ++bj) { float v[8];
#pragma unroll
                    for (int j = 0; j < 4; ++j) { v[j] = acc[ai][bj][m][0][j] * rs[ai][m]; v[4 + j] = acc[ai][bj][m][1][j] * rs[ai][m]; }
                    *(u32x4*)(outb + row * D + col0 + bj * 128) = pack8(v); } }
    }
};

__device__ __forceinline__ void attn_unit(Frame& F, int unit) {
    const int tid = F.tid, w = F.wave, lane = F.lane, fr = lane & 15, fq = lane >> 4;
    const int b = unit >> 5, h = (unit >> 3) & 3, qb = unit & 7;
    const size_t tq = (size_t)b * SEQ + qb * 256 + 32 * w;
    LAS unsigned char* const bufs[2] = {F.lds, F.lds + 36864};
    const bf16_t* kg = F.kmem() + (size_t)(b * 256 + (tid >> 1)) * D + h * 256 + (tid & 1) * 32;
    const int kls = (tid >> 1) * 144 + (tid & 1) * 64;
    const bf16_t* vg = F.vt() + (size_t)(h * 256 + (tid >> 3)) * TM + b * 256 + (tid & 7) * 32;
    const int vls = (tid >> 3) * 528 + (tid & 7) * 64;
    u32x4 st[4];
#pragma unroll
    for (int i = 0; i < 4; ++i) st[i] = *(const u32x4*)(kg + 8 * i);
#pragma unroll
    for (int i = 0; i < 4; ++i) *(LAS u32x4*)(bufs[0] + kls + 16 * i) = st[i];
    __syncthreads();
    f32x4 s[16][2];
#pragma unroll
    for (int nt = 0; nt < 16; ++nt) { s[nt][0] = (f32x4){0.f, 0.f, 0.f, 0.f}; s[nt][1] = (f32x4){0.f, 0.f, 0.f, 0.f}; }
#pragma unroll
    for (int c = 0; c < 4; ++c) {
        if (c < 3) {
#pragma unroll
            for (int i = 0; i < 4; ++i) st[i] = *(const u32x4*)(kg + 64 * (c + 1) + 8 * i); }
        else {
#pragma unroll
            for (int i = 0; i < 4; ++i) st[i] = *(const u32x4*)(vg + 8 * i); }
        LAS unsigned char* kb = bufs[c & 1];
        bf16x8 qf[2][2];
#pragma unroll
        for (int qt = 0; qt < 2; ++qt)
#pragma unroll
            for (int ks = 0; ks < 2; ++ks) qf[qt][ks] = *(const bf16x8*)(F.q() + (tq + 16 * qt + fr) * D + h * 256 + 64 * c + 32 * ks + 8 * fq);
#pragma unroll
        for (int nt = 0; nt < 16; ++nt)
#pragma unroll
            for (int ks = 0; ks < 2; ++ks) { const bf16x8 a = *(const LAS bf16x8*)(kb + (16 * nt + fr) * 144 + (32 * ks + 8 * fq) * 2);
                s[nt][0] = mma16(a, qf[0][ks], s[nt][0]); s[nt][1] = mma16(a, qf[1][ks], s[nt][1]); }
        if (c < 3) {
#pragma unroll
            for (int i = 0; i < 4; ++i) *(LAS u32x4*)(bufs[(c + 1) & 1] + kls + 16 * i) = st[i]; }
        __syncthreads();
    }
#pragma unroll
    for (int i = 0; i < 4; ++i) *(LAS u32x4*)(bufs[0] + vls + 16 * i) = st[i];
    float inv[2]; bf16x8 pb[2][8];
#pragma unroll
    for (int qt = 0; qt < 2; ++qt) { float mx = s[0][qt][0];
#pragma unroll
        for (int nt = 0; nt < 16; ++nt)
#pragma unroll
            for (int r = 0; r < 4; ++r) mx = fmaxf(mx, s[nt][qt][r]);
        mx = fmaxf(mx, __shfl_xor(mx, 16)); mx = fmaxf(mx, __shfl_xor(mx, 32));
        float sum = 0.f;
#pragma unroll
        for (int nt = 0; nt < 16; ++nt)
#pragma unroll
            for (int r = 0; r < 4; ++r) { const float e = __expf(s[nt][qt][r] - mx); s[nt][qt][r] = e; sum += e; }
        sum += __shfl_xor(sum, 16); sum += __shfl_xor(sum, 32);
        inv[qt] = __builtin_amdgcn_rcpf(sum);
#pragma unroll
        for (int sk = 0; sk < 8; ++sk) { const float pv[8] = {s[2 * sk][qt][0], s[2 * sk][qt][1], s[2 * sk][qt][2], s[2 * sk][qt][3], s[2 * sk + 1][qt][0], s[2 * sk + 1][qt][1], s[2 * sk + 1][qt][2], s[2 * sk + 1][qt][3]};
            const u32x4 pk = pack8(pv); pb[qt][sk] = __builtin_bit_cast(bf16x8, pk); } }
    __syncthreads();
#pragma unroll
    for (int c = 0; c < 4; ++c) {
        if (c < 3) {
#pragma unroll
            for (int i = 0; i < 4; ++i) st[i] = *(const u32x4*)(vg + (size_t)64 * (c + 1) * TM + 8 * i); }
        LAS unsigned char* vb = bufs[c & 1];
#pragma unroll
        for (int dt = 0; dt < 4; ++dt) { f32x4 o0 = {0.f, 0.f, 0.f, 0.f}, o1 = {0.f, 0.f, 0.f, 0.f};
#pragma unroll
            for (int sk = 0; sk < 8; ++sk) { const LAS unsigned char* vp = vb + (16 * dt + fr) * 528 + (32 * sk + 4 * fq) * 2;
                const u32x2 lo = *(const LAS u32x2*)vp, hi = *(const LAS u32x2*)(vp + 32);
                const u32x4 av = {lo.x, lo.y, hi.x, hi.y}; const bf16x8 a = __builtin_bit_cast(bf16x8, av);
                o0 = mma16(a, pb[0][sk], o0); o1 = mma16(a, pb[1][sk], o1); }
            const int col = h * 256 + 64 * c + 16 * dt + 4 * fq;
            int w0 = 0, w1 = 0;
            w0 = __builtin_amdgcn_cvt_pk_fp8_f32(o0[0] * inv[0], o0[1] * inv[0], w0, false); w0 = __builtin_amdgcn_cvt_pk_fp8_f32(o0[2] * inv[0], o0[3] * inv[0], w0, true);
            w1 = __builtin_amdgcn_cvt_pk_fp8_f32(o1[0] * inv[1], o1[1] * inv[1], w1, false); w1 = __builtin_amdgcn_cvt_pk_fp8_f32(o1[2] * inv[1], o1[3] * inv[1], w1, true);
            *(int*)((unsigned char*)F.ao() + (tq + fr) * D + col) = w0; *(int*)((unsigned char*)F.ao() + (tq + 16 + fr) * D + col) = w1; }
        if (c < 3) {
#pragma unroll
            for (int i = 0; i < 4; ++i) *(LAS u32x4*)(bufs[(c + 1) & 1] + vls + 16 * i) = st[i]; }
        __syncthreads();
    }
}

__device__ __forceinline__ void router_item(Frame& F, int item) {
    const int w = F.wave, lane = F.lane, fr = lane & 15, fq = lane >> 4;
    const size_t t0 = (size_t)item * 16;
    LAS float* lg = (LAS float*)F.lds + w * (16 * 33 + 64);
    LAS int* ex = (LAS int*)(lg + 16 * 33);
    f32x4 acc[2] = {{0.f, 0.f, 0.f, 0.f}, {0.f, 0.f, 0.f, 0.f}};
    for (int k0 = 0; k0 < 32; k0 += 8) { bf16x8 a[8], b0[8], b1[8];
#pragma unroll
        for (int i = 0; i < 8; ++i) { a[i] = *(const bf16x8*)(F.x2b() + (t0 + fr) * D + 32 * (k0 + i) + 8 * fq);
            b0[i] = *(const bf16x8*)(F.Wr_t() + (size_t)fr * D + 32 * (k0 + i) + 8 * fq); b1[i] = *(const bf16x8*)(F.Wr_t() + (size_t)(16 + fr) * D + 32 * (k0 + i) + 8 * fq); }
#pragma unroll
        for (int i = 0; i < 8; ++i) { acc[0] = mma16(a[i], b0[i], acc[0]); acc[1] = mma16(a[i], b1[i], acc[1]); } }
#pragma unroll
    for (int r = 0; r < 4; ++r)
#pragma unroll
        for (int nt = 0; nt < 2; ++nt) lg[(4 * fq + r) * 33 + 16 * nt + fr] = acc[nt][r];
    LDS_WAIT();
    float rs = 0.f, gk[4] = {0.f, 0.f, 0.f, 0.f};
    if (lane < 16) { const size_t t = t0 + lane; rs = row_rs(F.ssq2(), t);
        float v[32];
#pragma unroll
        for (int e = 0; e < 32; ++e) v[e] = lg[lane * 33 + e] * rs + F.A->in[I_BR][e];
        unsigned taken = 0u; float tv[4];
#pragma unroll
        for (int k = 0; k < 4; ++k) { float best = -INFINITY; int bi = 0;
#pragma unroll
            for (int e = 0; e < 32; ++e) { const bool ok = !((taken >> e) & 1u) && (v[e] > best); best = ok ? v[e] : best; bi = ok ? e : bi; }
            taken |= 1u << bi; tv[k] = best; ex[lane * 4 + k] = bi; }
        float sum = 0.f;
#pragma unroll
        for (int k = 0; k < 4; ++k) { gk[k] = __expf(tv[k] - tv[0]); sum += gk[k]; }
        const float inv = 1.f / sum;
        *(f32x4*)(F.gates() + t * 4) = (f32x4){gk[0] * inv, gk[1] * inv, gk[2] * inv, gk[3] * inv}; }
    LDS_WAIT();
    const int me = ex[lane]; const float my_rs = __shfl(rs, lane >> 2);
    int rank = 0, mytot = 0;
#pragma unroll
    for (int e = 0; e < 32; ++e) { const unsigned long long m = __ballot(me == e); const int below = __builtin_popcountll(m & ((1ull << lane) - 1ull));
        rank = (me == e) ? below : rank; mytot = (lane == e) ? __builtin_popcountll(m) : mytot; }
    unsigned base = 0u;
    if (lane < 32 && mytot > 0) base = atomicAdd(F.ctl + CW_CNT + lane, (unsigned)mytot);
    const unsigned slot = (unsigned)__shfl((int)base, me) + (unsigned)rank;
    F.list()[me * ECAP + slot] = (int)(t0 * 4 + lane); F.lscale()[me * ECAP + slot] = my_rs;
    LDS_WAIT();
}

__device__ __forceinline__ void expert_tables(Frame& F) {
    LAS int* tab = (LAS int*)(F.lds + TAB_OFF);
    if (F.tid < 32) tab[F.tid] = (int)__hip_atomic_load(F.ctl + CW_CNT + F.tid, __ATOMIC_RELAXED, __HIP_MEMORY_SCOPE_AGENT);
    __syncthreads();
    if (F.tid == 0) { int s = 0; for (int e = 0; e < 32; ++e) { tab[32 + e] = s; s += (tab[e] + 255) >> 8; } tab[64] = s; }
    __syncthreads();
}
template <int NTN, bool GATH> struct ProbExp {
    static constexpr bool GATHER = GATH, gather = GATH, FP8 = true; static constexpr int WSCALE = FP8_WSCALE;
    int K, lda, ldb, G, c; const LAS int* tab; const unsigned char* A; const unsigned char* Bt; const int* list; mutable int ehint;
    __device__ __forceinline__ bool next(int i, Unit& u) const {
        const int L = i * G + c; if (L >= NTN * tab[64]) return false;
        int e = ehint;
#pragma unroll 1
        while (e < 31 && L >= NTN * tab[32 + e + 1]) ++e;
        ehint = e;
        const int r = L - NTN * tab[32 + e], mte = tab[32 + e + 1] - tab[32 + e];
        u.aux = e; u.pn = r / mte; u.pm = r % mte; return true;
    }
    __device__ __forceinline__ const char* a_base(const Unit& u) const { return gather ? (const char*)A : (const char*)(A + (size_t)(tab[32 + u.aux] + u.pm) * 256 * D); }
    __device__ __forceinline__ const char* b_base(const Unit& u) const { return (const char*)(Bt + ((size_t)u.aux * NTN + u.pn) * 256 * D); }
    __device__ __forceinline__ unsigned a_off(const Unit& u, int row, int C) const {
        if (!gather) return (unsigned)(row * D + C * 2);
        const int slot = u.pm * 256 + row; const int av = list[u.aux * ECAP + slot];
        const int a = slot < tab[u.aux] ? av : 0;
        return (unsigned)((a >> 2) * D + C * 2);
    }
};
struct EpiE1 {
    static constexpr bool MID = false;
    const LAS int* tab; const float* lscale; const float* b1; unsigned char* act;
    __device__ __forceinline__ void operator()(const f32x4 (&acc)[2][2][4][2], const Unit& u, int wr, int wc, int fr, int fq) const {
        asm volatile("" : "+v"(fr), "+v"(fq));
        const int e = u.aux; const size_t rbase = (size_t)(tab[32 + e] + u.pm) * 256;
        const int j0 = u.pn * 128 + wc * 32 + 8 * fq;
        const float* bp = b1 + (size_t)e * 2048 + j0;
        const f32x4 bg0 = *(const f32x4*)bp, bg1 = *(const f32x4*)(bp + 4), bl0 = *(const f32x4*)(bp + 1024), bl1 = *(const f32x4*)(bp + 1028);
        const float bg[8] = {bg0.x, bg0.y, bg0.z, bg0.w, bg1.x, bg1.y, bg1.z, bg1.w}, bl[8] = {bl0.x, bl0.y, bl0.z, bl0.w, bl1.x, bl1.y, bl1.z, bl1.w};
        float sc[2][4];
#pragma unroll
        for (int ai = 0; ai < 2; ++ai)
#pragma unroll
            for (int m = 0; m < 4; ++m) sc[ai][m] = lscale[e * ECAP + u.pm * 256 + ai * 128 + wr * 64 + m * 16 + fr];
#pragma unroll
        for (int ai = 0; ai < 2; ++ai)
#pragma unroll
            for (int m = 0; m < 4; ++m) { const int rt = ai * 128 + wr * 64 + m * 16 + fr; float v[8];
                const f32x2 s2 = {sc[ai][m], sc[ai][m]};
#pragma unroll
                for (int jp = 0; jp < 4; ++jp) {
                    const f32x2 ag = {acc[ai][0][m][jp >> 1][2 * (jp & 1)], acc[ai][0][m][jp >> 1][2 * (jp & 1) + 1]}, al = {acc[ai][1][m][jp >> 1][2 * (jp & 1)], acc[ai][1][m][jp >> 1][2 * (jp & 1) + 1]};
                    const f32x2 bg2 = {bg[2 * jp], bg[2 * jp + 1]}, bl2 = {bl[2 * jp], bl[2 * jp + 1]};
                    const f32x2 ga = ag * s2 + bg2, la = al * s2 + bl2;
                    const f32x2 glu = {fminf(ga.x, 7.0f), fminf(ga.y, 7.0f)}, lin = {fminf(fmaxf(la.x, -7.0f), 7.0f), fminf(fmaxf(la.y, -7.0f), 7.0f)};
                    const f32x2 t = glu * (-1.702f * 1.4426950408889634f);
                    const f32x2 d = (f32x2){__builtin_amdgcn_exp2f(t.x), __builtin_amdgcn_exp2f(t.y)} + 1.0f;
                    const f32x2 r = {__builtin_amdgcn_rcpf(d.x), __builtin_amdgcn_rcpf(d.y)};
                    const f32x2 o = ((lin + 1.0f) * glu) * r;
                    v[2 * jp] = o.x; v[2 * jp + 1] = o.y; }
                *(u32x2*)(act + (rbase + rt) * D + j0) = pack8_fp8(v); }
    }
};
struct EpiE2 {
    static constexpr bool MID = false;
    const LAS int* tab; const int* list; const float* b2; unsigned char* yb; unsigned char* dummy;
    __device__ __forceinline__ void operator()(const f32x4 (&acc)[2][2][4][2], const Unit& u, int wr, int wc, int fr, int fq) const {
        asm volatile("" : "+v"(fr), "+v"(fq));
        const int e = u.aux, cnt = tab[e]; const int col0 = u.pn * 256 + wc * 32 + 8 * fq;
        float bb[2][8];
#pragma unroll
        for (int bj = 0; bj < 2; ++bj) { const f32x4 x0 = *(const f32x4*)(b2 + (size_t)e * D + col0 + bj * 128), x1 = *(const f32x4*)(b2 + (size_t)e * D + col0 + bj * 128 + 4);
            bb[bj][0] = x0.x; bb[bj][1] = x0.y; bb[bj][2] = x0.z; bb[bj][3] = x0.w; bb[bj][4] = x1.x; bb[bj][5] = x1.y; bb[bj][6] = x1.z; bb[bj][7] = x1.w; }
        int aidx[2][4];
#pragma unroll
        for (int ai = 0; ai < 2; ++ai)
#pragma unroll
            for (int m = 0; m < 4; ++m) aidx[ai][m] = list[e * ECAP + u.pm * 256 + ai * 128 + wr * 64 + m * 16 + fr];
#pragma unroll
        for (int ai = 0; ai < 2; ++ai)
#pragma unroll
            for (int m = 0; m < 4; ++m) { const int slot = u.pm * 256 + ai * 128 + wr * 64 + m * 16 + fr;
                unsigned char* rowp = (slot < cnt) ? yb + (size_t)aidx[ai][m] * D : dummy;
#pragma unroll
                for (int bj = 0; bj < 2; ++bj) { float v[8];
#pragma unroll
                    for (int j = 0; j < 4; ++j) { v[j] = acc[ai][bj][m][0][j] + bb[bj][j]; v[4 + j] = acc[ai][bj][m][1][j] + bb[bj][4 + j]; }
                    *(u32x2*)(rowp + col0 + bj * 128) = pack8_fp8(v); } }
    }
};

struct CombTok { u32x4 x[2]; u32x2 y[2][4]; f32x4 g; };
__device__ __forceinline__ void comb_load(Frame& F, int t, int lane, CombTok& c) {
    c.g = *(const f32x4*)(F.gates() + (size_t)t * 4);
#pragma unroll
    for (int hf = 0; hf < 2; ++hf) { const int col = hf * 512 + lane * 8; c.x[hf] = *(const u32x4*)(F.x2b() + (size_t)t * D + col);
#pragma unroll
        for (int k = 0; k < 4; ++k) c.y[hf][k] = *(const u32x2*)((const unsigned char*)F.yb() + ((size_t)t * 4 + k) * D + col); }
}
__device__ __forceinline__ void comb_finish(Frame& F, int t, int lane, const CombTok& c) {
    const float gk[4] = {c.g.x, c.g.y, c.g.z, c.g.w}; float x[2][8]; float ss = 0.f;
#pragma unroll
    for (int hf = 0; hf < 2; ++hf) { unpack8(c.x[hf], x[hf]);
#pragma unroll
        for (int k = 0; k < 4; ++k) { float y[8]; unpack8_fp8(c.y[hf][k], y);
#pragma unroll
            for (int j = 0; j < 8; ++j) x[hf][j] += gk[k] * y[j]; }
#pragma unroll
        for (int j = 0; j < 8; ++j) ss += x[hf][j] * x[hf][j]; }
    const float rs = rsqrtf(wave_sum(ss) * (1.f / D) + EPS);
#pragma unroll
    for (int hf = 0; hf < 2; ++hf) { const int col = hf * 512 + lane * 8; const f32x4 g0 = *(const f32x4*)(F.A->in[I_NFING] + col), g1 = *(const f32x4*)(F.A->in[I_NFING] + col + 4);
        *(f32x4*)(F.A->out + (size_t)t * D + col) = (f32x4){x[hf][0] * rs * g0.x, x[hf][1] * rs * g0.y, x[hf][2] * rs * g0.z, x[hf][3] * rs * g0.w};
        *(f32x4*)(F.A->out + (size_t)t * D + col + 4) = (f32x4){x[hf][4] * rs * g1.x, x[hf][5] * rs * g1.y, x[hf][6] * rs * g1.z, x[hf][7] * rs * g1.w}; }
}
__device__ __forceinline__ void combine_rows(Frame& F) {
    const int gw = F.vcu * 8 + F.wave, NGW = F.G * 8, lane = F.lane;
    if (gw >= T) return;
    CombTok ca, cb; comb_load(F, gw, lane, ca);
    for (int t = gw;;) {
        const bool hb = t + NGW < T; if (hb) comb_load(F, t + NGW, lane, cb);
        comb_finish(F, t, lane, ca); if (!hb) break;
        const bool ha = t + 2 * NGW < T; if (ha) comb_load(F, t + 2 * NGW, lane, ca);
        comb_finish(F, t + NGW, lane, cb); if (!ha) break;
        t += 2 * NGW; }
}

#ifndef DBG_OUT
#define DBG_OUT 0
#endif
#if DBG_OUT
__device__ __forceinline__ void dbg_rows(Frame& F) {
    const int gw = F.vcu * 8 + F.wave, NGW = F.G * 8, lane = F.lane;
    for (int t = gw; t < T; t += NGW) {
#pragma unroll
        for (int hf = 0; hf < 2; ++hf) { const int col = hf * 512 + lane * 8; float x[8];
#pragma unroll
            for (int j = 0; j < 8; ++j) x[j] = 0.f;
            if (DBG_OUT == 1) { for (int m = 0; m < 5; ++m) { if (col + 1024 * m < PN) { float y[8]; unpack8(*(const u32x4*)(F.p() + (size_t)t * PN + col + 1024 * m), y);
#pragma unroll
                for (int j = 0; j < 8; ++j) x[j] += y[j]; } } }
            else if (DBG_OUT == 8) { for (int k = 0; k < 4; ++k) { float y[8]; unpack8_fp8(*(const u32x2*)((const unsigned char*)F.yb() + ((size_t)t * 4 + k) * D + col), y); const float g = F.gates()[t * 4 + k];
#pragma unroll
                for (int j = 0; j < 8; ++j) x[j] += g * y[j]; } }
            else { const bf16_t* B = DBG_OUT == 2 ? F.oab() : DBG_OUT == 3 ? F.mix() : DBG_OUT == 4 ? F.x1b() : DBG_OUT == 5 ? F.q() : DBG_OUT == 6 ? F.ao() : F.x2b();
                unpack8(*(const u32x4*)(B + (size_t)t * D + col), x); }
#pragma unroll
            for (int j = 0; j < 8; ++j) if (!(fabsf(x[j]) < 1e30f)) x[j] = 1e6f;
            *(f32x4*)(F.A->out + (size_t)t * D + col) = (f32x4){x[0], x[1], x[2], x[3]};
            *(f32x4*)(F.A->out + (size_t)t * D + col + 4) = (f32x4){x[4], x[5], x[6], x[7]}; }
    }
}
#endif

__global__ void __launch_bounds__(512, 2) fwd_kernel(Args args) {
    extern __shared__ __attribute__((aligned(16))) unsigned char lds[];
    Frame F;
    F.lds = (LAS unsigned char*)lds; F.MISC = (volatile LAS unsigned*)(F.lds + MISC_OFF);
    F.tid = threadIdx.x; F.lane = F.tid & 63; F.wave = __builtin_amdgcn_readfirstlane(F.tid >> 6);
    F.G = gridDim.x; { const int bx = blockIdx.x; F.vcu = (F.G % 8 == 0) ? (bx % 8) * (F.G / 8) + bx / 8 : bx; }
    F.ctl = (unsigned*)(args.ws + WS_CTL);
    F.A = &args;
    for (int u = F.tid; u < 64; u += 512) ((LAS unsigned*)(F.lds + MISC_OFF))[u] = 0u;
    __syncthreads();
    XcdBarrier bar; bar.bar = F.ctl + CW_BAR; bar.x = 0; bar.st = nullptr;
    if (!MK_PER_PHASE) bar = xcd_barrier_post(F.ctl + CW_BAR, F.MISC + 8);
    const int lo = args.ph_lo, hi = args.ph_hi;
#ifndef PH_MASK
#define PH_MASK 0x3fff
#endif
#define IN(k) (((PH_MASK >> (k)) & 1) && lo <= (k) && (k) < hi)
#ifndef DOUBLE_MASK
#define DOUBLE_MASK 0
#endif
#define REP(k) for (int _rep = 0; _rep < ((((DOUBLE_MASK) >> (k)) & 1) ? 2 : 1); ++_rep, ((((DOUBLE_MASK) >> (k)) & 1) && _rep == 1 ? xcd_barrier(bar) : (void)0))
#define SEAM(k) do { if (IN(k) && IN((k) + 1)) xcd_barrier(bar); } while (0)
    const int c = (int)blockIdx.x;

    if (IN(0)) REP(0) { p0_prologue(F); } SEAM(0);
    if (IN(1)) REP(1) { ProbP1 P{D, D, ProbP1::EB * D, F.G, c, args.ws}; EpiP1 E{args.ws}; pg8::gemm_phase(F.lds, P, E); } SEAM(1);
    if (IN(2)) REP(2) { for (int u = F.vcu; u < 1024; u += F.G) gla_a_unit(F, u); } SEAM(2);
    if (IN(3)) REP(3) { cvt_range(F, CVT_LATE, CVT_EXPERT);
                        if (F.wave < 4) for (int it = F.vcu * 4 + F.wave; it < 1024; it += F.G * 4) gla_sscan_item(F, it);
                        for (int u = F.vcu; u < 512; u += F.G) sgu_unit(F, u); } SEAM(3);
    if (IN(4)) REP(4) { for (int it = F.vcu * 8 + F.wave; it < 4096; it += F.G * 8) gla_out_item(F, it); } SEAM(4);
    if (IN(5)) REP(5) { ProbStd P{D, D, 2 * D, F.G, c, F.oab(), F.Wpab_t()}; EpiMix2 E{F.p(), F.mix()}; pg8::gemm_phase(F.lds, P, E); } SEAM(5);
    if (IN(6)) REP(6) { ProbStd P{D, D, 2 * D, F.G, c, F.mix(), F.Wmo_t()}; EpiRes<true> E{(const void*)F.A->in[I_X], F.x1b(), F.ssq1(), F.x1q()}; pg8::gemm_phase(F.lds, P, E); } SEAM(6);
    if (IN(7)) REP(7) { ProbStdT<true, 0x75757575> P{D, D, D, F.G, c, F.x1q(), F.Wq_t()}; EpiScale E{F.ssq1(), F.q()};     pg8::gemm_phase(F.lds, P, E); } SEAM(7);
    if (IN(8)) REP(8) { for (int u = F.vcu; u < 256; u += F.G) attn_unit(F, u); } SEAM(8);
    if (IN(9)) REP(9) { ProbStdT<true> P{D, D, D, F.G, c, F.ao(), F.Wo_t()}; EpiRes<false> E{(const void*)F.x1b(), F.x2b(), F.ssq2(), F.x2q()}; pg8::gemm_phase(F.lds, P, E); } SEAM(9);
    if (IN(10)) REP(10) { for (int it = F.wave * F.G + F.vcu; it < 1024; it += 8 * F.G) router_item(F, it); cvt_range(F, CVT_EXPERT, CVT_END); } SEAM(10);
    if (IN(11)) REP(11) { expert_tables(F); const LAS int* tab = (const LAS int*)(F.lds + TAB_OFF);
        ProbExp<8, true> P{D, D, D, F.G, F.vcu, tab, F.x2q(), (const unsigned char*)F.W1_t(), F.list(), 0}; EpiE1 E{tab, F.lscale(), F.A->in[I_BE1], (unsigned char*)F.act()}; pg8::gemm_phase(F.lds, P, E); } SEAM(11);
    if (IN(12)) REP(12) { expert_tables(F); const LAS int* tab = (const LAS int*)(F.lds + TAB_OFF);
        ProbExp<4, false> P{D, D, D, F.G, F.vcu, tab, (const unsigned char*)F.act(), (const unsigned char*)F.W2_t(), F.list(), 0}; EpiE2 E{tab, F.list(), F.A->in[I_BE2], (unsigned char*)F.yb(), (unsigned char*)(args.ws + WS_CTL + 512 * 1024)}; pg8::gemm_phase(F.lds, P, E); } SEAM(12);
#if DBG_OUT
    if (lo <= 13 && 13 < hi) { dbg_rows(F); }
#else
    if (IN(13)) REP(13) { combine_rows(F); }
#endif
#undef IN
#undef SEAM
}

extern "C" void kernel_launch(void* const* d_in, const int* in_sizes, int n_in, void* d_out, int out_size, void* d_ws, size_t ws_size, hipStream_t stream) {
    static int grid = 0;
    if (grid == 0) {
        if (n_in != 28 || in_sizes[0] != T * D || out_size != T * D || ws_size < WS_END) { fprintf(stderr, "kernel_launch: unexpected problem (n_in %d, in0 %d, out %d, ws %zu); nothing launched\n", n_in, n_in > 0 ? in_sizes[0] : -1, out_size, ws_size); grid = -1; return; }
        int dev = 0, cus = 0, per_cu = 0;
        if (hipGetDevice(&dev) != hipSuccess || hipDeviceGetAttribute(&cus, hipDeviceAttributeMultiprocessorCount, dev) != hipSuccess) { grid = -1; return; }
        if (hipFuncSetAttribute((const void*)fwd_kernel, hipFuncAttributeMaxDynamicSharedMemorySize, LDS_BYTES) != hipSuccess) { fprintf(stderr, "kernel_launch: hipFuncSetAttribute failed\n"); grid = -1; return; }
        if (hipOccupancyMaxActiveBlocksPerMultiprocessor(&per_cu, (const void*)fwd_kernel, 512, LDS_BYTES) != hipSuccess || per_cu < 1) fprintf(stderr, "kernel_launch: occupancy query reports %d blocks per CU\n", per_cu);
        (void)hipGetLastError();
        grid = cus;
    }
    if (grid < 0) return;
    if (hipMemsetAsync((char*)d_ws + WS_CTL, 0, CTL_ZERO_BYTES, stream) != hipSuccess) { fprintf(stderr, "kernel_launch: memset failed\n"); return; }
    Args a{};
    for (int i = 0; i < 28; ++i) a.in[i] = (const float*)d_in[i];
    a.out = (float*)d_out; a.ws = (unsigned char*)d_ws;
#if MK_PER_PHASE
    for (int ph = 0; ph < NPHASE; ++ph) { a.ph_lo = ph; a.ph_hi = ph + 1; hipLaunchKernelGGL(fwd_kernel, dim3(grid), dim3(512), LDS_BYTES, stream, a); }
#else
    a.ph_lo = 0; a.ph_hi = NPHASE;
    hipLaunchKernelGGL(fwd_kernel, dim3(grid), dim3(512), LDS_BYTES, stream, a);
#endif
}
```

```cpp
#include <hip/hip_runtime.h>
#include <cstdio>
#include <cstdint>

#ifndef P1_FP8
#define P1_FP8 0
#endif
#ifndef MK_PER_PHASE
#define MK_PER_PHASE 0
#endif

#define LAS __attribute__((address_space(3)))
#define GAS __attribute__((address_space(1)))
typedef unsigned short bf16_t;
typedef short bf16x8 __attribute__((ext_vector_type(8)));
typedef float f32x4 __attribute__((ext_vector_type(4)));
typedef float f32x2 __attribute__((ext_vector_type(2)));
typedef unsigned u32x4 __attribute__((ext_vector_type(4)));
typedef unsigned u32x2 __attribute__((ext_vector_type(2)));
typedef int i32x4 __attribute__((ext_vector_type(4)));
typedef int i32x8 __attribute__((ext_vector_type(8)));
#define FP8_WSCALE 0x79797979
constexpr float FP8_WMUL = 64.0f;
typedef GAS unsigned gu32;

constexpr int T = 16384, D = 1024, NBATCH = 8, SEQ = 2048, MEMLEN = 256, TM = NBATCH * MEMLEN;
constexpr int INC = 4624;
constexpr int PN = 4864;
constexpr int PC_Q = 0, PC_K = 256, PC_V = 512, PC_R = 1024, PC_U = 1536, PC_SV = 2048, PC_GA = 2560, PC_GB = 3584, PC_A = 4608;
constexpr int OFF_A = 1536;
constexpr int NE = 32, NASG = T * 4, ECAP = 16384;
constexpr float EPS = 1e-5f;
constexpr int NPHASE = 14;

constexpr size_t MiB = 1u << 20;
constexpr size_t WS_CTL = 0, CTL_ZERO_BYTES = 1 * MiB;
constexpr size_t WS_WR = 1 * MiB, WS_SGUW = 1 * MiB + 256 * 1024, WS_DECAY = 1 * MiB + 512 * 1024;
constexpr size_t WS_WIN = 2 * MiB, WS_WK = 12 * MiB, WS_WV = 14 * MiB, WS_WPAB = 16 * MiB, WS_WMO = 18 * MiB, WS_WQ = 20 * MiB, WS_WO = 22 * MiB;
constexpr size_t WS_SSQ1 = 24 * MiB, WS_SSQ2 = 25 * MiB, WS_LIST = 26 * MiB, WS_LSCALE = 28 * MiB, WS_GATES = 30 * MiB;
constexpr size_t WS_W1 = 32 * MiB, WS_W2 = 160 * MiB, WS_H = 224 * MiB, WS_MEMN = 256 * MiB, WS_KMEM = 260 * MiB, WS_VT = 264 * MiB, WS_QIN = 268 * MiB;
constexpr size_t WS_OINTRA = 276 * MiB, WS_KVT = 308 * MiB, WS_OAB = 340 * MiB, WS_MIX = 372 * MiB, WS_X1B = 404 * MiB, WS_Q = 436 * MiB, WS_AO = 468 * MiB, WS_X2B = 500 * MiB;
constexpr size_t WS_P = 532 * MiB, WS_ACT = 684 * MiB, WS_YB = 828 * MiB, WS_SPT = 956 * MiB, WS_X2Q = 972 * MiB, WS_X1Q = 988 * MiB, WS_SVS = 1004 * MiB, WS_END = 1005 * MiB;
static_assert(WS_P + (size_t)T * PN * 2 <= WS_ACT && WS_ACT + (size_t)(NASG + NE * 256) * 1024 * 2 <= WS_YB && WS_YB + (size_t)NASG * 1024 * 2 <= WS_END, "ws map");
constexpr int CW_CNT = 64;
constexpr int CW_BAR = 4096;

constexpr int RING_BYTES = 131072;
constexpr int TAB_OFF = 139264, MISC_OFF = 141312, LDS_BYTES = 147456;

typedef __bf16 bf16x2_t __attribute__((ext_vector_type(2)));
__device__ __forceinline__ unsigned cvt_pk_bf16(float lo, float hi) { const f32x2 v = {lo, hi}; const bf16x2_t b = __builtin_convertvector(v, bf16x2_t); return __builtin_bit_cast(unsigned, b); }
__device__ __forceinline__ bf16_t f2bf(float f) { return (bf16_t)(cvt_pk_bf16(f, 0.f) & 0xffffu); }
__device__ __forceinline__ float bflo(unsigned w) { return __uint_as_float(w << 16); }
__device__ __forceinline__ float bfhi(unsigned w) { return __uint_as_float(w & 0xffff0000u); }
__device__ __forceinline__ float bf2f(bf16_t v) { return __uint_as_float((unsigned)v << 16); }
__device__ __forceinline__ void unpack8(const u32x4 w, float (&f)[8]) { f[0] = bflo(w.x); f[1] = bfhi(w.x); f[2] = bflo(w.y); f[3] = bfhi(w.y); f[4] = bflo(w.z); f[5] = bfhi(w.z); f[6] = bflo(w.w); f[7] = bfhi(w.w); }
__device__ __forceinline__ u32x4 pack8(const float (&f)[8]) { u32x4 w; w.x = cvt_pk_bf16(f[0], f[1]); w.y = cvt_pk_bf16(f[2], f[3]); w.z = cvt_pk_bf16(f[4], f[5]); w.w = cvt_pk_bf16(f[6], f[7]); return w; }
__device__ __forceinline__ u32x2 pack8_fp8(const float (&f)[8]) { int a = 0, b = 0;
    a = __builtin_amdgcn_cvt_pk_fp8_f32(f[0], f[1], a, false); a = __builtin_amdgcn_cvt_pk_fp8_f32(f[2], f[3], a, true);
    b = __builtin_amdgcn_cvt_pk_fp8_f32(f[4], f[5], b, false); b = __builtin_amdgcn_cvt_pk_fp8_f32(f[6], f[7], b, true);
    return (u32x2){(unsigned)a, (unsigned)b}; }
__device__ __forceinline__ void unpack8_fp8(const u32x2 w, float (&f)[8]) {
    const f32x2 a = __builtin_amdgcn_cvt_pk_f32_fp8((int)w.x, false), b = __builtin_amdgcn_cvt_pk_f32_fp8((int)w.x, true), c = __builtin_amdgcn_cvt_pk_f32_fp8((int)w.y, false), d = __builtin_amdgcn_cvt_pk_f32_fp8((int)w.y, true);
    f[0] = a.x; f[1] = a.y; f[2] = b.x; f[3] = b.y; f[4] = c.x; f[5] = c.y; f[6] = d.x; f[7] = d.y; }
__device__ __forceinline__ f32x4 mma16(bf16x8 a, bf16x8 b, f32x4 c) { return __builtin_amdgcn_mfma_f32_16x16x32_bf16(a, b, c, 0, 0, 0); }
__device__ __forceinline__ float wave_sum(float v) {
#pragma unroll
    for (int o = 1; o < 64; o <<= 1) v += __shfl_xor(v, o);
    return v;
}
__device__ __forceinline__ float sigmoidf_(float x) { return __builtin_amdgcn_rcpf(1.0f + __expf(-x)); }
__device__ __forceinline__ float gelu_erf(float v) {
    const float av = fabsf(v), t = __builtin_amdgcn_rcpf(av * 0.2316418882f + 1.0f);
    float q = t * 0.5307027145f + (-0.7265760135f); q = q * t + 0.7107068705f; q = q * t + (-0.142248368f); q = q * t + 0.127414796f; q = q * t;
    const float e = __builtin_amdgcn_exp2f((v * v) * (-0.72134752044f));
    const float m = v * (q * e);
    return v < 0.f ? m : v - m;
}
__device__ __forceinline__ f32x2 gelu_pk(f32x2 v) {
    const f32x2 av = __builtin_elementwise_abs(v), d = av * 0.2316418882f + 1.0f;
    f32x2 t; t.x = __builtin_amdgcn_rcpf(d.x); t.y = __builtin_amdgcn_rcpf(d.y);
    f32x2 q = t * 0.5307027145f + (-0.7265760135f); q = q * t + 0.7107068705f; q = q * t + (-0.142248368f); q = q * t + 0.127414796f; q = q * t;
    const f32x2 s = (v * v) * (-0.72134752044f);
    f32x2 e; e.x = __builtin_amdgcn_exp2f(s.x); e.y = __builtin_amdgcn_exp2f(s.y);
    const f32x2 m = v * (q * e), r = v - m;
    f32x2 o; o.x = v.x < 0.f ? m.x : r.x; o.y = v.y < 0.f ? m.y : r.y; return o;
}
__device__ __forceinline__ f32x2 sigmoid_pk(f32x2 v) {
    const f32x2 t = v * (-1.4426950408889634f); const f32x2 d = (f32x2){__builtin_amdgcn_exp2f(t.x), __builtin_amdgcn_exp2f(t.y)} + 1.0f;
    return (f32x2){__builtin_amdgcn_rcpf(d.x), __builtin_amdgcn_rcpf(d.y)};
}
#define LDS_WAIT() asm volatile("s_waitcnt lgkmcnt(0)" ::: "memory")
#define VM_WAIT() asm volatile("s_waitcnt vmcnt(0)" ::: "memory")

#define XB_TMO      128
#define XB_XCNT(j)  (256  + 64 * (j))
#define XB_XSUB(j)  (1280 + 64 * (j))
#define XB_XGEN(j)  (2304 + 64 * (j))
#define XB_TOP      3328
#define XB_TOPGEN   3392
#define XCD_BAR_WORDS 3456
#define XB_SPIN_CAP (1u << 22)
__device__ __forceinline__ unsigned xb_ld(unsigned* p)              { return __hip_atomic_load(p, __ATOMIC_RELAXED, __HIP_MEMORY_SCOPE_AGENT); }
__device__ __forceinline__ unsigned xb_add(unsigned* p, unsigned v) { return __hip_atomic_fetch_add(p, v, __ATOMIC_RELAXED, __HIP_MEMORY_SCOPE_AGENT); }
__device__ __forceinline__ unsigned xb_xcc_id() { return (unsigned)__builtin_amdgcn_s_getreg((3 << 11) | 20) & 0xFu; }
#define XB_SPIN(cond, bar) do { unsigned _sp = 0; while (cond) { __builtin_amdgcn_s_sleep(1); \
    if ((++_sp & 255u) == 0u) { if (xb_ld(&(bar)[XB_TMO])) break; if (_sp > XB_SPIN_CAP) { atomicAdd(&(bar)[XB_TMO], 1u); break; } } } } while (0)
struct XcdBarrier { unsigned* bar; unsigned x; volatile LAS unsigned* st; };
__device__ __forceinline__ XcdBarrier xcd_barrier_post(unsigned* bar, volatile LAS unsigned* st) {
    XcdBarrier b; b.bar = bar; b.x = xb_xcc_id(); b.st = st;
    if (threadIdx.x == 0) (void)xb_add(&bar[XB_XCNT(b.x)], 1u);
    return b;
}
__device__ __forceinline__ void xcd_barrier_complete(unsigned* bar, unsigned x, unsigned& nloc, unsigned& nx) {
    const unsigned G = gridDim.x * gridDim.y * gridDim.z;
    unsigned sum, cnt, mine, sp = 0u;
    for (;;) {
        sum = 0u; cnt = 0u; mine = 0u;
#pragma unroll
        for (unsigned j = 0; j < 16; ++j) { const unsigned c = xb_ld(&bar[XB_XCNT(j)]); sum += c; cnt += (c > 0u) ? 1u : 0u; mine = (j == x) ? c : mine; }
        if (sum == G) break;
        __builtin_amdgcn_s_sleep(1);
        if ((++sp & 255u) == 0u) { if (xb_ld(&bar[XB_TMO])) break; if (sp > XB_SPIN_CAP) { atomicAdd(&bar[XB_TMO], 1u); break; } }
    }
    nloc = mine > 0u ? mine : 1u; nx = cnt > 0u ? cnt : 1u;
}
__device__ __forceinline__ void xcd_barrier(const XcdBarrier& b) {
    asm volatile("s_waitcnt vmcnt(0)" ::: "memory");
    __syncthreads();
    if (threadIdx.x == 0) {
        unsigned* bar = b.bar;
        __builtin_amdgcn_s_waitcnt(0);
        unsigned nloc = b.st[0], nx = b.st[1];
        if (nloc == 0u) { xcd_barrier_complete(bar, b.x, nloc, nx); b.st[0] = nloc; b.st[1] = nx; }
        const unsigned old = xb_add(&bar[XB_XSUB(b.x)], 1u);
        const unsigned gen = old / nloc;
        if (old + 1u == (gen + 1u) * nloc) {
            __builtin_amdgcn_fence(__ATOMIC_RELEASE, "agent");
            asm volatile("s_waitcnt vmcnt(0)" ::: "memory");
            const unsigned og = xb_add(&bar[XB_TOP], 1u);
            const unsigned tg = og / nx;
            if (og + 1u == (tg + 1u) * nx) xb_add(&bar[XB_TOPGEN], 1u);
            else XB_SPIN(xb_ld(&bar[XB_TOPGEN]) == tg, bar);
            __builtin_amdgcn_fence(__ATOMIC_ACQUIRE, "agent");
            xb_add(&bar[XB_XGEN(b.x)], 1u);
            asm volatile("s_waitcnt vmcnt(0)" ::: "memory");
        } else {
            __builtin_amdgcn_fence(__ATOMIC_ACQUIRE, "agent");
            XB_SPIN(xb_ld(&bar[XB_XGEN(b.x)]) == gen, bar);
            asm volatile("s_waitcnt vmcnt(0)" ::: "memory");
        }
    }
    __syncthreads();
}

namespace pg8 {
constexpr int BM = 256, BK = 64, HALF = 128, HTB = HALF * BK * 2, NXCD = 8, WGM = 8;
__host__ __device__ __forceinline__ int lds_byte(int r, int c) { const int st = (r >> 4) * 2 + (c >> 5), rr = r & 15, cc = c & 31, ob = rr * 64 + cc * 2; return st * 1024 + (ob ^ (((ob >> 9) & 1) << 5)); }
__host__ __device__ __forceinline__ void stage_rc(int b, int& R, int& C) { const int st = b / 1024, sb = b % 1024, swz = sb ^ (((sb >> 9) & 1) << 5); R = (st >> 1) * 16 + swz / 64; C = (st & 1) * 32 + (swz % 64) / 2; }
__host__ __device__ __forceinline__ int perm32(int rho) { const int n = rho >> 4, i = rho & 15; return 8 * (i >> 2) + 4 * n + (i & 3); }
struct Unit { int pm, pn, aux; };
__device__ __forceinline__ void map_tile(int L, int nM, int nN, int& pm, int& pn) {
    const int nwg = nM * nN; int wgid = L;
    { const int q = nwg / NXCD, r = nwg % NXCD, xcd = wgid % NXCD, off = wgid / NXCD; wgid = (xcd < r ? xcd * (q + 1) : r * (q + 1) + (xcd - r) * q) + off; }
    const int nig = WGM * nN, gid = wgid / nig, fm = gid * WGM, gsz = (nM - fm) < WGM ? (nM - fm) : WGM;
    pm = fm + ((wgid % nig) % gsz); pn = (wgid % nig) / gsz;
}
template <class Epi, class Prob>
__device__ __forceinline__ void gemm_phase(LAS unsigned char* lds, const Prob& P, const Epi& E) {
    const int tid = threadIdx.x, wid = __builtin_amdgcn_readfirstlane(tid >> 6), lane = tid & 63, wr = wid >> 2, wc = wid & 3, fr = lane & 15, fq = lane >> 4;
    const int nt = P.K / (Prob::FP8 ? 128 : BK);
    unsigned voffB[2];
#pragma unroll
    for (int i = 0; i < 2; ++i) { int R_, C_; stage_rc(tid * 16 + i * 8192, R_, C_); const int Rb = (R_ & ~31) + perm32(R_ & 31); voffB[i] = (unsigned)(Rb * P.ldb + C_ * 2); }
#define PG8_AOFF(dst0, dst1, unit) do { _Pragma("unroll") for (int _i = 0; _i < 2; ++_i) { int R_, C_; stage_rc(tid * 16 + _i * 8192, R_, C_); dst0[_i] = P.a_off(unit, R_, C_); dst1[_i] = P.a_off(unit, R_ + HALF, C_); } } while (0)
    const size_t kstep = (size_t)(BK * 2);
    const size_t hstepB = (size_t)HALF * P.ldb;
    const unsigned ldsw = (unsigned)wid * 1024u;
    const int aoff = lds_byte(wr * 64 + fr, fq * 8), boff = lds_byte(wc * 32 + fr, fq * 8);
#define PG8_SA(b, h) (((b) * 2 + (h)) * HTB)
#define PG8_SB(b, h) ((4 + (b) * 2 + (h)) * HTB)
#define PG8_STAGE(bufoff, gbase, voff) do { _Pragma("unroll") for (int _i = 0; _i < 2; ++_i) \
        __builtin_amdgcn_global_load_lds((const unsigned*)((const char*)(gbase) + (voff)[_i]), (LAS unsigned*)(lds + (bufoff) + ldsw + _i * 8192), 16, 0, 0); } while (0)
#define PG8_LD8(addr) __builtin_shufflevector(*(const LAS i32x4*)(addr), *(const LAS i32x4*)((addr) + 1024), 0, 1, 2, 3, 4, 5, 6, 7)
#define PG8_LDA(dst, b, h) do { _Pragma("unroll") for (int m = 0; m < 4; ++m) dst[m] = PG8_LD8(lds + PG8_SA(b, h) + aoff + m * 2048); } while (0)
#define PG8_LDB(dst, b, h) do { _Pragma("unroll") for (int n = 0; n < 2; ++n) dst[n] = PG8_LD8(lds + PG8_SB(b, h) + boff + n * 2048); } while (0)
#define PG8_LO(x) __builtin_bit_cast(bf16x8, __builtin_shufflevector(x, x, 0, 1, 2, 3))
#define PG8_HI(x) __builtin_bit_cast(bf16x8, __builtin_shufflevector(x, x, 4, 5, 6, 7))
#define PG8_MMA(ai, bj, At, Bt) do { __builtin_amdgcn_s_setprio(1); _Pragma("unroll") for (int m = 0; m < 4; ++m) _Pragma("unroll") for (int n = 0; n < 2; ++n) { \
        if constexpr (Prob::FP8) asm volatile("v_mfma_scale_f32_16x16x128_f8f6f4 %0, %1, %2, %0, %3, %4 op_sel_hi:[0,0,0]" : "+v"(acc[ai][bj][m][n]) : "v"(Bt[n]), "v"(At[m]), "v"(scl_w), "v"(scl_1)); \
        else { acc[ai][bj][m][n] = __builtin_amdgcn_mfma_f32_16x16x32_bf16(PG8_LO(Bt[n]), PG8_LO(At[m]), acc[ai][bj][m][n], 0, 0, 0); \
               acc[ai][bj][m][n] = __builtin_amdgcn_mfma_f32_16x16x32_bf16(PG8_HI(Bt[n]), PG8_HI(At[m]), acc[ai][bj][m][n], 0, 0, 0); } } \
        __builtin_amdgcn_s_setprio(0); } while (0)
#define PG8_WAIT_V(n) asm volatile("s_waitcnt vmcnt(" #n ")" ::: "memory")
#define PG8_WAIT_L(n) asm volatile("s_waitcnt lgkmcnt(" #n ")" ::: "memory")
#define PG8_BAR __builtin_amdgcn_s_barrier()
#define PG8_SCHED __builtin_amdgcn_sched_barrier(0)
    Unit cur, nxt; int ui = 0;
    if (!P.next(0, cur)) return;
    f32x4 acc[2][2][4][2];
#pragma unroll
    for (int a = 0; a < 2; ++a)
#pragma unroll
        for (int b = 0; b < 2; ++b)
#pragma unroll
            for (int m = 0; m < 4; ++m)
#pragma unroll
                for (int n = 0; n < 2; ++n) acc[a][b][m][n] = (f32x4){0.f, 0.f, 0.f, 0.f};
    i32x8 At[4], B0[2], B1[2];
    int scl_w = Prob::WSCALE, scl_1 = 0x7f7f7f7f; asm volatile("" : "+v"(scl_w), "+v"(scl_1));
    unsigned cO0[2], cO1[2], nO0[2], nO1[2];
    PG8_AOFF(cO0, cO1, cur);
    const char* cA = P.a_base(cur); const char* cB = P.b_base(cur);
    PG8_STAGE(PG8_SB(0, 0), cB, voffB); PG8_STAGE(PG8_SB(0, 1), cB + hstepB, voffB); PG8_STAGE(PG8_SA(0, 0), cA, cO0); PG8_STAGE(PG8_SA(0, 1), cA, cO1);
    if (wr == 1) PG8_BAR;
    PG8_WAIT_V(2); PG8_BAR;
    PG8_STAGE(PG8_SB(1, 0), cB + kstep, voffB); PG8_STAGE(PG8_SA(1, 0), cA + kstep, cO0); PG8_STAGE(PG8_SB(1, 1), cB + hstepB + kstep, voffB);
    PG8_WAIT_V(6); PG8_BAR;
    for (;;) {
        const bool has_next = P.next(ui + 1, nxt);
        const char* nA = cA; const char* nB = cB;
        if constexpr (Prob::GATHER) {
#pragma unroll
            for (int i = 0; i < 2; ++i) { nO0[i] = cO0[i]; nO1[i] = cO1[i]; } }
        if (has_next) { nA = P.a_base(nxt); nB = P.b_base(nxt); if constexpr (Prob::GATHER) PG8_AOFF(nO0, nO1, nxt); }
        for (int t = 0; t < nt; t += 2) {
            const bool last = (t == nt - 2);
            const char* a1 = cA + (size_t)(t + 1) * kstep;
            const char* a2 = last ? nA : cA + (size_t)(t + 2) * kstep; const char* b2 = last ? nB : cB + (size_t)(t + 2) * kstep;
            const char* a3 = a2 + kstep; const char* b3 = b2 + kstep;
            unsigned o20[2], o21[2];
#pragma unroll
            for (int i = 0; i < 2; ++i) { if constexpr (Prob::GATHER) { o20[i] = last ? nO0[i] : cO0[i]; o21[i] = last ? nO1[i] : cO1[i]; } else { o20[i] = cO0[i]; o21[i] = cO1[i]; } }
            PG8_LDB(B0, 0, 0); PG8_LDB(B1, 0, 1); PG8_SCHED; PG8_LDA(At, 0, 0); PG8_STAGE(PG8_SA(1, 1), a1, cO1);
            PG8_WAIT_V(8); PG8_WAIT_L(0); PG8_BAR; PG8_MMA(0, 0, At, B0); PG8_MMA(0, 1, At, B1); PG8_BAR; PG8_SCHED;
            PG8_LDA(At, 0, 1); PG8_STAGE(PG8_SB(0, 0), b2, voffB); PG8_STAGE(PG8_SB(0, 1), b2 + hstepB, voffB); PG8_STAGE(PG8_SA(0, 0), a2, o20);
            PG8_WAIT_V(8); PG8_WAIT_L(0); PG8_BAR; PG8_MMA(1, 0, At, B0); PG8_MMA(1, 1, At, B1); PG8_BAR; PG8_SCHED;
            PG8_LDB(B0, 1, 0); PG8_LDB(B1, 1, 1); PG8_SCHED; PG8_LDA(At, 1, 0); PG8_STAGE(PG8_SA(0, 1), a2, o21);
            PG8_WAIT_V(8); PG8_WAIT_L(0); PG8_BAR; PG8_MMA(0, 0, At, B0); PG8_MMA(0, 1, At, B1); PG8_BAR; PG8_SCHED;
            PG8_LDA(At, 1, 1); PG8_STAGE(PG8_SB(1, 0), b3, voffB); PG8_STAGE(PG8_SB(1, 1), b3 + hstepB, voffB); PG8_STAGE(PG8_SA(1, 0), a3, o20);
            PG8_WAIT_V(8); PG8_WAIT_L(0); PG8_BAR; PG8_MMA(1, 0, At, B0); PG8_MMA(1, 1, At, B1); PG8_BAR; PG8_SCHED;
            if constexpr (Epi::MID) { if (t + 2 == nt / 2) E.mid(acc, cur, wr, wc, fr, fq); }
        }
        if (wr == 0) PG8_BAR;
        if constexpr (Prob::FP8) asm volatile("s_nop 15\n\ts_nop 15" ::: "memory");
        E(acc, cur, wr, wc, fr, fq);
        if (!has_next) break;
#pragma unroll
        for (int a = 0; a < 2; ++a)
#pragma unroll
            for (int b = 0; b < 2; ++b)
#pragma unroll
                for (int m = 0; m < 4; ++m)
#pragma unroll
                    for (int n = 0; n < 2; ++n) acc[a][b][m][n] = (f32x4){0.f, 0.f, 0.f, 0.f};
        cur = nxt; cA = nA; cB = nB; ++ui;
        if constexpr (Prob::GATHER) {
#pragma unroll
            for (int i = 0; i < 2; ++i) { cO0[i] = nO0[i]; cO1[i] = nO1[i]; } }
        if (wr == 1) PG8_BAR;
    }
    PG8_WAIT_V(0);
    PG8_BAR;
#undef PG8_AOFF
#undef PG8_SA
#undef PG8_SB
#undef PG8_STAGE
#undef PG8_LDA
#undef PG8_LD8
#undef PG8_LO
#undef PG8_HI
#undef PG8_LDB
#undef PG8_MMA
#undef PG8_WAIT_V
#undef PG8_WAIT_L
#undef PG8_BAR
#undef PG8_SCHED
}
}
using pg8::Unit;

struct Args { const float* in[28]; float* out; unsigned char* ws; int ph_lo, ph_hi; };
struct Frame {
    LAS unsigned char* lds;
    volatile LAS unsigned* MISC;
    unsigned* ctl;
    int tid, lane, wave, vcu, G;
    const Args* A;
    __device__ __forceinline__ bf16_t* Win_t() const { return (bf16_t*)(A->ws + WS_WIN); }
    __device__ __forceinline__ bf16_t* Wk_t() const { return (bf16_t*)(A->ws + WS_WK); }
    __device__ __forceinline__ bf16_t* Wv_t() const { return (bf16_t*)(A->ws + WS_WV); }
    __device__ __forceinline__ bf16_t* Wpab_t() const { return (bf16_t*)(A->ws + WS_WPAB); }
    __device__ __forceinline__ bf16_t* Wmo_t() const { return (bf16_t*)(A->ws + WS_WMO); }
    __device__ __forceinline__ bf16_t* Wq_t() const { return (bf16_t*)(A->ws + WS_WQ); }
    __device__ __forceinline__ bf16_t* Wo_t() const { return (bf16_t*)(A->ws + WS_WO); }
    __device__ __forceinline__ bf16_t* Wr_t() const { return (bf16_t*)(A->ws + WS_WR); }
    __device__ __forceinline__ bf16_t* W1_t() const { return (bf16_t*)(A->ws + WS_W1); }
    __device__ __forceinline__ bf16_t* W2_t() const { return (bf16_t*)(A->ws + WS_W2); }
    __device__ __forceinline__ bf16_t* sguw() const { return (bf16_t*)(A->ws + WS_SGUW); }
    __device__ __forceinline__ bf16_t* h() const { return (bf16_t*)(A->ws + WS_H); }
    __device__ __forceinline__ bf16_t* memn() const { return (bf16_t*)(A->ws + WS_MEMN); }
    __device__ __forceinline__ bf16_t* kmem() const { return (bf16_t*)(A->ws + WS_KMEM); }
    __device__ __forceinline__ bf16_t* vt() const { return (bf16_t*)(A->ws + WS_VT); }
    __device__ __forceinline__ bf16_t* qin() const { return (bf16_t*)(A->ws + WS_QIN); }
    __device__ __forceinline__ bf16_t* oab() const { return (bf16_t*)(A->ws + WS_OAB); }
    __device__ __forceinline__ bf16_t* mix() const { return (bf16_t*)(A->ws + WS_MIX); }
    __device__ __forceinline__ bf16_t* x1b() const { return (bf16_t*)(A->ws + WS_X1B); }
    __device__ __forceinline__ bf16_t* q() const { return (bf16_t*)(A->ws + WS_Q); }
    __device__ __forceinline__ bf16_t* ao() const { return (bf16_t*)(A->ws + WS_AO); }
    __device__ __forceinline__ bf16_t* x2b() const { return (bf16_t*)(A->ws + WS_X2B); }
    __device__ __forceinline__ bf16_t* p() const { return (bf16_t*)(A->ws + WS_P); }
    __device__ __forceinline__ bf16_t* act() const { return (bf16_t*)(A->ws + WS_ACT); }
    __device__ __forceinline__ bf16_t* yb() const { return (bf16_t*)(A->ws + WS_YB); }
    __device__ __forceinline__ bf16_t* ointra() const { return (bf16_t*)(A->ws + WS_OINTRA); }
    __device__ __forceinline__ bf16_t* kvT() const { return (bf16_t*)(A->ws + WS_KVT); }
    __device__ __forceinline__ float* decay() const { return (float*)(A->ws + WS_DECAY); }
    __device__ __forceinline__ float* ssq1() const { return (float*)(A->ws + WS_SSQ1); }
    __device__ __forceinline__ float* ssq2() const { return (float*)(A->ws + WS_SSQ2); }
    __device__ __forceinline__ float* lscale() const { return (float*)(A->ws + WS_LSCALE); }
    __device__ __forceinline__ float* gates() const { return (float*)(A->ws + WS_GATES); }
    __device__ __forceinline__ int* list() const { return (int*)(A->ws + WS_LIST); }
    __device__ __forceinline__ bf16_t* spT() const { return (bf16_t*)(A->ws + WS_SPT); }
    __device__ __forceinline__ unsigned char* x2q() const { return (unsigned char*)(A->ws + WS_X2Q); }
    __device__ __forceinline__ unsigned char* x1q() const { return (unsigned char*)(A->ws + WS_X1Q); }
};
enum { I_X = 0, I_MEM, I_NMIXG, I_WIN, I_WA2, I_BA, I_GOUTG, I_SNG, I_SNB, I_SW, I_SB, I_WPA, I_WPB, I_WMO, I_NXG, I_NMEMG, I_WXQ, I_WXK, I_WXV, I_WXO, I_NFFNG, I_WR, I_BR, I_WE1, I_BE1, I_WE2, I_BE2, I_NFING };

struct CvtItem { const float* src; size_t ldw; unsigned char* dst; const float* kscale; float mul; int fp8; };
__device__ __forceinline__ void cvt_load(const CvtItem& c, float (&v)[64]) {
#pragma unroll
    for (int i = 0; i < 64; ++i) v[i] = __builtin_nontemporal_load(c.src + (size_t)i * c.ldw);
}
__device__ __forceinline__ void cvt_finish(const CvtItem& c, float (&v)[64]) {
    if (c.kscale) {
#pragma unroll
        for (int i = 0; i < 64; ++i) v[i] *= c.kscale[i] * c.mul; }
    else {
#pragma unroll
        for (int i = 0; i < 64; ++i) v[i] *= c.mul; }
    if (c.fp8) {
#pragma unroll
        for (int q = 0; q < 4; ++q) { const float f0[8] = {v[16 * q], v[16 * q + 1], v[16 * q + 2], v[16 * q + 3], v[16 * q + 4], v[16 * q + 5], v[16 * q + 6], v[16 * q + 7]};
            const float f1[8] = {v[16 * q + 8], v[16 * q + 9], v[16 * q + 10], v[16 * q + 11], v[16 * q + 12], v[16 * q + 13], v[16 * q + 14], v[16 * q + 15]};
            const u32x2 lo = pack8_fp8(f0), hi = pack8_fp8(f1); *(u32x4*)(c.dst + 16 * q) = (u32x4){lo.x, lo.y, hi.x, hi.y}; } }
    else {
#pragma unroll
        for (int q = 0; q < 8; ++q) { const float f[8] = {v[8 * q], v[8 * q + 1], v[8 * q + 2], v[8 * q + 3], v[8 * q + 4], v[8 * q + 5], v[8 * q + 6], v[8 * q + 7]}; *(u32x4*)(c.dst + 16 * q) = pack8(f); } }
}
__device__ __forceinline__ CvtItem cvt_desc(const float* W, int ldw, int src_col0, int k0, void* WT, int ldt, int dst_row0, int dst_k0, const float* kscale, float mul, int fp8, int lane) {
    CvtItem c; const int eb = fp8 ? 1 : 2;
    c.src = W + (size_t)k0 * ldw + src_col0 + lane; c.ldw = (size_t)ldw; c.dst = (unsigned char*)WT + ((size_t)(dst_row0 + lane) * ldt + dst_k0 + k0) * eb;
    c.kscale = kscale ? kscale + k0 : nullptr; c.mul = mul; c.fp8 = fp8; return c;
}
__device__ __forceinline__ void cvt_expert128(Frame& F) {
    const int gw = F.vcu * 8 + F.wave, NGW = F.G * 8, lane = F.lane;
    constexpr int I1 = NE * 8 * 32, I2 = NE * 8 * 16;
    for (int it = gw; it < I1 + I2; it += NGW) {
        const float* src; size_t ldw; unsigned char* dst; const float* ks; (void)ks;
        if (it < I1) { const int e = it >> 8, q = it & 255, kb = q >> 5, nb = q & 31, nd = nb * 64; const int sc = ((nd & 128) ? 1024 : 0) + 128 * (nd >> 8) + (nd & 127);
            src = F.A->in[I_WE1] + (size_t)e * D * 2048 + (size_t)(kb * 128) * 2048 + sc + lane; ldw = 2048;
            dst = (unsigned char*)F.W1_t() + (size_t)e * 2048 * D + (size_t)(nd + lane) * D + kb * 128; ks = nullptr; }
        else { const int r = it - I1, e = r >> 7, q = r & 127, kb = q >> 4, nb = q & 15;
            src = F.A->in[I_WE2] + (size_t)e * D * D + (size_t)(kb * 128) * D + nb * 64 + lane; ldw = D;
            dst = (unsigned char*)F.W2_t() + (size_t)e * D * D + (size_t)(nb * 64 + lane) * D + kb * 128; ks = nullptr; }
        float v[128]; const float* pp = src;
#pragma unroll
        for (int i = 0; i < 128; ++i) { v[i] = __builtin_nontemporal_load(pp); pp += ldw; asm volatile("" : "+v"(pp)); }
#pragma unroll
        for (int i = 0; i < 128; ++i) v[i] *= FP8_WMUL;
#pragma unroll
        for (int q = 0; q < 8; ++q) { const float f0[8] = {v[16 * q], v[16 * q + 1], v[16 * q + 2], v[16 * q + 3], v[16 * q + 4], v[16 * q + 5], v[16 * q + 6], v[16 * q + 7]};
            const float f1[8] = {v[16 * q + 8], v[16 * q + 9], v[16 * q + 10], v[16 * q + 11], v[16 * q + 12], v[16 * q + 13], v[16 * q + 14], v[16 * q + 15]};
            const u32x2 lo = pack8_fp8(f0), hi = pack8_fp8(f1); *(u32x4*)(dst + 16 * q) = (u32x4){lo.x, lo.y, hi.x, hi.y}; }
    }
}
template <bool Q8>
__device__ __forceinline__ void rms_row_to_bf16(const float* xrow, const float* g, bf16_t* orow, int lane) {
    f32x4 v[4]; float s = 0.f;
#pragma unroll
    for (int j = 0; j < 4; ++j) { v[j] = *(const f32x4*)(xrow + 256 * j + 4 * lane); s += (v[j].x * v[j].x + v[j].y * v[j].y) + (v[j].z * v[j].z + v[j].w * v[j].w); }
    const float rs = rsqrtf(wave_sum(s) * (1.f / D) + EPS);
#pragma unroll
    for (int j = 0; j < 4; ++j) { const f32x4 gg = *(const f32x4*)(g + 256 * j + 4 * lane);
        if constexpr (Q8) { int w = 0; w = __builtin_amdgcn_cvt_pk_fp8_f32(v[j].x * rs * gg.x, v[j].y * rs * gg.y, w, false); w = __builtin_amdgcn_cvt_pk_fp8_f32(v[j].z * rs * gg.z, v[j].w * rs * gg.w, w, true);
            *(int*)((unsigned char*)orow + 256 * j + 4 * lane) = w; }
        else { u32x2 o; o.x = cvt_pk_bf16(v[j].x * rs * gg.x, v[j].y * rs * gg.y); o.y = cvt_pk_bf16(v[j].z * rs * gg.z, v[j].w * rs * gg.w);
            *(u32x2*)(orow + 256 * j + 4 * lane) = o; } }
}
__device__ __forceinline__ void cvt_range(Frame& F, int ibeg, int iend) {
    const int gw = F.vcu * 8 + F.wave, NGW = F.G * 8, lane = F.lane;
    constexpr int N_WIN = 16 * 72, N_SQ = 256, N_PA = 8 * 16, N_E1 = 512, N_E2 = 256;
    constexpr int S_WIN = 0, S_WK = S_WIN + N_WIN, S_WV = S_WK + N_SQ, S_PA = S_WV + N_SQ, S_PB = S_PA + N_PA, S_MO = S_PB + N_PA, S_Q = S_MO + N_SQ, S_O = S_Q + N_SQ, S_E1 = S_O + N_SQ, S_E2 = S_E1 + NE * N_E1, S_END = S_E2 + NE * N_E2;
    static_assert(S_E1 == 16 * 72 + 256 * 2 + 8 * 16 * 2 + 256 * 3 && S_END == S_E1 + NE * 512 + NE * 256, "item ranges");
    const int IEND = iend < S_END ? iend : S_END;
    auto desc = [&](int it) -> CvtItem {
        if (it < S_WK) { const int r = it - S_WIN, kb = r / 72, nb = r % 72, n0 = nb * 64; return cvt_desc(F.A->in[I_WIN], INC, n0 < 1536 ? n0 : n0 + 16, kb * 64, F.Win_t(), D, n0, 0, nullptr, P1_FP8 ? FP8_WMUL : 1.f, P1_FP8, lane); }
        if (it < S_WV) { const int r = it - S_WK; return cvt_desc(F.A->in[I_WXK], D, (r & 15) * 64, (r >> 4) * 64, F.Wk_t(), D, (r & 15) * 64, 0, nullptr, P1_FP8 ? FP8_WMUL : 1.f, P1_FP8, lane); }
        if (it < S_PA) { const int r = it - S_WV; return cvt_desc(F.A->in[I_WXV], D, (r & 15) * 64, (r >> 4) * 64, F.Wv_t(), D, (r & 15) * 64, 0, nullptr, P1_FP8 ? FP8_WMUL : 1.f, P1_FP8, lane); }
        if (it < S_PB) { const int r = it - S_PA; return cvt_desc(F.A->in[I_WPA], D, (r & 15) * 64, (r >> 4) * 64, F.Wpab_t(), D, (r & 15) * 64, 0, nullptr, 1.f, 0, lane); }
        if (it < S_MO) { const int r = it - S_PB; return cvt_desc(F.A->in[I_WPB], D, (r & 15) * 64, (r >> 4) * 64, F.Wpab_t(), D, (r & 15) * 64, 512, nullptr, 1.f, 0, lane); }
        if (it < S_Q)  { const int r = it - S_MO; return cvt_desc(F.A->in[I_WMO], D, (r & 15) * 64, (r >> 4) * 64, F.Wmo_t(), D, (r & 15) * 64, 0, nullptr, 1.f, 0, lane); }
        if (it < S_O)  { const int r = it - S_Q;  return cvt_desc(F.A->in[I_WXQ], D, (r & 15) * 64, (r >> 4) * 64, F.Wq_t(), D, (r & 15) * 64, 0, F.A->in[I_NXG], FP8_WMUL, 1, lane); }
        if (it < S_E1) { const int r = it - S_O;  return cvt_desc(F.A->in[I_WXO], D, (r & 15) * 64, (r >> 4) * 64, F.Wo_t(), D, (r & 15) * 64, 0, nullptr, FP8_WMUL, 1, lane); }
        if (it < S_E2) { const int r = it - S_E1, e = r / N_E1, q = r % N_E1, kb = q >> 5, nb = q & 31, nd = nb * 64;
            const int src = ((nd & 128) ? 1024 : 0) + 128 * (nd >> 8) + (nd & 127);
            return cvt_desc(F.A->in[I_WE1] + (size_t)e * D * 2048, 2048, src, kb * 64, (unsigned char*)F.W1_t() + (size_t)e * 2048 * D, D, nd, 0, F.A->in[I_NFFNG], FP8_WMUL, 1, lane); }
        const int r = it - S_E2, e = r / N_E2, q = r % N_E2;
        return cvt_desc(F.A->in[I_WE2] + (size_t)e * D * D, D, (q & 15) * 64, (q >> 4) * 64, (unsigned char*)F.W2_t() + (size_t)e * D * D, D, (q & 15) * 64, 0, nullptr, FP8_WMUL, 1, lane); };
    if (ibeg + gw < IEND) {
        float va[64], vb[64]; CvtItem ca = desc(ibeg + gw), cb = ca; cvt_load(ca, va);
        for (int it = ibeg + gw;;) {
            const bool hb = it + NGW < IEND; if (hb) { cb = desc(it + NGW); cvt_load(cb, vb); }
            cvt_finish(ca, va); if (!hb) break;
            const bool ha = it + 2 * NGW < IEND; if (ha) { ca = desc(it + 2 * NGW); cvt_load(ca, va); }
            cvt_finish(cb, vb); if (!ha) break;
            it += 2 * NGW; }
    }
}
constexpr int CVT_LATE = 16 * 72 + 256 * 2, CVT_EXPERT = 16 * 72 + 256 * 2 + 8 * 16 * 2 + 256 * 3, CVT_END = CVT_EXPERT + NE * 512 + NE * 256;
__device__ __forceinline__ void p0_prologue(Frame& F) {
    const int gw = F.vcu * 8 + F.wave, NGW = F.G * 8, lane = F.lane;
    cvt_range(F, 0, CVT_LATE);
    for (int m = gw; m < T; m += NGW) rms_row_to_bf16<P1_FP8 != 0>(F.A->in[I_X] + (size_t)m * D, F.A->in[I_NMIXG], (bf16_t*)((unsigned char*)F.h() + (size_t)m * D * (P1_FP8 ? 1 : 2)), lane);
    for (int m = gw; m < TM; m += NGW) rms_row_to_bf16<P1_FP8 != 0>(F.A->in[I_MEM] + (size_t)m * D, F.A->in[I_NMEMG], (bf16_t*)((unsigned char*)F.memn() + (size_t)m * D * (P1_FP8 ? 1 : 2)), lane);
    const int gt = F.vcu * 512 + F.tid, NGT = F.G * 512;
    for (int i = gt; i < 256 * D; i += NGT) { const int j = i >> 10, k = i & 1023; const float* wr_ = F.A->in[I_WIN] + (size_t)k * INC + OFF_A; float s = 0.f;
#pragma unroll
        for (int r = 0; r < 16; ++r) s += wr_[r] * F.A->in[I_WA2][r * 256 + j];
        if (P1_FP8) { int w = __builtin_amdgcn_cvt_pk_fp8_f32(s * FP8_WMUL, 0.f, 0, false); ((unsigned char*)F.Win_t())[(size_t)(PC_A + j) * D + k] = (unsigned char)(w & 0xff); }
        else F.Win_t()[(size_t)(PC_A + j) * D + k] = f2bf(s); }
    for (int i = gt; i < NE * D; i += NGT) { const int e = i >> 10, k = i & 1023; F.Wr_t()[i] = f2bf(F.A->in[I_WR][k * NE + e] * F.A->in[I_NFFNG][k]); }
    for (int i = gt; i < 4 * 128 * 128; i += NGT) { const int t = (i >> 7) & 127, s = i & 127; F.sguw()[i] = f2bf(s <= t ? F.A->in[I_SW][i] : 0.f); }
}

struct ProbP1 {
    static constexpr bool GATHER = false, FP8 = (P1_FP8 != 0); static constexpr int EB = P1_FP8 ? 1 : 2, WSCALE = FP8_WSCALE;
    int K, lda, ldb, G, c; const unsigned char* ws;
    __device__ __forceinline__ bool next(int i, Unit& u) const {
        const int L = i * G + c;
        if (L < 1216) { u.aux = 0; pg8::map_tile(L, 64, 19, u.pm, u.pn); return true; }
        if (L < 1248) { u.aux = 1; u.pm = (L - 1216) >> 2; u.pn = (L - 1216) & 3; return true; }
        if (L < 1280) { u.aux = 2; u.pm = (L - 1248) >> 3; u.pn = (L - 1248) & 7; return true; }
        return false;
    }
    __device__ __forceinline__ const char* a_base(const Unit& u) const { const size_t o = u.aux == 0 ? WS_H : (u.aux == 1 ? WS_MEMN : WS_WV); return (const char*)(ws + o + (size_t)u.pm * 256 * D * EB); }
    __device__ __forceinline__ const char* b_base(const Unit& u) const { const size_t o = u.aux == 0 ? WS_WIN : (u.aux == 1 ? WS_WK : WS_MEMN); return (const char*)(ws + o + (size_t)u.pn * 256 * D * EB); }
    __device__ __forceinline__ unsigned a_off(const Unit&, int row, int C) const { return (unsigned)(row * D * EB + C * 2); }
};
struct EpiP1 {
    static constexpr bool MID = false;
    unsigned char* ws;
    __device__ __forceinline__ void operator()(const f32x4 (&acc)[2][2][4][2], const Unit& u, int wr, int wc, int fr, int fq) const {
        asm volatile("" : "+v"(fr), "+v"(fq));
        const size_t oo = u.aux == 0 ? WS_P : (u.aux == 1 ? WS_KMEM : WS_VT);
        bf16_t* O = (bf16_t*)(ws + oo); const int ldc = u.aux == 0 ? PN : (u.aux == 1 ? D : TM);
        const int act = (u.aux == 0) ? ((u.pn >= 6 && u.pn < 10) ? 1 : ((u.pn >= 10 && u.pn < 18) ? 2 : 0)) : 0;
        const int row0 = u.pm * 256 + wr * 64 + fr, col0 = u.pn * 256 + wc * 32 + 8 * fq; const bool svstat = (u.aux == 0) && (u.pn == 8 || u.pn == 9);
#pragma unroll
        for (int ai = 0; ai < 2; ++ai)
#pragma unroll
            for (int m = 0; m < 4; ++m) { bf16_t* rowp = O + (size_t)(row0 + ai * 128 + m * 16) * ldc + col0; float s1 = 0.f, s2 = 0.f;
#pragma unroll
                for (int bj = 0; bj < 2; ++bj) { float v[8];
#pragma unroll
                    for (int j = 0; j < 4; ++j) { v[j] = acc[ai][bj][m][0][j]; v[4 + j] = acc[ai][bj][m][1][j]; }
                    if (act == 1) {
#pragma unroll
                        for (int j = 0; j < 8; j += 2) { const f32x2 o = gelu_pk((f32x2){v[j], v[j + 1]}); v[j] = o.x; v[j + 1] = o.y; }
#pragma unroll
                        for (int j = 0; j < 8; ++j) { s1 += v[j]; s2 += v[j] * v[j]; } }
                    else if (act == 2) {
#pragma unroll
                        for (int j = 0; j < 8; j += 2) { const f32x2 o = sigmoid_pk((f32x2){v[j], v[j + 1]}); v[j] = o.x; v[j + 1] = o.y; } }
                    *(u32x4*)(rowp + bj * 128) = pack8(v); }
                if (svstat) {
                    s1 += __shfl_xor(s1, 16); s1 += __shfl_xor(s1, 32); s2 += __shfl_xor(s2, 16); s2 += __shfl_xor(s2, 32);
                    if (fq == 0) *(f32x2*)((float*)(ws + WS_SVS) + (size_t)(row0 + ai * 128 + m * 16) * 16 + (u.pn - 8) * 8 + wc * 2) = (f32x2){s1, s2}; } }
    }
};

__device__ __forceinline__ void gla_a_unit(Frame& F, int unit) {
    const int tid = F.tid, lane = F.lane, w = F.wave, fr = lane & 15, fq = lane >> 4;
    const int bh = unit >> 5, n = unit & 31, b = bh >> 2, h = bh & 3;
    const int t0 = b * SEQ + n * 64;
    LAS float* cum = (LAS float*)(F.lds); LAS float* tot = (LAS float*)(F.lds + 16640);
    LAS bf16_t* QIN = (LAS bf16_t*)(F.lds + 18688); LAS bf16_t* KIN = (LAS bf16_t*)(F.lds + 27904); LAS bf16_t* KOT = (LAS bf16_t*)(F.lds + 37120);
    LAS bf16_t* ATT = (LAS bf16_t*)(F.lds + 46336); LAS bf16_t* VT = (LAS bf16_t*)(F.lds + 55552);
    const int c = tid >> 3, d8 = (tid & 7) * 8;
    {
        float g[8]; unpack8(*(const u32x4*)(F.p() + (size_t)(t0 + c) * PN + PC_A + h * 64 + d8), g);
        const f32x4 b0 = *(const f32x4*)(F.A->in[I_BA] + h * 64 + d8), b1 = *(const f32x4*)(F.A->in[I_BA] + h * 64 + d8 + 4);
        const float bb[8] = {b0.x, b0.y, b0.z, b0.w, b1.x, b1.y, b1.z, b1.w};
#pragma unroll
        for (int j = 0; j < 8; ++j) { const float x = g[j] + bb[j]; const float ls = fminf(x, 0.f) - __logf(1.f + __expf(-fabsf(x))); cum[c * 65 + d8 + j] = ls * 0.0625f; }
    }
    __syncthreads();
    { const int d = tid & 63, seg = tid >> 6; float run = 0.f;
#pragma unroll
        for (int i = 0; i < 8; ++i) { run += cum[(seg * 8 + i) * 65 + d]; cum[(seg * 8 + i) * 65 + d] = run; }
        tot[seg * 64 + d] = run; }
    __syncthreads();
    { const int d = tid & 63, seg = tid >> 6; float off = 0.f;
#pragma unroll
        for (int s = 0; s < 7; ++s) if (s < seg) off += tot[s * 64 + d];
#pragma unroll
        for (int i = 0; i < 8; ++i) cum[(seg * 8 + i) * 65 + d] += off; }
    __syncthreads();
    {
        float qv[8], kv[8], qi[8], ki[8];
        unpack8(*(const u32x4*)(F.p() + (size_t)(t0 + c) * PN + PC_Q + h * 64 + d8), qv);
        unpack8(*(const u32x4*)(F.p() + (size_t)(t0 + c) * PN + PC_K + h * 64 + d8), kv);
#pragma unroll
        for (int j = 0; j < 8; ++j) { const float cm = cum[c * 65 + d8 + j], cl = cum[63 * 65 + d8 + j];
            qi[j] = qv[j] * 0.125f * __expf(cm); ki[j] = kv[j] * __expf(-cm);
            KOT[(d8 + j) * 72 + c] = f2bf(kv[j] * __expf(cl - cm));
            if (c == 63) F.decay()[unit * 64 + d8 + j] = __expf(cl); }
        const u32x4 qp = pack8(qi), kp = pack8(ki);
        *(LAS u32x4*)(QIN + c * 72 + d8) = qp; *(LAS u32x4*)(KIN + c * 72 + d8) = kp;
        *(u32x4*)(F.qin() + (size_t)(t0 + c) * 256 + h * 64 + d8) = qp;
        const int e16 = (tid & 7) * 16;
#pragma unroll
        for (int hh = 0; hh < 2; ++hh) { const u32x4 vv = *(const u32x4*)(F.p() + (size_t)(t0 + c) * PN + PC_V + h * 128 + e16 + 8 * hh);
            const unsigned ww[4] = {vv.x, vv.y, vv.z, vv.w};
#pragma unroll
            for (int j = 0; j < 4; ++j) { VT[(e16 + 8 * hh + 2 * j) * 72 + c] = (bf16_t)(ww[j] & 0xffffu); VT[(e16 + 8 * hh + 2 * j + 1) * 72 + c] = (bf16_t)(ww[j] >> 16); } }
    }
    __syncthreads();
    {
        const int mt = w >> 1;
        bf16x8 a[2];
#pragma unroll
        for (int ks = 0; ks < 2; ++ks) a[ks] = *(const LAS bf16x8*)(QIN + (16 * mt + fr) * 72 + 32 * ks + 8 * fq);
#pragma unroll
        for (int q = 0; q < 2; ++q) { const int nt = (w & 1) * 2 + q; f32x4 s = {0.f, 0.f, 0.f, 0.f};
#pragma unroll
            for (int ks = 0; ks < 2; ++ks) s = mma16(a[ks], *(const LAS bf16x8*)(KIN + (16 * nt + fr) * 72 + 32 * ks + 8 * fq), s);
#pragma unroll
            for (int r = 0; r < 4; ++r) { const int cc = 16 * mt + 4 * fq + r, ss = 16 * nt + fr; ATT[cc * 72 + ss] = f2bf(ss <= cc ? s[r] : 0.f); } }
    }
    __syncthreads();
    {
        const int mt = w >> 1, nt0 = (w & 1) * 4;
        bf16x8 aa[2], ak[2];
#pragma unroll
        for (int ks = 0; ks < 2; ++ks) { aa[ks] = *(const LAS bf16x8*)(ATT + (16 * mt + fr) * 72 + 32 * ks + 8 * fq); ak[ks] = *(const LAS bf16x8*)(KOT + (16 * mt + fr) * 72 + 32 * ks + 8 * fq); }
#pragma unroll
        for (int q = 0; q < 4; ++q) { const int nt = nt0 + q; f32x4 o = {0.f, 0.f, 0.f, 0.f}, kvv = {0.f, 0.f, 0.f, 0.f};
#pragma unroll
            for (int ks = 0; ks < 2; ++ks) { const bf16x8 bv = *(const LAS bf16x8*)(VT + (16 * nt + fr) * 72 + 32 * ks + 8 * fq); o = mma16(bv, aa[ks], o); kvv = mma16(ak[ks], bv, kvv); }
            *(u32x2*)(F.ointra() + (size_t)(t0 + 16 * mt + fr) * 512 + h * 128 + 16 * nt + 4 * fq) = (u32x2){cvt_pk_bf16(o[0], o[1]), cvt_pk_bf16(o[2], o[3])};
            *(u32x2*)(F.kvT() + ((size_t)unit * 128 + 16 * nt + fr) * 64 + 16 * mt + 4 * fq) = (u32x2){cvt_pk_bf16(kvv[0], kvv[1]), cvt_pk_bf16(kvv[2], kvv[3])}; }
    }
    __syncthreads();
}

__device__ __forceinline__ void gla_sscan_item(Frame& F, int item) {
    const int lane = F.lane, idx = item * 64 + lane, d4 = idx & 15, e = (idx >> 4) & 127, bh = idx >> 11;
    const bf16_t* kvp = F.kvT() + ((size_t)(bh * 32) * 128 + e) * 64 + d4 * 4; const float* dcp = F.decay() + (size_t)(bh * 32) * 64 + d4 * 4;
    bf16_t* sp = F.spT() + ((size_t)(bh * 32) * 128 + e) * 64 + d4 * 4;
    f32x4 S = {0.f, 0.f, 0.f, 0.f};
    for (int n0 = 0; n0 < 32; n0 += 8) { f32x4 kv[8], dc[8];
#pragma unroll
        for (int i = 0; i < 8; ++i) { const u32x2 kw = *(const u32x2*)(kvp + (size_t)(n0 + i) * 128 * 64); kv[i] = (f32x4){bflo(kw.x), bfhi(kw.x), bflo(kw.y), bfhi(kw.y)}; dc[i] = *(const f32x4*)(dcp + (size_t)(n0 + i) * 64); }
#pragma unroll
        for (int i = 0; i < 8; ++i) { u32x2 o; o.x = cvt_pk_bf16(S.x, S.y); o.y = cvt_pk_bf16(S.z, S.w); *(u32x2*)(sp + (size_t)(n0 + i) * 128 * 64) = o; S = dc[i] * S + kv[i]; } }
}
__device__ __forceinline__ void sgu_unit(Frame& F, int unit) {
    const int tid = F.tid, w = F.wave, lane = F.lane, fr = lane & 15, fq = lane >> 4, ch = unit >> 2, g = unit & 3, t0 = ch * 128;
    LAS f32x2* stat = (LAS f32x2*)F.lds; LAS bf16_t* vnT = (LAS bf16_t*)(F.lds + 1024);
    if (tid < 128) { const float* sp = (const float*)(F.A->ws + WS_SVS) + (size_t)(t0 + tid) * 16;
        const f32x4 a = *(const f32x4*)sp, b = *(const f32x4*)(sp + 4), c4 = *(const f32x4*)(sp + 8), d = *(const f32x4*)(sp + 12);
        const float s = (a.x + a.z) + (b.x + b.z) + (c4.x + c4.z) + (d.x + d.z), s2 = (a.y + a.w) + (b.y + b.w) + (c4.y + c4.w) + (d.y + d.w);
        const float mean = s * (1.f / 512.f), var = fmaxf(s2 * (1.f / 512.f) - mean * mean, 0.f);
        stat[tid] = (f32x2){mean, rsqrtf(var + EPS)}; }
    __syncthreads();
    { const int s = tid >> 2, c32 = (tid & 3) * 32; const f32x2 ms = stat[s];
#pragma unroll
        for (int q = 0; q < 4; ++q) { float v[8]; unpack8(*(const u32x4*)(F.p() + (size_t)(t0 + s) * PN + PC_SV + g * 128 + c32 + 8 * q), v);
#pragma unroll
            for (int j = 0; j < 8; ++j) { const int cidx = g * 128 + c32 + 8 * q + j; vnT[(c32 + 8 * q + j) * 136 + s] = f2bf((v[j] - ms.x) * ms.y * F.A->in[I_SNG][cidx] + F.A->in[I_SNB][cidx]); } } }
    __syncthreads();
    f32x4 acc[8];
#pragma unroll
    for (int ct = 0; ct < 8; ++ct) acc[ct] = (f32x4){0.f, 0.f, 0.f, 0.f};
    const int nks = (16 * w + 15) / 32 + 1;
    for (int ks = 0; ks < nks; ++ks) { const bf16x8 bw = *(const bf16x8*)(F.sguw() + (size_t)(g * 128 + 16 * w + fr) * 128 + 32 * ks + 8 * fq);
#pragma unroll
        for (int ct = 0; ct < 8; ++ct) acc[ct] = mma16(*(const LAS bf16x8*)(vnT + (16 * ct + fr) * 136 + 32 * ks + 8 * fq), bw, acc[ct]); }
    {
        const int t = 16 * w + fr; const float bias = F.A->in[I_SB][g * 128 + t];
        u32x2 uv[8];
#pragma unroll
        for (int ct = 0; ct < 8; ++ct) uv[ct] = *(const u32x2*)(F.p() + (size_t)(t0 + t) * PN + PC_U + g * 128 + 16 * ct + 4 * fq);
#pragma unroll
        for (int ct = 0; ct < 8; ++ct) { const int cidx = g * 128 + 16 * ct + 4 * fq; const u32x2 uu = uv[ct];
            u32x2 o; o.x = cvt_pk_bf16(bflo(uu.x) * (acc[ct][0] + bias), bfhi(uu.x) * (acc[ct][1] + bias)); o.y = cvt_pk_bf16(bflo(uu.y) * (acc[ct][2] + bias), bfhi(uu.y) * (acc[ct][3] + bias));
            *(u32x2*)(F.oab() + (size_t)(t0 + t) * D + 512 + cidx) = o; } }
    __syncthreads();
}
__device__ __forceinline__ void gla_out_item(Frame& F, int item) {
    const int lane = F.lane, fr = lane & 15, fq = lane >> 4, unit = item >> 2, mt = item & 3;
    const int bh = unit >> 5, n = unit & 31, b = bh >> 2, h = bh & 3; const size_t t = (size_t)b * SEQ + n * 64 + 16 * mt + fr;
    bf16x8 qf[2];
#pragma unroll
    for (int ks = 0; ks < 2; ++ks) qf[ks] = *(const bf16x8*)(F.qin() + t * 256 + h * 64 + 32 * ks + 8 * fq);
    const bf16_t* sp = F.spT() + (size_t)unit * 128 * 64;
    f32x4 o[8]; float ss = 0.f;
#pragma unroll
    for (int et = 0; et < 8; ++et) { const u32x2 ow = *(const u32x2*)(F.ointra() + t * 512 + h * 128 + 16 * et + 4 * fq); f32x4 acc = {bflo(ow.x), bfhi(ow.x), bflo(ow.y), bfhi(ow.y)};
#pragma unroll
        for (int ks = 0; ks < 2; ++ks) acc = mma16(*(const bf16x8*)(sp + (size_t)(16 * et + fr) * 64 + 32 * ks + 8 * fq), qf[ks], acc);
        o[et] = acc; ss += (acc[0] * acc[0] + acc[1] * acc[1]) + (acc[2] * acc[2] + acc[3] * acc[3]); }
    ss += __shfl_xor(ss, 16); ss += __shfl_xor(ss, 32);
    const float rstd = rsqrtf(ss * (1.f / 128.f) + EPS);
    f32x4 gv[8]; u32x2 rv[8];
#pragma unroll
    for (int et = 0; et < 8; ++et) { const int e = h * 128 + 16 * et + 4 * fq; gv[et] = *(const f32x4*)(F.A->in[I_GOUTG] + e); rv[et] = *(const u32x2*)(F.p() + t * PN + PC_R + e); }
#pragma unroll
    for (int et = 0; et < 8; ++et) { const int e = h * 128 + 16 * et + 4 * fq; const f32x4 g = gv[et];
        const u32x2 rr = rv[et]; const float r0 = bflo(rr.x), r1 = bfhi(rr.x), r2 = bflo(rr.y), r3 = bfhi(rr.y);
        u32x2 ov; ov.x = cvt_pk_bf16(o[et][0] * rstd * g.x * r0 * sigmoidf_(r0), o[et][1] * rstd * g.y * r1 * sigmoidf_(r1));
        ov.y = cvt_pk_bf16(o[et][2] * rstd * g.z * r2 * sigmoidf_(r2), o[et][3] * rstd * g.w * r3 * sigmoidf_(r3));
        *(u32x2*)(F.oab() + t * D + e) = ov; }
}

struct ProbSeg {
    static constexpr bool GATHER = false, FP8 = false; static constexpr int WSCALE = FP8_WSCALE;
    int K, lda, ldb, G, c; const bf16_t *oab, *Wpab_t;
    __device__ __forceinline__ bool next(int i, Unit& u) const { const int L = (i >> 1) * G + c; if (L >= 256) return false; pg8::map_tile(L, 64, 4, u.pm, u.pn); u.aux = i & 1; return true; }
    __device__ __forceinline__ const char* a_base(const Unit& u) const { return (const char*)(oab + (size_t)u.pm * 256 * D + u.aux * 512); }
    __device__ __forceinline__ const char* b_base(const Unit& u) const { return (const char*)(Wpab_t + (size_t)u.pn * 256 * D + u.aux * 512); }
    __device__ __forceinline__ unsigned a_off(const Unit&, int row, int C) const { return (unsigned)(row * D + C) * 2u; }
};
struct EpiMix {
    static constexpr bool MID = false;
    const bf16_t* p; bf16_t* mix;
    __device__ __forceinline__ void operator()(const f32x4 (&acc)[2][2][4][2], const Unit& u, int wr, int wc, int fr, int fq) const {
        asm volatile("" : "+v"(fr), "+v"(fq));
        const int row0 = u.pm * 256 + wr * 64 + fr, col0 = u.pn * 256 + wc * 32 + 8 * fq, gc = u.aux ? PC_GB : PC_GA;
#pragma unroll
        for (int ai = 0; ai < 2; ++ai) {
            u32x4 gw[4][2], pw[4][2];
#pragma unroll
            for (int m = 0; m < 4; ++m)
#pragma unroll
                for (int bj = 0; bj < 2; ++bj) { const size_t row = (size_t)(row0 + ai * 128 + m * 16);
                    gw[m][bj] = *(const u32x4*)(p + row * PN + gc + col0 + bj * 128);
                    pw[m][bj] = u.aux ? *(const u32x4*)(mix + row * D + col0 + bj * 128) : (u32x4){0u, 0u, 0u, 0u}; }
#pragma unroll
            for (int m = 0; m < 4; ++m)
#pragma unroll
                for (int bj = 0; bj < 2; ++bj) { const size_t row = (size_t)(row0 + ai * 128 + m * 16); float g[8], pv[8], v[8]; unpack8(gw[m][bj], g); unpack8(pw[m][bj], pv);
#pragma unroll
                    for (int j = 0; j < 4; ++j) { v[j] = acc[ai][bj][m][0][j] * g[j] + pv[j]; v[4 + j] = acc[ai][bj][m][1][j] * g[4 + j] + pv[4 + j]; }
                    *(u32x4*)(mix + row * D + col0 + bj * 128) = pack8(v); } }
    }
};

struct EpiMix2 {
    static constexpr bool MID = true;
    const bf16_t* p; bf16_t* mix;
    __device__ __forceinline__ void mid(f32x4 (&acc)[2][2][4][2], const Unit& u, int wr, int wc, int fr, int fq) const {
        asm volatile("" : "+v"(fr), "+v"(fq));
        const int row0 = u.pm * 256 + wr * 64 + fr, col0 = u.pn * 256 + wc * 32 + 8 * fq;
#pragma unroll
        for (int ai = 0; ai < 2; ++ai) { u32x4 ga[4][2], gb[4][2];
#pragma unroll
            for (int m = 0; m < 4; ++m)
#pragma unroll
                for (int bj = 0; bj < 2; ++bj) { const size_t row = (size_t)(row0 + ai * 128 + m * 16); ga[m][bj] = *(const u32x4*)(p + row * PN + PC_GA + col0 + bj * 128); gb[m][bj] = *(const u32x4*)(p + row * PN + PC_GB + col0 + bj * 128); }
#pragma unroll
            for (int m = 0; m < 4; ++m)
#pragma unroll
                for (int bj = 0; bj < 2; ++bj) { float a[8], b[8]; unpack8(ga[m][bj], a); unpack8(gb[m][bj], b);
#pragma unroll
                    for (int j = 0; j < 4; ++j) { acc[ai][bj][m][0][j] *= a[j] * __builtin_amdgcn_rcpf(fmaxf(b[j], 1e-20f)); acc[ai][bj][m][1][j] *= a[4 + j] * __builtin_amdgcn_rcpf(fmaxf(b[4 + j], 1e-20f)); } } }
    }
    __device__ __forceinline__ void operator()(const f32x4 (&acc)[2][2][4][2], const Unit& u, int wr, int wc, int fr, int fq) const {
        asm volatile("" : "+v"(fr), "+v"(fq));
        const int row0 = u.pm * 256 + wr * 64 + fr, col0 = u.pn * 256 + wc * 32 + 8 * fq;
#pragma unroll
        for (int ai = 0; ai < 2; ++ai) { u32x4 gb[4][2];
#pragma unroll
            for (int m = 0; m < 4; ++m)
#pragma unroll
                for (int bj = 0; bj < 2; ++bj) gb[m][bj] = *(const u32x4*)(p + (size_t)(row0 + ai * 128 + m * 16) * PN + PC_GB + col0 + bj * 128);
#pragma unroll
            for (int m = 0; m < 4; ++m)
#pragma unroll
                for (int bj = 0; bj < 2; ++bj) { float b[8], v[8]; unpack8(gb[m][bj], b);
#pragma unroll
                    for (int j = 0; j < 4; ++j) { v[j] = acc[ai][bj][m][0][j] * fmaxf(b[j], 1e-20f); v[4 + j] = acc[ai][bj][m][1][j] * fmaxf(b[4 + j], 1e-20f); }
                    *(u32x4*)(mix + (size_t)(row0 + ai * 128 + m * 16) * D + col0 + bj * 128) = pack8(v); } }
    }
};

template <bool Q8 = false, int WS_ = FP8_WSCALE> struct ProbStdT {
    static constexpr bool GATHER = false, FP8 = Q8; static constexpr int WSCALE = WS_, EB = Q8 ? 1 : 2;
    int K, lda, ldb, G, c; const void *A, *Bt;
    __device__ __forceinline__ bool next(int i, Unit& u) const { const int L = i * G + c; if (L >= 256) return false; pg8::map_tile(L, 64, 4, u.pm, u.pn); u.aux = 0; return true; }
    __device__ __forceinline__ const char* a_base(const Unit& u) const { return (const char*)A + (size_t)u.pm * 256 * D * EB; }
    __device__ __forceinline__ const char* b_base(const Unit& u) const { return (const char*)Bt + (size_t)u.pn * 256 * D * EB; }
    __device__ __forceinline__ unsigned a_off(const Unit&, int row, int C) const { return (unsigned)(row * D * EB + C * 2); }
};
typedef ProbStdT<false> ProbStd;
template <bool RESF32> struct EpiRes {
    static constexpr bool MID = false;
    const void* res; bf16_t* outb; float* ssq; unsigned char* outq; const float* qgain;
    __device__ __forceinline__ void operator()(const f32x4 (&acc)[2][2][4][2], const Unit& u, int wr, int wc, int fr, int fq) const {
        asm volatile("" : "+v"(fr), "+v"(fq));
        const int row0 = u.pm * 256 + wr * 64 + fr, col0 = u.pn * 256 + wc * 32 + 8 * fq;
#pragma unroll
        for (int ai = 0; ai < 2; ++ai) {
            f32x4 rf[4][2][2]; u32x4 rb[4][2];
#pragma unroll
            for (int m = 0; m < 4; ++m)
#pragma unroll
                for (int bj = 0; bj < 2; ++bj) { const size_t off = (size_t)(row0 + ai * 128 + m * 16) * D + col0 + bj * 128;
                    if (RESF32) { rf[m][bj][0] = *(const f32x4*)((const float*)res + off); rf[m][bj][1] = *(const f32x4*)((const float*)res + off + 4); }
                    else rb[m][bj] = *(const u32x4*)((const bf16_t*)res + off); }
#pragma unroll
            for (int m = 0; m < 4; ++m) { const size_t row = (size_t)(row0 + ai * 128 + m * 16); float sq = 0.f;
#pragma unroll
                for (int bj = 0; bj < 2; ++bj) { float r[8], v[8];
                    if (RESF32) { r[0] = rf[m][bj][0].x; r[1] = rf[m][bj][0].y; r[2] = rf[m][bj][0].z; r[3] = rf[m][bj][0].w; r[4] = rf[m][bj][1].x; r[5] = rf[m][bj][1].y; r[6] = rf[m][bj][1].z; r[7] = rf[m][bj][1].w; }
                    else unpack8(rb[m][bj], r);
#pragma unroll
                    for (int j = 0; j < 4; ++j) { v[j] = acc[ai][bj][m][0][j] + r[j]; v[4 + j] = acc[ai][bj][m][1][j] + r[4 + j]; }
#pragma unroll
                    for (int j = 0; j < 8; ++j) sq += v[j] * v[j];
                    *(u32x4*)(outb + row * D + col0 + bj * 128) = pack8(v);
                    if (qgain) { const f32x4 g0 = *(const f32x4*)(qgain + col0 + bj * 128), g1 = *(const f32x4*)(qgain + col0 + bj * 128 + 4);
                        v[0] *= g0.x; v[1] *= g0.y; v[2] *= g0.z; v[3] *= g0.w; v[4] *= g1.x; v[5] *= g1.y; v[6] *= g1.z; v[7] *= g1.w; }
                    *(u32x2*)(outq + row * D + col0 + bj * 128) = pack8_fp8(v); }
                sq += __shfl_xor(sq, 16); sq += __shfl_xor(sq, 32);
                if (fq == 0) ssq[row * 16 + u.pn * 4 + wc] = sq; } }
    }
};
__device__ __forceinline__ float row_rs(const float* ssq, size_t row) {
    const f32x4 a = *(const f32x4*)(ssq + row * 16), b = *(const f32x4*)(ssq + row * 16 + 4), c = *(const f32x4*)(ssq + row * 16 + 8), d = *(const f32x4*)(ssq + row * 16 + 12);
    const float s = ((a.x + a.y) + (a.z + a.w)) + ((b.x + b.y) + (b.z + b.w)) + ((c.x + c.y) + (c.z + c.w)) + ((d.x + d.y) + (d.z + d.w));
    return rsqrtf(s * (1.f / D) + EPS);
}
struct EpiScale {
    static constexpr bool MID = false;
    const float* ssq; bf16_t* outb;
    __device__ __forceinline__ void operator()(const f32x4 (&acc)[2][2][4][2], const Unit& u, int wr, int wc, int fr, int fq) const {
        asm volatile("" : "+v"(fr), "+v"(fq));
        const int row0 = u.pm * 256 + wr * 64 + fr, col0 = u.pn * 256 + wc * 32 + 8 * fq;
        float rs[2][4];
#pragma unroll
        for (int ai = 0; ai < 2; ++ai)
#pragma unroll
            for (int m = 0; m < 4; ++m) rs[ai][m] = row_rs(ssq, (size_t)(row0 + ai * 128 + m * 16));
#pragma unroll
        for (int ai = 0; ai < 2; ++ai)
#pragma unroll
            for (int m = 0; m < 4; ++m) { const size_t row = (size_t)(row0 + ai * 128 + m * 16);
#pragma unroll
                for (int bj = 0; bj < 2; ++bj) { float v[8];
#pragma unroll
                    for (int j = 0; j < 4; ++j) { v[j] = acc[ai][bj][m][0][j] * rs[ai][m]; v[4 + j] = acc[ai][bj][m][1][j] * rs[ai][m]; }
                    *(u32x4*)(outb + row * D + col0 + bj * 128) = pack8(v); } }
    }
};

__device__ __forceinline__ void attn_unit(Frame& F, int unit) {
    const int tid = F.tid, w = F.wave, lane = F.lane, fr = lane & 15, fq = lane >> 4;
    const int b = unit >> 5, h = (unit >> 3) & 3, qb = unit & 7;
    const size_t tq = (size_t)b * SEQ + qb * 256 + 32 * w;
    LAS unsigned char* const bufs[2] = {F.lds, F.lds + 36864};
    const bf16_t* kg = F.kmem() + (size_t)(b * 256 + (tid >> 1)) * D + h * 256 + (tid & 1) * 32;
    const int kls = (tid >> 1) * 144 + (tid & 1) * 64;
    const bf16_t* vg = F.vt() + (size_t)(h * 256 + (tid >> 3)) * TM + b * 256 + (tid & 7) * 32;
    const int vls = (tid >> 3) * 528 + (tid & 7) * 64;
    u32x4 st[4];
#pragma unroll
    for (int i = 0; i < 4; ++i) st[i] = *(const u32x4*)(kg + 8 * i);
#pragma unroll
    for (int i = 0; i < 4; ++i) *(LAS u32x4*)(bufs[0] + kls + 16 * i) = st[i];
    __syncthreads();
    f32x4 s[16][2];
#pragma unroll
    for (int nt = 0; nt < 16; ++nt) { s[nt][0] = (f32x4){0.f, 0.f, 0.f, 0.f}; s[nt][1] = (f32x4){0.f, 0.f, 0.f, 0.f}; }
#pragma unroll
    for (int c = 0; c < 4; ++c) {
        if (c < 3) {
#pragma unroll
            for (int i = 0; i < 4; ++i) st[i] = *(const u32x4*)(kg + 64 * (c + 1) + 8 * i); }
        else {
#pragma unroll
            for (int i = 0; i < 4; ++i) st[i] = *(const u32x4*)(vg + 8 * i); }
        LAS unsigned char* kb = bufs[c & 1];
        bf16x8 qf[2][2];
#pragma unroll
        for (int qt = 0; qt < 2; ++qt)
#pragma unroll
            for (int ks = 0; ks < 2; ++ks) qf[qt][ks] = *(const bf16x8*)(F.q() + (tq + 16 * qt + fr) * D + h * 256 + 64 * c + 32 * ks + 8 * fq);
#pragma unroll
        for (int nt = 0; nt < 16; ++nt)
#pragma unroll
            for (int ks = 0; ks < 2; ++ks) { const bf16x8 a = *(const LAS bf16x8*)(kb + (16 * nt + fr) * 144 + (32 * ks + 8 * fq) * 2);
                s[nt][0] = mma16(a, qf[0][ks], s[nt][0]); s[nt][1] = mma16(a, qf[1][ks], s[nt][1]); }
        if (c < 3) {
#pragma unroll
            for (int i = 0; i < 4; ++i) *(LAS u32x4*)(bufs[(c + 1) & 1] + kls + 16 * i) = st[i]; }
        __syncthreads();
    }
#pragma unroll
    for (int i = 0; i < 4; ++i) *(LAS u32x4*)(bufs[0] + vls + 16 * i) = st[i];
    float inv[2]; bf16x8 pb[2][8];
#pragma unroll
    for (int qt = 0; qt < 2; ++qt) { float mx = s[0][qt][0];
#pragma unroll
        for (int nt = 0; nt < 16; ++nt)
#pragma unroll
            for (int r = 0; r < 4; ++r) mx = fmaxf(mx, s[nt][qt][r]);
        mx = fmaxf(mx, __shfl_xor(mx, 16)); mx = fmaxf(mx, __shfl_xor(mx, 32));
        float sum = 0.f;
#pragma unroll
        for (int nt = 0; nt < 16; ++nt)
#pragma unroll
            for (int r = 0; r < 4; ++r) { const float e = __expf(s[nt][qt][r] - mx); s[nt][qt][r] = e; sum += e; }
        sum += __shfl_xor(sum, 16); sum += __shfl_xor(sum, 32);
        inv[qt] = __builtin_amdgcn_rcpf(sum);
#pragma unroll
        for (int sk = 0; sk < 8; ++sk) { const float pv[8] = {s[2 * sk][qt][0], s[2 * sk][qt][1], s[2 * sk][qt][2], s[2 * sk][qt][3], s[2 * sk + 1][qt][0], s[2 * sk + 1][qt][1], s[2 * sk + 1][qt][2], s[2 * sk + 1][qt][3]};
            const u32x4 pk = pack8(pv); pb[qt][sk] = __builtin_bit_cast(bf16x8, pk); } }
    __syncthreads();
#pragma unroll
    for (int c = 0; c < 4; ++c) {
        if (c < 3) {
#pragma unroll
            for (int i = 0; i < 4; ++i) st[i] = *(const u32x4*)(vg + (size_t)64 * (c + 1) * TM + 8 * i); }
        LAS unsigned char* vb = bufs[c & 1];
#pragma unroll
        for (int dt = 0; dt < 4; ++dt) { f32x4 o0 = {0.f, 0.f, 0.f, 0.f}, o1 = {0.f, 0.f, 0.f, 0.f};
#pragma unroll
            for (int sk = 0; sk < 8; ++sk) { const LAS unsigned char* vp = vb + (16 * dt + fr) * 528 + (32 * sk + 4 * fq) * 2;
                const u32x2 lo = *(const LAS u32x2*)vp, hi = *(const LAS u32x2*)(vp + 32);
                const u32x4 av = {lo.x, lo.y, hi.x, hi.y}; const bf16x8 a = __builtin_bit_cast(bf16x8, av);
                o0 = mma16(a, pb[0][sk], o0); o1 = mma16(a, pb[1][sk], o1); }
            const int col = h * 256 + 64 * c + 16 * dt + 4 * fq;
            int w0 = 0, w1 = 0;
            w0 = __builtin_amdgcn_cvt_pk_fp8_f32(o0[0] * inv[0], o0[1] * inv[0], w0, false); w0 = __builtin_amdgcn_cvt_pk_fp8_f32(o0[2] * inv[0], o0[3] * inv[0], w0, true);
            w1 = __builtin_amdgcn_cvt_pk_fp8_f32(o1[0] * inv[1], o1[1] * inv[1], w1, false); w1 = __builtin_amdgcn_cvt_pk_fp8_f32(o1[2] * inv[1], o1[3] * inv[1], w1, true);
            *(int*)((unsigned char*)F.ao() + (tq + fr) * D + col) = w0; *(int*)((unsigned char*)F.ao() + (tq + 16 + fr) * D + col) = w1; }
        if (c < 3) {
#pragma unroll
            for (int i = 0; i < 4; ++i) *(LAS u32x4*)(bufs[(c + 1) & 1] + vls + 16 * i) = st[i]; }
        __syncthreads();
    }
}

__device__ __forceinline__ void router_item(Frame& F, int item) {
    const int w = F.wave, lane = F.lane, fr = lane & 15, fq = lane >> 4;
    const size_t t0 = (size_t)item * 16;
    LAS float* lg = (LAS float*)F.lds + w * (16 * 33 + 64);
    LAS int* ex = (LAS int*)(lg + 16 * 33);
    f32x4 acc[2] = {{0.f, 0.f, 0.f, 0.f}, {0.f, 0.f, 0.f, 0.f}};
    for (int k0 = 0; k0 < 32; k0 += 8) { bf16x8 a[8], b0[8], b1[8];
#pragma unroll
        for (int i = 0; i < 8; ++i) { a[i] = *(const bf16x8*)(F.x2b() + (t0 + fr) * D + 32 * (k0 + i) + 8 * fq);
            b0[i] = *(const bf16x8*)(F.Wr_t() + (size_t)fr * D + 32 * (k0 + i) + 8 * fq); b1[i] = *(const bf16x8*)(F.Wr_t() + (size_t)(16 + fr) * D + 32 * (k0 + i) + 8 * fq); }
#pragma unroll
        for (int i = 0; i < 8; ++i) { acc[0] = mma16(a[i], b0[i], acc[0]); acc[1] = mma16(a[i], b1[i], acc[1]); } }
#pragma unroll
    for (int r = 0; r < 4; ++r)
#pragma unroll
        for (int nt = 0; nt < 2; ++nt) lg[(4 * fq + r) * 33 + 16 * nt + fr] = acc[nt][r];
    LDS_WAIT();
    float rs = 0.f, gk[4] = {0.f, 0.f, 0.f, 0.f};
    if (lane < 16) { const size_t t = t0 + lane; rs = row_rs(F.ssq2(), t);
        float v[32];
#pragma unroll
        for (int e = 0; e < 32; ++e) v[e] = lg[lane * 33 + e] * rs + F.A->in[I_BR][e];
        unsigned taken = 0u; float tv[4];
#pragma unroll
        for (int k = 0; k < 4; ++k) { float best = -INFINITY; int bi = 0;
#pragma unroll
            for (int e = 0; e < 32; ++e) { const bool ok = !((taken >> e) & 1u) && (v[e] > best); best = ok ? v[e] : best; bi = ok ? e : bi; }
            taken |= 1u << bi; tv[k] = best; ex[lane * 4 + k] = bi; }
        float sum = 0.f;
#pragma unroll
        for (int k = 0; k < 4; ++k) { gk[k] = __expf(tv[k] - tv[0]); sum += gk[k]; }
        const float inv = 1.f / sum;
        *(f32x4*)(F.gates() + t * 4) = (f32x4){gk[0] * inv, gk[1] * inv, gk[2] * inv, gk[3] * inv}; }
    LDS_WAIT();
    const int me = ex[lane]; const float my_rs = __shfl(rs, lane >> 2);
    int rank = 0, mytot = 0;
#pragma unroll
    for (int e = 0; e < 32; ++e) { const unsigned long long m = __ballot(me == e); const int below = __builtin_popcountll(m & ((1ull << lane) - 1ull));
        rank = (me == e) ? below : rank; mytot = (lane == e) ? __builtin_popcountll(m) : mytot; }
    unsigned base = 0u;
    if (lane < 32 && mytot > 0) base = atomicAdd(F.ctl + CW_CNT + lane, (unsigned)mytot);
    const unsigned slot = (unsigned)__shfl((int)base, me) + (unsigned)rank;
    F.list()[me * ECAP + slot] = (int)(t0 * 4 + lane); F.lscale()[me * ECAP + slot] = my_rs;
    LDS_WAIT();
}

__device__ __forceinline__ void expert_tables(Frame& F) {
    LAS int* tab = (LAS int*)(F.lds + TAB_OFF);
    if (F.tid < 32) tab[F.tid] = (int)__hip_atomic_load(F.ctl + CW_CNT + F.tid, __ATOMIC_RELAXED, __HIP_MEMORY_SCOPE_AGENT);
    __syncthreads();
    if (F.tid == 0) { int s = 0; for (int e = 0; e < 32; ++e) { tab[32 + e] = s; s += (tab[e] + 255) >> 8; } tab[64] = s; }
    __syncthreads();
}
template <int NTN, bool GATH> struct ProbExp {
    static constexpr bool GATHER = GATH, gather = GATH, FP8 = true; static constexpr int WSCALE = FP8_WSCALE;
    int K, lda, ldb, G, c; const LAS int* tab; const unsigned char* A; const unsigned char* Bt; const int* list; mutable int ehint;
    __device__ __forceinline__ bool next(int i, Unit& u) const {
        const int L = i * G + c; if (L >= NTN * tab[64]) return false;
        int e = ehint;
#pragma unroll 1
        while (e < 31 && L >= NTN * tab[32 + e + 1]) ++e;
        ehint = e;
        const int r = L - NTN * tab[32 + e], mte = tab[32 + e + 1] - tab[32 + e];
        u.aux = e; u.pn = r / mte; u.pm = r % mte; return true;
    }
    __device__ __forceinline__ const char* a_base(const Unit& u) const { return gather ? (const char*)A : (const char*)(A + (size_t)(tab[32 + u.aux] + u.pm) * 256 * D); }
    __device__ __forceinline__ const char* b_base(const Unit& u) const { return (const char*)(Bt + ((size_t)u.aux * NTN + u.pn) * 256 * D); }
    __device__ __forceinline__ unsigned a_off(const Unit& u, int row, int C) const {
        if (!gather) return (unsigned)(row * D + C * 2);
        const int slot = u.pm * 256 + row; const int av = list[u.aux * ECAP + slot];
        const int a = slot < tab[u.aux] ? av : 0;
        return (unsigned)((a >> 2) * D + C * 2);
    }
};
struct EpiE1 {
    static constexpr bool MID = false;
    const LAS int* tab; const float* lscale; const float* b1; unsigned char* act;
    __device__ __forceinline__ void operator()(const f32x4 (&acc)[2][2][4][2], const Unit& u, int wr, int wc, int fr, int fq) const {
        asm volatile("" : "+v"(fr), "+v"(fq));
        const int e = u.aux; const size_t rbase = (size_t)(tab[32 + e] + u.pm) * 256;
        const int j0 = u.pn * 128 + wc * 32 + 8 * fq;
        const float* bp = b1 + (size_t)e * 2048 + j0;
        const f32x4 bg0 = *(const f32x4*)bp, bg1 = *(const f32x4*)(bp + 4), bl0 = *(const f32x4*)(bp + 1024), bl1 = *(const f32x4*)(bp + 1028);
        const float bg[8] = {bg0.x, bg0.y, bg0.z, bg0.w, bg1.x, bg1.y, bg1.z, bg1.w}, bl[8] = {bl0.x, bl0.y, bl0.z, bl0.w, bl1.x, bl1.y, bl1.z, bl1.w};
        float sc[2][4];
#pragma unroll
        for (int ai = 0; ai < 2; ++ai)
#pragma unroll
            for (int m = 0; m < 4; ++m) sc[ai][m] = lscale[e * ECAP + u.pm * 256 + ai * 128 + wr * 64 + m * 16 + fr];
#pragma unroll
        for (int ai = 0; ai < 2; ++ai)
#pragma unroll
            for (int m = 0; m < 4; ++m) { const int rt = ai * 128 + wr * 64 + m * 16 + fr; float v[8];
                const f32x2 s2 = {sc[ai][m], sc[ai][m]};
#pragma unroll
                for (int jp = 0; jp < 4; ++jp) {
                    const f32x2 ag = {acc[ai][0][m][jp >> 1][2 * (jp & 1)], acc[ai][0][m][jp >> 1][2 * (jp & 1) + 1]}, al = {acc[ai][1][m][jp >> 1][2 * (jp & 1)], acc[ai][1][m][jp >> 1][2 * (jp & 1) + 1]};
                    const f32x2 bg2 = {bg[2 * jp], bg[2 * jp + 1]}, bl2 = {bl[2 * jp], bl[2 * jp + 1]};
                    const f32x2 ga = ag * s2 + bg2, la = al * s2 + bl2;
                    const f32x2 glu = {fminf(ga.x, 7.0f), fminf(ga.y, 7.0f)}, lin = {fminf(fmaxf(la.x, -7.0f), 7.0f), fminf(fmaxf(la.y, -7.0f), 7.0f)};
                    const f32x2 t = glu * (-1.702f * 1.4426950408889634f);
                    const f32x2 d = (f32x2){__builtin_amdgcn_exp2f(t.x), __builtin_amdgcn_exp2f(t.y)} + 1.0f;
                    const f32x2 r = {__builtin_amdgcn_rcpf(d.x), __builtin_amdgcn_rcpf(d.y)};
                    const f32x2 o = ((lin + 1.0f) * glu) * r;
                    v[2 * jp] = o.x; v[2 * jp + 1] = o.y; }
                *(u32x2*)(act + (rbase + rt) * D + j0) = pack8_fp8(v); }
    }
};
struct EpiE2 {
    static constexpr bool MID = false;
    const LAS int* tab; const int* list; const float* b2; unsigned char* yb; unsigned char* dummy;
    __device__ __forceinline__ void operator()(const f32x4 (&acc)[2][2][4][2], const Unit& u, int wr, int wc, int fr, int fq) const {
        asm volatile("" : "+v"(fr), "+v"(fq));
        const int e = u.aux, cnt = tab[e]; const int col0 = u.pn * 256 + wc * 32 + 8 * fq;
        float bb[2][8];
#pragma unroll
        for (int bj = 0; bj < 2; ++bj) { const f32x4 x0 = *(const f32x4*)(b2 + (size_t)e * D + col0 + bj * 128), x1 = *(const f32x4*)(b2 + (size_t)e * D + col0 + bj * 128 + 4);
            bb[bj][0] = x0.x; bb[bj][1] = x0.y; bb[bj][2] = x0.z; bb[bj][3] = x0.w; bb[bj][4] = x1.x; bb[bj][5] = x1.y; bb[bj][6] = x1.z; bb[bj][7] = x1.w; }
        int aidx[2][4];
#pragma unroll
        for (int ai = 0; ai < 2; ++ai)
#pragma unroll
            for (int m = 0; m < 4; ++m) aidx[ai][m] = list[e * ECAP + u.pm * 256 + ai * 128 + wr * 64 + m * 16 + fr];
#pragma unroll
        for (int ai = 0; ai < 2; ++ai)
#pragma unroll
            for (int m = 0; m < 4; ++m) { const int slot = u.pm * 256 + ai * 128 + wr * 64 + m * 16 + fr;
                unsigned char* rowp = (slot < cnt) ? yb + (size_t)aidx[ai][m] * D : dummy;
#pragma unroll
                for (int bj = 0; bj < 2; ++bj) { float v[8];
#pragma unroll
                    for (int j = 0; j < 4; ++j) { v[j] = acc[ai][bj][m][0][j] + bb[bj][j]; v[4 + j] = acc[ai][bj][m][1][j] + bb[bj][4 + j]; }
                    *(u32x2*)(rowp + col0 + bj * 128) = pack8_fp8(v); } }
    }
};

struct CombTok { u32x4 x[2]; u32x2 y[2][4]; f32x4 g; };
__device__ __forceinline__ void comb_load(Frame& F, int t, int lane, CombTok& c) {
    c.g = *(const f32x4*)(F.gates() + (size_t)t * 4);
#pragma unroll
    for (int hf = 0; hf < 2; ++hf) { const int col = hf * 512 + lane * 8; c.x[hf] = *(const u32x4*)(F.x2b() + (size_t)t * D + col);
#pragma unroll
        for (int k = 0; k < 4; ++k) c.y[hf][k] = *(const u32x2*)((const unsigned char*)F.yb() + ((size_t)t * 4 + k) * D + col); }
}
__device__ __forceinline__ void comb_finish(Frame& F, int t, int lane, const CombTok& c) {
    const float gk[4] = {c.g.x, c.g.y, c.g.z, c.g.w}; float x[2][8]; float ss = 0.f;
#pragma unroll
    for (int hf = 0; hf < 2; ++hf) { unpack8(c.x[hf], x[hf]);
#pragma unroll
        for (int k = 0; k < 4; ++k) { float y[8]; unpack8_fp8(c.y[hf][k], y);
#pragma unroll
            for (int j = 0; j < 8; ++j) x[hf][j] += gk[k] * y[j]; }
#pragma unroll
        for (int j = 0; j < 8; ++j) ss += x[hf][j] * x[hf][j]; }
    const float rs = rsqrtf(wave_sum(ss) * (1.f / D) + EPS);
#pragma unroll
    for (int hf = 0; hf < 2; ++hf) { const int col = hf * 512 + lane * 8; const f32x4 g0 = *(const f32x4*)(F.A->in[I_NFING] + col), g1 = *(const f32x4*)(F.A->in[I_NFING] + col + 4);
        *(f32x4*)(F.A->out + (size_t)t * D + col) = (f32x4){x[hf][0] * rs * g0.x, x[hf][1] * rs * g0.y, x[hf][2] * rs * g0.z, x[hf][3] * rs * g0.w};
        *(f32x4*)(F.A->out + (size_t)t * D + col + 4) = (f32x4){x[hf][4] * rs * g1.x, x[hf][5] * rs * g1.y, x[hf][6] * rs * g1.z, x[hf][7] * rs * g1.w}; }
}
__device__ __forceinline__ void combine_rows(Frame& F) {
    const int gw = F.vcu * 8 + F.wave, NGW = F.G * 8, lane = F.lane;
    if (gw >= T) return;
    CombTok ca, cb; comb_load(F, gw, lane, ca);
    for (int t = gw;;) {
        const bool hb = t + NGW < T; if (hb) comb_load(F, t + NGW, lane, cb);
        comb_finish(F, t, lane, ca); if (!hb) break;
        const bool ha = t + 2 * NGW < T; if (ha) comb_load(F, t + 2 * NGW, lane, ca);
        comb_finish(F, t + NGW, lane, cb); if (!ha) break;
        t += 2 * NGW; }
}

#ifndef DBG_OUT
#define DBG_OUT 0
#endif
#if DBG_OUT
__device__ __forceinline__ void dbg_rows(Frame& F) {
    const int gw = F.vcu * 8 + F.wave, NGW = F.G * 8, lane = F.lane;
    for (int t = gw; t < T; t += NGW) {
#pragma unroll
        for (int hf = 0; hf < 2; ++hf) { const int col = hf * 512 + lane * 8; float x[8];
#pragma unroll
            for (int j = 0; j < 8; ++j) x[j] = 0.f;
            if (DBG_OUT == 1) { for (int m = 0; m < 5; ++m) { if (col + 1024 * m < PN) { float y[8]; unpack8(*(const u32x4*)(F.p() + (size_t)t * PN + col + 1024 * m), y);
#pragma unroll
                for (int j = 0; j < 8; ++j) x[j] += y[j]; } } }
            else if (DBG_OUT == 8) { for (int k = 0; k < 4; ++k) { float y[8]; unpack8_fp8(*(const u32x2*)((const unsigned char*)F.yb() + ((size_t)t * 4 + k) * D + col), y); const float g = F.gates()[t * 4 + k];
#pragma unroll
                for (int j = 0; j < 8; ++j) x[j] += g * y[j]; } }
            else { const bf16_t* B = DBG_OUT == 2 ? F.oab() : DBG_OUT == 3 ? F.mix() : DBG_OUT == 4 ? F.x1b() : DBG_OUT == 5 ? F.q() : DBG_OUT == 6 ? F.ao() : F.x2b();
                unpack8(*(const u32x4*)(B + (size_t)t * D + col), x); }
#pragma unroll
            for (int j = 0; j < 8; ++j) if (!(fabsf(x[j]) < 1e30f)) x[j] = 1e6f;
            *(f32x4*)(F.A->out + (size_t)t * D + col) = (f32x4){x[0], x[1], x[2], x[3]};
            *(f32x4*)(F.A->out + (size_t)t * D + col + 4) = (f32x4){x[4], x[5], x[6], x[7]}; }
    }
}
#endif

__global__ void __launch_bounds__(512, 2) fwd_kernel(Args args) {
    extern __shared__ __attribute__((aligned(16))) unsigned char lds[];
    Frame F;
    F.lds = (LAS unsigned char*)lds; F.MISC = (volatile LAS unsigned*)(F.lds + MISC_OFF);
    F.tid = threadIdx.x; F.lane = F.tid & 63; F.wave = __builtin_amdgcn_readfirstlane(F.tid >> 6);
    F.G = gridDim.x; { const int bx = blockIdx.x; F.vcu = (F.G % 8 == 0) ? (bx % 8) * (F.G / 8) + bx / 8 : bx; }
    F.ctl = (unsigned*)(args.ws + WS_CTL);
    F.A = &args;
    for (int u = F.tid; u < 64; u += 512) ((LAS unsigned*)(F.lds + MISC_OFF))[u] = 0u;
    __syncthreads();
    XcdBarrier bar; bar.bar = F.ctl + CW_BAR; bar.x = 0; bar.st = nullptr;
    if (!MK_PER_PHASE) bar = xcd_barrier_post(F.ctl + CW_BAR, F.MISC + 8);
    const int lo = args.ph_lo, hi = args.ph_hi;
#ifndef PH_MASK
#define PH_MASK 0x3fff
#endif
#define IN(k) (((PH_MASK >> (k)) & 1) && lo <= (k) && (k) < hi)
#ifndef DOUBLE_MASK
#define DOUBLE_MASK 0
#endif
#define REP(k) for (int _rep = 0; _rep < ((((DOUBLE_MASK) >> (k)) & 1) ? 2 : 1); ++_rep, ((((DOUBLE_MASK) >> (k)) & 1) && _rep == 1 ? xcd_barrier(bar) : (void)0))
#define SEAM(k) do { if (IN(k) && IN((k) + 1)) xcd_barrier(bar); } while (0)
    const int c = (int)blockIdx.x;

    if (IN(0)) REP(0) { p0_prologue(F); } SEAM(0);
    if (IN(1)) REP(1) { ProbP1 P{D, D, ProbP1::EB * D, F.G, c, args.ws}; EpiP1 E{args.ws}; pg8::gemm_phase(F.lds, P, E); } SEAM(1);
    if (IN(2)) REP(2) { for (int u = F.vcu; u < 1024; u += F.G) gla_a_unit(F, u); } SEAM(2);
    if (IN(3)) REP(3) { cvt_range(F, CVT_LATE, CVT_EXPERT);
                        if (F.wave < 4) for (int it = F.vcu * 4 + F.wave; it < 1024; it += F.G * 4) gla_sscan_item(F, it);
                        for (int u = F.vcu; u < 512; u += F.G) sgu_unit(F, u); } SEAM(3);
    if (IN(4)) REP(4) { for (int it = F.vcu * 8 + F.wave; it < 4096; it += F.G * 8) gla_out_item(F, it); } SEAM(4);
    if (IN(5)) REP(5) { ProbStd P{D, D, 2 * D, F.G, c, F.oab(), F.Wpab_t()}; EpiMix2 E{F.p(), F.mix()}; pg8::gemm_phase(F.lds, P, E); } SEAM(5);
    if (IN(6)) REP(6) { ProbStd P{D, D, 2 * D, F.G, c, F.mix(), F.Wmo_t()}; EpiRes<true> E{(const void*)F.A->in[I_X], F.x1b(), F.ssq1(), F.x1q(), nullptr}; pg8::gemm_phase(F.lds, P, E); } SEAM(6);
    if (IN(7)) REP(7) { ProbStdT<true, 0x75757575> P{D, D, D, F.G, c, F.x1q(), F.Wq_t()}; EpiScale E{F.ssq1(), F.q()};     pg8::gemm_phase(F.lds, P, E); } SEAM(7);
    if (IN(8)) REP(8) { for (int u = F.vcu; u < 256; u += F.G) attn_unit(F, u); } SEAM(8);
    if (IN(9)) REP(9) { ProbStdT<true> P{D, D, D, F.G, c, F.ao(), F.Wo_t()}; EpiRes<false> E{(const void*)F.x1b(), F.x2b(), F.ssq2(), F.x2q(), F.A->in[I_NFFNG]}; pg8::gemm_phase(F.lds, P, E); } SEAM(9);
    if (IN(10)) REP(10) { for (int it = F.wave * F.G + F.vcu; it < 1024; it += 8 * F.G) router_item(F, it); cvt_expert128(F); } SEAM(10);
    if (IN(11)) REP(11) { expert_tables(F); const LAS int* tab = (const LAS int*)(F.lds + TAB_OFF);
        ProbExp<8, true> P{D, D, D, F.G, F.vcu, tab, F.x2q(), (const unsigned char*)F.W1_t(), F.list(), 0}; EpiE1 E{tab, F.lscale(), F.A->in[I_BE1], (unsigned char*)F.act()}; pg8::gemm_phase(F.lds, P, E); } SEAM(11);
    if (IN(12)) REP(12) { expert_tables(F); const LAS int* tab = (const LAS int*)(F.lds + TAB_OFF);
        ProbExp<4, false> P{D, D, D, F.G, F.vcu, tab, (const unsigned char*)F.act(), (const unsigned char*)F.W2_t(), F.list(), 0}; EpiE2 E{tab, F.list(), F.A->in[I_BE2], (unsigned char*)F.yb(), (unsigned char*)(args.ws + WS_CTL + 512 * 1024)}; pg8::gemm_phase(F.lds, P, E); } SEAM(12);
#if DBG_OUT
    if (lo <= 13 && 13 < hi) { dbg_rows(F); }
#else
    if (IN(13)) REP(13) { combine_rows(F); }
#endif
#undef IN
#undef SEAM
}

extern "C" void kernel_launch(void* const* d_in, const int* in_sizes, int n_in, void* d_out, int out_size, void* d_ws, size_t ws_size, hipStream_t stream) {
    static int grid = 0;
    if (grid == 0) {
        if (n_in != 28 || in_sizes[0] != T * D || out_size != T * D || ws_size < WS_END) { fprintf(stderr, "kernel_launch: unexpected problem (n_in %d, in0 %d, out %d, ws %zu); nothing launched\n", n_in, n_in > 0 ? in_sizes[0] : -1, out_size, ws_size); grid = -1; return; }
        int dev = 0, cus = 0, per_cu = 0;
        if (hipGetDevice(&dev) != hipSuccess || hipDeviceGetAttribute(&cus, hipDeviceAttributeMultiprocessorCount, dev) != hipSuccess) { grid = -1; return; }
        if (hipFuncSetAttribute((const void*)fwd_kernel, hipFuncAttributeMaxDynamicSharedMemorySize, LDS_BYTES) != hipSuccess) { fprintf(stderr, "kernel_launch: hipFuncSetAttribute failed\n"); grid = -1; return; }
        if (hipOccupancyMaxActiveBlocksPerMultiprocessor(&per_cu, (const void*)fwd_kernel, 512, LDS_BYTES) != hipSuccess || per_cu < 1) fprintf(stderr, "kernel_launch: occupancy query reports %d blocks per CU\n", per_cu);
        (void)hipGetLastError();
        grid = cus;
    }
    if (grid < 0) return;
    if (hipMemsetAsync((char*)d_ws + WS_CTL, 0, CTL_ZERO_BYTES, stream) != hipSuccess) { fprintf(stderr, "kernel_launch: memset failed\n"); return; }
    Args a{};
    for (int i = 0; i < 28; ++i) a.in[i] = (const float*)d_in[i];
    a.out = (float*)d_out; a.ws = (unsigned char*)d_ws;
#if MK_PER_PHASE
    for (int ph = 0; ph < NPHASE; ++ph) { a.ph_lo = ph; a.ph_hi = ph + 1; hipLaunchKernelGGL(fwd_kernel, dim3(grid), dim3(512), LDS_BYTES, stream, a); }
#else
    a.ph_lo = 0; a.ph_hi = NPHASE;
    hipLaunchKernelGGL(fwd_kernel, dim3(grid), dim3(512), LDS_BYTES, stream, a);
#endif
}
```

```cpp
#include <hip/hip_runtime.h>
#include <cstdio>
#include <cstdint>

#ifndef P1_FP8
#define P1_FP8 0
#endif
#ifndef MK_PER_PHASE
#define MK_PER_PHASE 0
#endif

#define LAS __attribute__((address_space(3)))
#define GAS __attribute__((address_space(1)))
typedef unsigned short bf16_t;
typedef short bf16x8 __attribute__((ext_vector_type(8)));
typedef float f32x4 __attribute__((ext_vector_type(4)));
typedef float f32x2 __attribute__((ext_vector_type(2)));
typedef unsigned u32x4 __attribute__((ext_vector_type(4)));
typedef unsigned u32x2 __attribute__((ext_vector_type(2)));
typedef int i32x4 __attribute__((ext_vector_type(4)));
typedef int i32x8 __attribute__((ext_vector_type(8)));
#define FP8_WSCALE 0x79797979
constexpr float FP8_WMUL = 64.0f;
typedef GAS unsigned gu32;

constexpr int T = 16384, D = 1024, NBATCH = 8, SEQ = 2048, MEMLEN = 256, TM = NBATCH * MEMLEN;
constexpr int INC = 4624;
constexpr int PN = 4864;
constexpr int PC_Q = 0, PC_K = 256, PC_V = 512, PC_R = 1024, PC_U = 1536, PC_SV = 2048, PC_GA = 2560, PC_GB = 3584, PC_A = 4608;
constexpr int OFF_A = 1536;
constexpr int NE = 32, NASG = T * 4, ECAP = 16384;
constexpr float EPS = 1e-5f;
constexpr int NPHASE = 14;

constexpr size_t MiB = 1u << 20;
constexpr size_t WS_CTL = 0, CTL_ZERO_BYTES = 1 * MiB;
constexpr size_t WS_WR = 1 * MiB, WS_SGUW = 1 * MiB + 256 * 1024, WS_DECAY = 1 * MiB + 512 * 1024;
constexpr size_t WS_WIN = 2 * MiB, WS_WK = 12 * MiB, WS_WV = 14 * MiB, WS_WPAB = 16 * MiB, WS_WMO = 18 * MiB, WS_WQ = 20 * MiB, WS_WO = 22 * MiB;
constexpr size_t WS_SSQ1 = 24 * MiB, WS_SSQ2 = 25 * MiB, WS_LIST = 26 * MiB, WS_LSCALE = 28 * MiB, WS_GATES = 30 * MiB;
constexpr size_t WS_W1 = 32 * MiB, WS_W2 = 160 * MiB, WS_H = 224 * MiB, WS_MEMN = 256 * MiB, WS_KMEM = 260 * MiB, WS_VT = 264 * MiB, WS_QIN = 268 * MiB;
constexpr size_t WS_OINTRA = 276 * MiB, WS_KVT = 308 * MiB, WS_OAB = 340 * MiB, WS_MIX = 372 * MiB, WS_X1B = 404 * MiB, WS_Q = 436 * MiB, WS_AO = 468 * MiB, WS_X2B = 500 * MiB;
constexpr size_t WS_P = 532 * MiB, WS_ACT = 684 * MiB, WS_YB = 828 * MiB, WS_SPT = 956 * MiB, WS_X2Q = 972 * MiB, WS_X1Q = 988 * MiB, WS_SVS = 1004 * MiB, WS_END = 1005 * MiB;
static_assert(WS_P + (size_t)T * PN * 2 <= WS_ACT && WS_ACT + (size_t)(NASG + NE * 256) * 1024 * 2 <= WS_YB && WS_YB + (size_t)NASG * 1024 * 2 <= WS_END, "ws map");
constexpr int CW_CNT = 64;
constexpr int CW_BAR = 4096;

constexpr int RING_BYTES = 131072;
constexpr int TAB_OFF = 139264, MISC_OFF = 141312, LDS_BYTES = 147456;

typedef __bf16 bf16x2_t __attribute__((ext_vector_type(2)));
__device__ __forceinline__ unsigned cvt_pk_bf16(float lo, float hi) { const f32x2 v = {lo, hi}; const bf16x2_t b = __builtin_convertvector(v, bf16x2_t); return __builtin_bit_cast(unsigned, b); }
__device__ __forceinline__ bf16_t f2bf(float f) { return (bf16_t)(cvt_pk_bf16(f, 0.f) & 0xffffu); }
__device__ __forceinline__ float bflo(unsigned w) { return __uint_as_float(w << 16); }
__device__ __forceinline__ float bfhi(unsigned w) { return __uint_as_float(w & 0xffff0000u); }
__device__ __forceinline__ float bf2f(bf16_t v) { return __uint_as_float((unsigned)v << 16); }
__device__ __forceinline__ void unpack8(const u32x4 w, float (&f)[8]) { f[0] = bflo(w.x); f[1] = bfhi(w.x); f[2] = bflo(w.y); f[3] = bfhi(w.y); f[4] = bflo(w.z); f[5] = bfhi(w.z); f[6] = bflo(w.w); f[7] = bfhi(w.w); }
__device__ __forceinline__ u32x4 pack8(const float (&f)[8]) { u32x4 w; w.x = cvt_pk_bf16(f[0], f[1]); w.y = cvt_pk_bf16(f[2], f[3]); w.z = cvt_pk_bf16(f[4], f[5]); w.w = cvt_pk_bf16(f[6], f[7]); return w; }
__device__ __forceinline__ u32x2 pack8_fp8(const float (&f)[8]) { int a = 0, b = 0;
    a = __builtin_amdgcn_cvt_pk_fp8_f32(f[0], f[1], a, false); a = __builtin_amdgcn_cvt_pk_fp8_f32(f[2], f[3], a, true);
    b = __builtin_amdgcn_cvt_pk_fp8_f32(f[4], f[5], b, false); b = __builtin_amdgcn_cvt_pk_fp8_f32(f[6], f[7], b, true);
    return (u32x2){(unsigned)a, (unsigned)b}; }
__device__ __forceinline__ void unpack8_fp8(const u32x2 w, float (&f)[8]) {
    const f32x2 a = __builtin_amdgcn_cvt_pk_f32_fp8((int)w.x, false), b = __builtin_amdgcn_cvt_pk_f32_fp8((int)w.x, true), c = __builtin_amdgcn_cvt_pk_f32_fp8((int)w.y, false), d = __builtin_amdgcn_cvt_pk_f32_fp8((int)w.y, true);
    f[0] = a.x; f[1] = a.y; f[2] = b.x; f[3] = b.y; f[4] = c.x; f[5] = c.y; f[6] = d.x; f[7] = d.y; }
__device__ __forceinline__ f32x4 mma16(bf16x8 a, bf16x8 b, f32x4 c) { return __builtin_amdgcn_mfma_f32_16x16x32_bf16(a, b, c, 0, 0, 0); }
__device__ __forceinline__ float wave_sum(float v) {
#pragma unroll
    for (int o = 1; o < 64; o <<= 1) v += __shfl_xor(v, o);
    return v;
}
__device__ __forceinline__ float sigmoidf_(float x) { return __builtin_amdgcn_rcpf(1.0f + __expf(-x)); }
__device__ __forceinline__ float gelu_erf(float v) {
    const float av = fabsf(v), t = __builtin_amdgcn_rcpf(av * 0.2316418882f + 1.0f);
    float q = t * 0.5307027145f + (-0.7265760135f); q = q * t + 0.7107068705f; q = q * t + (-0.142248368f); q = q * t + 0.127414796f; q = q * t;
    const float e = __builtin_amdgcn_exp2f((v * v) * (-0.72134752044f));
    const float m = v * (q * e);
    return v < 0.f ? m : v - m;
}
__device__ __forceinline__ f32x2 gelu_pk(f32x2 v) {
    const f32x2 av = __builtin_elementwise_abs(v), d = av * 0.2316418882f + 1.0f;
    f32x2 t; t.x = __builtin_amdgcn_rcpf(d.x); t.y = __builtin_amdgcn_rcpf(d.y);
    f32x2 q = t * 0.5307027145f + (-0.7265760135f); q = q * t + 0.7107068705f; q = q * t + (-0.142248368f); q = q * t + 0.127414796f; q = q * t;
    const f32x2 s = (v * v) * (-0.72134752044f);
    f32x2 e; e.x = __builtin_amdgcn_exp2f(s.x); e.y = __builtin_amdgcn_exp2f(s.y);
    const f32x2 m = v * (q * e), r = v - m;
    f32x2 o; o.x = v.x < 0.f ? m.x : r.x; o.y = v.y < 0.f ? m.y : r.y; return o;
}
__device__ __forceinline__ f32x2 sigmoid_pk(f32x2 v) {
    const f32x2 t = v * (-1.4426950408889634f); const f32x2 d = (f32x2){__builtin_amdgcn_exp2f(t.x), __builtin_amdgcn_exp2f(t.y)} + 1.0f;
    return (f32x2){__builtin_amdgcn_rcpf(d.x), __builtin_amdgcn_rcpf(d.y)};
}
#define LDS_WAIT() asm volatile("s_waitcnt lgkmcnt(0)" ::: "memory")
#define VM_WAIT() asm volatile("s_waitcnt vmcnt(0)" ::: "memory")

#define XB_TMO      128
#define XB_XCNT(j)  (256  + 64 * (j))
#define XB_XSUB(j)  (1280 + 64 * (j))
#define XB_XGEN(j)  (2304 + 64 * (j))
#define XB_TOP      3328
#define XB_TOPGEN   3392
#define XCD_BAR_WORDS 3456
#define XB_SPIN_CAP (1u << 22)
__device__ __forceinline__ unsigned xb_ld(unsigned* p)              { return __hip_atomic_load(p, __ATOMIC_RELAXED, __HIP_MEMORY_SCOPE_AGENT); }
__device__ __forceinline__ unsigned xb_add(unsigned* p, unsigned v) { return __hip_atomic_fetch_add(p, v, __ATOMIC_RELAXED, __HIP_MEMORY_SCOPE_AGENT); }
__device__ __forceinline__ unsigned xb_xcc_id() { return (unsigned)__builtin_amdgcn_s_getreg((3 << 11) | 20) & 0xFu; }
#define XB_SPIN(cond, bar) do { unsigned _sp = 0; while (cond) { __builtin_amdgcn_s_sleep(1); \
    if ((++_sp & 255u) == 0u) { if (xb_ld(&(bar)[XB_TMO])) break; if (_sp > XB_SPIN_CAP) { atomicAdd(&(bar)[XB_TMO], 1u); break; } } } } while (0)
struct XcdBarrier { unsigned* bar; unsigned x; volatile LAS unsigned* st; };
__device__ __forceinline__ XcdBarrier xcd_barrier_post(unsigned* bar, volatile LAS unsigned* st) {
    XcdBarrier b; b.bar = bar; b.x = xb_xcc_id(); b.st = st;
    if (threadIdx.x == 0) (void)xb_add(&bar[XB_XCNT(b.x)], 1u);
    return b;
}
__device__ __forceinline__ void xcd_barrier_complete(unsigned* bar, unsigned x, unsigned& nloc, unsigned& nx) {
    const unsigned G = gridDim.x * gridDim.y * gridDim.z;
    unsigned sum, cnt, mine, sp = 0u;
    for (;;) {
        sum = 0u; cnt = 0u; mine = 0u;
#pragma unroll
        for (unsigned j = 0; j < 16; ++j) { const unsigned c = xb_ld(&bar[XB_XCNT(j)]); sum += c; cnt += (c > 0u) ? 1u : 0u; mine = (j == x) ? c : mine; }
        if (sum == G) break;
        __builtin_amdgcn_s_sleep(1);
        if ((++sp & 255u) == 0u) { if (xb_ld(&bar[XB_TMO])) break; if (sp > XB_SPIN_CAP) { atomicAdd(&bar[XB_TMO], 1u); break; } }
    }
    nloc = mine > 0u ? mine : 1u; nx = cnt > 0u ? cnt : 1u;
}
__device__ __forceinline__ void xcd_barrier(const XcdBarrier& b) {
    asm volatile("s_waitcnt vmcnt(0)" ::: "memory");
    __syncthreads();
    if (threadIdx.x == 0) {
        unsigned* bar = b.bar;
        __builtin_amdgcn_s_waitcnt(0);
        unsigned nloc = b.st[0], nx = b.st[1];
        if (nloc == 0u) { xcd_barrier_complete(bar, b.x, nloc, nx); b.st[0] = nloc; b.st[1] = nx; }
        const unsigned old = xb_add(&bar[XB_XSUB(b.x)], 1u);
        const unsigned gen = old / nloc;
        if (old + 1u == (gen + 1u) * nloc) {
            __builtin_amdgcn_fence(__ATOMIC_RELEASE, "agent");
            asm volatile("s_waitcnt vmcnt(0)" ::: "memory");
            const unsigned og = xb_add(&bar[XB_TOP], 1u);
            const unsigned tg = og / nx;
            if (og + 1u == (tg + 1u) * nx) xb_add(&bar[XB_TOPGEN], 1u);
            else XB_SPIN(xb_ld(&bar[XB_TOPGEN]) == tg, bar);
            __builtin_amdgcn_fence(__ATOMIC_ACQUIRE, "agent");
            xb_add(&bar[XB_XGEN(b.x)], 1u);
            asm volatile("s_waitcnt vmcnt(0)" ::: "memory");
        } else {
            __builtin_amdgcn_fence(__ATOMIC_ACQUIRE, "agent");
            XB_SPIN(xb_ld(&bar[XB_XGEN(b.x)]) == gen, bar);
            asm volatile("s_waitcnt vmcnt(0)" ::: "memory");
        }
    }
    __syncthreads();
}

namespace pg8 {
constexpr int BM = 256, BK = 64, HALF = 128, HTB = HALF * BK * 2, NXCD = 8, WGM = 8;
__host__ __device__ __forceinline__ int lds_byte(int r, int c) { const int st = (r >> 4) * 2 + (c >> 5), rr = r & 15, cc = c & 31, ob = rr * 64 + cc * 2; return st * 1024 + (ob ^ (((ob >> 9) & 1) << 5)); }
__host__ __device__ __forceinline__ void stage_rc(int b, int& R, int& C) { const int st = b / 1024, sb = b % 1024, swz = sb ^ (((sb >> 9) & 1) << 5); R = (st >> 1) * 16 + swz / 64; C = (st & 1) * 32 + (swz % 64) / 2; }
__host__ __device__ __forceinline__ int perm32(int rho) { const int n = rho >> 4, i = rho & 15; return 8 * (i >> 2) + 4 * n + (i & 3); }
struct Unit { int pm, pn, aux; };
__device__ __forceinline__ void map_tile(int L, int nM, int nN, int& pm, int& pn) {
    const int nwg = nM * nN; int wgid = L;
    { const int q = nwg / NXCD, r = nwg % NXCD, xcd = wgid % NXCD, off = wgid / NXCD; wgid = (xcd < r ? xcd * (q + 1) : r * (q + 1) + (xcd - r) * q) + off; }
    const int nig = WGM * nN, gid = wgid / nig, fm = gid * WGM, gsz = (nM - fm) < WGM ? (nM - fm) : WGM;
    pm = fm + ((wgid % nig) % gsz); pn = (wgid % nig) / gsz;
}
template <class Epi, class Prob>
__device__ __forceinline__ void gemm_phase(LAS unsigned char* lds, const Prob& P, const Epi& E) {
    const int tid = threadIdx.x, wid = __builtin_amdgcn_readfirstlane(tid >> 6), lane = tid & 63, wr = wid >> 2, wc = wid & 3, fr = lane & 15, fq = lane >> 4;
    const int nt = P.K / (Prob::FP8 ? 128 : BK);
    unsigned voffB[2];
#pragma unroll
    for (int i = 0; i < 2; ++i) { int R_, C_; stage_rc(tid * 16 + i * 8192, R_, C_); const int Rb = (R_ & ~31) + perm32(R_ & 31); voffB[i] = (unsigned)(Rb * P.ldb + C_ * 2); }
#define PG8_AOFF(dst0, dst1, unit) do { _Pragma("unroll") for (int _i = 0; _i < 2; ++_i) { int R_, C_; stage_rc(tid * 16 + _i * 8192, R_, C_); dst0[_i] = P.a_off(unit, R_, C_); dst1[_i] = P.a_off(unit, R_ + HALF, C_); } } while (0)
    const size_t kstep = (size_t)(BK * 2);
    const size_t hstepB = (size_t)HALF * P.ldb;
    const unsigned ldsw = (unsigned)wid * 1024u;
    const int aoff = lds_byte(wr * 64 + fr, fq * 8), boff = lds_byte(wc * 32 + fr, fq * 8);
#define PG8_SA(b, h) (((b) * 2 + (h)) * HTB)
#define PG8_SB(b, h) ((4 + (b) * 2 + (h)) * HTB)
#define PG8_STAGE(bufoff, gbase, voff) do { _Pragma("unroll") for (int _i = 0; _i < 2; ++_i) \
        __builtin_amdgcn_global_load_lds((const unsigned*)((const char*)(gbase) + (voff)[_i]), (LAS unsigned*)(lds + (bufoff) + ldsw + _i * 8192), 16, 0, 0); } while (0)
#define PG8_LD8(addr) __builtin_shufflevector(*(const LAS i32x4*)(addr), *(const LAS i32x4*)((addr) + 1024), 0, 1, 2, 3, 4, 5, 6, 7)
#define PG8_LDA(dst, b, h) do { _Pragma("unroll") for (int m = 0; m < 4; ++m) dst[m] = PG8_LD8(lds + PG8_SA(b, h) + aoff + m * 2048); } while (0)
#define PG8_LDB(dst, b, h) do { _Pragma("unroll") for (int n = 0; n < 2; ++n) dst[n] = PG8_LD8(lds + PG8_SB(b, h) + boff + n * 2048); } while (0)
#define PG8_LO(x) __builtin_bit_cast(bf16x8, __builtin_shufflevector(x, x, 0, 1, 2, 3))
#define PG8_HI(x) __builtin_bit_cast(bf16x8, __builtin_shufflevector(x, x, 4, 5, 6, 7))
#define PG8_MMA(ai, bj, At, Bt) do { __builtin_amdgcn_s_setprio(1); _Pragma("unroll") for (int m = 0; m < 4; ++m) _Pragma("unroll") for (int n = 0; n < 2; ++n) { \
        if constexpr (Prob::FP8) asm volatile("v_mfma_scale_f32_16x16x128_f8f6f4 %0, %1, %2, %0, %3, %4 op_sel_hi:[0,0,0]" : "+v"(acc[ai][bj][m][n]) : "v"(Bt[n]), "v"(At[m]), "v"(scl_w), "v"(scl_1)); \
        else { acc[ai][bj][m][n] = __builtin_amdgcn_mfma_f32_16x16x32_bf16(PG8_LO(Bt[n]), PG8_LO(At[m]), acc[ai][bj][m][n], 0, 0, 0); \
               acc[ai][bj][m][n] = __builtin_amdgcn_mfma_f32_16x16x32_bf16(PG8_HI(Bt[n]), PG8_HI(At[m]), acc[ai][bj][m][n], 0, 0, 0); } } \
        __builtin_amdgcn_s_setprio(0); } while (0)
#define PG8_WAIT_V(n) asm volatile("s_waitcnt vmcnt(" #n ")" ::: "memory")
#define PG8_WAIT_L(n) asm volatile("s_waitcnt lgkmcnt(" #n ")" ::: "memory")
#define PG8_BAR __builtin_amdgcn_s_barrier()
#define PG8_SCHED __builtin_amdgcn_sched_barrier(0)
    Unit cur, nxt; int ui = 0;
    if (!P.next(0, cur)) return;
    f32x4 acc[2][2][4][2];
#pragma unroll
    for (int a = 0; a < 2; ++a)
#pragma unroll
        for (int b = 0; b < 2; ++b)
#pragma unroll
            for (int m = 0; m < 4; ++m)
#pragma unroll
                for (int n = 0; n < 2; ++n) acc[a][b][m][n] = (f32x4){0.f, 0.f, 0.f, 0.f};
    i32x8 At[4], B0[2], B1[2];
    int scl_w = Prob::WSCALE, scl_1 = 0x7f7f7f7f; asm volatile("" : "+v"(scl_w), "+v"(scl_1));
    unsigned cO0[2], cO1[2], nO0[2], nO1[2];
    PG8_AOFF(cO0, cO1, cur);
    const char* cA = P.a_base(cur); const char* cB = P.b_base(cur);
    PG8_STAGE(PG8_SB(0, 0), cB, voffB); PG8_STAGE(PG8_SB(0, 1), cB + hstepB, voffB); PG8_STAGE(PG8_SA(0, 0), cA, cO0); PG8_STAGE(PG8_SA(0, 1), cA, cO1);
    if (wr == 1) PG8_BAR;
    PG8_WAIT_V(2); PG8_BAR;
    PG8_STAGE(PG8_SB(1, 0), cB + kstep, voffB); PG8_STAGE(PG8_SA(1, 0), cA + kstep, cO0); PG8_STAGE(PG8_SB(1, 1), cB + hstepB + kstep, voffB);
    PG8_WAIT_V(6); PG8_BAR;
    for (;;) {
        const bool has_next = P.next(ui + 1, nxt);
        const char* nA = cA; const char* nB = cB;
        if constexpr (Prob::GATHER) {
#pragma unroll
            for (int i = 0; i < 2; ++i) { nO0[i] = cO0[i]; nO1[i] = cO1[i]; } }
        if (has_next) { nA = P.a_base(nxt); nB = P.b_base(nxt); if constexpr (Prob::GATHER) PG8_AOFF(nO0, nO1, nxt); }
        for (int t = 0; t < nt; t += 2) {
            const bool last = (t == nt - 2);
            const char* a1 = cA + (size_t)(t + 1) * kstep;
            const char* a2 = last ? nA : cA + (size_t)(t + 2) * kstep; const char* b2 = last ? nB : cB + (size_t)(t + 2) * kstep;
            const char* a3 = a2 + kstep; const char* b3 = b2 + kstep;
            unsigned o20[2], o21[2];
#pragma unroll
            for (int i = 0; i < 2; ++i) { if constexpr (Prob::GATHER) { o20[i] = last ? nO0[i] : cO0[i]; o21[i] = last ? nO1[i] : cO1[i]; } else { o20[i] = cO0[i]; o21[i] = cO1[i]; } }
            PG8_LDB(B0, 0, 0); PG8_LDB(B1, 0, 1); PG8_SCHED; PG8_LDA(At, 0, 0); PG8_STAGE(PG8_SA(1, 1), a1, cO1);
            PG8_WAIT_V(8); PG8_WAIT_L(0); PG8_BAR; PG8_MMA(0, 0, At, B0); PG8_MMA(0, 1, At, B1); PG8_BAR; PG8_SCHED;
            PG8_LDA(At, 0, 1); PG8_STAGE(PG8_SB(0, 0), b2, voffB); PG8_STAGE(PG8_SB(0, 1), b2 + hstepB, voffB); PG8_STAGE(PG8_SA(0, 0), a2, o20);
            PG8_WAIT_V(8); PG8_WAIT_L(0); PG8_BAR; PG8_MMA(1, 0, At, B0); PG8_MMA(1, 1, At, B1); PG8_BAR; PG8_SCHED;
            PG8_LDB(B0, 1, 0); PG8_LDB(B1, 1, 1); PG8_SCHED; PG8_LDA(At, 1, 0); PG8_STAGE(PG8_SA(0, 1), a2, o21);
            PG8_WAIT_V(8); PG8_WAIT_L(0); PG8_BAR; PG8_MMA(0, 0, At, B0); PG8_MMA(0, 1, At, B1); PG8_BAR; PG8_SCHED;
            PG8_LDA(At, 1, 1); PG8_STAGE(PG8_SB(1, 0), b3, voffB); PG8_STAGE(PG8_SB(1, 1), b3 + hstepB, voffB); PG8_STAGE(PG8_SA(1, 0), a3, o20);
            PG8_WAIT_V(8); PG8_WAIT_L(0); PG8_BAR; PG8_MMA(1, 0, At, B0); PG8_MMA(1, 1, At, B1); PG8_BAR; PG8_SCHED;
            if constexpr (Epi::MID) { if (t + 2 == nt / 2) E.mid(acc, cur, wr, wc, fr, fq); }
        }
        if (wr == 0) PG8_BAR;
        if constexpr (Prob::FP8) asm volatile("s_nop 15\n\ts_nop 15" ::: "memory");
        E(acc, cur, wr, wc, fr, fq);
        if (!has_next) break;
#pragma unroll
        for (int a = 0; a < 2; ++a)
#pragma unroll
            for (int b = 0; b < 2; ++b)
#pragma unroll
                for (int m = 0; m < 4; ++m)
#pragma unroll
                    for (int n = 0; n < 2; ++n) acc[a][b][m][n] = (f32x4){0.f, 0.f, 0.f, 0.f};
        cur = nxt; cA = nA; cB = nB; ++ui;
        if constexpr (Prob::GATHER) {
#pragma unroll
            for (int i = 0; i < 2; ++i) { cO0[i] = nO0[i]; cO1[i] = nO1[i]; } }
        if (wr == 1) PG8_BAR;
    }
    PG8_WAIT_V(0);
    PG8_BAR;
#undef PG8_AOFF
#undef PG8_SA
#undef PG8_SB
#undef PG8_STAGE
#undef PG8_LDA
#undef PG8_LD8
#undef PG8_LO
#undef PG8_HI
#undef PG8_LDB
#undef PG8_MMA
#undef PG8_WAIT_V
#undef PG8_WAIT_L
#undef PG8_BAR
#undef PG8_SCHED
}
}
using pg8::Unit;

struct Args { const float* in[28]; float* out; unsigned char* ws; int ph_lo, ph_hi; };
struct Frame {
    LAS unsigned char* lds;
    volatile LAS unsigned* MISC;
    unsigned* ctl;
    int tid, lane, wave, vcu, G;
    const Args* A;
    __device__ __forceinline__ bf16_t* Win_t() const { return (bf16_t*)(A->ws + WS_WIN); }
    __device__ __forceinline__ bf16_t* Wk_t() const { return (bf16_t*)(A->ws + WS_WK); }
    __device__ __forceinline__ bf16_t* Wv_t() const { return (bf16_t*)(A->ws + WS_WV); }
    __device__ __forceinline__ bf16_t* Wpab_t() const { return (bf16_t*)(A->ws + WS_WPAB); }
    __device__ __forceinline__ bf16_t* Wmo_t() const { return (bf16_t*)(A->ws + WS_WMO); }
    __device__ __forceinline__ bf16_t* Wq_t() const { return (bf16_t*)(A->ws + WS_WQ); }
    __device__ __forceinline__ bf16_t* Wo_t() const { return (bf16_t*)(A->ws + WS_WO); }
    __device__ __forceinline__ bf16_t* Wr_t() const { return (bf16_t*)(A->ws + WS_WR); }
    __device__ __forceinline__ bf16_t* W1_t() const { return (bf16_t*)(A->ws + WS_W1); }
    __device__ __forceinline__ bf16_t* W2_t() const { return (bf16_t*)(A->ws + WS_W2); }
    __device__ __forceinline__ bf16_t* sguw() const { return (bf16_t*)(A->ws + WS_SGUW); }
    __device__ __forceinline__ bf16_t* h() const { return (bf16_t*)(A->ws + WS_H); }
    __device__ __forceinline__ bf16_t* memn() const { return (bf16_t*)(A->ws + WS_MEMN); }
    __device__ __forceinline__ bf16_t* kmem() const { return (bf16_t*)(A->ws + WS_KMEM); }
    __device__ __forceinline__ bf16_t* vt() const { return (bf16_t*)(A->ws + WS_VT); }
    __device__ __forceinline__ bf16_t* qin() const { return (bf16_t*)(A->ws + WS_QIN); }
    __device__ __forceinline__ bf16_t* oab() const { return (bf16_t*)(A->ws + WS_OAB); }
    __device__ __forceinline__ bf16_t* mix() const { return (bf16_t*)(A->ws + WS_MIX); }
    __device__ __forceinline__ bf16_t* x1b() const { return (bf16_t*)(A->ws + WS_X1B); }
    __device__ __forceinline__ bf16_t* q() const { return (bf16_t*)(A->ws + WS_Q); }
    __device__ __forceinline__ bf16_t* ao() const { return (bf16_t*)(A->ws + WS_AO); }
    __device__ __forceinline__ bf16_t* x2b() const { return (bf16_t*)(A->ws + WS_X2B); }
    __device__ __forceinline__ bf16_t* p() const { return (bf16_t*)(A->ws + WS_P); }
    __device__ __forceinline__ bf16_t* act() const { return (bf16_t*)(A->ws + WS_ACT); }
    __device__ __forceinline__ bf16_t* yb() const { return (bf16_t*)(A->ws + WS_YB); }
    __device__ __forceinline__ bf16_t* ointra() const { return (bf16_t*)(A->ws + WS_OINTRA); }
    __device__ __forceinline__ bf16_t* kvT() const { return (bf16_t*)(A->ws + WS_KVT); }
    __device__ __forceinline__ float* decay() const { return (float*)(A->ws + WS_DECAY); }
    __device__ __forceinline__ float* ssq1() const { return (float*)(A->ws + WS_SSQ1); }
    __device__ __forceinline__ float* ssq2() const { return (float*)(A->ws + WS_SSQ2); }
    __device__ __forceinline__ float* lscale() const { return (float*)(A->ws + WS_LSCALE); }
    __device__ __forceinline__ float* gates() const { return (float*)(A->ws + WS_GATES); }
    __device__ __forceinline__ int* list() const { return (int*)(A->ws + WS_LIST); }
    __device__ __forceinline__ bf16_t* spT() const { return (bf16_t*)(A->ws + WS_SPT); }
    __device__ __forceinline__ unsigned char* x2q() const { return (unsigned char*)(A->ws + WS_X2Q); }
    __device__ __forceinline__ unsigned char* x1q() const { return (unsigned char*)(A->ws + WS_X1Q); }
};
enum { I_X = 0, I_MEM, I_NMIXG, I_WIN, I_WA2, I_BA, I_GOUTG, I_SNG, I_SNB, I_SW, I_SB, I_WPA, I_WPB, I_WMO, I_NXG, I_NMEMG, I_WXQ, I_WXK, I_WXV, I_WXO, I_NFFNG, I_WR, I_BR, I_WE1, I_BE1, I_WE2, I_BE2, I_NFING };

struct CvtItem { const float* src; size_t ldw; unsigned char* dst; const float* kscale; float mul; int fp8; };
__device__ __forceinline__ void cvt_load(const CvtItem& c, float (&v)[64]) {
#pragma unroll
    for (int i = 0; i < 64; ++i) v[i] = __builtin_nontemporal_load(c.src + (size_t)i * c.ldw);
}
__device__ __forceinline__ void cvt_finish(const CvtItem& c, float (&v)[64]) {
    if (c.kscale) {
#pragma unroll
        for (int i = 0; i < 64; ++i) v[i] *= c.kscale[i] * c.mul; }
    else {
#pragma unroll
        for (int i = 0; i < 64; ++i) v[i] *= c.mul; }
    if (c.fp8) {
#pragma unroll
        for (int q = 0; q < 4; ++q) { const float f0[8] = {v[16 * q], v[16 * q + 1], v[16 * q + 2], v[16 * q + 3], v[16 * q + 4], v[16 * q + 5], v[16 * q + 6], v[16 * q + 7]};
            const float f1[8] = {v[16 * q + 8], v[16 * q + 9], v[16 * q + 10], v[16 * q + 11], v[16 * q + 12], v[16 * q + 13], v[16 * q + 14], v[16 * q + 15]};
            const u32x2 lo = pack8_fp8(f0), hi = pack8_fp8(f1); *(u32x4*)(c.dst + 16 * q) = (u32x4){lo.x, lo.y, hi.x, hi.y}; } }
    else {
#pragma unroll
        for (int q = 0; q < 8; ++q) { const float f[8] = {v[8 * q], v[8 * q + 1], v[8 * q + 2], v[8 * q + 3], v[8 * q + 4], v[8 * q + 5], v[8 * q + 6], v[8 * q + 7]}; *(u32x4*)(c.dst + 16 * q) = pack8(f); } }
}
__device__ __forceinline__ CvtItem cvt_desc(const float* W, int ldw, int src_col0, int k0, void* WT, int ldt, int dst_row0, int dst_k0, const float* kscale, float mul, int fp8, int lane) {
    CvtItem c; const int eb = fp8 ? 1 : 2;
    c.src = W + (size_t)k0 * ldw + src_col0 + lane; c.ldw = (size_t)ldw; c.dst = (unsigned char*)WT + ((size_t)(dst_row0 + lane) * ldt + dst_k0 + k0) * eb;
    c.kscale = kscale ? kscale + k0 : nullptr; c.mul = mul; c.fp8 = fp8; return c;
}
__device__ __forceinline__ void cvt_expert128(Frame& F) {
    const int gw = F.vcu * 8 + F.wave, NGW = F.G * 8, lane = F.lane;
    constexpr int I1 = NE * 8 * 32, I2 = NE * 8 * 16;
    for (int it = gw; it < I1 + I2; it += NGW) {
        const float* src; size_t ldw; unsigned char* dst; const float* ks; (void)ks;
        if (it < I1) { const int e = it >> 8, q = it & 255, kb = q >> 5, nb = q & 31, nd = nb * 64; const int sc = ((nd & 128) ? 1024 : 0) + 128 * (nd >> 8) + (nd & 127);
            src = F.A->in[I_WE1] + (size_t)e * D * 2048 + (size_t)(kb * 128) * 2048 + sc + lane; ldw = 2048;
            dst = (unsigned char*)F.W1_t() + (size_t)e * 2048 * D + (size_t)(nd + lane) * D + kb * 128; ks = nullptr; }
        else { const int r = it - I1, e = r >> 7, q = r & 127, kb = q >> 4, nb = q & 15;
            src = F.A->in[I_WE2] + (size_t)e * D * D + (size_t)(kb * 128) * D + nb * 64 + lane; ldw = D;
            dst = (unsigned char*)F.W2_t() + (size_t)e * D * D + (size_t)(nb * 64 + lane) * D + kb * 128; ks = nullptr; }
        float v[128]; const float* pp = src;
#pragma unroll
        for (int i = 0; i < 128; ++i) { v[i] = __builtin_nontemporal_load(pp); pp += ldw; asm volatile("" : "+v"(pp)); }
#pragma unroll
        for (int i = 0; i < 128; ++i) v[i] *= FP8_WMUL;
#pragma unroll
        for (int q = 0; q < 8; ++q) { const float f0[8] = {v[16 * q], v[16 * q + 1], v[16 * q + 2], v[16 * q + 3], v[16 * q + 4], v[16 * q + 5], v[16 * q + 6], v[16 * q + 7]};
            const float f1[8] = {v[16 * q + 8], v[16 * q + 9], v[16 * q + 10], v[16 * q + 11], v[16 * q + 12], v[16 * q + 13], v[16 * q + 14], v[16 * q + 15]};
            const u32x2 lo = pack8_fp8(f0), hi = pack8_fp8(f1); *(u32x4*)(dst + 16 * q) = (u32x4){lo.x, lo.y, hi.x, hi.y}; }
    }
}
template <bool Q8>
__device__ __forceinline__ void rms_row_to_bf16(const float* xrow, const float* g, bf16_t* orow, int lane) {
    f32x4 v[4]; float s = 0.f;
#pragma unroll
    for (int j = 0; j < 4; ++j) { v[j] = *(const f32x4*)(xrow + 256 * j + 4 * lane); s += (v[j].x * v[j].x + v[j].y * v[j].y) + (v[j].z * v[j].z + v[j].w * v[j].w); }
    const float rs = rsqrtf(wave_sum(s) * (1.f / D) + EPS);
#pragma unroll
    for (int j = 0; j < 4; ++j) { const f32x4 gg = *(const f32x4*)(g + 256 * j + 4 * lane);
        if constexpr (Q8) { int w = 0; w = __builtin_amdgcn_cvt_pk_fp8_f32(v[j].x * rs * gg.x, v[j].y * rs * gg.y, w, false); w = __builtin_amdgcn_cvt_pk_fp8_f32(v[j].z * rs * gg.z, v[j].w * rs * gg.w, w, true);
            *(int*)((unsigned char*)orow + 256 * j + 4 * lane) = w; }
        else { u32x2 o; o.x = cvt_pk_bf16(v[j].x * rs * gg.x, v[j].y * rs * gg.y); o.y = cvt_pk_bf16(v[j].z * rs * gg.z, v[j].w * rs * gg.w);
            *(u32x2*)(orow + 256 * j + 4 * lane) = o; } }
}
__device__ __forceinline__ void cvt_range(Frame& F, int ibeg, int iend) {
    const int gw = F.vcu * 8 + F.wave, NGW = F.G * 8, lane = F.lane;
    constexpr int N_WIN = 16 * 72, N_SQ = 256, N_PA = 8 * 16, N_E1 = 512, N_E2 = 256;
    constexpr int S_WIN = 0, S_WK = S_WIN + N_WIN, S_WV = S_WK + N_SQ, S_PA = S_WV + N_SQ, S_PB = S_PA + N_PA, S_MO = S_PB + N_PA, S_Q = S_MO + N_SQ, S_O = S_Q + N_SQ, S_E1 = S_O + N_SQ, S_E2 = S_E1 + NE * N_E1, S_END = S_E2 + NE * N_E2;
    static_assert(S_E1 == 16 * 72 + 256 * 2 + 8 * 16 * 2 + 256 * 3 && S_END == S_E1 + NE * 512 + NE * 256, "item ranges");
    const int IEND = iend < S_END ? iend : S_END;
    auto desc = [&](int it) -> CvtItem {
        if (it < S_WK) { const int r = it - S_WIN, kb = r / 72, nb = r % 72, n0 = nb * 64; return cvt_desc(F.A->in[I_WIN], INC, n0 < 1536 ? n0 : n0 + 16, kb * 64, F.Win_t(), D, n0, 0, nullptr, P1_FP8 ? FP8_WMUL : 1.f, P1_FP8, lane); }
        if (it < S_WV) { const int r = it - S_WK; return cvt_desc(F.A->in[I_WXK], D, (r & 15) * 64, (r >> 4) * 64, F.Wk_t(), D, (r & 15) * 64, 0, nullptr, P1_FP8 ? FP8_WMUL : 1.f, P1_FP8, lane); }
        if (it < S_PA) { const int r = it - S_WV; return cvt_desc(F.A->in[I_WXV], D, (r & 15) * 64, (r >> 4) * 64, F.Wv_t(), D, (r & 15) * 64, 0, nullptr, P1_FP8 ? FP8_WMUL : 1.f, P1_FP8, lane); }
        if (it < S_PB) { const int r = it - S_PA; return cvt_desc(F.A->in[I_WPA], D, (r & 15) * 64, (r >> 4) * 64, F.Wpab_t(), D, (r & 15) * 64, 0, nullptr, 1.f, 0, lane); }
        if (it < S_MO) { const int r = it - S_PB; return cvt_desc(F.A->in[I_WPB], D, (r & 15) * 64, (r >> 4) * 64, F.Wpab_t(), D, (r & 15) * 64, 512, nullptr, 1.f, 0, lane); }
        if (it < S_Q)  { const int r = it - S_MO; return cvt_desc(F.A->in[I_WMO], D, (r & 15) * 64, (r >> 4) * 64, F.Wmo_t(), D, (r & 15) * 64, 0, nullptr, 1.f, 0, lane); }
        if (it < S_O)  { const int r = it - S_Q;  return cvt_desc(F.A->in[I_WXQ], D, (r & 15) * 64, (r >> 4) * 64, F.Wq_t(), D, (r & 15) * 64, 0, F.A->in[I_NXG], FP8_WMUL, 1, lane); }
        if (it < S_E1) { const int r = it - S_O;  return cvt_desc(F.A->in[I_WXO], D, (r & 15) * 64, (r >> 4) * 64, F.Wo_t(), D, (r & 15) * 64, 0, nullptr, FP8_WMUL, 1, lane); }
        if (it < S_E2) { const int r = it - S_E1, e = r / N_E1, q = r % N_E1, kb = q >> 5, nb = q & 31, nd = nb * 64;
            const int src = ((nd & 128) ? 1024 : 0) + 128 * (nd >> 8) + (nd & 127);
            return cvt_desc(F.A->in[I_WE1] + (size_t)e * D * 2048, 2048, src, kb * 64, (unsigned char*)F.W1_t() + (size_t)e * 2048 * D, D, nd, 0, F.A->in[I_NFFNG], FP8_WMUL, 1, lane); }
        const int r = it - S_E2, e = r / N_E2, q = r % N_E2;
        return cvt_desc(F.A->in[I_WE2] + (size_t)e * D * D, D, (q & 15) * 64, (q >> 4) * 64, (unsigned char*)F.W2_t() + (size_t)e * D * D, D, (q & 15) * 64, 0, nullptr, FP8_WMUL, 1, lane); };
    if (ibeg + gw < IEND) {
        float va[64], vb[64]; CvtItem ca = desc(ibeg + gw), cb = ca; cvt_load(ca, va);
        for (int it = ibeg + gw;;) {
            const bool hb = it + NGW < IEND; if (hb) { cb = desc(it + NGW); cvt_load(cb, vb); }
            cvt_finish(ca, va); if (!hb) break;
            const bool ha = it + 2 * NGW < IEND; if (ha) { ca = desc(it + 2 * NGW); cvt_load(ca, va); }
            cvt_finish(cb, vb); if (!ha) break;
            it += 2 * NGW; }
    }
}
constexpr int CVT_LATE = 16 * 72 + 256 * 2, CVT_EXPERT = 16 * 72 + 256 * 2 + 8 * 16 * 2 + 256 * 3, CVT_END = CVT_EXPERT + NE * 512 + NE * 256;
__device__ __forceinline__ void p0_prologue(Frame& F) {
    const int gw = F.vcu * 8 + F.wave, NGW = F.G * 8, lane = F.lane;
    cvt_range(F, 0, CVT_LATE);
    for (int m = gw; m < T; m += NGW) rms_row_to_bf16<P1_FP8 != 0>(F.A->in[I_X] + (size_t)m * D, F.A->in[I_NMIXG], (bf16_t*)((unsigned char*)F.h() + (size_t)m * D * (P1_FP8 ? 1 : 2)), lane);
    for (int m = gw; m < TM; m += NGW) rms_row_to_bf16<P1_FP8 != 0>(F.A->in[I_MEM] + (size_t)m * D, F.A->in[I_NMEMG], (bf16_t*)((unsigned char*)F.memn() + (size_t)m * D * (P1_FP8 ? 1 : 2)), lane);
    const int gt = F.vcu * 512 + F.tid, NGT = F.G * 512;
    for (int i = gt; i < 256 * D; i += NGT) { const int j = i >> 10, k = i & 1023; const float* wr_ = F.A->in[I_WIN] + (size_t)k * INC + OFF_A; float s = 0.f;
#pragma unroll
        for (int r = 0; r < 16; ++r) s += wr_[r] * F.A->in[I_WA2][r * 256 + j];
        if (P1_FP8) { int w = __builtin_amdgcn_cvt_pk_fp8_f32(s * FP8_WMUL, 0.f, 0, false); ((unsigned char*)F.Win_t())[(size_t)(PC_A + j) * D + k] = (unsigned char)(w & 0xff); }
        else F.Win_t()[(size_t)(PC_A + j) * D + k] = f2bf(s); }
    for (int i = gt; i < NE * D; i += NGT) { const int e = i >> 10, k = i & 1023; F.Wr_t()[i] = f2bf(F.A->in[I_WR][k * NE + e] * F.A->in[I_NFFNG][k]); }
    for (int i = gt; i < 4 * 128 * 128; i += NGT) { const int t = (i >> 7) & 127, s = i & 127; F.sguw()[i] = f2bf(s <= t ? F.A->in[I_SW][i] : 0.f); }
}

struct ProbP1 {
    static constexpr bool GATHER = false, FP8 = (P1_FP8 != 0); static constexpr int EB = P1_FP8 ? 1 : 2, WSCALE = FP8_WSCALE;
    int K, lda, ldb, G, c; const unsigned char* ws;
    __device__ __forceinline__ bool next(int i, Unit& u) const {
        const int L = i * G + c;
        if (L < 1216) { u.aux = 0; pg8::map_tile(L, 64, 19, u.pm, u.pn); return true; }
        if (L < 1248) { u.aux = 1; u.pm = (L - 1216) >> 2; u.pn = (L - 1216) & 3; return true; }
        if (L < 1280) { u.aux = 2; u.pm = (L - 1248) >> 3; u.pn = (L - 1248) & 7; return true; }
        return false;
    }
    __device__ __forceinline__ const char* a_base(const Unit& u) const { const size_t o = u.aux == 0 ? WS_H : (u.aux == 1 ? WS_MEMN : WS_WV); return (const char*)(ws + o + (size_t)u.pm * 256 * D * EB); }
    __device__ __forceinline__ const char* b_base(const Unit& u) const { const size_t o = u.aux == 0 ? WS_WIN : (u.aux == 1 ? WS_WK : WS_MEMN); return (const char*)(ws + o + (size_t)u.pn * 256 * D * EB); }
    __device__ __forceinline__ unsigned a_off(const Unit&, int row, int C) const { return (unsigned)(row * D * EB + C * 2); }
};
struct EpiP1 {
    static constexpr bool MID = false;
    unsigned char* ws;
    __device__ __forceinline__ void operator()(const f32x4 (&acc)[2][2][4][2], const Unit& u, int wr, int wc, int fr, int fq) const {
        asm volatile("" : "+v"(fr), "+v"(fq));
        const size_t oo = u.aux == 0 ? WS_P : (u.aux == 1 ? WS_KMEM : WS_VT);
        bf16_t* O = (bf16_t*)(ws + oo); const int ldc = u.aux == 0 ? PN : (u.aux == 1 ? D : TM);
        const int act = (u.aux == 0) ? ((u.pn >= 6 && u.pn < 10) ? 1 : ((u.pn >= 10 && u.pn < 18) ? 2 : 0)) : 0;
        const int row0 = u.pm * 256 + wr * 64 + fr, col0 = u.pn * 256 + wc * 32 + 8 * fq; const bool svstat = (u.aux == 0) && (u.pn == 8 || u.pn == 9);
#pragma unroll
        for (int ai = 0; ai < 2; ++ai)
#pragma unroll
            for (int m = 0; m < 4; ++m) { bf16_t* rowp = O + (size_t)(row0 + ai * 128 + m * 16) * ldc + col0; float s1 = 0.f, s2 = 0.f;
#pragma unroll
                for (int bj = 0; bj < 2; ++bj) { float v[8];
#pragma unroll
                    for (int j = 0; j < 4; ++j) { v[j] = acc[ai][bj][m][0][j]; v[4 + j] = acc[ai][bj][m][1][j]; }
                    if (act == 1) {
#pragma unroll
                        for (int j = 0; j < 8; j += 2) { const f32x2 o = gelu_pk((f32x2){v[j], v[j + 1]}); v[j] = o.x; v[j + 1] = o.y; }
#pragma unroll
                        for (int j = 0; j < 8; ++j) { s1 += v[j]; s2 += v[j] * v[j]; } }
                    else if (act == 2) {
#pragma unroll
                        for (int j = 0; j < 8; j += 2) { const f32x2 o = sigmoid_pk((f32x2){v[j], v[j + 1]}); v[j] = o.x; v[j + 1] = o.y; } }
                    *(u32x4*)(rowp + bj * 128) = pack8(v); }
                if (svstat) {
                    s1 += __shfl_xor(s1, 16); s1 += __shfl_xor(s1, 32); s2 += __shfl_xor(s2, 16); s2 += __shfl_xor(s2, 32);
                    if (fq == 0) *(f32x2*)((float*)(ws + WS_SVS) + (size_t)(row0 + ai * 128 + m * 16) * 16 + (u.pn - 8) * 8 + wc * 2) = (f32x2){s1, s2}; } }
    }
};

__device__ __forceinline__ void gla_a_unit(Frame& F, int unit) {
    const int tid = F.tid, lane = F.lane, w = F.wave, fr = lane & 15, fq = lane >> 4;
    const int bh = unit >> 5, n = unit & 31, b = bh >> 2, h = bh & 3;
    const int t0 = b * SEQ + n * 64;
    LAS float* cum = (LAS float*)(F.lds); LAS float* tot = (LAS float*)(F.lds + 16640);
    LAS bf16_t* QIN = (LAS bf16_t*)(F.lds + 18688); LAS bf16_t* KIN = (LAS bf16_t*)(F.lds + 27904); LAS bf16_t* KOT = (LAS bf16_t*)(F.lds + 37120);
    LAS bf16_t* ATT = (LAS bf16_t*)(F.lds + 46336); LAS bf16_t* VT = (LAS bf16_t*)(F.lds + 55552);
    const int c = tid >> 3, d8 = (tid & 7) * 8;
    {
        float g[8]; unpack8(*(const u32x4*)(F.p() + (size_t)(t0 + c) * PN + PC_A + h * 64 + d8), g);
        const f32x4 b0 = *(const f32x4*)(F.A->in[I_BA] + h * 64 + d8), b1 = *(const f32x4*)(F.A->in[I_BA] + h * 64 + d8 + 4);
        const float bb[8] = {b0.x, b0.y, b0.z, b0.w, b1.x, b1.y, b1.z, b1.w};
#pragma unroll
        for (int j = 0; j < 8; ++j) { const float x = g[j] + bb[j]; const float ls = fminf(x, 0.f) - __logf(1.f + __expf(-fabsf(x))); cum[c * 65 + d8 + j] = ls * 0.0625f; }
    }
    __syncthreads();
    { const int d = tid & 63, seg = tid >> 6; float run = 0.f;
#pragma unroll
        for (int i = 0; i < 8; ++i) { run += cum[(seg * 8 + i) * 65 + d]; cum[(seg * 8 + i) * 65 + d] = run; }
        tot[seg * 64 + d] = run; }
    __syncthreads();
    { const int d = tid & 63, seg = tid >> 6; float off = 0.f;
#pragma unroll
        for (int s = 0; s < 7; ++s) if (s < seg) off += tot[s * 64 + d];
#pragma unroll
        for (int i = 0; i < 8; ++i) cum[(seg * 8 + i) * 65 + d] += off; }
    __syncthreads();
    {
        float qv[8], kv[8], qi[8], ki[8];
        unpack8(*(const u32x4*)(F.p() + (size_t)(t0 + c) * PN + PC_Q + h * 64 + d8), qv);
        unpack8(*(const u32x4*)(F.p() + (size_t)(t0 + c) * PN + PC_K + h * 64 + d8), kv);
#pragma unroll
        for (int j = 0; j < 8; ++j) { const float cm = cum[c * 65 + d8 + j], cl = cum[63 * 65 + d8 + j];
            qi[j] = qv[j] * 0.125f * __expf(cm); ki[j] = kv[j] * __expf(-cm);
            KOT[(d8 + j) * 72 + c] = f2bf(kv[j] * __expf(cl - cm));
            if (c == 63) F.decay()[unit * 64 + d8 + j] = __expf(cl); }
        const u32x4 qp = pack8(qi), kp = pack8(ki);
        *(LAS u32x4*)(QIN + c * 72 + d8) = qp; *(LAS u32x4*)(KIN + c * 72 + d8) = kp;
        *(u32x4*)(F.qin() + (size_t)(t0 + c) * 256 + h * 64 + d8) = qp;
        const int e16 = (tid & 7) * 16;
#pragma unroll
        for (int hh = 0; hh < 2; ++hh) { const u32x4 vv = *(const u32x4*)(F.p() + (size_t)(t0 + c) * PN + PC_V + h * 128 + e16 + 8 * hh);
            const unsigned ww[4] = {vv.x, vv.y, vv.z, vv.w};
#pragma unroll
            for (int j = 0; j < 4; ++j) { VT[(e16 + 8 * hh + 2 * j) * 72 + c] = (bf16_t)(ww[j] & 0xffffu); VT[(e16 + 8 * hh + 2 * j + 1) * 72 + c] = (bf16_t)(ww[j] >> 16); } }
    }
    __syncthreads();
    {
        const int mt = w >> 1;
        bf16x8 a[2];
#pragma unroll
        for (int ks = 0; ks < 2; ++ks) a[ks] = *(const LAS bf16x8*)(QIN + (16 * mt + fr) * 72 + 32 * ks + 8 * fq);
#pragma unroll
        for (int q = 0; q < 2; ++q) { const int nt = (w & 1) * 2 + q; f32x4 s = {0.f, 0.f, 0.f, 0.f};
#pragma unroll
            for (int ks = 0; ks < 2; ++ks) s = mma16(a[ks], *(const LAS bf16x8*)(KIN + (16 * nt + fr) * 72 + 32 * ks + 8 * fq), s);
#pragma unroll
            for (int r = 0; r < 4; ++r) { const int cc = 16 * mt + 4 * fq + r, ss = 16 * nt + fr; ATT[cc * 72 + ss] = f2bf(ss <= cc ? s[r] : 0.f); } }
    }
    __syncthreads();
    {
        const int mt = w >> 1, nt0 = (w & 1) * 4;
        bf16x8 aa[2], ak[2];
#pragma unroll
        for (int ks = 0; ks < 2; ++ks) { aa[ks] = *(const LAS bf16x8*)(ATT + (16 * mt + fr) * 72 + 32 * ks + 8 * fq); ak[ks] = *(const LAS bf16x8*)(KOT + (16 * mt + fr) * 72 + 32 * ks + 8 * fq); }
#pragma unroll
        for (int q = 0; q < 4; ++q) { const int nt = nt0 + q; f32x4 o = {0.f, 0.f, 0.f, 0.f}, kvv = {0.f, 0.f, 0.f, 0.f};
#pragma unroll
            for (int ks = 0; ks < 2; ++ks) { const bf16x8 bv = *(const LAS bf16x8*)(VT + (16 * nt + fr) * 72 + 32 * ks + 8 * fq); o = mma16(bv, aa[ks], o); kvv = mma16(ak[ks], bv, kvv); }
            *(u32x2*)(F.ointra() + (size_t)(t0 + 16 * mt + fr) * 512 + h * 128 + 16 * nt + 4 * fq) = (u32x2){cvt_pk_bf16(o[0], o[1]), cvt_pk_bf16(o[2], o[3])};
            *(u32x2*)(F.kvT() + ((size_t)unit * 128 + 16 * nt + fr) * 64 + 16 * mt + 4 * fq) = (u32x2){cvt_pk_bf16(kvv[0], kvv[1]), cvt_pk_bf16(kvv[2], kvv[3])}; }
    }
    __syncthreads();
}

__device__ __forceinline__ void gla_sscan_item(Frame& F, int item) {
    const int lane = F.lane, idx = item * 64 + lane, d4 = idx & 15, e = (idx >> 4) & 127, bh = idx >> 11;
    const bf16_t* kvp = F.kvT() + ((size_t)(bh * 32) * 128 + e) * 64 + d4 * 4; const float* dcp = F.decay() + (size_t)(bh * 32) * 64 + d4 * 4;
    bf16_t* sp = F.spT() + ((size_t)(bh * 32) * 128 + e) * 64 + d4 * 4;
    f32x4 S = {0.f, 0.f, 0.f, 0.f};
    for (int n0 = 0; n0 < 32; n0 += 8) { f32x4 kv[8], dc[8];
#pragma unroll
        for (int i = 0; i < 8; ++i) { const u32x2 kw = *(const u32x2*)(kvp + (size_t)(n0 + i) * 128 * 64); kv[i] = (f32x4){bflo(kw.x), bfhi(kw.x), bflo(kw.y), bfhi(kw.y)}; dc[i] = *(const f32x4*)(dcp + (size_t)(n0 + i) * 64); }
#pragma unroll
        for (int i = 0; i < 8; ++i) { u32x2 o; o.x = cvt_pk_bf16(S.x, S.y); o.y = cvt_pk_bf16(S.z, S.w); *(u32x2*)(sp + (size_t)(n0 + i) * 128 * 64) = o; S = dc[i] * S + kv[i]; } }
}
__device__ __forceinline__ void sgu_unit(Frame& F, int unit) {
    const int tid = F.tid, w = F.wave, lane = F.lane, fr = lane & 15, fq = lane >> 4, ch = unit >> 2, g = unit & 3, t0 = ch * 128;
    LAS f32x2* stat = (LAS f32x2*)F.lds; LAS bf16_t* vnT = (LAS bf16_t*)(F.lds + 1024);
    if (tid < 128) { const float* sp = (const float*)(F.A->ws + WS_SVS) + (size_t)(t0 + tid) * 16;
        const f32x4 a = *(const f32x4*)sp, b = *(const f32x4*)(sp + 4), c4 = *(const f32x4*)(sp + 8), d = *(const f32x4*)(sp + 12);
        const float s = (a.x + a.z) + (b.x + b.z) + (c4.x + c4.z) + (d.x + d.z), s2 = (a.y + a.w) + (b.y + b.w) + (c4.y + c4.w) + (d.y + d.w);
        const float mean = s * (1.f / 512.f), var = fmaxf(s2 * (1.f / 512.f) - mean * mean, 0.f);
        stat[tid] = (f32x2){mean, rsqrtf(var + EPS)}; }
    __syncthreads();
    { const int s = tid >> 2, c32 = (tid & 3) * 32; const f32x2 ms = stat[s];
#pragma unroll
        for (int q = 0; q < 4; ++q) { float v[8]; unpack8(*(const u32x4*)(F.p() + (size_t)(t0 + s) * PN + PC_SV + g * 128 + c32 + 8 * q), v);
#pragma unroll
            for (int j = 0; j < 8; ++j) { const int cidx = g * 128 + c32 + 8 * q + j; vnT[(c32 + 8 * q + j) * 136 + s] = f2bf((v[j] - ms.x) * ms.y * F.A->in[I_SNG][cidx] + F.A->in[I_SNB][cidx]); } } }
    __syncthreads();
    f32x4 acc[8];
#pragma unroll
    for (int ct = 0; ct < 8; ++ct) acc[ct] = (f32x4){0.f, 0.f, 0.f, 0.f};
    const int nks = (16 * w + 15) / 32 + 1;
    for (int ks = 0; ks < nks; ++ks) { const bf16x8 bw = *(const bf16x8*)(F.sguw() + (size_t)(g * 128 + 16 * w + fr) * 128 + 32 * ks + 8 * fq);
#pragma unroll
        for (int ct = 0; ct < 8; ++ct) acc[ct] = mma16(*(const LAS bf16x8*)(vnT + (16 * ct + fr) * 136 + 32 * ks + 8 * fq), bw, acc[ct]); }
    {
        const int t = 16 * w + fr; const float bias = F.A->in[I_SB][g * 128 + t];
        u32x2 uv[8];
#pragma unroll
        for (int ct = 0; ct < 8; ++ct) uv[ct] = *(const u32x2*)(F.p() + (size_t)(t0 + t) * PN + PC_U + g * 128 + 16 * ct + 4 * fq);
#pragma unroll
        for (int ct = 0; ct < 8; ++ct) { const int cidx = g * 128 + 16 * ct + 4 * fq; const u32x2 uu = uv[ct];
            u32x2 o; o.x = cvt_pk_bf16(bflo(uu.x) * (acc[ct][0] + bias), bfhi(uu.x) * (acc[ct][1] + bias)); o.y = cvt_pk_bf16(bflo(uu.y) * (acc[ct][2] + bias), bfhi(uu.y) * (acc[ct][3] + bias));
            *(u32x2*)(F.oab() + (size_t)(t0 + t) * D + 512 + cidx) = o; } }
    __syncthreads();
}
__device__ __forceinline__ void gla_out_item(Frame& F, int item) {
    const int lane = F.lane, fr = lane & 15, fq = lane >> 4, unit = item >> 2, mt = item & 3;
    const int bh = unit >> 5, n = unit & 31, b = bh >> 2, h = bh & 3; const size_t t = (size_t)b * SEQ + n * 64 + 16 * mt + fr;
    bf16x8 qf[2];
#pragma unroll
    for (int ks = 0; ks < 2; ++ks) qf[ks] = *(const bf16x8*)(F.qin() + t * 256 + h * 64 + 32 * ks + 8 * fq);
    const bf16_t* sp = F.spT() + (size_t)unit * 128 * 64;
    f32x4 o[8]; float ss = 0.f;
#pragma unroll
    for (int et = 0; et < 8; ++et) { const u32x2 ow = *(const u32x2*)(F.ointra() + t * 512 + h * 128 + 16 * et + 4 * fq); f32x4 acc = {bflo(ow.x), bfhi(ow.x), bflo(ow.y), bfhi(ow.y)};
#pragma unroll
        for (int ks = 0; ks < 2; ++ks) acc = mma16(*(const bf16x8*)(sp + (size_t)(16 * et + fr) * 64 + 32 * ks + 8 * fq), qf[ks], acc);
        o[et] = acc; ss += (acc[0] * acc[0] + acc[1] * acc[1]) + (acc[2] * acc[2] + acc[3] * acc[3]); }
    ss += __shfl_xor(ss, 16); ss += __shfl_xor(ss, 32);
    const float rstd = rsqrtf(ss * (1.f / 128.f) + EPS);
    f32x4 gv[8]; u32x2 rv[8];
#pragma unroll
    for (int et = 0; et < 8; ++et) { const int e = h * 128 + 16 * et + 4 * fq; gv[et] = *(const f32x4*)(F.A->in[I_GOUTG] + e); rv[et] = *(const u32x2*)(F.p() + t * PN + PC_R + e); }
#pragma unroll
    for (int et = 0; et < 8; ++et) { const int e = h * 128 + 16 * et + 4 * fq; const f32x4 g = gv[et];
        const u32x2 rr = rv[et]; const float r0 = bflo(rr.x), r1 = bfhi(rr.x), r2 = bflo(rr.y), r3 = bfhi(rr.y);
        u32x2 ov; ov.x = cvt_pk_bf16(o[et][0] * rstd * g.x * r0 * sigmoidf_(r0), o[et][1] * rstd * g.y * r1 * sigmoidf_(r1));
        ov.y = cvt_pk_bf16(o[et][2] * rstd * g.z * r2 * sigmoidf_(r2), o[et][3] * rstd * g.w * r3 * sigmoidf_(r3));
        *(u32x2*)(F.oab() + t * D + e) = ov; }
}

struct ProbSeg {
    static constexpr bool GATHER = false, FP8 = false; static constexpr int WSCALE = FP8_WSCALE;
    int K, lda, ldb, G, c; const bf16_t *oab, *Wpab_t;
    __device__ __forceinline__ bool next(int i, Unit& u) const { const int L = (i >> 1) * G + c; if (L >= 256) return false; pg8::map_tile(L, 64, 4, u.pm, u.pn); u.aux = i & 1; return true; }
    __device__ __forceinline__ const char* a_base(const Unit& u) const { return (const char*)(oab + (size_t)u.pm * 256 * D + u.aux * 512); }
    __device__ __forceinline__ const char* b_base(const Unit& u) const { return (const char*)(Wpab_t + (size_t)u.pn * 256 * D + u.aux * 512); }
    __device__ __forceinline__ unsigned a_off(const Unit&, int row, int C) const { return (unsigned)(row * D + C) * 2u; }
};
struct EpiMix {
    static constexpr bool MID = false;
    const bf16_t* p; bf16_t* mix;
    __device__ __forceinline__ void operator()(const f32x4 (&acc)[2][2][4][2], const Unit& u, int wr, int wc, int fr, int fq) const {
        asm volatile("" : "+v"(fr), "+v"(fq));
        const int row0 = u.pm * 256 + wr * 64 + fr, col0 = u.pn * 256 + wc * 32 + 8 * fq, gc = u.aux ? PC_GB : PC_GA;
#pragma unroll
        for (int ai = 0; ai < 2; ++ai) {
            u32x4 gw[4][2], pw[4][2];
#pragma unroll
            for (int m = 0; m < 4; ++m)
#pragma unroll
                for (int bj = 0; bj < 2; ++bj) { const size_t row = (size_t)(row0 + ai * 128 + m * 16);
                    gw[m][bj] = *(const u32x4*)(p + row * PN + gc + col0 + bj * 128);
                    pw[m][bj] = u.aux ? *(const u32x4*)(mix + row * D + col0 + bj * 128) : (u32x4){0u, 0u, 0u, 0u}; }
#pragma unroll
            for (int m = 0; m < 4; ++m)
#pragma unroll
                for (int bj = 0; bj < 2; ++bj) { const size_t row = (size_t)(row0 + ai * 128 + m * 16); float g[8], pv[8], v[8]; unpack8(gw[m][bj], g); unpack8(pw[m][bj], pv);
#pragma unroll
                    for (int j = 0; j < 4; ++j) { v[j] = acc[ai][bj][m][0][j] * g[j] + pv[j]; v[4 + j] = acc[ai][bj][m][1][j] * g[4 + j] + pv[4 + j]; }
                    *(u32x4*)(mix + row * D + col0 + bj * 128) = pack8(v); } }
    }
};

struct EpiMix2 {
    static constexpr bool MID = true;
    const bf16_t* p; bf16_t* mix;
    __device__ __forceinline__ void mid(f32x4 (&acc)[2][2][4][2], const Unit& u, int wr, int wc, int fr, int fq) const {
        asm volatile("" : "+v"(fr), "+v"(fq));
        const int row0 = u.pm * 256 + wr * 64 + fr, col0 = u.pn * 256 + wc * 32 + 8 * fq;
#pragma unroll
        for (int ai = 0; ai < 2; ++ai) { u32x4 ga[4][2], gb[4][2];
#pragma unroll
            for (int m = 0; m < 4; ++m)
#pragma unroll
                for (int bj = 0; bj < 2; ++bj) { const size_t row = (size_t)(row0 + ai * 128 + m * 16); ga[m][bj] = *(const u32x4*)(p + row * PN + PC_GA + col0 + bj * 128); gb[m][bj] = *(const u32x4*)(p + row * PN + PC_GB + col0 + bj * 128); }
#pragma unroll
            for (int m = 0; m < 4; ++m)
#pragma unroll
                for (int bj = 0; bj < 2; ++bj) { float a[8], b[8]; unpack8(ga[m][bj], a); unpack8(gb[m][bj], b);
#pragma unroll
                    for (int j = 0; j < 4; ++j) { acc[ai][bj][m][0][j] *= a[j] * __builtin_amdgcn_rcpf(fmaxf(b[j], 1e-20f)); acc[ai][bj][m][1][j] *= a[4 + j] * __builtin_amdgcn_rcpf(fmaxf(b[4 + j], 1e-20f)); } } }
    }
    __device__ __forceinline__ void operator()(const f32x4 (&acc)[2][2][4][2], const Unit& u, int wr, int wc, int fr, int fq) const {
        asm volatile("" : "+v"(fr), "+v"(fq));
        const int row0 = u.pm * 256 + wr * 64 + fr, col0 = u.pn * 256 + wc * 32 + 8 * fq;
#pragma unroll
        for (int ai = 0; ai < 2; ++ai) { u32x4 gb[4][2];
#pragma unroll
            for (int m = 0; m < 4; ++m)
#pragma unroll
                for (int bj = 0; bj < 2; ++bj) gb[m][bj] = *(const u32x4*)(p + (size_t)(row0 + ai * 128 + m * 16) * PN + PC_GB + col0 + bj * 128);
#pragma unroll
            for (int m = 0; m < 4; ++m)
#pragma unroll
                for (int bj = 0; bj < 2; ++bj) { float b[8], v[8]; unpack8(gb[m][bj], b);
#pragma unroll
                    for (int j = 0; j < 4; ++j) { v[j] = acc[ai][bj][m][0][j] * fmaxf(b[j], 1e-20f); v[4 + j] = acc[ai][bj][m][1][j] * fmaxf(b[4 + j], 1e-20f); }
                    *(u32x4*)(mix + (size_t)(row0 + ai * 128 + m * 16) * D + col0 + bj * 128) = pack8(v); } }
    }
};

template <bool Q8 = false, int WS_ = FP8_WSCALE> struct ProbStdT {
    static constexpr bool GATHER = false, FP8 = Q8; static constexpr int WSCALE = WS_, EB = Q8 ? 1 : 2;
    int K, lda, ldb, G, c; const void *A, *Bt;
    __device__ __forceinline__ bool next(int i, Unit& u) const { const int L = i * G + c; if (L >= 256) return false; pg8::map_tile(L, 64, 4, u.pm, u.pn); u.aux = 0; return true; }
    __device__ __forceinline__ const char* a_base(const Unit& u) const { return (const char*)A + (size_t)u.pm * 256 * D * EB; }
    __device__ __forceinline__ const char* b_base(const Unit& u) const { return (const char*)Bt + (size_t)u.pn * 256 * D * EB; }
    __device__ __forceinline__ unsigned a_off(const Unit&, int row, int C) const { return (unsigned)(row * D * EB + C * 2); }
};
typedef ProbStdT<false> ProbStd;
template <bool RESF32> struct EpiRes {
    static constexpr bool MID = false;
    const void* res; bf16_t* outb; float* ssq; unsigned char* outq; const float* qgain;
    __device__ __forceinline__ void operator()(const f32x4 (&acc)[2][2][4][2], const Unit& u, int wr, int wc, int fr, int fq) const {
        asm volatile("" : "+v"(fr), "+v"(fq));
        const int row0 = u.pm * 256 + wr * 64 + fr, col0 = u.pn * 256 + wc * 32 + 8 * fq;
#pragma unroll
        for (int ai = 0; ai < 2; ++ai) {
            f32x4 rf[4][2][2]; u32x4 rb[4][2];
#pragma unroll
            for (int m = 0; m < 4; ++m)
#pragma unroll
                for (int bj = 0; bj < 2; ++bj) { const size_t off = (size_t)(row0 + ai * 128 + m * 16) * D + col0 + bj * 128;
                    if (RESF32) { rf[m][bj][0] = *(const f32x4*)((const float*)res + off); rf[m][bj][1] = *(const f32x4*)((const float*)res + off + 4); }
                    else rb[m][bj] = *(const u32x4*)((const bf16_t*)res + off); }
#pragma unroll
            for (int m = 0; m < 4; ++m) { const size_t row = (size_t)(row0 + ai * 128 + m * 16); float sq = 0.f;
#pragma unroll
                for (int bj = 0; bj < 2; ++bj) { float r[8], v[8];
                    if (RESF32) { r[0] = rf[m][bj][0].x; r[1] = rf[m][bj][0].y; r[2] = rf[m][bj][0].z; r[3] = rf[m][bj][0].w; r[4] = rf[m][bj][1].x; r[5] = rf[m][bj][1].y; r[6] = rf[m][bj][1].z; r[7] = rf[m][bj][1].w; }
                    else unpack8(rb[m][bj], r);
#pragma unroll
                    for (int j = 0; j < 4; ++j) { v[j] = acc[ai][bj][m][0][j] + r[j]; v[4 + j] = acc[ai][bj][m][1][j] + r[4 + j]; }
#pragma unroll
                    for (int j = 0; j < 8; ++j) sq += v[j] * v[j];
                    *(u32x4*)(outb + row * D + col0 + bj * 128) = pack8(v);
                    if (outq) *(u32x2*)(outq + row * D + col0 + bj * 128) = pack8_fp8(v); }
                sq += __shfl_xor(sq, 16); sq += __shfl_xor(sq, 32);
                if (fq == 0) ssq[row * 16 + u.pn * 4 + wc] = sq; } }
    }
};
__device__ __forceinline__ float row_rs(const float* ssq, size_t row) {
    const f32x4 a = *(const f32x4*)(ssq + row * 16), b = *(const f32x4*)(ssq + row * 16 + 4), c = *(const f32x4*)(ssq + row * 16 + 8), d = *(const f32x4*)(ssq + row * 16 + 12);
    const float s = ((a.x + a.y) + (a.z + a.w)) + ((b.x + b.y) + (b.z + b.w)) + ((c.x + c.y) + (c.z + c.w)) + ((d.x + d.y) + (d.z + d.w));
    return rsqrtf(s * (1.f / D) + EPS);
}
struct EpiScale {
    static constexpr bool MID = false;
    const float* ssq; bf16_t* outb;
    __device__ __forceinline__ void operator()(const f32x4 (&acc)[2][2][4][2], const Unit& u, int wr, int wc, int fr, int fq) const {
        asm volatile("" : "+v"(fr), "+v"(fq));
        const int row0 = u.pm * 256 + wr * 64 + fr, col0 = u.pn * 256 + wc * 32 + 8 * fq;
        float rs[2][4];
#pragma unroll
        for (int ai = 0; ai < 2; ++ai)
#pragma unroll
            for (int m = 0; m < 4; ++m) rs[ai][m] = row_rs(ssq, (size_t)(row0 + ai * 128 + m * 16));
#pragma unroll
        for (int ai = 0; ai < 2; ++ai)
#pragma unroll
            for (int m = 0; m < 4; ++m) { const size_t row = (size_t)(row0 + ai * 128 + m * 16);
#pragma unroll
                for (int bj = 0; bj < 2; ++bj) { float v[8];
#pragma unroll
                    for (int j = 0; j < 4; ++j) { v[j] = acc[ai][bj][m][0][j] * rs[ai][m]; v[4 + j] = acc[ai][bj][m][1][j] * rs[ai][m]; }
                    *(u32x4*)(outb + row * D + col0 + bj * 128) = pack8(v); } }
    }
};

__device__ __forceinline__ void attn_unit(Frame& F, int unit) {
    const int tid = F.tid, w = F.wave, lane = F.lane, fr = lane & 15, fq = lane >> 4;
    const int b = unit >> 5, h = (unit >> 3) & 3, qb = unit & 7;
    const size_t tq = (size_t)b * SEQ + qb * 256 + 32 * w;
    LAS unsigned char* const bufs[2] = {F.lds, F.lds + 36864};
    const bf16_t* kg = F.kmem() + (size_t)(b * 256 + (tid >> 1)) * D + h * 256 + (tid & 1) * 32;
    const int kls = (tid >> 1) * 144 + (tid & 1) * 64;
    const bf16_t* vg = F.vt() + (size_t)(h * 256 + (tid >> 3)) * TM + b * 256 + (tid & 7) * 32;
    const int vls = (tid >> 3) * 528 + (tid & 7) * 64;
    u32x4 st[4];
#pragma unroll
    for (int i = 0; i < 4; ++i) st[i] = *(const u32x4*)(kg + 8 * i);
#pragma unroll
    for (int i = 0; i < 4; ++i) *(LAS u32x4*)(bufs[0] + kls + 16 * i) = st[i];
    __syncthreads();
    f32x4 s[16][2];
#pragma unroll
    for (int nt = 0; nt < 16; ++nt) { s[nt][0] = (f32x4){0.f, 0.f, 0.f, 0.f}; s[nt][1] = (f32x4){0.f, 0.f, 0.f, 0.f}; }
#pragma unroll
    for (int c = 0; c < 4; ++c) {
        if (c < 3) {
#pragma unroll
            for (int i = 0; i < 4; ++i) st[i] = *(const u32x4*)(kg + 64 * (c + 1) + 8 * i); }
        else {
#pragma unroll
            for (int i = 0; i < 4; ++i) st[i] = *(const u32x4*)(vg + 8 * i); }
        LAS unsigned char* kb = bufs[c & 1];
        bf16x8 qf[2][2];
#pragma unroll
        for (int qt = 0; qt < 2; ++qt)
#pragma unroll
            for (int ks = 0; ks < 2; ++ks) qf[qt][ks] = *(const bf16x8*)(F.q() + (tq + 16 * qt + fr) * D + h * 256 + 64 * c + 32 * ks + 8 * fq);
#pragma unroll
        for (int nt = 0; nt < 16; ++nt)
#pragma unroll
            for (int ks = 0; ks < 2; ++ks) { const bf16x8 a = *(const LAS bf16x8*)(kb + (16 * nt + fr) * 144 + (32 * ks + 8 * fq) * 2);
                s[nt][0] = mma16(a, qf[0][ks], s[nt][0]); s[nt][1] = mma16(a, qf[1][ks], s[nt][1]); }
        if (c < 3) {
#pragma unroll
            for (int i = 0; i < 4; ++i) *(LAS u32x4*)(bufs[(c + 1) & 1] + kls + 16 * i) = st[i]; }
        __syncthreads();
    }
#pragma unroll
    for (int i = 0; i < 4; ++i) *(LAS u32x4*)(bufs[0] + vls + 16 * i) = st[i];
    float inv[2]; bf16x8 pb[2][8];
#pragma unroll
    for (int qt = 0; qt < 2; ++qt) { float mx = s[0][qt][0];
#pragma unroll
        for (int nt = 0; nt < 16; ++nt)
#pragma unroll
            for (int r = 0; r < 4; ++r) mx = fmaxf(mx, s[nt][qt][r]);
        mx = fmaxf(mx, __shfl_xor(mx, 16)); mx = fmaxf(mx, __shfl_xor(mx, 32));
        float sum = 0.f;
#pragma unroll
        for (int nt = 0; nt < 16; ++nt)
#pragma unroll
            for (int r = 0; r < 4; ++r) { const float e = __expf(s[nt][qt][r] - mx); s[nt][qt][r] = e; sum += e; }
        sum += __shfl_xor(sum, 16); sum += __shfl_xor(sum, 32);
        inv[qt] = __builtin_amdgcn_rcpf(sum);
#pragma unroll
        for (int sk = 0; sk < 8; ++sk) { const float pv[8] = {s[2 * sk][qt][0], s[2 * sk][qt][1], s[2 * sk][qt][2], s[2 * sk][qt][3], s[2 * sk + 1][qt][0], s[2 * sk + 1][qt][1], s[2 * sk + 1][qt][2], s[2 * sk + 1][qt][3]};
            const u32x4 pk = pack8(pv); pb[qt][sk] = __builtin_bit_cast(bf16x8, pk); } }
    __syncthreads();
#pragma unroll
    for (int c = 0; c < 4; ++c) {
        if (c < 3) {
#pragma unroll
            for (int i = 0; i < 4; ++i) st[i] = *(const u32x4*)(vg + (size_t)64 * (c + 1) * TM + 8 * i); }
        LAS unsigned char* vb = bufs[c & 1];
#pragma unroll
        for (int dt = 0; dt < 4; ++dt) { f32x4 o0 = {0.f, 0.f, 0.f, 0.f}, o1 = {0.f, 0.f, 0.f, 0.f};
#pragma unroll
            for (int sk = 0; sk < 8; ++sk) { const LAS unsigned char* vp = vb + (16 * dt + fr) * 528 + (32 * sk + 4 * fq) * 2;
                const u32x2 lo = *(const LAS u32x2*)vp, hi = *(const LAS u32x2*)(vp + 32);
                const u32x4 av = {lo.x, lo.y, hi.x, hi.y}; const bf16x8 a = __builtin_bit_cast(bf16x8, av);
                o0 = mma16(a, pb[0][sk], o0); o1 = mma16(a, pb[1][sk], o1); }
            const int col = h * 256 + 64 * c + 16 * dt + 4 * fq;
            int w0 = 0, w1 = 0;
            w0 = __builtin_amdgcn_cvt_pk_fp8_f32(o0[0] * inv[0], o0[1] * inv[0], w0, false); w0 = __builtin_amdgcn_cvt_pk_fp8_f32(o0[2] * inv[0], o0[3] * inv[0], w0, true);
            w1 = __builtin_amdgcn_cvt_pk_fp8_f32(o1[0] * inv[1], o1[1] * inv[1], w1, false); w1 = __builtin_amdgcn_cvt_pk_fp8_f32(o1[2] * inv[1], o1[3] * inv[1], w1, true);
            *(int*)((unsigned char*)F.ao() + (tq + fr) * D + col) = w0; *(int*)((unsigned char*)F.ao() + (tq + 16 + fr) * D + col) = w1; }
        if (c < 3) {
#pragma unroll
            for (int i = 0; i < 4; ++i) *(LAS u32x4*)(bufs[(c + 1) & 1] + vls + 16 * i) = st[i]; }
        __syncthreads();
    }
}

__device__ __forceinline__ void router_item(Frame& F, int item) {
    const int w = F.wave, lane = F.lane, fr = lane & 15, fq = lane >> 4;
    const size_t t0 = (size_t)item * 16;
    LAS float* lg = (LAS float*)F.lds + w * (16 * 33 + 64);
    LAS int* ex = (LAS int*)(lg + 16 * 33);
    f32x4 acc[2] = {{0.f, 0.f, 0.f, 0.f}, {0.f, 0.f, 0.f, 0.f}};
    const float rsl = row_rs(F.ssq2(), t0 + fr);
    for (int k0 = 0; k0 < 32; k0 += 8) { bf16x8 a[8], b0[8], b1[8];
#pragma unroll
        for (int i = 0; i < 8; ++i) { a[i] = *(const bf16x8*)(F.x2b() + (t0 + fr) * D + 32 * (k0 + i) + 8 * fq);
            b0[i] = *(const bf16x8*)(F.Wr_t() + (size_t)fr * D + 32 * (k0 + i) + 8 * fq); b1[i] = *(const bf16x8*)(F.Wr_t() + (size_t)(16 + fr) * D + 32 * (k0 + i) + 8 * fq); }
#pragma unroll
        for (int i = 0; i < 8; ++i) { acc[0] = mma16(a[i], b0[i], acc[0]); acc[1] = mma16(a[i], b1[i], acc[1]);
            const int col = 32 * (k0 + i) + 8 * fq; const f32x4 g0 = *(const f32x4*)(F.A->in[I_NFFNG] + col), g1 = *(const f32x4*)(F.A->in[I_NFFNG] + col + 4);
            float xv[8]; unpack8(__builtin_bit_cast(u32x4, a[i]), xv);
            xv[0] *= rsl * g0.x; xv[1] *= rsl * g0.y; xv[2] *= rsl * g0.z; xv[3] *= rsl * g0.w; xv[4] *= rsl * g1.x; xv[5] *= rsl * g1.y; xv[6] *= rsl * g1.z; xv[7] *= rsl * g1.w;
            *(u32x2*)(F.x2q() + (t0 + fr) * D + col) = pack8_fp8(xv); } }
#pragma unroll
    for (int r = 0; r < 4; ++r)
#pragma unroll
        for (int nt = 0; nt < 2; ++nt) lg[(4 * fq + r) * 33 + 16 * nt + fr] = acc[nt][r];
    LDS_WAIT();
    float rs = 0.f, gk[4] = {0.f, 0.f, 0.f, 0.f};
    if (lane < 16) { const size_t t = t0 + lane; rs = row_rs(F.ssq2(), t);
        float v[32];
#pragma unroll
        for (int e = 0; e < 32; ++e) v[e] = lg[lane * 33 + e] * rs + F.A->in[I_BR][e];
        unsigned taken = 0u; float tv[4];
#pragma unroll
        for (int k = 0; k < 4; ++k) { float best = -INFINITY; int bi = 0;
#pragma unroll
            for (int e = 0; e < 32; ++e) { const bool ok = !((taken >> e) & 1u) && (v[e] > best); best = ok ? v[e] : best; bi = ok ? e : bi; }
            taken |= 1u << bi; tv[k] = best; ex[lane * 4 + k] = bi; }
        float sum = 0.f;
#pragma unroll
        for (int k = 0; k < 4; ++k) { gk[k] = __expf(tv[k] - tv[0]); sum += gk[k]; }
        const float inv = 1.f / sum;
        *(f32x4*)(F.gates() + t * 4) = (f32x4){gk[0] * inv, gk[1] * inv, gk[2] * inv, gk[3] * inv}; }
    LDS_WAIT();
    const int me = ex[lane]; const float my_rs = __shfl(rs, lane >> 2);
    int rank = 0, mytot = 0;
#pragma unroll
    for (int e = 0; e < 32; ++e) { const unsigned long long m = __ballot(me == e); const int below = __builtin_popcountll(m & ((1ull << lane) - 1ull));
        rank = (me == e) ? below : rank; mytot = (lane == e) ? __builtin_popcountll(m) : mytot; }
    unsigned base = 0u;
    if (lane < 32 && mytot > 0) base = atomicAdd(F.ctl + CW_CNT + lane, (unsigned)mytot);
    const unsigned slot = (unsigned)__shfl((int)base, me) + (unsigned)rank;
    F.list()[me * ECAP + slot] = (int)(t0 * 4 + lane); (void)my_rs;
    LDS_WAIT();
}

__device__ __forceinline__ void expert_tables(Frame& F) {
    LAS int* tab = (LAS int*)(F.lds + TAB_OFF);
    if (F.tid < 32) tab[F.tid] = (int)__hip_atomic_load(F.ctl + CW_CNT + F.tid, __ATOMIC_RELAXED, __HIP_MEMORY_SCOPE_AGENT);
    __syncthreads();
    if (F.tid == 0) { int s = 0; for (int e = 0; e < 32; ++e) { tab[32 + e] = s; s += (tab[e] + 255) >> 8; } tab[64] = s; }
    __syncthreads();
}
template <int NTN, bool GATH> struct ProbExp {
    static constexpr bool GATHER = GATH, gather = GATH, FP8 = true; static constexpr int WSCALE = FP8_WSCALE;
    int K, lda, ldb, G, c; const LAS int* tab; const unsigned char* A; const unsigned char* Bt; const int* list; mutable int ehint;
    __device__ __forceinline__ bool next(int i, Unit& u) const {
        const int L = i * G + c; if (L >= NTN * tab[64]) return false;
        int e = ehint;
#pragma unroll 1
        while (e < 31 && L >= NTN * tab[32 + e + 1]) ++e;
        ehint = e;
        const int r = L - NTN * tab[32 + e], mte = tab[32 + e + 1] - tab[32 + e];
        u.aux = e; u.pn = r / mte; u.pm = r % mte; return true;
    }
    __device__ __forceinline__ const char* a_base(const Unit& u) const { return gather ? (const char*)A : (const char*)(A + (size_t)(tab[32 + u.aux] + u.pm) * 256 * D); }
    __device__ __forceinline__ const char* b_base(const Unit& u) const { return (const char*)(Bt + ((size_t)u.aux * NTN + u.pn) * 256 * D); }
    __device__ __forceinline__ unsigned a_off(const Unit& u, int row, int C) const {
        if (!gather) return (unsigned)(row * D + C * 2);
        const int slot = u.pm * 256 + row; const int av = list[u.aux * ECAP + slot];
        const int a = slot < tab[u.aux] ? av : 0;
        return (unsigned)((a >> 2) * D + C * 2);
    }
};
struct EpiE1 {
    static constexpr bool MID = false;
    const LAS int* tab; const float* lscale; const float* b1; unsigned char* act;
    __device__ __forceinline__ void operator()(const f32x4 (&acc)[2][2][4][2], const Unit& u, int wr, int wc, int fr, int fq) const {
        asm volatile("" : "+v"(fr), "+v"(fq));
        const int e = u.aux; const size_t rbase = (size_t)(tab[32 + e] + u.pm) * 256;
        const int j0 = u.pn * 128 + wc * 32 + 8 * fq;
        const float* bp = b1 + (size_t)e * 2048 + j0;
        const f32x4 bg0 = *(const f32x4*)bp, bg1 = *(const f32x4*)(bp + 4), bl0 = *(const f32x4*)(bp + 1024), bl1 = *(const f32x4*)(bp + 1028);
        const float bg[8] = {bg0.x, bg0.y, bg0.z, bg0.w, bg1.x, bg1.y, bg1.z, bg1.w}, bl[8] = {bl0.x, bl0.y, bl0.z, bl0.w, bl1.x, bl1.y, bl1.z, bl1.w};
#pragma unroll
        for (int ai = 0; ai < 2; ++ai)
#pragma unroll
            for (int m = 0; m < 4; ++m) { const int rt = ai * 128 + wr * 64 + m * 16 + fr; float v[8];
#pragma unroll
                for (int jp = 0; jp < 4; ++jp) {
                    const f32x2 ag = {acc[ai][0][m][jp >> 1][2 * (jp & 1)], acc[ai][0][m][jp >> 1][2 * (jp & 1) + 1]}, al = {acc[ai][1][m][jp >> 1][2 * (jp & 1)], acc[ai][1][m][jp >> 1][2 * (jp & 1) + 1]};
                    const f32x2 bg2 = {bg[2 * jp], bg[2 * jp + 1]}, bl2 = {bl[2 * jp], bl[2 * jp + 1]};
                    const f32x2 ga = ag + bg2, la = al + bl2;
                    const f32x2 glu = {fminf(ga.x, 7.0f), fminf(ga.y, 7.0f)}, lin = {fminf(fmaxf(la.x, -7.0f), 7.0f), fminf(fmaxf(la.y, -7.0f), 7.0f)};
                    const f32x2 t = glu * (-1.702f * 1.4426950408889634f);
                    const f32x2 d = (f32x2){__builtin_amdgcn_exp2f(t.x), __builtin_amdgcn_exp2f(t.y)} + 1.0f;
                    const f32x2 r = {__builtin_amdgcn_rcpf(d.x), __builtin_amdgcn_rcpf(d.y)};
                    const f32x2 o = ((lin + 1.0f) * glu) * r;
                    v[2 * jp] = o.x; v[2 * jp + 1] = o.y; }
                *(u32x2*)(act + (rbase + rt) * D + j0) = pack8_fp8(v); }
    }
};
struct EpiE2 {
    static constexpr bool MID = false;
    const LAS int* tab; const int* list; const float* b2; unsigned char* yb; unsigned char* dummy;
    __device__ __forceinline__ void operator()(const f32x4 (&acc)[2][2][4][2], const Unit& u, int wr, int wc, int fr, int fq) const {
        asm volatile("" : "+v"(fr), "+v"(fq));
        const int e = u.aux, cnt = tab[e]; const int col0 = u.pn * 256 + wc * 32 + 8 * fq;
        float bb[2][8];
#pragma unroll
        for (int bj = 0; bj < 2; ++bj) { const f32x4 x0 = *(const f32x4*)(b2 + (size_t)e * D + col0 + bj * 128), x1 = *(const f32x4*)(b2 + (size_t)e * D + col0 + bj * 128 + 4);
            bb[bj][0] = x0.x; bb[bj][1] = x0.y; bb[bj][2] = x0.z; bb[bj][3] = x0.w; bb[bj][4] = x1.x; bb[bj][5] = x1.y; bb[bj][6] = x1.z; bb[bj][7] = x1.w; }
        int aidx[2][4];
#pragma unroll
        for (int ai = 0; ai < 2; ++ai)
#pragma unroll
            for (int m = 0; m < 4; ++m) aidx[ai][m] = list[e * ECAP + u.pm * 256 + ai * 128 + wr * 64 + m * 16 + fr];
#pragma unroll
        for (int ai = 0; ai < 2; ++ai)
#pragma unroll
            for (int m = 0; m < 4; ++m) { const int slot = u.pm * 256 + ai * 128 + wr * 64 + m * 16 + fr;
                unsigned char* rowp = (slot < cnt) ? yb + (size_t)aidx[ai][m] * D : dummy;
#pragma unroll
                for (int bj = 0; bj < 2; ++bj) { float v[8];
#pragma unroll
                    for (int j = 0; j < 4; ++j) { v[j] = acc[ai][bj][m][0][j] + bb[bj][j]; v[4 + j] = acc[ai][bj][m][1][j] + bb[bj][4 + j]; }
                    *(u32x2*)(rowp + col0 + bj * 128) = pack8_fp8(v); } }
    }
};

struct CombTok { u32x4 x[2]; u32x2 y[2][4]; f32x4 g; };
__device__ __forceinline__ void comb_load(Frame& F, int t, int lane, CombTok& c) {
    c.g = *(const f32x4*)(F.gates() + (size_t)t * 4);
#pragma unroll
    for (int hf = 0; hf < 2; ++hf) { const int col = hf * 512 + lane * 8; c.x[hf] = *(const u32x4*)(F.x2b() + (size_t)t * D + col);
#pragma unroll
        for (int k = 0; k < 4; ++k) c.y[hf][k] = *(const u32x2*)((const unsigned char*)F.yb() + ((size_t)t * 4 + k) * D + col); }
}
__device__ __forceinline__ void comb_finish(Frame& F, int t, int lane, const CombTok& c) {
    const float gk[4] = {c.g.x, c.g.y, c.g.z, c.g.w}; float x[2][8]; float ss = 0.f;
#pragma unroll
    for (int hf = 0; hf < 2; ++hf) { unpack8(c.x[hf], x[hf]);
#pragma unroll
        for (int k = 0; k < 4; ++k) { float y[8]; unpack8_fp8(c.y[hf][k], y);
#pragma unroll
            for (int j = 0; j < 8; ++j) x[hf][j] += gk[k] * y[j]; }
#pragma unroll
        for (int j = 0; j < 8; ++j) ss += x[hf][j] * x[hf][j]; }
    const float rs = rsqrtf(wave_sum(ss) * (1.f / D) + EPS);
#pragma unroll
    for (int hf = 0; hf < 2; ++hf) { const int col = hf * 512 + lane * 8; const f32x4 g0 = *(const f32x4*)(F.A->in[I_NFING] + col), g1 = *(const f32x4*)(F.A->in[I_NFING] + col + 4);
        *(f32x4*)(F.A->out + (size_t)t * D + col) = (f32x4){x[hf][0] * rs * g0.x, x[hf][1] * rs * g0.y, x[hf][2] * rs * g0.z, x[hf][3] * rs * g0.w};
        *(f32x4*)(F.A->out + (size_t)t * D + col + 4) = (f32x4){x[hf][4] * rs * g1.x, x[hf][5] * rs * g1.y, x[hf][6] * rs * g1.z, x[hf][7] * rs * g1.w}; }
}
__device__ __forceinline__ void combine_rows(Frame& F) {
    const int gw = F.vcu * 8 + F.wave, NGW = F.G * 8, lane = F.lane;
    if (gw >= T) return;
    CombTok ca, cb; comb_load(F, gw, lane, ca);
    for (int t = gw;;) {
        const bool hb = t + NGW < T; if (hb) comb_load(F, t + NGW, lane, cb);
        comb_finish(F, t, lane, ca); if (!hb) break;
        const bool ha = t + 2 * NGW < T; if (ha) comb_load(F, t + 2 * NGW, lane, ca);
        comb_finish(F, t + NGW, lane, cb); if (!ha) break;
        t += 2 * NGW; }
}

#ifndef DBG_OUT
#define DBG_OUT 0
#endif
#if DBG_OUT
__device__ __forceinline__ void dbg_rows(Frame& F) {
    const int gw = F.vcu * 8 + F.wave, NGW = F.G * 8, lane = F.lane;
    for (int t = gw; t < T; t += NGW) {
#pragma unroll
        for (int hf = 0; hf < 2; ++hf) { const int col = hf * 512 + lane * 8; float x[8];
#pragma unroll
            for (int j = 0; j < 8; ++j) x[j] = 0.f;
            if (DBG_OUT == 1) { for (int m = 0; m < 5; ++m) { if (col + 1024 * m < PN) { float y[8]; unpack8(*(const u32x4*)(F.p() + (size_t)t * PN + col + 1024 * m), y);
#pragma unroll
                for (int j = 0; j < 8; ++j) x[j] += y[j]; } } }
            else if (DBG_OUT == 8) { for (int k = 0; k < 4; ++k) { float y[8]; unpack8_fp8(*(const u32x2*)((const unsigned char*)F.yb() + ((size_t)t * 4 + k) * D + col), y); const float g = F.gates()[t * 4 + k];
#pragma unroll
                for (int j = 0; j < 8; ++j) x[j] += g * y[j]; } }
            else { const bf16_t* B = DBG_OUT == 2 ? F.oab() : DBG_OUT == 3 ? F.mix() : DBG_OUT == 4 ? F.x1b() : DBG_OUT == 5 ? F.q() : DBG_OUT == 6 ? F.ao() : F.x2b();
                unpack8(*(const u32x4*)(B + (size_t)t * D + col), x); }
#pragma unroll
            for (int j = 0; j < 8; ++j) if (!(fabsf(x[j]) < 1e30f)) x[j] = 1e6f;
            *(f32x4*)(F.A->out + (size_t)t * D + col) = (f32x4){x[0], x[1], x[2], x[3]};
            *(f32x4*)(F.A->out + (size_t)t * D + col + 4) = (f32x4){x[4], x[5], x[6], x[7]}; }
    }
}
#endif

__global__ void __launch_bounds__(512, 2) fwd_kernel(Args args) {
    extern __shared__ __attribute__((aligned(16))) unsigned char lds[];
    Frame F;
    F.lds = (LAS unsigned char*)lds; F.MISC = (volatile LAS unsigned*)(F.lds + MISC_OFF);
    F.tid = threadIdx.x; F.lane = F.tid & 63; F.wave = __builtin_amdgcn_readfirstlane(F.tid >> 6);
    F.G = gridDim.x; { const int bx = blockIdx.x; F.vcu = (F.G % 8 == 0) ? (bx % 8) * (F.G / 8) + bx / 8 : bx; }
    F.ctl = (unsigned*)(args.ws + WS_CTL);
    F.A = &args;
    for (int u = F.tid; u < 64; u += 512) ((LAS unsigned*)(F.lds + MISC_OFF))[u] = 0u;
    __syncthreads();
    XcdBarrier bar; bar.bar = F.ctl + CW_BAR; bar.x = 0; bar.st = nullptr;
    if (!MK_PER_PHASE) bar = xcd_barrier_post(F.ctl + CW_BAR, F.MISC + 8);
    const int lo = args.ph_lo, hi = args.ph_hi;
#ifndef PH_MASK
#define PH_MASK 0x3fff
#endif
#define IN(k) (((PH_MASK >> (k)) & 1) && lo <= (k) && (k) < hi)
#ifndef DOUBLE_MASK
#define DOUBLE_MASK 0
#endif
#define REP(k) for (int _rep = 0; _rep < ((((DOUBLE_MASK) >> (k)) & 1) ? 2 : 1); ++_rep, ((((DOUBLE_MASK) >> (k)) & 1) && _rep == 1 ? xcd_barrier(bar) : (void)0))
#define SEAM(k) do { if (IN(k) && IN((k) + 1)) xcd_barrier(bar); } while (0)
    const int c = (int)blockIdx.x;

    if (IN(0)) REP(0) { p0_prologue(F); } SEAM(0);
    if (IN(1)) REP(1) { ProbP1 P{D, D, ProbP1::EB * D, F.G, c, args.ws}; EpiP1 E{args.ws}; pg8::gemm_phase(F.lds, P, E); } SEAM(1);
    if (IN(2)) REP(2) { for (int u = F.vcu; u < 1024; u += F.G) gla_a_unit(F, u); } SEAM(2);
    if (IN(3)) REP(3) { cvt_range(F, CVT_LATE, CVT_EXPERT);
                        if (F.wave < 4) for (int it = F.vcu * 4 + F.wave; it < 1024; it += F.G * 4) gla_sscan_item(F, it);
                        for (int u = F.vcu; u < 512; u += F.G) sgu_unit(F, u); } SEAM(3);
    if (IN(4)) REP(4) { for (int it = F.vcu * 8 + F.wave; it < 4096; it += F.G * 8) gla_out_item(F, it); } SEAM(4);
    if (IN(5)) REP(5) { ProbStd P{D, D, 2 * D, F.G, c, F.oab(), F.Wpab_t()}; EpiMix2 E{F.p(), F.mix()}; pg8::gemm_phase(F.lds, P, E); } SEAM(5);
    if (IN(6)) REP(6) { ProbStd P{D, D, 2 * D, F.G, c, F.mix(), F.Wmo_t()}; EpiRes<true> E{(const void*)F.A->in[I_X], F.x1b(), F.ssq1(), F.x1q(), nullptr}; pg8::gemm_phase(F.lds, P, E); } SEAM(6);
    if (IN(7)) REP(7) { ProbStdT<true, 0x75757575> P{D, D, D, F.G, c, F.x1q(), F.Wq_t()}; EpiScale E{F.ssq1(), F.q()};     pg8::gemm_phase(F.lds, P, E); } SEAM(7);
    if (IN(8)) REP(8) { for (int u = F.vcu; u < 256; u += F.G) attn_unit(F, u); } SEAM(8);
    if (IN(9)) REP(9) { ProbStdT<true> P{D, D, D, F.G, c, F.ao(), F.Wo_t()}; EpiRes<false> E{(const void*)F.x1b(), F.x2b(), F.ssq2(), nullptr, nullptr}; pg8::gemm_phase(F.lds, P, E); } SEAM(9);
    if (IN(10)) REP(10) { for (int it = F.wave * F.G + F.vcu; it < 1024; it += 8 * F.G) router_item(F, it); cvt_expert128(F); } SEAM(10);
    if (IN(11)) REP(11) { expert_tables(F); const LAS int* tab = (const LAS int*)(F.lds + TAB_OFF);
        ProbExp<8, true> P{D, D, D, F.G, F.vcu, tab, F.x2q(), (const unsigned char*)F.W1_t(), F.list(), 0}; EpiE1 E{tab, F.lscale(), F.A->in[I_BE1], (unsigned char*)F.act()}; pg8::gemm_phase(F.lds, P, E); } SEAM(11);
    if (IN(12)) REP(12) { expert_tables(F); const LAS int* tab = (const LAS int*)(F.lds + TAB_OFF);
        ProbExp<4, false> P{D, D, D, F.G, F.vcu, tab, (const unsigned char*)F.act(), (const unsigned char*)F.W2_t(), F.list(), 0}; EpiE2 E{tab, F.list(), F.A->in[I_BE2], (unsigned char*)F.yb(), (unsigned char*)(args.ws + WS_CTL + 512 * 1024)}; pg8::gemm_phase(F.lds, P, E); } SEAM(12);
#if DBG_OUT
    if (lo <= 13 && 13 < hi) { dbg_rows(F); }
#else
    if (IN(13)) REP(13) { combine_rows(F); }
#endif
#undef IN
#undef SEAM
}

extern "C" void kernel_launch(void* const* d_in, const int* in_sizes, int n_in, void* d_out, int out_size, void* d_ws, size_t ws_size, hipStream_t stream) {
    static int grid = 0;
    if (grid == 0) {
        if (n_in != 28 || in_sizes[0] != T * D || out_size != T * D || ws_size < WS_END) { fprintf(stderr, "kernel_launch: unexpected problem (n_in %d, in0 %d, out %d, ws %zu); nothing launched\n", n_in, n_in > 0 ? in_sizes[0] : -1, out_size, ws_size); grid = -1; return; }
        int dev = 0, cus = 0, per_cu = 0;
        if (hipGetDevice(&dev) != hipSuccess || hipDeviceGetAttribute(&cus, hipDeviceAttributeMultiprocessorCount, dev) != hipSuccess) { grid = -1; return; }
        if (hipFuncSetAttribute((const void*)fwd_kernel, hipFuncAttributeMaxDynamicSharedMemorySize, LDS_BYTES) != hipSuccess) { fprintf(stderr, "kernel_launch: hipFuncSetAttribute failed\n"); grid = -1; return; }
        if (hipOccupancyMaxActiveBlocksPerMultiprocessor(&per_cu, (const void*)fwd_kernel, 512, LDS_BYTES) != hipSuccess || per_cu < 1) fprintf(stderr, "kernel_launch: occupancy query reports %d blocks per CU\n", per_cu);
        (void)hipGetLastError();
        grid = cus;
    }
    if (grid < 0) return;
    if (hipMemsetAsync((char*)d_ws + WS_CTL, 0, CTL_ZERO_BYTES, stream) != hipSuccess) { fprintf(stderr, "kernel_launch: memset failed\n"); return; }
    Args a{};
    for (int i = 0; i < 28; ++i) a.in[i] = (const float*)d_in[i];
    a.out = (float*)d_out; a.ws = (unsigned char*)d_ws;
#if MK_PER_PHASE
    for (int ph = 0; ph < NPHASE; ++ph) { a.ph_lo = ph; a.ph_hi = ph + 1; hipLaunchKernelGGL(fwd_kernel, dim3(grid), dim3(512), LDS_BYTES, stream, a); }
#else
    a.ph_lo = 0; a.ph_hi = NPHASE;
    hipLaunchKernelGGL(fwd_kernel, dim3(grid), dim3(512), LDS_BYTES, stream, a);
#endif
}
```

```cpp
#include <hip/hip_runtime.h>
#include <cstdio>
#include <cstdint>

#ifndef P1_FP8
#define P1_FP8 0
#endif
#ifndef MK_PER_PHASE
#define MK_PER_PHASE 0
#endif

#define LAS __attribute__((address_space(3)))
#define GAS __attribute__((address_space(1)))
typedef unsigned short bf16_t;
typedef short bf16x8 __attribute__((ext_vector_type(8)));
typedef float f32x4 __attribute__((ext_vector_type(4)));
typedef float f32x2 __attribute__((ext_vector_type(2)));
typedef unsigned u32x4 __attribute__((ext_vector_type(4)));
typedef unsigned u32x2 __attribute__((ext_vector_type(2)));
typedef int i32x4 __attribute__((ext_vector_type(4)));
typedef int i32x8 __attribute__((ext_vector_type(8)));
#define FP8_WSCALE 0x79797979
constexpr float FP8_WMUL = 64.0f;
typedef GAS unsigned gu32;

constexpr int T = 16384, D = 1024, NBATCH = 8, SEQ = 2048, MEMLEN = 256, TM = NBATCH * MEMLEN;
constexpr int INC = 4624;
constexpr int PN = 4864;
constexpr int PC_Q = 0, PC_K = 256, PC_V = 512, PC_R = 1024, PC_U = 1536, PC_SV = 2048, PC_GA = 2560, PC_GB = 3584, PC_A = 4608;
constexpr int OFF_A = 1536;
constexpr int NE = 32, NASG = T * 4, ECAP = 16384;
constexpr float EPS = 1e-5f;
constexpr int NPHASE = 14;

constexpr size_t MiB = 1u << 20;
constexpr size_t WS_CTL = 0, CTL_ZERO_BYTES = 1 * MiB;
constexpr size_t WS_WR = 1 * MiB, WS_SGUW = 1 * MiB + 256 * 1024, WS_DECAY = 1 * MiB + 512 * 1024;
constexpr size_t WS_WIN = 2 * MiB, WS_WK = 12 * MiB, WS_WV = 14 * MiB, WS_WPAB = 16 * MiB, WS_WMO = 18 * MiB, WS_WQ = 20 * MiB, WS_WO = 22 * MiB;
constexpr size_t WS_SSQ1 = 24 * MiB, WS_SSQ2 = 25 * MiB, WS_LIST = 26 * MiB, WS_LSCALE = 28 * MiB, WS_GATES = 30 * MiB;
constexpr size_t WS_W1 = 32 * MiB, WS_W2 = 160 * MiB, WS_H = 224 * MiB, WS_MEMN = 256 * MiB, WS_KMEM = 260 * MiB, WS_VT = 264 * MiB, WS_QIN = 268 * MiB;
constexpr size_t WS_OINTRA = 276 * MiB, WS_KVT = 308 * MiB, WS_OAB = 340 * MiB, WS_MIX = 372 * MiB, WS_X1B = 404 * MiB, WS_Q = 436 * MiB, WS_AO = 468 * MiB, WS_X2B = 500 * MiB;
constexpr size_t WS_P = 532 * MiB, WS_ACT = 684 * MiB, WS_YB = 828 * MiB, WS_SPT = 956 * MiB, WS_X2Q = 972 * MiB, WS_X1Q = 988 * MiB, WS_SVS = 1004 * MiB, WS_END = 1005 * MiB;
static_assert(WS_P + (size_t)T * PN * 2 <= WS_ACT && WS_ACT + (size_t)(NASG + NE * 256) * 1024 * 2 <= WS_YB && WS_YB + (size_t)NASG * 1024 * 2 <= WS_END, "ws map");
constexpr int CW_CNT = 64;
constexpr int CW_BAR = 4096;

constexpr int RING_BYTES = 131072;
constexpr int TAB_OFF = 139264, MISC_OFF = 141312, LDS_BYTES = 147456;

typedef __bf16 bf16x2_t __attribute__((ext_vector_type(2)));
__device__ __forceinline__ unsigned cvt_pk_bf16(float lo, float hi) { const f32x2 v = {lo, hi}; const bf16x2_t b = __builtin_convertvector(v, bf16x2_t); return __builtin_bit_cast(unsigned, b); }
__device__ __forceinline__ bf16_t f2bf(float f) { return (bf16_t)(cvt_pk_bf16(f, 0.f) & 0xffffu); }
__device__ __forceinline__ float bflo(unsigned w) { return __uint_as_float(w << 16); }
__device__ __forceinline__ float bfhi(unsigned w) { return __uint_as_float(w & 0xffff0000u); }
__device__ __forceinline__ float bf2f(bf16_t v) { return __uint_as_float((unsigned)v << 16); }
__device__ __forceinline__ void unpack8(const u32x4 w, float (&f)[8]) { f[0] = bflo(w.x); f[1] = bfhi(w.x); f[2] = bflo(w.y); f[3] = bfhi(w.y); f[4] = bflo(w.z); f[5] = bfhi(w.z); f[6] = bflo(w.w); f[7] = bfhi(w.w); }
__device__ __forceinline__ u32x4 pack8(const float (&f)[8]) { u32x4 w; w.x = cvt_pk_bf16(f[0], f[1]); w.y = cvt_pk_bf16(f[2], f[3]); w.z = cvt_pk_bf16(f[4], f[5]); w.w = cvt_pk_bf16(f[6], f[7]); return w; }
__device__ __forceinline__ u32x2 pack8_fp8(const float (&f)[8]) { int a = 0, b = 0;
    a = __builtin_amdgcn_cvt_pk_fp8_f32(f[0], f[1], a, false); a = __builtin_amdgcn_cvt_pk_fp8_f32(f[2], f[3], a, true);
    b = __builtin_amdgcn_cvt_pk_fp8_f32(f[4], f[5], b, false); b = __builtin_amdgcn_cvt_pk_fp8_f32(f[6], f[7], b, true);
    return (u32x2){(unsigned)a, (unsigned)b}; }
__device__ __forceinline__ void unpack8_fp8(const u32x2 w, float (&f)[8]) {
    const f32x2 a = __builtin_amdgcn_cvt_pk_f32_fp8((int)w.x, false), b = __builtin_amdgcn_cvt_pk_f32_fp8((int)w.x, true), c = __builtin_amdgcn_cvt_pk_f32_fp8((int)w.y, false), d = __builtin_amdgcn_cvt_pk_f32_fp8((int)w.y, true);
    f[0] = a.x; f[1] = a.y; f[2] = b.x; f[3] = b.y; f[4] = c.x; f[5] = c.y; f[6] = d.x; f[7] = d.y; }
__device__ __forceinline__ f32x4 mma16(bf16x8 a, bf16x8 b, f32x4 c) { return __builtin_amdgcn_mfma_f32_16x16x32_bf16(a, b, c, 0, 0, 0); }
__device__ __forceinline__ float wave_sum(float v) {
#pragma unroll
    for (int o = 1; o < 64; o <<= 1) v += __shfl_xor(v, o);
    return v;
}
__device__ __forceinline__ float sigmoidf_(float x) { return __builtin_amdgcn_rcpf(1.0f + __expf(-x)); }
__device__ __forceinline__ float gelu_erf(float v) {
    const float av = fabsf(v), t = __builtin_amdgcn_rcpf(av * 0.2316418882f + 1.0f);
    float q = t * 0.5307027145f + (-0.7265760135f); q = q * t + 0.7107068705f; q = q * t + (-0.142248368f); q = q * t + 0.127414796f; q = q * t;
    const float e = __builtin_amdgcn_exp2f((v * v) * (-0.72134752044f));
    const float m = v * (q * e);
    return v < 0.f ? m : v - m;
}
__device__ __forceinline__ f32x2 gelu_pk(f32x2 v) {
    const f32x2 av = __builtin_elementwise_abs(v), d = av * 0.2316418882f + 1.0f;
    f32x2 t; t.x = __builtin_amdgcn_rcpf(d.x); t.y = __builtin_amdgcn_rcpf(d.y);
    f32x2 q = t * 0.5307027145f + (-0.7265760135f); q = q * t + 0.7107068705f; q = q * t + (-0.142248368f); q = q * t + 0.127414796f; q = q * t;
    const f32x2 s = (v * v) * (-0.72134752044f);
    f32x2 e; e.x = __builtin_amdgcn_exp2f(s.x); e.y = __builtin_amdgcn_exp2f(s.y);
    const f32x2 m = v * (q * e), r = v - m;
    f32x2 o; o.x = v.x < 0.f ? m.x : r.x; o.y = v.y < 0.f ? m.y : r.y; return o;
}
__device__ __forceinline__ f32x2 sigmoid_pk(f32x2 v) {
    const f32x2 t = v * (-1.4426950408889634f); const f32x2 d = (f32x2){__builtin_amdgcn_exp2f(t.x), __builtin_amdgcn_exp2f(t.y)} + 1.0f;
    return (f32x2){__builtin_amdgcn_rcpf(d.x), __builtin_amdgcn_rcpf(d.y)};
}
#define LDS_WAIT() asm volatile("s_waitcnt lgkmcnt(0)" ::: "memory")
#define VM_WAIT() asm volatile("s_waitcnt vmcnt(0)" ::: "memory")

#define XB_TMO      128
#define XB_XCNT(j)  (256  + 64 * (j))
#define XB_XSUB(j)  (1280 + 64 * (j))
#define XB_XGEN(j)  (2304 + 64 * (j))
#define XB_TOP      3328
#define XB_TOPGEN   3392
#define XCD_BAR_WORDS 3456
#define XB_SPIN_CAP (1u << 22)
__device__ __forceinline__ unsigned xb_ld(unsigned* p)              { return __hip_atomic_load(p, __ATOMIC_RELAXED, __HIP_MEMORY_SCOPE_AGENT); }
__device__ __forceinline__ unsigned xb_add(unsigned* p, unsigned v) { return __hip_atomic_fetch_add(p, v, __ATOMIC_RELAXED, __HIP_MEMORY_SCOPE_AGENT); }
__device__ __forceinline__ unsigned xb_xcc_id() { return (unsigned)__builtin_amdgcn_s_getreg((3 << 11) | 20) & 0xFu; }
#define XB_SPIN(cond, bar) do { unsigned _sp = 0; while (cond) { __builtin_amdgcn_s_sleep(1); \
    if ((++_sp & 255u) == 0u) { if (xb_ld(&(bar)[XB_TMO])) break; if (_sp > XB_SPIN_CAP) { atomicAdd(&(bar)[XB_TMO], 1u); break; } } } } while (0)
struct XcdBarrier { unsigned* bar; unsigned x; volatile LAS unsigned* st; };
__device__ __forceinline__ XcdBarrier xcd_barrier_post(unsigned* bar, volatile LAS unsigned* st) {
    XcdBarrier b; b.bar = bar; b.x = xb_xcc_id(); b.st = st;
    if (threadIdx.x == 0) (void)xb_add(&bar[XB_XCNT(b.x)], 1u);
    return b;
}
__device__ __forceinline__ void xcd_barrier_complete(unsigned* bar, unsigned x, unsigned& nloc, unsigned& nx) {
    const unsigned G = gridDim.x * gridDim.y * gridDim.z;
    unsigned sum, cnt, mine, sp = 0u;
    for (;;) {
        sum = 0u; cnt = 0u; mine = 0u;
#pragma unroll
        for (unsigned j = 0; j < 16; ++j) { const unsigned c = xb_ld(&bar[XB_XCNT(j)]); sum += c; cnt += (c > 0u) ? 1u : 0u; mine = (j == x) ? c : mine; }
        if (sum == G) break;
        __builtin_amdgcn_s_sleep(1);
        if ((++sp & 255u) == 0u) { if (xb_ld(&bar[XB_TMO])) break; if (sp > XB_SPIN_CAP) { atomicAdd(&bar[XB_TMO], 1u); break; } }
    }
    nloc = mine > 0u ? mine : 1u; nx = cnt > 0u ? cnt : 1u;
}
__device__ __forceinline__ void xcd_barrier(const XcdBarrier& b) {
    asm volatile("s_waitcnt vmcnt(0)" ::: "memory");
    __syncthreads();
    if (threadIdx.x == 0) {
        unsigned* bar = b.bar;
        __builtin_amdgcn_s_waitcnt(0);
        unsigned nloc = b.st[0], nx = b.st[1];
        if (nloc == 0u) { xcd_barrier_complete(bar, b.x, nloc, nx); b.st[0] = nloc; b.st[1] = nx; }
        const unsigned old = xb_add(&bar[XB_XSUB(b.x)], 1u);
        const unsigned gen = old / nloc;
        if (old + 1u == (gen + 1u) * nloc) {
            __builtin_amdgcn_fence(__ATOMIC_RELEASE, "agent");
            asm volatile("s_waitcnt vmcnt(0)" ::: "memory");
            const unsigned og = xb_add(&bar[XB_TOP], 1u);
            const unsigned tg = og / nx;
            if (og + 1u == (tg + 1u) * nx) xb_add(&bar[XB_TOPGEN], 1u);
            else XB_SPIN(xb_ld(&bar[XB_TOPGEN]) == tg, bar);
            __builtin_amdgcn_fence(__ATOMIC_ACQUIRE, "agent");
            xb_add(&bar[XB_XGEN(b.x)], 1u);
            asm volatile("s_waitcnt vmcnt(0)" ::: "memory");
        } else {
            __builtin_amdgcn_fence(__ATOMIC_ACQUIRE, "agent");
            XB_SPIN(xb_ld(&bar[XB_XGEN(b.x)]) == gen, bar);
            asm volatile("s_waitcnt vmcnt(0)" ::: "memory");
        }
    }
    __syncthreads();
}

namespace pg8 {
constexpr int BM = 256, BK = 64, HALF = 128, HTB = HALF * BK * 2, NXCD = 8, WGM = 8;
__host__ __device__ __forceinline__ int lds_byte(int r, int c) { const int st = (r >> 4) * 2 + (c >> 5), rr = r & 15, cc = c & 31, ob = rr * 64 + cc * 2; return st * 1024 + (ob ^ (((ob >> 9) & 1) << 5)); }
__host__ __device__ __forceinline__ void stage_rc(int b, int& R, int& C) { const int st = b / 1024, sb = b % 1024, swz = sb ^ (((sb >> 9) & 1) << 5); R = (st >> 1) * 16 + swz / 64; C = (st & 1) * 32 + (swz % 64) / 2; }
__host__ __device__ __forceinline__ int perm32(int rho) { const int n = rho >> 4, i = rho & 15; return 8 * (i >> 2) + 4 * n + (i & 3); }
struct Unit { int pm, pn, aux; };
__device__ __forceinline__ void map_tile(int L, int nM, int nN, int& pm, int& pn) {
    const int nwg = nM * nN; int wgid = L;
    { const int q = nwg / NXCD, r = nwg % NXCD, xcd = wgid % NXCD, off = wgid / NXCD; wgid = (xcd < r ? xcd * (q + 1) : r * (q + 1) + (xcd - r) * q) + off; }
    const int nig = WGM * nN, gid = wgid / nig, fm = gid * WGM, gsz = (nM - fm) < WGM ? (nM - fm) : WGM;
    pm = fm + ((wgid % nig) % gsz); pn = (wgid % nig) / gsz;
}
template <class Epi, class Prob>
__device__ __forceinline__ void gemm_phase(LAS unsigned char* lds, const Prob& P, const Epi& E) {
    const int tid = threadIdx.x, wid = __builtin_amdgcn_readfirstlane(tid >> 6), lane = tid & 63, wr = wid >> 2, wc = wid & 3, fr = lane & 15, fq = lane >> 4;
    const int nt = P.K / (Prob::FP8 ? 128 : BK);
    unsigned voffB[2];
#pragma unroll
    for (int i = 0; i < 2; ++i) { int R_, C_; stage_rc(tid * 16 + i * 8192, R_, C_); const int Rb = (R_ & ~31) + perm32(R_ & 31); voffB[i] = (unsigned)(Rb * P.ldb + C_ * 2); }
#define PG8_AOFF(dst0, dst1, unit) do { _Pragma("unroll") for (int _i = 0; _i < 2; ++_i) { int R_, C_; stage_rc(tid * 16 + _i * 8192, R_, C_); dst0[_i] = P.a_off(unit, R_, C_); dst1[_i] = P.a_off(unit, R_ + HALF, C_); } } while (0)
    const size_t kstep = (size_t)(BK * 2);
    const size_t hstepB = (size_t)HALF * P.ldb;
    const unsigned ldsw = (unsigned)wid * 1024u;
    const int aoff = lds_byte(wr * 64 + fr, fq * 8), boff = lds_byte(wc * 32 + fr, fq * 8);
#define PG8_SA(b, h) (((b) * 2 + (h)) * HTB)
#define PG8_SB(b, h) ((4 + (b) * 2 + (h)) * HTB)
#define PG8_STAGE(bufoff, gbase, voff) do { _Pragma("unroll") for (int _i = 0; _i < 2; ++_i) \
        __builtin_amdgcn_global_load_lds((const unsigned*)((const char*)(gbase) + (voff)[_i]), (LAS unsigned*)(lds + (bufoff) + ldsw + _i * 8192), 16, 0, 0); } while (0)
#define PG8_LD8(addr) __builtin_shufflevector(*(const LAS i32x4*)(addr), *(const LAS i32x4*)((addr) + 1024), 0, 1, 2, 3, 4, 5, 6, 7)
#define PG8_LDA(dst, b, h) do { _Pragma("unroll") for (int m = 0; m < 4; ++m) dst[m] = PG8_LD8(lds + PG8_SA(b, h) + aoff + m * 2048); } while (0)
#define PG8_LDB(dst, b, h) do { _Pragma("unroll") for (int n = 0; n < 2; ++n) dst[n] = PG8_LD8(lds + PG8_SB(b, h) + boff + n * 2048); } while (0)
#define PG8_LO(x) __builtin_bit_cast(bf16x8, __builtin_shufflevector(x, x, 0, 1, 2, 3))
#define PG8_HI(x) __builtin_bit_cast(bf16x8, __builtin_shufflevector(x, x, 4, 5, 6, 7))
#define PG8_MMA(ai, bj, At, Bt) do { __builtin_amdgcn_s_setprio(1); _Pragma("unroll") for (int m = 0; m < 4; ++m) _Pragma("unroll") for (int n = 0; n < 2; ++n) { \
        if constexpr (Prob::FP8) asm volatile("v_mfma_scale_f32_16x16x128_f8f6f4 %0, %1, %2, %0, %3, %4 op_sel_hi:[0,0,0]" : "+v"(acc[ai][bj][m][n]) : "v"(Bt[n]), "v"(At[m]), "v"(scl_w), "v"(scl_1)); \
        else { acc[ai][bj][m][n] = __builtin_amdgcn_mfma_f32_16x16x32_bf16(PG8_LO(Bt[n]), PG8_LO(At[m]), acc[ai][bj][m][n], 0, 0, 0); \
               acc[ai][bj][m][n] = __builtin_amdgcn_mfma_f32_16x16x32_bf16(PG8_HI(Bt[n]), PG8_HI(At[m]), acc[ai][bj][m][n], 0, 0, 0); } } \
        __builtin_amdgcn_s_setprio(0); } while (0)
#define PG8_WAIT_V(n) asm volatile("s_waitcnt vmcnt(" #n ")" ::: "memory")
#define PG8_WAIT_L(n) asm volatile("s_waitcnt lgkmcnt(" #n ")" ::: "memory")
#define PG8_BAR __builtin_amdgcn_s_barrier()
#define PG8_SCHED __builtin_amdgcn_sched_barrier(0)
    Unit cur, nxt; int ui = 0;
    if (!P.next(0, cur)) return;
    f32x4 acc[2][2][4][2];
#pragma unroll
    for (int a = 0; a < 2; ++a)
#pragma unroll
        for (int b = 0; b < 2; ++b)
#pragma unroll
            for (int m = 0; m < 4; ++m)
#pragma unroll
                for (int n = 0; n < 2; ++n) acc[a][b][m][n] = (f32x4){0.f, 0.f, 0.f, 0.f};
    i32x8 At[4], B0[2], B1[2];
    int scl_w = Prob::WSCALE, scl_1 = 0x7f7f7f7f; asm volatile("" : "+v"(scl_w), "+v"(scl_1));
    unsigned cO0[2], cO1[2], nO0[2], nO1[2];
    PG8_AOFF(cO0, cO1, cur);
    const char* cA = P.a_base(cur); const char* cB = P.b_base(cur);
    PG8_STAGE(PG8_SB(0, 0), cB, voffB); PG8_STAGE(PG8_SB(0, 1), cB + hstepB, voffB); PG8_STAGE(PG8_SA(0, 0), cA, cO0); PG8_STAGE(PG8_SA(0, 1), cA, cO1);
    if (wr == 1) PG8_BAR;
    PG8_WAIT_V(2); PG8_BAR;
    PG8_STAGE(PG8_SB(1, 0), cB + kstep, voffB); PG8_STAGE(PG8_SA(1, 0), cA + kstep, cO0); PG8_STAGE(PG8_SB(1, 1), cB + hstepB + kstep, voffB);
    PG8_WAIT_V(6); PG8_BAR;
    for (;;) {
        const bool has_next = P.next(ui + 1, nxt);
        const char* nA = cA; const char* nB = cB;
        if constexpr (Prob::GATHER) {
#pragma unroll
            for (int i = 0; i < 2; ++i) { nO0[i] = cO0[i]; nO1[i] = cO1[i]; } }
        if (has_next) { nA = P.a_base(nxt); nB = P.b_base(nxt); if constexpr (Prob::GATHER) PG8_AOFF(nO0, nO1, nxt); }
        for (int t = 0; t < nt; t += 2) {
            const bool last = (t == nt - 2);
            const char* a1 = cA + (size_t)(t + 1) * kstep;
            const char* a2 = last ? nA : cA + (size_t)(t + 2) * kstep; const char* b2 = last ? nB : cB + (size_t)(t + 2) * kstep;
            const char* a3 = a2 + kstep; const char* b3 = b2 + kstep;
            unsigned o20[2], o21[2];
#pragma unroll
            for (int i = 0; i < 2; ++i) { if constexpr (Prob::GATHER) { o20[i] = last ? nO0[i] : cO0[i]; o21[i] = last ? nO1[i] : cO1[i]; } else { o20[i] = cO0[i]; o21[i] = cO1[i]; } }
            const bool fin = last && !has_next;
            PG8_LDB(B0, 0, 0); PG8_LDB(B1, 0, 1); PG8_SCHED; PG8_LDA(At, 0, 0); PG8_STAGE(PG8_SA(1, 1), a1, cO1);
            PG8_WAIT_V(8); PG8_WAIT_L(0); PG8_BAR; PG8_MMA(0, 0, At, B0); PG8_MMA(0, 1, At, B1); PG8_BAR; PG8_SCHED;
            PG8_LDA(At, 0, 1);
            if (!fin) { PG8_STAGE(PG8_SB(0, 0), b2, voffB); PG8_STAGE(PG8_SB(0, 1), b2 + hstepB, voffB); PG8_STAGE(PG8_SA(0, 0), a2, o20); PG8_WAIT_V(8); }
            else PG8_WAIT_V(2);
            PG8_WAIT_L(0); PG8_BAR; PG8_MMA(1, 0, At, B0); PG8_MMA(1, 1, At, B1); PG8_BAR; PG8_SCHED;
            PG8_LDB(B0, 1, 0); PG8_LDB(B1, 1, 1); PG8_SCHED; PG8_LDA(At, 1, 0);
            if (!fin) { PG8_STAGE(PG8_SA(0, 1), a2, o21); PG8_WAIT_V(8); }
            else PG8_WAIT_V(0);
            PG8_WAIT_L(0); PG8_BAR; PG8_MMA(0, 0, At, B0); PG8_MMA(0, 1, At, B1); PG8_BAR; PG8_SCHED;
            PG8_LDA(At, 1, 1);
            if (!fin) { PG8_STAGE(PG8_SB(1, 0), b3, voffB); PG8_STAGE(PG8_SB(1, 1), b3 + hstepB, voffB); PG8_STAGE(PG8_SA(1, 0), a3, o20); PG8_WAIT_V(8); }
            PG8_WAIT_L(0); PG8_BAR; PG8_MMA(1, 0, At, B0); PG8_MMA(1, 1, At, B1); PG8_BAR; PG8_SCHED;
            if constexpr (Epi::MID) { if (t + 2 == nt / 2) E.mid(acc, cur, wr, wc, fr, fq); }
        }
        if (wr == 0) PG8_BAR;
        if constexpr (Prob::FP8) asm volatile("s_nop 15\n\ts_nop 15" ::: "memory");
        E(acc, cur, wr, wc, fr, fq);
        if (!has_next) break;
#pragma unroll
        for (int a = 0; a < 2; ++a)
#pragma unroll
            for (int b = 0; b < 2; ++b)
#pragma unroll
                for (int m = 0; m < 4; ++m)
#pragma unroll
                    for (int n = 0; n < 2; ++n) acc[a][b][m][n] = (f32x4){0.f, 0.f, 0.f, 0.f};
        cur = nxt; cA = nA; cB = nB; ++ui;
        if constexpr (Prob::GATHER) {
#pragma unroll
            for (int i = 0; i < 2; ++i) { cO0[i] = nO0[i]; cO1[i] = nO1[i]; } }
        if (wr == 1) PG8_BAR;
    }
    PG8_WAIT_V(0);
    PG8_BAR;
#undef PG8_AOFF
#undef PG8_SA
#undef PG8_SB
#undef PG8_STAGE
#undef PG8_LDA
#undef PG8_LD8
#undef PG8_LO
#undef PG8_HI
#undef PG8_LDB
#undef PG8_MMA
#undef PG8_WAIT_V
#undef PG8_WAIT_L
#undef PG8_BAR
#undef PG8_SCHED
}
}
using pg8::Unit;

struct Args { const float* in[28]; float* out; unsigned char* ws; int ph_lo, ph_hi; };
struct Frame {
    LAS unsigned char* lds;
    volatile LAS unsigned* MISC;
    unsigned* ctl;
    int tid, lane, wave, vcu, G;
    const Args* A;
    __device__ __forceinline__ bf16_t* Win_t() const { return (bf16_t*)(A->ws + WS_WIN); }
    __device__ __forceinline__ bf16_t* Wk_t() const { return (bf16_t*)(A->ws + WS_WK); }
    __device__ __forceinline__ bf16_t* Wv_t() const { return (bf16_t*)(A->ws + WS_WV); }
    __device__ __forceinline__ bf16_t* Wpab_t() const { return (bf16_t*)(A->ws + WS_WPAB); }
    __device__ __forceinline__ bf16_t* Wmo_t() const { return (bf16_t*)(A->ws + WS_WMO); }
    __device__ __forceinline__ bf16_t* Wq_t() const { return (bf16_t*)(A->ws + WS_WQ); }
    __device__ __forceinline__ bf16_t* Wo_t() const { return (bf16_t*)(A->ws + WS_WO); }
    __device__ __forceinline__ bf16_t* Wr_t() const { return (bf16_t*)(A->ws + WS_WR); }
    __device__ __forceinline__ bf16_t* W1_t() const { return (bf16_t*)(A->ws + WS_W1); }
    __device__ __forceinline__ bf16_t* W2_t() const { return (bf16_t*)(A->ws + WS_W2); }
    __device__ __forceinline__ bf16_t* sguw() const { return (bf16_t*)(A->ws + WS_SGUW); }
    __device__ __forceinline__ bf16_t* h() const { return (bf16_t*)(A->ws + WS_H); }
    __device__ __forceinline__ bf16_t* memn() const { return (bf16_t*)(A->ws + WS_MEMN); }
    __device__ __forceinline__ bf16_t* kmem() const { return (bf16_t*)(A->ws + WS_KMEM); }
    __device__ __forceinline__ bf16_t* vt() const { return (bf16_t*)(A->ws + WS_VT); }
    __device__ __forceinline__ bf16_t* qin() const { return (bf16_t*)(A->ws + WS_QIN); }
    __device__ __forceinline__ bf16_t* oab() const { return (bf16_t*)(A->ws + WS_OAB); }
    __device__ __forceinline__ bf16_t* mix() const { return (bf16_t*)(A->ws + WS_MIX); }
    __device__ __forceinline__ bf16_t* x1b() const { return (bf16_t*)(A->ws + WS_X1B); }
    __device__ __forceinline__ bf16_t* q() const { return (bf16_t*)(A->ws + WS_Q); }
    __device__ __forceinline__ bf16_t* ao() const { return (bf16_t*)(A->ws + WS_AO); }
    __device__ __forceinline__ bf16_t* x2b() const { return (bf16_t*)(A->ws + WS_X2B); }
    __device__ __forceinline__ bf16_t* p() const { return (bf16_t*)(A->ws + WS_P); }
    __device__ __forceinline__ bf16_t* act() const { return (bf16_t*)(A->ws + WS_ACT); }
    __device__ __forceinline__ bf16_t* yb() const { return (bf16_t*)(A->ws + WS_YB); }
    __device__ __forceinline__ bf16_t* ointra() const { return (bf16_t*)(A->ws + WS_OINTRA); }
    __device__ __forceinline__ bf16_t* kvT() const { return (bf16_t*)(A->ws + WS_KVT); }
    __device__ __forceinline__ float* decay() const { return (float*)(A->ws + WS_DECAY); }
    __device__ __forceinline__ float* ssq1() const { return (float*)(A->ws + WS_SSQ1); }
    __device__ __forceinline__ float* ssq2() const { return (float*)(A->ws + WS_SSQ2); }
    __device__ __forceinline__ float* lscale() const { return (float*)(A->ws + WS_LSCALE); }
    __device__ __forceinline__ float* gates() const { return (float*)(A->ws + WS_GATES); }
    __device__ __forceinline__ int* list() const { return (int*)(A->ws + WS_LIST); }
    __device__ __forceinline__ bf16_t* spT() const { return (bf16_t*)(A->ws + WS_SPT); }
    __device__ __forceinline__ unsigned char* x2q() const { return (unsigned char*)(A->ws + WS_X2Q); }
    __device__ __forceinline__ unsigned char* x1q() const { return (unsigned char*)(A->ws + WS_X1Q); }
};
enum { I_X = 0, I_MEM, I_NMIXG, I_WIN, I_WA2, I_BA, I_GOUTG, I_SNG, I_SNB, I_SW, I_SB, I_WPA, I_WPB, I_WMO, I_NXG, I_NMEMG, I_WXQ, I_WXK, I_WXV, I_WXO, I_NFFNG, I_WR, I_BR, I_WE1, I_BE1, I_WE2, I_BE2, I_NFING };

struct CvtItem { const float* src; size_t ldw; unsigned char* dst; const float* kscale; float mul; int fp8; };
__device__ __forceinline__ void cvt_load(const CvtItem& c, float (&v)[64]) {
#pragma unroll
    for (int i = 0; i < 64; ++i) v[i] = __builtin_nontemporal_load(c.src + (size_t)i * c.ldw);
}
__device__ __forceinline__ void cvt_finish(const CvtItem& c, float (&v)[64]) {
    if (c.kscale) {
#pragma unroll
        for (int i = 0; i < 64; ++i) v[i] *= c.kscale[i] * c.mul; }
    else {
#pragma unroll
        for (int i = 0; i < 64; ++i) v[i] *= c.mul; }
    if (c.fp8) {
#pragma unroll
        for (int q = 0; q < 4; ++q) { const float f0[8] = {v[16 * q], v[16 * q + 1], v[16 * q + 2], v[16 * q + 3], v[16 * q + 4], v[16 * q + 5], v[16 * q + 6], v[16 * q + 7]};
            const float f1[8] = {v[16 * q + 8], v[16 * q + 9], v[16 * q + 10], v[16 * q + 11], v[16 * q + 12], v[16 * q + 13], v[16 * q + 14], v[16 * q + 15]};
            const u32x2 lo = pack8_fp8(f0), hi = pack8_fp8(f1); *(u32x4*)(c.dst + 16 * q) = (u32x4){lo.x, lo.y, hi.x, hi.y}; } }
    else {
#pragma unroll
        for (int q = 0; q < 8; ++q) { const float f[8] = {v[8 * q], v[8 * q + 1], v[8 * q + 2], v[8 * q + 3], v[8 * q + 4], v[8 * q + 5], v[8 * q + 6], v[8 * q + 7]}; *(u32x4*)(c.dst + 16 * q) = pack8(f); } }
}
__device__ __forceinline__ CvtItem cvt_desc(const float* W, int ldw, int src_col0, int k0, void* WT, int ldt, int dst_row0, int dst_k0, const float* kscale, float mul, int fp8, int lane) {
    CvtItem c; const int eb = fp8 ? 1 : 2;
    c.src = W + (size_t)k0 * ldw + src_col0 + lane; c.ldw = (size_t)ldw; c.dst = (unsigned char*)WT + ((size_t)(dst_row0 + lane) * ldt + dst_k0 + k0) * eb;
    c.kscale = kscale ? kscale + k0 : nullptr; c.mul = mul; c.fp8 = fp8; return c;
}
__device__ __forceinline__ void cvt_expert128(Frame& F) {
    const int gw = F.vcu * 8 + F.wave, NGW = F.G * 8, lane = F.lane;
    constexpr int I1 = NE * 8 * 32, I2 = NE * 8 * 16;
    for (int it = gw; it < I1 + I2; it += NGW) {
        const float* src; size_t ldw; unsigned char* dst; const float* ks; (void)ks;
        if (it < I1) { const int e = it >> 8, q = it & 255, kb = q >> 5, nb = q & 31, nd = nb * 64; const int sc = ((nd & 128) ? 1024 : 0) + 128 * (nd >> 8) + (nd & 127);
            src = F.A->in[I_WE1] + (size_t)e * D * 2048 + (size_t)(kb * 128) * 2048 + sc + lane; ldw = 2048;
            dst = (unsigned char*)F.W1_t() + (size_t)e * 2048 * D + (size_t)(nd + lane) * D + kb * 128; ks = nullptr; }
        else { const int r = it - I1, e = r >> 7, q = r & 127, kb = q >> 4, nb = q & 15;
            src = F.A->in[I_WE2] + (size_t)e * D * D + (size_t)(kb * 128) * D + nb * 64 + lane; ldw = D;
            dst = (unsigned char*)F.W2_t() + (size_t)e * D * D + (size_t)(nb * 64 + lane) * D + kb * 128; ks = nullptr; }
        float v[128]; const float* pp = src;
#pragma unroll
        for (int i = 0; i < 128; ++i) { v[i] = __builtin_nontemporal_load(pp); pp += ldw; asm volatile("" : "+v"(pp)); }
#pragma unroll
        for (int i = 0; i < 128; ++i) v[i] *= FP8_WMUL;
#pragma unroll
        for (int q = 0; q < 8; ++q) { const float f0[8] = {v[16 * q], v[16 * q + 1], v[16 * q + 2], v[16 * q + 3], v[16 * q + 4], v[16 * q + 5], v[16 * q + 6], v[16 * q + 7]};
            const float f1[8] = {v[16 * q + 8], v[16 * q + 9], v[16 * q + 10], v[16 * q + 11], v[16 * q + 12], v[16 * q + 13], v[16 * q + 14], v[16 * q + 15]};
            const u32x2 lo = pack8_fp8(f0), hi = pack8_fp8(f1); *(u32x4*)(dst + 16 * q) = (u32x4){lo.x, lo.y, hi.x, hi.y}; }
    }
}
template <bool Q8>
__device__ __forceinline__ void rms_row_to_bf16(const float* xrow, const float* g, bf16_t* orow, int lane) {
    f32x4 v[4]; float s = 0.f;
#pragma unroll
    for (int j = 0; j < 4; ++j) { v[j] = *(const f32x4*)(xrow + 256 * j + 4 * lane); s += (v[j].x * v[j].x + v[j].y * v[j].y) + (v[j].z * v[j].z + v[j].w * v[j].w); }
    const float rs = rsqrtf(wave_sum(s) * (1.f / D) + EPS);
#pragma unroll
    for (int j = 0; j < 4; ++j) { const f32x4 gg = *(const f32x4*)(g + 256 * j + 4 * lane);
        if constexpr (Q8) { int w = 0; w = __builtin_amdgcn_cvt_pk_fp8_f32(v[j].x * rs * gg.x, v[j].y * rs * gg.y, w, false); w = __builtin_amdgcn_cvt_pk_fp8_f32(v[j].z * rs * gg.z, v[j].w * rs * gg.w, w, true);
            *(int*)((unsigned char*)orow + 256 * j + 4 * lane) = w; }
        else { u32x2 o; o.x = cvt_pk_bf16(v[j].x * rs * gg.x, v[j].y * rs * gg.y); o.y = cvt_pk_bf16(v[j].z * rs * gg.z, v[j].w * rs * gg.w);
            *(u32x2*)(orow + 256 * j + 4 * lane) = o; } }
}
__device__ __forceinline__ void cvt_range(Frame& F, int ibeg, int iend) {
    const int gw = F.vcu * 8 + F.wave, NGW = F.G * 8, lane = F.lane;
    constexpr int N_WIN = 16 * 72, N_SQ = 256, N_PA = 8 * 16, N_E1 = 512, N_E2 = 256;
    constexpr int S_WIN = 0, S_WK = S_WIN + N_WIN, S_WV = S_WK + N_SQ, S_PA = S_WV + N_SQ, S_PB = S_PA + N_PA, S_MO = S_PB + N_PA, S_Q = S_MO + N_SQ, S_O = S_Q + N_SQ, S_E1 = S_O + N_SQ, S_E2 = S_E1 + NE * N_E1, S_END = S_E2 + NE * N_E2;
    static_assert(S_E1 == 16 * 72 + 256 * 2 + 8 * 16 * 2 + 256 * 3 && S_END == S_E1 + NE * 512 + NE * 256, "item ranges");
    const int IEND = iend < S_END ? iend : S_END;
    auto desc = [&](int it) -> CvtItem {
        if (it < S_WK) { const int r = it - S_WIN, kb = r / 72, nb = r % 72, n0 = nb * 64; return cvt_desc(F.A->in[I_WIN], INC, n0 < 1536 ? n0 : n0 + 16, kb * 64, F.Win_t(), D, n0, 0, nullptr, P1_FP8 ? FP8_WMUL : 1.f, P1_FP8, lane); }
        if (it < S_WV) { const int r = it - S_WK; return cvt_desc(F.A->in[I_WXK], D, (r & 15) * 64, (r >> 4) * 64, F.Wk_t(), D, (r & 15) * 64, 0, nullptr, P1_FP8 ? FP8_WMUL : 1.f, P1_FP8, lane); }
        if (it < S_PA) { const int r = it - S_WV; return cvt_desc(F.A->in[I_WXV], D, (r & 15) * 64, (r >> 4) * 64, F.Wv_t(), D, (r & 15) * 64, 0, nullptr, P1_FP8 ? FP8_WMUL : 1.f, P1_FP8, lane); }
        if (it < S_PB) { const int r = it - S_PA; return cvt_desc(F.A->in[I_WPA], D, (r & 15) * 64, (r >> 4) * 64, F.Wpab_t(), D, (r & 15) * 64, 0, nullptr, 1.f, 0, lane); }
        if (it < S_MO) { const int r = it - S_PB; return cvt_desc(F.A->in[I_WPB], D, (r & 15) * 64, (r >> 4) * 64, F.Wpab_t(), D, (r & 15) * 64, 512, nullptr, 1.f, 0, lane); }
        if (it < S_Q)  { const int r = it - S_MO; return cvt_desc(F.A->in[I_WMO], D, (r & 15) * 64, (r >> 4) * 64, F.Wmo_t(), D, (r & 15) * 64, 0, nullptr, 1.f, 0, lane); }
        if (it < S_O)  { const int r = it - S_Q;  return cvt_desc(F.A->in[I_WXQ], D, (r & 15) * 64, (r >> 4) * 64, F.Wq_t(), D, (r & 15) * 64, 0, F.A->in[I_NXG], FP8_WMUL, 1, lane); }
        if (it < S_E1) { const int r = it - S_O;  return cvt_desc(F.A->in[I_WXO], D, (r & 15) * 64, (r >> 4) * 64, F.Wo_t(), D, (r & 15) * 64, 0, nullptr, FP8_WMUL, 1, lane); }
        if (it < S_E2) { const int r = it - S_E1, e = r / N_E1, q = r % N_E1, kb = q >> 5, nb = q & 31, nd = nb * 64;
            const int src = ((nd & 128) ? 1024 : 0) + 128 * (nd >> 8) + (nd & 127);
            return cvt_desc(F.A->in[I_WE1] + (size_t)e * D * 2048, 2048, src, kb * 64, (unsigned char*)F.W1_t() + (size_t)e * 2048 * D, D, nd, 0, F.A->in[I_NFFNG], FP8_WMUL, 1, lane); }
        const int r = it - S_E2, e = r / N_E2, q = r % N_E2;
        return cvt_desc(F.A->in[I_WE2] + (size_t)e * D * D, D, (q & 15) * 64, (q >> 4) * 64, (unsigned char*)F.W2_t() + (size_t)e * D * D, D, (q & 15) * 64, 0, nullptr, FP8_WMUL, 1, lane); };
    if (ibeg + gw < IEND) {
        float va[64], vb[64]; CvtItem ca = desc(ibeg + gw), cb = ca; cvt_load(ca, va);
        for (int it = ibeg + gw;;) {
            const bool hb = it + NGW < IEND; if (hb) { cb = desc(it + NGW); cvt_load(cb, vb); }
            cvt_finish(ca, va); if (!hb) break;
            const bool ha = it + 2 * NGW < IEND; if (ha) { ca = desc(it + 2 * NGW); cvt_load(ca, va); }
            cvt_finish(cb, vb); if (!ha) break;
            it += 2 * NGW; }
    }
}
constexpr int CVT_LATE = 16 * 72 + 256 * 2, CVT_EXPERT = 16 * 72 + 256 * 2 + 8 * 16 * 2 + 256 * 3, CVT_END = CVT_EXPERT + NE * 512 + NE * 256;
__device__ __forceinline__ void p0_prologue(Frame& F) {
    const int gw = F.vcu * 8 + F.wave, NGW = F.G * 8, lane = F.lane;
    cvt_range(F, 0, CVT_LATE);
    for (int m = gw; m < T; m += NGW) rms_row_to_bf16<P1_FP8 != 0>(F.A->in[I_X] + (size_t)m * D, F.A->in[I_NMIXG], (bf16_t*)((unsigned char*)F.h() + (size_t)m * D * (P1_FP8 ? 1 : 2)), lane);
    for (int m = gw; m < TM; m += NGW) rms_row_to_bf16<P1_FP8 != 0>(F.A->in[I_MEM] + (size_t)m * D, F.A->in[I_NMEMG], (bf16_t*)((unsigned char*)F.memn() + (size_t)m * D * (P1_FP8 ? 1 : 2)), lane);
    const int gt = F.vcu * 512 + F.tid, NGT = F.G * 512;
    for (int i = gt; i < 256 * D; i += NGT) { const int j = i >> 10, k = i & 1023; const float* wr_ = F.A->in[I_WIN] + (size_t)k * INC + OFF_A; float s = 0.f;
#pragma unroll
        for (int r = 0; r < 16; ++r) s += wr_[r] * F.A->in[I_WA2][r * 256 + j];
        if (P1_FP8) { int w = __builtin_amdgcn_cvt_pk_fp8_f32(s * FP8_WMUL, 0.f, 0, false); ((unsigned char*)F.Win_t())[(size_t)(PC_A + j) * D + k] = (unsigned char)(w & 0xff); }
        else F.Win_t()[(size_t)(PC_A + j) * D + k] = f2bf(s); }
    for (int i = gt; i < NE * D; i += NGT) { const int e = i >> 10, k = i & 1023; F.Wr_t()[i] = f2bf(F.A->in[I_WR][k * NE + e] * F.A->in[I_NFFNG][k]); }
    for (int i = gt; i < 4 * 128 * 128; i += NGT) { const int t = (i >> 7) & 127, s = i & 127; F.sguw()[i] = f2bf(s <= t ? F.A->in[I_SW][i] : 0.f); }
}

struct ProbP1 {
    static constexpr bool GATHER = false, FP8 = (P1_FP8 != 0); static constexpr int EB = P1_FP8 ? 1 : 2, WSCALE = FP8_WSCALE;
    int K, lda, ldb, G, c; const unsigned char* ws;
    __device__ __forceinline__ bool next(int i, Unit& u) const {
        const int L = i * G + c;
        if (L < 1216) { u.aux = 0; pg8::map_tile(L, 64, 19, u.pm, u.pn); return true; }
        if (L < 1248) { u.aux = 1; u.pm = (L - 1216) >> 2; u.pn = (L - 1216) & 3; return true; }
        if (L < 1280) { u.aux = 2; u.pm = (L - 1248) >> 3; u.pn = (L - 1248) & 7; return true; }
        return false;
    }
    __device__ __forceinline__ const char* a_base(const Unit& u) const { const size_t o = u.aux == 0 ? WS_H : (u.aux == 1 ? WS_MEMN : WS_WV); return (const char*)(ws + o + (size_t)u.pm * 256 * D * EB); }
    __device__ __forceinline__ const char* b_base(const Unit& u) const { const size_t o = u.aux == 0 ? WS_WIN : (u.aux == 1 ? WS_WK : WS_MEMN); return (const char*)(ws + o + (size_t)u.pn * 256 * D * EB); }
    __device__ __forceinline__ unsigned a_off(const Unit&, int row, int C) const { return (unsigned)(row * D * EB + C * 2); }
};
struct EpiP1 {
    static constexpr bool MID = false;
    unsigned char* ws;
    __device__ __forceinline__ void operator()(const f32x4 (&acc)[2][2][4][2], const Unit& u, int wr, int wc, int fr, int fq) const {
        asm volatile("" : "+v"(fr), "+v"(fq));
        const size_t oo = u.aux == 0 ? WS_P : (u.aux == 1 ? WS_KMEM : WS_VT);
        bf16_t* O = (bf16_t*)(ws + oo); const int ldc = u.aux == 0 ? PN : (u.aux == 1 ? D : TM);
        const int act = (u.aux == 0) ? ((u.pn >= 6 && u.pn < 10) ? 1 : ((u.pn >= 10 && u.pn < 18) ? 2 : 0)) : 0;
        const int row0 = u.pm * 256 + wr * 64 + fr, col0 = u.pn * 256 + wc * 32 + 8 * fq; const bool svstat = (u.aux == 0) && (u.pn == 8 || u.pn == 9);
#pragma unroll
        for (int ai = 0; ai < 2; ++ai)
#pragma unroll
            for (int m = 0; m < 4; ++m) { bf16_t* rowp = O + (size_t)(row0 + ai * 128 + m * 16) * ldc + col0; float s1 = 0.f, s2 = 0.f;
#pragma unroll
                for (int bj = 0; bj < 2; ++bj) { float v[8];
#pragma unroll
                    for (int j = 0; j < 4; ++j) { v[j] = acc[ai][bj][m][0][j]; v[4 + j] = acc[ai][bj][m][1][j]; }
                    if (act == 1) {
#pragma unroll
                        for (int j = 0; j < 8; j += 2) { const f32x2 o = gelu_pk((f32x2){v[j], v[j + 1]}); v[j] = o.x; v[j + 1] = o.y; }
#pragma unroll
                        for (int j = 0; j < 8; ++j) { s1 += v[j]; s2 += v[j] * v[j]; } }
                    else if (act == 2) {
#pragma unroll
                        for (int j = 0; j < 8; j += 2) { const f32x2 o = sigmoid_pk((f32x2){v[j], v[j + 1]}); v[j] = o.x; v[j + 1] = o.y; } }
                    *(u32x4*)(rowp + bj * 128) = pack8(v); }
                if (svstat) {
                    s1 += __shfl_xor(s1, 16); s1 += __shfl_xor(s1, 32); s2 += __shfl_xor(s2, 16); s2 += __shfl_xor(s2, 32);
                    if (fq == 0) *(f32x2*)((float*)(ws + WS_SVS) + (size_t)(row0 + ai * 128 + m * 16) * 16 + (u.pn - 8) * 8 + wc * 2) = (f32x2){s1, s2}; } }
    }
};

__device__ __forceinline__ void gla_a_unit(Frame& F, int unit) {
    const int tid = F.tid, lane = F.lane, w = F.wave, fr = lane & 15, fq = lane >> 4;
    const int bh = unit >> 5, n = unit & 31, b = bh >> 2, h = bh & 3;
    const int t0 = b * SEQ + n * 64;
    LAS float* cum = (LAS float*)(F.lds); LAS float* tot = (LAS float*)(F.lds + 16640);
    LAS bf16_t* QIN = (LAS bf16_t*)(F.lds + 18688); LAS bf16_t* KIN = (LAS bf16_t*)(F.lds + 27904); LAS bf16_t* KOT = (LAS bf16_t*)(F.lds + 37120);
    LAS bf16_t* ATT = (LAS bf16_t*)(F.lds + 46336); LAS bf16_t* VT = (LAS bf16_t*)(F.lds + 55552);
    const int c = tid >> 3, d8 = (tid & 7) * 8;
    {
        float g[8]; unpack8(*(const u32x4*)(F.p() + (size_t)(t0 + c) * PN + PC_A + h * 64 + d8), g);
        const f32x4 b0 = *(const f32x4*)(F.A->in[I_BA] + h * 64 + d8), b1 = *(const f32x4*)(F.A->in[I_BA] + h * 64 + d8 + 4);
        const float bb[8] = {b0.x, b0.y, b0.z, b0.w, b1.x, b1.y, b1.z, b1.w};
#pragma unroll
        for (int j = 0; j < 8; ++j) { const float x = g[j] + bb[j]; const float ls = fminf(x, 0.f) - __logf(1.f + __expf(-fabsf(x))); cum[c * 65 + d8 + j] = ls * 0.0625f; }
    }
    __syncthreads();
    { const int d = tid & 63, seg = tid >> 6; float run = 0.f;
#pragma unroll
        for (int i = 0; i < 8; ++i) { run += cum[(seg * 8 + i) * 65 + d]; cum[(seg * 8 + i) * 65 + d] = run; }
        tot[seg * 64 + d] = run; }
    __syncthreads();
    { const int d = tid & 63, seg = tid >> 6; float off = 0.f;
#pragma unroll
        for (int s = 0; s < 7; ++s) if (s < seg) off += tot[s * 64 + d];
#pragma unroll
        for (int i = 0; i < 8; ++i) cum[(seg * 8 + i) * 65 + d] += off; }
    __syncthreads();
    {
        float qv[8], kv[8], qi[8], ki[8];
        unpack8(*(const u32x4*)(F.p() + (size_t)(t0 + c) * PN + PC_Q + h * 64 + d8), qv);
        unpack8(*(const u32x4*)(F.p() + (size_t)(t0 + c) * PN + PC_K + h * 64 + d8), kv);
#pragma unroll
        for (int j = 0; j < 8; ++j) { const float cm = cum[c * 65 + d8 + j], cl = cum[63 * 65 + d8 + j];
            qi[j] = qv[j] * 0.125f * __expf(cm); ki[j] = kv[j] * __expf(-cm);
            KOT[(d8 + j) * 72 + c] = f2bf(kv[j] * __expf(cl - cm));
            if (c == 63) F.decay()[unit * 64 + d8 + j] = __expf(cl); }
        const u32x4 qp = pack8(qi), kp = pack8(ki);
        *(LAS u32x4*)(QIN + c * 72 + d8) = qp; *(LAS u32x4*)(KIN + c * 72 + d8) = kp;
        *(u32x4*)(F.qin() + (size_t)(t0 + c) * 256 + h * 64 + d8) = qp;
        const int e16 = (tid & 7) * 16;
#pragma unroll
        for (int hh = 0; hh < 2; ++hh) { const u32x4 vv = *(const u32x4*)(F.p() + (size_t)(t0 + c) * PN + PC_V + h * 128 + e16 + 8 * hh);
            const unsigned ww[4] = {vv.x, vv.y, vv.z, vv.w};
#pragma unroll
            for (int j = 0; j < 4; ++j) { VT[(e16 + 8 * hh + 2 * j) * 72 + c] = (bf16_t)(ww[j] & 0xffffu); VT[(e16 + 8 * hh + 2 * j + 1) * 72 + c] = (bf16_t)(ww[j] >> 16); } }
    }
    __syncthreads();
    {
        const int mt = w >> 1;
        bf16x8 a[2];
#pragma unroll
        for (int ks = 0; ks < 2; ++ks) a[ks] = *(const LAS bf16x8*)(QIN + (16 * mt + fr) * 72 + 32 * ks + 8 * fq);
#pragma unroll
        for (int q = 0; q < 2; ++q) { const int nt = (w & 1) * 2 + q; f32x4 s = {0.f, 0.f, 0.f, 0.f};
#pragma unroll
            for (int ks = 0; ks < 2; ++ks) s = mma16(a[ks], *(const LAS bf16x8*)(KIN + (16 * nt + fr) * 72 + 32 * ks + 8 * fq), s);
#pragma unroll
            for (int r = 0; r < 4; ++r) { const int cc = 16 * mt + 4 * fq + r, ss = 16 * nt + fr; ATT[cc * 72 + ss] = f2bf(ss <= cc ? s[r] : 0.f); } }
    }
    __syncthreads();
    {
        const int mt = w >> 1, nt0 = (w & 1) * 4;
        bf16x8 aa[2], ak[2];
#pragma unroll
        for (int ks = 0; ks < 2; ++ks) { aa[ks] = *(const LAS bf16x8*)(ATT + (16 * mt + fr) * 72 + 32 * ks + 8 * fq); ak[ks] = *(const LAS bf16x8*)(KOT + (16 * mt + fr) * 72 + 32 * ks + 8 * fq); }
#pragma unroll
        for (int q = 0; q < 4; ++q) { const int nt = nt0 + q; f32x4 o = {0.f, 0.f, 0.f, 0.f}, kvv = {0.f, 0.f, 0.f, 0.f};
#pragma unroll
            for (int ks = 0; ks < 2; ++ks) { const bf16x8 bv = *(const LAS bf16x8*)(VT + (16 * nt + fr) * 72 + 32 * ks + 8 * fq); o = mma16(bv, aa[ks], o); kvv = mma16(ak[ks], bv, kvv); }
            *(u32x2*)(F.ointra() + (size_t)(t0 + 16 * mt + fr) * 512 + h * 128 + 16 * nt + 4 * fq) = (u32x2){cvt_pk_bf16(o[0], o[1]), cvt_pk_bf16(o[2], o[3])};
            *(u32x2*)(F.kvT() + ((size_t)unit * 128 + 16 * nt + fr) * 64 + 16 * mt + 4 * fq) = (u32x2){cvt_pk_bf16(kvv[0], kvv[1]), cvt_pk_bf16(kvv[2], kvv[3])}; }
    }
    __syncthreads();
}

__device__ __forceinline__ void gla_sscan_item(Frame& F, int item) {
    const int lane = F.lane, idx = item * 64 + lane, d4 = idx & 15, e = (idx >> 4) & 127, bh = idx >> 11;
    const bf16_t* kvp = F.kvT() + ((size_t)(bh * 32) * 128 + e) * 64 + d4 * 4; const float* dcp = F.decay() + (size_t)(bh * 32) * 64 + d4 * 4;
    bf16_t* sp = F.spT() + ((size_t)(bh * 32) * 128 + e) * 64 + d4 * 4;
    f32x4 S = {0.f, 0.f, 0.f, 0.f};
    for (int n0 = 0; n0 < 32; n0 += 8) { f32x4 kv[8], dc[8];
#pragma unroll
        for (int i = 0; i < 8; ++i) { const u32x2 kw = *(const u32x2*)(kvp + (size_t)(n0 + i) * 128 * 64); kv[i] = (f32x4){bflo(kw.x), bfhi(kw.x), bflo(kw.y), bfhi(kw.y)}; dc[i] = *(const f32x4*)(dcp + (size_t)(n0 + i) * 64); }
#pragma unroll
        for (int i = 0; i < 8; ++i) { u32x2 o; o.x = cvt_pk_bf16(S.x, S.y); o.y = cvt_pk_bf16(S.z, S.w); *(u32x2*)(sp + (size_t)(n0 + i) * 128 * 64) = o; S = dc[i] * S + kv[i]; } }
}
__device__ __forceinline__ void sgu_unit(Frame& F, int unit) {
    const int tid = F.tid, w = F.wave, lane = F.lane, fr = lane & 15, fq = lane >> 4, ch = unit >> 2, g = unit & 3, t0 = ch * 128;
    LAS f32x2* stat = (LAS f32x2*)F.lds; LAS bf16_t* vnT = (LAS bf16_t*)(F.lds + 1024);
    if (tid < 128) { const float* sp = (const float*)(F.A->ws + WS_SVS) + (size_t)(t0 + tid) * 16;
        const f32x4 a = *(const f32x4*)sp, b = *(const f32x4*)(sp + 4), c4 = *(const f32x4*)(sp + 8), d = *(const f32x4*)(sp + 12);
        const float s = (a.x + a.z) + (b.x + b.z) + (c4.x + c4.z) + (d.x + d.z), s2 = (a.y + a.w) + (b.y + b.w) + (c4.y + c4.w) + (d.y + d.w);
        const float mean = s * (1.f / 512.f), var = fmaxf(s2 * (1.f / 512.f) - mean * mean, 0.f);
        stat[tid] = (f32x2){mean, rsqrtf(var + EPS)}; }
    __syncthreads();
    { const int s = tid >> 2, c32 = (tid & 3) * 32; const f32x2 ms = stat[s];
#pragma unroll
        for (int q = 0; q < 4; ++q) { float v[8]; unpack8(*(const u32x4*)(F.p() + (size_t)(t0 + s) * PN + PC_SV + g * 128 + c32 + 8 * q), v);
#pragma unroll
            for (int j = 0; j < 8; ++j) { const int cidx = g * 128 + c32 + 8 * q + j; vnT[(c32 + 8 * q + j) * 136 + s] = f2bf((v[j] - ms.x) * ms.y * F.A->in[I_SNG][cidx] + F.A->in[I_SNB][cidx]); } } }
    __syncthreads();
    f32x4 acc[8];
#pragma unroll
    for (int ct = 0; ct < 8; ++ct) acc[ct] = (f32x4){0.f, 0.f, 0.f, 0.f};
    const int nks = (16 * w + 15) / 32 + 1;
    for (int ks = 0; ks < nks; ++ks) { const bf16x8 bw = *(const bf16x8*)(F.sguw() + (size_t)(g * 128 + 16 * w + fr) * 128 + 32 * ks + 8 * fq);
#pragma unroll
        for (int ct = 0; ct < 8; ++ct) acc[ct] = mma16(*(const LAS bf16x8*)(vnT + (16 * ct + fr) * 136 + 32 * ks + 8 * fq), bw, acc[ct]); }
    {
        const int t = 16 * w + fr; const float bias = F.A->in[I_SB][g * 128 + t];
        u32x2 uv[8];
#pragma unroll
        for (int ct = 0; ct < 8; ++ct) uv[ct] = *(const u32x2*)(F.p() + (size_t)(t0 + t) * PN + PC_U + g * 128 + 16 * ct + 4 * fq);
#pragma unroll
        for (int ct = 0; ct < 8; ++ct) { const int cidx = g * 128 + 16 * ct + 4 * fq; const u32x2 uu = uv[ct];
            u32x2 o; o.x = cvt_pk_bf16(bflo(uu.x) * (acc[ct][0] + bias), bfhi(uu.x) * (acc[ct][1] + bias)); o.y = cvt_pk_bf16(bflo(uu.y) * (acc[ct][2] + bias), bfhi(uu.y) * (acc[ct][3] + bias));
            *(u32x2*)(F.oab() + (size_t)(t0 + t) * D + 512 + cidx) = o; } }
    __syncthreads();
}
__device__ __forceinline__ void gla_out_item(Frame& F, int item) {
    const int lane = F.lane, fr = lane & 15, fq = lane >> 4, unit = item >> 2, mt = item & 3;
    const int bh = unit >> 5, n = unit & 31, b = bh >> 2, h = bh & 3; const size_t t = (size_t)b * SEQ + n * 64 + 16 * mt + fr;
    bf16x8 qf[2];
#pragma unroll
    for (int ks = 0; ks < 2; ++ks) qf[ks] = *(const bf16x8*)(F.qin() + t * 256 + h * 64 + 32 * ks + 8 * fq);
    const bf16_t* sp = F.spT() + (size_t)unit * 128 * 64;
    f32x4 o[8]; float ss = 0.f;
#pragma unroll
    for (int et = 0; et < 8; ++et) { const u32x2 ow = *(const u32x2*)(F.ointra() + t * 512 + h * 128 + 16 * et + 4 * fq); f32x4 acc = {bflo(ow.x), bfhi(ow.x), bflo(ow.y), bfhi(ow.y)};
#pragma unroll
        for (int ks = 0; ks < 2; ++ks) acc = mma16(*(const bf16x8*)(sp + (size_t)(16 * et + fr) * 64 + 32 * ks + 8 * fq), qf[ks], acc);
        o[et] = acc; ss += (acc[0] * acc[0] + acc[1] * acc[1]) + (acc[2] * acc[2] + acc[3] * acc[3]); }
    ss += __shfl_xor(ss, 16); ss += __shfl_xor(ss, 32);
    const float rstd = rsqrtf(ss * (1.f / 128.f) + EPS);
    f32x4 gv[8]; u32x2 rv[8];
#pragma unroll
    for (int et = 0; et < 8; ++et) { const int e = h * 128 + 16 * et + 4 * fq; gv[et] = *(const f32x4*)(F.A->in[I_GOUTG] + e); rv[et] = *(const u32x2*)(F.p() + t * PN + PC_R + e); }
#pragma unroll
    for (int et = 0; et < 8; ++et) { const int e = h * 128 + 16 * et + 4 * fq; const f32x4 g = gv[et];
        const u32x2 rr = rv[et]; const float r0 = bflo(rr.x), r1 = bfhi(rr.x), r2 = bflo(rr.y), r3 = bfhi(rr.y);
        u32x2 ov; ov.x = cvt_pk_bf16(o[et][0] * rstd * g.x * r0 * sigmoidf_(r0), o[et][1] * rstd * g.y * r1 * sigmoidf_(r1));
        ov.y = cvt_pk_bf16(o[et][2] * rstd * g.z * r2 * sigmoidf_(r2), o[et][3] * rstd * g.w * r3 * sigmoidf_(r3));
        *(u32x2*)(F.oab() + t * D + e) = ov; }
}

struct ProbSeg {
    static constexpr bool GATHER = false, FP8 = false; static constexpr int WSCALE = FP8_WSCALE;
    int K, lda, ldb, G, c; const bf16_t *oab, *Wpab_t;
    __device__ __forceinline__ bool next(int i, Unit& u) const { const int L = (i >> 1) * G + c; if (L >= 256) return false; pg8::map_tile(L, 64, 4, u.pm, u.pn); u.aux = i & 1; return true; }
    __device__ __forceinline__ const char* a_base(const Unit& u) const { return (const char*)(oab + (size_t)u.pm * 256 * D + u.aux * 512); }
    __device__ __forceinline__ const char* b_base(const Unit& u) const { return (const char*)(Wpab_t + (size_t)u.pn * 256 * D + u.aux * 512); }
    __device__ __forceinline__ unsigned a_off(const Unit&, int row, int C) const { return (unsigned)(row * D + C) * 2u; }
};
struct EpiMix {
    static constexpr bool MID = false;
    const bf16_t* p; bf16_t* mix;
    __device__ __forceinline__ void operator()(const f32x4 (&acc)[2][2][4][2], const Unit& u, int wr, int wc, int fr, int fq) const {
        asm volatile("" : "+v"(fr), "+v"(fq));
        const int row0 = u.pm * 256 + wr * 64 + fr, col0 = u.pn * 256 + wc * 32 + 8 * fq, gc = u.aux ? PC_GB : PC_GA;
#pragma unroll
        for (int ai = 0; ai < 2; ++ai) {
            u32x4 gw[4][2], pw[4][2];
#pragma unroll
            for (int m = 0; m < 4; ++m)
#pragma unroll
                for (int bj = 0; bj < 2; ++bj) { const size_t row = (size_t)(row0 + ai * 128 + m * 16);
                    gw[m][bj] = *(const u32x4*)(p + row * PN + gc + col0 + bj * 128);
                    pw[m][bj] = u.aux ? *(const u32x4*)(mix + row * D + col0 + bj * 128) : (u32x4){0u, 0u, 0u, 0u}; }
#pragma unroll
            for (int m = 0; m < 4; ++m)
#pragma unroll
                for (int bj = 0; bj < 2; ++bj) { const size_t row = (size_t)(row0 + ai * 128 + m * 16); float g[8], pv[8], v[8]; unpack8(gw[m][bj], g); unpack8(pw[m][bj], pv);
#pragma unroll
                    for (int j = 0; j < 4; ++j) { v[j] = acc[ai][bj][m][0][j] * g[j] + pv[j]; v[4 + j] = acc[ai][bj][m][1][j] * g[4 + j] + pv[4 + j]; }
                    *(u32x4*)(mix + row * D + col0 + bj * 128) = pack8(v); } }
    }
};

struct EpiMix2 {
    static constexpr bool MID = true;
    const bf16_t* p; bf16_t* mix;
    __device__ __forceinline__ void mid(f32x4 (&acc)[2][2][4][2], const Unit& u, int wr, int wc, int fr, int fq) const {
        asm volatile("" : "+v"(fr), "+v"(fq));
        const int row0 = u.pm * 256 + wr * 64 + fr, col0 = u.pn * 256 + wc * 32 + 8 * fq;
#pragma unroll
        for (int ai = 0; ai < 2; ++ai) { u32x4 ga[4][2], gb[4][2];
#pragma unroll
            for (int m = 0; m < 4; ++m)
#pragma unroll
                for (int bj = 0; bj < 2; ++bj) { const size_t row = (size_t)(row0 + ai * 128 + m * 16); ga[m][bj] = *(const u32x4*)(p + row * PN + PC_GA + col0 + bj * 128); gb[m][bj] = *(const u32x4*)(p + row * PN + PC_GB + col0 + bj * 128); }
#pragma unroll
            for (int m = 0; m < 4; ++m)
#pragma unroll
                for (int bj = 0; bj < 2; ++bj) { float a[8], b[8]; unpack8(ga[m][bj], a); unpack8(gb[m][bj], b);
#pragma unroll
                    for (int j = 0; j < 4; ++j) { acc[ai][bj][m][0][j] *= a[j] * __builtin_amdgcn_rcpf(fmaxf(b[j], 1e-20f)); acc[ai][bj][m][1][j] *= a[4 + j] * __builtin_amdgcn_rcpf(fmaxf(b[4 + j], 1e-20f)); } } }
    }
    __device__ __forceinline__ void operator()(const f32x4 (&acc)[2][2][4][2], const Unit& u, int wr, int wc, int fr, int fq) const {
        asm volatile("" : "+v"(fr), "+v"(fq));
        const int row0 = u.pm * 256 + wr * 64 + fr, col0 = u.pn * 256 + wc * 32 + 8 * fq;
#pragma unroll
        for (int ai = 0; ai < 2; ++ai) { u32x4 gb[4][2];
#pragma unroll
            for (int m = 0; m < 4; ++m)
#pragma unroll
                for (int bj = 0; bj < 2; ++bj) gb[m][bj] = *(const u32x4*)(p + (size_t)(row0 + ai * 128 + m * 16) * PN + PC_GB + col0 + bj * 128);
#pragma unroll
            for (int m = 0; m < 4; ++m)
#pragma unroll
                for (int bj = 0; bj < 2; ++bj) { float b[8], v[8]; unpack8(gb[m][bj], b);
#pragma unroll
                    for (int j = 0; j < 4; ++j) { v[j] = acc[ai][bj][m][0][j] * fmaxf(b[j], 1e-20f); v[4 + j] = acc[ai][bj][m][1][j] * fmaxf(b[4 + j], 1e-20f); }
                    *(u32x4*)(mix + (size_t)(row0 + ai * 128 + m * 16) * D + col0 + bj * 128) = pack8(v); } }
    }
};

template <bool Q8 = false, int WS_ = FP8_WSCALE> struct ProbStdT {
    static constexpr bool GATHER = false, FP8 = Q8; static constexpr int WSCALE = WS_, EB = Q8 ? 1 : 2;
    int K, lda, ldb, G, c; const void *A, *Bt;
    __device__ __forceinline__ bool next(int i, Unit& u) const { const int L = i * G + c; if (L >= 256) return false; pg8::map_tile(L, 64, 4, u.pm, u.pn); u.aux = 0; return true; }
    __device__ __forceinline__ const char* a_base(const Unit& u) const { return (const char*)A + (size_t)u.pm * 256 * D * EB; }
    __device__ __forceinline__ const char* b_base(const Unit& u) const { return (const char*)Bt + (size_t)u.pn * 256 * D * EB; }
    __device__ __forceinline__ unsigned a_off(const Unit&, int row, int C) const { return (unsigned)(row * D * EB + C * 2); }
};
typedef ProbStdT<false> ProbStd;
template <bool RESF32> struct EpiRes {
    static constexpr bool MID = false;
    const void* res; bf16_t* outb; float* ssq; unsigned char* outq; const float* qgain;
    __device__ __forceinline__ void operator()(const f32x4 (&acc)[2][2][4][2], const Unit& u, int wr, int wc, int fr, int fq) const {
        asm volatile("" : "+v"(fr), "+v"(fq));
        const int row0 = u.pm * 256 + wr * 64 + fr, col0 = u.pn * 256 + wc * 32 + 8 * fq;
#pragma unroll
        for (int ai = 0; ai < 2; ++ai) {
            f32x4 rf[4][2][2]; u32x4 rb[4][2];
#pragma unroll
            for (int m = 0; m < 4; ++m)
#pragma unroll
                for (int bj = 0; bj < 2; ++bj) { const size_t off = (size_t)(row0 + ai * 128 + m * 16) * D + col0 + bj * 128;
                    if (RESF32) { rf[m][bj][0] = *(const f32x4*)((const float*)res + off); rf[m][bj][1] = *(const f32x4*)((const float*)res + off + 4); }
                    else rb[m][bj] = *(const u32x4*)((const bf16_t*)res + off); }
#pragma unroll
            for (int m = 0; m < 4; ++m) { const size_t row = (size_t)(row0 + ai * 128 + m * 16); float sq = 0.f;
#pragma unroll
                for (int bj = 0; bj < 2; ++bj) { float r[8], v[8];
                    if (RESF32) { r[0] = rf[m][bj][0].x; r[1] = rf[m][bj][0].y; r[2] = rf[m][bj][0].z; r[3] = rf[m][bj][0].w; r[4] = rf[m][bj][1].x; r[5] = rf[m][bj][1].y; r[6] = rf[m][bj][1].z; r[7] = rf[m][bj][1].w; }
                    else unpack8(rb[m][bj], r);
#pragma unroll
                    for (int j = 0; j < 4; ++j) { v[j] = acc[ai][bj][m][0][j] + r[j]; v[4 + j] = acc[ai][bj][m][1][j] + r[4 + j]; }
#pragma unroll
                    for (int j = 0; j < 8; ++j) sq += v[j] * v[j];
                    *(u32x4*)(outb + row * D + col0 + bj * 128) = pack8(v);
                    if (outq) *(u32x2*)(outq + row * D + col0 + bj * 128) = pack8_fp8(v); }
                sq += __shfl_xor(sq, 16); sq += __shfl_xor(sq, 32);
                if (fq == 0) ssq[row * 16 + u.pn * 4 + wc] = sq; } }
    }
};
__device__ __forceinline__ float row_rs(const float* ssq, size_t row) {
    const f32x4 a = *(const f32x4*)(ssq + row * 16), b = *(const f32x4*)(ssq + row * 16 + 4), c = *(const f32x4*)(ssq + row * 16 + 8), d = *(const f32x4*)(ssq + row * 16 + 12);
    const float s = ((a.x + a.y) + (a.z + a.w)) + ((b.x + b.y) + (b.z + b.w)) + ((c.x + c.y) + (c.z + c.w)) + ((d.x + d.y) + (d.z + d.w));
    return rsqrtf(s * (1.f / D) + EPS);
}
struct EpiScale {
    static constexpr bool MID = false;
    const float* ssq; bf16_t* outb;
    __device__ __forceinline__ void operator()(const f32x4 (&acc)[2][2][4][2], const Unit& u, int wr, int wc, int fr, int fq) const {
        asm volatile("" : "+v"(fr), "+v"(fq));
        const int row0 = u.pm * 256 + wr * 64 + fr, col0 = u.pn * 256 + wc * 32 + 8 * fq;
        float rs[2][4];
#pragma unroll
        for (int ai = 0; ai < 2; ++ai)
#pragma unroll
            for (int m = 0; m < 4; ++m) rs[ai][m] = row_rs(ssq, (size_t)(row0 + ai * 128 + m * 16));
#pragma unroll
        for (int ai = 0; ai < 2; ++ai)
#pragma unroll
            for (int m = 0; m < 4; ++m) { const size_t row = (size_t)(row0 + ai * 128 + m * 16);
#pragma unroll
                for (int bj = 0; bj < 2; ++bj) { float v[8];
#pragma unroll
                    for (int j = 0; j < 4; ++j) { v[j] = acc[ai][bj][m][0][j] * rs[ai][m]; v[4 + j] = acc[ai][bj][m][1][j] * rs[ai][m]; }
                    *(u32x4*)(outb + row * D + col0 + bj * 128) = pack8(v); } }
    }
};

__device__ __forceinline__ void attn_unit(Frame& F, int unit) {
    const int tid = F.tid, w = F.wave, lane = F.lane, fr = lane & 15, fq = lane >> 4;
    const int b = unit >> 5, h = (unit >> 3) & 3, qb = unit & 7;
    const size_t tq = (size_t)b * SEQ + qb * 256 + 32 * w;
    LAS unsigned char* const bufs[2] = {F.lds, F.lds + 36864};
    const bf16_t* kg = F.kmem() + (size_t)(b * 256 + (tid >> 1)) * D + h * 256 + (tid & 1) * 32;
    const int kls = (tid >> 1) * 144 + (tid & 1) * 64;
    const bf16_t* vg = F.vt() + (size_t)(h * 256 + (tid >> 3)) * TM + b * 256 + (tid & 7) * 32;
    const int vls = (tid >> 3) * 528 + (tid & 7) * 64;
    u32x4 st[4];
#pragma unroll
    for (int i = 0; i < 4; ++i) st[i] = *(const u32x4*)(kg + 8 * i);
#pragma unroll
    for (int i = 0; i < 4; ++i) *(LAS u32x4*)(bufs[0] + kls + 16 * i) = st[i];
    __syncthreads();
    f32x4 s[16][2];
#pragma unroll
    for (int nt = 0; nt < 16; ++nt) { s[nt][0] = (f32x4){0.f, 0.f, 0.f, 0.f}; s[nt][1] = (f32x4){0.f, 0.f, 0.f, 0.f}; }
#pragma unroll
    for (int c = 0; c < 4; ++c) {
        if (c < 3) {
#pragma unroll
            for (int i = 0; i < 4; ++i) st[i] = *(const u32x4*)(kg + 64 * (c + 1) + 8 * i); }
        else {
#pragma unroll
            for (int i = 0; i < 4; ++i) st[i] = *(const u32x4*)(vg + 8 * i); }
        LAS unsigned char* kb = bufs[c & 1];
        bf16x8 qf[2][2];
#pragma unroll
        for (int qt = 0; qt < 2; ++qt)
#pragma unroll
            for (int ks = 0; ks < 2; ++ks) qf[qt][ks] = *(const bf16x8*)(F.q() + (tq + 16 * qt + fr) * D + h * 256 + 64 * c + 32 * ks + 8 * fq);
#pragma unroll
        for (int nt = 0; nt < 16; ++nt)
#pragma unroll
            for (int ks = 0; ks < 2; ++ks) { const bf16x8 a = *(const LAS bf16x8*)(kb + (16 * nt + fr) * 144 + (32 * ks + 8 * fq) * 2);
                s[nt][0] = mma16(a, qf[0][ks], s[nt][0]); s[nt][1] = mma16(a, qf[1][ks], s[nt][1]); }
        if (c < 3) {
#pragma unroll
            for (int i = 0; i < 4; ++i) *(LAS u32x4*)(bufs[(c + 1) & 1] + kls + 16 * i) = st[i]; }
        __syncthreads();
    }
#pragma unroll
    for (int i = 0; i < 4; ++i) *(LAS u32x4*)(bufs[0] + vls + 16 * i) = st[i];
    float inv[2]; bf16x8 pb[2][8];
#pragma unroll
    for (int qt = 0; qt < 2; ++qt) { float mx = s[0][qt][0];
#pragma unroll
        for (int nt = 0; nt < 16; ++nt)
#pragma unroll
            for (int r = 0; r < 4; ++r) mx = fmaxf(mx, s[nt][qt][r]);
        mx = fmaxf(mx, __shfl_xor(mx, 16)); mx = fmaxf(mx, __shfl_xor(mx, 32));
        float sum = 0.f;
#pragma unroll
        for (int nt = 0; nt < 16; ++nt)
#pragma unroll
            for (int r = 0; r < 4; ++r) { const float e = __expf(s[nt][qt][r] - mx); s[nt][qt][r] = e; sum += e; }
        sum += __shfl_xor(sum, 16); sum += __shfl_xor(sum, 32);
        inv[qt] = __builtin_amdgcn_rcpf(sum);
#pragma unroll
        for (int sk = 0; sk < 8; ++sk) { const float pv[8] = {s[2 * sk][qt][0], s[2 * sk][qt][1], s[2 * sk][qt][2], s[2 * sk][qt][3], s[2 * sk + 1][qt][0], s[2 * sk + 1][qt][1], s[2 * sk + 1][qt][2], s[2 * sk + 1][qt][3]};
            const u32x4 pk = pack8(pv); pb[qt][sk] = __builtin_bit_cast(bf16x8, pk); } }
    __syncthreads();
#pragma unroll
    for (int c = 0; c < 4; ++c) {
        if (c < 3) {
#pragma unroll
            for (int i = 0; i < 4; ++i) st[i] = *(const u32x4*)(vg + (size_t)64 * (c + 1) * TM + 8 * i); }
        LAS unsigned char* vb = bufs[c & 1];
#pragma unroll
        for (int dt = 0; dt < 4; ++dt) { f32x4 o0 = {0.f, 0.f, 0.f, 0.f}, o1 = {0.f, 0.f, 0.f, 0.f};
#pragma unroll
            for (int sk = 0; sk < 8; ++sk) { const LAS unsigned char* vp = vb + (16 * dt + fr) * 528 + (32 * sk + 4 * fq) * 2;
                const u32x2 lo = *(const LAS u32x2*)vp, hi = *(const LAS u32x2*)(vp + 32);
                const u32x4 av = {lo.x, lo.y, hi.x, hi.y}; const bf16x8 a = __builtin_bit_cast(bf16x8, av);
                o0 = mma16(a, pb[0][sk], o0); o1 = mma16(a, pb[1][sk], o1); }
            const int col = h * 256 + 64 * c + 16 * dt + 4 * fq;
            int w0 = 0, w1 = 0;
            w0 = __builtin_amdgcn_cvt_pk_fp8_f32(o0[0] * inv[0], o0[1] * inv[0], w0, false); w0 = __builtin_amdgcn_cvt_pk_fp8_f32(o0[2] * inv[0], o0[3] * inv[0], w0, true);
            w1 = __builtin_amdgcn_cvt_pk_fp8_f32(o1[0] * inv[1], o1[1] * inv[1], w1, false); w1 = __builtin_amdgcn_cvt_pk_fp8_f32(o1[2] * inv[1], o1[3] * inv[1], w1, true);
            *(int*)((unsigned char*)F.ao() + (tq + fr) * D + col) = w0; *(int*)((unsigned char*)F.ao() + (tq + 16 + fr) * D + col) = w1; }
        if (c < 3) {
#pragma unroll
            for (int i = 0; i < 4; ++i) *(LAS u32x4*)(bufs[(c + 1) & 1] + vls + 16 * i) = st[i]; }
        __syncthreads();
    }
}

__device__ __forceinline__ void router_item(Frame& F, int item) {
    const int w = F.wave, lane = F.lane, fr = lane & 15, fq = lane >> 4;
    const size_t t0 = (size_t)item * 16;
    LAS float* lg = (LAS float*)F.lds + w * (16 * 33 + 64);
    LAS int* ex = (LAS int*)(lg + 16 * 33);
    f32x4 acc[2] = {{0.f, 0.f, 0.f, 0.f}, {0.f, 0.f, 0.f, 0.f}};
    const float rsl = row_rs(F.ssq2(), t0 + fr);
    for (int k0 = 0; k0 < 32; k0 += 8) { bf16x8 a[8], b0[8], b1[8];
#pragma unroll
        for (int i = 0; i < 8; ++i) { a[i] = *(const bf16x8*)(F.x2b() + (t0 + fr) * D + 32 * (k0 + i) + 8 * fq);
            b0[i] = *(const bf16x8*)(F.Wr_t() + (size_t)fr * D + 32 * (k0 + i) + 8 * fq); b1[i] = *(const bf16x8*)(F.Wr_t() + (size_t)(16 + fr) * D + 32 * (k0 + i) + 8 * fq); }
#pragma unroll
        for (int i = 0; i < 8; ++i) { acc[0] = mma16(a[i], b0[i], acc[0]); acc[1] = mma16(a[i], b1[i], acc[1]);
            const int col = 32 * (k0 + i) + 8 * fq; const f32x4 g0 = *(const f32x4*)(F.A->in[I_NFFNG] + col), g1 = *(const f32x4*)(F.A->in[I_NFFNG] + col + 4);
            float xv[8]; unpack8(__builtin_bit_cast(u32x4, a[i]), xv);
            xv[0] *= rsl * g0.x; xv[1] *= rsl * g0.y; xv[2] *= rsl * g0.z; xv[3] *= rsl * g0.w; xv[4] *= rsl * g1.x; xv[5] *= rsl * g1.y; xv[6] *= rsl * g1.z; xv[7] *= rsl * g1.w;
            *(u32x2*)(F.x2q() + (t0 + fr) * D + col) = pack8_fp8(xv); } }
#pragma unroll
    for (int r = 0; r < 4; ++r)
#pragma unroll
        for (int nt = 0; nt < 2; ++nt) lg[(4 * fq + r) * 33 + 16 * nt + fr] = acc[nt][r];
    LDS_WAIT();
    float rs = 0.f, gk[4] = {0.f, 0.f, 0.f, 0.f};
    if (lane < 16) { const size_t t = t0 + lane; rs = row_rs(F.ssq2(), t);
        float v[32];
#pragma unroll
        for (int e = 0; e < 32; ++e) v[e] = lg[lane * 33 + e] * rs + F.A->in[I_BR][e];
        unsigned taken = 0u; float tv[4];
#pragma unroll
        for (int k = 0; k < 4; ++k) { float best = -INFINITY; int bi = 0;
#pragma unroll
            for (int e = 0; e < 32; ++e) { const bool ok = !((taken >> e) & 1u) && (v[e] > best); best = ok ? v[e] : best; bi = ok ? e : bi; }
            taken |= 1u << bi; tv[k] = best; ex[lane * 4 + k] = bi; }
        float sum = 0.f;
#pragma unroll
        for (int k = 0; k < 4; ++k) { gk[k] = __expf(tv[k] - tv[0]); sum += gk[k]; }
        const float inv = 1.f / sum;
        *(f32x4*)(F.gates() + t * 4) = (f32x4){gk[0] * inv, gk[1] * inv, gk[2] * inv, gk[3] * inv}; }
    LDS_WAIT();
    const int me = ex[lane]; const float my_rs = __shfl(rs, lane >> 2);
    int rank = 0, mytot = 0;
#pragma unroll
    for (int e = 0; e < 32; ++e) { const unsigned long long m = __ballot(me == e); const int below = __builtin_popcountll(m & ((1ull << lane) - 1ull));
        rank = (me == e) ? below : rank; mytot = (lane == e) ? __builtin_popcountll(m) : mytot; }
    unsigned base = 0u;
    if (lane < 32 && mytot > 0) base = atomicAdd(F.ctl + CW_CNT + lane, (unsigned)mytot);
    const unsigned slot = (unsigned)__shfl((int)base, me) + (unsigned)rank;
    F.list()[me * ECAP + slot] = (int)(t0 * 4 + lane); (void)my_rs;
    LDS_WAIT();
}

__device__ __forceinline__ void expert_tables(Frame& F) {
    LAS int* tab = (LAS int*)(F.lds + TAB_OFF);
    if (F.tid < 32) tab[F.tid] = (int)__hip_atomic_load(F.ctl + CW_CNT + F.tid, __ATOMIC_RELAXED, __HIP_MEMORY_SCOPE_AGENT);
    __syncthreads();
    if (F.tid == 0) { int s = 0; for (int e = 0; e < 32; ++e) { tab[32 + e] = s; s += (tab[e] + 255) >> 8; } tab[64] = s; }
    __syncthreads();
}
template <int NTN, bool GATH> struct ProbExp {
    static constexpr bool GATHER = GATH, gather = GATH, FP8 = true; static constexpr int WSCALE = FP8_WSCALE;
    int K, lda, ldb, G, c; const LAS int* tab; const unsigned char* A; const unsigned char* Bt; const int* list; mutable int ehint;
    __device__ __forceinline__ bool next(int i, Unit& u) const {
        const int L = i * G + c; if (L >= NTN * tab[64]) return false;
        int e = ehint;
#pragma unroll 1
        while (e < 31 && L >= NTN * tab[32 + e + 1]) ++e;
        ehint = e;
        const int r = L - NTN * tab[32 + e], mte = tab[32 + e + 1] - tab[32 + e];
        u.aux = e; u.pn = r / mte; u.pm = r % mte; return true;
    }
    __device__ __forceinline__ const char* a_base(const Unit& u) const { return gather ? (const char*)A : (const char*)(A + (size_t)(tab[32 + u.aux] + u.pm) * 256 * D); }
    __device__ __forceinline__ const char* b_base(const Unit& u) const { return (const char*)(Bt + ((size_t)u.aux * NTN + u.pn) * 256 * D); }
    __device__ __forceinline__ unsigned a_off(const Unit& u, int row, int C) const {
        if (!gather) return (unsigned)(row * D + C * 2);
        const int slot = u.pm * 256 + row; const int av = list[u.aux * ECAP + slot];
        const int a = slot < tab[u.aux] ? av : 0;
        return (unsigned)((a >> 2) * D + C * 2);
    }
};
struct EpiE1 {
    static constexpr bool MID = false;
    const LAS int* tab; const float* lscale; const float* b1; unsigned char* act;
    __device__ __forceinline__ void operator()(const f32x4 (&acc)[2][2][4][2], const Unit& u, int wr, int wc, int fr, int fq) const {
        asm volatile("" : "+v"(fr), "+v"(fq));
        const int e = u.aux; const size_t rbase = (size_t)(tab[32 + e] + u.pm) * 256;
        const int j0 = u.pn * 128 + wc * 32 + 8 * fq;
        const float* bp = b1 + (size_t)e * 2048 + j0;
        const f32x4 bg0 = *(const f32x4*)bp, bg1 = *(const f32x4*)(bp + 4), bl0 = *(const f32x4*)(bp + 1024), bl1 = *(const f32x4*)(bp + 1028);
        const float bg[8] = {bg0.x, bg0.y, bg0.z, bg0.w, bg1.x, bg1.y, bg1.z, bg1.w}, bl[8] = {bl0.x, bl0.y, bl0.z, bl0.w, bl1.x, bl1.y, bl1.z, bl1.w};
#pragma unroll
        for (int ai = 0; ai < 2; ++ai)
#pragma unroll
            for (int m = 0; m < 4; ++m) { const int rt = ai * 128 + wr * 64 + m * 16 + fr; float v[8];
#pragma unroll
                for (int jp = 0; jp < 4; ++jp) {
                    const f32x2 ag = {acc[ai][0][m][jp >> 1][2 * (jp & 1)], acc[ai][0][m][jp >> 1][2 * (jp & 1) + 1]}, al = {acc[ai][1][m][jp >> 1][2 * (jp & 1)], acc[ai][1][m][jp >> 1][2 * (jp & 1) + 1]};
                    const f32x2 bg2 = {bg[2 * jp], bg[2 * jp + 1]}, bl2 = {bl[2 * jp], bl[2 * jp + 1]};
                    const f32x2 ga = ag + bg2, la = al + bl2;
                    const f32x2 glu = {fminf(ga.x, 7.0f), fminf(ga.y, 7.0f)}, lin = {fminf(fmaxf(la.x, -7.0f), 7.0f), fminf(fmaxf(la.y, -7.0f), 7.0f)};
                    const f32x2 t = glu * (-1.702f * 1.4426950408889634f);
                    const f32x2 d = (f32x2){__builtin_amdgcn_exp2f(t.x), __builtin_amdgcn_exp2f(t.y)} + 1.0f;
                    const f32x2 r = {__builtin_amdgcn_rcpf(d.x), __builtin_amdgcn_rcpf(d.y)};
                    const f32x2 o = ((lin + 1.0f) * glu) * r;
                    v[2 * jp] = o.x; v[2 * jp + 1] = o.y; }
                *(u32x2*)(act + (rbase + rt) * D + j0) = pack8_fp8(v); }
    }
};
struct EpiE2 {
    static constexpr bool MID = false;
    const LAS int* tab; const int* list; const float* b2; unsigned char* yb; unsigned char* dummy;
    __device__ __forceinline__ void operator()(const f32x4 (&acc)[2][2][4][2], const Unit& u, int wr, int wc, int fr, int fq) const {
        asm volatile("" : "+v"(fr), "+v"(fq));
        const int e = u.aux, cnt = tab[e]; const int col0 = u.pn * 256 + wc * 32 + 8 * fq;
        float bb[2][8];
#pragma unroll
        for (int bj = 0; bj < 2; ++bj) { const f32x4 x0 = *(const f32x4*)(b2 + (size_t)e * D + col0 + bj * 128), x1 = *(const f32x4*)(b2 + (size_t)e * D + col0 + bj * 128 + 4);
            bb[bj][0] = x0.x; bb[bj][1] = x0.y; bb[bj][2] = x0.z; bb[bj][3] = x0.w; bb[bj][4] = x1.x; bb[bj][5] = x1.y; bb[bj][6] = x1.z; bb[bj][7] = x1.w; }
        int aidx[2][4];
#pragma unroll
        for (int ai = 0; ai < 2; ++ai)
#pragma unroll
            for (int m = 0; m < 4; ++m) aidx[ai][m] = list[e * ECAP + u.pm * 256 + ai * 128 + wr * 64 + m * 16 + fr];
#pragma unroll
        for (int ai = 0; ai < 2; ++ai)
#pragma unroll
            for (int m = 0; m < 4; ++m) { const int slot = u.pm * 256 + ai * 128 + wr * 64 + m * 16 + fr;
                unsigned char* rowp = (slot < cnt) ? yb + (size_t)aidx[ai][m] * D : dummy;
#pragma unroll
                for (int bj = 0; bj < 2; ++bj) { float v[8];
#pragma unroll
                    for (int j = 0; j < 4; ++j) { v[j] = acc[ai][bj][m][0][j] + bb[bj][j]; v[4 + j] = acc[ai][bj][m][1][j] + bb[bj][4 + j]; }
                    *(u32x2*)(rowp + col0 + bj * 128) = pack8_fp8(v); } }
    }
};

struct CombTok { u32x4 x[2]; u32x2 y[2][4]; f32x4 g; };
__device__ __forceinline__ void comb_load(Frame& F, int t, int lane, CombTok& c) {
    c.g = *(const f32x4*)(F.gates() + (size_t)t * 4);
#pragma unroll
    for (int hf = 0; hf < 2; ++hf) { const int col = hf * 512 + lane * 8; c.x[hf] = *(const u32x4*)(F.x2b() + (size_t)t * D + col);
#pragma unroll
        for (int k = 0; k < 4; ++k) c.y[hf][k] = *(const u32x2*)((const unsigned char*)F.yb() + ((size_t)t * 4 + k) * D + col); }
}
__device__ __forceinline__ void comb_finish(Frame& F, int t, int lane, const CombTok& c) {
    const float gk[4] = {c.g.x, c.g.y, c.g.z, c.g.w}; float x[2][8]; float ss = 0.f;
#pragma unroll
    for (int hf = 0; hf < 2; ++hf) { unpack8(c.x[hf], x[hf]);
#pragma unroll
        for (int k = 0; k < 4; ++k) { float y[8]; unpack8_fp8(c.y[hf][k], y);
#pragma unroll
            for (int j = 0; j < 8; ++j) x[hf][j] += gk[k] * y[j]; }
#pragma unroll
        for (int j = 0; j < 8; ++j) ss += x[hf][j] * x[hf][j]; }
    const float rs = rsqrtf(wave_sum(ss) * (1.f / D) + EPS);
#pragma unroll
    for (int hf = 0; hf < 2; ++hf) { const int col = hf * 512 + lane * 8; const f32x4 g0 = *(const f32x4*)(F.A->in[I_NFING] + col), g1 = *(const f32x4*)(F.A->in[I_NFING] + col + 4);
        *(f32x4*)(F.A->out + (size_t)t * D + col) = (f32x4){x[hf][0] * rs * g0.x, x[hf][1] * rs * g0.y, x[hf][2] * rs * g0.z, x[hf][3] * rs * g0.w};
        *(f32x4*)(F.A->out + (size_t)t * D + col + 4) = (f32x4){x[hf][4] * rs * g1.x, x[hf][5] * rs * g1.y, x[hf][6] * rs * g1.z, x[hf][7] * rs * g1.w}; }
}
__device__ __forceinline__ void combine_rows(Frame& F) {
    const int gw = F.vcu * 8 + F.wave, NGW = F.G * 8, lane = F.lane;
    if (gw >= T) return;
    CombTok ca, cb; comb_load(F, gw, lane, ca);
    for (int t = gw;;) {
        const bool hb = t + NGW < T; if (hb) comb_load(F, t + NGW, lane, cb);
        comb_finish(F, t, lane, ca); if (!hb) break;
        const bool ha = t + 2 * NGW < T; if (ha) comb_load(F, t + 2 * NGW, lane, ca);
        comb_finish(F, t + NGW, lane, cb); if (!ha) break;
        t += 2 * NGW; }
}

#ifndef DBG_OUT
#define DBG_OUT 0
#endif
#if DBG_OUT
__device__ __forceinline__ void dbg_rows(Frame& F) {
    const int gw = F.vcu * 8 + F.wave, NGW = F.G * 8, lane = F.lane;
    for (int t = gw; t < T; t += NGW) {
#pragma unroll
        for (int hf = 0; hf < 2; ++hf) { const int col = hf * 512 + lane * 8; float x[8];
#pragma unroll
            for (int j = 0; j < 8; ++j) x[j] = 0.f;
            if (DBG_OUT == 1) { for (int m = 0; m < 5; ++m) { if (col + 1024 * m < PN) { float y[8]; unpack8(*(const u32x4*)(F.p() + (size_t)t * PN + col + 1024 * m), y);
#pragma unroll
                for (int j = 0; j < 8; ++j) x[j] += y[j]; } } }
            else if (DBG_OUT == 8) { for (int k = 0; k < 4; ++k) { float y[8]; unpack8_fp8(*(const u32x2*)((const unsigned char*)F.yb() + ((size_t)t * 4 + k) * D + col), y); const float g = F.gates()[t * 4 + k];
#pragma unroll
                for (int j = 0; j < 8; ++j) x[j] += g * y[j]; } }
            else { const bf16_t* B = DBG_OUT == 2 ? F.oab() : DBG_OUT == 3 ? F.mix() : DBG_OUT == 4 ? F.x1b() : DBG_OUT == 5 ? F.q() : DBG_OUT == 6 ? F.ao() : F.x2b();
                unpack8(*(const u32x4*)(B + (size_t)t * D + col), x); }
#pragma unroll
            for (int j = 0; j < 8; ++j) if (!(fabsf(x[j]) < 1e30f)) x[j] = 1e6f;
            *(f32x4*)(F.A->out + (size_t)t * D + col) = (f32x4){x[0], x[1], x[2], x[3]};
            *(f32x4*)(F.A->out + (size_t)t * D + col + 4) = (f32x4){x[4], x[5], x[6], x[7]}; }
    }
}
#endif

__global__ void __launch_bounds__(512, 2) fwd_kernel(Args args) {
    extern __shared__ __attribute__((aligned(16))) unsigned char lds[];
    Frame F;
    F.lds = (LAS unsigned char*)lds; F.MISC = (volatile LAS unsigned*)(F.lds + MISC_OFF);
    F.tid = threadIdx.x; F.lane = F.tid & 63; F.wave = __builtin_amdgcn_readfirstlane(F.tid >> 6);
    F.G = gridDim.x; { const int bx = blockIdx.x; F.vcu = (F.G % 8 == 0) ? (bx % 8) * (F.G / 8) + bx / 8 : bx; }
    F.ctl = (unsigned*)(args.ws + WS_CTL);
    F.A = &args;
    for (int u = F.tid; u < 64; u += 512) ((LAS unsigned*)(F.lds + MISC_OFF))[u] = 0u;
    __syncthreads();
    XcdBarrier bar; bar.bar = F.ctl + CW_BAR; bar.x = 0; bar.st = nullptr;
    if (!MK_PER_PHASE) bar = xcd_barrier_post(F.ctl + CW_BAR, F.MISC + 8);
    const int lo = args.ph_lo, hi = args.ph_hi;
#ifndef PH_MASK
#define PH_MASK 0x3fff
#endif
#define IN(k) (((PH_MASK >> (k)) & 1) && lo <= (k) && (k) < hi)
#ifndef DOUBLE_MASK
#define DOUBLE_MASK 0
#endif
#define REP(k) for (int _rep = 0; _rep < ((((DOUBLE_MASK) >> (k)) & 1) ? 2 : 1); ++_rep, ((((DOUBLE_MASK) >> (k)) & 1) && _rep == 1 ? xcd_barrier(bar) : (void)0))
#define SEAM(k) do { if (IN(k) && IN((k) + 1)) xcd_barrier(bar); } while (0)
    const int c = (int)blockIdx.x;

    if (IN(0)) REP(0) { p0_prologue(F); } SEAM(0);
    if (IN(1)) REP(1) { ProbP1 P{D, D, ProbP1::EB * D, F.G, c, args.ws}; EpiP1 E{args.ws}; pg8::gemm_phase(F.lds, P, E); } SEAM(1);
    if (IN(2)) REP(2) { for (int u = F.vcu; u < 1024; u += F.G) gla_a_unit(F, u); } SEAM(2);
    if (IN(3)) REP(3) { cvt_range(F, CVT_LATE, CVT_EXPERT);
                        if (F.wave < 4) for (int it = F.vcu * 4 + F.wave; it < 1024; it += F.G * 4) gla_sscan_item(F, it);
                        for (int u = F.vcu; u < 512; u += F.G) sgu_unit(F, u); } SEAM(3);
    if (IN(4)) REP(4) { for (int it = F.vcu * 8 + F.wave; it < 4096; it += F.G * 8) gla_out_item(F, it); } SEAM(4);
    if (IN(5)) REP(5) { ProbStd P{D, D, 2 * D, F.G, c, F.oab(), F.Wpab_t()}; EpiMix2 E{F.p(), F.mix()}; pg8::gemm_phase(F.lds, P, E); } SEAM(5);
    if (IN(6)) REP(6) { ProbStd P{D, D, 2 * D, F.G, c, F.mix(), F.Wmo_t()}; EpiRes<true> E{(const void*)F.A->in[I_X], F.x1b(), F.ssq1(), F.x1q(), nullptr}; pg8::gemm_phase(F.lds, P, E); } SEAM(6);
    if (IN(7)) REP(7) { ProbStdT<true, 0x75757575> P{D, D, D, F.G, c, F.x1q(), F.Wq_t()}; EpiScale E{F.ssq1(), F.q()};     pg8::gemm_phase(F.lds, P, E); } SEAM(7);
    if (IN(8)) REP(8) { for (int u = F.vcu; u < 256; u += F.G) attn_unit(F, u); } SEAM(8);
    if (IN(9)) REP(9) { ProbStdT<true> P{D, D, D, F.G, c, F.ao(), F.Wo_t()}; EpiRes<false> E{(const void*)F.x1b(), F.x2b(), F.ssq2(), nullptr, nullptr}; pg8::gemm_phase(F.lds, P, E); } SEAM(9);
    if (IN(10)) REP(10) { for (int it = F.wave * F.G + F.vcu; it < 1024; it += 8 * F.G) router_item(F, it); cvt_expert128(F); } SEAM(10);
    if (IN(11)) REP(11) { expert_tables(F); const LAS int* tab = (const LAS int*)(F.lds + TAB_OFF);
        ProbExp<8, true> P{D, D, D, F.G, F.vcu, tab, F.x2q(), (const unsigned char*)F.W1_t(), F.list(), 0}; EpiE1 E{tab, F.lscale(), F.A->in[I_BE1], (unsigned char*)F.act()}; pg8::gemm_phase(F.lds, P, E); } SEAM(11);
    if (IN(12)) REP(12) { expert_tables(F); const LAS int* tab = (const LAS int*)(F.lds + TAB_OFF);
        ProbExp<4, false> P{D, D, D, F.G, F.vcu, tab, (const unsigned char*)F.act(), (const unsigned char*)F.W2_t(), F.list(), 0}; EpiE2 E{tab, F.list(), F.A->in[I_BE2], (unsigned char*)F.yb(), (unsigned char*)(args.ws + WS_CTL + 512 * 1024)}; pg8::gemm_phase(F.lds, P, E); } SEAM(12);
#if DBG_OUT
    if (lo <= 13 && 13 < hi) { dbg_rows(F); }
#else
    if (IN(13)) REP(13) { combine_rows(F); }
#endif
#undef IN
#undef SEAM
}

extern "C" void kernel_launch(void* const* d_in, const int* in_sizes, int n_in, void* d_out, int out_size, void* d_ws, size_t ws_size, hipStream_t stream) {
    static int grid = 0;
    if (grid == 0) {
        if (n_in != 28 || in_sizes[0] != T * D || out_size != T * D || ws_size < WS_END) { fprintf(stderr, "kernel_launch: unexpected problem (n_in %d, in0 %d, out %d, ws %zu); nothing launched\n", n_in, n_in > 0 ? in_sizes[0] : -1, out_size, ws_size); grid = -1; return; }
        int dev = 0, cus = 0, per_cu = 0;
        if (hipGetDevice(&dev) != hipSuccess || hipDeviceGetAttribute(&cus, hipDeviceAttributeMultiprocessorCount, dev) != hipSuccess) { grid = -1; return; }
        if (hipFuncSetAttribute((const void*)fwd_kernel, hipFuncAttributeMaxDynamicSharedMemorySize, LDS_BYTES) != hipSuccess) { fprintf(stderr, "kernel_launch: hipFuncSetAttribute failed\n"); grid = -1; return; }
        if (hipOccupancyMaxActiveBlocksPerMultiprocessor(&per_cu, (const void*)fwd_kernel, 512, LDS_BYTES) != hipSuccess || per_cu < 1) fprintf(stderr, "kernel_launch: occupancy query reports %d blocks per CU\n", per_cu);
        (void)hipGetLastError();
        grid = cus;
    }
    if (grid < 0) return;
    if (hipMemsetAsync((char*)d_ws + WS_CTL, 0, CTL_ZERO_BYTES, stream) != hipSuccess) { fprintf(stderr, "kernel_launch: memset failed\n"); return; }
    Args a{};
    for (int i = 0; i < 28; ++i) a.in[i] = (const float*)d_in[i];
    a.out = (float*)d_out; a.ws = (unsigned char*)d_ws;
#if MK_PER_PHASE
    for (int ph = 0; ph < NPHASE; ++ph) { a.ph_lo = ph; a.ph_hi = ph + 1; hipLaunchKernelGGL(fwd_kernel, dim3(grid), dim3(512), LDS_BYTES, stream, a); }
#else
    a.ph_lo = 0; a.ph_hi = NPHASE;
    hipLaunchKernelGGL(fwd_kernel, dim3(grid), dim3(512), LDS_BYTES, stream, a);
#endif
}
```

```cpp
#include <hip/hip_runtime.h>
#include <cstdio>
#include <cstdint>

#ifndef P1_FP8
#define P1_FP8 0
#endif
#ifndef MK_PER_PHASE
#define MK_PER_PHASE 0
#endif

#define LAS __attribute__((address_space(3)))
#define GAS __attribute__((address_space(1)))
typedef unsigned short bf16_t;
typedef short bf16x8 __attribute__((ext_vector_type(8)));
typedef float f32x4 __attribute__((ext_vector_type(4)));
typedef float f32x2 __attribute__((ext_vector_type(2)));
typedef unsigned u32x4 __attribute__((ext_vector_type(4)));
typedef unsigned u32x2 __attribute__((ext_vector_type(2)));
typedef int i32x4 __attribute__((ext_vector_type(4)));
typedef int i32x8 __attribute__((ext_vector_type(8)));
#define FP8_WSCALE 0x79797979
constexpr float FP8_WMUL = 64.0f;
typedef GAS unsigned gu32;

constexpr int T = 16384, D = 1024, NBATCH = 8, SEQ = 2048, MEMLEN = 256, TM = NBATCH * MEMLEN;
constexpr int INC = 4624;
constexpr int PN = 4864;
constexpr int PC_Q = 0, PC_K = 256, PC_V = 512, PC_R = 1024, PC_U = 1536, PC_SV = 2048, PC_GA = 2560, PC_GB = 3584, PC_A = 4608;
constexpr int OFF_A = 1536;
constexpr int NE = 32, NASG = T * 4, ECAP = 16384;
constexpr float EPS = 1e-5f;
constexpr int NPHASE = 14;

constexpr size_t MiB = 1u << 20;
constexpr size_t WS_CTL = 0, CTL_ZERO_BYTES = 1 * MiB;
constexpr size_t WS_WR = 1 * MiB, WS_SGUW = 1 * MiB + 256 * 1024, WS_DECAY = 1 * MiB + 512 * 1024;
constexpr size_t WS_WIN = 2 * MiB, WS_WK = 12 * MiB, WS_WV = 14 * MiB, WS_WPAB = 16 * MiB, WS_WMO = 18 * MiB, WS_WQ = 20 * MiB, WS_WO = 22 * MiB;
constexpr size_t WS_SSQ1 = 24 * MiB, WS_SSQ2 = 25 * MiB, WS_LIST = 26 * MiB, WS_LSCALE = 28 * MiB, WS_GATES = 30 * MiB;
constexpr size_t WS_W1 = 32 * MiB, WS_W2 = 160 * MiB, WS_H = 224 * MiB, WS_MEMN = 256 * MiB, WS_KMEM = 260 * MiB, WS_VT = 264 * MiB, WS_QIN = 268 * MiB;
constexpr size_t WS_OINTRA = 276 * MiB, WS_KVT = 308 * MiB, WS_OAB = 340 * MiB, WS_MIX = 372 * MiB, WS_X1B = 404 * MiB, WS_Q = 436 * MiB, WS_AO = 468 * MiB, WS_X2B = 500 * MiB;
constexpr size_t WS_P = 532 * MiB, WS_ACT = 684 * MiB, WS_YB = 828 * MiB, WS_SPT = 956 * MiB, WS_X2Q = 972 * MiB, WS_X1Q = 988 * MiB, WS_SVS = 1004 * MiB, WS_END = 1005 * MiB;
static_assert(WS_P + (size_t)T * PN * 2 <= WS_ACT && WS_ACT + (size_t)(NASG + NE * 256) * 1024 * 2 <= WS_YB && WS_YB + (size_t)NASG * 1024 * 2 <= WS_END, "ws map");
constexpr int CW_CNT = 64;
constexpr int CW_BAR = 4096;

constexpr int RING_BYTES = 131072;
constexpr int TAB_OFF = 139264, MISC_OFF = 141312, LDS_BYTES = 147456;

typedef __bf16 bf16x2_t __attribute__((ext_vector_type(2)));
__device__ __forceinline__ unsigned cvt_pk_bf16(float lo, float hi) { const f32x2 v = {lo, hi}; const bf16x2_t b = __builtin_convertvector(v, bf16x2_t); return __builtin_bit_cast(unsigned, b); }
__device__ __forceinline__ bf16_t f2bf(float f) { return (bf16_t)(cvt_pk_bf16(f, 0.f) & 0xffffu); }
__device__ __forceinline__ float bflo(unsigned w) { return __uint_as_float(w << 16); }
__device__ __forceinline__ float bfhi(unsigned w) { return __uint_as_float(w & 0xffff0000u); }
__device__ __forceinline__ float bf2f(bf16_t v) { return __uint_as_float((unsigned)v << 16); }
__device__ __forceinline__ void unpack8(const u32x4 w, float (&f)[8]) { f[0] = bflo(w.x); f[1] = bfhi(w.x); f[2] = bflo(w.y); f[3] = bfhi(w.y); f[4] = bflo(w.z); f[5] = bfhi(w.z); f[6] = bflo(w.w); f[7] = bfhi(w.w); }
__device__ __forceinline__ u32x4 pack8(const float (&f)[8]) { u32x4 w; w.x = cvt_pk_bf16(f[0], f[1]); w.y = cvt_pk_bf16(f[2], f[3]); w.z = cvt_pk_bf16(f[4], f[5]); w.w = cvt_pk_bf16(f[6], f[7]); return w; }
__device__ __forceinline__ u32x2 pack8_fp8(const float (&f)[8]) { int a = 0, b = 0;
    a = __builtin_amdgcn_cvt_pk_fp8_f32(f[0], f[1], a, false); a = __builtin_amdgcn_cvt_pk_fp8_f32(f[2], f[3], a, true);
    b = __builtin_amdgcn_cvt_pk_fp8_f32(f[4], f[5], b, false); b = __builtin_amdgcn_cvt_pk_fp8_f32(f[6], f[7], b, true);
    return (u32x2){(unsigned)a, (unsigned)b}; }
__device__ __forceinline__ void unpack8_fp8(const u32x2 w, float (&f)[8]) {
    const f32x2 a = __builtin_amdgcn_cvt_pk_f32_fp8((int)w.x, false), b = __builtin_amdgcn_cvt_pk_f32_fp8((int)w.x, true), c = __builtin_amdgcn_cvt_pk_f32_fp8((int)w.y, false), d = __builtin_amdgcn_cvt_pk_f32_fp8((int)w.y, true);
    f[0] = a.x; f[1] = a.y; f[2] = b.x; f[3] = b.y; f[4] = c.x; f[5] = c.y; f[6] = d.x; f[7] = d.y; }
__device__ __forceinline__ f32x4 mma16(bf16x8 a, bf16x8 b, f32x4 c) { return __builtin_amdgcn_mfma_f32_16x16x32_bf16(a, b, c, 0, 0, 0); }
__device__ __forceinline__ float wave_sum(float v) {
#pragma unroll
    for (int o = 1; o < 64; o <<= 1) v += __shfl_xor(v, o);
    return v;
}
__device__ __forceinline__ float sigmoidf_(float x) { return __builtin_amdgcn_rcpf(1.0f + __expf(-x)); }
__device__ __forceinline__ float gelu_erf(float v) {
    const float av = fabsf(v), t = __builtin_amdgcn_rcpf(av * 0.2316418882f + 1.0f);
    float q = t * 0.5307027145f + (-0.7265760135f); q = q * t + 0.7107068705f; q = q * t + (-0.142248368f); q = q * t + 0.127414796f; q = q * t;
    const float e = __builtin_amdgcn_exp2f((v * v) * (-0.72134752044f));
    const float m = v * (q * e);
    return v < 0.f ? m : v - m;
}
__device__ __forceinline__ f32x2 gelu_pk(f32x2 v) {
    const f32x2 av = __builtin_elementwise_abs(v), d = av * 0.2316418882f + 1.0f;
    f32x2 t; t.x = __builtin_amdgcn_rcpf(d.x); t.y = __builtin_amdgcn_rcpf(d.y);
    f32x2 q = t * 0.5307027145f + (-0.7265760135f); q = q * t + 0.7107068705f; q = q * t + (-0.142248368f); q = q * t + 0.127414796f; q = q * t;
    const f32x2 s = (v * v) * (-0.72134752044f);
    f32x2 e; e.x = __builtin_amdgcn_exp2f(s.x); e.y = __builtin_amdgcn_exp2f(s.y);
    const f32x2 m = v * (q * e), r = v - m;
    f32x2 o; o.x = v.x < 0.f ? m.x : r.x; o.y = v.y < 0.f ? m.y : r.y; return o;
}
__device__ __forceinline__ f32x2 sigmoid_pk(f32x2 v) {
    const f32x2 t = v * (-1.4426950408889634f); const f32x2 d = (f32x2){__builtin_amdgcn_exp2f(t.x), __builtin_amdgcn_exp2f(t.y)} + 1.0f;
    return (f32x2){__builtin_amdgcn_rcpf(d.x), __builtin_amdgcn_rcpf(d.y)};
}
#define LDS_WAIT() asm volatile("s_waitcnt lgkmcnt(0)" ::: "memory")
#define VM_WAIT() asm volatile("s_waitcnt vmcnt(0)" ::: "memory")

#define XB_TMO      128
#define XB_XCNT(j)  (256  + 64 * (j))
#define XB_XSUB(j)  (1280 + 64 * (j))
#define XB_XGEN(j)  (2304 + 64 * (j))
#define XB_TOP      3328
#define XB_TOPGEN   3392
#define XCD_BAR_WORDS 3456
#define XB_SPIN_CAP (1u << 22)
__device__ __forceinline__ unsigned xb_ld(unsigned* p)              { return __hip_atomic_load(p, __ATOMIC_RELAXED, __HIP_MEMORY_SCOPE_AGENT); }
__device__ __forceinline__ unsigned xb_add(unsigned* p, unsigned v) { return __hip_atomic_fetch_add(p, v, __ATOMIC_RELAXED, __HIP_MEMORY_SCOPE_AGENT); }
__device__ __forceinline__ unsigned xb_xcc_id() { return (unsigned)__builtin_amdgcn_s_getreg((3 << 11) | 20) & 0xFu; }
#define XB_SPIN(cond, bar) do { unsigned _sp = 0; while (cond) { __builtin_amdgcn_s_sleep(1); \
    if ((++_sp & 255u) == 0u) { if (xb_ld(&(bar)[XB_TMO])) break; if (_sp > XB_SPIN_CAP) { atomicAdd(&(bar)[XB_TMO], 1u); break; } } } } while (0)
struct XcdBarrier { unsigned* bar; unsigned x; volatile LAS unsigned* st; };
__device__ __forceinline__ XcdBarrier xcd_barrier_post(unsigned* bar, volatile LAS unsigned* st) {
    XcdBarrier b; b.bar = bar; b.x = xb_xcc_id(); b.st = st;
    if (threadIdx.x == 0) (void)xb_add(&bar[XB_XCNT(b.x)], 1u);
    return b;
}
__device__ __forceinline__ void xcd_barrier_complete(unsigned* bar, unsigned x, unsigned& nloc, unsigned& nx) {
    const unsigned G = gridDim.x * gridDim.y * gridDim.z;
    unsigned sum, cnt, mine, sp = 0u;
    for (;;) {
        sum = 0u; cnt = 0u; mine = 0u;
#pragma unroll
        for (unsigned j = 0; j < 16; ++j) { const unsigned c = xb_ld(&bar[XB_XCNT(j)]); sum += c; cnt += (c > 0u) ? 1u : 0u; mine = (j == x) ? c : mine; }
        if (sum == G) break;
        __builtin_amdgcn_s_sleep(1);
        if ((++sp & 255u) == 0u) { if (xb_ld(&bar[XB_TMO])) break; if (sp > XB_SPIN_CAP) { atomicAdd(&bar[XB_TMO], 1u); break; } }
    }
    nloc = mine > 0u ? mine : 1u; nx = cnt > 0u ? cnt : 1u;
}
__device__ __forceinline__ void xcd_barrier(const XcdBarrier& b) {
    asm volatile("s_waitcnt vmcnt(0)" ::: "memory");
    __syncthreads();
    if (threadIdx.x == 0) {
        unsigned* bar = b.bar;
        __builtin_amdgcn_s_waitcnt(0);
        unsigned nloc = b.st[0], nx = b.st[1];
        if (nloc == 0u) { xcd_barrier_complete(bar, b.x, nloc, nx); b.st[0] = nloc; b.st[1] = nx; }
        const unsigned old = xb_add(&bar[XB_XSUB(b.x)], 1u);
        const unsigned gen = old / nloc;
        if (old + 1u == (gen + 1u) * nloc) {
            __builtin_amdgcn_fence(__ATOMIC_RELEASE, "agent");
            asm volatile("s_waitcnt vmcnt(0)" ::: "memory");
            const unsigned og = xb_add(&bar[XB_TOP], 1u);
            const unsigned tg = og / nx;
            if (og + 1u == (tg + 1u) * nx) xb_add(&bar[XB_TOPGEN], 1u);
            else XB_SPIN(xb_ld(&bar[XB_TOPGEN]) == tg, bar);
            __builtin_amdgcn_fence(__ATOMIC_ACQUIRE, "agent");
            xb_add(&bar[XB_XGEN(b.x)], 1u);
            asm volatile("s_waitcnt vmcnt(0)" ::: "memory");
        } else {
            __builtin_amdgcn_fence(__ATOMIC_ACQUIRE, "agent");
            XB_SPIN(xb_ld(&bar[XB_XGEN(b.x)]) == gen, bar);
            asm volatile("s_waitcnt vmcnt(0)" ::: "memory");
        }
    }
    __syncthreads();
}

namespace pg8 {
constexpr int BM = 256, BK = 64, HALF = 128, HTB = HALF * BK * 2, NXCD = 8, WGM = 8;
__host__ __device__ __forceinline__ int lds_byte(int r, int c) { const int st = (r >> 4) * 2 + (c >> 5), rr = r & 15, cc = c & 31, ob = rr * 64 + cc * 2; return st * 1024 + (ob ^ (((ob >> 9) & 1) << 5)); }
__host__ __device__ __forceinline__ void stage_rc(int b, int& R, int& C) { const int st = b / 1024, sb = b % 1024, swz = sb ^ (((sb >> 9) & 1) << 5); R = (st >> 1) * 16 + swz / 64; C = (st & 1) * 32 + (swz % 64) / 2; }
__host__ __device__ __forceinline__ int perm32(int rho) { const int n = rho >> 4, i = rho & 15; return 8 * (i >> 2) + 4 * n + (i & 3); }
struct Unit { int pm, pn, aux; };
__device__ __forceinline__ void map_tile(int L, int nM, int nN, int& pm, int& pn) {
    const int nwg = nM * nN; int wgid = L;
    { const int q = nwg / NXCD, r = nwg % NXCD, xcd = wgid % NXCD, off = wgid / NXCD; wgid = (xcd < r ? xcd * (q + 1) : r * (q + 1) + (xcd - r) * q) + off; }
    const int nig = WGM * nN, gid = wgid / nig, fm = gid * WGM, gsz = (nM - fm) < WGM ? (nM - fm) : WGM;
    pm = fm + ((wgid % nig) % gsz); pn = (wgid % nig) / gsz;
}
template <class Epi, class Prob>
__device__ __forceinline__ void gemm_phase(LAS unsigned char* lds, const Prob& P, const Epi& E) {
    const int tid = threadIdx.x, wid = __builtin_amdgcn_readfirstlane(tid >> 6), lane = tid & 63, wr = wid >> 2, wc = wid & 3, fr = lane & 15, fq = lane >> 4;
    const int nt = P.K / (Prob::FP8 ? 128 : BK);
    unsigned voffB[2];
#pragma unroll
    for (int i = 0; i < 2; ++i) { int R_, C_; stage_rc(tid * 16 + i * 8192, R_, C_); const int Rb = (R_ & ~31) + perm32(R_ & 31); voffB[i] = (unsigned)(Rb * P.ldb + C_ * 2); }
#define PG8_AOFF(dst0, dst1, unit) do { _Pragma("unroll") for (int _i = 0; _i < 2; ++_i) { int R_, C_; stage_rc(tid * 16 + _i * 8192, R_, C_); dst0[_i] = P.a_off(unit, R_, C_); dst1[_i] = P.a_off(unit, R_ + HALF, C_); } } while (0)
    const size_t kstep = (size_t)(BK * 2);
    const size_t hstepB = (size_t)HALF * P.ldb;
    const unsigned ldsw = (unsigned)wid * 1024u;
    const int aoff = lds_byte(wr * 64 + fr, fq * 8), boff = lds_byte(wc * 32 + fr, fq * 8);
#define PG8_SA(b, h) (((b) * 2 + (h)) * HTB)
#define PG8_SB(b, h) ((4 + (b) * 2 + (h)) * HTB)
#define PG8_STAGE(bufoff, gbase, voff) do { _Pragma("unroll") for (int _i = 0; _i < 2; ++_i) \
        __builtin_amdgcn_global_load_lds((const unsigned*)((const char*)(gbase) + (voff)[_i]), (LAS unsigned*)(lds + (bufoff) + ldsw + _i * 8192), 16, 0, 0); } while (0)
#define PG8_LD8(addr) __builtin_shufflevector(*(const LAS i32x4*)(addr), *(const LAS i32x4*)((addr) + 1024), 0, 1, 2, 3, 4, 5, 6, 7)
#define PG8_LDA(dst, b, h) do { _Pragma("unroll") for (int m = 0; m < 4; ++m) dst[m] = PG8_LD8(lds + PG8_SA(b, h) + aoff + m * 2048); } while (0)
#define PG8_LDB(dst, b, h) do { _Pragma("unroll") for (int n = 0; n < 2; ++n) dst[n] = PG8_LD8(lds + PG8_SB(b, h) + boff + n * 2048); } while (0)
#define PG8_LO(x) __builtin_bit_cast(bf16x8, __builtin_shufflevector(x, x, 0, 1, 2, 3))
#define PG8_HI(x) __builtin_bit_cast(bf16x8, __builtin_shufflevector(x, x, 4, 5, 6, 7))
#define PG8_MMA(ai, bj, At, Bt) do { __builtin_amdgcn_s_setprio(1); _Pragma("unroll") for (int m = 0; m < 4; ++m) _Pragma("unroll") for (int n = 0; n < 2; ++n) { \
        if constexpr (Prob::FP8) asm volatile("v_mfma_scale_f32_16x16x128_f8f6f4 %0, %1, %2, %0, %3, %4 op_sel_hi:[0,0,0]" : "+v"(acc[ai][bj][m][n]) : "v"(Bt[n]), "v"(At[m]), "v"(scl_w), "v"(scl_1)); \
        else { acc[ai][bj][m][n] = __builtin_amdgcn_mfma_f32_16x16x32_bf16(PG8_LO(Bt[n]), PG8_LO(At[m]), acc[ai][bj][m][n], 0, 0, 0); \
               acc[ai][bj][m][n] = __builtin_amdgcn_mfma_f32_16x16x32_bf16(PG8_HI(Bt[n]), PG8_HI(At[m]), acc[ai][bj][m][n], 0, 0, 0); } } \
        __builtin_amdgcn_s_setprio(0); } while (0)
#define PG8_WAIT_V(n) asm volatile("s_waitcnt vmcnt(" #n ")" ::: "memory")
#define PG8_WAIT_L(n) asm volatile("s_waitcnt lgkmcnt(" #n ")" ::: "memory")
#define PG8_BAR __builtin_amdgcn_s_barrier()
#define PG8_SCHED __builtin_amdgcn_sched_barrier(0)
    Unit cur, nxt; int ui = 0;
    if (!P.next(0, cur)) return;
    f32x4 acc[2][2][4][2];
#pragma unroll
    for (int a = 0; a < 2; ++a)
#pragma unroll
        for (int b = 0; b < 2; ++b)
#pragma unroll
            for (int m = 0; m < 4; ++m)
#pragma unroll
                for (int n = 0; n < 2; ++n) acc[a][b][m][n] = (f32x4){0.f, 0.f, 0.f, 0.f};
    i32x8 At[4], B0[2], B1[2];
    int scl_w = Prob::WSCALE, scl_1 = 0x7f7f7f7f; asm volatile("" : "+v"(scl_w), "+v"(scl_1));
    unsigned cO0[2], cO1[2], nO0[2], nO1[2];
    PG8_AOFF(cO0, cO1, cur);
    const char* cA = P.a_base(cur); const char* cB = P.b_base(cur);
    PG8_STAGE(PG8_SB(0, 0), cB, voffB); PG8_STAGE(PG8_SB(0, 1), cB + hstepB, voffB); PG8_STAGE(PG8_SA(0, 0), cA, cO0); PG8_STAGE(PG8_SA(0, 1), cA, cO1);
    if (wr == 1) PG8_BAR;
    PG8_WAIT_V(2); PG8_BAR;
    PG8_STAGE(PG8_SB(1, 0), cB + kstep, voffB); PG8_STAGE(PG8_SA(1, 0), cA + kstep, cO0); PG8_STAGE(PG8_SB(1, 1), cB + hstepB + kstep, voffB);
    PG8_WAIT_V(6); PG8_BAR;
    for (;;) {
        const bool has_next = P.next(ui + 1, nxt);
        const char* nA = cA; const char* nB = cB;
        if constexpr (Prob::GATHER) {
#pragma unroll
            for (int i = 0; i < 2; ++i) { nO0[i] = cO0[i]; nO1[i] = cO1[i]; } }
        if (has_next) { nA = P.a_base(nxt); nB = P.b_base(nxt); if constexpr (Prob::GATHER) PG8_AOFF(nO0, nO1, nxt); }
        for (int t = 0; t < nt; t += 2) {
            const bool last = (t == nt - 2);
            const char* a1 = cA + (size_t)(t + 1) * kstep;
            const char* a2 = last ? nA : cA + (size_t)(t + 2) * kstep; const char* b2 = last ? nB : cB + (size_t)(t + 2) * kstep;
            const char* a3 = a2 + kstep; const char* b3 = b2 + kstep;
            unsigned o20[2], o21[2];
#pragma unroll
            for (int i = 0; i < 2; ++i) { if constexpr (Prob::GATHER) { o20[i] = last ? nO0[i] : cO0[i]; o21[i] = last ? nO1[i] : cO1[i]; } else { o20[i] = cO0[i]; o21[i] = cO1[i]; } }
            const bool fin = last && !has_next;
            PG8_LDB(B0, 0, 0); PG8_LDB(B1, 0, 1); PG8_SCHED; PG8_LDA(At, 0, 0); PG8_STAGE(PG8_SA(1, 1), a1, cO1);
            PG8_WAIT_V(8); PG8_WAIT_L(0); PG8_BAR; PG8_MMA(0, 0, At, B0); PG8_MMA(0, 1, At, B1); PG8_BAR; PG8_SCHED;
            PG8_LDA(At, 0, 1);
            if (!fin) { PG8_STAGE(PG8_SB(0, 0), b2, voffB); PG8_STAGE(PG8_SB(0, 1), b2 + hstepB, voffB); PG8_STAGE(PG8_SA(0, 0), a2, o20); PG8_WAIT_V(8); }
            else PG8_WAIT_V(2);
            PG8_WAIT_L(0); PG8_BAR; PG8_MMA(1, 0, At, B0); PG8_MMA(1, 1, At, B1); PG8_BAR; PG8_SCHED;
            PG8_LDB(B0, 1, 0); PG8_LDB(B1, 1, 1); PG8_SCHED; PG8_LDA(At, 1, 0);
            if (!fin) { PG8_STAGE(PG8_SA(0, 1), a2, o21); PG8_WAIT_V(8); }
            else PG8_WAIT_V(0);
            PG8_WAIT_L(0); PG8_BAR; PG8_MMA(0, 0, At, B0); PG8_MMA(0, 1, At, B1); PG8_BAR; PG8_SCHED;
            PG8_LDA(At, 1, 1);
            if (!fin) { PG8_STAGE(PG8_SB(1, 0), b3, voffB); PG8_STAGE(PG8_SB(1, 1), b3 + hstepB, voffB); PG8_STAGE(PG8_SA(1, 0), a3, o20); PG8_WAIT_V(8); }
            PG8_WAIT_L(0); PG8_BAR; PG8_MMA(1, 0, At, B0); PG8_MMA(1, 1, At, B1); PG8_BAR; PG8_SCHED;
            if constexpr (Epi::MID) { if (t + 2 == nt / 2) E.mid(acc, cur, wr, wc, fr, fq); }
        }
        if (wr == 0) PG8_BAR;
        if constexpr (Prob::FP8) asm volatile("s_nop 15\n\ts_nop 15" ::: "memory");
        E(acc, cur, wr, wc, fr, fq);
        if (!has_next) break;
#pragma unroll
        for (int a = 0; a < 2; ++a)
#pragma unroll
            for (int b = 0; b < 2; ++b)
#pragma unroll
                for (int m = 0; m < 4; ++m)
#pragma unroll
                    for (int n = 0; n < 2; ++n) acc[a][b][m][n] = (f32x4){0.f, 0.f, 0.f, 0.f};
        cur = nxt; cA = nA; cB = nB; ++ui;
        if constexpr (Prob::GATHER) {
#pragma unroll
            for (int i = 0; i < 2; ++i) { cO0[i] = nO0[i]; cO1[i] = nO1[i]; } }
        if (wr == 1) PG8_BAR;
    }
    PG8_WAIT_V(0);
    PG8_BAR;
#undef PG8_AOFF
#undef PG8_SA
#undef PG8_SB
#undef PG8_STAGE
#undef PG8_LDA
#undef PG8_LD8
#undef PG8_LO
#undef PG8_HI
#undef PG8_LDB
#undef PG8_MMA
#undef PG8_WAIT_V
#undef PG8_WAIT_L
#undef PG8_BAR
#undef PG8_SCHED
}
}
using pg8::Unit;

struct Args { const float* in[28]; float* out; unsigned char* ws; int ph_lo, ph_hi; };
struct Frame {
    LAS unsigned char* lds;
    volatile LAS unsigned* MISC;
    unsigned* ctl;
    int tid, lane, wave, vcu, G;
    const Args* A;
    __device__ __forceinline__ bf16_t* Win_t() const { return (bf16_t*)(A->ws + WS_WIN); }
    __device__ __forceinline__ bf16_t* Wk_t() const { return (bf16_t*)(A->ws + WS_WK); }
    __device__ __forceinline__ bf16_t* Wv_t() const { return (bf16_t*)(A->ws + WS_WV); }
    __device__ __forceinline__ bf16_t* Wpab_t() const { return (bf16_t*)(A->ws + WS_WPAB); }
    __device__ __forceinline__ bf16_t* Wmo_t() const { return (bf16_t*)(A->ws + WS_WMO); }
    __device__ __forceinline__ bf16_t* Wq_t() const { return (bf16_t*)(A->ws + WS_WQ); }
    __device__ __forceinline__ bf16_t* Wo_t() const { return (bf16_t*)(A->ws + WS_WO); }
    __device__ __forceinline__ bf16_t* Wr_t() const { return (bf16_t*)(A->ws + WS_WR); }
    __device__ __forceinline__ bf16_t* W1_t() const { return (bf16_t*)(A->ws + WS_W1); }
    __device__ __forceinline__ bf16_t* W2_t() const { return (bf16_t*)(A->ws + WS_W2); }
    __device__ __forceinline__ bf16_t* sguw() const { return (bf16_t*)(A->ws + WS_SGUW); }
    __device__ __forceinline__ bf16_t* h() const { return (bf16_t*)(A->ws + WS_H); }
    __device__ __forceinline__ bf16_t* memn() const { return (bf16_t*)(A->ws + WS_MEMN); }
    __device__ __forceinline__ bf16_t* kmem() const { return (bf16_t*)(A->ws + WS_KMEM); }
    __device__ __forceinline__ bf16_t* vt() const { return (bf16_t*)(A->ws + WS_VT); }
    __device__ __forceinline__ bf16_t* qin() const { return (bf16_t*)(A->ws + WS_QIN); }
    __device__ __forceinline__ bf16_t* oab() const { return (bf16_t*)(A->ws + WS_OAB); }
    __device__ __forceinline__ bf16_t* mix() const { return (bf16_t*)(A->ws + WS_MIX); }
    __device__ __forceinline__ bf16_t* x1b() const { return (bf16_t*)(A->ws + WS_X1B); }
    __device__ __forceinline__ bf16_t* q() const { return (bf16_t*)(A->ws + WS_Q); }
    __device__ __forceinline__ bf16_t* ao() const { return (bf16_t*)(A->ws + WS_AO); }
    __device__ __forceinline__ bf16_t* x2b() const { return (bf16_t*)(A->ws + WS_X2B); }
    __device__ __forceinline__ bf16_t* p() const { return (bf16_t*)(A->ws + WS_P); }
    __device__ __forceinline__ bf16_t* act() const { return (bf16_t*)(A->ws + WS_ACT); }
    __device__ __forceinline__ bf16_t* yb() const { return (bf16_t*)(A->ws + WS_YB); }
    __device__ __forceinline__ bf16_t* ointra() const { return (bf16_t*)(A->ws + WS_OINTRA); }
    __device__ __forceinline__ bf16_t* kvT() const { return (bf16_t*)(A->ws + WS_KVT); }
    __device__ __forceinline__ float* decay() const { return (float*)(A->ws + WS_DECAY); }
    __device__ __forceinline__ float* ssq1() const { return (float*)(A->ws + WS_SSQ1); }
    __device__ __forceinline__ float* ssq2() const { return (float*)(A->ws + WS_SSQ2); }
    __device__ __forceinline__ float* lscale() const { return (float*)(A->ws + WS_LSCALE); }
    __device__ __forceinline__ float* gates() const { return (float*)(A->ws + WS_GATES); }
    __device__ __forceinline__ int* list() const { return (int*)(A->ws + WS_LIST); }
    __device__ __forceinline__ bf16_t* spT() const { return (bf16_t*)(A->ws + WS_SPT); }
    __device__ __forceinline__ unsigned char* x2q() const { return (unsigned char*)(A->ws + WS_X2Q); }
    __device__ __forceinline__ unsigned char* x1q() const { return (unsigned char*)(A->ws + WS_X1Q); }
};
enum { I_X = 0, I_MEM, I_NMIXG, I_WIN, I_WA2, I_BA, I_GOUTG, I_SNG, I_SNB, I_SW, I_SB, I_WPA, I_WPB, I_WMO, I_NXG, I_NMEMG, I_WXQ, I_WXK, I_WXV, I_WXO, I_NFFNG, I_WR, I_BR, I_WE1, I_BE1, I_WE2, I_BE2, I_NFING };

struct CvtItem { const float* src; size_t ldw; unsigned char* dst; const float* kscale; float mul; int fp8; };
__device__ __forceinline__ void cvt_load(const CvtItem& c, float (&v)[64]) {
#pragma unroll
    for (int i = 0; i < 64; ++i) v[i] = __builtin_nontemporal_load(c.src + (size_t)i * c.ldw);
}
__device__ __forceinline__ void cvt_finish(const CvtItem& c, float (&v)[64]) {
    if (c.kscale) {
#pragma unroll
        for (int i = 0; i < 64; ++i) v[i] *= c.kscale[i] * c.mul; }
    else {
#pragma unroll
        for (int i = 0; i < 64; ++i) v[i] *= c.mul; }
    if (c.fp8) {
#pragma unroll
        for (int q = 0; q < 4; ++q) { const float f0[8] = {v[16 * q], v[16 * q + 1], v[16 * q + 2], v[16 * q + 3], v[16 * q + 4], v[16 * q + 5], v[16 * q + 6], v[16 * q + 7]};
            const float f1[8] = {v[16 * q + 8], v[16 * q + 9], v[16 * q + 10], v[16 * q + 11], v[16 * q + 12], v[16 * q + 13], v[16 * q + 14], v[16 * q + 15]};
            const u32x2 lo = pack8_fp8(f0), hi = pack8_fp8(f1); *(u32x4*)(c.dst + 16 * q) = (u32x4){lo.x, lo.y, hi.x, hi.y}; } }
    else {
#pragma unroll
        for (int q = 0; q < 8; ++q) { const float f[8] = {v[8 * q], v[8 * q + 1], v[8 * q + 2], v[8 * q + 3], v[8 * q + 4], v[8 * q + 5], v[8 * q + 6], v[8 * q + 7]}; *(u32x4*)(c.dst + 16 * q) = pack8(f); } }
}
__device__ __forceinline__ CvtItem cvt_desc(const float* W, int ldw, int src_col0, int k0, void* WT, int ldt, int dst_row0, int dst_k0, const float* kscale, float mul, int fp8, int lane) {
    CvtItem c; const int eb = fp8 ? 1 : 2;
    c.src = W + (size_t)k0 * ldw + src_col0 + lane; c.ldw = (size_t)ldw; c.dst = (unsigned char*)WT + ((size_t)(dst_row0 + lane) * ldt + dst_k0 + k0) * eb;
    c.kscale = kscale ? kscale + k0 : nullptr; c.mul = mul; c.fp8 = fp8; return c;
}
__device__ __forceinline__ void cvt_expert128(Frame& F) {
    const int gw = F.vcu * 8 + F.wave, NGW = F.G * 8, lane = F.lane;
    constexpr int I1 = NE * 8 * 32, I2 = NE * 8 * 16;
    for (int it = gw; it < I1 + I2; it += NGW) {
        const float* src; size_t ldw; unsigned char* dst; const float* ks; (void)ks;
        if (it < I1) { const int e = it >> 8, q = it & 255, kb = q >> 5, nb = q & 31, nd = nb * 64; const int sc = ((nd & 128) ? 1024 : 0) + 128 * (nd >> 8) + (nd & 127);
            src = F.A->in[I_WE1] + (size_t)e * D * 2048 + (size_t)(kb * 128) * 2048 + sc + lane; ldw = 2048;
            dst = (unsigned char*)F.W1_t() + (size_t)e * 2048 * D + (size_t)(nd + lane) * D + kb * 128; ks = nullptr; }
        else { const int r = it - I1, e = r >> 7, q = r & 127, kb = q >> 4, nb = q & 15;
            src = F.A->in[I_WE2] + (size_t)e * D * D + (size_t)(kb * 128) * D + nb * 64 + lane; ldw = D;
            dst = (unsigned char*)F.W2_t() + (size_t)e * D * D + (size_t)(nb * 64 + lane) * D + kb * 128; ks = nullptr; }
        float v[128]; const float* pp = src;
#pragma unroll
        for (int i = 0; i < 128; ++i) { v[i] = __builtin_nontemporal_load(pp); pp += ldw; asm volatile("" : "+v"(pp)); }
#pragma unroll
        for (int i = 0; i < 128; ++i) v[i] *= FP8_WMUL;
#pragma unroll
        for (int q = 0; q < 8; ++q) { const float f0[8] = {v[16 * q], v[16 * q + 1], v[16 * q + 2], v[16 * q + 3], v[16 * q + 4], v[16 * q + 5], v[16 * q + 6], v[16 * q + 7]};
            const float f1[8] = {v[16 * q + 8], v[16 * q + 9], v[16 * q + 10], v[16 * q + 11], v[16 * q + 12], v[16 * q + 13], v[16 * q + 14], v[16 * q + 15]};
            const u32x2 lo = pack8_fp8(f0), hi = pack8_fp8(f1); *(u32x4*)(dst + 16 * q) = (u32x4){lo.x, lo.y, hi.x, hi.y}; }
    }
}
constexpr int CVT_SLOT = 16 * 1040;
struct CvtDma { const float* src; unsigned ldw; unsigned char* dst; };
__device__ __forceinline__ CvtDma cvt_dma_desc(const Frame& F, int it) {
    constexpr int I1 = NE * 8 * 64; CvtDma c;
    if (it < I1) { const int e = it >> 9, q = it & 511, kb = q >> 6, nb = q & 63, nd = nb * 32; const int sc = ((nd & 128) ? 1024 : 0) + 128 * (nd >> 8) + (nd & 127);
        c.src = F.A->in[I_WE1] + (size_t)e * D * 2048 + (size_t)(kb * 128) * 2048 + sc; c.ldw = 2048;
        c.dst = (unsigned char*)F.W1_t() + (size_t)e * 2048 * D + (size_t)nd * D + kb * 128; }
    else { const int r = it - I1, e = r >> 8, q = r & 255, kb = q >> 5, nb = q & 31;
        c.src = F.A->in[I_WE2] + (size_t)e * D * D + (size_t)(kb * 128) * D + nb * 32; c.ldw = D;
        c.dst = (unsigned char*)F.W2_t() + (size_t)e * D * D + (size_t)(nb * 32) * D + kb * 128; }
    return c;
}
__device__ __forceinline__ void cvt_dma_issue(const CvtDma& c, LAS unsigned char* slot, int lane) {
    const float* p = c.src + (size_t)(lane >> 3) * c.ldw + (lane & 7) * 4;
#pragma unroll
    for (int i = 0; i < 16; ++i) { __builtin_amdgcn_global_load_lds((const unsigned*)p, (LAS unsigned*)(slot + i * 1040), 16, 0, 2); p += (size_t)8 * c.ldw; }
}
__device__ __forceinline__ void cvt_expert_dma(Frame& F) {
    const int gw = F.vcu * 8 + F.wave, NGW = F.G * 8, lane = F.lane;
    constexpr int ITEMS = NE * 8 * 64 + NE * 8 * 32;
    LAS unsigned char* slot = F.lds + F.wave * CVT_SLOT;
    const LAS unsigned char* rd = slot + (lane & 7) * 2080 + (lane >> 3) * 4;
    CvtDma cur = cvt_dma_desc(F, gw < ITEMS ? gw : 0);
    if (gw < ITEMS) cvt_dma_issue(cur, slot, lane);
    for (int it = gw; it < ITEMS; it += NGW) {
        asm volatile("s_waitcnt vmcnt(0)" ::: "memory");
        float v[4][16];
#pragma unroll
        for (int q = 0; q < 4; ++q)
#pragma unroll
            for (int j = 0; j < 16; ++j) v[q][j] = *(const LAS float*)(rd + q * 32 + (j >> 3) * 1040 + (j & 7) * 128);
        asm volatile("s_waitcnt lgkmcnt(0)" ::: "memory");
        unsigned char* dst = cur.dst + (size_t)(lane >> 3) * D + (lane & 7) * 16;
        if (it + NGW < ITEMS) { cur = cvt_dma_desc(F, it + NGW); cvt_dma_issue(cur, slot, lane); }
#pragma unroll
        for (int q = 0; q < 4; ++q) {
            float f0[8], f1[8];
#pragma unroll
            for (int j = 0; j < 8; ++j) { f0[j] = v[q][j] * FP8_WMUL; f1[j] = v[q][8 + j] * FP8_WMUL; }
            const u32x2 lo = pack8_fp8(f0), hi = pack8_fp8(f1);
            *(u32x4*)(dst + (size_t)(8 * q) * D) = (u32x4){lo.x, lo.y, hi.x, hi.y}; }
    }
    asm volatile("s_waitcnt vmcnt(0)" ::: "memory");
}
template <bool Q8>
__device__ __forceinline__ void rms_row_to_bf16(const float* xrow, const float* g, bf16_t* orow, int lane) {
    f32x4 v[4]; float s = 0.f;
#pragma unroll
    for (int j = 0; j < 4; ++j) { v[j] = *(const f32x4*)(xrow + 256 * j + 4 * lane); s += (v[j].x * v[j].x + v[j].y * v[j].y) + (v[j].z * v[j].z + v[j].w * v[j].w); }
    const float rs = rsqrtf(wave_sum(s) * (1.f / D) + EPS);
#pragma unroll
    for (int j = 0; j < 4; ++j) { const f32x4 gg = *(const f32x4*)(g + 256 * j + 4 * lane);
        if constexpr (Q8) { int w = 0; w = __builtin_amdgcn_cvt_pk_fp8_f32(v[j].x * rs * gg.x, v[j].y * rs * gg.y, w, false); w = __builtin_amdgcn_cvt_pk_fp8_f32(v[j].z * rs * gg.z, v[j].w * rs * gg.w, w, true);
            *(int*)((unsigned char*)orow + 256 * j + 4 * lane) = w; }
        else { u32x2 o; o.x = cvt_pk_bf16(v[j].x * rs * gg.x, v[j].y * rs * gg.y); o.y = cvt_pk_bf16(v[j].z * rs * gg.z, v[j].w * rs * gg.w);
            *(u32x2*)(orow + 256 * j + 4 * lane) = o; } }
}
__device__ __forceinline__ void cvt_range(Frame& F, int ibeg, int iend) {
    const int gw = F.vcu * 8 + F.wave, NGW = F.G * 8, lane = F.lane;
    constexpr int N_WIN = 16 * 72, N_SQ = 256, N_PA = 8 * 16, N_E1 = 512, N_E2 = 256;
    constexpr int S_WIN = 0, S_WK = S_WIN + N_WIN, S_WV = S_WK + N_SQ, S_PA = S_WV + N_SQ, S_PB = S_PA + N_PA, S_MO = S_PB + N_PA, S_Q = S_MO + N_SQ, S_O = S_Q + N_SQ, S_E1 = S_O + N_SQ, S_E2 = S_E1 + NE * N_E1, S_END = S_E2 + NE * N_E2;
    static_assert(S_E1 == 16 * 72 + 256 * 2 + 8 * 16 * 2 + 256 * 3 && S_END == S_E1 + NE * 512 + NE * 256, "item ranges");
    const int IEND = iend < S_END ? iend : S_END;
    auto desc = [&](int it) -> CvtItem {
        if (it < S_WK) { const int r = it - S_WIN, kb = r / 72, nb = r % 72, n0 = nb * 64; return cvt_desc(F.A->in[I_WIN], INC, n0 < 1536 ? n0 : n0 + 16, kb * 64, F.Win_t(), D, n0, 0, nullptr, P1_FP8 ? FP8_WMUL : 1.f, P1_FP8, lane); }
        if (it < S_WV) { const int r = it - S_WK; return cvt_desc(F.A->in[I_WXK], D, (r & 15) * 64, (r >> 4) * 64, F.Wk_t(), D, (r & 15) * 64, 0, nullptr, P1_FP8 ? FP8_WMUL : 1.f, P1_FP8, lane); }
        if (it < S_PA) { const int r = it - S_WV; return cvt_desc(F.A->in[I_WXV], D, (r & 15) * 64, (r >> 4) * 64, F.Wv_t(), D, (r & 15) * 64, 0, nullptr, P1_FP8 ? FP8_WMUL : 1.f, P1_FP8, lane); }
        if (it < S_PB) { const int r = it - S_PA; return cvt_desc(F.A->in[I_WPA], D, (r & 15) * 64, (r >> 4) * 64, F.Wpab_t(), D, (r & 15) * 64, 0, nullptr, 1.f, 0, lane); }
        if (it < S_MO) { const int r = it - S_PB; return cvt_desc(F.A->in[I_WPB], D, (r & 15) * 64, (r >> 4) * 64, F.Wpab_t(), D, (r & 15) * 64, 512, nullptr, 1.f, 0, lane); }
        if (it < S_Q)  { const int r = it - S_MO; return cvt_desc(F.A->in[I_WMO], D, (r & 15) * 64, (r >> 4) * 64, F.Wmo_t(), D, (r & 15) * 64, 0, nullptr, 1.f, 0, lane); }
        if (it < S_O)  { const int r = it - S_Q;  return cvt_desc(F.A->in[I_WXQ], D, (r & 15) * 64, (r >> 4) * 64, F.Wq_t(), D, (r & 15) * 64, 0, F.A->in[I_NXG], FP8_WMUL, 1, lane); }
        if (it < S_E1) { const int r = it - S_O;  return cvt_desc(F.A->in[I_WXO], D, (r & 15) * 64, (r >> 4) * 64, F.Wo_t(), D, (r & 15) * 64, 0, nullptr, FP8_WMUL, 1, lane); }
        if (it < S_E2) { const int r = it - S_E1, e = r / N_E1, q = r % N_E1, kb = q >> 5, nb = q & 31, nd = nb * 64;
            const int src = ((nd & 128) ? 1024 : 0) + 128 * (nd >> 8) + (nd & 127);
            return cvt_desc(F.A->in[I_WE1] + (size_t)e * D * 2048, 2048, src, kb * 64, (unsigned char*)F.W1_t() + (size_t)e * 2048 * D, D, nd, 0, F.A->in[I_NFFNG], FP8_WMUL, 1, lane); }
        const int r = it - S_E2, e = r / N_E2, q = r % N_E2;
        return cvt_desc(F.A->in[I_WE2] + (size_t)e * D * D, D, (q & 15) * 64, (q >> 4) * 64, (unsigned char*)F.W2_t() + (size_t)e * D * D, D, (q & 15) * 64, 0, nullptr, FP8_WMUL, 1, lane); };
    if (ibeg + gw < IEND) {
        float va[64], vb[64]; CvtItem ca = desc(ibeg + gw), cb = ca; cvt_load(ca, va);
        for (int it = ibeg + gw;;) {
            const bool hb = it + NGW < IEND; if (hb) { cb = desc(it + NGW); cvt_load(cb, vb); }
            cvt_finish(ca, va); if (!hb) break;
            const bool ha = it + 2 * NGW < IEND; if (ha) { ca = desc(it + 2 * NGW); cvt_load(ca, va); }
            cvt_finish(cb, vb); if (!ha) break;
            it += 2 * NGW; }
    }
}
constexpr int CVT_LATE = 16 * 72 + 256 * 2, CVT_EXPERT = 16 * 72 + 256 * 2 + 8 * 16 * 2 + 256 * 3, CVT_END = CVT_EXPERT + NE * 512 + NE * 256;
__device__ __forceinline__ void p0_prologue(Frame& F) {
    const int gw = F.vcu * 8 + F.wave, NGW = F.G * 8, lane = F.lane;
    cvt_range(F, 0, CVT_LATE);
    for (int m = gw; m < T; m += NGW) rms_row_to_bf16<P1_FP8 != 0>(F.A->in[I_X] + (size_t)m * D, F.A->in[I_NMIXG], (bf16_t*)((unsigned char*)F.h() + (size_t)m * D * (P1_FP8 ? 1 : 2)), lane);
    for (int m = gw; m < TM; m += NGW) rms_row_to_bf16<P1_FP8 != 0>(F.A->in[I_MEM] + (size_t)m * D, F.A->in[I_NMEMG], (bf16_t*)((unsigned char*)F.memn() + (size_t)m * D * (P1_FP8 ? 1 : 2)), lane);
    const int gt = F.vcu * 512 + F.tid, NGT = F.G * 512;
    for (int i = gt; i < 256 * D; i += NGT) { const int j = i >> 10, k = i & 1023; const float* wr_ = F.A->in[I_WIN] + (size_t)k * INC + OFF_A; float s = 0.f;
#pragma unroll
        for (int r = 0; r < 16; ++r) s += wr_[r] * F.A->in[I_WA2][r * 256 + j];
        if (P1_FP8) { int w = __builtin_amdgcn_cvt_pk_fp8_f32(s * FP8_WMUL, 0.f, 0, false); ((unsigned char*)F.Win_t())[(size_t)(PC_A + j) * D + k] = (unsigned char)(w & 0xff); }
        else F.Win_t()[(size_t)(PC_A + j) * D + k] = f2bf(s); }
    for (int i = gt; i < NE * D; i += NGT) { const int e = i >> 10, k = i & 1023; F.Wr_t()[i] = f2bf(F.A->in[I_WR][k * NE + e] * F.A->in[I_NFFNG][k]); }
    for (int i = gt; i < 4 * 128 * 128; i += NGT) { const int t = (i >> 7) & 127, s = i & 127; F.sguw()[i] = f2bf(s <= t ? F.A->in[I_SW][i] : 0.f); }
}

struct ProbP1 {
    static constexpr bool GATHER = false, FP8 = (P1_FP8 != 0); static constexpr int EB = P1_FP8 ? 1 : 2, WSCALE = FP8_WSCALE;
    int K, lda, ldb, G, c; const unsigned char* ws;
    __device__ __forceinline__ bool next(int i, Unit& u) const {
        const int L = i * G + c;
        if (L < 1216) { u.aux = 0; pg8::map_tile(L, 64, 19, u.pm, u.pn); return true; }
        if (L < 1248) { u.aux = 1; u.pm = (L - 1216) >> 2; u.pn = (L - 1216) & 3; return true; }
        if (L < 1280) { u.aux = 2; u.pm = (L - 1248) >> 3; u.pn = (L - 1248) & 7; return true; }
        return false;
    }
    __device__ __forceinline__ const char* a_base(const Unit& u) const { const size_t o = u.aux == 0 ? WS_H : (u.aux == 1 ? WS_MEMN : WS_WV); return (const char*)(ws + o + (size_t)u.pm * 256 * D * EB); }
    __device__ __forceinline__ const char* b_base(const Unit& u) const { const size_t o = u.aux == 0 ? WS_WIN : (u.aux == 1 ? WS_WK : WS_MEMN); return (const char*)(ws + o + (size_t)u.pn * 256 * D * EB); }
    __device__ __forceinline__ unsigned a_off(const Unit&, int row, int C) const { return (unsigned)(row * D * EB + C * 2); }
};
struct EpiP1 {
    static constexpr bool MID = false;
    unsigned char* ws;
    __device__ __forceinline__ void operator()(const f32x4 (&acc)[2][2][4][2], const Unit& u, int wr, int wc, int fr, int fq) const {
        asm volatile("" : "+v"(fr), "+v"(fq));
        const size_t oo = u.aux == 0 ? WS_P : (u.aux == 1 ? WS_KMEM : WS_VT);
        bf16_t* O = (bf16_t*)(ws + oo); const int ldc = u.aux == 0 ? PN : (u.aux == 1 ? D : TM);
        const int act = (u.aux == 0) ? ((u.pn >= 6 && u.pn < 10) ? 1 : ((u.pn >= 10 && u.pn < 18) ? 2 : 0)) : 0;
        const int row0 = u.pm * 256 + wr * 64 + fr, col0 = u.pn * 256 + wc * 32 + 8 * fq; const bool svstat = (u.aux == 0) && (u.pn == 8 || u.pn == 9);
#pragma unroll
        for (int ai = 0; ai < 2; ++ai)
#pragma unroll
            for (int m = 0; m < 4; ++m) { bf16_t* rowp = O + (size_t)(row0 + ai * 128 + m * 16) * ldc + col0; float s1 = 0.f, s2 = 0.f;
#pragma unroll
                for (int bj = 0; bj < 2; ++bj) { float v[8];
#pragma unroll
                    for (int j = 0; j < 4; ++j) { v[j] = acc[ai][bj][m][0][j]; v[4 + j] = acc[ai][bj][m][1][j]; }
                    if (act == 1) {
#pragma unroll
                        for (int j = 0; j < 8; j += 2) { const f32x2 o = gelu_pk((f32x2){v[j], v[j + 1]}); v[j] = o.x; v[j + 1] = o.y; }
#pragma unroll
                        for (int j = 0; j < 8; ++j) { s1 += v[j]; s2 += v[j] * v[j]; } }
                    else if (act == 2) {
#pragma unroll
                        for (int j = 0; j < 8; j += 2) { const f32x2 o = sigmoid_pk((f32x2){v[j], v[j + 1]}); v[j] = o.x; v[j + 1] = o.y; } }
                    *(u32x4*)(rowp + bj * 128) = pack8(v); }
                if (svstat) {
                    s1 += __shfl_xor(s1, 16); s1 += __shfl_xor(s1, 32); s2 += __shfl_xor(s2, 16); s2 += __shfl_xor(s2, 32);
                    if (fq == 0) *(f32x2*)((float*)(ws + WS_SVS) + (size_t)(row0 + ai * 128 + m * 16) * 16 + (u.pn - 8) * 8 + wc * 2) = (f32x2){s1, s2}; } }
    }
};

__device__ __forceinline__ void gla_a_unit(Frame& F, int unit) {
    const int tid = F.tid, lane = F.lane, w = F.wave, fr = lane & 15, fq = lane >> 4;
    const int bh = unit >> 5, n = unit & 31, b = bh >> 2, h = bh & 3;
    const int t0 = b * SEQ + n * 64;
    LAS float* cum = (LAS float*)(F.lds); LAS float* tot = (LAS float*)(F.lds + 16640);
    LAS bf16_t* QIN = (LAS bf16_t*)(F.lds + 18688); LAS bf16_t* KIN = (LAS bf16_t*)(F.lds + 27904); LAS bf16_t* KOT = (LAS bf16_t*)(F.lds + 37120);
    LAS bf16_t* ATT = (LAS bf16_t*)(F.lds + 46336); LAS bf16_t* VT = (LAS bf16_t*)(F.lds + 55552);
    const int c = tid >> 3, d8 = (tid & 7) * 8;
    {
        float g[8]; unpack8(*(const u32x4*)(F.p() + (size_t)(t0 + c) * PN + PC_A + h * 64 + d8), g);
        const f32x4 b0 = *(const f32x4*)(F.A->in[I_BA] + h * 64 + d8), b1 = *(const f32x4*)(F.A->in[I_BA] + h * 64 + d8 + 4);
        const float bb[8] = {b0.x, b0.y, b0.z, b0.w, b1.x, b1.y, b1.z, b1.w};
#pragma unroll
        for (int j = 0; j < 8; ++j) { const float x = g[j] + bb[j]; const float ls = fminf(x, 0.f) - __logf(1.f + __expf(-fabsf(x))); cum[c * 65 + d8 + j] = ls * 0.0625f; }
    }
    __syncthreads();
    { const int d = tid & 63, seg = tid >> 6; float run = 0.f;
#pragma unroll
        for (int i = 0; i < 8; ++i) { run += cum[(seg * 8 + i) * 65 + d]; cum[(seg * 8 + i) * 65 + d] = run; }
        tot[seg * 64 + d] = run; }
    __syncthreads();
    { const int d = tid & 63, seg = tid >> 6; float off = 0.f;
#pragma unroll
        for (int s = 0; s < 7; ++s) if (s < seg) off += tot[s * 64 + d];
#pragma unroll
        for (int i = 0; i < 8; ++i) cum[(seg * 8 + i) * 65 + d] += off; }
    __syncthreads();
    {
        float qv[8], kv[8], qi[8], ki[8];
        unpack8(*(const u32x4*)(F.p() + (size_t)(t0 + c) * PN + PC_Q + h * 64 + d8), qv);
        unpack8(*(const u32x4*)(F.p() + (size_t)(t0 + c) * PN + PC_K + h * 64 + d8), kv);
#pragma unroll
        for (int j = 0; j < 8; ++j) { const float cm = cum[c * 65 + d8 + j], cl = cum[63 * 65 + d8 + j];
            qi[j] = qv[j] * 0.125f * __expf(cm); ki[j] = kv[j] * __expf(-cm);
            KOT[(d8 + j) * 72 + c] = f2bf(kv[j] * __expf(cl - cm));
            if (c == 63) F.decay()[unit * 64 + d8 + j] = __expf(cl); }
        const u32x4 qp = pack8(qi), kp = pack8(ki);
        *(LAS u32x4*)(QIN + c * 72 + d8) = qp; *(LAS u32x4*)(KIN + c * 72 + d8) = kp;
        *(u32x4*)(F.qin() + (size_t)(t0 + c) * 256 + h * 64 + d8) = qp;
        const int e16 = (tid & 7) * 16;
#pragma unroll
        for (int hh = 0; hh < 2; ++hh) { const u32x4 vv = *(const u32x4*)(F.p() + (size_t)(t0 + c) * PN + PC_V + h * 128 + e16 + 8 * hh);
            const unsigned ww[4] = {vv.x, vv.y, vv.z, vv.w};
#pragma unroll
            for (int j = 0; j < 4; ++j) { VT[(e16 + 8 * hh + 2 * j) * 72 + c] = (bf16_t)(ww[j] & 0xffffu); VT[(e16 + 8 * hh + 2 * j + 1) * 72 + c] = (bf16_t)(ww[j] >> 16); } }
    }
    __syncthreads();
    {
        const int mt = w >> 1;
        bf16x8 a[2];
#pragma unroll
        for (int ks = 0; ks < 2; ++ks) a[ks] = *(const LAS bf16x8*)(QIN + (16 * mt + fr) * 72 + 32 * ks + 8 * fq);
#pragma unroll
        for (int q = 0; q < 2; ++q) { const int nt = (w & 1) * 2 + q; f32x4 s = {0.f, 0.f, 0.f, 0.f};
#pragma unroll
            for (int ks = 0; ks < 2; ++ks) s = mma16(a[ks], *(const LAS bf16x8*)(KIN + (16 * nt + fr) * 72 + 32 * ks + 8 * fq), s);
#pragma unroll
            for (int r = 0; r < 4; ++r) { const int cc = 16 * mt + 4 * fq + r, ss = 16 * nt + fr; ATT[cc * 72 + ss] = f2bf(ss <= cc ? s[r] : 0.f); } }
    }
    __syncthreads();
    {
        const int mt = w >> 1, nt0 = (w & 1) * 4;
        bf16x8 aa[2], ak[2];
#pragma unroll
        for (int ks = 0; ks < 2; ++ks) { aa[ks] = *(const LAS bf16x8*)(ATT + (16 * mt + fr) * 72 + 32 * ks + 8 * fq); ak[ks] = *(const LAS bf16x8*)(KOT + (16 * mt + fr) * 72 + 32 * ks + 8 * fq); }
#pragma unroll
        for (int q = 0; q < 4; ++q) { const int nt = nt0 + q; f32x4 o = {0.f, 0.f, 0.f, 0.f}, kvv = {0.f, 0.f, 0.f, 0.f};
#pragma unroll
            for (int ks = 0; ks < 2; ++ks) { const bf16x8 bv = *(const LAS bf16x8*)(VT + (16 * nt + fr) * 72 + 32 * ks + 8 * fq); o = mma16(bv, aa[ks], o); kvv = mma16(ak[ks], bv, kvv); }
            *(u32x2*)(F.ointra() + (size_t)(t0 + 16 * mt + fr) * 512 + h * 128 + 16 * nt + 4 * fq) = (u32x2){cvt_pk_bf16(o[0], o[1]), cvt_pk_bf16(o[2], o[3])};
            *(u32x2*)(F.kvT() + ((size_t)unit * 128 + 16 * nt + fr) * 64 + 16 * mt + 4 * fq) = (u32x2){cvt_pk_bf16(kvv[0], kvv[1]), cvt_pk_bf16(kvv[2], kvv[3])}; }
    }
    __syncthreads();
}

__device__ __forceinline__ void gla_sscan_item(Frame& F, int item) {
    const int lane = F.lane, idx = item * 64 + lane, d4 = idx & 15, e = (idx >> 4) & 127, bh = idx >> 11;
    const bf16_t* kvp = F.kvT() + ((size_t)(bh * 32) * 128 + e) * 64 + d4 * 4; const float* dcp = F.decay() + (size_t)(bh * 32) * 64 + d4 * 4;
    bf16_t* sp = F.spT() + ((size_t)(bh * 32) * 128 + e) * 64 + d4 * 4;
    f32x4 S = {0.f, 0.f, 0.f, 0.f};
    for (int n0 = 0; n0 < 32; n0 += 8) { f32x4 kv[8], dc[8];
#pragma unroll
        for (int i = 0; i < 8; ++i) { const u32x2 kw = *(const u32x2*)(kvp + (size_t)(n0 + i) * 128 * 64); kv[i] = (f32x4){bflo(kw.x), bfhi(kw.x), bflo(kw.y), bfhi(kw.y)}; dc[i] = *(const f32x4*)(dcp + (size_t)(n0 + i) * 64); }
#pragma unroll
        for (int i = 0; i < 8; ++i) { u32x2 o; o.x = cvt_pk_bf16(S.x, S.y); o.y = cvt_pk_bf16(S.z, S.w); *(u32x2*)(sp + (size_t)(n0 + i) * 128 * 64) = o; S = dc[i] * S + kv[i]; } }
}
__device__ __forceinline__ void sgu_unit(Frame& F, int unit) {
    const int tid = F.tid, w = F.wave, lane = F.lane, fr = lane & 15, fq = lane >> 4, ch = unit >> 2, g = unit & 3, t0 = ch * 128;
    LAS f32x2* stat = (LAS f32x2*)F.lds; LAS bf16_t* vnT = (LAS bf16_t*)(F.lds + 1024);
    if (tid < 128) { const float* sp = (const float*)(F.A->ws + WS_SVS) + (size_t)(t0 + tid) * 16;
        const f32x4 a = *(const f32x4*)sp, b = *(const f32x4*)(sp + 4), c4 = *(const f32x4*)(sp + 8), d = *(const f32x4*)(sp + 12);
        const float s = (a.x + a.z) + (b.x + b.z) + (c4.x + c4.z) + (d.x + d.z), s2 = (a.y + a.w) + (b.y + b.w) + (c4.y + c4.w) + (d.y + d.w);
        const float mean = s * (1.f / 512.f), var = fmaxf(s2 * (1.f / 512.f) - mean * mean, 0.f);
        stat[tid] = (f32x2){mean, rsqrtf(var + EPS)}; }
    __syncthreads();
    { const int s = tid >> 2, c32 = (tid & 3) * 32; const f32x2 ms = stat[s];
#pragma unroll
        for (int q = 0; q < 4; ++q) { float v[8]; unpack8(*(const u32x4*)(F.p() + (size_t)(t0 + s) * PN + PC_SV + g * 128 + c32 + 8 * q), v);
#pragma unroll
            for (int j = 0; j < 8; ++j) { const int cidx = g * 128 + c32 + 8 * q + j; vnT[(c32 + 8 * q + j) * 136 + s] = f2bf((v[j] - ms.x) * ms.y * F.A->in[I_SNG][cidx] + F.A->in[I_SNB][cidx]); } } }
    __syncthreads();
    f32x4 acc[8];
#pragma unroll
    for (int ct = 0; ct < 8; ++ct) acc[ct] = (f32x4){0.f, 0.f, 0.f, 0.f};
    const int nks = (16 * w + 15) / 32 + 1;
    for (int ks = 0; ks < nks; ++ks) { const bf16x8 bw = *(const bf16x8*)(F.sguw() + (size_t)(g * 128 + 16 * w + fr) * 128 + 32 * ks + 8 * fq);
#pragma unroll
        for (int ct = 0; ct < 8; ++ct) acc[ct] = mma16(*(const LAS bf16x8*)(vnT + (16 * ct + fr) * 136 + 32 * ks + 8 * fq), bw, acc[ct]); }
    {
        const int t = 16 * w + fr; const float bias = F.A->in[I_SB][g * 128 + t];
        u32x2 uv[8];
#pragma unroll
        for (int ct = 0; ct < 8; ++ct) uv[ct] = *(const u32x2*)(F.p() + (size_t)(t0 + t) * PN + PC_U + g * 128 + 16 * ct + 4 * fq);
#pragma unroll
        for (int ct = 0; ct < 8; ++ct) { const int cidx = g * 128 + 16 * ct + 4 * fq; const u32x2 uu = uv[ct];
            u32x2 o; o.x = cvt_pk_bf16(bflo(uu.x) * (acc[ct][0] + bias), bfhi(uu.x) * (acc[ct][1] + bias)); o.y = cvt_pk_bf16(bflo(uu.y) * (acc[ct][2] + bias), bfhi(uu.y) * (acc[ct][3] + bias));
            *(u32x2*)(F.oab() + (size_t)(t0 + t) * D + 512 + cidx) = o; } }
    __syncthreads();
}
__device__ __forceinline__ void gla_out_item(Frame& F, int item) {
    const int lane = F.lane, fr = lane & 15, fq = lane >> 4, unit = item >> 2, mt = item & 3;
    const int bh = unit >> 5, n = unit & 31, b = bh >> 2, h = bh & 3; const size_t t = (size_t)b * SEQ + n * 64 + 16 * mt + fr;
    bf16x8 qf[2];
#pragma unroll
    for (int ks = 0; ks < 2; ++ks) qf[ks] = *(const bf16x8*)(F.qin() + t * 256 + h * 64 + 32 * ks + 8 * fq);
    const bf16_t* sp = F.spT() + (size_t)unit * 128 * 64;
    f32x4 o[8]; float ss = 0.f;
#pragma unroll
    for (int et = 0; et < 8; ++et) { const u32x2 ow = *(const u32x2*)(F.ointra() + t * 512 + h * 128 + 16 * et + 4 * fq); f32x4 acc = {bflo(ow.x), bfhi(ow.x), bflo(ow.y), bfhi(ow.y)};
#pragma unroll
        for (int ks = 0; ks < 2; ++ks) acc = mma16(*(const bf16x8*)(sp + (size_t)(16 * et + fr) * 64 + 32 * ks + 8 * fq), qf[ks], acc);
        o[et] = acc; ss += (acc[0] * acc[0] + acc[1] * acc[1]) + (acc[2] * acc[2] + acc[3] * acc[3]); }
    ss += __shfl_xor(ss, 16); ss += __shfl_xor(ss, 32);
    const float rstd = rsqrtf(ss * (1.f / 128.f) + EPS);
    f32x4 gv[8]; u32x2 rv[8];
#pragma unroll
    for (int et = 0; et < 8; ++et) { const int e = h * 128 + 16 * et + 4 * fq; gv[et] = *(const f32x4*)(F.A->in[I_GOUTG] + e); rv[et] = *(const u32x2*)(F.p() + t * PN + PC_R + e); }
#pragma unroll
    for (int et = 0; et < 8; ++et) { const int e = h * 128 + 16 * et + 4 * fq; const f32x4 g = gv[et];
        const u32x2 rr = rv[et]; const float r0 = bflo(rr.x), r1 = bfhi(rr.x), r2 = bflo(rr.y), r3 = bfhi(rr.y);
        u32x2 ov; ov.x = cvt_pk_bf16(o[et][0] * rstd * g.x * r0 * sigmoidf_(r0), o[et][1] * rstd * g.y * r1 * sigmoidf_(r1));
        ov.y = cvt_pk_bf16(o[et][2] * rstd * g.z * r2 * sigmoidf_(r2), o[et][3] * rstd * g.w * r3 * sigmoidf_(r3));
        *(u32x2*)(F.oab() + t * D + e) = ov; }
}

struct ProbSeg {
    static constexpr bool GATHER = false, FP8 = false; static constexpr int WSCALE = FP8_WSCALE;
    int K, lda, ldb, G, c; const bf16_t *oab, *Wpab_t;
    __device__ __forceinline__ bool next(int i, Unit& u) const { const int L = (i >> 1) * G + c; if (L >= 256) return false; pg8::map_tile(L, 64, 4, u.pm, u.pn); u.aux = i & 1; return true; }
    __device__ __forceinline__ const char* a_base(const Unit& u) const { return (const char*)(oab + (size_t)u.pm * 256 * D + u.aux * 512); }
    __device__ __forceinline__ const char* b_base(const Unit& u) const { return (const char*)(Wpab_t + (size_t)u.pn * 256 * D + u.aux * 512); }
    __device__ __forceinline__ unsigned a_off(const Unit&, int row, int C) const { return (unsigned)(row * D + C) * 2u; }
};
struct EpiMix {
    static constexpr bool MID = false;
    const bf16_t* p; bf16_t* mix;
    __device__ __forceinline__ void operator()(const f32x4 (&acc)[2][2][4][2], const Unit& u, int wr, int wc, int fr, int fq) const {
        asm volatile("" : "+v"(fr), "+v"(fq));
        const int row0 = u.pm * 256 + wr * 64 + fr, col0 = u.pn * 256 + wc * 32 + 8 * fq, gc = u.aux ? PC_GB : PC_GA;
#pragma unroll
        for (int ai = 0; ai < 2; ++ai) {
            u32x4 gw[4][2], pw[4][2];
#pragma unroll
            for (int m = 0; m < 4; ++m)
#pragma unroll
                for (int bj = 0; bj < 2; ++bj) { const size_t row = (size_t)(row0 + ai * 128 + m * 16);
                    gw[m][bj] = *(const u32x4*)(p + row * PN + gc + col0 + bj * 128);
                    pw[m][bj] = u.aux ? *(const u32x4*)(mix + row * D + col0 + bj * 128) : (u32x4){0u, 0u, 0u, 0u}; }
#pragma unroll
            for (int m = 0; m < 4; ++m)
#pragma unroll
                for (int bj = 0; bj < 2; ++bj) { const size_t row = (size_t)(row0 + ai * 128 + m * 16); float g[8], pv[8], v[8]; unpack8(gw[m][bj], g); unpack8(pw[m][bj], pv);
#pragma unroll
                    for (int j = 0; j < 4; ++j) { v[j] = acc[ai][bj][m][0][j] * g[j] + pv[j]; v[4 + j] = acc[ai][bj][m][1][j] * g[4 + j] + pv[4 + j]; }
                    *(u32x4*)(mix + row * D + col0 + bj * 128) = pack8(v); } }
    }
};

struct EpiMix2 {
    static constexpr bool MID = true;
    const bf16_t* p; bf16_t* mix;
    __device__ __forceinline__ void mid(f32x4 (&acc)[2][2][4][2], const Unit& u, int wr, int wc, int fr, int fq) const {
        asm volatile("" : "+v"(fr), "+v"(fq));
        const int row0 = u.pm * 256 + wr * 64 + fr, col0 = u.pn * 256 + wc * 32 + 8 * fq;
#pragma unroll
        for (int ai = 0; ai < 2; ++ai) { u32x4 ga[4][2], gb[4][2];
#pragma unroll
            for (int m = 0; m < 4; ++m)
#pragma unroll
                for (int bj = 0; bj < 2; ++bj) { const size_t row = (size_t)(row0 + ai * 128 + m * 16); ga[m][bj] = *(const u32x4*)(p + row * PN + PC_GA + col0 + bj * 128); gb[m][bj] = *(const u32x4*)(p + row * PN + PC_GB + col0 + bj * 128); }
#pragma unroll
            for (int m = 0; m < 4; ++m)
#pragma unroll
                for (int bj = 0; bj < 2; ++bj) { float a[8], b[8]; unpack8(ga[m][bj], a); unpack8(gb[m][bj], b);
#pragma unroll
                    for (int j = 0; j < 4; ++j) { acc[ai][bj][m][0][j] *= a[j] * __builtin_amdgcn_rcpf(fmaxf(b[j], 1e-20f)); acc[ai][bj][m][1][j] *= a[4 + j] * __builtin_amdgcn_rcpf(fmaxf(b[4 + j], 1e-20f)); } } }
    }
    __device__ __forceinline__ void operator()(const f32x4 (&acc)[2][2][4][2], const Unit& u, int wr, int wc, int fr, int fq) const {
        asm volatile("" : "+v"(fr), "+v"(fq));
        const int row0 = u.pm * 256 + wr * 64 + fr, col0 = u.pn * 256 + wc * 32 + 8 * fq;
#pragma unroll
        for (int ai = 0; ai < 2; ++ai) { u32x4 gb[4][2];
#pragma unroll
            for (int m = 0; m < 4; ++m)
#pragma unroll
                for (int bj = 0; bj < 2; ++bj) gb[m][bj] = *(const u32x4*)(p + (size_t)(row0 + ai * 128 + m * 16) * PN + PC_GB + col0 + bj * 128);
#pragma unroll
            for (int m = 0; m < 4; ++m)
#pragma unroll
                for (int bj = 0; bj < 2; ++bj) { float b[8], v[8]; unpack8(gb[m][bj], b);
#pragma unroll
                    for (int j = 0; j < 4; ++j) { v[j] = acc[ai][bj][m][0][j] * fmaxf(b[j], 1e-20f); v[4 + j] = acc[ai][bj][m][1][j] * fmaxf(b[4 + j], 1e-20f); }
                    *(u32x4*)(mix + (size_t)(row0 + ai * 128 + m * 16) * D + col0 + bj * 128) = pack8(v); } }
    }
};

template <bool Q8 = false, int WS_ = FP8_WSCALE> struct ProbStdT {
    static constexpr bool GATHER = false, FP8 = Q8; static constexpr int WSCALE = WS_, EB = Q8 ? 1 : 2;
    int K, lda, ldb, G, c; const void *A, *Bt;
    __device__ __forceinline__ bool next(int i, Unit& u) const { const int L = i * G + c; if (L >= 256) return false; pg8::map_tile(L, 64, 4, u.pm, u.pn); u.aux = 0; return true; }
    __device__ __forceinline__ const char* a_base(const Unit& u) const { return (const char*)A + (size_t)u.pm * 256 * D * EB; }
    __device__ __forceinline__ const char* b_base(const Unit& u) const { return (const char*)Bt + (size_t)u.pn * 256 * D * EB; }
    __device__ __forceinline__ unsigned a_off(const Unit&, int row, int C) const { return (unsigned)(row * D * EB + C * 2); }
};
typedef ProbStdT<false> ProbStd;
template <bool RESF32> struct EpiRes {
    static constexpr bool MID = false;
    const void* res; bf16_t* outb; float* ssq; unsigned char* outq; const float* qgain;
    __device__ __forceinline__ void operator()(const f32x4 (&acc)[2][2][4][2], const Unit& u, int wr, int wc, int fr, int fq) const {
        asm volatile("" : "+v"(fr), "+v"(fq));
        const int row0 = u.pm * 256 + wr * 64 + fr, col0 = u.pn * 256 + wc * 32 + 8 * fq;
#pragma unroll
        for (int ai = 0; ai < 2; ++ai) {
            f32x4 rf[4][2][2]; u32x4 rb[4][2];
#pragma unroll
            for (int m = 0; m < 4; ++m)
#pragma unroll
                for (int bj = 0; bj < 2; ++bj) { const size_t off = (size_t)(row0 + ai * 128 + m * 16) * D + col0 + bj * 128;
                    if (RESF32) { rf[m][bj][0] = *(const f32x4*)((const float*)res + off); rf[m][bj][1] = *(const f32x4*)((const float*)res + off + 4); }
                    else rb[m][bj] = *(const u32x4*)((const bf16_t*)res + off); }
#pragma unroll
            for (int m = 0; m < 4; ++m) { const size_t row = (size_t)(row0 + ai * 128 + m * 16); float sq = 0.f;
#pragma unroll
                for (int bj = 0; bj < 2; ++bj) { float r[8], v[8];
                    if (RESF32) { r[0] = rf[m][bj][0].x; r[1] = rf[m][bj][0].y; r[2] = rf[m][bj][0].z; r[3] = rf[m][bj][0].w; r[4] = rf[m][bj][1].x; r[5] = rf[m][bj][1].y; r[6] = rf[m][bj][1].z; r[7] = rf[m][bj][1].w; }
                    else unpack8(rb[m][bj], r);
#pragma unroll
                    for (int j = 0; j < 4; ++j) { v[j] = acc[ai][bj][m][0][j] + r[j]; v[4 + j] = acc[ai][bj][m][1][j] + r[4 + j]; }
#pragma unroll
                    for (int j = 0; j < 8; ++j) sq += v[j] * v[j];
                    *(u32x4*)(outb + row * D + col0 + bj * 128) = pack8(v);
                    if (outq) *(u32x2*)(outq + row * D + col0 + bj * 128) = pack8_fp8(v); }
                sq += __shfl_xor(sq, 16); sq += __shfl_xor(sq, 32);
                if (fq == 0) ssq[row * 16 + u.pn * 4 + wc] = sq; } }
    }
};
__device__ __forceinline__ float row_rs(const float* ssq, size_t row) {
    const f32x4 a = *(const f32x4*)(ssq + row * 16), b = *(const f32x4*)(ssq + row * 16 + 4), c = *(const f32x4*)(ssq + row * 16 + 8), d = *(const f32x4*)(ssq + row * 16 + 12);
    const float s = ((a.x + a.y) + (a.z + a.w)) + ((b.x + b.y) + (b.z + b.w)) + ((c.x + c.y) + (c.z + c.w)) + ((d.x + d.y) + (d.z + d.w));
    return rsqrtf(s * (1.f / D) + EPS);
}
struct EpiScale {
    static constexpr bool MID = false;
    const float* ssq; bf16_t* outb;
    __device__ __forceinline__ void operator()(const f32x4 (&acc)[2][2][4][2], const Unit& u, int wr, int wc, int fr, int fq) const {
        asm volatile("" : "+v"(fr), "+v"(fq));
        const int row0 = u.pm * 256 + wr * 64 + fr, col0 = u.pn * 256 + wc * 32 + 8 * fq;
        float rs[2][4];
#pragma unroll
        for (int ai = 0; ai < 2; ++ai)
#pragma unroll
            for (int m = 0; m < 4; ++m) rs[ai][m] = row_rs(ssq, (size_t)(row0 + ai * 128 + m * 16));
#pragma unroll
        for (int ai = 0; ai < 2; ++ai)
#pragma unroll
            for (int m = 0; m < 4; ++m) { const size_t row = (size_t)(row0 + ai * 128 + m * 16);
#pragma unroll
                for (int bj = 0; bj < 2; ++bj) { float v[8];
#pragma unroll
                    for (int j = 0; j < 4; ++j) { v[j] = acc[ai][bj][m][0][j] * rs[ai][m]; v[4 + j] = acc[ai][bj][m][1][j] * rs[ai][m]; }
                    *(u32x4*)(outb + row * D + col0 + bj * 128) = pack8(v); } }
    }
};

__device__ __forceinline__ void attn_unit(Frame& F, int unit) {
    const int tid = F.tid, w = F.wave, lane = F.lane, fr = lane & 15, fq = lane >> 4;
    const int b = unit >> 5, h = (unit >> 3) & 3, qb = unit & 7;
    const size_t tq = (size_t)b * SEQ + qb * 256 + 32 * w;
    LAS unsigned char* const bufs[2] = {F.lds, F.lds + 36864};
    const bf16_t* kg = F.kmem() + (size_t)(b * 256 + (tid >> 1)) * D + h * 256 + (tid & 1) * 32;
    const int kls = (tid >> 1) * 144 + (tid & 1) * 64;
    const bf16_t* vg = F.vt() + (size_t)(h * 256 + (tid >> 3)) * TM + b * 256 + (tid & 7) * 32;
    const int vls = (tid >> 3) * 528 + (tid & 7) * 64;
    u32x4 st[4];
#pragma unroll
    for (int i = 0; i < 4; ++i) st[i] = *(const u32x4*)(kg + 8 * i);
#pragma unroll
    for (int i = 0; i < 4; ++i) *(LAS u32x4*)(bufs[0] + kls + 16 * i) = st[i];
    __syncthreads();
    f32x4 s[16][2];
#pragma unroll
    for (int nt = 0; nt < 16; ++nt) { s[nt][0] = (f32x4){0.f, 0.f, 0.f, 0.f}; s[nt][1] = (f32x4){0.f, 0.f, 0.f, 0.f}; }
#pragma unroll
    for (int c = 0; c < 4; ++c) {
        if (c < 3) {
#pragma unroll
            for (int i = 0; i < 4; ++i) st[i] = *(const u32x4*)(kg + 64 * (c + 1) + 8 * i); }
        else {
#pragma unroll
            for (int i = 0; i < 4; ++i) st[i] = *(const u32x4*)(vg + 8 * i); }
        LAS unsigned char* kb = bufs[c & 1];
        bf16x8 qf[2][2];
#pragma unroll
        for (int qt = 0; qt < 2; ++qt)
#pragma unroll
            for (int ks = 0; ks < 2; ++ks) qf[qt][ks] = *(const bf16x8*)(F.q() + (tq + 16 * qt + fr) * D + h * 256 + 64 * c + 32 * ks + 8 * fq);
#pragma unroll
        for (int nt = 0; nt < 16; ++nt)
#pragma unroll
            for (int ks = 0; ks < 2; ++ks) { const bf16x8 a = *(const LAS bf16x8*)(kb + (16 * nt + fr) * 144 + (32 * ks + 8 * fq) * 2);
                s[nt][0] = mma16(a, qf[0][ks], s[nt][0]); s[nt][1] = mma16(a, qf[1][ks], s[nt][1]); }
        if (c < 3) {
#pragma unroll
            for (int i = 0; i < 4; ++i) *(LAS u32x4*)(bufs[(c + 1) & 1] + kls + 16 * i) = st[i]; }
        __syncthreads();
    }
#pragma unroll
    for (int i = 0; i < 4; ++i) *(LAS u32x4*)(bufs[0] + vls + 16 * i) = st[i];
    float inv[2]; bf16x8 pb[2][8];
#pragma unroll
    for (int qt = 0; qt < 2; ++qt) { float mx = s[0][qt][0];
#pragma unroll
        for (int nt = 0; nt < 16; ++nt)
#pragma unroll
            for (int r = 0; r < 4; ++r) mx = fmaxf(mx, s[nt][qt][r]);
        mx = fmaxf(mx, __shfl_xor(mx, 16)); mx = fmaxf(mx, __shfl_xor(mx, 32));
        float sum = 0.f;
#pragma unroll
        for (int nt = 0; nt < 16; ++nt)
#pragma unroll
            for (int r = 0; r < 4; ++r) { const float e = __expf(s[nt][qt][r] - mx); s[nt][qt][r] = e; sum += e; }
        sum += __shfl_xor(sum, 16); sum += __shfl_xor(sum, 32);
        inv[qt] = __builtin_amdgcn_rcpf(sum);
#pragma unroll
        for (int sk = 0; sk < 8; ++sk) { const float pv[8] = {s[2 * sk][qt][0], s[2 * sk][qt][1], s[2 * sk][qt][2], s[2 * sk][qt][3], s[2 * sk + 1][qt][0], s[2 * sk + 1][qt][1], s[2 * sk + 1][qt][2], s[2 * sk + 1][qt][3]};
            const u32x4 pk = pack8(pv); pb[qt][sk] = __builtin_bit_cast(bf16x8, pk); } }
    __syncthreads();
#pragma unroll
    for (int c = 0; c < 4; ++c) {
        if (c < 3) {
#pragma unroll
            for (int i = 0; i < 4; ++i) st[i] = *(const u32x4*)(vg + (size_t)64 * (c + 1) * TM + 8 * i); }
        LAS unsigned char* vb = bufs[c & 1];
#pragma unroll
        for (int dt = 0; dt < 4; ++dt) { f32x4 o0 = {0.f, 0.f, 0.f, 0.f}, o1 = {0.f, 0.f, 0.f, 0.f};
#pragma unroll
            for (int sk = 0; sk < 8; ++sk) { const LAS unsigned char* vp = vb + (16 * dt + fr) * 528 + (32 * sk + 4 * fq) * 2;
                const u32x2 lo = *(const LAS u32x2*)vp, hi = *(const LAS u32x2*)(vp + 32);
                const u32x4 av = {lo.x, lo.y, hi.x, hi.y}; const bf16x8 a = __builtin_bit_cast(bf16x8, av);
                o0 = mma16(a, pb[0][sk], o0); o1 = mma16(a, pb[1][sk], o1); }
            const int col = h * 256 + 64 * c + 16 * dt + 4 * fq;
            int w0 = 0, w1 = 0;
            w0 = __builtin_amdgcn_cvt_pk_fp8_f32(o0[0] * inv[0], o0[1] * inv[0], w0, false); w0 = __builtin_amdgcn_cvt_pk_fp8_f32(o0[2] * inv[0], o0[3] * inv[0], w0, true);
            w1 = __builtin_amdgcn_cvt_pk_fp8_f32(o1[0] * inv[1], o1[1] * inv[1], w1, false); w1 = __builtin_amdgcn_cvt_pk_fp8_f32(o1[2] * inv[1], o1[3] * inv[1], w1, true);
            *(int*)((unsigned char*)F.ao() + (tq + fr) * D + col) = w0; *(int*)((unsigned char*)F.ao() + (tq + 16 + fr) * D + col) = w1; }
        if (c < 3) {
#pragma unroll
            for (int i = 0; i < 4; ++i) *(LAS u32x4*)(bufs[(c + 1) & 1] + vls + 16 * i) = st[i]; }
        __syncthreads();
    }
}

__device__ __forceinline__ void router_item(Frame& F, int item) {
    const int w = F.wave, lane = F.lane, fr = lane & 15, fq = lane >> 4;
    const size_t t0 = (size_t)item * 16;
    LAS float* lg = (LAS float*)(F.lds + w * CVT_SLOT);
    LAS int* ex = (LAS int*)(lg + 16 * 33);
    f32x4 acc[2] = {{0.f, 0.f, 0.f, 0.f}, {0.f, 0.f, 0.f, 0.f}};
    const float rsl = row_rs(F.ssq2(), t0 + fr);
    for (int k0 = 0; k0 < 32; k0 += 8) { bf16x8 a[8], b0[8], b1[8];
#pragma unroll
        for (int i = 0; i < 8; ++i) { a[i] = *(const bf16x8*)(F.x2b() + (t0 + fr) * D + 32 * (k0 + i) + 8 * fq);
            b0[i] = *(const bf16x8*)(F.Wr_t() + (size_t)fr * D + 32 * (k0 + i) + 8 * fq); b1[i] = *(const bf16x8*)(F.Wr_t() + (size_t)(16 + fr) * D + 32 * (k0 + i) + 8 * fq); }
#pragma unroll
        for (int i = 0; i < 8; ++i) { acc[0] = mma16(a[i], b0[i], acc[0]); acc[1] = mma16(a[i], b1[i], acc[1]);
            const int col = 32 * (k0 + i) + 8 * fq; const f32x4 g0 = *(const f32x4*)(F.A->in[I_NFFNG] + col), g1 = *(const f32x4*)(F.A->in[I_NFFNG] + col + 4);
            float xv[8]; unpack8(__builtin_bit_cast(u32x4, a[i]), xv);
            xv[0] *= rsl * g0.x; xv[1] *= rsl * g0.y; xv[2] *= rsl * g0.z; xv[3] *= rsl * g0.w; xv[4] *= rsl * g1.x; xv[5] *= rsl * g1.y; xv[6] *= rsl * g1.z; xv[7] *= rsl * g1.w;
            *(u32x2*)(F.x2q() + (t0 + fr) * D + col) = pack8_fp8(xv); } }
#pragma unroll
    for (int r = 0; r < 4; ++r)
#pragma unroll
        for (int nt = 0; nt < 2; ++nt) lg[(4 * fq + r) * 33 + 16 * nt + fr] = acc[nt][r];
    LDS_WAIT();
    float rs = 0.f, gk[4] = {0.f, 0.f, 0.f, 0.f};
    if (lane < 16) { const size_t t = t0 + lane; rs = row_rs(F.ssq2(), t);
        float v[32];
#pragma unroll
        for (int e = 0; e < 32; ++e) v[e] = lg[lane * 33 + e] * rs + F.A->in[I_BR][e];
        unsigned taken = 0u; float tv[4];
#pragma unroll
        for (int k = 0; k < 4; ++k) { float best = -INFINITY; int bi = 0;
#pragma unroll
            for (int e = 0; e < 32; ++e) { const bool ok = !((taken >> e) & 1u) && (v[e] > best); best = ok ? v[e] : best; bi = ok ? e : bi; }
            taken |= 1u << bi; tv[k] = best; ex[lane * 4 + k] = bi; }
        float sum = 0.f;
#pragma unroll
        for (int k = 0; k < 4; ++k) { gk[k] = __expf(tv[k] - tv[0]); sum += gk[k]; }
        const float inv = 1.f / sum;
        *(f32x4*)(F.gates() + t * 4) = (f32x4){gk[0] * inv, gk[1] * inv, gk[2] * inv, gk[3] * inv}; }
    LDS_WAIT();
    const int me = ex[lane]; const float my_rs = __shfl(rs, lane >> 2);
    int rank = 0, mytot = 0;
#pragma unroll
    for (int e = 0; e < 32; ++e) { const unsigned long long m = __ballot(me == e); const int below = __builtin_popcountll(m & ((1ull << lane) - 1ull));
        rank = (me == e) ? below : rank; mytot = (lane == e) ? __builtin_popcountll(m) : mytot; }
    unsigned base = 0u;
    if (lane < 32 && mytot > 0) base = atomicAdd(F.ctl + CW_CNT + lane, (unsigned)mytot);
    const unsigned slot = (unsigned)__shfl((int)base, me) + (unsigned)rank;
    F.list()[me * ECAP + slot] = (int)(t0 * 4 + lane); (void)my_rs;
    LDS_WAIT();
}

__device__ __forceinline__ void expert_tables(Frame& F) {
    LAS int* tab = (LAS int*)(F.lds + TAB_OFF);
    if (F.tid < 32) tab[F.tid] = (int)__hip_atomic_load(F.ctl + CW_CNT + F.tid, __ATOMIC_RELAXED, __HIP_MEMORY_SCOPE_AGENT);
    __syncthreads();
    if (F.tid == 0) { int s = 0; for (int e = 0; e < 32; ++e) { tab[32 + e] = s; s += (tab[e] + 255) >> 8; } tab[64] = s; }
    __syncthreads();
}
template <int NTN, bool GATH> struct ProbExp {
    static constexpr bool GATHER = GATH, gather = GATH, FP8 = true; static constexpr int WSCALE = FP8_WSCALE;
    int K, lda, ldb, G, c; const LAS int* tab; const unsigned char* A; const unsigned char* Bt; const int* list; mutable int ehint;
    __device__ __forceinline__ bool next(int i, Unit& u) const {
        const int L = i * G + c; if (L >= NTN * tab[64]) return false;
        int e = ehint;
#pragma unroll 1
        while (e < 31 && L >= NTN * tab[32 + e + 1]) ++e;
        ehint = e;
        const int r = L - NTN * tab[32 + e], mte = tab[32 + e + 1] - tab[32 + e];
        u.aux = e; u.pn = r / mte; u.pm = r % mte; return true;
    }
    __device__ __forceinline__ const char* a_base(const Unit& u) const { return gather ? (const char*)A : (const char*)(A + (size_t)(tab[32 + u.aux] + u.pm) * 256 * D); }
    __device__ __forceinline__ const char* b_base(const Unit& u) const { return (const char*)(Bt + ((size_t)u.aux * NTN + u.pn) * 256 * D); }
    __device__ __forceinline__ unsigned a_off(const Unit& u, int row, int C) const {
        if (!gather) return (unsigned)(row * D + C * 2);
        const int slot = u.pm * 256 + row; const int av = list[u.aux * ECAP + slot];
        const int a = slot < tab[u.aux] ? av : 0;
        return (unsigned)((a >> 2) * D + C * 2);
    }
};
struct EpiE1 {
    static constexpr bool MID = false;
    const LAS int* tab; const float* lscale; const float* b1; unsigned char* act;
    __device__ __forceinline__ void operator()(const f32x4 (&acc)[2][2][4][2], const Unit& u, int wr, int wc, int fr, int fq) const {
        asm volatile("" : "+v"(fr), "+v"(fq));
        const int e = u.aux; const size_t rbase = (size_t)(tab[32 + e] + u.pm) * 256;
        const int j0 = u.pn * 128 + wc * 32 + 8 * fq;
        const float* bp = b1 + (size_t)e * 2048 + j0;
        const f32x4 bg0 = *(const f32x4*)bp, bg1 = *(const f32x4*)(bp + 4), bl0 = *(const f32x4*)(bp + 1024), bl1 = *(const f32x4*)(bp + 1028);
        const float bg[8] = {bg0.x, bg0.y, bg0.z, bg0.w, bg1.x, bg1.y, bg1.z, bg1.w}, bl[8] = {bl0.x, bl0.y, bl0.z, bl0.w, bl1.x, bl1.y, bl1.z, bl1.w};
#pragma unroll
        for (int ai = 0; ai < 2; ++ai)
#pragma unroll
            for (int m = 0; m < 4; ++m) { const int rt = ai * 128 + wr * 64 + m * 16 + fr; float v[8];
#pragma unroll
                for (int jp = 0; jp < 4; ++jp) {
                    const f32x2 ag = {acc[ai][0][m][jp >> 1][2 * (jp & 1)], acc[ai][0][m][jp >> 1][2 * (jp & 1) + 1]}, al = {acc[ai][1][m][jp >> 1][2 * (jp & 1)], acc[ai][1][m][jp >> 1][2 * (jp & 1) + 1]};
                    const f32x2 bg2 = {bg[2 * jp], bg[2 * jp + 1]}, bl2 = {bl[2 * jp], bl[2 * jp + 1]};
                    const f32x2 ga = ag + bg2, la = al + bl2;
                    const f32x2 glu = {fminf(ga.x, 7.0f), fminf(ga.y, 7.0f)}, lin = {fminf(fmaxf(la.x, -7.0f), 7.0f), fminf(fmaxf(la.y, -7.0f), 7.0f)};
                    const f32x2 t = glu * (-1.702f * 1.4426950408889634f);
                    const f32x2 d = (f32x2){__builtin_amdgcn_exp2f(t.x), __builtin_amdgcn_exp2f(t.y)} + 1.0f;
                    const f32x2 r = {__builtin_amdgcn_rcpf(d.x), __builtin_amdgcn_rcpf(d.y)};
                    const f32x2 o = ((lin + 1.0f) * glu) * r;
                    v[2 * jp] = o.x; v[2 * jp + 1] = o.y; }
                *(u32x2*)(act + (rbase + rt) * D + j0) = pack8_fp8(v); }
    }
};
struct EpiE2 {
    static constexpr bool MID = false;
    const LAS int* tab; const int* list; const float* b2; unsigned char* yb; unsigned char* dummy;
    __device__ __forceinline__ void operator()(const f32x4 (&acc)[2][2][4][2], const Unit& u, int wr, int wc, int fr, int fq) const {
        asm volatile("" : "+v"(fr), "+v"(fq));
        const int e = u.aux, cnt = tab[e]; const int col0 = u.pn * 256 + wc * 32 + 8 * fq;
        float bb[2][8];
#pragma unroll
        for (int bj = 0; bj < 2; ++bj) { const f32x4 x0 = *(const f32x4*)(b2 + (size_t)e * D + col0 + bj * 128), x1 = *(const f32x4*)(b2 + (size_t)e * D + col0 + bj * 128 + 4);
            bb[bj][0] = x0.x; bb[bj][1] = x0.y; bb[bj][2] = x0.z; bb[bj][3] = x0.w; bb[bj][4] = x1.x; bb[bj][5] = x1.y; bb[bj][6] = x1.z; bb[bj][7] = x1.w; }
        int aidx[2][4];
#pragma unroll
        for (int ai = 0; ai < 2; ++ai)
#pragma unroll
            for (int m = 0; m < 4; ++m) aidx[ai][m] = list[e * ECAP + u.pm * 256 + ai * 128 + wr * 64 + m * 16 + fr];
#pragma unroll
        for (int ai = 0; ai < 2; ++ai)
#pragma unroll
            for (int m = 0; m < 4; ++m) { const int slot = u.pm * 256 + ai * 128 + wr * 64 + m * 16 + fr;
                unsigned char* rowp = (slot < cnt) ? yb + (size_t)aidx[ai][m] * D : dummy;
#pragma unroll
                for (int bj = 0; bj < 2; ++bj) { float v[8];
#pragma unroll
                    for (int j = 0; j < 4; ++j) { v[j] = acc[ai][bj][m][0][j] + bb[bj][j]; v[4 + j] = acc[ai][bj][m][1][j] + bb[bj][4 + j]; }
                    *(u32x2*)(rowp + col0 + bj * 128) = pack8_fp8(v); } }
    }
};

struct CombTok { u32x4 x[2]; u32x2 y[2][4]; f32x4 g; };
__device__ __forceinline__ void comb_load(Frame& F, int t, int lane, CombTok& c) {
    c.g = *(const f32x4*)(F.gates() + (size_t)t * 4);
#pragma unroll
    for (int hf = 0; hf < 2; ++hf) { const int col = hf * 512 + lane * 8; c.x[hf] = *(const u32x4*)(F.x2b() + (size_t)t * D + col);
#pragma unroll
        for (int k = 0; k < 4; ++k) c.y[hf][k] = *(const u32x2*)((const unsigned char*)F.yb() + ((size_t)t * 4 + k) * D + col); }
}
__device__ __forceinline__ void comb_finish(Frame& F, int t, int lane, const CombTok& c) {
    const float gk[4] = {c.g.x, c.g.y, c.g.z, c.g.w}; float x[2][8]; float ss = 0.f;
#pragma unroll
    for (int hf = 0; hf < 2; ++hf) { unpack8(c.x[hf], x[hf]);
#pragma unroll
        for (int k = 0; k < 4; ++k) { float y[8]; unpack8_fp8(c.y[hf][k], y);
#pragma unroll
            for (int j = 0; j < 8; ++j) x[hf][j] += gk[k] * y[j]; }
#pragma unroll
        for (int j = 0; j < 8; ++j) ss += x[hf][j] * x[hf][j]; }
    const float rs = rsqrtf(wave_sum(ss) * (1.f / D) + EPS);
#pragma unroll
    for (int hf = 0; hf < 2; ++hf) { const int col = hf * 512 + lane * 8; const f32x4 g0 = *(const f32x4*)(F.A->in[I_NFING] + col), g1 = *(const f32x4*)(F.A->in[I_NFING] + col + 4);
        *(f32x4*)(F.A->out + (size_t)t * D + col) = (f32x4){x[hf][0] * rs * g0.x, x[hf][1] * rs * g0.y, x[hf][2] * rs * g0.z, x[hf][3] * rs * g0.w};
        *(f32x4*)(F.A->out + (size_t)t * D + col + 4) = (f32x4){x[hf][4] * rs * g1.x, x[hf][5] * rs * g1.y, x[hf][6] * rs * g1.z, x[hf][7] * rs * g1.w}; }
}
__device__ __forceinline__ void combine_rows(Frame& F) {
    const int gw = F.vcu * 8 + F.wave, NGW = F.G * 8, lane = F.lane;
    if (gw >= T) return;
    CombTok ca, cb; comb_load(F, gw, lane, ca);
    for (int t = gw;;) {
        const bool hb = t + NGW < T; if (hb) comb_load(F, t + NGW, lane, cb);
        comb_finish(F, t, lane, ca); if (!hb) break;
        const bool ha = t + 2 * NGW < T; if (ha) comb_load(F, t + 2 * NGW, lane, ca);
        comb_finish(F, t + NGW, lane, cb); if (!ha) break;
        t += 2 * NGW; }
}

#ifndef DBG_OUT
#define DBG_OUT 0
#endif
#if DBG_OUT
__device__ __forceinline__ void dbg_rows(Frame& F) {
    const int gw = F.vcu * 8 + F.wave, NGW = F.G * 8, lane = F.lane;
    for (int t = gw; t < T; t += NGW) {
#pragma unroll
        for (int hf = 0; hf < 2; ++hf) { const int col = hf * 512 + lane * 8; float x[8];
#pragma unroll
            for (int j = 0; j < 8; ++j) x[j] = 0.f;
            if (DBG_OUT == 1) { for (int m = 0; m < 5; ++m) { if (col + 1024 * m < PN) { float y[8]; unpack8(*(const u32x4*)(F.p() + (size_t)t * PN + col + 1024 * m), y);
#pragma unroll
                for (int j = 0; j < 8; ++j) x[j] += y[j]; } } }
            else if (DBG_OUT == 8) { for (int k = 0; k < 4; ++k) { float y[8]; unpack8_fp8(*(const u32x2*)((const unsigned char*)F.yb() + ((size_t)t * 4 + k) * D + col), y); const float g = F.gates()[t * 4 + k];
#pragma unroll
                for (int j = 0; j < 8; ++j) x[j] += g * y[j]; } }
            else { const bf16_t* B = DBG_OUT == 2 ? F.oab() : DBG_OUT == 3 ? F.mix() : DBG_OUT == 4 ? F.x1b() : DBG_OUT == 5 ? F.q() : DBG_OUT == 6 ? F.ao() : F.x2b();
                unpack8(*(const u32x4*)(B + (size_t)t * D + col), x); }
#pragma unroll
            for (int j = 0; j < 8; ++j) if (!(fabsf(x[j]) < 1e30f)) x[j] = 1e6f;
            *(f32x4*)(F.A->out + (size_t)t * D + col) = (f32x4){x[0], x[1], x[2], x[3]};
            *(f32x4*)(F.A->out + (size_t)t * D + col + 4) = (f32x4){x[4], x[5], x[6], x[7]}; }
    }
}
#endif

__global__ void __launch_bounds__(512, 2) fwd_kernel(Args args) {
    extern __shared__ __attribute__((aligned(16))) unsigned char lds[];
    Frame F;
    F.lds = (LAS unsigned char*)lds; F.MISC = (volatile LAS unsigned*)(F.lds + MISC_OFF);
    F.tid = threadIdx.x; F.lane = F.tid & 63; F.wave = __builtin_amdgcn_readfirstlane(F.tid >> 6);
    F.G = gridDim.x; { const int bx = blockIdx.x; F.vcu = (F.G % 8 == 0) ? (bx % 8) * (F.G / 8) + bx / 8 : bx; }
    F.ctl = (unsigned*)(args.ws + WS_CTL);
    F.A = &args;
    for (int u = F.tid; u < 64; u += 512) ((LAS unsigned*)(F.lds + MISC_OFF))[u] = 0u;
    __syncthreads();
    XcdBarrier bar; bar.bar = F.ctl + CW_BAR; bar.x = 0; bar.st = nullptr;
    if (!MK_PER_PHASE) bar = xcd_barrier_post(F.ctl + CW_BAR, F.MISC + 8);
    const int lo = args.ph_lo, hi = args.ph_hi;
#ifndef PH_MASK
#define PH_MASK 0x3fff
#endif
#define IN(k) (((PH_MASK >> (k)) & 1) && lo <= (k) && (k) < hi)
#ifndef DOUBLE_MASK
#define DOUBLE_MASK 0
#endif
#define REP(k) for (int _rep = 0; _rep < ((((DOUBLE_MASK) >> (k)) & 1) ? 2 : 1); ++_rep, ((((DOUBLE_MASK) >> (k)) & 1) && _rep == 1 ? xcd_barrier(bar) : (void)0))
#define SEAM(k) do { if (IN(k) && IN((k) + 1)) xcd_barrier(bar); } while (0)
    const int c = (int)blockIdx.x;

    if (IN(0)) REP(0) { p0_prologue(F); } SEAM(0);
    if (IN(1)) REP(1) { ProbP1 P{D, D, ProbP1::EB * D, F.G, c, args.ws}; EpiP1 E{args.ws}; pg8::gemm_phase(F.lds, P, E); } SEAM(1);
    if (IN(2)) REP(2) { for (int u = F.vcu; u < 1024; u += F.G) gla_a_unit(F, u); } SEAM(2);
    if (IN(3)) REP(3) { cvt_range(F, CVT_LATE, CVT_EXPERT);
                        if (F.wave < 4) for (int it = F.vcu * 4 + F.wave; it < 1024; it += F.G * 4) gla_sscan_item(F, it);
                        for (int u = F.vcu; u < 512; u += F.G) sgu_unit(F, u); } SEAM(3);
    if (IN(4)) REP(4) { for (int it = F.vcu * 8 + F.wave; it < 4096; it += F.G * 8) gla_out_item(F, it); } SEAM(4);
    if (IN(5)) REP(5) { ProbStd P{D, D, 2 * D, F.G, c, F.oab(), F.Wpab_t()}; EpiMix2 E{F.p(), F.mix()}; pg8::gemm_phase(F.lds, P, E); } SEAM(5);
    if (IN(6)) REP(6) { ProbStd P{D, D, 2 * D, F.G, c, F.mix(), F.Wmo_t()}; EpiRes<true> E{(const void*)F.A->in[I_X], F.x1b(), F.ssq1(), F.x1q(), nullptr}; pg8::gemm_phase(F.lds, P, E); } SEAM(6);
    if (IN(7)) REP(7) { ProbStdT<true, 0x75757575> P{D, D, D, F.G, c, F.x1q(), F.Wq_t()}; EpiScale E{F.ssq1(), F.q()};     pg8::gemm_phase(F.lds, P, E); } SEAM(7);
    if (IN(8)) REP(8) { for (int u = F.vcu; u < 256; u += F.G) attn_unit(F, u); } SEAM(8);
    if (IN(9)) REP(9) { ProbStdT<true> P{D, D, D, F.G, c, F.ao(), F.Wo_t()}; EpiRes<false> E{(const void*)F.x1b(), F.x2b(), F.ssq2(), nullptr, nullptr}; pg8::gemm_phase(F.lds, P, E); } SEAM(9);
    if (IN(10)) REP(10) { for (int it = F.wave * F.G + F.vcu; it < 1024; it += 8 * F.G) router_item(F, it); cvt_expert_dma(F); } SEAM(10);
    if (IN(11)) REP(11) { expert_tables(F); const LAS int* tab = (const LAS int*)(F.lds + TAB_OFF);
        ProbExp<8, true> P{D, D, D, F.G, F.vcu, tab, F.x2q(), (const unsigned char*)F.W1_t(), F.list(), 0}; EpiE1 E{tab, F.lscale(), F.A->in[I_BE1], (unsigned char*)F.act()}; pg8::gemm_phase(F.lds, P, E); } SEAM(11);
    if (IN(12)) REP(12) { expert_tables(F); const LAS int* tab = (const LAS int*)(F.lds + TAB_OFF);
        ProbExp<4, false> P{D, D, D, F.G, F.vcu, tab, (const unsigned char*)F.act(), (const unsigned char*)F.W2_t(), F.list(), 0}; EpiE2 E{tab, F.list(), F.A->in[I_BE2], (unsigned char*)F.yb(), (unsigned char*)(args.ws + WS_CTL + 512 * 1024)}; pg8::gemm_phase(F.lds, P, E); } SEAM(12);
#if DBG_OUT
    if (lo <= 13 && 13 < hi) { dbg_rows(F); }
#else
    if (IN(13)) REP(13) { combine_rows(F); }
#endif
#undef IN
#undef SEAM
}

extern "C" void kernel_launch(void* const* d_in, const int* in_sizes, int n_in, void* d_out, int out_size, void* d_ws, size_t ws_size, hipStream_t stream) {
    static int grid = 0;
    if (grid == 0) {
        if (n_in != 28 || in_sizes[0] != T * D || out_size != T * D || ws_size < WS_END) { fprintf(stderr, "kernel_launch: unexpected problem (n_in %d, in0 %d, out %d, ws %zu); nothing launched\n", n_in, n_in > 0 ? in_sizes[0] : -1, out_size, ws_size); grid = -1; return; }
        int dev = 0, cus = 0, per_cu = 0;
        if (hipGetDevice(&dev) != hipSuccess || hipDeviceGetAttribute(&cus, hipDeviceAttributeMultiprocessorCount, dev) != hipSuccess) { grid = -1; return; }
        if (hipFuncSetAttribute((const void*)fwd_kernel, hipFuncAttributeMaxDynamicSharedMemorySize, LDS_BYTES) != hipSuccess) { fprintf(stderr, "kernel_launch: hipFuncSetAttribute failed\n"); grid = -1; return; }
        if (hipOccupancyMaxActiveBlocksPerMultiprocessor(&per_cu, (const void*)fwd_kernel, 512, LDS_BYTES) != hipSuccess || per_cu < 1) fprintf(stderr, "kernel_launch: occupancy query reports %d blocks per CU\n", per_cu);
        (void)hipGetLastError();
        grid = cus;
    }
    if (grid < 0) return;
    if (hipMemsetAsync((char*)d_ws + WS_CTL, 0, CTL_ZERO_BYTES, stream) != hipSuccess) { fprintf(stderr, "kernel_launch: memset failed\n"); return; }
    Args a{};
    for (int i = 0; i < 28; ++i) a.in[i] = (const float*)d_in[i];
    a.out = (float*)d_out; a.ws = (unsigned char*)d_ws;
#if MK_PER_PHASE
    for (int ph = 0; ph < NPHASE; ++ph) { a.ph_lo = ph; a.ph_hi = ph + 1; hipLaunchKernelGGL(fwd_kernel, dim3(grid), dim3(512), LDS_BYTES, stream, a); }
#else
    a.ph_lo = 0; a.ph_hi = NPHASE;
    hipLaunchKernelGGL(fwd_kernel, dim3(grid), dim3(512), LDS_BYTES, stream, a);
#endif
}
```

```cpp
#include <hip/hip_runtime.h>
#include <cstdio>
#include <cstdint>

#ifndef P1_FP8
#define P1_FP8 0
#endif
#ifndef MK_PER_PHASE
#define MK_PER_PHASE 0
#endif

#define LAS __attribute__((address_space(3)))
#define GAS __attribute__((address_space(1)))
typedef unsigned short bf16_t;
typedef short bf16x8 __attribute__((ext_vector_type(8)));
typedef float f32x4 __attribute__((ext_vector_type(4)));
typedef float f32x2 __attribute__((ext_vector_type(2)));
typedef unsigned u32x4 __attribute__((ext_vector_type(4)));
typedef unsigned u32x2 __attribute__((ext_vector_type(2)));
typedef int i32x4 __attribute__((ext_vector_type(4)));
typedef int i32x8 __attribute__((ext_vector_type(8)));
#define FP8_WSCALE 0x79797979
constexpr float FP8_WMUL = 64.0f;
typedef GAS unsigned gu32;

constexpr int T = 16384, D = 1024, NBATCH = 8, SEQ = 2048, MEMLEN = 256, TM = NBATCH * MEMLEN;
constexpr int INC = 4624;
constexpr int PN = 4864;
constexpr int PC_Q = 0, PC_K = 256, PC_V = 512, PC_R = 1024, PC_U = 1536, PC_SV = 2048, PC_GA = 2560, PC_GB = 3584, PC_A = 4608;
constexpr int OFF_A = 1536;
constexpr int NE = 32, NASG = T * 4, ECAP = 16384;
constexpr float EPS = 1e-5f;
constexpr int NPHASE = 14;

constexpr size_t MiB = 1u << 20;
constexpr size_t WS_CTL = 0, CTL_ZERO_BYTES = 1 * MiB;
constexpr size_t WS_WR = 1 * MiB, WS_SGUW = 1 * MiB + 256 * 1024, WS_DECAY = 1 * MiB + 512 * 1024;
constexpr size_t WS_WIN = 2 * MiB, WS_WK = 12 * MiB, WS_WV = 14 * MiB, WS_WPAB = 16 * MiB, WS_WMO = 18 * MiB, WS_WQ = 20 * MiB, WS_WO = 22 * MiB;
constexpr size_t WS_SSQ1 = 24 * MiB, WS_SSQ2 = 25 * MiB, WS_LIST = 26 * MiB, WS_LSCALE = 28 * MiB, WS_GATES = 30 * MiB;
constexpr size_t WS_W1 = 32 * MiB, WS_W2 = 160 * MiB, WS_H = 224 * MiB, WS_MEMN = 256 * MiB, WS_KMEM = 260 * MiB, WS_VT = 264 * MiB, WS_QIN = 268 * MiB;
constexpr size_t WS_OINTRA = 276 * MiB, WS_KVT = 308 * MiB, WS_OAB = 340 * MiB, WS_MIX = 372 * MiB, WS_X1B = 404 * MiB, WS_Q = 436 * MiB, WS_AO = 468 * MiB, WS_X2B = 500 * MiB;
constexpr size_t WS_P = 532 * MiB, WS_ACT = 684 * MiB, WS_YB = 828 * MiB, WS_SPT = 956 * MiB, WS_X2Q = 972 * MiB, WS_X1Q = 988 * MiB, WS_SVS = 1004 * MiB, WS_END = 1005 * MiB;
static_assert(WS_P + (size_t)T * PN * 2 <= WS_ACT && WS_ACT + (size_t)(NASG + NE * 256) * 1024 * 2 <= WS_YB && WS_YB + (size_t)NASG * 1024 * 2 <= WS_END, "ws map");
constexpr int CW_CNT = 64;
constexpr int CW_BAR = 4096;

constexpr int RING_BYTES = 131072;
constexpr int TAB_OFF = 139264, MISC_OFF = 141312, ROUTER_OFF = 147456, LDS_BYTES = 157696;

typedef __bf16 bf16x2_t __attribute__((ext_vector_type(2)));
__device__ __forceinline__ unsigned cvt_pk_bf16(float lo, float hi) { const f32x2 v = {lo, hi}; const bf16x2_t b = __builtin_convertvector(v, bf16x2_t); return __builtin_bit_cast(unsigned, b); }
__device__ __forceinline__ bf16_t f2bf(float f) { return (bf16_t)(cvt_pk_bf16(f, 0.f) & 0xffffu); }
__device__ __forceinline__ float bflo(unsigned w) { return __uint_as_float(w << 16); }
__device__ __forceinline__ float bfhi(unsigned w) { return __uint_as_float(w & 0xffff0000u); }
__device__ __forceinline__ float bf2f(bf16_t v) { return __uint_as_float((unsigned)v << 16); }
__device__ __forceinline__ void unpack8(const u32x4 w, float (&f)[8]) { f[0] = bflo(w.x); f[1] = bfhi(w.x); f[2] = bflo(w.y); f[3] = bfhi(w.y); f[4] = bflo(w.z); f[5] = bfhi(w.z); f[6] = bflo(w.w); f[7] = bfhi(w.w); }
__device__ __forceinline__ u32x4 pack8(const float (&f)[8]) { u32x4 w; w.x = cvt_pk_bf16(f[0], f[1]); w.y = cvt_pk_bf16(f[2], f[3]); w.z = cvt_pk_bf16(f[4], f[5]); w.w = cvt_pk_bf16(f[6], f[7]); return w; }
__device__ __forceinline__ u32x2 pack8_fp8(const float (&f)[8]) { int a = 0, b = 0;
    a = __builtin_amdgcn_cvt_pk_fp8_f32(f[0], f[1], a, false); a = __builtin_amdgcn_cvt_pk_fp8_f32(f[2], f[3], a, true);
    b = __builtin_amdgcn_cvt_pk_fp8_f32(f[4], f[5], b, false); b = __builtin_amdgcn_cvt_pk_fp8_f32(f[6], f[7], b, true);
    return (u32x2){(unsigned)a, (unsigned)b}; }
__device__ __forceinline__ void unpack8_fp8(const u32x2 w, float (&f)[8]) {
    const f32x2 a = __builtin_amdgcn_cvt_pk_f32_fp8((int)w.x, false), b = __builtin_amdgcn_cvt_pk_f32_fp8((int)w.x, true), c = __builtin_amdgcn_cvt_pk_f32_fp8((int)w.y, false), d = __builtin_amdgcn_cvt_pk_f32_fp8((int)w.y, true);
    f[0] = a.x; f[1] = a.y; f[2] = b.x; f[3] = b.y; f[4] = c.x; f[5] = c.y; f[6] = d.x; f[7] = d.y; }
__device__ __forceinline__ f32x4 mma16(bf16x8 a, bf16x8 b, f32x4 c) { return __builtin_amdgcn_mfma_f32_16x16x32_bf16(a, b, c, 0, 0, 0); }
__device__ __forceinline__ float wave_sum(float v) {
#pragma unroll
    for (int o = 1; o < 64; o <<= 1) v += __shfl_xor(v, o);
    return v;
}
__device__ __forceinline__ float sigmoidf_(float x) { return __builtin_amdgcn_rcpf(1.0f + __expf(-x)); }
__device__ __forceinline__ float gelu_erf(float v) {
    const float av = fabsf(v), t = __builtin_amdgcn_rcpf(av * 0.2316418882f + 1.0f);
    float q = t * 0.5307027145f + (-0.7265760135f); q = q * t + 0.7107068705f; q = q * t + (-0.142248368f); q = q * t + 0.127414796f; q = q * t;
    const float e = __builtin_amdgcn_exp2f((v * v) * (-0.72134752044f));
    const float m = v * (q * e);
    return v < 0.f ? m : v - m;
}
__device__ __forceinline__ f32x2 gelu_pk(f32x2 v) {
    const f32x2 av = __builtin_elementwise_abs(v), d = av * 0.2316418882f + 1.0f;
    f32x2 t; t.x = __builtin_amdgcn_rcpf(d.x); t.y = __builtin_amdgcn_rcpf(d.y);
    f32x2 q = t * 0.5307027145f + (-0.7265760135f); q = q * t + 0.7107068705f; q = q * t + (-0.142248368f); q = q * t + 0.127414796f; q = q * t;
    const f32x2 s = (v * v) * (-0.72134752044f);
    f32x2 e; e.x = __builtin_amdgcn_exp2f(s.x); e.y = __builtin_amdgcn_exp2f(s.y);
    const f32x2 m = v * (q * e), r = v - m;
    f32x2 o; o.x = v.x < 0.f ? m.x : r.x; o.y = v.y < 0.f ? m.y : r.y; return o;
}
__device__ __forceinline__ f32x2 sigmoid_pk(f32x2 v) {
    const f32x2 t = v * (-1.4426950408889634f); const f32x2 d = (f32x2){__builtin_amdgcn_exp2f(t.x), __builtin_amdgcn_exp2f(t.y)} + 1.0f;
    return (f32x2){__builtin_amdgcn_rcpf(d.x), __builtin_amdgcn_rcpf(d.y)};
}
#define LDS_WAIT() asm volatile("s_waitcnt lgkmcnt(0)" ::: "memory")
#define VM_WAIT() asm volatile("s_waitcnt vmcnt(0)" ::: "memory")

#define XB_TMO      128
#define XB_XCNT(j)  (256  + 64 * (j))
#define XB_XSUB(j)  (1280 + 64 * (j))
#define XB_XGEN(j)  (2304 + 64 * (j))
#define XB_TOP      3328
#define XB_TOPGEN   3392
#define XCD_BAR_WORDS 3456
#define XB_SPIN_CAP (1u << 22)
__device__ __forceinline__ unsigned xb_ld(unsigned* p)              { return __hip_atomic_load(p, __ATOMIC_RELAXED, __HIP_MEMORY_SCOPE_AGENT); }
__device__ __forceinline__ unsigned xb_add(unsigned* p, unsigned v) { return __hip_atomic_fetch_add(p, v, __ATOMIC_RELAXED, __HIP_MEMORY_SCOPE_AGENT); }
__device__ __forceinline__ unsigned xb_xcc_id() { return (unsigned)__builtin_amdgcn_s_getreg((3 << 11) | 20) & 0xFu; }
#define XB_SPIN(cond, bar) do { unsigned _sp = 0; while (cond) { __builtin_amdgcn_s_sleep(1); \
    if ((++_sp & 255u) == 0u) { if (xb_ld(&(bar)[XB_TMO])) break; if (_sp > XB_SPIN_CAP) { atomicAdd(&(bar)[XB_TMO], 1u); break; } } } } while (0)
struct XcdBarrier { unsigned* bar; unsigned x; volatile LAS unsigned* st; };
__device__ __forceinline__ XcdBarrier xcd_barrier_post(unsigned* bar, volatile LAS unsigned* st) {
    XcdBarrier b; b.bar = bar; b.x = xb_xcc_id(); b.st = st;
    if (threadIdx.x == 0) (void)xb_add(&bar[XB_XCNT(b.x)], 1u);
    return b;
}
__device__ __forceinline__ void xcd_barrier_complete(unsigned* bar, unsigned x, unsigned& nloc, unsigned& nx) {
    const unsigned G = gridDim.x * gridDim.y * gridDim.z;
    unsigned sum, cnt, mine, sp = 0u;
    for (;;) {
        sum = 0u; cnt = 0u; mine = 0u;
#pragma unroll
        for (unsigned j = 0; j < 16; ++j) { const unsigned c = xb_ld(&bar[XB_XCNT(j)]); sum += c; cnt += (c > 0u) ? 1u : 0u; mine = (j == x) ? c : mine; }
        if (sum == G) break;
        __builtin_amdgcn_s_sleep(1);
        if ((++sp & 255u) == 0u) { if (xb_ld(&bar[XB_TMO])) break; if (sp > XB_SPIN_CAP) { atomicAdd(&bar[XB_TMO], 1u); break; } }
    }
    nloc = mine > 0u ? mine : 1u; nx = cnt > 0u ? cnt : 1u;
}
__device__ __forceinline__ void xcd_barrier(const XcdBarrier& b) {
    asm volatile("s_waitcnt vmcnt(0)" ::: "memory");
    __syncthreads();
    if (threadIdx.x == 0) {
        unsigned* bar = b.bar;
        __builtin_amdgcn_s_waitcnt(0);
        unsigned nloc = b.st[0], nx = b.st[1];
        if (nloc == 0u) { xcd_barrier_complete(bar, b.x, nloc, nx); b.st[0] = nloc; b.st[1] = nx; }
        const unsigned old = xb_add(&bar[XB_XSUB(b.x)], 1u);
        const unsigned gen = old / nloc;
        if (old + 1u == (gen + 1u) * nloc) {
            __builtin_amdgcn_fence(__ATOMIC_RELEASE, "agent");
            asm volatile("s_waitcnt vmcnt(0)" ::: "memory");
            const unsigned og = xb_add(&bar[XB_TOP], 1u);
            const unsigned tg = og / nx;
            if (og + 1u == (tg + 1u) * nx) xb_add(&bar[XB_TOPGEN], 1u);
            else XB_SPIN(xb_ld(&bar[XB_TOPGEN]) == tg, bar);
            __builtin_amdgcn_fence(__ATOMIC_ACQUIRE, "agent");
            xb_add(&bar[XB_XGEN(b.x)], 1u);
            asm volatile("s_waitcnt vmcnt(0)" ::: "memory");
        } else {
            __builtin_amdgcn_fence(__ATOMIC_ACQUIRE, "agent");
            XB_SPIN(xb_ld(&bar[XB_XGEN(b.x)]) == gen, bar);
            asm volatile("s_waitcnt vmcnt(0)" ::: "memory");
        }
    }
    __syncthreads();
}

namespace pg8 {
constexpr int BM = 256, BK = 64, HALF = 128, HTB = HALF * BK * 2, NXCD = 8, WGM = 8;
__host__ __device__ __forceinline__ int lds_byte(int r, int c) { const int st = (r >> 4) * 2 + (c >> 5), rr = r & 15, cc = c & 31, ob = rr * 64 + cc * 2; return st * 1024 + (ob ^ (((ob >> 9) & 1) << 5)); }
__host__ __device__ __forceinline__ void stage_rc(int b, int& R, int& C) { const int st = b / 1024, sb = b % 1024, swz = sb ^ (((sb >> 9) & 1) << 5); R = (st >> 1) * 16 + swz / 64; C = (st & 1) * 32 + (swz % 64) / 2; }
__host__ __device__ __forceinline__ int perm32(int rho) { const int n = rho >> 4, i = rho & 15; return 8 * (i >> 2) + 4 * n + (i & 3); }
struct Unit { int pm, pn, aux; };
__device__ __forceinline__ void map_tile(int L, int nM, int nN, int& pm, int& pn) {
    const int nwg = nM * nN; int wgid = L;
    { const int q = nwg / NXCD, r = nwg % NXCD, xcd = wgid % NXCD, off = wgid / NXCD; wgid = (xcd < r ? xcd * (q + 1) : r * (q + 1) + (xcd - r) * q) + off; }
    const int nig = WGM * nN, gid = wgid / nig, fm = gid * WGM, gsz = (nM - fm) < WGM ? (nM - fm) : WGM;
    pm = fm + ((wgid % nig) % gsz); pn = (wgid % nig) / gsz;
}
template <class Epi, class Prob>
__device__ __forceinline__ void gemm_phase(LAS unsigned char* lds, const Prob& P, const Epi& E) {
    const int tid = threadIdx.x, wid = __builtin_amdgcn_readfirstlane(tid >> 6), lane = tid & 63, wr = wid >> 2, wc = wid & 3, fr = lane & 15, fq = lane >> 4;
    const int nt = P.K / (Prob::FP8 ? 128 : BK);
    unsigned voffB[2];
#pragma unroll
    for (int i = 0; i < 2; ++i) { int R_, C_; stage_rc(tid * 16 + i * 8192, R_, C_); const int Rb = (R_ & ~31) + perm32(R_ & 31); voffB[i] = (unsigned)(Rb * P.ldb + C_ * 2); }
#define PG8_AOFF(dst0, dst1, unit) do { _Pragma("unroll") for (int _i = 0; _i < 2; ++_i) { int R_, C_; stage_rc(tid * 16 + _i * 8192, R_, C_); dst0[_i] = P.a_off(unit, R_, C_); dst1[_i] = P.a_off(unit, R_ + HALF, C_); } } while (0)
    const size_t kstep = (size_t)(BK * 2);
    const size_t hstepB = (size_t)HALF * P.ldb;
    const unsigned ldsw = (unsigned)wid * 1024u;
    const int aoff = lds_byte(wr * 64 + fr, fq * 8), boff = lds_byte(wc * 32 + fr, fq * 8);
#define PG8_SA(b, h) (((b) * 2 + (h)) * HTB)
#define PG8_SB(b, h) ((4 + (b) * 2 + (h)) * HTB)
#define PG8_STAGE(bufoff, gbase, voff) do { _Pragma("unroll") for (int _i = 0; _i < 2; ++_i) \
        __builtin_amdgcn_global_load_lds((const unsigned*)((const char*)(gbase) + (voff)[_i]), (LAS unsigned*)(lds + (bufoff) + ldsw + _i * 8192), 16, 0, 0); } while (0)
#define PG8_LD8(addr) __builtin_shufflevector(*(const LAS i32x4*)(addr), *(const LAS i32x4*)((addr) + 1024), 0, 1, 2, 3, 4, 5, 6, 7)
#define PG8_LDA(dst, b, h) do { _Pragma("unroll") for (int m = 0; m < 4; ++m) dst[m] = PG8_LD8(lds + PG8_SA(b, h) + aoff + m * 2048); } while (0)
#define PG8_LDB(dst, b, h) do { _Pragma("unroll") for (int n = 0; n < 2; ++n) dst[n] = PG8_LD8(lds + PG8_SB(b, h) + boff + n * 2048); } while (0)
#define PG8_LO(x) __builtin_bit_cast(bf16x8, __builtin_shufflevector(x, x, 0, 1, 2, 3))
#define PG8_HI(x) __builtin_bit_cast(bf16x8, __builtin_shufflevector(x, x, 4, 5, 6, 7))
#define PG8_MMA(ai, bj, At, Bt) do { __builtin_amdgcn_s_setprio(1); _Pragma("unroll") for (int m = 0; m < 4; ++m) _Pragma("unroll") for (int n = 0; n < 2; ++n) { \
        if constexpr (Prob::FP8) asm volatile("v_mfma_scale_f32_16x16x128_f8f6f4 %0, %1, %2, %0, %3, %4 op_sel_hi:[0,0,0]" : "+v"(acc[ai][bj][m][n]) : "v"(Bt[n]), "v"(At[m]), "v"(scl_w), "v"(scl_1)); \
        else { acc[ai][bj][m][n] = __builtin_amdgcn_mfma_f32_16x16x32_bf16(PG8_LO(Bt[n]), PG8_LO(At[m]), acc[ai][bj][m][n], 0, 0, 0); \
               acc[ai][bj][m][n] = __builtin_amdgcn_mfma_f32_16x16x32_bf16(PG8_HI(Bt[n]), PG8_HI(At[m]), acc[ai][bj][m][n], 0, 0, 0); } } \
        __builtin_amdgcn_s_setprio(0); } while (0)
#define PG8_WAIT_V(n) asm volatile("s_waitcnt vmcnt(" #n ")" ::: "memory")
#define PG8_WAIT_L(n) asm volatile("s_waitcnt lgkmcnt(" #n ")" ::: "memory")
#define PG8_BAR __builtin_amdgcn_s_barrier()
#define PG8_SCHED __builtin_amdgcn_sched_barrier(0)
    Unit cur, nxt; int ui = 0;
    if (!P.next(0, cur)) return;
    f32x4 acc[2][2][4][2];
#pragma unroll
    for (int a = 0; a < 2; ++a)
#pragma unroll
        for (int b = 0; b < 2; ++b)
#pragma unroll
            for (int m = 0; m < 4; ++m)
#pragma unroll
                for (int n = 0; n < 2; ++n) acc[a][b][m][n] = (f32x4){0.f, 0.f, 0.f, 0.f};
    i32x8 At[4], B0[2], B1[2];
    int scl_w = Prob::WSCALE, scl_1 = 0x7f7f7f7f; asm volatile("" : "+v"(scl_w), "+v"(scl_1));
    unsigned cO0[2], cO1[2], nO0[2], nO1[2];
    PG8_AOFF(cO0, cO1, cur);
    const char* cA = P.a_base(cur); const char* cB = P.b_base(cur);
    PG8_STAGE(PG8_SB(0, 0), cB, voffB); PG8_STAGE(PG8_SB(0, 1), cB + hstepB, voffB); PG8_STAGE(PG8_SA(0, 0), cA, cO0); PG8_STAGE(PG8_SA(0, 1), cA, cO1);
    if (wr == 1) PG8_BAR;
    PG8_WAIT_V(2); PG8_BAR;
    PG8_STAGE(PG8_SB(1, 0), cB + kstep, voffB); PG8_STAGE(PG8_SA(1, 0), cA + kstep, cO0); PG8_STAGE(PG8_SB(1, 1), cB + hstepB + kstep, voffB);
    PG8_WAIT_V(6); PG8_BAR;
    for (;;) {
        const bool has_next = P.next(ui + 1, nxt);
        const char* nA = cA; const char* nB = cB;
        if constexpr (Prob::GATHER) {
#pragma unroll
            for (int i = 0; i < 2; ++i) { nO0[i] = cO0[i]; nO1[i] = cO1[i]; } }
        if (has_next) { nA = P.a_base(nxt); nB = P.b_base(nxt); if constexpr (Prob::GATHER) PG8_AOFF(nO0, nO1, nxt); }
        for (int t = 0; t < nt; t += 2) {
            const bool last = (t == nt - 2);
            const char* a1 = cA + (size_t)(t + 1) * kstep;
            const char* a2 = last ? nA : cA + (size_t)(t + 2) * kstep; const char* b2 = last ? nB : cB + (size_t)(t + 2) * kstep;
            const char* a3 = a2 + kstep; const char* b3 = b2 + kstep;
            unsigned o20[2], o21[2];
#pragma unroll
            for (int i = 0; i < 2; ++i) { if constexpr (Prob::GATHER) { o20[i] = last ? nO0[i] : cO0[i]; o21[i] = last ? nO1[i] : cO1[i]; } else { o20[i] = cO0[i]; o21[i] = cO1[i]; } }
            const bool fin = last && !has_next;
            PG8_LDB(B0, 0, 0); PG8_LDB(B1, 0, 1); PG8_SCHED; PG8_LDA(At, 0, 0); PG8_STAGE(PG8_SA(1, 1), a1, cO1);
            PG8_WAIT_V(8); PG8_WAIT_L(0); PG8_BAR; PG8_MMA(0, 0, At, B0); PG8_MMA(0, 1, At, B1); PG8_BAR; PG8_SCHED;
            PG8_LDA(At, 0, 1);
            if (!fin) { PG8_STAGE(PG8_SB(0, 0), b2, voffB); PG8_STAGE(PG8_SB(0, 1), b2 + hstepB, voffB); PG8_STAGE(PG8_SA(0, 0), a2, o20); PG8_WAIT_V(8); }
            else PG8_WAIT_V(2);
            PG8_WAIT_L(0); PG8_BAR; PG8_MMA(1, 0, At, B0); PG8_MMA(1, 1, At, B1); PG8_BAR; PG8_SCHED;
            PG8_LDB(B0, 1, 0); PG8_LDB(B1, 1, 1); PG8_SCHED; PG8_LDA(At, 1, 0);
            if (!fin) { PG8_STAGE(PG8_SA(0, 1), a2, o21); PG8_WAIT_V(8); }
            else PG8_WAIT_V(0);
            PG8_WAIT_L(0); PG8_BAR; PG8_MMA(0, 0, At, B0); PG8_MMA(0, 1, At, B1); PG8_BAR; PG8_SCHED;
            PG8_LDA(At, 1, 1);
            if (!fin) { PG8_STAGE(PG8_SB(1, 0), b3, voffB); PG8_STAGE(PG8_SB(1, 1), b3 + hstepB, voffB); PG8_STAGE(PG8_SA(1, 0), a3, o20); PG8_WAIT_V(8); }
            PG8_WAIT_L(0); PG8_BAR; PG8_MMA(1, 0, At, B0); PG8_MMA(1, 1, At, B1); PG8_BAR; PG8_SCHED;
            if constexpr (Epi::MID) { if (t + 2 == nt / 2) E.mid(acc, cur, wr, wc, fr, fq); }
        }
        if (wr == 0) PG8_BAR;
        if constexpr (Prob::FP8) asm volatile("s_nop 15\n\ts_nop 15" ::: "memory");
        E(acc, cur, wr, wc, fr, fq);
        if (!has_next) break;
#pragma unroll
        for (int a = 0; a < 2; ++a)
#pragma unroll
            for (int b = 0; b < 2; ++b)
#pragma unroll
                for (int m = 0; m < 4; ++m)
#pragma unroll
                    for (int n = 0; n < 2; ++n) acc[a][b][m][n] = (f32x4){0.f, 0.f, 0.f, 0.f};
        cur = nxt; cA = nA; cB = nB; ++ui;
        if constexpr (Prob::GATHER) {
#pragma unroll
            for (int i = 0; i < 2; ++i) { cO0[i] = nO0[i]; cO1[i] = nO1[i]; } }
        if (wr == 1) PG8_BAR;
    }
    PG8_WAIT_V(0);
    PG8_BAR;
#undef PG8_AOFF
#undef PG8_SA
#undef PG8_SB
#undef PG8_STAGE
#undef PG8_LDA
#undef PG8_LD8
#undef PG8_LO
#undef PG8_HI
#undef PG8_LDB
#undef PG8_MMA
#undef PG8_WAIT_V
#undef PG8_WAIT_L
#undef PG8_BAR
#undef PG8_SCHED
}
}
using pg8::Unit;

struct Args { const float* in[28]; float* out; unsigned char* ws; int ph_lo, ph_hi; };
struct Frame {
    LAS unsigned char* lds;
    volatile LAS unsigned* MISC;
    unsigned* ctl;
    int tid, lane, wave, vcu, G;
    const Args* A;
    __device__ __forceinline__ bf16_t* Win_t() const { return (bf16_t*)(A->ws + WS_WIN); }
    __device__ __forceinline__ bf16_t* Wk_t() const { return (bf16_t*)(A->ws + WS_WK); }
    __device__ __forceinline__ bf16_t* Wv_t() const { return (bf16_t*)(A->ws + WS_WV); }
    __device__ __forceinline__ bf16_t* Wpab_t() const { return (bf16_t*)(A->ws + WS_WPAB); }
    __device__ __forceinline__ bf16_t* Wmo_t() const { return (bf16_t*)(A->ws + WS_WMO); }
    __device__ __forceinline__ bf16_t* Wq_t() const { return (bf16_t*)(A->ws + WS_WQ); }
    __device__ __forceinline__ bf16_t* Wo_t() const { return (bf16_t*)(A->ws + WS_WO); }
    __device__ __forceinline__ bf16_t* Wr_t() const { return (bf16_t*)(A->ws + WS_WR); }
    __device__ __forceinline__ bf16_t* W1_t() const { return (bf16_t*)(A->ws + WS_W1); }
    __device__ __forceinline__ bf16_t* W2_t() const { return (bf16_t*)(A->ws + WS_W2); }
    __device__ __forceinline__ bf16_t* sguw() const { return (bf16_t*)(A->ws + WS_SGUW); }
    __device__ __forceinline__ bf16_t* h() const { return (bf16_t*)(A->ws + WS_H); }
    __device__ __forceinline__ bf16_t* memn() const { return (bf16_t*)(A->ws + WS_MEMN); }
    __device__ __forceinline__ bf16_t* kmem() const { return (bf16_t*)(A->ws + WS_KMEM); }
    __device__ __forceinline__ bf16_t* vt() const { return (bf16_t*)(A->ws + WS_VT); }
    __device__ __forceinline__ bf16_t* qin() const { return (bf16_t*)(A->ws + WS_QIN); }
    __device__ __forceinline__ bf16_t* oab() const { return (bf16_t*)(A->ws + WS_OAB); }
    __device__ __forceinline__ bf16_t* mix() const { return (bf16_t*)(A->ws + WS_MIX); }
    __device__ __forceinline__ bf16_t* x1b() const { return (bf16_t*)(A->ws + WS_X1B); }
    __device__ __forceinline__ bf16_t* q() const { return (bf16_t*)(A->ws + WS_Q); }
    __device__ __forceinline__ bf16_t* ao() const { return (bf16_t*)(A->ws + WS_AO); }
    __device__ __forceinline__ bf16_t* x2b() const { return (bf16_t*)(A->ws + WS_X2B); }
    __device__ __forceinline__ bf16_t* p() const { return (bf16_t*)(A->ws + WS_P); }
    __device__ __forceinline__ bf16_t* act() const { return (bf16_t*)(A->ws + WS_ACT); }
    __device__ __forceinline__ bf16_t* yb() const { return (bf16_t*)(A->ws + WS_YB); }
    __device__ __forceinline__ bf16_t* ointra() const { return (bf16_t*)(A->ws + WS_OINTRA); }
    __device__ __forceinline__ bf16_t* kvT() const { return (bf16_t*)(A->ws + WS_KVT); }
    __device__ __forceinline__ float* decay() const { return (float*)(A->ws + WS_DECAY); }
    __device__ __forceinline__ float* ssq1() const { return (float*)(A->ws + WS_SSQ1); }
    __device__ __forceinline__ float* ssq2() const { return (float*)(A->ws + WS_SSQ2); }
    __device__ __forceinline__ float* lscale() const { return (float*)(A->ws + WS_LSCALE); }
    __device__ __forceinline__ float* gates() const { return (float*)(A->ws + WS_GATES); }
    __device__ __forceinline__ int* list() const { return (int*)(A->ws + WS_LIST); }
    __device__ __forceinline__ bf16_t* spT() const { return (bf16_t*)(A->ws + WS_SPT); }
    __device__ __forceinline__ unsigned char* x2q() const { return (unsigned char*)(A->ws + WS_X2Q); }
    __device__ __forceinline__ unsigned char* x1q() const { return (unsigned char*)(A->ws + WS_X1Q); }
};
enum { I_X = 0, I_MEM, I_NMIXG, I_WIN, I_WA2, I_BA, I_GOUTG, I_SNG, I_SNB, I_SW, I_SB, I_WPA, I_WPB, I_WMO, I_NXG, I_NMEMG, I_WXQ, I_WXK, I_WXV, I_WXO, I_NFFNG, I_WR, I_BR, I_WE1, I_BE1, I_WE2, I_BE2, I_NFING };

struct CvtItem { const float* src; size_t ldw; unsigned char* dst; const float* kscale; float mul; int fp8; };
__device__ __forceinline__ void cvt_load(const CvtItem& c, float (&v)[64]) {
#pragma unroll
    for (int i = 0; i < 64; ++i) v[i] = __builtin_nontemporal_load(c.src + (size_t)i * c.ldw);
}
__device__ __forceinline__ void cvt_finish(const CvtItem& c, float (&v)[64]) {
    if (c.kscale) {
#pragma unroll
        for (int i = 0; i < 64; ++i) v[i] *= c.kscale[i] * c.mul; }
    else {
#pragma unroll
        for (int i = 0; i < 64; ++i) v[i] *= c.mul; }
    if (c.fp8) {
#pragma unroll
        for (int q = 0; q < 4; ++q) { const float f0[8] = {v[16 * q], v[16 * q + 1], v[16 * q + 2], v[16 * q + 3], v[16 * q + 4], v[16 * q + 5], v[16 * q + 6], v[16 * q + 7]};
            const float f1[8] = {v[16 * q + 8], v[16 * q + 9], v[16 * q + 10], v[16 * q + 11], v[16 * q + 12], v[16 * q + 13], v[16 * q + 14], v[16 * q + 15]};
            const u32x2 lo = pack8_fp8(f0), hi = pack8_fp8(f1); *(u32x4*)(c.dst + 16 * q) = (u32x4){lo.x, lo.y, hi.x, hi.y}; } }
    else {
#pragma unroll
        for (int q = 0; q < 8; ++q) { const float f[8] = {v[8 * q], v[8 * q + 1], v[8 * q + 2], v[8 * q + 3], v[8 * q + 4], v[8 * q + 5], v[8 * q + 6], v[8 * q + 7]}; *(u32x4*)(c.dst + 16 * q) = pack8(f); } }
}
__device__ __forceinline__ CvtItem cvt_desc(const float* W, int ldw, int src_col0, int k0, void* WT, int ldt, int dst_row0, int dst_k0, const float* kscale, float mul, int fp8, int lane) {
    CvtItem c; const int eb = fp8 ? 1 : 2;
    c.src = W + (size_t)k0 * ldw + src_col0 + lane; c.ldw = (size_t)ldw; c.dst = (unsigned char*)WT + ((size_t)(dst_row0 + lane) * ldt + dst_k0 + k0) * eb;
    c.kscale = kscale ? kscale + k0 : nullptr; c.mul = mul; c.fp8 = fp8; return c;
}
__device__ __forceinline__ void cvt_expert128(Frame& F) {
    const int gw = F.vcu * 8 + F.wave, NGW = F.G * 8, lane = F.lane;
    constexpr int I1 = NE * 8 * 32, I2 = NE * 8 * 16;
    for (int it = gw; it < I1 + I2; it += NGW) {
        const float* src; size_t ldw; unsigned char* dst; const float* ks; (void)ks;
        if (it < I1) { const int e = it >> 8, q = it & 255, kb = q >> 5, nb = q & 31, nd = nb * 64; const int sc = ((nd & 128) ? 1024 : 0) + 128 * (nd >> 8) + (nd & 127);
            src = F.A->in[I_WE1] + (size_t)e * D * 2048 + (size_t)(kb * 128) * 2048 + sc + lane; ldw = 2048;
            dst = (unsigned char*)F.W1_t() + (size_t)e * 2048 * D + (size_t)(nd + lane) * D + kb * 128; ks = nullptr; }
        else { const int r = it - I1, e = r >> 7, q = r & 127, kb = q >> 4, nb = q & 15;
            src = F.A->in[I_WE2] + (size_t)e * D * D + (size_t)(kb * 128) * D + nb * 64 + lane; ldw = D;
            dst = (unsigned char*)F.W2_t() + (size_t)e * D * D + (size_t)(nb * 64 + lane) * D + kb * 128; ks = nullptr; }
        float v[128]; const float* pp = src;
#pragma unroll
        for (int i = 0; i < 128; ++i) { v[i] = __builtin_nontemporal_load(pp); pp += ldw; asm volatile("" : "+v"(pp)); }
#pragma unroll
        for (int i = 0; i < 128; ++i) v[i] *= FP8_WMUL;
#pragma unroll
        for (int q = 0; q < 8; ++q) { const float f0[8] = {v[16 * q], v[16 * q + 1], v[16 * q + 2], v[16 * q + 3], v[16 * q + 4], v[16 * q + 5], v[16 * q + 6], v[16 * q + 7]};
            const float f1[8] = {v[16 * q + 8], v[16 * q + 9], v[16 * q + 10], v[16 * q + 11], v[16 * q + 12], v[16 * q + 13], v[16 * q + 14], v[16 * q + 15]};
            const u32x2 lo = pack8_fp8(f0), hi = pack8_fp8(f1); *(u32x4*)(dst + 16 * q) = (u32x4){lo.x, lo.y, hi.x, hi.y}; }
    }
}
constexpr int CVT_SLOT = 16 * 1040;
struct CvtDma { const float* src; unsigned ldw; unsigned char* dst; };
__device__ __forceinline__ CvtDma cvt_dma_desc(const Frame& F, int it) {
    constexpr int I1 = NE * 8 * 64; CvtDma c;
    if (it < I1) { const int e = it >> 9, q = it & 511, kb = q >> 6, nb = q & 63, nd = nb * 32; const int sc = ((nd & 128) ? 1024 : 0) + 128 * (nd >> 8) + (nd & 127);
        c.src = F.A->in[I_WE1] + (size_t)e * D * 2048 + (size_t)(kb * 128) * 2048 + sc; c.ldw = 2048;
        c.dst = (unsigned char*)F.W1_t() + (size_t)e * 2048 * D + (size_t)nd * D + kb * 128; }
    else { const int r = it - I1, e = r >> 8, q = r & 255, kb = q >> 5, nb = q & 31;
        c.src = F.A->in[I_WE2] + (size_t)e * D * D + (size_t)(kb * 128) * D + nb * 32; c.ldw = D;
        c.dst = (unsigned char*)F.W2_t() + (size_t)e * D * D + (size_t)(nb * 32) * D + kb * 128; }
    return c;
}
__device__ __forceinline__ void cvt_dma_issue(const CvtDma& c, LAS unsigned char* slot, int lane) {
    const float* p = c.src + (size_t)(lane >> 3) * c.ldw + (lane & 7) * 4;
#pragma unroll
    for (int i = 0; i < 16; ++i) { __builtin_amdgcn_global_load_lds((const unsigned*)p, (LAS unsigned*)(slot + i * 1040), 16, 0, 2); p += (size_t)8 * c.ldw; }
}
__device__ __forceinline__ void cvt_expert_dma(Frame& F) {
    if (F.wave < 4) return;
    const int cw = F.vcu * 4 + (F.wave - 4), NCW = F.G * 4, lane = F.lane;
    constexpr int ITEMS = NE * 8 * 64 + NE * 8 * 32;
    const int n = cw < ITEMS ? (ITEMS - cw + NCW - 1) / NCW : 0;
    LAS unsigned char* slot0 = F.lds + (F.wave - 4) * (2 * CVT_SLOT);
    const int rdo = (lane & 7) * 2080 + (lane >> 3) * 4;
    CvtDma d0 = cvt_dma_desc(F, n > 0 ? cw : 0), d1 = cvt_dma_desc(F, n > 1 ? cw + NCW : 0);
    if (n > 0) cvt_dma_issue(d0, slot0, lane);
    if (n > 1) cvt_dma_issue(d1, slot0 + CVT_SLOT, lane);
    for (int j = 0; j < n; ++j) {
        if (j + 1 >= n) asm volatile("s_waitcnt vmcnt(0)" ::: "memory");
        else if (j == 0) asm volatile("s_waitcnt vmcnt(16)" ::: "memory");
        else asm volatile("s_waitcnt vmcnt(20)" ::: "memory");
        LAS unsigned char* slot = slot0 + (j & 1) * CVT_SLOT;
        const LAS unsigned char* rd = slot + rdo;
        float v[4][16];
        const unsigned rda = (unsigned)(size_t)rd;
#pragma unroll
        for (int q = 0; q < 4; ++q)
#pragma unroll
            for (int jj = 0; jj < 16; ++jj) asm volatile("ds_read_b32 %0, %1 offset:%2" : "=v"(v[q][jj]) : "v"(rda), "n"(q * 32 + (jj >> 3) * 1040 + (jj & 7) * 128));
        asm volatile("s_waitcnt lgkmcnt(0)" ::: "memory");
#pragma unroll
        for (int q = 0; q < 4; ++q) asm volatile("" : "+v"(v[q][0]), "+v"(v[q][1]), "+v"(v[q][2]), "+v"(v[q][3]), "+v"(v[q][4]), "+v"(v[q][5]), "+v"(v[q][6]), "+v"(v[q][7]),
                                                     "+v"(v[q][8]), "+v"(v[q][9]), "+v"(v[q][10]), "+v"(v[q][11]), "+v"(v[q][12]), "+v"(v[q][13]), "+v"(v[q][14]), "+v"(v[q][15]));
        unsigned char* dst = d0.dst + (size_t)(lane >> 3) * D + (lane & 7) * 16;
        d0 = d1;
        if (j + 2 < n) { d1 = cvt_dma_desc(F, cw + (j + 2) * NCW); cvt_dma_issue(d1, slot, lane); }
#pragma unroll
        for (int q = 0; q < 4; ++q) {
            float f0[8], f1[8];
#pragma unroll
            for (int jj = 0; jj < 8; ++jj) { f0[jj] = v[q][jj] * FP8_WMUL; f1[jj] = v[q][8 + jj] * FP8_WMUL; }
            const u32x2 lo = pack8_fp8(f0), hi = pack8_fp8(f1);
            *(u32x4*)(dst + (size_t)(8 * q) * D) = (u32x4){lo.x, lo.y, hi.x, hi.y}; }
    }
    asm volatile("s_waitcnt vmcnt(0)" ::: "memory");
}
template <bool Q8>
__device__ __forceinline__ void rms_row_to_bf16(const float* xrow, const float* g, bf16_t* orow, int lane) {
    f32x4 v[4]; float s = 0.f;
#pragma unroll
    for (int j = 0; j < 4; ++j) { v[j] = *(const f32x4*)(xrow + 256 * j + 4 * lane); s += (v[j].x * v[j].x + v[j].y * v[j].y) + (v[j].z * v[j].z + v[j].w * v[j].w); }
    const float rs = rsqrtf(wave_sum(s) * (1.f / D) + EPS);
#pragma unroll
    for (int j = 0; j < 4; ++j) { const f32x4 gg = *(const f32x4*)(g + 256 * j + 4 * lane);
        if constexpr (Q8) { int w = 0; w = __builtin_amdgcn_cvt_pk_fp8_f32(v[j].x * rs * gg.x, v[j].y * rs * gg.y, w, false); w = __builtin_amdgcn_cvt_pk_fp8_f32(v[j].z * rs * gg.z, v[j].w * rs * gg.w, w, true);
            *(int*)((unsigned char*)orow + 256 * j + 4 * lane) = w; }
        else { u32x2 o; o.x = cvt_pk_bf16(v[j].x * rs * gg.x, v[j].y * rs * gg.y); o.y = cvt_pk_bf16(v[j].z * rs * gg.z, v[j].w * rs * gg.w);
            *(u32x2*)(orow + 256 * j + 4 * lane) = o; } }
}
__device__ __forceinline__ void cvt_range(Frame& F, int ibeg, int iend) {
    const int gw = F.vcu * 8 + F.wave, NGW = F.G * 8, lane = F.lane;
    constexpr int N_WIN = 16 * 72, N_SQ = 256, N_PA = 8 * 16, N_E1 = 512, N_E2 = 256;
    constexpr int S_WIN = 0, S_WK = S_WIN + N_WIN, S_WV = S_WK + N_SQ, S_PA = S_WV + N_SQ, S_PB = S_PA + N_PA, S_MO = S_PB + N_PA, S_Q = S_MO + N_SQ, S_O = S_Q + N_SQ, S_E1 = S_O + N_SQ, S_E2 = S_E1 + NE * N_E1, S_END = S_E2 + NE * N_E2;
    static_assert(S_E1 == 16 * 72 + 256 * 2 + 8 * 16 * 2 + 256 * 3 && S_END == S_E1 + NE * 512 + NE * 256, "item ranges");
    const int IEND = iend < S_END ? iend : S_END;
    auto desc = [&](int it) -> CvtItem {
        if (it < S_WK) { const int r = it - S_WIN, kb = r / 72, nb = r % 72, n0 = nb * 64; return cvt_desc(F.A->in[I_WIN], INC, n0 < 1536 ? n0 : n0 + 16, kb * 64, F.Win_t(), D, n0, 0, nullptr, P1_FP8 ? FP8_WMUL : 1.f, P1_FP8, lane); }
        if (it < S_WV) { const int r = it - S_WK; return cvt_desc(F.A->in[I_WXK], D, (r & 15) * 64, (r >> 4) * 64, F.Wk_t(), D, (r & 15) * 64, 0, nullptr, P1_FP8 ? FP8_WMUL : 1.f, P1_FP8, lane); }
        if (it < S_PA) { const int r = it - S_WV; return cvt_desc(F.A->in[I_WXV], D, (r & 15) * 64, (r >> 4) * 64, F.Wv_t(), D, (r & 15) * 64, 0, nullptr, P1_FP8 ? FP8_WMUL : 1.f, P1_FP8, lane); }
        if (it < S_PB) { const int r = it - S_PA; return cvt_desc(F.A->in[I_WPA], D, (r & 15) * 64, (r >> 4) * 64, F.Wpab_t(), D, (r & 15) * 64, 0, nullptr, 1.f, 0, lane); }
        if (it < S_MO) { const int r = it - S_PB; return cvt_desc(F.A->in[I_WPB], D, (r & 15) * 64, (r >> 4) * 64, F.Wpab_t(), D, (r & 15) * 64, 512, nullptr, 1.f, 0, lane); }
        if (it < S_Q)  { const int r = it - S_MO; return cvt_desc(F.A->in[I_WMO], D, (r & 15) * 64, (r >> 4) * 64, F.Wmo_t(), D, (r & 15) * 64, 0, nullptr, 1.f, 0, lane); }
        if (it < S_O)  { const int r = it - S_Q;  return cvt_desc(F.A->in[I_WXQ], D, (r & 15) * 64, (r >> 4) * 64, F.Wq_t(), D, (r & 15) * 64, 0, F.A->in[I_NXG], FP8_WMUL, 1, lane); }
        if (it < S_E1) { const int r = it - S_O;  return cvt_desc(F.A->in[I_WXO], D, (r & 15) * 64, (r >> 4) * 64, F.Wo_t(), D, (r & 15) * 64, 0, nullptr, FP8_WMUL, 1, lane); }
        if (it < S_E2) { const int r = it - S_E1, e = r / N_E1, q = r % N_E1, kb = q >> 5, nb = q & 31, nd = nb * 64;
            const int src = ((nd & 128) ? 1024 : 0) + 128 * (nd >> 8) + (nd & 127);
            return cvt_desc(F.A->in[I_WE1] + (size_t)e * D * 2048, 2048, src, kb * 64, (unsigned char*)F.W1_t() + (size_t)e * 2048 * D, D, nd, 0, F.A->in[I_NFFNG], FP8_WMUL, 1, lane); }
        const int r = it - S_E2, e = r / N_E2, q = r % N_E2;
        return cvt_desc(F.A->in[I_WE2] + (size_t)e * D * D, D, (q & 15) * 64, (q >> 4) * 64, (unsigned char*)F.W2_t() + (size_t)e * D * D, D, (q & 15) * 64, 0, nullptr, FP8_WMUL, 1, lane); };
    if (ibeg + gw < IEND) {
        float va[64], vb[64]; CvtItem ca = desc(ibeg + gw), cb = ca; cvt_load(ca, va);
        for (int it = ibeg + gw;;) {
            const bool hb = it + NGW < IEND; if (hb) { cb = desc(it + NGW); cvt_load(cb, vb); }
            cvt_finish(ca, va); if (!hb) break;
            const bool ha = it + 2 * NGW < IEND; if (ha) { ca = desc(it + 2 * NGW); cvt_load(ca, va); }
            cvt_finish(cb, vb); if (!ha) break;
            it += 2 * NGW; }
    }
}
constexpr int CVT_LATE = 16 * 72 + 256 * 2, CVT_EXPERT = 16 * 72 + 256 * 2 + 8 * 16 * 2 + 256 * 3, CVT_END = CVT_EXPERT + NE * 512 + NE * 256;
__device__ __forceinline__ void p0_prologue(Frame& F) {
    const int gw = F.vcu * 8 + F.wave, NGW = F.G * 8, lane = F.lane;
    cvt_range(F, 0, CVT_LATE);
    for (int m = gw; m < T; m += NGW) rms_row_to_bf16<P1_FP8 != 0>(F.A->in[I_X] + (size_t)m * D, F.A->in[I_NMIXG], (bf16_t*)((unsigned char*)F.h() + (size_t)m * D * (P1_FP8 ? 1 : 2)), lane);
    for (int m = gw; m < TM; m += NGW) rms_row_to_bf16<P1_FP8 != 0>(F.A->in[I_MEM] + (size_t)m * D, F.A->in[I_NMEMG], (bf16_t*)((unsigned char*)F.memn() + (size_t)m * D * (P1_FP8 ? 1 : 2)), lane);
    const int gt = F.vcu * 512 + F.tid, NGT = F.G * 512;
    for (int i = gt; i < 256 * D; i += NGT) { const int j = i >> 10, k = i & 1023; const float* wr_ = F.A->in[I_WIN] + (size_t)k * INC + OFF_A; float s = 0.f;
#pragma unroll
        for (int r = 0; r < 16; ++r) s += wr_[r] * F.A->in[I_WA2][r * 256 + j];
        if (P1_FP8) { int w = __builtin_amdgcn_cvt_pk_fp8_f32(s * FP8_WMUL, 0.f, 0, false); ((unsigned char*)F.Win_t())[(size_t)(PC_A + j) * D + k] = (unsigned char)(w & 0xff); }
        else F.Win_t()[(size_t)(PC_A + j) * D + k] = f2bf(s); }
    for (int i = gt; i < NE * D; i += NGT) { const int e = i >> 10, k = i & 1023; F.Wr_t()[i] = f2bf(F.A->in[I_WR][k * NE + e] * F.A->in[I_NFFNG][k]); }
    for (int i = gt; i < 4 * 128 * 128; i += NGT) { const int t = (i >> 7) & 127, s = i & 127; F.sguw()[i] = f2bf(s <= t ? F.A->in[I_SW][i] : 0.f); }
}

struct ProbP1 {
    static constexpr bool GATHER = false, FP8 = (P1_FP8 != 0); static constexpr int EB = P1_FP8 ? 1 : 2, WSCALE = FP8_WSCALE;
    int K, lda, ldb, G, c; const unsigned char* ws;
    __device__ __forceinline__ bool next(int i, Unit& u) const {
        const int L = i * G + c;
        if (L < 1216) { u.aux = 0; pg8::map_tile(L, 64, 19, u.pm, u.pn); return true; }
        if (L < 1248) { u.aux = 1; u.pm = (L - 1216) >> 2; u.pn = (L - 1216) & 3; return true; }
        if (L < 1280) { u.aux = 2; u.pm = (L - 1248) >> 3; u.pn = (L - 1248) & 7; return true; }
        return false;
    }
    __device__ __forceinline__ const char* a_base(const Unit& u) const { const size_t o = u.aux == 0 ? WS_H : (u.aux == 1 ? WS_MEMN : WS_WV); return (const char*)(ws + o + (size_t)u.pm * 256 * D * EB); }
    __device__ __forceinline__ const char* b_base(const Unit& u) const { const size_t o = u.aux == 0 ? WS_WIN : (u.aux == 1 ? WS_WK : WS_MEMN); return (const char*)(ws + o + (size_t)u.pn * 256 * D * EB); }
    __device__ __forceinline__ unsigned a_off(const Unit&, int row, int C) const { return (unsigned)(row * D * EB + C * 2); }
};
struct EpiP1 {
    static constexpr bool MID = false;
    unsigned char* ws;
    __device__ __forceinline__ void operator()(const f32x4 (&acc)[2][2][4][2], const Unit& u, int wr, int wc, int fr, int fq) const {
        asm volatile("" : "+v"(fr), "+v"(fq));
        const size_t oo = u.aux == 0 ? WS_P : (u.aux == 1 ? WS_KMEM : WS_VT);
        bf16_t* O = (bf16_t*)(ws + oo); const int ldc = u.aux == 0 ? PN : (u.aux == 1 ? D : TM);
        const int act = (u.aux == 0) ? ((u.pn >= 6 && u.pn < 10) ? 1 : ((u.pn >= 10 && u.pn < 18) ? 2 : 0)) : 0;
        const int row0 = u.pm * 256 + wr * 64 + fr, col0 = u.pn * 256 + wc * 32 + 8 * fq; const bool svstat = (u.aux == 0) && (u.pn == 8 || u.pn == 9);
#pragma unroll
        for (int ai = 0; ai < 2; ++ai)
#pragma unroll
            for (int m = 0; m < 4; ++m) { bf16_t* rowp = O + (size_t)(row0 + ai * 128 + m * 16) * ldc + col0; float s1 = 0.f, s2 = 0.f;
#pragma unroll
                for (int bj = 0; bj < 2; ++bj) { float v[8];
#pragma unroll
                    for (int j = 0; j < 4; ++j) { v[j] = acc[ai][bj][m][0][j]; v[4 + j] = acc[ai][bj][m][1][j]; }
                    if (act == 1) {
#pragma unroll
                        for (int j = 0; j < 8; j += 2) { const f32x2 o = gelu_pk((f32x2){v[j], v[j + 1]}); v[j] = o.x; v[j + 1] = o.y; }
#pragma unroll
                        for (int j = 0; j < 8; ++j) { s1 += v[j]; s2 += v[j] * v[j]; } }
                    else if (act == 2) {
#pragma unroll
                        for (int j = 0; j < 8; j += 2) { const f32x2 o = sigmoid_pk((f32x2){v[j], v[j + 1]}); v[j] = o.x; v[j + 1] = o.y; } }
                    *(u32x4*)(rowp + bj * 128) = pack8(v); }
                if (svstat) {
                    s1 += __shfl_xor(s1, 16); s1 += __shfl_xor(s1, 32); s2 += __shfl_xor(s2, 16); s2 += __shfl_xor(s2, 32);
                    if (fq == 0) *(f32x2*)((float*)(ws + WS_SVS) + (size_t)(row0 + ai * 128 + m * 16) * 16 + (u.pn - 8) * 8 + wc * 2) = (f32x2){s1, s2}; } }
    }
};

__device__ __forceinline__ void gla_a_unit(Frame& F, int unit) {
    const int tid = F.tid, lane = F.lane, w = F.wave, fr = lane & 15, fq = lane >> 4;
    const int bh = unit >> 5, n = unit & 31, b = bh >> 2, h = bh & 3;
    const int t0 = b * SEQ + n * 64;
    LAS float* cum = (LAS float*)(F.lds); LAS float* tot = (LAS float*)(F.lds + 16640);
    LAS bf16_t* QIN = (LAS bf16_t*)(F.lds + 18688); LAS bf16_t* KIN = (LAS bf16_t*)(F.lds + 27904); LAS bf16_t* KOT = (LAS bf16_t*)(F.lds + 37120);
    LAS bf16_t* ATT = (LAS bf16_t*)(F.lds + 46336); LAS bf16_t* VT = (LAS bf16_t*)(F.lds + 55552);
    const int c = tid >> 3, d8 = (tid & 7) * 8;
    {
        float g[8]; unpack8(*(const u32x4*)(F.p() + (size_t)(t0 + c) * PN + PC_A + h * 64 + d8), g);
        const f32x4 b0 = *(const f32x4*)(F.A->in[I_BA] + h * 64 + d8), b1 = *(const f32x4*)(F.A->in[I_BA] + h * 64 + d8 + 4);
        const float bb[8] = {b0.x, b0.y, b0.z, b0.w, b1.x, b1.y, b1.z, b1.w};
#pragma unroll
        for (int j = 0; j < 8; ++j) { const float x = g[j] + bb[j]; const float ls = fminf(x, 0.f) - __logf(1.f + __expf(-fabsf(x))); cum[c * 65 + d8 + j] = ls * 0.0625f; }
    }
    __syncthreads();
    { const int d = tid & 63, seg = tid >> 6; float run = 0.f;
#pragma unroll
        for (int i = 0; i < 8; ++i) { run += cum[(seg * 8 + i) * 65 + d]; cum[(seg * 8 + i) * 65 + d] = run; }
        tot[seg * 64 + d] = run; }
    __syncthreads();
    { const int d = tid & 63, seg = tid >> 6; float off = 0.f;
#pragma unroll
        for (int s = 0; s < 7; ++s) if (s < seg) off += tot[s * 64 + d];
#pragma unroll
        for (int i = 0; i < 8; ++i) cum[(seg * 8 + i) * 65 + d] += off; }
    __syncthreads();
    {
        float qv[8], kv[8], qi[8], ki[8];
        unpack8(*(const u32x4*)(F.p() + (size_t)(t0 + c) * PN + PC_Q + h * 64 + d8), qv);
        unpack8(*(const u32x4*)(F.p() + (size_t)(t0 + c) * PN + PC_K + h * 64 + d8), kv);
#pragma unroll
        for (int j = 0; j < 8; ++j) { const float cm = cum[c * 65 + d8 + j], cl = cum[63 * 65 + d8 + j];
            qi[j] = qv[j] * 0.125f * __expf(cm); ki[j] = kv[j] * __expf(-cm);
            KOT[(d8 + j) * 72 + c] = f2bf(kv[j] * __expf(cl - cm));
            if (c == 63) F.decay()[unit * 64 + d8 + j] = __expf(cl); }
        const u32x4 qp = pack8(qi), kp = pack8(ki);
        *(LAS u32x4*)(QIN + c * 72 + d8) = qp; *(LAS u32x4*)(KIN + c * 72 + d8) = kp;
        *(u32x4*)(F.qin() + (size_t)(t0 + c) * 256 + h * 64 + d8) = qp;
        const int e16 = (tid & 7) * 16;
#pragma unroll
        for (int hh = 0; hh < 2; ++hh) { const u32x4 vv = *(const u32x4*)(F.p() + (size_t)(t0 + c) * PN + PC_V + h * 128 + e16 + 8 * hh);
            const unsigned ww[4] = {vv.x, vv.y, vv.z, vv.w};
#pragma unroll
            for (int j = 0; j < 4; ++j) { VT[(e16 + 8 * hh + 2 * j) * 72 + c] = (bf16_t)(ww[j] & 0xffffu); VT[(e16 + 8 * hh + 2 * j + 1) * 72 + c] = (bf16_t)(ww[j] >> 16); } }
    }
    __syncthreads();
    {
        const int mt = w >> 1;
        bf16x8 a[2];
#pragma unroll
        for (int ks = 0; ks < 2; ++ks) a[ks] = *(const LAS bf16x8*)(QIN + (16 * mt + fr) * 72 + 32 * ks + 8 * fq);
#pragma unroll
        for (int q = 0; q < 2; ++q) { const int nt = (w & 1) * 2 + q; f32x4 s = {0.f, 0.f, 0.f, 0.f};
#pragma unroll
            for (int ks = 0; ks < 2; ++ks) s = mma16(a[ks], *(const LAS bf16x8*)(KIN + (16 * nt + fr) * 72 + 32 * ks + 8 * fq), s);
#pragma unroll
            for (int r = 0; r < 4; ++r) { const int cc = 16 * mt + 4 * fq + r, ss = 16 * nt + fr; ATT[cc * 72 + ss] = f2bf(ss <= cc ? s[r] : 0.f); } }
    }
    __syncthreads();
    {
        const int mt = w >> 1, nt0 = (w & 1) * 4;
        bf16x8 aa[2], ak[2];
#pragma unroll
        for (int ks = 0; ks < 2; ++ks) { aa[ks] = *(const LAS bf16x8*)(ATT + (16 * mt + fr) * 72 + 32 * ks + 8 * fq); ak[ks] = *(const LAS bf16x8*)(KOT + (16 * mt + fr) * 72 + 32 * ks + 8 * fq); }
#pragma unroll
        for (int q = 0; q < 4; ++q) { const int nt = nt0 + q; f32x4 o = {0.f, 0.f, 0.f, 0.f}, kvv = {0.f, 0.f, 0.f, 0.f};
#pragma unroll
            for (int ks = 0; ks < 2; ++ks) { const bf16x8 bv = *(const LAS bf16x8*)(VT + (16 * nt + fr) * 72 + 32 * ks + 8 * fq); o = mma16(bv, aa[ks], o); kvv = mma16(ak[ks], bv, kvv); }
            *(u32x2*)(F.ointra() + (size_t)(t0 + 16 * mt + fr) * 512 + h * 128 + 16 * nt + 4 * fq) = (u32x2){cvt_pk_bf16(o[0], o[1]), cvt_pk_bf16(o[2], o[3])};
            *(u32x2*)(F.kvT() + ((size_t)unit * 128 + 16 * nt + fr) * 64 + 16 * mt + 4 * fq) = (u32x2){cvt_pk_bf16(kvv[0], kvv[1]), cvt_pk_bf16(kvv[2], kvv[3])}; }
    }
    __syncthreads();
}

__device__ __forceinline__ void gla_sscan_item(Frame& F, int item) {
    const int lane = F.lane, idx = item * 64 + lane, d4 = idx & 15, e = (idx >> 4) & 127, bh = idx >> 11;
    const bf16_t* kvp = F.kvT() + ((size_t)(bh * 32) * 128 + e) * 64 + d4 * 4; const float* dcp = F.decay() + (size_t)(bh * 32) * 64 + d4 * 4;
    bf16_t* sp = F.spT() + ((size_t)(bh * 32) * 128 + e) * 64 + d4 * 4;
    f32x4 S = {0.f, 0.f, 0.f, 0.f};
    for (int n0 = 0; n0 < 32; n0 += 8) { f32x4 kv[8], dc[8];
#pragma unroll
        for (int i = 0; i < 8; ++i) { const u32x2 kw = *(const u32x2*)(kvp + (size_t)(n0 + i) * 128 * 64); kv[i] = (f32x4){bflo(kw.x), bfhi(kw.x), bflo(kw.y), bfhi(kw.y)}; dc[i] = *(const f32x4*)(dcp + (size_t)(n0 + i) * 64); }
#pragma unroll
        for (int i = 0; i < 8; ++i) { u32x2 o; o.x = cvt_pk_bf16(S.x, S.y); o.y = cvt_pk_bf16(S.z, S.w); *(u32x2*)(sp + (size_t)(n0 + i) * 128 * 64) = o; S = dc[i] * S + kv[i]; } }
}
__device__ __forceinline__ void sgu_unit(Frame& F, int unit) {
    const int tid = F.tid, w = F.wave, lane = F.lane, fr = lane & 15, fq = lane >> 4, ch = unit >> 2, g = unit & 3, t0 = ch * 128;
    LAS f32x2* stat = (LAS f32x2*)F.lds; LAS bf16_t* vnT = (LAS bf16_t*)(F.lds + 1024);
    if (tid < 128) { const float* sp = (const float*)(F.A->ws + WS_SVS) + (size_t)(t0 + tid) * 16;
        const f32x4 a = *(const f32x4*)sp, b = *(const f32x4*)(sp + 4), c4 = *(const f32x4*)(sp + 8), d = *(const f32x4*)(sp + 12);
        const float s = (a.x + a.z) + (b.x + b.z) + (c4.x + c4.z) + (d.x + d.z), s2 = (a.y + a.w) + (b.y + b.w) + (c4.y + c4.w) + (d.y + d.w);
        const float mean = s * (1.f / 512.f), var = fmaxf(s2 * (1.f / 512.f) - mean * mean, 0.f);
        stat[tid] = (f32x2){mean, rsqrtf(var + EPS)}; }
    __syncthreads();
    { const int s = tid >> 2, c32 = (tid & 3) * 32; const f32x2 ms = stat[s];
#pragma unroll
        for (int q = 0; q < 4; ++q) { float v[8]; unpack8(*(const u32x4*)(F.p() + (size_t)(t0 + s) * PN + PC_SV + g * 128 + c32 + 8 * q), v);
#pragma unroll
            for (int j = 0; j < 8; ++j) { const int cidx = g * 128 + c32 + 8 * q + j; vnT[(c32 + 8 * q + j) * 136 + s] = f2bf((v[j] - ms.x) * ms.y * F.A->in[I_SNG][cidx] + F.A->in[I_SNB][cidx]); } } }
    __syncthreads();
    f32x4 acc[8];
#pragma unroll
    for (int ct = 0; ct < 8; ++ct) acc[ct] = (f32x4){0.f, 0.f, 0.f, 0.f};
    const int nks = (16 * w + 15) / 32 + 1;
    for (int ks = 0; ks < nks; ++ks) { const bf16x8 bw = *(const bf16x8*)(F.sguw() + (size_t)(g * 128 + 16 * w + fr) * 128 + 32 * ks + 8 * fq);
#pragma unroll
        for (int ct = 0; ct < 8; ++ct) acc[ct] = mma16(*(const LAS bf16x8*)(vnT + (16 * ct + fr) * 136 + 32 * ks + 8 * fq), bw, acc[ct]); }
    {
        const int t = 16 * w + fr; const float bias = F.A->in[I_SB][g * 128 + t];
        u32x2 uv[8];
#pragma unroll
        for (int ct = 0; ct < 8; ++ct) uv[ct] = *(const u32x2*)(F.p() + (size_t)(t0 + t) * PN + PC_U + g * 128 + 16 * ct + 4 * fq);
#pragma unroll
        for (int ct = 0; ct < 8; ++ct) { const int cidx = g * 128 + 16 * ct + 4 * fq; const u32x2 uu = uv[ct];
            u32x2 o; o.x = cvt_pk_bf16(bflo(uu.x) * (acc[ct][0] + bias), bfhi(uu.x) * (acc[ct][1] + bias)); o.y = cvt_pk_bf16(bflo(uu.y) * (acc[ct][2] + bias), bfhi(uu.y) * (acc[ct][3] + bias));
            *(u32x2*)(F.oab() + (size_t)(t0 + t) * D + 512 + cidx) = o; } }
    __syncthreads();
}
__device__ __forceinline__ void gla_out_item(Frame& F, int item) {
    const int lane = F.lane, fr = lane & 15, fq = lane >> 4, unit = item >> 2, mt = item & 3;
    const int bh = unit >> 5, n = unit & 31, b = bh >> 2, h = bh & 3; const size_t t = (size_t)b * SEQ + n * 64 + 16 * mt + fr;
    bf16x8 qf[2];
#pragma unroll
    for (int ks = 0; ks < 2; ++ks) qf[ks] = *(const bf16x8*)(F.qin() + t * 256 + h * 64 + 32 * ks + 8 * fq);
    const bf16_t* sp = F.spT() + (size_t)unit * 128 * 64;
    f32x4 o[8]; float ss = 0.f;
#pragma unroll
    for (int et = 0; et < 8; ++et) { const u32x2 ow = *(const u32x2*)(F.ointra() + t * 512 + h * 128 + 16 * et + 4 * fq); f32x4 acc = {bflo(ow.x), bfhi(ow.x), bflo(ow.y), bfhi(ow.y)};
#pragma unroll
        for (int ks = 0; ks < 2; ++ks) acc = mma16(*(const bf16x8*)(sp + (size_t)(16 * et + fr) * 64 + 32 * ks + 8 * fq), qf[ks], acc);
        o[et] = acc; ss += (acc[0] * acc[0] + acc[1] * acc[1]) + (acc[2] * acc[2] + acc[3] * acc[3]); }
    ss += __shfl_xor(ss, 16); ss += __shfl_xor(ss, 32);
    const float rstd = rsqrtf(ss * (1.f / 128.f) + EPS);
    f32x4 gv[8]; u32x2 rv[8];
#pragma unroll
    for (int et = 0; et < 8; ++et) { const int e = h * 128 + 16 * et + 4 * fq; gv[et] = *(const f32x4*)(F.A->in[I_GOUTG] + e); rv[et] = *(const u32x2*)(F.p() + t * PN + PC_R + e); }
#pragma unroll
    for (int et = 0; et < 8; ++et) { const int e = h * 128 + 16 * et + 4 * fq; const f32x4 g = gv[et];
        const u32x2 rr = rv[et]; const float r0 = bflo(rr.x), r1 = bfhi(rr.x), r2 = bflo(rr.y), r3 = bfhi(rr.y);
        u32x2 ov; ov.x = cvt_pk_bf16(o[et][0] * rstd * g.x * r0 * sigmoidf_(r0), o[et][1] * rstd * g.y * r1 * sigmoidf_(r1));
        ov.y = cvt_pk_bf16(o[et][2] * rstd * g.z * r2 * sigmoidf_(r2), o[et][3] * rstd * g.w * r3 * sigmoidf_(r3));
        *(u32x2*)(F.oab() + t * D + e) = ov; }
}

struct ProbSeg {
    static constexpr bool GATHER = false, FP8 = false; static constexpr int WSCALE = FP8_WSCALE;
    int K, lda, ldb, G, c; const bf16_t *oab, *Wpab_t;
    __device__ __forceinline__ bool next(int i, Unit& u) const { const int L = (i >> 1) * G + c; if (L >= 256) return false; pg8::map_tile(L, 64, 4, u.pm, u.pn); u.aux = i & 1; return true; }
    __device__ __forceinline__ const char* a_base(const Unit& u) const { return (const char*)(oab + (size_t)u.pm * 256 * D + u.aux * 512); }
    __device__ __forceinline__ const char* b_base(const Unit& u) const { return (const char*)(Wpab_t + (size_t)u.pn * 256 * D + u.aux * 512); }
    __device__ __forceinline__ unsigned a_off(const Unit&, int row, int C) const { return (unsigned)(row * D + C) * 2u; }
};
struct EpiMix {
    static constexpr bool MID = false;
    const bf16_t* p; bf16_t* mix;
    __device__ __forceinline__ void operator()(const f32x4 (&acc)[2][2][4][2], const Unit& u, int wr, int wc, int fr, int fq) const {
        asm volatile("" : "+v"(fr), "+v"(fq));
        const int row0 = u.pm * 256 + wr * 64 + fr, col0 = u.pn * 256 + wc * 32 + 8 * fq, gc = u.aux ? PC_GB : PC_GA;
#pragma unroll
        for (int ai = 0; ai < 2; ++ai) {
            u32x4 gw[4][2], pw[4][2];
#pragma unroll
            for (int m = 0; m < 4; ++m)
#pragma unroll
                for (int bj = 0; bj < 2; ++bj) { const size_t row = (size_t)(row0 + ai * 128 + m * 16);
                    gw[m][bj] = *(const u32x4*)(p + row * PN + gc + col0 + bj * 128);
                    pw[m][bj] = u.aux ? *(const u32x4*)(mix + row * D + col0 + bj * 128) : (u32x4){0u, 0u, 0u, 0u}; }
#pragma unroll
            for (int m = 0; m < 4; ++m)
#pragma unroll
                for (int bj = 0; bj < 2; ++bj) { const size_t row = (size_t)(row0 + ai * 128 + m * 16); float g[8], pv[8], v[8]; unpack8(gw[m][bj], g); unpack8(pw[m][bj], pv);
#pragma unroll
                    for (int j = 0; j < 4; ++j) { v[j] = acc[ai][bj][m][0][j] * g[j] + pv[j]; v[4 + j] = acc[ai][bj][m][1][j] * g[4 + j] + pv[4 + j]; }
                    *(u32x4*)(mix + row * D + col0 + bj * 128) = pack8(v); } }
    }
};

struct EpiMix2 {
    static constexpr bool MID = true;
    const bf16_t* p; bf16_t* mix;
    __device__ __forceinline__ void mid(f32x4 (&acc)[2][2][4][2], const Unit& u, int wr, int wc, int fr, int fq) const {
        asm volatile("" : "+v"(fr), "+v"(fq));
        const int row0 = u.pm * 256 + wr * 64 + fr, col0 = u.pn * 256 + wc * 32 + 8 * fq;
#pragma unroll
        for (int ai = 0; ai < 2; ++ai) { u32x4 ga[4][2], gb[4][2];
#pragma unroll
            for (int m = 0; m < 4; ++m)
#pragma unroll
                for (int bj = 0; bj < 2; ++bj) { const size_t row = (size_t)(row0 + ai * 128 + m * 16); ga[m][bj] = *(const u32x4*)(p + row * PN + PC_GA + col0 + bj * 128); gb[m][bj] = *(const u32x4*)(p + row * PN + PC_GB + col0 + bj * 128); }
#pragma unroll
            for (int m = 0; m < 4; ++m)
#pragma unroll
                for (int bj = 0; bj < 2; ++bj) { float a[8], b[8]; unpack8(ga[m][bj], a); unpack8(gb[m][bj], b);
#pragma unroll
                    for (int j = 0; j < 4; ++j) { acc[ai][bj][m][0][j] *= a[j] * __builtin_amdgcn_rcpf(fmaxf(b[j], 1e-20f)); acc[ai][bj][m][1][j] *= a[4 + j] * __builtin_amdgcn_rcpf(fmaxf(b[4 + j], 1e-20f)); } } }
    }
    __device__ __forceinline__ void operator()(const f32x4 (&acc)[2][2][4][2], const Unit& u, int wr, int wc, int fr, int fq) const {
        asm volatile("" : "+v"(fr), "+v"(fq));
        const int row0 = u.pm * 256 + wr * 64 + fr, col0 = u.pn * 256 + wc * 32 + 8 * fq;
#pragma unroll
        for (int ai = 0; ai < 2; ++ai) { u32x4 gb[4][2];
#pragma unroll
            for (int m = 0; m < 4; ++m)
#pragma unroll
                for (int bj = 0; bj < 2; ++bj) gb[m][bj] = *(const u32x4*)(p + (size_t)(row0 + ai * 128 + m * 16) * PN + PC_GB + col0 + bj * 128);
#pragma unroll
            for (int m = 0; m < 4; ++m)
#pragma unroll
                for (int bj = 0; bj < 2; ++bj) { float b[8], v[8]; unpack8(gb[m][bj], b);
#pragma unroll
                    for (int j = 0; j < 4; ++j) { v[j] = acc[ai][bj][m][0][j] * fmaxf(b[j], 1e-20f); v[4 + j] = acc[ai][bj][m][1][j] * fmaxf(b[4 + j], 1e-20f); }
                    *(u32x4*)(mix + (size_t)(row0 + ai * 128 + m * 16) * D + col0 + bj * 128) = pack8(v); } }
    }
};

template <bool Q8 = false, int WS_ = FP8_WSCALE> struct ProbStdT {
    static constexpr bool GATHER = false, FP8 = Q8; static constexpr int WSCALE = WS_, EB = Q8 ? 1 : 2;
    int K, lda, ldb, G, c; const void *A, *Bt;
    __device__ __forceinline__ bool next(int i, Unit& u) const { const int L = i * G + c; if (L >= 256) return false; pg8::map_tile(L, 64, 4, u.pm, u.pn); u.aux = 0; return true; }
    __device__ __forceinline__ const char* a_base(const Unit& u) const { return (const char*)A + (size_t)u.pm * 256 * D * EB; }
    __device__ __forceinline__ const char* b_base(const Unit& u) const { return (const char*)Bt + (size_t)u.pn * 256 * D * EB; }
    __device__ __forceinline__ unsigned a_off(const Unit&, int row, int C) const { return (unsigned)(row * D * EB + C * 2); }
};
typedef ProbStdT<false> ProbStd;
template <bool RESF32> struct EpiRes {
    static constexpr bool MID = false;
    const void* res; bf16_t* outb; float* ssq; unsigned char* outq; const float* qgain;
    __device__ __forceinline__ void operator()(const f32x4 (&acc)[2][2][4][2], const Unit& u, int wr, int wc, int fr, int fq) const {
        asm volatile("" : "+v"(fr), "+v"(fq));
        const int row0 = u.pm * 256 + wr * 64 + fr, col0 = u.pn * 256 + wc * 32 + 8 * fq;
#pragma unroll
        for (int ai = 0; ai < 2; ++ai) {
            f32x4 rf[4][2][2]; u32x4 rb[4][2];
#pragma unroll
            for (int m = 0; m < 4; ++m)
#pragma unroll
                for (int bj = 0; bj < 2; ++bj) { const size_t off = (size_t)(row0 + ai * 128 + m * 16) * D + col0 + bj * 128;
                    if (RESF32) { rf[m][bj][0] = *(const f32x4*)((const float*)res + off); rf[m][bj][1] = *(const f32x4*)((const float*)res + off + 4); }
                    else rb[m][bj] = *(const u32x4*)((const bf16_t*)res + off); }
#pragma unroll
            for (int m = 0; m < 4; ++m) { const size_t row = (size_t)(row0 + ai * 128 + m * 16); float sq = 0.f;
#pragma unroll
                for (int bj = 0; bj < 2; ++bj) { float r[8], v[8];
                    if (RESF32) { r[0] = rf[m][bj][0].x; r[1] = rf[m][bj][0].y; r[2] = rf[m][bj][0].z; r[3] = rf[m][bj][0].w; r[4] = rf[m][bj][1].x; r[5] = rf[m][bj][1].y; r[6] = rf[m][bj][1].z; r[7] = rf[m][bj][1].w; }
                    else unpack8(rb[m][bj], r);
#pragma unroll
                    for (int j = 0; j < 4; ++j) { v[j] = acc[ai][bj][m][0][j] + r[j]; v[4 + j] = acc[ai][bj][m][1][j] + r[4 + j]; }
#pragma unroll
                    for (int j = 0; j < 8; ++j) sq += v[j] * v[j];
                    *(u32x4*)(outb + row * D + col0 + bj * 128) = pack8(v);
                    if (outq) *(u32x2*)(outq + row * D + col0 + bj * 128) = pack8_fp8(v); }
                sq += __shfl_xor(sq, 16); sq += __shfl_xor(sq, 32);
                if (fq == 0) ssq[row * 16 + u.pn * 4 + wc] = sq; } }
    }
};
__device__ __forceinline__ float row_rs(const float* ssq, size_t row) {
    const f32x4 a = *(const f32x4*)(ssq + row * 16), b = *(const f32x4*)(ssq + row * 16 + 4), c = *(const f32x4*)(ssq + row * 16 + 8), d = *(const f32x4*)(ssq + row * 16 + 12);
    const float s = ((a.x + a.y) + (a.z + a.w)) + ((b.x + b.y) + (b.z + b.w)) + ((c.x + c.y) + (c.z + c.w)) + ((d.x + d.y) + (d.z + d.w));
    return rsqrtf(s * (1.f / D) + EPS);
}
struct EpiScale {
    static constexpr bool MID = false;
    const float* ssq; bf16_t* outb;
    __device__ __forceinline__ void operator()(const f32x4 (&acc)[2][2][4][2], const Unit& u, int wr, int wc, int fr, int fq) const {
        asm volatile("" : "+v"(fr), "+v"(fq));
        const int row0 = u.pm * 256 + wr * 64 + fr, col0 = u.pn * 256 + wc * 32 + 8 * fq;
        float rs[2][4];
#pragma unroll
        for (int ai = 0; ai < 2; ++ai)
#pragma unroll
            for (int m = 0; m < 4; ++m) rs[ai][m] = row_rs(ssq, (size_t)(row0 + ai * 128 + m * 16));
#pragma unroll
        for (int ai = 0; ai < 2; ++ai)
#pragma unroll
            for (int m = 0; m < 4; ++m) { const size_t row = (size_t)(row0 + ai * 128 + m * 16);
#pragma unroll
                for (int bj = 0; bj < 2; ++bj) { float v[8];
#pragma unroll
                    for (int j = 0; j < 4; ++j) { v[j] = acc[ai][bj][m][0][j] * rs[ai][m]; v[4 + j] = acc[ai][bj][m][1][j] * rs[ai][m]; }
                    *(u32x4*)(outb + row * D + col0 + bj * 128) = pack8(v); } }
    }
};

__device__ __forceinline__ void attn_unit(Frame& F, int unit) {
    const int tid = F.tid, w = F.wave, lane = F.lane, fr = lane & 15, fq = lane >> 4;
    const int b = unit >> 5, h = (unit >> 3) & 3, qb = unit & 7;
    const size_t tq = (size_t)b * SEQ + qb * 256 + 32 * w;
    LAS unsigned char* const bufs[2] = {F.lds, F.lds + 36864};
    const bf16_t* kg = F.kmem() + (size_t)(b * 256 + (tid >> 1)) * D + h * 256 + (tid & 1) * 32;
    const int kls = (tid >> 1) * 144 + (tid & 1) * 64;
    const bf16_t* vg = F.vt() + (size_t)(h * 256 + (tid >> 3)) * TM + b * 256 + (tid & 7) * 32;
    const int vls = (tid >> 3) * 528 + (tid & 7) * 64;
    u32x4 st[4];
#pragma unroll
    for (int i = 0; i < 4; ++i) st[i] = *(const u32x4*)(kg + 8 * i);
#pragma unroll
    for (int i = 0; i < 4; ++i) *(LAS u32x4*)(bufs[0] + kls + 16 * i) = st[i];
    __syncthreads();
    f32x4 s[16][2];
#pragma unroll
    for (int nt = 0; nt < 16; ++nt) { s[nt][0] = (f32x4){0.f, 0.f, 0.f, 0.f}; s[nt][1] = (f32x4){0.f, 0.f, 0.f, 0.f}; }
#pragma unroll
    for (int c = 0; c < 4; ++c) {
        if (c < 3) {
#pragma unroll
            for (int i = 0; i < 4; ++i) st[i] = *(const u32x4*)(kg + 64 * (c + 1) + 8 * i); }
        else {
#pragma unroll
            for (int i = 0; i < 4; ++i) st[i] = *(const u32x4*)(vg + 8 * i); }
        LAS unsigned char* kb = bufs[c & 1];
        bf16x8 qf[2][2];
#pragma unroll
        for (int qt = 0; qt < 2; ++qt)
#pragma unroll
            for (int ks = 0; ks < 2; ++ks) qf[qt][ks] = *(const bf16x8*)(F.q() + (tq + 16 * qt + fr) * D + h * 256 + 64 * c + 32 * ks + 8 * fq);
#pragma unroll
        for (int nt = 0; nt < 16; ++nt)
#pragma unroll
            for (int ks = 0; ks < 2; ++ks) { const bf16x8 a = *(const LAS bf16x8*)(kb + (16 * nt + fr) * 144 + (32 * ks + 8 * fq) * 2);
                s[nt][0] = mma16(a, qf[0][ks], s[nt][0]); s[nt][1] = mma16(a, qf[1][ks], s[nt][1]); }
        if (c < 3) {
#pragma unroll
            for (int i = 0; i < 4; ++i) *(LAS u32x4*)(bufs[(c + 1) & 1] + kls + 16 * i) = st[i]; }
        __syncthreads();
    }
#pragma unroll
    for (int i = 0; i < 4; ++i) *(LAS u32x4*)(bufs[0] + vls + 16 * i) = st[i];
    float inv[2]; bf16x8 pb[2][8];
#pragma unroll
    for (int qt = 0; qt < 2; ++qt) { float mx = s[0][qt][0];
#pragma unroll
        for (int nt = 0; nt < 16; ++nt)
#pragma unroll
            for (int r = 0; r < 4; ++r) mx = fmaxf(mx, s[nt][qt][r]);
        mx = fmaxf(mx, __shfl_xor(mx, 16)); mx = fmaxf(mx, __shfl_xor(mx, 32));
        float sum = 0.f;
#pragma unroll
        for (int nt = 0; nt < 16; ++nt)
#pragma unroll
            for (int r = 0; r < 4; ++r) { const float e = __expf(s[nt][qt][r] - mx); s[nt][qt][r] = e; sum += e; }
        sum += __shfl_xor(sum, 16); sum += __shfl_xor(sum, 32);
        inv[qt] = __builtin_amdgcn_rcpf(sum);
#pragma unroll
        for (int sk = 0; sk < 8; ++sk) { const float pv[8] = {s[2 * sk][qt][0], s[2 * sk][qt][1], s[2 * sk][qt][2], s[2 * sk][qt][3], s[2 * sk + 1][qt][0], s[2 * sk + 1][qt][1], s[2 * sk + 1][qt][2], s[2 * sk + 1][qt][3]};
            const u32x4 pk = pack8(pv); pb[qt][sk] = __builtin_bit_cast(bf16x8, pk); } }
    __syncthreads();
#pragma unroll
    for (int c = 0; c < 4; ++c) {
        if (c < 3) {
#pragma unroll
            for (int i = 0; i < 4; ++i) st[i] = *(const u32x4*)(vg + (size_t)64 * (c + 1) * TM + 8 * i); }
        LAS unsigned char* vb = bufs[c & 1];
#pragma unroll
        for (int dt = 0; dt < 4; ++dt) { f32x4 o0 = {0.f, 0.f, 0.f, 0.f}, o1 = {0.f, 0.f, 0.f, 0.f};
#pragma unroll
            for (int sk = 0; sk < 8; ++sk) { const LAS unsigned char* vp = vb + (16 * dt + fr) * 528 + (32 * sk + 4 * fq) * 2;
                const u32x2 lo = *(const LAS u32x2*)vp, hi = *(const LAS u32x2*)(vp + 32);
                const u32x4 av = {lo.x, lo.y, hi.x, hi.y}; const bf16x8 a = __builtin_bit_cast(bf16x8, av);
                o0 = mma16(a, pb[0][sk], o0); o1 = mma16(a, pb[1][sk], o1); }
            const int col = h * 256 + 64 * c + 16 * dt + 4 * fq;
            int w0 = 0, w1 = 0;
            w0 = __builtin_amdgcn_cvt_pk_fp8_f32(o0[0] * inv[0], o0[1] * inv[0], w0, false); w0 = __builtin_amdgcn_cvt_pk_fp8_f32(o0[2] * inv[0], o0[3] * inv[0], w0, true);
            w1 = __builtin_amdgcn_cvt_pk_fp8_f32(o1[0] * inv[1], o1[1] * inv[1], w1, false); w1 = __builtin_amdgcn_cvt_pk_fp8_f32(o1[2] * inv[1], o1[3] * inv[1], w1, true);
            *(int*)((unsigned char*)F.ao() + (tq + fr) * D + col) = w0; *(int*)((unsigned char*)F.ao() + (tq + 16 + fr) * D + col) = w1; }
        if (c < 3) {
#pragma unroll
            for (int i = 0; i < 4; ++i) *(LAS u32x4*)(bufs[(c + 1) & 1] + vls + 16 * i) = st[i]; }
        __syncthreads();
    }
}

__device__ __forceinline__ void router_item(Frame& F, int item) {
    const int w = F.wave, lane = F.lane, fr = lane & 15, fq = lane >> 4;
    const size_t t0 = (size_t)item * 16;
    LAS float* lg = (LAS float*)(F.lds + ROUTER_OFF) + w * (16 * 33 + 64);
    LAS int* ex = (LAS int*)(lg + 16 * 33);
    f32x4 acc[2] = {{0.f, 0.f, 0.f, 0.f}, {0.f, 0.f, 0.f, 0.f}};
    const float rsl = row_rs(F.ssq2(), t0 + fr);
    for (int k0 = 0; k0 < 32; k0 += 8) { bf16x8 a[8], b0[8], b1[8];
#pragma unroll
        for (int i = 0; i < 8; ++i) { a[i] = *(const bf16x8*)(F.x2b() + (t0 + fr) * D + 32 * (k0 + i) + 8 * fq);
            b0[i] = *(const bf16x8*)(F.Wr_t() + (size_t)fr * D + 32 * (k0 + i) + 8 * fq); b1[i] = *(const bf16x8*)(F.Wr_t() + (size_t)(16 + fr) * D + 32 * (k0 + i) + 8 * fq); }
#pragma unroll
        for (int i = 0; i < 8; ++i) { acc[0] = mma16(a[i], b0[i], acc[0]); acc[1] = mma16(a[i], b1[i], acc[1]);
            const int col = 32 * (k0 + i) + 8 * fq; const f32x4 g0 = *(const f32x4*)(F.A->in[I_NFFNG] + col), g1 = *(const f32x4*)(F.A->in[I_NFFNG] + col + 4);
            float xv[8]; unpack8(__builtin_bit_cast(u32x4, a[i]), xv);
            xv[0] *= rsl * g0.x; xv[1] *= rsl * g0.y; xv[2] *= rsl * g0.z; xv[3] *= rsl * g0.w; xv[4] *= rsl * g1.x; xv[5] *= rsl * g1.y; xv[6] *= rsl * g1.z; xv[7] *= rsl * g1.w;
            *(u32x2*)(F.x2q() + (t0 + fr) * D + col) = pack8_fp8(xv); } }
#pragma unroll
    for (int r = 0; r < 4; ++r)
#pragma unroll
        for (int nt = 0; nt < 2; ++nt) lg[(4 * fq + r) * 33 + 16 * nt + fr] = acc[nt][r];
    LDS_WAIT();
    float rs = 0.f, gk[4] = {0.f, 0.f, 0.f, 0.f};
    if (lane < 16) { const size_t t = t0 + lane; rs = row_rs(F.ssq2(), t);
        float v[32];
#pragma unroll
        for (int e = 0; e < 32; ++e) v[e] = lg[lane * 33 + e] * rs + F.A->in[I_BR][e];
        unsigned taken = 0u; float tv[4];
#pragma unroll
        for (int k = 0; k < 4; ++k) { float best = -INFINITY; int bi = 0;
#pragma unroll
            for (int e = 0; e < 32; ++e) { const bool ok = !((taken >> e) & 1u) && (v[e] > best); best = ok ? v[e] : best; bi = ok ? e : bi; }
            taken |= 1u << bi; tv[k] = best; ex[lane * 4 + k] = bi; }
        float sum = 0.f;
#pragma unroll
        for (int k = 0; k < 4; ++k) { gk[k] = __expf(tv[k] - tv[0]); sum += gk[k]; }
        const float inv = 1.f / sum;
        *(f32x4*)(F.gates() + t * 4) = (f32x4){gk[0] * inv, gk[1] * inv, gk[2] * inv, gk[3] * inv}; }
    LDS_WAIT();
    const int me = ex[lane]; const float my_rs = __shfl(rs, lane >> 2);
    int rank = 0, mytot = 0;
#pragma unroll
    for (int e = 0; e < 32; ++e) { const unsigned long long m = __ballot(me == e); const int below = __builtin_popcountll(m & ((1ull << lane) - 1ull));
        rank = (me == e) ? below : rank; mytot = (lane == e) ? __builtin_popcountll(m) : mytot; }
    unsigned base = 0u;
    if (lane < 32 && mytot > 0) base = atomicAdd(F.ctl + CW_CNT + lane, (unsigned)mytot);
    const unsigned slot = (unsigned)__shfl((int)base, me) + (unsigned)rank;
    F.list()[me * ECAP + slot] = (int)(t0 * 4 + lane); (void)my_rs;
    LDS_WAIT();
}

__device__ __forceinline__ void expert_tables(Frame& F) {
    LAS int* tab = (LAS int*)(F.lds + TAB_OFF);
    if (F.tid < 32) tab[F.tid] = (int)__hip_atomic_load(F.ctl + CW_CNT + F.tid, __ATOMIC_RELAXED, __HIP_MEMORY_SCOPE_AGENT);
    __syncthreads();
    if (F.tid == 0) { int s = 0; for (int e = 0; e < 32; ++e) { tab[32 + e] = s; s += (tab[e] + 255) >> 8; } tab[64] = s; }
    __syncthreads();
}
template <int NTN, bool GATH> struct ProbExp {
    static constexpr bool GATHER = GATH, gather = GATH, FP8 = true; static constexpr int WSCALE = FP8_WSCALE;
    int K, lda, ldb, G, c; const LAS int* tab; const unsigned char* A; const unsigned char* Bt; const int* list; mutable int ehint;
    __device__ __forceinline__ bool next(int i, Unit& u) const {
        const int L = i * G + c; if (L >= NTN * tab[64]) return false;
        int e = ehint;
#pragma unroll 1
        while (e < 31 && L >= NTN * tab[32 + e + 1]) ++e;
        ehint = e;
        const int r = L - NTN * tab[32 + e], mte = tab[32 + e + 1] - tab[32 + e];
        u.aux = e; u.pn = r / mte; u.pm = r % mte; return true;
    }
    __device__ __forceinline__ const char* a_base(const Unit& u) const { return gather ? (const char*)A : (const char*)(A + (size_t)(tab[32 + u.aux] + u.pm) * 256 * D); }
    __device__ __forceinline__ const char* b_base(const Unit& u) const { return (const char*)(Bt + ((size_t)u.aux * NTN + u.pn) * 256 * D); }
    __device__ __forceinline__ unsigned a_off(const Unit& u, int row, int C) const {
        if (!gather) return (unsigned)(row * D + C * 2);
        const int slot = u.pm * 256 + row; const int av = list[u.aux * ECAP + slot];
        const int a = slot < tab[u.aux] ? av : 0;
        return (unsigned)((a >> 2) * D + C * 2);
    }
};
struct EpiE1 {
    static constexpr bool MID = false;
    const LAS int* tab; const float* lscale; const float* b1; unsigned char* act;
    __device__ __forceinline__ void operator()(const f32x4 (&acc)[2][2][4][2], const Unit& u, int wr, int wc, int fr, int fq) const {
        asm volatile("" : "+v"(fr), "+v"(fq));
        const int e = u.aux; const size_t rbase = (size_t)(tab[32 + e] + u.pm) * 256;
        const int j0 = u.pn * 128 + wc * 32 + 8 * fq;
        const float* bp = b1 + (size_t)e * 2048 + j0;
        const f32x4 bg0 = *(const f32x4*)bp, bg1 = *(const f32x4*)(bp + 4), bl0 = *(const f32x4*)(bp + 1024), bl1 = *(const f32x4*)(bp + 1028);
        const float bg[8] = {bg0.x, bg0.y, bg0.z, bg0.w, bg1.x, bg1.y, bg1.z, bg1.w}, bl[8] = {bl0.x, bl0.y, bl0.z, bl0.w, bl1.x, bl1.y, bl1.z, bl1.w};
#pragma unroll
        for (int ai = 0; ai < 2; ++ai)
#pragma unroll
            for (int m = 0; m < 4; ++m) { const int rt = ai * 128 + wr * 64 + m * 16 + fr; float v[8];
#pragma unroll
                for (int jp = 0; jp < 4; ++jp) {
                    const f32x2 ag = {acc[ai][0][m][jp >> 1][2 * (jp & 1)], acc[ai][0][m][jp >> 1][2 * (jp & 1) + 1]}, al = {acc[ai][1][m][jp >> 1][2 * (jp & 1)], acc[ai][1][m][jp >> 1][2 * (jp & 1) + 1]};
                    const f32x2 bg2 = {bg[2 * jp], bg[2 * jp + 1]}, bl2 = {bl[2 * jp], bl[2 * jp + 1]};
                    const f32x2 ga = ag + bg2, la = al + bl2;
                    const f32x2 glu = {fminf(ga.x, 7.0f), fminf(ga.y, 7.0f)}, lin = {fminf(fmaxf(la.x, -7.0f), 7.0f), fminf(fmaxf(la.y, -7.0f), 7.0f)};
                    const f32x2 t = glu * (-1.702f * 1.4426950408889634f);
                    const f32x2 d = (f32x2){__builtin_amdgcn_exp2f(t.x), __builtin_amdgcn_exp2f(t.y)} + 1.0f;
                    const f32x2 r = {__builtin_amdgcn_rcpf(d.x), __builtin_amdgcn_rcpf(d.y)};
                    const f32x2 o = ((lin + 1.0f) * glu) * r;
                    v[2 * jp] = o.x; v[2 * jp + 1] = o.y; }
                *(u32x2*)(act + (rbase + rt) * D + j0) = pack8_fp8(v); }
    }
};
struct EpiE2 {
    static constexpr bool MID = false;
    const LAS int* tab; const int* list; const float* b2; unsigned char* yb; unsigned char* dummy;
    __device__ __forceinline__ void operator()(const f32x4 (&acc)[2][2][4][2], const Unit& u, int wr, int wc, int fr, int fq) const {
        asm volatile("" : "+v"(fr), "+v"(fq));
        const int e = u.aux, cnt = tab[e]; const int col0 = u.pn * 256 + wc * 32 + 8 * fq;
        float bb[2][8];
#pragma unroll
        for (int bj = 0; bj < 2; ++bj) { const f32x4 x0 = *(const f32x4*)(b2 + (size_t)e * D + col0 + bj * 128), x1 = *(const f32x4*)(b2 + (size_t)e * D + col0 + bj * 128 + 4);
            bb[bj][0] = x0.x; bb[bj][1] = x0.y; bb[bj][2] = x0.z; bb[bj][3] = x0.w; bb[bj][4] = x1.x; bb[bj][5] = x1.y; bb[bj][6] = x1.z; bb[bj][7] = x1.w; }
        int aidx[2][4];
#pragma unroll
        for (int ai = 0; ai < 2; ++ai)
#pragma unroll
            for (int m = 0; m < 4; ++m) aidx[ai][m] = list[e * ECAP + u.pm * 256 + ai * 128 + wr * 64 + m * 16 + fr];
#pragma unroll
        for (int ai = 0; ai < 2; ++ai)
#pragma unroll
            for (int m = 0; m < 4; ++m) { const int slot = u.pm * 256 + ai * 128 + wr * 64 + m * 16 + fr;
                unsigned char* rowp = (slot < cnt) ? yb + (size_t)aidx[ai][m] * D : dummy;
#pragma unroll
                for (int bj = 0; bj < 2; ++bj) { float v[8];
#pragma unroll
                    for (int j = 0; j < 4; ++j) { v[j] = acc[ai][bj][m][0][j] + bb[bj][j]; v[4 + j] = acc[ai][bj][m][1][j] + bb[bj][4 + j]; }
                    *(u32x2*)(rowp + col0 + bj * 128) = pack8_fp8(v); } }
    }
};

struct CombTok { u32x4 x[2]; u32x2 y[2][4]; f32x4 g; };
__device__ __forceinline__ void comb_load(Frame& F, int t, int lane, CombTok& c) {
    c.g = *(const f32x4*)(F.gates() + (size_t)t * 4);
#pragma unroll
    for (int hf = 0; hf < 2; ++hf) { const int col = hf * 512 + lane * 8; c.x[hf] = *(const u32x4*)(F.x2b() + (size_t)t * D + col);
#pragma unroll
        for (int k = 0; k < 4; ++k) c.y[hf][k] = *(const u32x2*)((const unsigned char*)F.yb() + ((size_t)t * 4 + k) * D + col); }
}
__device__ __forceinline__ void comb_finish(Frame& F, int t, int lane, const CombTok& c) {
    const float gk[4] = {c.g.x, c.g.y, c.g.z, c.g.w}; float x[2][8]; float ss = 0.f;
#pragma unroll
    for (int hf = 0; hf < 2; ++hf) { unpack8(c.x[hf], x[hf]);
#pragma unroll
        for (int k = 0; k < 4; ++k) { float y[8]; unpack8_fp8(c.y[hf][k], y);
#pragma unroll
            for (int j = 0; j < 8; ++j) x[hf][j] += gk[k] * y[j]; }
#pragma unroll
        for (int j = 0; j < 8; ++j) ss += x[hf][j] * x[hf][j]; }
    const float rs = rsqrtf(wave_sum(ss) * (1.f / D) + EPS);
#pragma unroll
    for (int hf = 0; hf < 2; ++hf) { const int col = hf * 512 + lane * 8; const f32x4 g0 = *(const f32x4*)(F.A->in[I_NFING] + col), g1 = *(const f32x4*)(F.A->in[I_NFING] + col + 4);
        *(f32x4*)(F.A->out + (size_t)t * D + col) = (f32x4){x[hf][0] * rs * g0.x, x[hf][1] * rs * g0.y, x[hf][2] * rs * g0.z, x[hf][3] * rs * g0.w};
        *(f32x4*)(F.A->out + (size_t)t * D + col + 4) = (f32x4){x[hf][4] * rs * g1.x, x[hf][5] * rs * g1.y, x[hf][6] * rs * g1.z, x[hf][7] * rs * g1.w}; }
}
__device__ __forceinline__ void combine_rows(Frame& F) {
    const int gw = F.vcu * 8 + F.wave, NGW = F.G * 8, lane = F.lane;
    if (gw >= T) return;
    CombTok ca, cb; comb_load(F, gw, lane, ca);
    for (int t = gw;;) {
        const bool hb = t + NGW < T; if (hb) comb_load(F, t + NGW, lane, cb);
        comb_finish(F, t, lane, ca); if (!hb) break;
        const bool ha = t + 2 * NGW < T; if (ha) comb_load(F, t + 2 * NGW, lane, ca);
        comb_finish(F, t + NGW, lane, cb); if (!ha) break;
        t += 2 * NGW; }
}

#ifndef DBG_OUT
#define DBG_OUT 0
#endif
#if DBG_OUT
__device__ __forceinline__ void dbg_rows(Frame& F) {
    const int gw = F.vcu * 8 + F.wave, NGW = F.G * 8, lane = F.lane;
    for (int t = gw; t < T; t += NGW) {
#pragma unroll
        for (int hf = 0; hf < 2; ++hf) { const int col = hf * 512 + lane * 8; float x[8];
#pragma unroll
            for (int j = 0; j < 8; ++j) x[j] = 0.f;
            if (DBG_OUT == 1) { for (int m = 0; m < 5; ++m) { if (col + 1024 * m < PN) { float y[8]; unpack8(*(const u32x4*)(F.p() + (size_t)t * PN + col + 1024 * m), y);
#pragma unroll
                for (int j = 0; j < 8; ++j) x[j] += y[j]; } } }
            else if (DBG_OUT == 8) { for (int k = 0; k < 4; ++k) { float y[8]; unpack8_fp8(*(const u32x2*)((const unsigned char*)F.yb() + ((size_t)t * 4 + k) * D + col), y); const float g = F.gates()[t * 4 + k];
#pragma unroll
                for (int j = 0; j < 8; ++j) x[j] += g * y[j]; } }
            else { const bf16_t* B = DBG_OUT == 2 ? F.oab() : DBG_OUT == 3 ? F.mix() : DBG_OUT == 4 ? F.x1b() : DBG_OUT == 5 ? F.q() : DBG_OUT == 6 ? F.ao() : F.x2b();
                unpack8(*(const u32x4*)(B + (size_t)t * D + col), x); }
#pragma unroll
            for (int j = 0; j < 8; ++j) if (!(fabsf(x[j]) < 1e30f)) x[j] = 1e6f;
            *(f32x4*)(F.A->out + (size_t)t * D + col) = (f32x4){x[0], x[1], x[2], x[3]};
            *(f32x4*)(F.A->out + (size_t)t * D + col + 4) = (f32x4){x[4], x[5], x[6], x[7]}; }
    }
}
#endif

__global__ void __launch_bounds__(512, 2) fwd_kernel(Args args) {
    extern __shared__ __attribute__((aligned(16))) unsigned char lds[];
    Frame F;
    F.lds = (LAS unsigned char*)lds; F.MISC = (volatile LAS unsigned*)(F.lds + MISC_OFF);
    F.tid = threadIdx.x; F.lane = F.tid & 63; F.wave = __builtin_amdgcn_readfirstlane(F.tid >> 6);
    F.G = gridDim.x; { const int bx = blockIdx.x; F.vcu = (F.G % 8 == 0) ? (bx % 8) * (F.G / 8) + bx / 8 : bx; }
    F.ctl = (unsigned*)(args.ws + WS_CTL);
    F.A = &args;
    for (int u = F.tid; u < 64; u += 512) ((LAS unsigned*)(F.lds + MISC_OFF))[u] = 0u;
    __syncthreads();
    XcdBarrier bar; bar.bar = F.ctl + CW_BAR; bar.x = 0; bar.st = nullptr;
    if (!MK_PER_PHASE) bar = xcd_barrier_post(F.ctl + CW_BAR, F.MISC + 8);
    const int lo = args.ph_lo, hi = args.ph_hi;
#ifndef PH_MASK
#define PH_MASK 0x3fff
#endif
#define IN(k) (((PH_MASK >> (k)) & 1) && lo <= (k) && (k) < hi)
#ifndef DOUBLE_MASK
#define DOUBLE_MASK 0
#endif
#define REP(k) for (int _rep = 0; _rep < ((((DOUBLE_MASK) >> (k)) & 1) ? 2 : 1); ++_rep, ((((DOUBLE_MASK) >> (k)) & 1) && _rep == 1 ? xcd_barrier(bar) : (void)0))
#define SEAM(k) do { if (IN(k) && IN((k) + 1)) xcd_barrier(bar); } while (0)
    const int c = (int)blockIdx.x;

    if (IN(0)) REP(0) { p0_prologue(F); } SEAM(0);
    if (IN(1)) REP(1) { ProbP1 P{D, D, ProbP1::EB * D, F.G, c, args.ws}; EpiP1 E{args.ws}; pg8::gemm_phase(F.lds, P, E); } SEAM(1);
    if (IN(2)) REP(2) { for (int u = F.vcu; u < 1024; u += F.G) gla_a_unit(F, u); } SEAM(2);
    if (IN(3)) REP(3) { cvt_range(F, CVT_LATE, CVT_EXPERT);
                        if (F.wave < 4) for (int it = F.vcu * 4 + F.wave; it < 1024; it += F.G * 4) gla_sscan_item(F, it);
                        for (int u = F.vcu; u < 512; u += F.G) sgu_unit(F, u); } SEAM(3);
    if (IN(4)) REP(4) { for (int it = F.vcu * 8 + F.wave; it < 4096; it += F.G * 8) gla_out_item(F, it); } SEAM(4);
    if (IN(5)) REP(5) { ProbStd P{D, D, 2 * D, F.G, c, F.oab(), F.Wpab_t()}; EpiMix2 E{F.p(), F.mix()}; pg8::gemm_phase(F.lds, P, E); } SEAM(5);
    if (IN(6)) REP(6) { ProbStd P{D, D, 2 * D, F.G, c, F.mix(), F.Wmo_t()}; EpiRes<true> E{(const void*)F.A->in[I_X], F.x1b(), F.ssq1(), F.x1q(), nullptr}; pg8::gemm_phase(F.lds, P, E); } SEAM(6);
    if (IN(7)) REP(7) { ProbStdT<true, 0x75757575> P{D, D, D, F.G, c, F.x1q(), F.Wq_t()}; EpiScale E{F.ssq1(), F.q()};     pg8::gemm_phase(F.lds, P, E); } SEAM(7);
    if (IN(8)) REP(8) { for (int u = F.vcu; u < 256; u += F.G) attn_unit(F, u); } SEAM(8);
    if (IN(9)) REP(9) { ProbStdT<true> P{D, D, D, F.G, c, F.ao(), F.Wo_t()}; EpiRes<false> E{(const void*)F.x1b(), F.x2b(), F.ssq2(), nullptr, nullptr}; pg8::gemm_phase(F.lds, P, E); } SEAM(9);
    if (IN(10)) REP(10) { for (int it = F.wave * F.G + F.vcu; it < 1024; it += 8 * F.G) router_item(F, it); cvt_expert_dma(F); } SEAM(10);
    if (IN(11)) REP(11) { expert_tables(F); const LAS int* tab = (const LAS int*)(F.lds + TAB_OFF);
        ProbExp<8, true> P{D, D, D, F.G, F.vcu, tab, F.x2q(), (const unsigned char*)F.W1_t(), F.list(), 0}; EpiE1 E{tab, F.lscale(), F.A->in[I_BE1], (unsigned char*)F.act()}; pg8::gemm_phase(F.lds, P, E); } SEAM(11);
    if (IN(12)) REP(12) { expert_tables(F); const LAS int* tab = (const LAS int*)(F.lds + TAB_OFF);
        ProbExp<4, false> P{D, D, D, F.G, F.vcu, tab, (const unsigned char*)F.act(), (const unsigned char*)F.W2_t(), F.list(), 0}; EpiE2 E{tab, F.list(), F.A->in[I_BE2], (unsigned char*)F.yb(), (unsigned char*)(args.ws + WS_CTL + 512 * 1024)}; pg8::gemm_phase(F.lds, P, E); } SEAM(12);
#if DBG_OUT
    if (lo <= 13 && 13 < hi) { dbg_rows(F); }
#else
    if (IN(13)) REP(13) { combine_rows(F); }
#endif
#undef IN
#undef SEAM
}

extern "C" void kernel_launch(void* const* d_in, const int* in_sizes, int n_in, void* d_out, int out_size, void* d_ws, size_t ws_size, hipStream_t stream) {
    static int grid = 0;
    if (grid == 0) {
        if (n_in != 28 || in_sizes[0] != T * D || out_size != T * D || ws_size < WS_END) { fprintf(stderr, "kernel_launch: unexpected problem (n_in %d, in0 %d, out %d, ws %zu); nothing launched\n", n_in, n_in > 0 ? in_sizes[0] : -1, out_size, ws_size); grid = -1; return; }
        int dev = 0, cus = 0, per_cu = 0;
        if (hipGetDevice(&dev) != hipSuccess || hipDeviceGetAttribute(&cus, hipDeviceAttributeMultiprocessorCount, dev) != hipSuccess) { grid = -1; return; }
        if (hipFuncSetAttribute((const void*)fwd_kernel, hipFuncAttributeMaxDynamicSharedMemorySize, LDS_BYTES) != hipSuccess) { fprintf(stderr, "kernel_launch: hipFuncSetAttribute failed\n"); grid = -1; return; }
        if (hipOccupancyMaxActiveBlocksPerMultiprocessor(&per_cu, (const void*)fwd_kernel, 512, LDS_BYTES) != hipSuccess || per_cu < 1) fprintf(stderr, "kernel_launch: occupancy query reports %d blocks per CU\n", per_cu);
        (void)hipGetLastError();
        grid = cus;
    }
    if (grid < 0) return;
    if (hipMemsetAsync((char*)d_ws + WS_CTL, 0, CTL_ZERO_BYTES, stream) != hipSuccess) { fprintf(stderr, "kernel_launch: memset failed\n"); return; }
    Args a{};
    for (int i = 0; i < 28; ++i) a.in[i] = (const float*)d_in[i];
    a.out = (float*)d_out; a.ws = (unsigned char*)d_ws;
#if MK_PER_PHASE
    for (int ph = 0; ph < NPHASE; ++ph) { a.ph_lo = ph; a.ph_hi = ph + 1; hipLaunchKernelGGL(fwd_kernel, dim3(grid), dim3(512), LDS_BYTES, stream, a); }
#else
    a.ph_lo = 0; a.ph_hi = NPHASE;
    hipLaunchKernelGGL(fwd_kernel, dim3(grid), dim3(512), LDS_BYTES, stream, a);
#endif
}
```

```cpp
#include <hip/hip_runtime.h>
#include <cstdio>
#include <cstdint>

#ifndef P1_FP8
#define P1_FP8 0
#endif
#ifndef MK_PER_PHASE
#define MK_PER_PHASE 0
#endif

#define LAS __attribute__((address_space(3)))
#define GAS __attribute__((address_space(1)))
typedef unsigned short bf16_t;
typedef short bf16x8 __attribute__((ext_vector_type(8)));
typedef float f32x4 __attribute__((ext_vector_type(4)));
typedef float f32x2 __attribute__((ext_vector_type(2)));
typedef unsigned u32x4 __attribute__((ext_vector_type(4)));
typedef unsigned u32x2 __attribute__((ext_vector_type(2)));
typedef int i32x4 __attribute__((ext_vector_type(4)));
typedef int i32x8 __attribute__((ext_vector_type(8)));
#define FP8_WSCALE 0x79797979
constexpr float FP8_WMUL = 64.0f;
typedef GAS unsigned gu32;

constexpr int T = 16384, D = 1024, NBATCH = 8, SEQ = 2048, MEMLEN = 256, TM = NBATCH * MEMLEN;
constexpr int INC = 4624;
constexpr int PN = 4864;
constexpr int PC_Q = 0, PC_K = 256, PC_V = 512, PC_R = 1024, PC_U = 1536, PC_SV = 2048, PC_GA = 2560, PC_GB = 3584, PC_A = 4608;
constexpr int OFF_A = 1536;
constexpr int NE = 32, NASG = T * 4, ECAP = 16384;
constexpr float EPS = 1e-5f;
constexpr int NPHASE = 14;

constexpr size_t MiB = 1u << 20;
constexpr size_t WS_CTL = 0, CTL_ZERO_BYTES = 1 * MiB;
constexpr size_t WS_WR = 1 * MiB, WS_SGUW = 1 * MiB + 256 * 1024, WS_DECAY = 1 * MiB + 512 * 1024;
constexpr size_t WS_WIN = 2 * MiB, WS_WK = 12 * MiB, WS_WV = 14 * MiB, WS_WPAB = 16 * MiB, WS_WMO = 18 * MiB, WS_WQ = 20 * MiB, WS_WO = 22 * MiB;
constexpr size_t WS_SSQ1 = 24 * MiB, WS_SSQ2 = 25 * MiB, WS_LIST = 26 * MiB, WS_LSCALE = 28 * MiB, WS_GATES = 30 * MiB;
constexpr size_t WS_W1 = 32 * MiB, WS_W2 = 160 * MiB, WS_H = 224 * MiB, WS_MEMN = 256 * MiB, WS_KMEM = 260 * MiB, WS_VT = 264 * MiB, WS_QIN = 268 * MiB;
constexpr size_t WS_OINTRA = 276 * MiB, WS_KVT = 308 * MiB, WS_OAB = 340 * MiB, WS_MIX = 372 * MiB, WS_X1B = 404 * MiB, WS_Q = 436 * MiB, WS_AO = 468 * MiB, WS_X2B = 500 * MiB;
constexpr size_t WS_P = 532 * MiB, WS_ACT = 684 * MiB, WS_YB = 828 * MiB, WS_SPT = 956 * MiB, WS_X2Q = 972 * MiB, WS_X1Q = 988 * MiB, WS_SVS = 1004 * MiB, WS_END = 1005 * MiB;
static_assert(WS_P + (size_t)T * PN * 2 <= WS_ACT && WS_ACT + (size_t)(NASG + NE * 256) * 1024 * 2 <= WS_YB && WS_YB + (size_t)NASG * 1024 * 2 <= WS_END, "ws map");
constexpr int CW_CNT = 64;
constexpr int CW_BAR = 4096;

constexpr int RING_BYTES = 131072;
constexpr int TAB_OFF = 139264, MISC_OFF = 141312, ROUTER_OFF = 147456, EPI_OFF = 147456, LDS_BYTES = 157696;

typedef __bf16 bf16x2_t __attribute__((ext_vector_type(2)));
__device__ __forceinline__ unsigned cvt_pk_bf16(float lo, float hi) { const f32x2 v = {lo, hi}; const bf16x2_t b = __builtin_convertvector(v, bf16x2_t); return __builtin_bit_cast(unsigned, b); }
__device__ __forceinline__ bf16_t f2bf(float f) { return (bf16_t)(cvt_pk_bf16(f, 0.f) & 0xffffu); }
__device__ __forceinline__ float bflo(unsigned w) { return __uint_as_float(w << 16); }
__device__ __forceinline__ float bfhi(unsigned w) { return __uint_as_float(w & 0xffff0000u); }
__device__ __forceinline__ float bf2f(bf16_t v) { return __uint_as_float((unsigned)v << 16); }
__device__ __forceinline__ void unpack8(const u32x4 w, float (&f)[8]) { f[0] = bflo(w.x); f[1] = bfhi(w.x); f[2] = bflo(w.y); f[3] = bfhi(w.y); f[4] = bflo(w.z); f[5] = bfhi(w.z); f[6] = bflo(w.w); f[7] = bfhi(w.w); }
__device__ __forceinline__ u32x4 pack8(const float (&f)[8]) { u32x4 w; w.x = cvt_pk_bf16(f[0], f[1]); w.y = cvt_pk_bf16(f[2], f[3]); w.z = cvt_pk_bf16(f[4], f[5]); w.w = cvt_pk_bf16(f[6], f[7]); return w; }
__device__ __forceinline__ u32x2 pack8_fp8(const float (&f)[8]) { int a = 0, b = 0;
    a = __builtin_amdgcn_cvt_pk_fp8_f32(f[0], f[1], a, false); a = __builtin_amdgcn_cvt_pk_fp8_f32(f[2], f[3], a, true);
    b = __builtin_amdgcn_cvt_pk_fp8_f32(f[4], f[5], b, false); b = __builtin_amdgcn_cvt_pk_fp8_f32(f[6], f[7], b, true);
    return (u32x2){(unsigned)a, (unsigned)b}; }
__device__ __forceinline__ void unpack8_fp8(const u32x2 w, float (&f)[8]) {
    const f32x2 a = __builtin_amdgcn_cvt_pk_f32_fp8((int)w.x, false), b = __builtin_amdgcn_cvt_pk_f32_fp8((int)w.x, true), c = __builtin_amdgcn_cvt_pk_f32_fp8((int)w.y, false), d = __builtin_amdgcn_cvt_pk_f32_fp8((int)w.y, true);
    f[0] = a.x; f[1] = a.y; f[2] = b.x; f[3] = b.y; f[4] = c.x; f[5] = c.y; f[6] = d.x; f[7] = d.y; }
__device__ __forceinline__ f32x4 mma16(bf16x8 a, bf16x8 b, f32x4 c) { return __builtin_amdgcn_mfma_f32_16x16x32_bf16(a, b, c, 0, 0, 0); }
__device__ __forceinline__ float wave_sum(float v) {
#pragma unroll
    for (int o = 1; o < 64; o <<= 1) v += __shfl_xor(v, o);
    return v;
}
__device__ __forceinline__ float sigmoidf_(float x) { return __builtin_amdgcn_rcpf(1.0f + __expf(-x)); }
__device__ __forceinline__ float gelu_erf(float v) {
    const float av = fabsf(v), t = __builtin_amdgcn_rcpf(av * 0.2316418882f + 1.0f);
    float q = t * 0.5307027145f + (-0.7265760135f); q = q * t + 0.7107068705f; q = q * t + (-0.142248368f); q = q * t + 0.127414796f; q = q * t;
    const float e = __builtin_amdgcn_exp2f((v * v) * (-0.72134752044f));
    const float m = v * (q * e);
    return v < 0.f ? m : v - m;
}
__device__ __forceinline__ f32x2 gelu_pk(f32x2 v) {
    const f32x2 av = __builtin_elementwise_abs(v), d = av * 0.2316418882f + 1.0f;
    f32x2 t; t.x = __builtin_amdgcn_rcpf(d.x); t.y = __builtin_amdgcn_rcpf(d.y);
    f32x2 q = t * 0.5307027145f + (-0.7265760135f); q = q * t + 0.7107068705f; q = q * t + (-0.142248368f); q = q * t + 0.127414796f; q = q * t;
    const f32x2 s = (v * v) * (-0.72134752044f);
    f32x2 e; e.x = __builtin_amdgcn_exp2f(s.x); e.y = __builtin_amdgcn_exp2f(s.y);
    const f32x2 m = v * (q * e), r = v - m;
    f32x2 o; o.x = v.x < 0.f ? m.x : r.x; o.y = v.y < 0.f ? m.y : r.y; return o;
}
__device__ __forceinline__ f32x2 sigmoid_pk(f32x2 v) {
    const f32x2 t = v * (-1.4426950408889634f); const f32x2 d = (f32x2){__builtin_amdgcn_exp2f(t.x), __builtin_amdgcn_exp2f(t.y)} + 1.0f;
    return (f32x2){__builtin_amdgcn_rcpf(d.x), __builtin_amdgcn_rcpf(d.y)};
}
#define LDS_WAIT() asm volatile("s_waitcnt lgkmcnt(0)" ::: "memory")
#define VM_WAIT() asm volatile("s_waitcnt vmcnt(0)" ::: "memory")

#define XB_TMO      128
#define XB_XCNT(j)  (256  + 64 * (j))
#define XB_XSUB(j)  (1280 + 64 * (j))
#define XB_XGEN(j)  (2304 + 64 * (j))
#define XB_TOP      3328
#define XB_TOPGEN   3392
#define XCD_BAR_WORDS 3456
#define XB_SPIN_CAP (1u << 22)
__device__ __forceinline__ unsigned xb_ld(unsigned* p)              { return __hip_atomic_load(p, __ATOMIC_RELAXED, __HIP_MEMORY_SCOPE_AGENT); }
__device__ __forceinline__ unsigned xb_add(unsigned* p, unsigned v) { return __hip_atomic_fetch_add(p, v, __ATOMIC_RELAXED, __HIP_MEMORY_SCOPE_AGENT); }
__device__ __forceinline__ unsigned xb_xcc_id() { return (unsigned)__builtin_amdgcn_s_getreg((3 << 11) | 20) & 0xFu; }
#define XB_SPIN(cond, bar) do { unsigned _sp = 0; while (cond) { __builtin_amdgcn_s_sleep(1); \
    if ((++_sp & 255u) == 0u) { if (xb_ld(&(bar)[XB_TMO])) break; if (_sp > XB_SPIN_CAP) { atomicAdd(&(bar)[XB_TMO], 1u); break; } } } } while (0)
struct XcdBarrier { unsigned* bar; unsigned x; volatile LAS unsigned* st; };
__device__ __forceinline__ XcdBarrier xcd_barrier_post(unsigned* bar, volatile LAS unsigned* st) {
    XcdBarrier b; b.bar = bar; b.x = xb_xcc_id(); b.st = st;
    if (threadIdx.x == 0) (void)xb_add(&bar[XB_XCNT(b.x)], 1u);
    return b;
}
__device__ __forceinline__ void xcd_barrier_complete(unsigned* bar, unsigned x, unsigned& nloc, unsigned& nx) {
    const unsigned G = gridDim.x * gridDim.y * gridDim.z;
    unsigned sum, cnt, mine, sp = 0u;
    for (;;) {
        sum = 0u; cnt = 0u; mine = 0u;
#pragma unroll
        for (unsigned j = 0; j < 16; ++j) { const unsigned c = xb_ld(&bar[XB_XCNT(j)]); sum += c; cnt += (c > 0u) ? 1u : 0u; mine = (j == x) ? c : mine; }
        if (sum == G) break;
        __builtin_amdgcn_s_sleep(1);
        if ((++sp & 255u) == 0u) { if (xb_ld(&bar[XB_TMO])) break; if (sp > XB_SPIN_CAP) { atomicAdd(&bar[XB_TMO], 1u); break; } }
    }
    nloc = mine > 0u ? mine : 1u; nx = cnt > 0u ? cnt : 1u;
}
__device__ __forceinline__ void xcd_barrier(const XcdBarrier& b) {
    asm volatile("s_waitcnt vmcnt(0)" ::: "memory");
    __syncthreads();
    if (threadIdx.x == 0) {
        unsigned* bar = b.bar;
        __builtin_amdgcn_s_waitcnt(0);
        unsigned nloc = b.st[0], nx = b.st[1];
        if (nloc == 0u) { xcd_barrier_complete(bar, b.x, nloc, nx); b.st[0] = nloc; b.st[1] = nx; }
        const unsigned old = xb_add(&bar[XB_XSUB(b.x)], 1u);
        const unsigned gen = old / nloc;
        if (old + 1u == (gen + 1u) * nloc) {
            __builtin_amdgcn_fence(__ATOMIC_RELEASE, "agent");
            asm volatile("s_waitcnt vmcnt(0)" ::: "memory");
            const unsigned og = xb_add(&bar[XB_TOP], 1u);
            const unsigned tg = og / nx;
            if (og + 1u == (tg + 1u) * nx) xb_add(&bar[XB_TOPGEN], 1u);
            else XB_SPIN(xb_ld(&bar[XB_TOPGEN]) == tg, bar);
            __builtin_amdgcn_fence(__ATOMIC_ACQUIRE, "agent");
            xb_add(&bar[XB_XGEN(b.x)], 1u);
            asm volatile("s_waitcnt vmcnt(0)" ::: "memory");
        } else {
            __builtin_amdgcn_fence(__ATOMIC_ACQUIRE, "agent");
            XB_SPIN(xb_ld(&bar[XB_XGEN(b.x)]) == gen, bar);
            asm volatile("s_waitcnt vmcnt(0)" ::: "memory");
        }
    }
    __syncthreads();
}

namespace pg8 {
constexpr int BM = 256, BK = 64, HALF = 128, HTB = HALF * BK * 2, NXCD = 8, WGM = 8;
__host__ __device__ __forceinline__ int lds_byte(int r, int c) { const int st = (r >> 4) * 2 + (c >> 5), rr = r & 15, cc = c & 31, ob = rr * 64 + cc * 2; return st * 1024 + (ob ^ (((ob >> 9) & 1) << 5)); }
__host__ __device__ __forceinline__ void stage_rc(int b, int& R, int& C) { const int st = b / 1024, sb = b % 1024, swz = sb ^ (((sb >> 9) & 1) << 5); R = (st >> 1) * 16 + swz / 64; C = (st & 1) * 32 + (swz % 64) / 2; }
__host__ __device__ __forceinline__ int perm32(int rho) { const int n = rho >> 4, i = rho & 15; return 8 * (i >> 2) + 4 * n + (i & 3); }
struct Unit { int pm, pn, aux; };
__device__ __forceinline__ void map_tile(int L, int nM, int nN, int& pm, int& pn) {
    const int nwg = nM * nN; int wgid = L;
    { const int q = nwg / NXCD, r = nwg % NXCD, xcd = wgid % NXCD, off = wgid / NXCD; wgid = (xcd < r ? xcd * (q + 1) : r * (q + 1) + (xcd - r) * q) + off; }
    const int nig = WGM * nN, gid = wgid / nig, fm = gid * WGM, gsz = (nM - fm) < WGM ? (nM - fm) : WGM;
    pm = fm + ((wgid % nig) % gsz); pn = (wgid % nig) / gsz;
}
template <class Epi, class Prob>
__device__ __forceinline__ void gemm_phase(LAS unsigned char* lds, const Prob& P, const Epi& E) {
    const int tid = threadIdx.x, wid = __builtin_amdgcn_readfirstlane(tid >> 6), lane = tid & 63, wr = wid >> 2, wc = wid & 3, fr = lane & 15, fq = lane >> 4;
    const int nt = P.K / (Prob::FP8 ? 128 : BK);
    unsigned voffB[2];
#pragma unroll
    for (int i = 0; i < 2; ++i) { int R_, C_; stage_rc(tid * 16 + i * 8192, R_, C_); const int Rb = (R_ & ~31) + perm32(R_ & 31); voffB[i] = (unsigned)(Rb * P.ldb + C_ * 2); }
#define PG8_AOFF(dst0, dst1, unit) do { _Pragma("unroll") for (int _i = 0; _i < 2; ++_i) { int R_, C_; stage_rc(tid * 16 + _i * 8192, R_, C_); dst0[_i] = P.a_off(unit, R_, C_); dst1[_i] = P.a_off(unit, R_ + HALF, C_); } } while (0)
    const size_t kstep = (size_t)(BK * 2);
    const size_t hstepB = (size_t)HALF * P.ldb;
    const unsigned ldsw = (unsigned)wid * 1024u;
    const int aoff = lds_byte(wr * 64 + fr, fq * 8), boff = lds_byte(wc * 32 + fr, fq * 8);
#define PG8_SA(b, h) (((b) * 2 + (h)) * HTB)
#define PG8_SB(b, h) ((4 + (b) * 2 + (h)) * HTB)
#define PG8_STAGE(bufoff, gbase, voff) do { _Pragma("unroll") for (int _i = 0; _i < 2; ++_i) \
        __builtin_amdgcn_global_load_lds((const unsigned*)((const char*)(gbase) + (voff)[_i]), (LAS unsigned*)(lds + (bufoff) + ldsw + _i * 8192), 16, 0, 0); } while (0)
#define PG8_LD8(addr) __builtin_shufflevector(*(const LAS i32x4*)(addr), *(const LAS i32x4*)((addr) + 1024), 0, 1, 2, 3, 4, 5, 6, 7)
#define PG8_LDA(dst, b, h) do { _Pragma("unroll") for (int m = 0; m < 4; ++m) dst[m] = PG8_LD8(lds + PG8_SA(b, h) + aoff + m * 2048); } while (0)
#define PG8_LDB(dst, b, h) do { _Pragma("unroll") for (int n = 0; n < 2; ++n) dst[n] = PG8_LD8(lds + PG8_SB(b, h) + boff + n * 2048); } while (0)
#define PG8_LO(x) __builtin_bit_cast(bf16x8, __builtin_shufflevector(x, x, 0, 1, 2, 3))
#define PG8_HI(x) __builtin_bit_cast(bf16x8, __builtin_shufflevector(x, x, 4, 5, 6, 7))
#define PG8_MMA(ai, bj, At, Bt) do { __builtin_amdgcn_s_setprio(1); _Pragma("unroll") for (int m = 0; m < 4; ++m) _Pragma("unroll") for (int n = 0; n < 2; ++n) { \
        if constexpr (Prob::FP8) asm volatile("v_mfma_scale_f32_16x16x128_f8f6f4 %0, %1, %2, %0, %3, %4 op_sel_hi:[0,0,0]" : "+v"(acc[ai][bj][m][n]) : "v"(Bt[n]), "v"(At[m]), "v"(scl_w), "v"(scl_1)); \
        else { acc[ai][bj][m][n] = __builtin_amdgcn_mfma_f32_16x16x32_bf16(PG8_LO(Bt[n]), PG8_LO(At[m]), acc[ai][bj][m][n], 0, 0, 0); \
               acc[ai][bj][m][n] = __builtin_amdgcn_mfma_f32_16x16x32_bf16(PG8_HI(Bt[n]), PG8_HI(At[m]), acc[ai][bj][m][n], 0, 0, 0); } } \
        __builtin_amdgcn_s_setprio(0); } while (0)
#define PG8_WAIT_V(n) asm volatile("s_waitcnt vmcnt(" #n ")" ::: "memory")
#define PG8_WAIT_L(n) asm volatile("s_waitcnt lgkmcnt(" #n ")" ::: "memory")
#define PG8_BAR __builtin_amdgcn_s_barrier()
#define PG8_SCHED __builtin_amdgcn_sched_barrier(0)
    Unit cur, nxt; int ui = 0;
    if (!P.next(0, cur)) return;
    f32x4 acc[2][2][4][2];
#pragma unroll
    for (int a = 0; a < 2; ++a)
#pragma unroll
        for (int b = 0; b < 2; ++b)
#pragma unroll
            for (int m = 0; m < 4; ++m)
#pragma unroll
                for (int n = 0; n < 2; ++n) acc[a][b][m][n] = (f32x4){0.f, 0.f, 0.f, 0.f};
    i32x8 At[4], B0[2], B1[2];
    int scl_w = Prob::WSCALE, scl_1 = 0x7f7f7f7f; asm volatile("" : "+v"(scl_w), "+v"(scl_1));
    unsigned cO0[2], cO1[2], nO0[2], nO1[2];
    PG8_AOFF(cO0, cO1, cur);
    const char* cA = P.a_base(cur); const char* cB = P.b_base(cur);
    PG8_STAGE(PG8_SB(0, 0), cB, voffB); PG8_STAGE(PG8_SB(0, 1), cB + hstepB, voffB); PG8_STAGE(PG8_SA(0, 0), cA, cO0); PG8_STAGE(PG8_SA(0, 1), cA, cO1);
    if (wr == 1) PG8_BAR;
    PG8_WAIT_V(2); PG8_BAR;
    PG8_STAGE(PG8_SB(1, 0), cB + kstep, voffB); PG8_STAGE(PG8_SA(1, 0), cA + kstep, cO0); PG8_STAGE(PG8_SB(1, 1), cB + hstepB + kstep, voffB);
    PG8_WAIT_V(6); PG8_BAR;
    for (;;) {
        const bool has_next = P.next(ui + 1, nxt);
        const char* nA = cA; const char* nB = cB;
        if constexpr (Prob::GATHER) {
#pragma unroll
            for (int i = 0; i < 2; ++i) { nO0[i] = cO0[i]; nO1[i] = cO1[i]; } }
        if (has_next) { nA = P.a_base(nxt); nB = P.b_base(nxt); if constexpr (Prob::GATHER) PG8_AOFF(nO0, nO1, nxt); }
        for (int t = 0; t < nt; t += 2) {
            const bool last = (t == nt - 2);
            const char* a1 = cA + (size_t)(t + 1) * kstep;
            const char* a2 = last ? nA : cA + (size_t)(t + 2) * kstep; const char* b2 = last ? nB : cB + (size_t)(t + 2) * kstep;
            const char* a3 = a2 + kstep; const char* b3 = b2 + kstep;
            unsigned o20[2], o21[2];
#pragma unroll
            for (int i = 0; i < 2; ++i) { if constexpr (Prob::GATHER) { o20[i] = last ? nO0[i] : cO0[i]; o21[i] = last ? nO1[i] : cO1[i]; } else { o20[i] = cO0[i]; o21[i] = cO1[i]; } }
            const bool fin = last && !has_next;
            PG8_LDB(B0, 0, 0); PG8_LDB(B1, 0, 1); PG8_SCHED; PG8_LDA(At, 0, 0); PG8_STAGE(PG8_SA(1, 1), a1, cO1);
            PG8_WAIT_V(8); PG8_WAIT_L(0); PG8_BAR; PG8_MMA(0, 0, At, B0); PG8_MMA(0, 1, At, B1); PG8_BAR; PG8_SCHED;
            PG8_LDA(At, 0, 1);
            if (!fin) { PG8_STAGE(PG8_SB(0, 0), b2, voffB); PG8_STAGE(PG8_SB(0, 1), b2 + hstepB, voffB); PG8_STAGE(PG8_SA(0, 0), a2, o20); PG8_WAIT_V(8); }
            else PG8_WAIT_V(2);
            PG8_WAIT_L(0); PG8_BAR; PG8_MMA(1, 0, At, B0); PG8_MMA(1, 1, At, B1); PG8_BAR; PG8_SCHED;
            if constexpr (Epi::STAGE) { if (last) E.stage(cur, wid, lane, lds); }
            PG8_LDB(B0, 1, 0); PG8_LDB(B1, 1, 1); PG8_SCHED; PG8_LDA(At, 1, 0);
            if (!fin) { PG8_STAGE(PG8_SA(0, 1), a2, o21); PG8_WAIT_V(8); }
            else PG8_WAIT_V(0);
            PG8_WAIT_L(0); PG8_BAR; PG8_MMA(0, 0, At, B0); PG8_MMA(0, 1, At, B1); PG8_BAR; PG8_SCHED;
            PG8_LDA(At, 1, 1);
            if (!fin) { PG8_STAGE(PG8_SB(1, 0), b3, voffB); PG8_STAGE(PG8_SB(1, 1), b3 + hstepB, voffB); PG8_STAGE(PG8_SA(1, 0), a3, o20); PG8_WAIT_V(8); }
            PG8_WAIT_L(0); PG8_BAR; PG8_MMA(1, 0, At, B0); PG8_MMA(1, 1, At, B1); PG8_BAR; PG8_SCHED;
            if constexpr (Epi::MID) { if (t + 2 == nt / 2) E.mid(acc, cur, wr, wc, fr, fq); }
        }
        if (wr == 0) PG8_BAR;
        if constexpr (Prob::FP8) asm volatile("s_nop 15\n\ts_nop 15" ::: "memory");
        E(acc, cur, wr, wc, fr, fq);
        if (!has_next) break;
#pragma unroll
        for (int a = 0; a < 2; ++a)
#pragma unroll
            for (int b = 0; b < 2; ++b)
#pragma unroll
                for (int m = 0; m < 4; ++m)
#pragma unroll
                    for (int n = 0; n < 2; ++n) acc[a][b][m][n] = (f32x4){0.f, 0.f, 0.f, 0.f};
        cur = nxt; cA = nA; cB = nB; ++ui;
        if constexpr (Prob::GATHER) {
#pragma unroll
            for (int i = 0; i < 2; ++i) { cO0[i] = nO0[i]; cO1[i] = nO1[i]; } }
        if (wr == 1) PG8_BAR;
    }
    PG8_WAIT_V(0);
    PG8_BAR;
#undef PG8_AOFF
#undef PG8_SA
#undef PG8_SB
#undef PG8_STAGE
#undef PG8_LDA
#undef PG8_LD8
#undef PG8_LO
#undef PG8_HI
#undef PG8_LDB
#undef PG8_MMA
#undef PG8_WAIT_V
#undef PG8_WAIT_L
#undef PG8_BAR
#undef PG8_SCHED
}
}
using pg8::Unit;

struct Args { const float* in[28]; float* out; unsigned char* ws; int ph_lo, ph_hi; };
struct Frame {
    LAS unsigned char* lds;
    volatile LAS unsigned* MISC;
    unsigned* ctl;
    int tid, lane, wave, vcu, G;
    const Args* A;
    __device__ __forceinline__ bf16_t* Win_t() const { return (bf16_t*)(A->ws + WS_WIN); }
    __device__ __forceinline__ bf16_t* Wk_t() const { return (bf16_t*)(A->ws + WS_WK); }
    __device__ __forceinline__ bf16_t* Wv_t() const { return (bf16_t*)(A->ws + WS_WV); }
    __device__ __forceinline__ bf16_t* Wpab_t() const { return (bf16_t*)(A->ws + WS_WPAB); }
    __device__ __forceinline__ bf16_t* Wmo_t() const { return (bf16_t*)(A->ws + WS_WMO); }
    __device__ __forceinline__ bf16_t* Wq_t() const { return (bf16_t*)(A->ws + WS_WQ); }
    __device__ __forceinline__ bf16_t* Wo_t() const { return (bf16_t*)(A->ws + WS_WO); }
    __device__ __forceinline__ bf16_t* Wr_t() const { return (bf16_t*)(A->ws + WS_WR); }
    __device__ __forceinline__ bf16_t* W1_t() const { return (bf16_t*)(A->ws + WS_W1); }
    __device__ __forceinline__ bf16_t* W2_t() const { return (bf16_t*)(A->ws + WS_W2); }
    __device__ __forceinline__ bf16_t* sguw() const { return (bf16_t*)(A->ws + WS_SGUW); }
    __device__ __forceinline__ bf16_t* h() const { return (bf16_t*)(A->ws + WS_H); }
    __device__ __forceinline__ bf16_t* memn() const { return (bf16_t*)(A->ws + WS_MEMN); }
    __device__ __forceinline__ bf16_t* kmem() const { return (bf16_t*)(A->ws + WS_KMEM); }
    __device__ __forceinline__ bf16_t* vt() const { return (bf16_t*)(A->ws + WS_VT); }
    __device__ __forceinline__ bf16_t* qin() const { return (bf16_t*)(A->ws + WS_QIN); }
    __device__ __forceinline__ bf16_t* oab() const { return (bf16_t*)(A->ws + WS_OAB); }
    __device__ __forceinline__ bf16_t* mix() const { return (bf16_t*)(A->ws + WS_MIX); }
    __device__ __forceinline__ bf16_t* x1b() const { return (bf16_t*)(A->ws + WS_X1B); }
    __device__ __forceinline__ bf16_t* q() const { return (bf16_t*)(A->ws + WS_Q); }
    __device__ __forceinline__ bf16_t* ao() const { return (bf16_t*)(A->ws + WS_AO); }
    __device__ __forceinline__ bf16_t* x2b() const { return (bf16_t*)(A->ws + WS_X2B); }
    __device__ __forceinline__ bf16_t* p() const { return (bf16_t*)(A->ws + WS_P); }
    __device__ __forceinline__ bf16_t* act() const { return (bf16_t*)(A->ws + WS_ACT); }
    __device__ __forceinline__ bf16_t* yb() const { return (bf16_t*)(A->ws + WS_YB); }
    __device__ __forceinline__ bf16_t* ointra() const { return (bf16_t*)(A->ws + WS_OINTRA); }
    __device__ __forceinline__ bf16_t* kvT() const { return (bf16_t*)(A->ws + WS_KVT); }
    __device__ __forceinline__ float* decay() const { return (float*)(A->ws + WS_DECAY); }
    __device__ __forceinline__ float* ssq1() const { return (float*)(A->ws + WS_SSQ1); }
    __device__ __forceinline__ float* ssq2() const { return (float*)(A->ws + WS_SSQ2); }
    __device__ __forceinline__ float* lscale() const { return (float*)(A->ws + WS_LSCALE); }
    __device__ __forceinline__ float* gates() const { return (float*)(A->ws + WS_GATES); }
    __device__ __forceinline__ int* list() const { return (int*)(A->ws + WS_LIST); }
    __device__ __forceinline__ bf16_t* spT() const { return (bf16_t*)(A->ws + WS_SPT); }
    __device__ __forceinline__ unsigned char* x2q() const { return (unsigned char*)(A->ws + WS_X2Q); }
    __device__ __forceinline__ unsigned char* x1q() const { return (unsigned char*)(A->ws + WS_X1Q); }
};
enum { I_X = 0, I_MEM, I_NMIXG, I_WIN, I_WA2, I_BA, I_GOUTG, I_SNG, I_SNB, I_SW, I_SB, I_WPA, I_WPB, I_WMO, I_NXG, I_NMEMG, I_WXQ, I_WXK, I_WXV, I_WXO, I_NFFNG, I_WR, I_BR, I_WE1, I_BE1, I_WE2, I_BE2, I_NFING };

struct CvtItem { const float* src; size_t ldw; unsigned char* dst; const float* kscale; float mul; int fp8; };
__device__ __forceinline__ void cvt_load(const CvtItem& c, float (&v)[64]) {
#pragma unroll
    for (int i = 0; i < 64; ++i) v[i] = __builtin_nontemporal_load(c.src + (size_t)i * c.ldw);
}
__device__ __forceinline__ void cvt_finish(const CvtItem& c, float (&v)[64]) {
    if (c.kscale) {
#pragma unroll
        for (int i = 0; i < 64; ++i) v[i] *= c.kscale[i] * c.mul; }
    else {
#pragma unroll
        for (int i = 0; i < 64; ++i) v[i] *= c.mul; }
    if (c.fp8) {
#pragma unroll
        for (int q = 0; q < 4; ++q) { const float f0[8] = {v[16 * q], v[16 * q + 1], v[16 * q + 2], v[16 * q + 3], v[16 * q + 4], v[16 * q + 5], v[16 * q + 6], v[16 * q + 7]};
            const float f1[8] = {v[16 * q + 8], v[16 * q + 9], v[16 * q + 10], v[16 * q + 11], v[16 * q + 12], v[16 * q + 13], v[16 * q + 14], v[16 * q + 15]};
            const u32x2 lo = pack8_fp8(f0), hi = pack8_fp8(f1); *(u32x4*)(c.dst + 16 * q) = (u32x4){lo.x, lo.y, hi.x, hi.y}; } }
    else {
#pragma unroll
        for (int q = 0; q < 8; ++q) { const float f[8] = {v[8 * q], v[8 * q + 1], v[8 * q + 2], v[8 * q + 3], v[8 * q + 4], v[8 * q + 5], v[8 * q + 6], v[8 * q + 7]}; *(u32x4*)(c.dst + 16 * q) = pack8(f); } }
}
__device__ __forceinline__ CvtItem cvt_desc(const float* W, int ldw, int src_col0, int k0, void* WT, int ldt, int dst_row0, int dst_k0, const float* kscale, float mul, int fp8, int lane) {
    CvtItem c; const int eb = fp8 ? 1 : 2;
    c.src = W + (size_t)k0 * ldw + src_col0 + lane; c.ldw = (size_t)ldw; c.dst = (unsigned char*)WT + ((size_t)(dst_row0 + lane) * ldt + dst_k0 + k0) * eb;
    c.kscale = kscale ? kscale + k0 : nullptr; c.mul = mul; c.fp8 = fp8; return c;
}
__device__ __forceinline__ void cvt_expert128(Frame& F) {
    const int gw = F.vcu * 8 + F.wave, NGW = F.G * 8, lane = F.lane;
    constexpr int I1 = NE * 8 * 32, I2 = NE * 8 * 16;
    for (int it = gw; it < I1 + I2; it += NGW) {
        const float* src; size_t ldw; unsigned char* dst; const float* ks; (void)ks;
        if (it < I1) { const int e = it >> 8, q = it & 255, kb = q >> 5, nb = q & 31, nd = nb * 64; const int sc = ((nd & 128) ? 1024 : 0) + 128 * (nd >> 8) + (nd & 127);
            src = F.A->in[I_WE1] + (size_t)e * D * 2048 + (size_t)(kb * 128) * 2048 + sc + lane; ldw = 2048;
            dst = (unsigned char*)F.W1_t() + (size_t)e * 2048 * D + (size_t)(nd + lane) * D + kb * 128; ks = nullptr; }
        else { const int r = it - I1, e = r >> 7, q = r & 127, kb = q >> 4, nb = q & 15;
            src = F.A->in[I_WE2] + (size_t)e * D * D + (size_t)(kb * 128) * D + nb * 64 + lane; ldw = D;
            dst = (unsigned char*)F.W2_t() + (size_t)e * D * D + (size_t)(nb * 64 + lane) * D + kb * 128; ks = nullptr; }
        float v[128]; const float* pp = src;
#pragma unroll
        for (int i = 0; i < 128; ++i) { v[i] = __builtin_nontemporal_load(pp); pp += ldw; asm volatile("" : "+v"(pp)); }
#pragma unroll
        for (int i = 0; i < 128; ++i) v[i] *= FP8_WMUL;
#pragma unroll
        for (int q = 0; q < 8; ++q) { const float f0[8] = {v[16 * q], v[16 * q + 1], v[16 * q + 2], v[16 * q + 3], v[16 * q + 4], v[16 * q + 5], v[16 * q + 6], v[16 * q + 7]};
            const float f1[8] = {v[16 * q + 8], v[16 * q + 9], v[16 * q + 10], v[16 * q + 11], v[16 * q + 12], v[16 * q + 13], v[16 * q + 14], v[16 * q + 15]};
            const u32x2 lo = pack8_fp8(f0), hi = pack8_fp8(f1); *(u32x4*)(dst + 16 * q) = (u32x4){lo.x, lo.y, hi.x, hi.y}; }
    }
}
constexpr int CVT_SLOT = 16 * 1040;
struct CvtDma { const float* src; unsigned ldw; unsigned char* dst; };
__device__ __forceinline__ CvtDma cvt_dma_desc(const Frame& F, int it) {
    constexpr int I1 = NE * 8 * 64; CvtDma c;
    if (it < I1) { const int e = it >> 9, q = it & 511, kb = q >> 6, nb = q & 63, nd = nb * 32; const int sc = ((nd & 128) ? 1024 : 0) + 128 * (nd >> 8) + (nd & 127);
        c.src = F.A->in[I_WE1] + (size_t)e * D * 2048 + (size_t)(kb * 128) * 2048 + sc; c.ldw = 2048;
        c.dst = (unsigned char*)F.W1_t() + (size_t)e * 2048 * D + (size_t)nd * D + kb * 128; }
    else { const int r = it - I1, e = r >> 8, q = r & 255, kb = q >> 5, nb = q & 31;
        c.src = F.A->in[I_WE2] + (size_t)e * D * D + (size_t)(kb * 128) * D + nb * 32; c.ldw = D;
        c.dst = (unsigned char*)F.W2_t() + (size_t)e * D * D + (size_t)(nb * 32) * D + kb * 128; }
    return c;
}
__device__ __forceinline__ void cvt_dma_issue(const CvtDma& c, LAS unsigned char* slot, int lane) {
    const float* p = c.src + (size_t)(lane >> 3) * c.ldw + (lane & 7) * 4;
#pragma unroll
    for (int i = 0; i < 16; ++i) { __builtin_amdgcn_global_load_lds((const unsigned*)p, (LAS unsigned*)(slot + i * 1040), 16, 0, 2); p += (size_t)8 * c.ldw; }
}
__device__ __forceinline__ void cvt_expert_dma(Frame& F) {
    if (F.wave < 4) return;
    const int cw = F.vcu * 4 + (F.wave - 4), NCW = F.G * 4, lane = F.lane;
    constexpr int ITEMS = NE * 8 * 64 + NE * 8 * 32;
    const int n = cw < ITEMS ? (ITEMS - cw + NCW - 1) / NCW : 0;
    LAS unsigned char* slot0 = F.lds + (F.wave - 4) * (2 * CVT_SLOT);
    const int rdo = (lane & 7) * 2080 + (lane >> 3) * 4;
    CvtDma d0 = cvt_dma_desc(F, n > 0 ? cw : 0), d1 = cvt_dma_desc(F, n > 1 ? cw + NCW : 0);
    if (n > 0) cvt_dma_issue(d0, slot0, lane);
    if (n > 1) cvt_dma_issue(d1, slot0 + CVT_SLOT, lane);
    for (int j = 0; j < n; ++j) {
        if (j + 1 >= n) asm volatile("s_waitcnt vmcnt(0)" ::: "memory");
        else if (j == 0) asm volatile("s_waitcnt vmcnt(16)" ::: "memory");
        else asm volatile("s_waitcnt vmcnt(20)" ::: "memory");
        LAS unsigned char* slot = slot0 + (j & 1) * CVT_SLOT;
        const LAS unsigned char* rd = slot + rdo;
        float v[4][16];
        const unsigned rda = (unsigned)(size_t)rd;
#pragma unroll
        for (int q = 0; q < 4; ++q)
#pragma unroll
            for (int jj = 0; jj < 16; ++jj) asm volatile("ds_read_b32 %0, %1 offset:%2" : "=v"(v[q][jj]) : "v"(rda), "n"(q * 32 + (jj >> 3) * 1040 + (jj & 7) * 128));
        asm volatile("s_waitcnt lgkmcnt(0)" ::: "memory");
#pragma unroll
        for (int q = 0; q < 4; ++q) asm volatile("" : "+v"(v[q][0]), "+v"(v[q][1]), "+v"(v[q][2]), "+v"(v[q][3]), "+v"(v[q][4]), "+v"(v[q][5]), "+v"(v[q][6]), "+v"(v[q][7]),
                                                     "+v"(v[q][8]), "+v"(v[q][9]), "+v"(v[q][10]), "+v"(v[q][11]), "+v"(v[q][12]), "+v"(v[q][13]), "+v"(v[q][14]), "+v"(v[q][15]));
        unsigned char* dst = d0.dst + (size_t)(lane >> 3) * D + (lane & 7) * 16;
        d0 = d1;
        if (j + 2 < n) { d1 = cvt_dma_desc(F, cw + (j + 2) * NCW); cvt_dma_issue(d1, slot, lane); }
#pragma unroll
        for (int q = 0; q < 4; ++q) {
            float f0[8], f1[8];
#pragma unroll
            for (int jj = 0; jj < 8; ++jj) { f0[jj] = v[q][jj] * FP8_WMUL; f1[jj] = v[q][8 + jj] * FP8_WMUL; }
            const u32x2 lo = pack8_fp8(f0), hi = pack8_fp8(f1);
            *(u32x4*)(dst + (size_t)(8 * q) * D) = (u32x4){lo.x, lo.y, hi.x, hi.y}; }
    }
    asm volatile("s_waitcnt vmcnt(0)" ::: "memory");
}
template <bool Q8>
__device__ __forceinline__ void rms_row_to_bf16(const float* xrow, const float* g, bf16_t* orow, int lane) {
    f32x4 v[4]; float s = 0.f;
#pragma unroll
    for (int j = 0; j < 4; ++j) { v[j] = *(const f32x4*)(xrow + 256 * j + 4 * lane); s += (v[j].x * v[j].x + v[j].y * v[j].y) + (v[j].z * v[j].z + v[j].w * v[j].w); }
    const float rs = rsqrtf(wave_sum(s) * (1.f / D) + EPS);
#pragma unroll
    for (int j = 0; j < 4; ++j) { const f32x4 gg = *(const f32x4*)(g + 256 * j + 4 * lane);
        if constexpr (Q8) { int w = 0; w = __builtin_amdgcn_cvt_pk_fp8_f32(v[j].x * rs * gg.x, v[j].y * rs * gg.y, w, false); w = __builtin_amdgcn_cvt_pk_fp8_f32(v[j].z * rs * gg.z, v[j].w * rs * gg.w, w, true);
            *(int*)((unsigned char*)orow + 256 * j + 4 * lane) = w; }
        else { u32x2 o; o.x = cvt_pk_bf16(v[j].x * rs * gg.x, v[j].y * rs * gg.y); o.y = cvt_pk_bf16(v[j].z * rs * gg.z, v[j].w * rs * gg.w);
            *(u32x2*)(orow + 256 * j + 4 * lane) = o; } }
}
__device__ __forceinline__ void cvt_range(Frame& F, int ibeg, int iend) {
    const int gw = F.vcu * 8 + F.wave, NGW = F.G * 8, lane = F.lane;
    constexpr int N_WIN = 16 * 72, N_SQ = 256, N_PA = 8 * 16, N_E1 = 512, N_E2 = 256;
    constexpr int S_WIN = 0, S_WK = S_WIN + N_WIN, S_WV = S_WK + N_SQ, S_PA = S_WV + N_SQ, S_PB = S_PA + N_PA, S_MO = S_PB + N_PA, S_Q = S_MO + N_SQ, S_O = S_Q + N_SQ, S_E1 = S_O + N_SQ, S_E2 = S_E1 + NE * N_E1, S_END = S_E2 + NE * N_E2;
    static_assert(S_E1 == 16 * 72 + 256 * 2 + 8 * 16 * 2 + 256 * 3 && S_END == S_E1 + NE * 512 + NE * 256, "item ranges");
    const int IEND = iend < S_END ? iend : S_END;
    auto desc = [&](int it) -> CvtItem {
        if (it < S_WK) { const int r = it - S_WIN, kb = r / 72, nb = r % 72, n0 = nb * 64; return cvt_desc(F.A->in[I_WIN], INC, n0 < 1536 ? n0 : n0 + 16, kb * 64, F.Win_t(), D, n0, 0, nullptr, P1_FP8 ? FP8_WMUL : 1.f, P1_FP8, lane); }
        if (it < S_WV) { const int r = it - S_WK; return cvt_desc(F.A->in[I_WXK], D, (r & 15) * 64, (r >> 4) * 64, F.Wk_t(), D, (r & 15) * 64, 0, nullptr, P1_FP8 ? FP8_WMUL : 1.f, P1_FP8, lane); }
        if (it < S_PA) { const int r = it - S_WV; return cvt_desc(F.A->in[I_WXV], D, (r & 15) * 64, (r >> 4) * 64, F.Wv_t(), D, (r & 15) * 64, 0, nullptr, P1_FP8 ? FP8_WMUL : 1.f, P1_FP8, lane); }
        if (it < S_PB) { const int r = it - S_PA; return cvt_desc(F.A->in[I_WPA], D, (r & 15) * 64, (r >> 4) * 64, F.Wpab_t(), D, (r & 15) * 64, 0, nullptr, 1.f, 0, lane); }
        if (it < S_MO) { const int r = it - S_PB; return cvt_desc(F.A->in[I_WPB], D, (r & 15) * 64, (r >> 4) * 64, F.Wpab_t(), D, (r & 15) * 64, 512, nullptr, 1.f, 0, lane); }
        if (it < S_Q)  { const int r = it - S_MO; return cvt_desc(F.A->in[I_WMO], D, (r & 15) * 64, (r >> 4) * 64, F.Wmo_t(), D, (r & 15) * 64, 0, nullptr, 1.f, 0, lane); }
        if (it < S_O)  { const int r = it - S_Q;  return cvt_desc(F.A->in[I_WXQ], D, (r & 15) * 64, (r >> 4) * 64, F.Wq_t(), D, (r & 15) * 64, 0, F.A->in[I_NXG], FP8_WMUL, 1, lane); }
        if (it < S_E1) { const int r = it - S_O;  return cvt_desc(F.A->in[I_WXO], D, (r & 15) * 64, (r >> 4) * 64, F.Wo_t(), D, (r & 15) * 64, 0, nullptr, FP8_WMUL, 1, lane); }
        if (it < S_E2) { const int r = it - S_E1, e = r / N_E1, q = r % N_E1, kb = q >> 5, nb = q & 31, nd = nb * 64;
            const int src = ((nd & 128) ? 1024 : 0) + 128 * (nd >> 8) + (nd & 127);
            return cvt_desc(F.A->in[I_WE1] + (size_t)e * D * 2048, 2048, src, kb * 64, (unsigned char*)F.W1_t() + (size_t)e * 2048 * D, D, nd, 0, F.A->in[I_NFFNG], FP8_WMUL, 1, lane); }
        const int r = it - S_E2, e = r / N_E2, q = r % N_E2;
        return cvt_desc(F.A->in[I_WE2] + (size_t)e * D * D, D, (q & 15) * 64, (q >> 4) * 64, (unsigned char*)F.W2_t() + (size_t)e * D * D, D, (q & 15) * 64, 0, nullptr, FP8_WMUL, 1, lane); };
    if (ibeg + gw < IEND) {
        float va[64], vb[64]; CvtItem ca = desc(ibeg + gw), cb = ca; cvt_load(ca, va);
        for (int it = ibeg + gw;;) {
            const bool hb = it + NGW < IEND; if (hb) { cb = desc(it + NGW); cvt_load(cb, vb); }
            cvt_finish(ca, va); if (!hb) break;
            const bool ha = it + 2 * NGW < IEND; if (ha) { ca = desc(it + 2 * NGW); cvt_load(ca, va); }
            cvt_finish(cb, vb); if (!ha) break;
            it += 2 * NGW; }
    }
}
constexpr int CVT_LATE = 16 * 72 + 256 * 2, CVT_EXPERT = 16 * 72 + 256 * 2 + 8 * 16 * 2 + 256 * 3, CVT_END = CVT_EXPERT + NE * 512 + NE * 256;
__device__ __forceinline__ void p0_prologue(Frame& F) {
    const int gw = F.vcu * 8 + F.wave, NGW = F.G * 8, lane = F.lane;
    cvt_range(F, 0, CVT_LATE);
    for (int m = gw; m < T; m += NGW) rms_row_to_bf16<P1_FP8 != 0>(F.A->in[I_X] + (size_t)m * D, F.A->in[I_NMIXG], (bf16_t*)((unsigned char*)F.h() + (size_t)m * D * (P1_FP8 ? 1 : 2)), lane);
    for (int m = gw; m < TM; m += NGW) rms_row_to_bf16<P1_FP8 != 0>(F.A->in[I_MEM] + (size_t)m * D, F.A->in[I_NMEMG], (bf16_t*)((unsigned char*)F.memn() + (size_t)m * D * (P1_FP8 ? 1 : 2)), lane);
    const int gt = F.vcu * 512 + F.tid, NGT = F.G * 512;
    for (int i = gt; i < 256 * D; i += NGT) { const int j = i >> 10, k = i & 1023; const float* wr_ = F.A->in[I_WIN] + (size_t)k * INC + OFF_A; float s = 0.f;
#pragma unroll
        for (int r = 0; r < 16; ++r) s += wr_[r] * F.A->in[I_WA2][r * 256 + j];
        if (P1_FP8) { int w = __builtin_amdgcn_cvt_pk_fp8_f32(s * FP8_WMUL, 0.f, 0, false); ((unsigned char*)F.Win_t())[(size_t)(PC_A + j) * D + k] = (unsigned char)(w & 0xff); }
        else F.Win_t()[(size_t)(PC_A + j) * D + k] = f2bf(s); }
    for (int i = gt; i < NE * D; i += NGT) { const int e = i >> 10, k = i & 1023; F.Wr_t()[i] = f2bf(F.A->in[I_WR][k * NE + e] * F.A->in[I_NFFNG][k]); }
    for (int i = gt; i < 4 * 128 * 128; i += NGT) { const int t = (i >> 7) & 127, s = i & 127; F.sguw()[i] = f2bf(s <= t ? F.A->in[I_SW][i] : 0.f); }
}

struct ProbP1 {
    static constexpr bool GATHER = false, FP8 = (P1_FP8 != 0); static constexpr int EB = P1_FP8 ? 1 : 2, WSCALE = FP8_WSCALE;
    int K, lda, ldb, G, c; const unsigned char* ws;
    __device__ __forceinline__ bool next(int i, Unit& u) const {
        const int L = i * G + c;
        if (L < 1216) { u.aux = 0; pg8::map_tile(L, 64, 19, u.pm, u.pn); return true; }
        if (L < 1248) { u.aux = 1; u.pm = (L - 1216) >> 2; u.pn = (L - 1216) & 3; return true; }
        if (L < 1280) { u.aux = 2; u.pm = (L - 1248) >> 3; u.pn = (L - 1248) & 7; return true; }
        return false;
    }
    __device__ __forceinline__ const char* a_base(const Unit& u) const { const size_t o = u.aux == 0 ? WS_H : (u.aux == 1 ? WS_MEMN : WS_WV); return (const char*)(ws + o + (size_t)u.pm * 256 * D * EB); }
    __device__ __forceinline__ const char* b_base(const Unit& u) const { const size_t o = u.aux == 0 ? WS_WIN : (u.aux == 1 ? WS_WK : WS_MEMN); return (const char*)(ws + o + (size_t)u.pn * 256 * D * EB); }
    __device__ __forceinline__ unsigned a_off(const Unit&, int row, int C) const { return (unsigned)(row * D * EB + C * 2); }
};
struct EpiP1 {
    static constexpr bool MID = false, STAGE = false;
    unsigned char* ws;
    __device__ __forceinline__ void operator()(const f32x4 (&acc)[2][2][4][2], const Unit& u, int wr, int wc, int fr, int fq) const {
        asm volatile("" : "+v"(fr), "+v"(fq));
        const size_t oo = u.aux == 0 ? WS_P : (u.aux == 1 ? WS_KMEM : WS_VT);
        bf16_t* O = (bf16_t*)(ws + oo); const int ldc = u.aux == 0 ? PN : (u.aux == 1 ? D : TM);
        const int act = (u.aux == 0) ? ((u.pn >= 6 && u.pn < 10) ? 1 : ((u.pn >= 10 && u.pn < 18) ? 2 : 0)) : 0;
        const int row0 = u.pm * 256 + wr * 64 + fr, col0 = u.pn * 256 + wc * 32 + 8 * fq; const bool svstat = (u.aux == 0) && (u.pn == 8 || u.pn == 9);
#pragma unroll
        for (int ai = 0; ai < 2; ++ai)
#pragma unroll
            for (int m = 0; m < 4; ++m) { bf16_t* rowp = O + (size_t)(row0 + ai * 128 + m * 16) * ldc + col0; float s1 = 0.f, s2 = 0.f;
#pragma unroll
                for (int bj = 0; bj < 2; ++bj) { float v[8];
#pragma unroll
                    for (int j = 0; j < 4; ++j) { v[j] = acc[ai][bj][m][0][j]; v[4 + j] = acc[ai][bj][m][1][j]; }
                    if (act == 1) {
#pragma unroll
                        for (int j = 0; j < 8; j += 2) { const f32x2 o = gelu_pk((f32x2){v[j], v[j + 1]}); v[j] = o.x; v[j + 1] = o.y; }
#pragma unroll
                        for (int j = 0; j < 8; ++j) { s1 += v[j]; s2 += v[j] * v[j]; } }
                    else if (act == 2) {
#pragma unroll
                        for (int j = 0; j < 8; j += 2) { const f32x2 o = sigmoid_pk((f32x2){v[j], v[j + 1]}); v[j] = o.x; v[j + 1] = o.y; } }
                    *(u32x4*)(rowp + bj * 128) = pack8(v); }
                if (svstat) {
                    s1 += __shfl_xor(s1, 16); s1 += __shfl_xor(s1, 32); s2 += __shfl_xor(s2, 16); s2 += __shfl_xor(s2, 32);
                    if (fq == 0) *(f32x2*)((float*)(ws + WS_SVS) + (size_t)(row0 + ai * 128 + m * 16) * 16 + (u.pn - 8) * 8 + wc * 2) = (f32x2){s1, s2}; } }
    }
};

__device__ __forceinline__ void gla_a_unit(Frame& F, int unit) {
    const int tid = F.tid, lane = F.lane, w = F.wave, fr = lane & 15, fq = lane >> 4;
    const int bh = unit >> 5, n = unit & 31, b = bh >> 2, h = bh & 3;
    const int t0 = b * SEQ + n * 64;
    LAS float* cum = (LAS float*)(F.lds); LAS float* tot = (LAS float*)(F.lds + 16640);
    LAS bf16_t* QIN = (LAS bf16_t*)(F.lds + 18688); LAS bf16_t* KIN = (LAS bf16_t*)(F.lds + 27904); LAS bf16_t* KOT = (LAS bf16_t*)(F.lds + 37120);
    LAS bf16_t* ATT = (LAS bf16_t*)(F.lds + 46336); LAS bf16_t* VT = (LAS bf16_t*)(F.lds + 55552);
    const int c = tid >> 3, d8 = (tid & 7) * 8;
    {
        float g[8]; unpack8(*(const u32x4*)(F.p() + (size_t)(t0 + c) * PN + PC_A + h * 64 + d8), g);
        const f32x4 b0 = *(const f32x4*)(F.A->in[I_BA] + h * 64 + d8), b1 = *(const f32x4*)(F.A->in[I_BA] + h * 64 + d8 + 4);
        const float bb[8] = {b0.x, b0.y, b0.z, b0.w, b1.x, b1.y, b1.z, b1.w};
#pragma unroll
        for (int j = 0; j < 8; ++j) { const float x = g[j] + bb[j]; const float ls = fminf(x, 0.f) - __logf(1.f + __expf(-fabsf(x))); cum[c * 65 + d8 + j] = ls * 0.0625f; }
    }
    __syncthreads();
    { const int d = tid & 63, seg = tid >> 6; float run = 0.f;
#pragma unroll
        for (int i = 0; i < 8; ++i) { run += cum[(seg * 8 + i) * 65 + d]; cum[(seg * 8 + i) * 65 + d] = run; }
        tot[seg * 64 + d] = run; }
    __syncthreads();
    { const int d = tid & 63, seg = tid >> 6; float off = 0.f;
#pragma unroll
        for (int s = 0; s < 7; ++s) if (s < seg) off += tot[s * 64 + d];
#pragma unroll
        for (int i = 0; i < 8; ++i) cum[(seg * 8 + i) * 65 + d] += off; }
    __syncthreads();
    {
        float qv[8], kv[8], qi[8], ki[8];
        unpack8(*(const u32x4*)(F.p() + (size_t)(t0 + c) * PN + PC_Q + h * 64 + d8), qv);
        unpack8(*(const u32x4*)(F.p() + (size_t)(t0 + c) * PN + PC_K + h * 64 + d8), kv);
#pragma unroll
        for (int j = 0; j < 8; ++j) { const float cm = cum[c * 65 + d8 + j], cl = cum[63 * 65 + d8 + j];
            qi[j] = qv[j] * 0.125f * __expf(cm); ki[j] = kv[j] * __expf(-cm);
            KOT[(d8 + j) * 72 + c] = f2bf(kv[j] * __expf(cl - cm));
            if (c == 63) F.decay()[unit * 64 + d8 + j] = __expf(cl); }
        const u32x4 qp = pack8(qi), kp = pack8(ki);
        *(LAS u32x4*)(QIN + c * 72 + d8) = qp; *(LAS u32x4*)(KIN + c * 72 + d8) = kp;
        *(u32x4*)(F.qin() + (size_t)(t0 + c) * 256 + h * 64 + d8) = qp;
        const int e16 = (tid & 7) * 16;
#pragma unroll
        for (int hh = 0; hh < 2; ++hh) { const u32x4 vv = *(const u32x4*)(F.p() + (size_t)(t0 + c) * PN + PC_V + h * 128 + e16 + 8 * hh);
            const unsigned ww[4] = {vv.x, vv.y, vv.z, vv.w};
#pragma unroll
            for (int j = 0; j < 4; ++j) { VT[(e16 + 8 * hh + 2 * j) * 72 + c] = (bf16_t)(ww[j] & 0xffffu); VT[(e16 + 8 * hh + 2 * j + 1) * 72 + c] = (bf16_t)(ww[j] >> 16); } }
    }
    __syncthreads();
    {
        const int mt = w >> 1;
        bf16x8 a[2];
#pragma unroll
        for (int ks = 0; ks < 2; ++ks) a[ks] = *(const LAS bf16x8*)(QIN + (16 * mt + fr) * 72 + 32 * ks + 8 * fq);
#pragma unroll
        for (int q = 0; q < 2; ++q) { const int nt = (w & 1) * 2 + q; f32x4 s = {0.f, 0.f, 0.f, 0.f};
#pragma unroll
            for (int ks = 0; ks < 2; ++ks) s = mma16(a[ks], *(const LAS bf16x8*)(KIN + (16 * nt + fr) * 72 + 32 * ks + 8 * fq), s);
#pragma unroll
            for (int r = 0; r < 4; ++r) { const int cc = 16 * mt + 4 * fq + r, ss = 16 * nt + fr; ATT[cc * 72 + ss] = f2bf(ss <= cc ? s[r] : 0.f); } }
    }
    __syncthreads();
    {
        const int mt = w >> 1, nt0 = (w & 1) * 4;
        bf16x8 aa[2], ak[2];
#pragma unroll
        for (int ks = 0; ks < 2; ++ks) { aa[ks] = *(const LAS bf16x8*)(ATT + (16 * mt + fr) * 72 + 32 * ks + 8 * fq); ak[ks] = *(const LAS bf16x8*)(KOT + (16 * mt + fr) * 72 + 32 * ks + 8 * fq); }
#pragma unroll
        for (int q = 0; q < 4; ++q) { const int nt = nt0 + q; f32x4 o = {0.f, 0.f, 0.f, 0.f}, kvv = {0.f, 0.f, 0.f, 0.f};
#pragma unroll
            for (int ks = 0; ks < 2; ++ks) { const bf16x8 bv = *(const LAS bf16x8*)(VT + (16 * nt + fr) * 72 + 32 * ks + 8 * fq); o = mma16(bv, aa[ks], o); kvv = mma16(ak[ks], bv, kvv); }
            *(u32x2*)(F.ointra() + (size_t)(t0 + 16 * mt + fr) * 512 + h * 128 + 16 * nt + 4 * fq) = (u32x2){cvt_pk_bf16(o[0], o[1]), cvt_pk_bf16(o[2], o[3])};
            *(u32x2*)(F.kvT() + ((size_t)unit * 128 + 16 * nt + fr) * 64 + 16 * mt + 4 * fq) = (u32x2){cvt_pk_bf16(kvv[0], kvv[1]), cvt_pk_bf16(kvv[2], kvv[3])}; }
    }
    __syncthreads();
}

__device__ __forceinline__ void gla_sscan_item(Frame& F, int item) {
    const int lane = F.lane, idx = item * 64 + lane, d4 = idx & 15, e = (idx >> 4) & 127, bh = idx >> 11;
    const bf16_t* kvp = F.kvT() + ((size_t)(bh * 32) * 128 + e) * 64 + d4 * 4; const float* dcp = F.decay() + (size_t)(bh * 32) * 64 + d4 * 4;
    bf16_t* sp = F.spT() + ((size_t)(bh * 32) * 128 + e) * 64 + d4 * 4;
    f32x4 S = {0.f, 0.f, 0.f, 0.f};
    for (int n0 = 0; n0 < 32; n0 += 8) { f32x4 kv[8], dc[8];
#pragma unroll
        for (int i = 0; i < 8; ++i) { const u32x2 kw = *(const u32x2*)(kvp + (size_t)(n0 + i) * 128 * 64); kv[i] = (f32x4){bflo(kw.x), bfhi(kw.x), bflo(kw.y), bfhi(kw.y)}; dc[i] = *(const f32x4*)(dcp + (size_t)(n0 + i) * 64); }
#pragma unroll
        for (int i = 0; i < 8; ++i) { u32x2 o; o.x = cvt_pk_bf16(S.x, S.y); o.y = cvt_pk_bf16(S.z, S.w); *(u32x2*)(sp + (size_t)(n0 + i) * 128 * 64) = o; S = dc[i] * S + kv[i]; } }
}
__device__ __forceinline__ void sgu_unit(Frame& F, int unit) {
    const int tid = F.tid, w = F.wave, lane = F.lane, fr = lane & 15, fq = lane >> 4, ch = unit >> 2, g = unit & 3, t0 = ch * 128;
    LAS f32x2* stat = (LAS f32x2*)F.lds; LAS bf16_t* vnT = (LAS bf16_t*)(F.lds + 1024);
    if (tid < 128) { const float* sp = (const float*)(F.A->ws + WS_SVS) + (size_t)(t0 + tid) * 16;
        const f32x4 a = *(const f32x4*)sp, b = *(const f32x4*)(sp + 4), c4 = *(const f32x4*)(sp + 8), d = *(const f32x4*)(sp + 12);
        const float s = (a.x + a.z) + (b.x + b.z) + (c4.x + c4.z) + (d.x + d.z), s2 = (a.y + a.w) + (b.y + b.w) + (c4.y + c4.w) + (d.y + d.w);
        const float mean = s * (1.f / 512.f), var = fmaxf(s2 * (1.f / 512.f) - mean * mean, 0.f);
        stat[tid] = (f32x2){mean, rsqrtf(var + EPS)}; }
    __syncthreads();
    { const int s = tid >> 2, c32 = (tid & 3) * 32; const f32x2 ms = stat[s];
#pragma unroll
        for (int q = 0; q < 4; ++q) { float v[8]; unpack8(*(const u32x4*)(F.p() + (size_t)(t0 + s) * PN + PC_SV + g * 128 + c32 + 8 * q), v);
#pragma unroll
            for (int j = 0; j < 8; ++j) { const int cidx = g * 128 + c32 + 8 * q + j; vnT[(c32 + 8 * q + j) * 136 + s] = f2bf((v[j] - ms.x) * ms.y * F.A->in[I_SNG][cidx] + F.A->in[I_SNB][cidx]); } } }
    __syncthreads();
    f32x4 acc[8];
#pragma unroll
    for (int ct = 0; ct < 8; ++ct) acc[ct] = (f32x4){0.f, 0.f, 0.f, 0.f};
    const int nks = (16 * w + 15) / 32 + 1;
    for (int ks = 0; ks < nks; ++ks) { const bf16x8 bw = *(const bf16x8*)(F.sguw() + (size_t)(g * 128 + 16 * w + fr) * 128 + 32 * ks + 8 * fq);
#pragma unroll
        for (int ct = 0; ct < 8; ++ct) acc[ct] = mma16(*(const LAS bf16x8*)(vnT + (16 * ct + fr) * 136 + 32 * ks + 8 * fq), bw, acc[ct]); }
    {
        const int t = 16 * w + fr; const float bias = F.A->in[I_SB][g * 128 + t];
        u32x2 uv[8];
#pragma unroll
        for (int ct = 0; ct < 8; ++ct) uv[ct] = *(const u32x2*)(F.p() + (size_t)(t0 + t) * PN + PC_U + g * 128 + 16 * ct + 4 * fq);
#pragma unroll
        for (int ct = 0; ct < 8; ++ct) { const int cidx = g * 128 + 16 * ct + 4 * fq; const u32x2 uu = uv[ct];
            u32x2 o; o.x = cvt_pk_bf16(bflo(uu.x) * (acc[ct][0] + bias), bfhi(uu.x) * (acc[ct][1] + bias)); o.y = cvt_pk_bf16(bflo(uu.y) * (acc[ct][2] + bias), bfhi(uu.y) * (acc[ct][3] + bias));
            *(u32x2*)(F.oab() + (size_t)(t0 + t) * D + 512 + cidx) = o; } }
    __syncthreads();
}
__device__ __forceinline__ void gla_out_item(Frame& F, int item) {
    const int lane = F.lane, fr = lane & 15, fq = lane >> 4, unit = item >> 2, mt = item & 3;
    const int bh = unit >> 5, n = unit & 31, b = bh >> 2, h = bh & 3; const size_t t = (size_t)b * SEQ + n * 64 + 16 * mt + fr;
    bf16x8 qf[2];
#pragma unroll
    for (int ks = 0; ks < 2; ++ks) qf[ks] = *(const bf16x8*)(F.qin() + t * 256 + h * 64 + 32 * ks + 8 * fq);
    const bf16_t* sp = F.spT() + (size_t)unit * 128 * 64;
    f32x4 o[8]; float ss = 0.f;
#pragma unroll
    for (int et = 0; et < 8; ++et) { const u32x2 ow = *(const u32x2*)(F.ointra() + t * 512 + h * 128 + 16 * et + 4 * fq); f32x4 acc = {bflo(ow.x), bfhi(ow.x), bflo(ow.y), bfhi(ow.y)};
#pragma unroll
        for (int ks = 0; ks < 2; ++ks) acc = mma16(*(const bf16x8*)(sp + (size_t)(16 * et + fr) * 64 + 32 * ks + 8 * fq), qf[ks], acc);
        o[et] = acc; ss += (acc[0] * acc[0] + acc[1] * acc[1]) + (acc[2] * acc[2] + acc[3] * acc[3]); }
    ss += __shfl_xor(ss, 16); ss += __shfl_xor(ss, 32);
    const float rstd = rsqrtf(ss * (1.f / 128.f) + EPS);
    f32x4 gv[8]; u32x2 rv[8];
#pragma unroll
    for (int et = 0; et < 8; ++et) { const int e = h * 128 + 16 * et + 4 * fq; gv[et] = *(const f32x4*)(F.A->in[I_GOUTG] + e); rv[et] = *(const u32x2*)(F.p() + t * PN + PC_R + e); }
#pragma unroll
    for (int et = 0; et < 8; ++et) { const int e = h * 128 + 16 * et + 4 * fq; const f32x4 g = gv[et];
        const u32x2 rr = rv[et]; const float r0 = bflo(rr.x), r1 = bfhi(rr.x), r2 = bflo(rr.y), r3 = bfhi(rr.y);
        u32x2 ov; ov.x = cvt_pk_bf16(o[et][0] * rstd * g.x * r0 * sigmoidf_(r0), o[et][1] * rstd * g.y * r1 * sigmoidf_(r1));
        ov.y = cvt_pk_bf16(o[et][2] * rstd * g.z * r2 * sigmoidf_(r2), o[et][3] * rstd * g.w * r3 * sigmoidf_(r3));
        *(u32x2*)(F.oab() + t * D + e) = ov; }
}

struct ProbSeg {
    static constexpr bool GATHER = false, FP8 = false; static constexpr int WSCALE = FP8_WSCALE;
    int K, lda, ldb, G, c; const bf16_t *oab, *Wpab_t;
    __device__ __forceinline__ bool next(int i, Unit& u) const { const int L = (i >> 1) * G + c; if (L >= 256) return false; pg8::map_tile(L, 64, 4, u.pm, u.pn); u.aux = i & 1; return true; }
    __device__ __forceinline__ const char* a_base(const Unit& u) const { return (const char*)(oab + (size_t)u.pm * 256 * D + u.aux * 512); }
    __device__ __forceinline__ const char* b_base(const Unit& u) const { return (const char*)(Wpab_t + (size_t)u.pn * 256 * D + u.aux * 512); }
    __device__ __forceinline__ unsigned a_off(const Unit&, int row, int C) const { return (unsigned)(row * D + C) * 2u; }
};
struct EpiMix {
    static constexpr bool MID = false, STAGE = false;
    const bf16_t* p; bf16_t* mix;
    __device__ __forceinline__ void operator()(const f32x4 (&acc)[2][2][4][2], const Unit& u, int wr, int wc, int fr, int fq) const {
        asm volatile("" : "+v"(fr), "+v"(fq));
        const int row0 = u.pm * 256 + wr * 64 + fr, col0 = u.pn * 256 + wc * 32 + 8 * fq, gc = u.aux ? PC_GB : PC_GA;
#pragma unroll
        for (int ai = 0; ai < 2; ++ai) {
            u32x4 gw[4][2], pw[4][2];
#pragma unroll
            for (int m = 0; m < 4; ++m)
#pragma unroll
                for (int bj = 0; bj < 2; ++bj) { const size_t row = (size_t)(row0 + ai * 128 + m * 16);
                    gw[m][bj] = *(const u32x4*)(p + row * PN + gc + col0 + bj * 128);
                    pw[m][bj] = u.aux ? *(const u32x4*)(mix + row * D + col0 + bj * 128) : (u32x4){0u, 0u, 0u, 0u}; }
#pragma unroll
            for (int m = 0; m < 4; ++m)
#pragma unroll
                for (int bj = 0; bj < 2; ++bj) { const size_t row = (size_t)(row0 + ai * 128 + m * 16); float g[8], pv[8], v[8]; unpack8(gw[m][bj], g); unpack8(pw[m][bj], pv);
#pragma unroll
                    for (int j = 0; j < 4; ++j) { v[j] = acc[ai][bj][m][0][j] * g[j] + pv[j]; v[4 + j] = acc[ai][bj][m][1][j] * g[4 + j] + pv[4 + j]; }
                    *(u32x4*)(mix + row * D + col0 + bj * 128) = pack8(v); } }
    }
};

struct EpiMix2 {
    static constexpr bool MID = true, STAGE = false;
    const bf16_t* p; bf16_t* mix;
    __device__ __forceinline__ void mid(f32x4 (&acc)[2][2][4][2], const Unit& u, int wr, int wc, int fr, int fq) const {
        asm volatile("" : "+v"(fr), "+v"(fq));
        const int row0 = u.pm * 256 + wr * 64 + fr, col0 = u.pn * 256 + wc * 32 + 8 * fq;
#pragma unroll
        for (int ai = 0; ai < 2; ++ai) { u32x4 ga[4][2], gb[4][2];
#pragma unroll
            for (int m = 0; m < 4; ++m)
#pragma unroll
                for (int bj = 0; bj < 2; ++bj) { const size_t row = (size_t)(row0 + ai * 128 + m * 16); ga[m][bj] = *(const u32x4*)(p + row * PN + PC_GA + col0 + bj * 128); gb[m][bj] = *(const u32x4*)(p + row * PN + PC_GB + col0 + bj * 128); }
#pragma unroll
            for (int m = 0; m < 4; ++m)
#pragma unroll
                for (int bj = 0; bj < 2; ++bj) { float a[8], b[8]; unpack8(ga[m][bj], a); unpack8(gb[m][bj], b);
#pragma unroll
                    for (int j = 0; j < 4; ++j) { acc[ai][bj][m][0][j] *= a[j] * __builtin_amdgcn_rcpf(fmaxf(b[j], 1e-20f)); acc[ai][bj][m][1][j] *= a[4 + j] * __builtin_amdgcn_rcpf(fmaxf(b[4 + j], 1e-20f)); } } }
    }
    __device__ __forceinline__ void operator()(const f32x4 (&acc)[2][2][4][2], const Unit& u, int wr, int wc, int fr, int fq) const {
        asm volatile("" : "+v"(fr), "+v"(fq));
        const int row0 = u.pm * 256 + wr * 64 + fr, col0 = u.pn * 256 + wc * 32 + 8 * fq;
#pragma unroll
        for (int ai = 0; ai < 2; ++ai) { u32x4 gb[4][2];
#pragma unroll
            for (int m = 0; m < 4; ++m)
#pragma unroll
                for (int bj = 0; bj < 2; ++bj) gb[m][bj] = *(const u32x4*)(p + (size_t)(row0 + ai * 128 + m * 16) * PN + PC_GB + col0 + bj * 128);
#pragma unroll
            for (int m = 0; m < 4; ++m)
#pragma unroll
                for (int bj = 0; bj < 2; ++bj) { float b[8], v[8]; unpack8(gb[m][bj], b);
#pragma unroll
                    for (int j = 0; j < 4; ++j) { v[j] = acc[ai][bj][m][0][j] * fmaxf(b[j], 1e-20f); v[4 + j] = acc[ai][bj][m][1][j] * fmaxf(b[4 + j], 1e-20f); }
                    *(u32x4*)(mix + (size_t)(row0 + ai * 128 + m * 16) * D + col0 + bj * 128) = pack8(v); } }
    }
};

template <bool Q8 = false, int WS_ = FP8_WSCALE> struct ProbStdT {
    static constexpr bool GATHER = false, FP8 = Q8; static constexpr int WSCALE = WS_, EB = Q8 ? 1 : 2;
    int K, lda, ldb, G, c; const void *A, *Bt;
    __device__ __forceinline__ bool next(int i, Unit& u) const { const int L = i * G + c; if (L >= 256) return false; pg8::map_tile(L, 64, 4, u.pm, u.pn); u.aux = 0; return true; }
    __device__ __forceinline__ const char* a_base(const Unit& u) const { return (const char*)A + (size_t)u.pm * 256 * D * EB; }
    __device__ __forceinline__ const char* b_base(const Unit& u) const { return (const char*)Bt + (size_t)u.pn * 256 * D * EB; }
    __device__ __forceinline__ unsigned a_off(const Unit&, int row, int C) const { return (unsigned)(row * D * EB + C * 2); }
};
typedef ProbStdT<false> ProbStd;
template <bool RESF32> struct EpiRes {
    static constexpr bool MID = false, STAGE = false;
    const void* res; bf16_t* outb; float* ssq; unsigned char* outq; const float* qgain;
    __device__ __forceinline__ void operator()(const f32x4 (&acc)[2][2][4][2], const Unit& u, int wr, int wc, int fr, int fq) const {
        asm volatile("" : "+v"(fr), "+v"(fq));
        const int row0 = u.pm * 256 + wr * 64 + fr, col0 = u.pn * 256 + wc * 32 + 8 * fq;
#pragma unroll
        for (int ai = 0; ai < 2; ++ai) {
            f32x4 rf[4][2][2]; u32x4 rb[4][2];
#pragma unroll
            for (int m = 0; m < 4; ++m)
#pragma unroll
                for (int bj = 0; bj < 2; ++bj) { const size_t off = (size_t)(row0 + ai * 128 + m * 16) * D + col0 + bj * 128;
                    if (RESF32) { rf[m][bj][0] = *(const f32x4*)((const float*)res + off); rf[m][bj][1] = *(const f32x4*)((const float*)res + off + 4); }
                    else rb[m][bj] = *(const u32x4*)((const bf16_t*)res + off); }
#pragma unroll
            for (int m = 0; m < 4; ++m) { const size_t row = (size_t)(row0 + ai * 128 + m * 16); float sq = 0.f;
#pragma unroll
                for (int bj = 0; bj < 2; ++bj) { float r[8], v[8];
                    if (RESF32) { r[0] = rf[m][bj][0].x; r[1] = rf[m][bj][0].y; r[2] = rf[m][bj][0].z; r[3] = rf[m][bj][0].w; r[4] = rf[m][bj][1].x; r[5] = rf[m][bj][1].y; r[6] = rf[m][bj][1].z; r[7] = rf[m][bj][1].w; }
                    else unpack8(rb[m][bj], r);
#pragma unroll
                    for (int j = 0; j < 4; ++j) { v[j] = acc[ai][bj][m][0][j] + r[j]; v[4 + j] = acc[ai][bj][m][1][j] + r[4 + j]; }
#pragma unroll
                    for (int j = 0; j < 8; ++j) sq += v[j] * v[j];
                    *(u32x4*)(outb + row * D + col0 + bj * 128) = pack8(v);
                    if (outq) *(u32x2*)(outq + row * D + col0 + bj * 128) = pack8_fp8(v); }
                sq += __shfl_xor(sq, 16); sq += __shfl_xor(sq, 32);
                if (fq == 0) ssq[row * 16 + u.pn * 4 + wc] = sq; } }
    }
};
__device__ __forceinline__ float row_rs(const float* ssq, size_t row) {
    const f32x4 a = *(const f32x4*)(ssq + row * 16), b = *(const f32x4*)(ssq + row * 16 + 4), c = *(const f32x4*)(ssq + row * 16 + 8), d = *(const f32x4*)(ssq + row * 16 + 12);
    const float s = ((a.x + a.y) + (a.z + a.w)) + ((b.x + b.y) + (b.z + b.w)) + ((c.x + c.y) + (c.z + c.w)) + ((d.x + d.y) + (d.z + d.w));
    return rsqrtf(s * (1.f / D) + EPS);
}
struct EpiScale {
    static constexpr bool MID = false, STAGE = false;
    const float* ssq; bf16_t* outb;
    __device__ __forceinline__ void operator()(const f32x4 (&acc)[2][2][4][2], const Unit& u, int wr, int wc, int fr, int fq) const {
        asm volatile("" : "+v"(fr), "+v"(fq));
        const int row0 = u.pm * 256 + wr * 64 + fr, col0 = u.pn * 256 + wc * 32 + 8 * fq;
        float rs[2][4];
#pragma unroll
        for (int ai = 0; ai < 2; ++ai)
#pragma unroll
            for (int m = 0; m < 4; ++m) rs[ai][m] = row_rs(ssq, (size_t)(row0 + ai * 128 + m * 16));
#pragma unroll
        for (int ai = 0; ai < 2; ++ai)
#pragma unroll
            for (int m = 0; m < 4; ++m) { const size_t row = (size_t)(row0 + ai * 128 + m * 16);
#pragma unroll
                for (int bj = 0; bj < 2; ++bj) { float v[8];
#pragma unroll
                    for (int j = 0; j < 4; ++j) { v[j] = acc[ai][bj][m][0][j] * rs[ai][m]; v[4 + j] = acc[ai][bj][m][1][j] * rs[ai][m]; }
                    *(u32x4*)(outb + row * D + col0 + bj * 128) = pack8(v); } }
    }
};

__device__ __forceinline__ void attn_unit(Frame& F, int unit) {
    const int tid = F.tid, w = F.wave, lane = F.lane, fr = lane & 15, fq = lane >> 4;
    const int b = unit >> 5, h = (unit >> 3) & 3, qb = unit & 7;
    const size_t tq = (size_t)b * SEQ + qb * 256 + 32 * w;
    LAS unsigned char* const bufs[2] = {F.lds, F.lds + 36864};
    const bf16_t* kg = F.kmem() + (size_t)(b * 256 + (tid >> 1)) * D + h * 256 + (tid & 1) * 32;
    const int kls = (tid >> 1) * 144 + (tid & 1) * 64;
    const bf16_t* vg = F.vt() + (size_t)(h * 256 + (tid >> 3)) * TM + b * 256 + (tid & 7) * 32;
    const int vls = (tid >> 3) * 528 + (tid & 7) * 64;
    u32x4 st[4];
#pragma unroll
    for (int i = 0; i < 4; ++i) st[i] = *(const u32x4*)(kg + 8 * i);
#pragma unroll
    for (int i = 0; i < 4; ++i) *(LAS u32x4*)(bufs[0] + kls + 16 * i) = st[i];
    __syncthreads();
    f32x4 s[16][2];
#pragma unroll
    for (int nt = 0; nt < 16; ++nt) { s[nt][0] = (f32x4){0.f, 0.f, 0.f, 0.f}; s[nt][1] = (f32x4){0.f, 0.f, 0.f, 0.f}; }
#pragma unroll
    for (int c = 0; c < 4; ++c) {
        if (c < 3) {
#pragma unroll
            for (int i = 0; i < 4; ++i) st[i] = *(const u32x4*)(kg + 64 * (c + 1) + 8 * i); }
        else {
#pragma unroll
            for (int i = 0; i < 4; ++i) st[i] = *(const u32x4*)(vg + 8 * i); }
        LAS unsigned char* kb = bufs[c & 1];
        bf16x8 qf[2][2];
#pragma unroll
        for (int qt = 0; qt < 2; ++qt)
#pragma unroll
            for (int ks = 0; ks < 2; ++ks) qf[qt][ks] = *(const bf16x8*)(F.q() + (tq + 16 * qt + fr) * D + h * 256 + 64 * c + 32 * ks + 8 * fq);
#pragma unroll
        for (int nt = 0; nt < 16; ++nt)
#pragma unroll
            for (int ks = 0; ks < 2; ++ks) { const bf16x8 a = *(const LAS bf16x8*)(kb + (16 * nt + fr) * 144 + (32 * ks + 8 * fq) * 2);
                s[nt][0] = mma16(a, qf[0][ks], s[nt][0]); s[nt][1] = mma16(a, qf[1][ks], s[nt][1]); }
        if (c < 3) {
#pragma unroll
            for (int i = 0; i < 4; ++i) *(LAS u32x4*)(bufs[(c + 1) & 1] + kls + 16 * i) = st[i]; }
        __syncthreads();
    }
#pragma unroll
    for (int i = 0; i < 4; ++i) *(LAS u32x4*)(bufs[0] + vls + 16 * i) = st[i];
    float inv[2]; bf16x8 pb[2][8];
#pragma unroll
    for (int qt = 0; qt < 2; ++qt) { float mx = s[0][qt][0];
#pragma unroll
        for (int nt = 0; nt < 16; ++nt)
#pragma unroll
            for (int r = 0; r < 4; ++r) mx = fmaxf(mx, s[nt][qt][r]);
        mx = fmaxf(mx, __shfl_xor(mx, 16)); mx = fmaxf(mx, __shfl_xor(mx, 32));
        float sum = 0.f;
#pragma unroll
        for (int nt = 0; nt < 16; ++nt)
#pragma unroll
            for (int r = 0; r < 4; ++r) { const float e = __expf(s[nt][qt][r] - mx); s[nt][qt][r] = e; sum += e; }
        sum += __shfl_xor(sum, 16); sum += __shfl_xor(sum, 32);
        inv[qt] = __builtin_amdgcn_rcpf(sum);
#pragma unroll
        for (int sk = 0; sk < 8; ++sk) { const float pv[8] = {s[2 * sk][qt][0], s[2 * sk][qt][1], s[2 * sk][qt][2], s[2 * sk][qt][3], s[2 * sk + 1][qt][0], s[2 * sk + 1][qt][1], s[2 * sk + 1][qt][2], s[2 * sk + 1][qt][3]};
            const u32x4 pk = pack8(pv); pb[qt][sk] = __builtin_bit_cast(bf16x8, pk); } }
    __syncthreads();
#pragma unroll
    for (int c = 0; c < 4; ++c) {
        if (c < 3) {
#pragma unroll
            for (int i = 0; i < 4; ++i) st[i] = *(const u32x4*)(vg + (size_t)64 * (c + 1) * TM + 8 * i); }
        LAS unsigned char* vb = bufs[c & 1];
#pragma unroll
        for (int dt = 0; dt < 4; ++dt) { f32x4 o0 = {0.f, 0.f, 0.f, 0.f}, o1 = {0.f, 0.f, 0.f, 0.f};
#pragma unroll
            for (int sk = 0; sk < 8; ++sk) { const LAS unsigned char* vp = vb + (16 * dt + fr) * 528 + (32 * sk + 4 * fq) * 2;
                const u32x2 lo = *(const LAS u32x2*)vp, hi = *(const LAS u32x2*)(vp + 32);
                const u32x4 av = {lo.x, lo.y, hi.x, hi.y}; const bf16x8 a = __builtin_bit_cast(bf16x8, av);
                o0 = mma16(a, pb[0][sk], o0); o1 = mma16(a, pb[1][sk], o1); }
            const int col = h * 256 + 64 * c + 16 * dt + 4 * fq;
            int w0 = 0, w1 = 0;
            w0 = __builtin_amdgcn_cvt_pk_fp8_f32(o0[0] * inv[0], o0[1] * inv[0], w0, false); w0 = __builtin_amdgcn_cvt_pk_fp8_f32(o0[2] * inv[0], o0[3] * inv[0], w0, true);
            w1 = __builtin_amdgcn_cvt_pk_fp8_f32(o1[0] * inv[1], o1[1] * inv[1], w1, false); w1 = __builtin_amdgcn_cvt_pk_fp8_f32(o1[2] * inv[1], o1[3] * inv[1], w1, true);
            *(int*)((unsigned char*)F.ao() + (tq + fr) * D + col) = w0; *(int*)((unsigned char*)F.ao() + (tq + 16 + fr) * D + col) = w1; }
        if (c < 3) {
#pragma unroll
            for (int i = 0; i < 4; ++i) *(LAS u32x4*)(bufs[(c + 1) & 1] + vls + 16 * i) = st[i]; }
        __syncthreads();
    }
}

__device__ __forceinline__ void router_item(Frame& F, int item) {
    const int w = F.wave, lane = F.lane, fr = lane & 15, fq = lane >> 4;
    const size_t t0 = (size_t)item * 16;
    LAS float* lg = (LAS float*)(F.lds + ROUTER_OFF) + w * (16 * 33 + 64);
    LAS int* ex = (LAS int*)(lg + 16 * 33);
    f32x4 acc[2] = {{0.f, 0.f, 0.f, 0.f}, {0.f, 0.f, 0.f, 0.f}};
    const float rsl = row_rs(F.ssq2(), t0 + fr);
    for (int k0 = 0; k0 < 32; k0 += 8) { bf16x8 a[8], b0[8], b1[8];
#pragma unroll
        for (int i = 0; i < 8; ++i) { a[i] = *(const bf16x8*)(F.x2b() + (t0 + fr) * D + 32 * (k0 + i) + 8 * fq);
            b0[i] = *(const bf16x8*)(F.Wr_t() + (size_t)fr * D + 32 * (k0 + i) + 8 * fq); b1[i] = *(const bf16x8*)(F.Wr_t() + (size_t)(16 + fr) * D + 32 * (k0 + i) + 8 * fq); }
#pragma unroll
        for (int i = 0; i < 8; ++i) { acc[0] = mma16(a[i], b0[i], acc[0]); acc[1] = mma16(a[i], b1[i], acc[1]);
            const int col = 32 * (k0 + i) + 8 * fq; const f32x4 g0 = *(const f32x4*)(F.A->in[I_NFFNG] + col), g1 = *(const f32x4*)(F.A->in[I_NFFNG] + col + 4);
            float xv[8]; unpack8(__builtin_bit_cast(u32x4, a[i]), xv);
            xv[0] *= rsl * g0.x; xv[1] *= rsl * g0.y; xv[2] *= rsl * g0.z; xv[3] *= rsl * g0.w; xv[4] *= rsl * g1.x; xv[5] *= rsl * g1.y; xv[6] *= rsl * g1.z; xv[7] *= rsl * g1.w;
            *(u32x2*)(F.x2q() + (t0 + fr) * D + col) = pack8_fp8(xv); } }
#pragma unroll
    for (int r = 0; r < 4; ++r)
#pragma unroll
        for (int nt = 0; nt < 2; ++nt) lg[(4 * fq + r) * 33 + 16 * nt + fr] = acc[nt][r];
    LDS_WAIT();
    float rs = 0.f, gk[4] = {0.f, 0.f, 0.f, 0.f};
    if (lane < 16) { const size_t t = t0 + lane; rs = row_rs(F.ssq2(), t);
        float v[32];
#pragma unroll
        for (int e = 0; e < 32; ++e) v[e] = lg[lane * 33 + e] * rs + F.A->in[I_BR][e];
        unsigned taken = 0u; float tv[4];
#pragma unroll
        for (int k = 0; k < 4; ++k) { float best = -INFINITY; int bi = 0;
#pragma unroll
            for (int e = 0; e < 32; ++e) { const bool ok = !((taken >> e) & 1u) && (v[e] > best); best = ok ? v[e] : best; bi = ok ? e : bi; }
            taken |= 1u << bi; tv[k] = best; ex[lane * 4 + k] = bi; }
        float sum = 0.f;
#pragma unroll
        for (int k = 0; k < 4; ++k) { gk[k] = __expf(tv[k] - tv[0]); sum += gk[k]; }
        const float inv = 1.f / sum;
        *(f32x4*)(F.gates() + t * 4) = (f32x4){gk[0] * inv, gk[1] * inv, gk[2] * inv, gk[3] * inv}; }
    LDS_WAIT();
    const int me = ex[lane]; const float my_rs = __shfl(rs, lane >> 2);
    int rank = 0, mytot = 0;
#pragma unroll
    for (int e = 0; e < 32; ++e) { const unsigned long long m = __ballot(me == e); const int below = __builtin_popcountll(m & ((1ull << lane) - 1ull));
        rank = (me == e) ? below : rank; mytot = (lane == e) ? __builtin_popcountll(m) : mytot; }
    unsigned base = 0u;
    if (lane < 32 && mytot > 0) base = atomicAdd(F.ctl + CW_CNT + lane, (unsigned)mytot);
    const unsigned slot = (unsigned)__shfl((int)base, me) + (unsigned)rank;
    F.list()[me * ECAP + slot] = (int)(t0 * 4 + lane); (void)my_rs;
    LDS_WAIT();
}

__device__ __forceinline__ void expert_tables(Frame& F) {
    LAS int* tab = (LAS int*)(F.lds + TAB_OFF);
    if (F.tid < 32) tab[F.tid] = (int)__hip_atomic_load(F.ctl + CW_CNT + F.tid, __ATOMIC_RELAXED, __HIP_MEMORY_SCOPE_AGENT);
    __syncthreads();
    if (F.tid == 0) { int s = 0; for (int e = 0; e < 32; ++e) { tab[32 + e] = s; s += (tab[e] + 255) >> 8; } tab[64] = s; }
    __syncthreads();
}
template <int NTN, bool GATH> struct ProbExp {
    static constexpr bool GATHER = GATH, gather = GATH, FP8 = true; static constexpr int WSCALE = FP8_WSCALE;
    int K, lda, ldb, G, c; const LAS int* tab; const unsigned char* A; const unsigned char* Bt; const int* list; mutable int ehint;
    __device__ __forceinline__ bool next(int i, Unit& u) const {
        const int L = i * G + c; if (L >= NTN * tab[64]) return false;
        int e = ehint;
#pragma unroll 1
        while (e < 31 && L >= NTN * tab[32 + e + 1]) ++e;
        ehint = e;
        const int r = L - NTN * tab[32 + e], mte = tab[32 + e + 1] - tab[32 + e];
        u.aux = e; u.pn = r / mte; u.pm = r % mte; return true;
    }
    __device__ __forceinline__ const char* a_base(const Unit& u) const { return gather ? (const char*)A : (const char*)(A + (size_t)(tab[32 + u.aux] + u.pm) * 256 * D); }
    __device__ __forceinline__ const char* b_base(const Unit& u) const { return (const char*)(Bt + ((size_t)u.aux * NTN + u.pn) * 256 * D); }
    __device__ __forceinline__ unsigned a_off(const Unit& u, int row, int C) const {
        if (!gather) return (unsigned)(row * D + C * 2);
        const int slot = u.pm * 256 + row; const int av = list[u.aux * ECAP + slot];
        const int a = slot < tab[u.aux] ? av : 0;
        return (unsigned)((a >> 2) * D + C * 2);
    }
};
struct EpiE1 {
    static constexpr bool MID = false, STAGE = true;
    const LAS int* tab; const float* lscale; const float* b1; unsigned char* act;
    __device__ __forceinline__ void stage(const Unit& u, int wid, int lane, LAS unsigned char* lds) const {
        if (wid < 4) { const float* src = b1 + (size_t)u.aux * 2048 + ((wid & 2) ? 1024 : 0) + u.pn * 128 + (wid & 1) * 64 + lane;
            __builtin_amdgcn_global_load_lds((const unsigned*)src, (LAS unsigned*)(lds + EPI_OFF + wid * 256), 4, 0, 0); }
    }
    __device__ __forceinline__ void operator()(const f32x4 (&acc)[2][2][4][2], const Unit& u, int wr, int wc, int fr, int fq) const {
        asm volatile("" : "+v"(fr), "+v"(fq));
        const int e = u.aux; const size_t rbase = (size_t)(tab[32 + e] + u.pm) * 256;
        const int j0 = u.pn * 128 + wc * 32 + 8 * fq;
        const LAS float* bp = (const LAS float*)((const LAS unsigned char*)tab - TAB_OFF + EPI_OFF) + wc * 32 + 8 * fq;
        const f32x4 bg0 = *(const LAS f32x4*)bp, bg1 = *(const LAS f32x4*)(bp + 4), bl0 = *(const LAS f32x4*)(bp + 128), bl1 = *(const LAS f32x4*)(bp + 132);
        const float bg[8] = {bg0.x, bg0.y, bg0.z, bg0.w, bg1.x, bg1.y, bg1.z, bg1.w}, bl[8] = {bl0.x, bl0.y, bl0.z, bl0.w, bl1.x, bl1.y, bl1.z, bl1.w};
#pragma unroll
        for (int ai = 0; ai < 2; ++ai)
#pragma unroll
            for (int m = 0; m < 4; ++m) { const int rt = ai * 128 + wr * 64 + m * 16 + fr; float v[8];
#pragma unroll
                for (int jp = 0; jp < 4; ++jp) {
                    const f32x2 ag = {acc[ai][0][m][jp >> 1][2 * (jp & 1)], acc[ai][0][m][jp >> 1][2 * (jp & 1) + 1]}, al = {acc[ai][1][m][jp >> 1][2 * (jp & 1)], acc[ai][1][m][jp >> 1][2 * (jp & 1) + 1]};
                    const f32x2 bg2 = {bg[2 * jp], bg[2 * jp + 1]}, bl2 = {bl[2 * jp], bl[2 * jp + 1]};
                    const f32x2 ga = ag + bg2, la = al + bl2;
                    const f32x2 glu = {fminf(ga.x, 7.0f), fminf(ga.y, 7.0f)}, lin = {fminf(fmaxf(la.x, -7.0f), 7.0f), fminf(fmaxf(la.y, -7.0f), 7.0f)};
                    const f32x2 t = glu * (-1.702f * 1.4426950408889634f);
                    const f32x2 d = (f32x2){__builtin_amdgcn_exp2f(t.x), __builtin_amdgcn_exp2f(t.y)} + 1.0f;
                    const f32x2 r = {__builtin_amdgcn_rcpf(d.x), __builtin_amdgcn_rcpf(d.y)};
                    const f32x2 o = ((lin + 1.0f) * glu) * r;
                    v[2 * jp] = o.x; v[2 * jp + 1] = o.y; }
                *(u32x2*)(act + (rbase + rt) * D + j0) = pack8_fp8(v); }
    }
};
struct EpiE2 {
    static constexpr bool MID = false, STAGE = true;
    const LAS int* tab; const int* list; const float* b2; unsigned char* yb; unsigned char* dummy;
    __device__ __forceinline__ void stage(const Unit& u, int wid, int lane, LAS unsigned char* lds) const {
        const unsigned* src = (wid < 4) ? (const unsigned*)(b2 + (size_t)u.aux * D + u.pn * 256 + wid * 64 + lane) : (const unsigned*)(list + u.aux * ECAP + u.pm * 256 + (wid - 4) * 64 + lane);
        __builtin_amdgcn_global_load_lds(src, (LAS unsigned*)(lds + EPI_OFF + wid * 256), 4, 0, 0);
    }
    __device__ __forceinline__ void operator()(const f32x4 (&acc)[2][2][4][2], const Unit& u, int wr, int wc, int fr, int fq) const {
        asm volatile("" : "+v"(fr), "+v"(fq));
        const int e = u.aux, cnt = tab[e]; const int col0 = u.pn * 256 + wc * 32 + 8 * fq;
        const LAS float* sb = (const LAS float*)((const LAS unsigned char*)tab - TAB_OFF + EPI_OFF); const LAS int* sl = (const LAS int*)(sb + 256);
        float bb[2][8];
#pragma unroll
        for (int bj = 0; bj < 2; ++bj) { const f32x4 x0 = *(const LAS f32x4*)(sb + bj * 128 + wc * 32 + 8 * fq), x1 = *(const LAS f32x4*)(sb + bj * 128 + wc * 32 + 8 * fq + 4);
            bb[bj][0] = x0.x; bb[bj][1] = x0.y; bb[bj][2] = x0.z; bb[bj][3] = x0.w; bb[bj][4] = x1.x; bb[bj][5] = x1.y; bb[bj][6] = x1.z; bb[bj][7] = x1.w; }
        int aidx[2][4];
#pragma unroll
        for (int ai = 0; ai < 2; ++ai)
#pragma unroll
            for (int m = 0; m < 4; ++m) aidx[ai][m] = sl[ai * 128 + wr * 64 + m * 16 + fr];
#pragma unroll
        for (int ai = 0; ai < 2; ++ai)
#pragma unroll
            for (int m = 0; m < 4; ++m) { const int slot = u.pm * 256 + ai * 128 + wr * 64 + m * 16 + fr;
                unsigned char* rowp = (slot < cnt) ? yb + (size_t)aidx[ai][m] * D : dummy;
#pragma unroll
                for (int bj = 0; bj < 2; ++bj) { float v[8];
#pragma unroll
                    for (int j = 0; j < 4; ++j) { v[j] = acc[ai][bj][m][0][j] + bb[bj][j]; v[4 + j] = acc[ai][bj][m][1][j] + bb[bj][4 + j]; }
                    *(u32x2*)(rowp + col0 + bj * 128) = pack8_fp8(v); } }
    }
};

struct CombTok { u32x4 x[2]; u32x2 y[2][4]; f32x4 g; };
__device__ __forceinline__ void comb_load(Frame& F, int t, int lane, CombTok& c) {
    c.g = *(const f32x4*)(F.gates() + (size_t)t * 4);
#pragma unroll
    for (int hf = 0; hf < 2; ++hf) { const int col = hf * 512 + lane * 8; c.x[hf] = *(const u32x4*)(F.x2b() + (size_t)t * D + col);
#pragma unroll
        for (int k = 0; k < 4; ++k) c.y[hf][k] = *(const u32x2*)((const unsigned char*)F.yb() + ((size_t)t * 4 + k) * D + col); }
}
__device__ __forceinline__ void comb_finish(Frame& F, int t, int lane, const CombTok& c) {
    const float gk[4] = {c.g.x, c.g.y, c.g.z, c.g.w}; float x[2][8]; float ss = 0.f;
#pragma unroll
    for (int hf = 0; hf < 2; ++hf) { unpack8(c.x[hf], x[hf]);
#pragma unroll
        for (int k = 0; k < 4; ++k) { float y[8]; unpack8_fp8(c.y[hf][k], y);
#pragma unroll
            for (int j = 0; j < 8; ++j) x[hf][j] += gk[k] * y[j]; }
#pragma unroll
        for (int j = 0; j < 8; ++j) ss += x[hf][j] * x[hf][j]; }
    const float rs = rsqrtf(wave_sum(ss) * (1.f / D) + EPS);
#pragma unroll
    for (int hf = 0; hf < 2; ++hf) { const int col = hf * 512 + lane * 8; const f32x4 g0 = *(const f32x4*)(F.A->in[I_NFING] + col), g1 = *(const f32x4*)(F.A->in[I_NFING] + col + 4);
        *(f32x4*)(F.A->out + (size_t)t * D + col) = (f32x4){x[hf][0] * rs * g0.x, x[hf][1] * rs * g0.y, x[hf][2] * rs * g0.z, x[hf][3] * rs * g0.w};
        *(f32x4*)(F.A->out + (size_t)t * D + col + 4) = (f32x4){x[hf][4] * rs * g1.x, x[hf][5] * rs * g1.y, x[hf][6] * rs * g1.z, x[hf][7] * rs * g1.w}; }
}
__device__ __forceinline__ void combine_rows(Frame& F) {
    const int gw = F.vcu * 8 + F.wave, NGW = F.G * 8, lane = F.lane;
    if (gw >= T) return;
    CombTok ca, cb; comb_load(F, gw, lane, ca);
    for (int t = gw;;) {
        const bool hb = t + NGW < T; if (hb) comb_load(F, t + NGW, lane, cb);
        comb_finish(F, t, lane, ca); if (!hb) break;
        const bool ha = t + 2 * NGW < T; if (ha) comb_load(F, t + 2 * NGW, lane, ca);
        comb_finish(F, t + NGW, lane, cb); if (!ha) break;
        t += 2 * NGW; }
}

#ifndef DBG_OUT
#define DBG_OUT 0
#endif
#if DBG_OUT
__device__ __forceinline__ void dbg_rows(Frame& F) {
    const int gw = F.vcu * 8 + F.wave, NGW = F.G * 8, lane = F.lane;
    for (int t = gw; t < T; t += NGW) {
#pragma unroll
        for (int hf = 0; hf < 2; ++hf) { const int col = hf * 512 + lane * 8; float x[8];
#pragma unroll
            for (int j = 0; j < 8; ++j) x[j] = 0.f;
            if (DBG_OUT == 1) { for (int m = 0; m < 5; ++m) { if (col + 1024 * m < PN) { float y[8]; unpack8(*(const u32x4*)(F.p() + (size_t)t * PN + col + 1024 * m), y);
#pragma unroll
                for (int j = 0; j < 8; ++j) x[j] += y[j]; } } }
            else if (DBG_OUT == 8) { for (int k = 0; k < 4; ++k) { float y[8]; unpack8_fp8(*(const u32x2*)((const unsigned char*)F.yb() + ((size_t)t * 4 + k) * D + col), y); const float g = F.gates()[t * 4 + k];
#pragma unroll
                for (int j = 0; j < 8; ++j) x[j] += g * y[j]; } }
            else { const bf16_t* B = DBG_OUT == 2 ? F.oab() : DBG_OUT == 3 ? F.mix() : DBG_OUT == 4 ? F.x1b() : DBG_OUT == 5 ? F.q() : DBG_OUT == 6 ? F.ao() : F.x2b();
                unpack8(*(const u32x4*)(B + (size_t)t * D + col), x); }
#pragma unroll
            for (int j = 0; j < 8; ++j) if (!(fabsf(x[j]) < 1e30f)) x[j] = 1e6f;
            *(f32x4*)(F.A->out + (size_t)t * D + col) = (f32x4){x[0], x[1], x[2], x[3]};
            *(f32x4*)(F.A->out + (size_t)t * D + col + 4) = (f32x4){x[4], x[5], x[6], x[7]}; }
    }
}
#endif

__global__ void __launch_bounds__(512, 2) fwd_kernel(Args args) {
    extern __shared__ __attribute__((aligned(16))) unsigned char lds[];
    Frame F;
    F.lds = (LAS unsigned char*)lds; F.MISC = (volatile LAS unsigned*)(F.lds + MISC_OFF);
    F.tid = threadIdx.x; F.lane = F.tid & 63; F.wave = __builtin_amdgcn_readfirstlane(F.tid >> 6);
    F.G = gridDim.x; { const int bx = blockIdx.x; F.vcu = (F.G % 8 == 0) ? (bx % 8) * (F.G / 8) + bx / 8 : bx; }
    F.ctl = (unsigned*)(args.ws + WS_CTL);
    F.A = &args;
    for (int u = F.tid; u < 64; u += 512) ((LAS unsigned*)(F.lds + MISC_OFF))[u] = 0u;
    __syncthreads();
    XcdBarrier bar; bar.bar = F.ctl + CW_BAR; bar.x = 0; bar.st = nullptr;
    if (!MK_PER_PHASE) bar = xcd_barrier_post(F.ctl + CW_BAR, F.MISC + 8);
    const int lo = args.ph_lo, hi = args.ph_hi;
#ifndef PH_MASK
#define PH_MASK 0x3fff
#endif
#define IN(k) (((PH_MASK >> (k)) & 1) && lo <= (k) && (k) < hi)
#ifndef DOUBLE_MASK
#define DOUBLE_MASK 0
#endif
#define REP(k) for (int _rep = 0; _rep < ((((DOUBLE_MASK) >> (k)) & 1) ? 2 : 1); ++_rep, ((((DOUBLE_MASK) >> (k)) & 1) && _rep == 1 ? xcd_barrier(bar) : (void)0))
#define SEAM(k) do { if (IN(k) && IN((k) + 1)) xcd_barrier(bar); } while (0)
    const int c = (int)blockIdx.x;

    if (IN(0)) REP(0) { p0_prologue(F); } SEAM(0);
    if (IN(1)) REP(1) { ProbP1 P{D, D, ProbP1::EB * D, F.G, c, args.ws}; EpiP1 E{args.ws}; pg8::gemm_phase(F.lds, P, E); } SEAM(1);
    if (IN(2)) REP(2) { for (int u = F.vcu; u < 1024; u += F.G) gla_a_unit(F, u); } SEAM(2);
    if (IN(3)) REP(3) { cvt_range(F, CVT_LATE, CVT_EXPERT);
                        if (F.wave < 4) for (int it = F.vcu * 4 + F.wave; it < 1024; it += F.G * 4) gla_sscan_item(F, it);
                        for (int u = F.vcu; u < 512; u += F.G) sgu_unit(F, u); } SEAM(3);
    if (IN(4)) REP(4) { for (int it = F.vcu * 8 + F.wave; it < 4096; it += F.G * 8) gla_out_item(F, it); } SEAM(4);
    if (IN(5)) REP(5) { ProbStd P{D, D, 2 * D, F.G, c, F.oab(), F.Wpab_t()}; EpiMix2 E{F.p(), F.mix()}; pg8::gemm_phase(F.lds, P, E); } SEAM(5);
    if (IN(6)) REP(6) { ProbStd P{D, D, 2 * D, F.G, c, F.mix(), F.Wmo_t()}; EpiRes<true> E{(const void*)F.A->in[I_X], F.x1b(), F.ssq1(), F.x1q(), nullptr}; pg8::gemm_phase(F.lds, P, E); } SEAM(6);
    if (IN(7)) REP(7) { ProbStdT<true, 0x75757575> P{D, D, D, F.G, c, F.x1q(), F.Wq_t()}; EpiScale E{F.ssq1(), F.q()};     pg8::gemm_phase(F.lds, P, E); } SEAM(7);
    if (IN(8)) REP(8) { for (int u = F.vcu; u < 256; u += F.G) attn_unit(F, u); } SEAM(8);
    if (IN(9)) REP(9) { ProbStdT<true> P{D, D, D, F.G, c, F.ao(), F.Wo_t()}; EpiRes<false> E{(const void*)F.x1b(), F.x2b(), F.ssq2(), nullptr, nullptr}; pg8::gemm_phase(F.lds, P, E); } SEAM(9);
    if (IN(10)) REP(10) { for (int it = F.wave * F.G + F.vcu; it < 1024; it += 8 * F.G) router_item(F, it); cvt_expert_dma(F); } SEAM(10);
    if (IN(11)) REP(11) { expert_tables(F); const LAS int* tab = (const LAS int*)(F.lds + TAB_OFF);
        ProbExp<8, true> P{D, D, D, F.G, F.vcu, tab, F.x2q(), (const unsigned char*)F.W1_t(), F.list(), 0}; EpiE1 E{tab, F.lscale(), F.A->in[I_BE1], (unsigned char*)F.act()}; pg8::gemm_phase(F.lds, P, E); } SEAM(11);
    if (IN(12)) REP(12) { expert_tables(F); const LAS int* tab = (const LAS int*)(F.lds + TAB_OFF);
        ProbExp<4, false> P{D, D, D, F.G, F.vcu, tab, (const unsigned char*)F.act(), (const unsigned char*)F.W2_t(), F.list(), 0}; EpiE2 E{tab, F.list(), F.A->in[I_BE2], (unsigned char*)F.yb(), (unsigned char*)(args.ws + WS_CTL + 512 * 1024)}; pg8::gemm_phase(F.lds, P, E); } SEAM(12);
#if DBG_OUT
    if (lo <= 13 && 13 < hi) { dbg_rows(F); }
#else
    if (IN(13)) REP(13) { combine_rows(F); }
#endif
#undef IN
#undef SEAM
}

extern "C" void kernel_launch(void* const* d_in, const int* in_sizes, int n_in, void* d_out, int out_size, void* d_ws, size_t ws_size, hipStream_t stream) {
    static int grid = 0;
    if (grid == 0) {
        if (n_in != 28 || in_sizes[0] != T * D || out_size != T * D || ws_size < WS_END) { fprintf(stderr, "kernel_launch: unexpected problem (n_in %d, in0 %d, out %d, ws %zu); nothing launched\n", n_in, n_in > 0 ? in_sizes[0] : -1, out_size, ws_size); grid = -1; return; }
        int dev = 0, cus = 0, per_cu = 0;
        if (hipGetDevice(&dev) != hipSuccess || hipDeviceGetAttribute(&cus, hipDeviceAttributeMultiprocessorCount, dev) != hipSuccess) { grid = -1; return; }
        if (hipFuncSetAttribute((const void*)fwd_kernel, hipFuncAttributeMaxDynamicSharedMemorySize, LDS_BYTES) != hipSuccess) { fprintf(stderr, "kernel_launch: hipFuncSetAttribute failed\n"); grid = -1; return; }
        if (hipOccupancyMaxActiveBlocksPerMultiprocessor(&per_cu, (const void*)fwd_kernel, 512, LDS_BYTES) != hipSuccess || per_cu < 1) fprintf(stderr, "kernel_launch: occupancy query reports %d blocks per CU\n", per_cu);
        (void)hipGetLastError();
        grid = cus;
    }
    if (grid < 0) return;
    if (hipMemsetAsync((char*)d_ws + WS_CTL, 0, CTL_ZERO_BYTES, stream) != hipSuccess) { fprintf(stderr, "kernel_launch: memset failed\n"); return; }
    Args a{};
    for (int i = 0; i < 28; ++i) a.in[i] = (const float*)d_in[i];
    a.out = (float*)d_out; a.ws = (unsigned char*)d_ws;
#if MK_PER_PHASE
    for (int ph = 0; ph < NPHASE; ++ph) { a.ph_lo = ph; a.ph_hi = ph + 1; hipLaunchKernelGGL(fwd_kernel, dim3(grid), dim3(512), LDS_BYTES, stream, a); }
#else
    a.ph_lo = 0; a.ph_hi = NPHASE;
    hipLaunchKernelGGL(fwd_kernel, dim3(grid), dim3(512), LDS_BYTES, stream, a);
#endif
}
```

```cpp
#include <hip/hip_runtime.h>
#include <cstdio>
#include <cstdint>

#ifndef P1_FP8
#define P1_FP8 0
#endif
#ifndef MK_PER_PHASE
#define MK_PER_PHASE 0
#endif

#define LAS __attribute__((address_space(3)))
#define GAS __attribute__((address_space(1)))
typedef unsigned short bf16_t;
typedef short bf16x8 __attribute__((ext_vector_type(8)));
typedef float f32x4 __attribute__((ext_vector_type(4)));
typedef float f32x2 __attribute__((ext_vector_type(2)));
typedef unsigned u32x4 __attribute__((ext_vector_type(4)));
typedef unsigned u32x2 __attribute__((ext_vector_type(2)));
typedef int i32x4 __attribute__((ext_vector_type(4)));
typedef int i32x8 __attribute__((ext_vector_type(8)));
#define FP8_WSCALE 0x79797979
constexpr float FP8_WMUL = 64.0f;
typedef GAS unsigned gu32;

constexpr int T = 16384, D = 1024, NBATCH = 8, SEQ = 2048, MEMLEN = 256, TM = NBATCH * MEMLEN;
constexpr int INC = 4624;
constexpr int PN = 4864;
constexpr int PC_Q = 0, PC_K = 256, PC_V = 512, PC_R = 1024, PC_U = 1536, PC_SV = 2048, PC_GA = 2560, PC_GB = 3584, PC_A = 4608;
constexpr int OFF_A = 1536;
constexpr int NE = 32, NASG = T * 4, ECAP = 16384;
constexpr float EPS = 1e-5f;
constexpr int NPHASE = 14;

constexpr size_t MiB = 1u << 20;
constexpr size_t WS_CTL = 0, CTL_ZERO_BYTES = 1 * MiB;
constexpr size_t WS_WR = 1 * MiB, WS_SGUW = 1 * MiB + 256 * 1024, WS_DECAY = 1 * MiB + 512 * 1024;
constexpr size_t WS_WIN = 2 * MiB, WS_WK = 12 * MiB, WS_WV = 14 * MiB, WS_WPAB = 16 * MiB, WS_WMO = 18 * MiB, WS_WQ = 20 * MiB, WS_WO = 22 * MiB;
constexpr size_t WS_SSQ1 = 24 * MiB, WS_SSQ2 = 25 * MiB, WS_LIST = 26 * MiB, WS_LSCALE = 28 * MiB, WS_GATES = 30 * MiB;
constexpr size_t WS_W1 = 32 * MiB, WS_W2 = 160 * MiB, WS_H = 224 * MiB, WS_MEMN = 256 * MiB, WS_KMEM = 260 * MiB, WS_VT = 264 * MiB, WS_QIN = 268 * MiB;
constexpr size_t WS_OINTRA = 276 * MiB, WS_KVT = 308 * MiB, WS_OAB = 340 * MiB, WS_MIX = 372 * MiB, WS_X1B = 404 * MiB, WS_Q = 436 * MiB, WS_AO = 468 * MiB, WS_X2B = 500 * MiB;
constexpr size_t WS_P = 532 * MiB, WS_ACT = 684 * MiB, WS_YB = 828 * MiB, WS_SPT = 956 * MiB, WS_X2Q = 972 * MiB, WS_X1Q = 988 * MiB, WS_SVS = 1004 * MiB, WS_END = 1005 * MiB;
static_assert(WS_P + (size_t)T * PN * 2 <= WS_ACT && WS_ACT + (size_t)(NASG + NE * 256) * 1024 * 2 <= WS_YB && WS_YB + (size_t)NASG * 1024 * 2 <= WS_END, "ws map");
constexpr int CW_CNT = 64;
constexpr int CW_BAR = 4096;

constexpr int RING_BYTES = 131072;
constexpr int TAB_OFF = 139264, MISC_OFF = 141312, ROUTER_OFF = 147456, EPI_OFF = 147456, LDS_BYTES = 157696;

typedef __bf16 bf16x2_t __attribute__((ext_vector_type(2)));
__device__ __forceinline__ unsigned cvt_pk_bf16(float lo, float hi) { const f32x2 v = {lo, hi}; const bf16x2_t b = __builtin_convertvector(v, bf16x2_t); return __builtin_bit_cast(unsigned, b); }
__device__ __forceinline__ bf16_t f2bf(float f) { return (bf16_t)(cvt_pk_bf16(f, 0.f) & 0xffffu); }
__device__ __forceinline__ float bflo(unsigned w) { return __uint_as_float(w << 16); }
__device__ __forceinline__ float bfhi(unsigned w) { return __uint_as_float(w & 0xffff0000u); }
__device__ __forceinline__ float bf2f(bf16_t v) { return __uint_as_float((unsigned)v << 16); }
__device__ __forceinline__ void unpack8(const u32x4 w, float (&f)[8]) { f[0] = bflo(w.x); f[1] = bfhi(w.x); f[2] = bflo(w.y); f[3] = bfhi(w.y); f[4] = bflo(w.z); f[5] = bfhi(w.z); f[6] = bflo(w.w); f[7] = bfhi(w.w); }
__device__ __forceinline__ u32x4 pack8(const float (&f)[8]) { u32x4 w; w.x = cvt_pk_bf16(f[0], f[1]); w.y = cvt_pk_bf16(f[2], f[3]); w.z = cvt_pk_bf16(f[4], f[5]); w.w = cvt_pk_bf16(f[6], f[7]); return w; }
__device__ __forceinline__ u32x2 pack8_fp8(const float (&f)[8]) { int a = 0, b = 0;
    a = __builtin_amdgcn_cvt_pk_fp8_f32(f[0], f[1], a, false); a = __builtin_amdgcn_cvt_pk_fp8_f32(f[2], f[3], a, true);
    b = __builtin_amdgcn_cvt_pk_fp8_f32(f[4], f[5], b, false); b = __builtin_amdgcn_cvt_pk_fp8_f32(f[6], f[7], b, true);
    return (u32x2){(unsigned)a, (unsigned)b}; }
__device__ __forceinline__ void unpack8_fp8(const u32x2 w, float (&f)[8]) {
    const f32x2 a = __builtin_amdgcn_cvt_pk_f32_fp8((int)w.x, false), b = __builtin_amdgcn_cvt_pk_f32_fp8((int)w.x, true), c = __builtin_amdgcn_cvt_pk_f32_fp8((int)w.y, false), d = __builtin_amdgcn_cvt_pk_f32_fp8((int)w.y, true);
    f[0] = a.x; f[1] = a.y; f[2] = b.x; f[3] = b.y; f[4] = c.x; f[5] = c.y; f[6] = d.x; f[7] = d.y; }
__device__ __forceinline__ f32x4 mma16(bf16x8 a, bf16x8 b, f32x4 c) { return __builtin_amdgcn_mfma_f32_16x16x32_bf16(a, b, c, 0, 0, 0); }
__device__ __forceinline__ float wave_sum(float v) {
#pragma unroll
    for (int o = 1; o < 64; o <<= 1) v += __shfl_xor(v, o);
    return v;
}
__device__ __forceinline__ float sigmoidf_(float x) { return __builtin_amdgcn_rcpf(1.0f + __expf(-x)); }
__device__ __forceinline__ float gelu_erf(float v) {
    const float av = fabsf(v), t = __builtin_amdgcn_rcpf(av * 0.2316418882f + 1.0f);
    float q = t * 0.5307027145f + (-0.7265760135f); q = q * t + 0.7107068705f; q = q * t + (-0.142248368f); q = q * t + 0.127414796f; q = q * t;
    const float e = __builtin_amdgcn_exp2f((v * v) * (-0.72134752044f));
    const float m = v * (q * e);
    return v < 0.f ? m : v - m;
}
__device__ __forceinline__ f32x2 gelu_pk(f32x2 v) {
    const f32x2 av = __builtin_elementwise_abs(v), d = av * 0.2316418882f + 1.0f;
    f32x2 t; t.x = __builtin_amdgcn_rcpf(d.x); t.y = __builtin_amdgcn_rcpf(d.y);
    f32x2 q = t * 0.5307027145f + (-0.7265760135f); q = q * t + 0.7107068705f; q = q * t + (-0.142248368f); q = q * t + 0.127414796f; q = q * t;
    const f32x2 s = (v * v) * (-0.72134752044f);
    f32x2 e; e.x = __builtin_amdgcn_exp2f(s.x); e.y = __builtin_amdgcn_exp2f(s.y);
    const f32x2 m = v * (q * e), r = v - m;
    f32x2 o; o.x = v.x < 0.f ? m.x : r.x; o.y = v.y < 0.f ? m.y : r.y; return o;
}
__device__ __forceinline__ f32x2 sigmoid_pk(f32x2 v) {
    const f32x2 t = v * (-1.4426950408889634f); const f32x2 d = (f32x2){__builtin_amdgcn_exp2f(t.x), __builtin_amdgcn_exp2f(t.y)} + 1.0f;
    return (f32x2){__builtin_amdgcn_rcpf(d.x), __builtin_amdgcn_rcpf(d.y)};
}
#define LDS_WAIT() asm volatile("s_waitcnt lgkmcnt(0)" ::: "memory")
#define VM_WAIT() asm volatile("s_waitcnt vmcnt(0)" ::: "memory")

#define XB_TMO      128
#define XB_XCNT(j)  (256  + 64 * (j))
#define XB_XSUB(j)  (1280 + 64 * (j))
#define XB_XGEN(j)  (2304 + 64 * (j))
#define XB_TOP      3328
#define XB_TOPGEN   3392
#define XCD_BAR_WORDS 3456
#define XB_SPIN_CAP (1u << 22)
__device__ __forceinline__ unsigned xb_ld(unsigned* p)              { return __hip_atomic_load(p, __ATOMIC_RELAXED, __HIP_MEMORY_SCOPE_AGENT); }
__device__ __forceinline__ unsigned xb_add(unsigned* p, unsigned v) { return __hip_atomic_fetch_add(p, v, __ATOMIC_RELAXED, __HIP_MEMORY_SCOPE_AGENT); }
__device__ __forceinline__ unsigned xb_xcc_id() { return (unsigned)__builtin_amdgcn_s_getreg((3 << 11) | 20) & 0xFu; }
#define XB_SPIN(cond, bar) do { unsigned _sp = 0; while (cond) { __builtin_amdgcn_s_sleep(1); \
    if ((++_sp & 255u) == 0u) { if (xb_ld(&(bar)[XB_TMO])) break; if (_sp > XB_SPIN_CAP) { atomicAdd(&(bar)[XB_TMO], 1u); break; } } } } while (0)
struct XcdBarrier { unsigned* bar; unsigned x; volatile LAS unsigned* st; };
__device__ __forceinline__ XcdBarrier xcd_barrier_post(unsigned* bar, volatile LAS unsigned* st) {
    XcdBarrier b; b.bar = bar; b.x = xb_xcc_id(); b.st = st;
    if (threadIdx.x == 0) (void)xb_add(&bar[XB_XCNT(b.x)], 1u);
    return b;
}
__device__ __forceinline__ void xcd_barrier_complete(unsigned* bar, unsigned x, unsigned& nloc, unsigned& nx) {
    const unsigned G = gridDim.x * gridDim.y * gridDim.z;
    unsigned sum, cnt, mine, sp = 0u;
    for (;;) {
        sum = 0u; cnt = 0u; mine = 0u;
#pragma unroll
        for (unsigned j = 0; j < 16; ++j) { const unsigned c = xb_ld(&bar[XB_XCNT(j)]); sum += c; cnt += (c > 0u) ? 1u : 0u; mine = (j == x) ? c : mine; }
        if (sum == G) break;
        __builtin_amdgcn_s_sleep(1);
        if ((++sp & 255u) == 0u) { if (xb_ld(&bar[XB_TMO])) break; if (sp > XB_SPIN_CAP) { atomicAdd(&bar[XB_TMO], 1u); break; } }
    }
    nloc = mine > 0u ? mine : 1u; nx = cnt > 0u ? cnt : 1u;
}
__device__ __forceinline__ void xcd_barrier(const XcdBarrier& b) {
    asm volatile("s_waitcnt vmcnt(0)" ::: "memory");
    __syncthreads();
    if (threadIdx.x == 0) {
        unsigned* bar = b.bar;
        __builtin_amdgcn_s_waitcnt(0);
        unsigned nloc = b.st[0], nx = b.st[1];
        if (nloc == 0u) { xcd_barrier_complete(bar, b.x, nloc, nx); b.st[0] = nloc; b.st[1] = nx; }
        const unsigned old = xb_add(&bar[XB_XSUB(b.x)], 1u);
        const unsigned gen = old / nloc;
        if (old + 1u == (gen + 1u) * nloc) {
            __builtin_amdgcn_fence(__ATOMIC_RELEASE, "agent");
            asm volatile("s_waitcnt vmcnt(0)" ::: "memory");
            const unsigned og = xb_add(&bar[XB_TOP], 1u);
            const unsigned tg = og / nx;
            if (og + 1u == (tg + 1u) * nx) xb_add(&bar[XB_TOPGEN], 1u);
            else XB_SPIN(xb_ld(&bar[XB_TOPGEN]) == tg, bar);
            __builtin_amdgcn_fence(__ATOMIC_ACQUIRE, "agent");
            xb_add(&bar[XB_XGEN(b.x)], 1u);
            asm volatile("s_waitcnt vmcnt(0)" ::: "memory");
        } else {
            __builtin_amdgcn_fence(__ATOMIC_ACQUIRE, "agent");
            XB_SPIN(xb_ld(&bar[XB_XGEN(b.x)]) == gen, bar);
            asm volatile("s_waitcnt vmcnt(0)" ::: "memory");
        }
    }
    __syncthreads();
}

namespace pg8 {
constexpr int BM = 256, BK = 64, HALF = 128, HTB = HALF * BK * 2, NXCD = 8, WGM = 8;
__host__ __device__ __forceinline__ int lds_byte(int r, int c) { const int st = (r >> 4) * 2 + (c >> 5), rr = r & 15, cc = c & 31, ob = rr * 64 + cc * 2; return st * 1024 + (ob ^ (((ob >> 9) & 1) << 5)); }
__host__ __device__ __forceinline__ void stage_rc(int b, int& R, int& C) { const int st = b / 1024, sb = b % 1024, swz = sb ^ (((sb >> 9) & 1) << 5); R = (st >> 1) * 16 + swz / 64; C = (st & 1) * 32 + (swz % 64) / 2; }
__host__ __device__ __forceinline__ int perm32(int rho) { const int n = rho >> 4, i = rho & 15; return 8 * (i >> 2) + 4 * n + (i & 3); }
struct Unit { int pm, pn, aux; };
__device__ __forceinline__ void map_tile(int L, int nM, int nN, int& pm, int& pn) {
    const int nwg = nM * nN; int wgid = L;
    { const int q = nwg / NXCD, r = nwg % NXCD, xcd = wgid % NXCD, off = wgid / NXCD; wgid = (xcd < r ? xcd * (q + 1) : r * (q + 1) + (xcd - r) * q) + off; }
    const int nig = WGM * nN, gid = wgid / nig, fm = gid * WGM, gsz = (nM - fm) < WGM ? (nM - fm) : WGM;
    pm = fm + ((wgid % nig) % gsz); pn = (wgid % nig) / gsz;
}
template <class Epi, class Prob>
__device__ __forceinline__ void gemm_phase(LAS unsigned char* lds, const Prob& P, const Epi& E) {
    const int tid = threadIdx.x, wid = __builtin_amdgcn_readfirstlane(tid >> 6), lane = tid & 63, wr = wid >> 2, wc = wid & 3, fr = lane & 15, fq = lane >> 4;
    const int nt = P.K / (Prob::FP8 ? 128 : BK);
    unsigned voffB[2];
#pragma unroll
    for (int i = 0; i < 2; ++i) { int R_, C_; stage_rc(tid * 16 + i * 8192, R_, C_); const int Rb = (R_ & ~31) + perm32(R_ & 31); voffB[i] = (unsigned)(Rb * P.ldb + C_ * 2); }
#define PG8_AOFF(dst0, dst1, unit) do { _Pragma("unroll") for (int _i = 0; _i < 2; ++_i) { int R_, C_; stage_rc(tid * 16 + _i * 8192, R_, C_); dst0[_i] = P.a_off(unit, R_, C_); dst1[_i] = P.a_off(unit, R_ + HALF, C_); } } while (0)
    const size_t kstep = (size_t)(BK * 2);
    const size_t hstepB = (size_t)HALF * P.ldb;
    const unsigned ldsw = (unsigned)wid * 1024u;
    const int aoff = lds_byte(wr * 64 + fr, fq * 8), boff = lds_byte(wc * 32 + fr, fq * 8);
#define PG8_SA(b, h) (((b) * 2 + (h)) * HTB)
#define PG8_SB(b, h) ((4 + (b) * 2 + (h)) * HTB)
#define PG8_STAGE(bufoff, gbase, voff) do { _Pragma("unroll") for (int _i = 0; _i < 2; ++_i) \
        __builtin_amdgcn_global_load_lds((const unsigned*)((const char*)(gbase) + (voff)[_i]), (LAS unsigned*)(lds + (bufoff) + ldsw + _i * 8192), 16, 0, 0); } while (0)
#define PG8_LD8(addr) __builtin_shufflevector(*(const LAS i32x4*)(addr), *(const LAS i32x4*)((addr) + 1024), 0, 1, 2, 3, 4, 5, 6, 7)
#define PG8_LDA(dst, b, h) do { _Pragma("unroll") for (int m = 0; m < 4; ++m) dst[m] = PG8_LD8(lds + PG8_SA(b, h) + aoff + m * 2048); } while (0)
#define PG8_LDB(dst, b, h) do { _Pragma("unroll") for (int n = 0; n < 2; ++n) dst[n] = PG8_LD8(lds + PG8_SB(b, h) + boff + n * 2048); } while (0)
#define PG8_LO(x) __builtin_bit_cast(bf16x8, __builtin_shufflevector(x, x, 0, 1, 2, 3))
#define PG8_HI(x) __builtin_bit_cast(bf16x8, __builtin_shufflevector(x, x, 4, 5, 6, 7))
#define PG8_MMA(ai, bj, At, Bt) do { __builtin_amdgcn_s_setprio(1); _Pragma("unroll") for (int m = 0; m < 4; ++m) _Pragma("unroll") for (int n = 0; n < 2; ++n) { \
        if constexpr (Prob::FP8) asm volatile("v_mfma_scale_f32_16x16x128_f8f6f4 %0, %1, %2, %0, %3, %4 op_sel_hi:[0,0,0]" : "+v"(acc[ai][bj][m][n]) : "v"(Bt[n]), "v"(At[m]), "v"(scl_w), "v"(scl_1)); \
        else { acc[ai][bj][m][n] = __builtin_amdgcn_mfma_f32_16x16x32_bf16(PG8_LO(Bt[n]), PG8_LO(At[m]), acc[ai][bj][m][n], 0, 0, 0); \
               acc[ai][bj][m][n] = __builtin_amdgcn_mfma_f32_16x16x32_bf16(PG8_HI(Bt[n]), PG8_HI(At[m]), acc[ai][bj][m][n], 0, 0, 0); } } \
        __builtin_amdgcn_s_setprio(0); } while (0)
#define PG8_WAIT_V(n) asm volatile("s_waitcnt vmcnt(" #n ")" ::: "memory")
#define PG8_WAIT_L(n) asm volatile("s_waitcnt lgkmcnt(" #n ")" ::: "memory")
#define PG8_BAR __builtin_amdgcn_s_barrier()
#define PG8_SCHED __builtin_amdgcn_sched_barrier(0)
    Unit cur, nxt; int ui = 0;
    if (!P.next(0, cur)) return;
    f32x4 acc[2][2][4][2];
#pragma unroll
    for (int a = 0; a < 2; ++a)
#pragma unroll
        for (int b = 0; b < 2; ++b)
#pragma unroll
            for (int m = 0; m < 4; ++m)
#pragma unroll
                for (int n = 0; n < 2; ++n) acc[a][b][m][n] = (f32x4){0.f, 0.f, 0.f, 0.f};
    i32x8 At[4], B0[2], B1[2];
    int scl_w = Prob::WSCALE, scl_1 = 0x7f7f7f7f; asm volatile("" : "+v"(scl_w), "+v"(scl_1));
    unsigned cO0[2], cO1[2], nO0[2], nO1[2];
    PG8_AOFF(cO0, cO1, cur);
    const char* cA = P.a_base(cur); const char* cB = P.b_base(cur);
    PG8_STAGE(PG8_SB(0, 0), cB, voffB); PG8_STAGE(PG8_SB(0, 1), cB + hstepB, voffB); PG8_STAGE(PG8_SA(0, 0), cA, cO0); PG8_STAGE(PG8_SA(0, 1), cA, cO1);
    if (wr == 1) PG8_BAR;
    PG8_WAIT_V(2); PG8_BAR;
    PG8_STAGE(PG8_SB(1, 0), cB + kstep, voffB); PG8_STAGE(PG8_SA(1, 0), cA + kstep, cO0); PG8_STAGE(PG8_SB(1, 1), cB + hstepB + kstep, voffB);
    PG8_WAIT_V(6); PG8_BAR;
    for (;;) {
        const bool has_next = P.next(ui + 1, nxt);
        const char* nA = cA; const char* nB = cB;
        if constexpr (Prob::GATHER) {
#pragma unroll
            for (int i = 0; i < 2; ++i) { nO0[i] = cO0[i]; nO1[i] = cO1[i]; } }
        if (has_next) { nA = P.a_base(nxt); nB = P.b_base(nxt); if constexpr (Prob::GATHER) PG8_AOFF(nO0, nO1, nxt); }
        for (int t = 0; t < nt; t += 2) {
            const bool last = (t == nt - 2);
            const char* a1 = cA + (size_t)(t + 1) * kstep;
            const char* a2 = last ? nA : cA + (size_t)(t + 2) * kstep; const char* b2 = last ? nB : cB + (size_t)(t + 2) * kstep;
            const char* a3 = a2 + kstep; const char* b3 = b2 + kstep;
            unsigned o20[2], o21[2];
#pragma unroll
            for (int i = 0; i < 2; ++i) { if constexpr (Prob::GATHER) { o20[i] = last ? nO0[i] : cO0[i]; o21[i] = last ? nO1[i] : cO1[i]; } else { o20[i] = cO0[i]; o21[i] = cO1[i]; } }
            const bool fin = last && !has_next;
            PG8_LDB(B0, 0, 0); PG8_LDB(B1, 0, 1); PG8_SCHED; PG8_LDA(At, 0, 0); PG8_STAGE(PG8_SA(1, 1), a1, cO1);
            PG8_WAIT_V(8); PG8_WAIT_L(0); PG8_BAR; PG8_MMA(0, 0, At, B0); PG8_MMA(0, 1, At, B1); PG8_BAR; PG8_SCHED;
            PG8_LDA(At, 0, 1);
            if (!fin) { PG8_STAGE(PG8_SB(0, 0), b2, voffB); PG8_STAGE(PG8_SB(0, 1), b2 + hstepB, voffB); PG8_STAGE(PG8_SA(0, 0), a2, o20); PG8_WAIT_V(8); }
            else PG8_WAIT_V(2);
            PG8_WAIT_L(0); PG8_BAR; PG8_MMA(1, 0, At, B0); PG8_MMA(1, 1, At, B1); PG8_BAR; PG8_SCHED;
            if constexpr (Epi::STAGE) { if (last) E.stage(cur, wid, lane, lds); }
            PG8_LDB(B0, 1, 0); PG8_LDB(B1, 1, 1); PG8_SCHED; PG8_LDA(At, 1, 0);
            if (!fin) { PG8_STAGE(PG8_SA(0, 1), a2, o21); PG8_WAIT_V(8); }
            else PG8_WAIT_V(0);
            PG8_WAIT_L(0); PG8_BAR; PG8_MMA(0, 0, At, B0); PG8_MMA(0, 1, At, B1); PG8_BAR; PG8_SCHED;
            PG8_LDA(At, 1, 1);
            if (!fin) { PG8_STAGE(PG8_SB(1, 0), b3, voffB); PG8_STAGE(PG8_SB(1, 1), b3 + hstepB, voffB); PG8_STAGE(PG8_SA(1, 0), a3, o20); PG8_WAIT_V(8); }
            PG8_WAIT_L(0); PG8_BAR; PG8_MMA(1, 0, At, B0); PG8_MMA(1, 1, At, B1); PG8_BAR; PG8_SCHED;
            if constexpr (Epi::MID) { if (t + 2 == nt / 2) E.mid(acc, cur, wr, wc, fr, fq); }
        }
        if (wr == 0) PG8_BAR;
        if constexpr (Prob::FP8) asm volatile("s_nop 15\n\ts_nop 15" ::: "memory");
        E(acc, cur, wr, wc, fr, fq);
        if (!has_next) break;
#pragma unroll
        for (int a = 0; a < 2; ++a)
#pragma unroll
            for (int b = 0; b < 2; ++b)
#pragma unroll
                for (int m = 0; m < 4; ++m)
#pragma unroll
                    for (int n = 0; n < 2; ++n) acc[a][b][m][n] = (f32x4){0.f, 0.f, 0.f, 0.f};
        cur = nxt; cA = nA; cB = nB; ++ui;
        if constexpr (Prob::GATHER) {
#pragma unroll
            for (int i = 0; i < 2; ++i) { cO0[i] = nO0[i]; cO1[i] = nO1[i]; } }
        if (wr == 1) PG8_BAR;
    }
    PG8_WAIT_V(0);
    PG8_BAR;
#undef PG8_AOFF
#undef PG8_SA
#undef PG8_SB
#undef PG8_STAGE
#undef PG8_LDA
#undef PG8_LD8
#undef PG8_LO
#undef PG8_HI
#undef PG8_LDB
#undef PG8_MMA
#undef PG8_WAIT_V
#undef PG8_WAIT_L
#undef PG8_BAR
#undef PG8_SCHED
}
}
using pg8::Unit;

struct Args { const float* in[28]; float* out; unsigned char* ws; int ph_lo, ph_hi; };
struct Frame {
    LAS unsigned char* lds;
    volatile LAS unsigned* MISC;
    unsigned* ctl;
    int tid, lane, wave, vcu, G;
    const Args* A;
    __device__ __forceinline__ bf16_t* Win_t() const { return (bf16_t*)(A->ws + WS_WIN); }
    __device__ __forceinline__ bf16_t* Wk_t() const { return (bf16_t*)(A->ws + WS_WK); }
    __device__ __forceinline__ bf16_t* Wv_t() const { return (bf16_t*)(A->ws + WS_WV); }
    __device__ __forceinline__ bf16_t* Wpab_t() const { return (bf16_t*)(A->ws + WS_WPAB); }
    __device__ __forceinline__ bf16_t* Wmo_t() const { return (bf16_t*)(A->ws + WS_WMO); }
    __device__ __forceinline__ bf16_t* Wq_t() const { return (bf16_t*)(A->ws + WS_WQ); }
    __device__ __forceinline__ bf16_t* Wo_t() const { return (bf16_t*)(A->ws + WS_WO); }
    __device__ __forceinline__ bf16_t* Wr_t() const { return (bf16_t*)(A->ws + WS_WR); }
    __device__ __forceinline__ bf16_t* W1_t() const { return (bf16_t*)(A->ws + WS_W1); }
    __device__ __forceinline__ bf16_t* W2_t() const { return (bf16_t*)(A->ws + WS_W2); }
    __device__ __forceinline__ bf16_t* sguw() const { return (bf16_t*)(A->ws + WS_SGUW); }
    __device__ __forceinline__ bf16_t* h() const { return (bf16_t*)(A->ws + WS_H); }
    __device__ __forceinline__ bf16_t* memn() const { return (bf16_t*)(A->ws + WS_MEMN); }
    __device__ __forceinline__ bf16_t* kmem() const { return (bf16_t*)(A->ws + WS_KMEM); }
    __device__ __forceinline__ bf16_t* vt() const { return (bf16_t*)(A->ws + WS_VT); }
    __device__ __forceinline__ bf16_t* qin() const { return (bf16_t*)(A->ws + WS_QIN); }
    __device__ __forceinline__ bf16_t* oab() const { return (bf16_t*)(A->ws + WS_OAB); }
    __device__ __forceinline__ bf16_t* mix() const { return (bf16_t*)(A->ws + WS_MIX); }
    __device__ __forceinline__ bf16_t* x1b() const { return (bf16_t*)(A->ws + WS_X1B); }
    __device__ __forceinline__ bf16_t* q() const { return (bf16_t*)(A->ws + WS_Q); }
    __device__ __forceinline__ bf16_t* ao() const { return (bf16_t*)(A->ws + WS_AO); }
    __device__ __forceinline__ bf16_t* x2b() const { return (bf16_t*)(A->ws + WS_X2B); }
    __device__ __forceinline__ bf16_t* p() const { return (bf16_t*)(A->ws + WS_P); }
    __device__ __forceinline__ bf16_t* act() const { return (bf16_t*)(A->ws + WS_ACT); }
    __device__ __forceinline__ bf16_t* yb() const { return (bf16_t*)(A->ws + WS_YB); }
    __device__ __forceinline__ bf16_t* ointra() const { return (bf16_t*)(A->ws + WS_OINTRA); }
    __device__ __forceinline__ bf16_t* kvT() const { return (bf16_t*)(A->ws + WS_KVT); }
    __device__ __forceinline__ float* decay() const { return (float*)(A->ws + WS_DECAY); }
    __device__ __forceinline__ float* ssq1() const { return (float*)(A->ws + WS_SSQ1); }
    __device__ __forceinline__ float* ssq2() const { return (float*)(A->ws + WS_SSQ2); }
    __device__ __forceinline__ float* lscale() const { return (float*)(A->ws + WS_LSCALE); }
    __device__ __forceinline__ float* gates() const { return (float*)(A->ws + WS_GATES); }
    __device__ __forceinline__ int* list() const { return (int*)(A->ws + WS_LIST); }
    __device__ __forceinline__ bf16_t* spT() const { return (bf16_t*)(A->ws + WS_SPT); }
    __device__ __forceinline__ unsigned char* x2q() const { return (unsigned char*)(A->ws + WS_X2Q); }
    __device__ __forceinline__ unsigned char* x1q() const { return (unsigned char*)(A->ws + WS_X1Q); }
};
enum { I_X = 0, I_MEM, I_NMIXG, I_WIN, I_WA2, I_BA, I_GOUTG, I_SNG, I_SNB, I_SW, I_SB, I_WPA, I_WPB, I_WMO, I_NXG, I_NMEMG, I_WXQ, I_WXK, I_WXV, I_WXO, I_NFFNG, I_WR, I_BR, I_WE1, I_BE1, I_WE2, I_BE2, I_NFING };

struct CvtItem { const float* src; size_t ldw; unsigned char* dst; const float* kscale; float mul; int fp8; };
__device__ __forceinline__ void cvt_load(const CvtItem& c, float (&v)[64]) {
#pragma unroll
    for (int i = 0; i < 64; ++i) v[i] = __builtin_nontemporal_load(c.src + (size_t)i * c.ldw);
}
__device__ __forceinline__ void cvt_finish(const CvtItem& c, float (&v)[64]) {
    if (c.kscale) {
#pragma unroll
        for (int i = 0; i < 64; ++i) v[i] *= c.kscale[i] * c.mul; }
    else {
#pragma unroll
        for (int i = 0; i < 64; ++i) v[i] *= c.mul; }
    if (c.fp8) {
#pragma unroll
        for (int q = 0; q < 4; ++q) { const float f0[8] = {v[16 * q], v[16 * q + 1], v[16 * q + 2], v[16 * q + 3], v[16 * q + 4], v[16 * q + 5], v[16 * q + 6], v[16 * q + 7]};
            const float f1[8] = {v[16 * q + 8], v[16 * q + 9], v[16 * q + 10], v[16 * q + 11], v[16 * q + 12], v[16 * q + 13], v[16 * q + 14], v[16 * q + 15]};
            const u32x2 lo = pack8_fp8(f0), hi = pack8_fp8(f1); *(u32x4*)(c.dst + 16 * q) = (u32x4){lo.x, lo.y, hi.x, hi.y}; } }
    else {
#pragma unroll
        for (int q = 0; q < 8; ++q) { const float f[8] = {v[8 * q], v[8 * q + 1], v[8 * q + 2], v[8 * q + 3], v[8 * q + 4], v[8 * q + 5], v[8 * q + 6], v[8 * q + 7]}; *(u32x4*)(c.dst + 16 * q) = pack8(f); } }
}
__device__ __forceinline__ CvtItem cvt_desc(const float* W, int ldw, int src_col0, int k0, void* WT, int ldt, int dst_row0, int dst_k0, const float* kscale, float mul, int fp8, int lane) {
    CvtItem c; const int eb = fp8 ? 1 : 2;
    c.src = W + (size_t)k0 * ldw + src_col0 + lane; c.ldw = (size_t)ldw; c.dst = (unsigned char*)WT + ((size_t)(dst_row0 + lane) * ldt + dst_k0 + k0) * eb;
    c.kscale = kscale ? kscale + k0 : nullptr; c.mul = mul; c.fp8 = fp8; return c;
}
__device__ __forceinline__ void cvt_expert128(Frame& F) {
    const int gw = F.vcu * 8 + F.wave, NGW = F.G * 8, lane = F.lane;
    constexpr int I1 = NE * 8 * 32, I2 = NE * 8 * 16;
    for (int it = gw; it < I1 + I2; it += NGW) {
        const float* src; size_t ldw; unsigned char* dst; const float* ks; (void)ks;
        if (it < I1) { const int e = it >> 8, q = it & 255, kb = q >> 5, nb = q & 31, nd = nb * 64; const int sc = ((nd & 128) ? 1024 : 0) + 128 * (nd >> 8) + (nd & 127);
            src = F.A->in[I_WE1] + (size_t)e * D * 2048 + (size_t)(kb * 128) * 2048 + sc + lane; ldw = 2048;
            dst = (unsigned char*)F.W1_t() + (size_t)e * 2048 * D + (size_t)(nd + lane) * D + kb * 128; ks = nullptr; }
        else { const int r = it - I1, e = r >> 7, q = r & 127, kb = q >> 4, nb = q & 15;
            src = F.A->in[I_WE2] + (size_t)e * D * D + (size_t)(kb * 128) * D + nb * 64 + lane; ldw = D;
            dst = (unsigned char*)F.W2_t() + (size_t)e * D * D + (size_t)(nb * 64 + lane) * D + kb * 128; ks = nullptr; }
        float v[128]; const float* pp = src;
#pragma unroll
        for (int i = 0; i < 128; ++i) { v[i] = __builtin_nontemporal_load(pp); pp += ldw; asm volatile("" : "+v"(pp)); }
#pragma unroll
        for (int i = 0; i < 128; ++i) v[i] *= FP8_WMUL;
#pragma unroll
        for (int q = 0; q < 8; ++q) { const float f0[8] = {v[16 * q], v[16 * q + 1], v[16 * q + 2], v[16 * q + 3], v[16 * q + 4], v[16 * q + 5], v[16 * q + 6], v[16 * q + 7]};
            const float f1[8] = {v[16 * q + 8], v[16 * q + 9], v[16 * q + 10], v[16 * q + 11], v[16 * q + 12], v[16 * q + 13], v[16 * q + 14], v[16 * q + 15]};
            const u32x2 lo = pack8_fp8(f0), hi = pack8_fp8(f1); *(u32x4*)(dst + 16 * q) = (u32x4){lo.x, lo.y, hi.x, hi.y}; }
    }
}
constexpr int CVT_SLOT = 16 * 1040, CVT_I1 = NE * 8 * 64, CVT_I2 = NE * 8 * 32;
struct CvtDma { const float* src; unsigned ldw; unsigned char* dst; };
__device__ __forceinline__ CvtDma cvt_dma_desc(const Frame& F, int it) {
    constexpr int I1 = NE * 8 * 64; CvtDma c;
    if (it < I1) { const int e = it >> 9, q = it & 511, kb = q >> 6, nb = q & 63, nd = nb * 32; const int sc = ((nd & 128) ? 1024 : 0) + 128 * (nd >> 8) + (nd & 127);
        c.src = F.A->in[I_WE1] + (size_t)e * D * 2048 + (size_t)(kb * 128) * 2048 + sc; c.ldw = 2048;
        c.dst = (unsigned char*)F.W1_t() + (size_t)e * 2048 * D + (size_t)nd * D + kb * 128; }
    else { const int r = it - I1, e = r >> 8, q = r & 255, kb = q >> 5, nb = q & 31;
        c.src = F.A->in[I_WE2] + (size_t)e * D * D + (size_t)(kb * 128) * D + nb * 32; c.ldw = D;
        c.dst = (unsigned char*)F.W2_t() + (size_t)e * D * D + (size_t)(nb * 32) * D + kb * 128; }
    return c;
}
__device__ __forceinline__ void cvt_dma_issue(const CvtDma& c, LAS unsigned char* slot, int lane) {
    const float* p = c.src + (size_t)(lane >> 3) * c.ldw + (lane & 7) * 4;
#pragma unroll
    for (int i = 0; i < 16; ++i) { __builtin_amdgcn_global_load_lds((const unsigned*)p, (LAS unsigned*)(slot + i * 1040), 16, 0, 2); p += (size_t)8 * c.ldw; }
}
__device__ __forceinline__ void cvt_expert_dma(Frame& F, int ibeg, int iend, int part, int nparts) {
    if (F.wave < 4) return;
    const int cw = ibeg + part * 4 + (F.wave - 4), NCW = nparts * 4, lane = F.lane;
    const int ITEMS = iend;
    const int n = cw < ITEMS ? (ITEMS - cw + NCW - 1) / NCW : 0;
    LAS unsigned char* slot0 = F.lds + (F.wave - 4) * (2 * CVT_SLOT);
    const int rdo = (lane & 7) * 2080 + (lane >> 3) * 4;
    CvtDma d0 = cvt_dma_desc(F, n > 0 ? cw : 0), d1 = cvt_dma_desc(F, n > 1 ? cw + NCW : 0);
    if (n > 0) cvt_dma_issue(d0, slot0, lane);
    if (n > 1) cvt_dma_issue(d1, slot0 + CVT_SLOT, lane);
    for (int j = 0; j < n; ++j) {
        if (j + 1 >= n) asm volatile("s_waitcnt vmcnt(0)" ::: "memory");
        else if (j == 0) asm volatile("s_waitcnt vmcnt(16)" ::: "memory");
        else asm volatile("s_waitcnt vmcnt(20)" ::: "memory");
        LAS unsigned char* slot = slot0 + (j & 1) * CVT_SLOT;
        const LAS unsigned char* rd = slot + rdo;
        float v[4][16];
        const unsigned rda = (unsigned)(size_t)rd;
#pragma unroll
        for (int q = 0; q < 4; ++q)
#pragma unroll
            for (int jj = 0; jj < 16; ++jj) asm volatile("ds_read_b32 %0, %1 offset:%2" : "=v"(v[q][jj]) : "v"(rda), "n"(q * 32 + (jj >> 3) * 1040 + (jj & 7) * 128));
        asm volatile("s_waitcnt lgkmcnt(0)" ::: "memory");
#pragma unroll
        for (int q = 0; q < 4; ++q) asm volatile("" : "+v"(v[q][0]), "+v"(v[q][1]), "+v"(v[q][2]), "+v"(v[q][3]), "+v"(v[q][4]), "+v"(v[q][5]), "+v"(v[q][6]), "+v"(v[q][7]),
                                                     "+v"(v[q][8]), "+v"(v[q][9]), "+v"(v[q][10]), "+v"(v[q][11]), "+v"(v[q][12]), "+v"(v[q][13]), "+v"(v[q][14]), "+v"(v[q][15]));
        unsigned char* dst = d0.dst + (size_t)(lane >> 3) * D + (lane & 7) * 16;
        d0 = d1;
        if (j + 2 < n) { d1 = cvt_dma_desc(F, cw + (j + 2) * NCW); cvt_dma_issue(d1, slot, lane); }
#pragma unroll
        for (int q = 0; q < 4; ++q) {
            float f0[8], f1[8];
#pragma unroll
            for (int jj = 0; jj < 8; ++jj) { f0[jj] = v[q][jj] * FP8_WMUL; f1[jj] = v[q][8 + jj] * FP8_WMUL; }
            const u32x2 lo = pack8_fp8(f0), hi = pack8_fp8(f1);
            *(u32x4*)(dst + (size_t)(8 * q) * D) = (u32x4){lo.x, lo.y, hi.x, hi.y}; }
    }
    asm volatile("s_waitcnt vmcnt(0)" ::: "memory");
}
template <bool Q8>
__device__ __forceinline__ void rms_row_to_bf16(const float* xrow, const float* g, bf16_t* orow, int lane) {
    f32x4 v[4]; float s = 0.f;
#pragma unroll
    for (int j = 0; j < 4; ++j) { v[j] = *(const f32x4*)(xrow + 256 * j + 4 * lane); s += (v[j].x * v[j].x + v[j].y * v[j].y) + (v[j].z * v[j].z + v[j].w * v[j].w); }
    const float rs = rsqrtf(wave_sum(s) * (1.f / D) + EPS);
#pragma unroll
    for (int j = 0; j < 4; ++j) { const f32x4 gg = *(const f32x4*)(g + 256 * j + 4 * lane);
        if constexpr (Q8) { int w = 0; w = __builtin_amdgcn_cvt_pk_fp8_f32(v[j].x * rs * gg.x, v[j].y * rs * gg.y, w, false); w = __builtin_amdgcn_cvt_pk_fp8_f32(v[j].z * rs * gg.z, v[j].w * rs * gg.w, w, true);
            *(int*)((unsigned char*)orow + 256 * j + 4 * lane) = w; }
        else { u32x2 o; o.x = cvt_pk_bf16(v[j].x * rs * gg.x, v[j].y * rs * gg.y); o.y = cvt_pk_bf16(v[j].z * rs * gg.z, v[j].w * rs * gg.w);
            *(u32x2*)(orow + 256 * j + 4 * lane) = o; } }
}
__device__ __forceinline__ void cvt_range(Frame& F, int ibeg, int iend) {
    const int gw = F.vcu * 8 + F.wave, NGW = F.G * 8, lane = F.lane;
    constexpr int N_WIN = 16 * 72, N_SQ = 256, N_PA = 8 * 16, N_E1 = 512, N_E2 = 256;
    constexpr int S_WIN = 0, S_WK = S_WIN + N_WIN, S_WV = S_WK + N_SQ, S_PA = S_WV + N_SQ, S_PB = S_PA + N_PA, S_MO = S_PB + N_PA, S_Q = S_MO + N_SQ, S_O = S_Q + N_SQ, S_E1 = S_O + N_SQ, S_E2 = S_E1 + NE * N_E1, S_END = S_E2 + NE * N_E2;
    static_assert(S_E1 == 16 * 72 + 256 * 2 + 8 * 16 * 2 + 256 * 3 && S_END == S_E1 + NE * 512 + NE * 256, "item ranges");
    const int IEND = iend < S_END ? iend : S_END;
    auto desc = [&](int it) -> CvtItem {
        if (it < S_WK) { const int r = it - S_WIN, kb = r / 72, nb = r % 72, n0 = nb * 64; return cvt_desc(F.A->in[I_WIN], INC, n0 < 1536 ? n0 : n0 + 16, kb * 64, F.Win_t(), D, n0, 0, nullptr, P1_FP8 ? FP8_WMUL : 1.f, P1_FP8, lane); }
        if (it < S_WV) { const int r = it - S_WK; return cvt_desc(F.A->in[I_WXK], D, (r & 15) * 64, (r >> 4) * 64, F.Wk_t(), D, (r & 15) * 64, 0, nullptr, P1_FP8 ? FP8_WMUL : 1.f, P1_FP8, lane); }
        if (it < S_PA) { const int r = it - S_WV; return cvt_desc(F.A->in[I_WXV], D, (r & 15) * 64, (r >> 4) * 64, F.Wv_t(), D, (r & 15) * 64, 0, nullptr, P1_FP8 ? FP8_WMUL : 1.f, P1_FP8, lane); }
        if (it < S_PB) { const int r = it - S_PA; return cvt_desc(F.A->in[I_WPA], D, (r & 15) * 64, (r >> 4) * 64, F.Wpab_t(), D, (r & 15) * 64, 0, nullptr, 1.f, 0, lane); }
        if (it < S_MO) { const int r = it - S_PB; return cvt_desc(F.A->in[I_WPB], D, (r & 15) * 64, (r >> 4) * 64, F.Wpab_t(), D, (r & 15) * 64, 512, nullptr, 1.f, 0, lane); }
        if (it < S_Q)  { const int r = it - S_MO; return cvt_desc(F.A->in[I_WMO], D, (r & 15) * 64, (r >> 4) * 64, F.Wmo_t(), D, (r & 15) * 64, 0, nullptr, 1.f, 0, lane); }
        if (it < S_O)  { const int r = it - S_Q;  return cvt_desc(F.A->in[I_WXQ], D, (r & 15) * 64, (r >> 4) * 64, F.Wq_t(), D, (r & 15) * 64, 0, F.A->in[I_NXG], FP8_WMUL, 1, lane); }
        if (it < S_E1) { const int r = it - S_O;  return cvt_desc(F.A->in[I_WXO], D, (r & 15) * 64, (r >> 4) * 64, F.Wo_t(), D, (r & 15) * 64, 0, nullptr, FP8_WMUL, 1, lane); }
        if (it < S_E2) { const int r = it - S_E1, e = r / N_E1, q = r % N_E1, kb = q >> 5, nb = q & 31, nd = nb * 64;
            const int src = ((nd & 128) ? 1024 : 0) + 128 * (nd >> 8) + (nd & 127);
            return cvt_desc(F.A->in[I_WE1] + (size_t)e * D * 2048, 2048, src, kb * 64, (unsigned char*)F.W1_t() + (size_t)e * 2048 * D, D, nd, 0, F.A->in[I_NFFNG], FP8_WMUL, 1, lane); }
        const int r = it - S_E2, e = r / N_E2, q = r % N_E2;
        return cvt_desc(F.A->in[I_WE2] + (size_t)e * D * D, D, (q & 15) * 64, (q >> 4) * 64, (unsigned char*)F.W2_t() + (size_t)e * D * D, D, (q & 15) * 64, 0, nullptr, FP8_WMUL, 1, lane); };
    if (ibeg + gw < IEND) {
        float va[64], vb[64]; CvtItem ca = desc(ibeg + gw), cb = ca; cvt_load(ca, va);
        for (int it = ibeg + gw;;) {
            const bool hb = it + NGW < IEND; if (hb) { cb = desc(it + NGW); cvt_load(cb, vb); }
            cvt_finish(ca, va); if (!hb) break;
            const bool ha = it + 2 * NGW < IEND; if (ha) { ca = desc(it + 2 * NGW); cvt_load(ca, va); }
            cvt_finish(cb, vb); if (!ha) break;
            it += 2 * NGW; }
    }
}
constexpr int CVT_LATE = 16 * 72 + 256 * 2, CVT_EXPERT = 16 * 72 + 256 * 2 + 8 * 16 * 2 + 256 * 3, CVT_END = CVT_EXPERT + NE * 512 + NE * 256;
__device__ __forceinline__ void p0_prologue(Frame& F) {
    const int gw = F.vcu * 8 + F.wave, NGW = F.G * 8, lane = F.lane;
    cvt_range(F, 0, CVT_LATE);
    for (int m = gw; m < T; m += NGW) rms_row_to_bf16<P1_FP8 != 0>(F.A->in[I_X] + (size_t)m * D, F.A->in[I_NMIXG], (bf16_t*)((unsigned char*)F.h() + (size_t)m * D * (P1_FP8 ? 1 : 2)), lane);
    for (int m = gw; m < TM; m += NGW) rms_row_to_bf16<P1_FP8 != 0>(F.A->in[I_MEM] + (size_t)m * D, F.A->in[I_NMEMG], (bf16_t*)((unsigned char*)F.memn() + (size_t)m * D * (P1_FP8 ? 1 : 2)), lane);
    const int gt = F.vcu * 512 + F.tid, NGT = F.G * 512;
    for (int i = gt; i < 256 * D; i += NGT) { const int j = i >> 10, k = i & 1023; const float* wr_ = F.A->in[I_WIN] + (size_t)k * INC + OFF_A; float s = 0.f;
#pragma unroll
        for (int r = 0; r < 16; ++r) s += wr_[r] * F.A->in[I_WA2][r * 256 + j];
        if (P1_FP8) { int w = __builtin_amdgcn_cvt_pk_fp8_f32(s * FP8_WMUL, 0.f, 0, false); ((unsigned char*)F.Win_t())[(size_t)(PC_A + j) * D + k] = (unsigned char)(w & 0xff); }
        else F.Win_t()[(size_t)(PC_A + j) * D + k] = f2bf(s); }
    for (int i = gt; i < NE * D; i += NGT) { const int e = i >> 10, k = i & 1023; F.Wr_t()[i] = f2bf(F.A->in[I_WR][k * NE + e] * F.A->in[I_NFFNG][k]); }
    for (int i = gt; i < 4 * 128 * 128; i += NGT) { const int t = (i >> 7) & 127, s = i & 127; F.sguw()[i] = f2bf(s <= t ? F.A->in[I_SW][i] : 0.f); }
}

struct ProbP1 {
    static constexpr bool GATHER = false, FP8 = (P1_FP8 != 0); static constexpr int EB = P1_FP8 ? 1 : 2, WSCALE = FP8_WSCALE;
    int K, lda, ldb, G, c; const unsigned char* ws;
    __device__ __forceinline__ bool next(int i, Unit& u) const {
        const int L = i * G + c;
        if (L < 1216) { u.aux = 0; pg8::map_tile(L, 64, 19, u.pm, u.pn); return true; }
        if (L < 1248) { u.aux = 1; u.pm = (L - 1216) >> 2; u.pn = (L - 1216) & 3; return true; }
        if (L < 1280) { u.aux = 2; u.pm = (L - 1248) >> 3; u.pn = (L - 1248) & 7; return true; }
        return false;
    }
    __device__ __forceinline__ const char* a_base(const Unit& u) const { const size_t o = u.aux == 0 ? WS_H : (u.aux == 1 ? WS_MEMN : WS_WV); return (const char*)(ws + o + (size_t)u.pm * 256 * D * EB); }
    __device__ __forceinline__ const char* b_base(const Unit& u) const { const size_t o = u.aux == 0 ? WS_WIN : (u.aux == 1 ? WS_WK : WS_MEMN); return (const char*)(ws + o + (size_t)u.pn * 256 * D * EB); }
    __device__ __forceinline__ unsigned a_off(const Unit&, int row, int C) const { return (unsigned)(row * D * EB + C * 2); }
};
struct EpiP1 {
    static constexpr bool MID = false, STAGE = false;
    unsigned char* ws;
    __device__ __forceinline__ void operator()(const f32x4 (&acc)[2][2][4][2], const Unit& u, int wr, int wc, int fr, int fq) const {
        asm volatile("" : "+v"(fr), "+v"(fq));
        const size_t oo = u.aux == 0 ? WS_P : (u.aux == 1 ? WS_KMEM : WS_VT);
        bf16_t* O = (bf16_t*)(ws + oo); const int ldc = u.aux == 0 ? PN : (u.aux == 1 ? D : TM);
        const int act = (u.aux == 0) ? ((u.pn >= 6 && u.pn < 10) ? 1 : ((u.pn >= 10 && u.pn < 18) ? 2 : 0)) : 0;
        const int row0 = u.pm * 256 + wr * 64 + fr, col0 = u.pn * 256 + wc * 32 + 8 * fq; const bool svstat = (u.aux == 0) && (u.pn == 8 || u.pn == 9);
#pragma unroll
        for (int ai = 0; ai < 2; ++ai)
#pragma unroll
            for (int m = 0; m < 4; ++m) { bf16_t* rowp = O + (size_t)(row0 + ai * 128 + m * 16) * ldc + col0; float s1 = 0.f, s2 = 0.f;
#pragma unroll
                for (int bj = 0; bj < 2; ++bj) { float v[8];
#pragma unroll
                    for (int j = 0; j < 4; ++j) { v[j] = acc[ai][bj][m][0][j]; v[4 + j] = acc[ai][bj][m][1][j]; }
                    if (act == 1) {
#pragma unroll
                        for (int j = 0; j < 8; j += 2) { const f32x2 o = gelu_pk((f32x2){v[j], v[j + 1]}); v[j] = o.x; v[j + 1] = o.y; }
#pragma unroll
                        for (int j = 0; j < 8; ++j) { s1 += v[j]; s2 += v[j] * v[j]; } }
                    else if (act == 2) {
#pragma unroll
                        for (int j = 0; j < 8; j += 2) { const f32x2 o = sigmoid_pk((f32x2){v[j], v[j + 1]}); v[j] = o.x; v[j + 1] = o.y; } }
                    *(u32x4*)(rowp + bj * 128) = pack8(v); }
                if (svstat) {
                    s1 += __shfl_xor(s1, 16); s1 += __shfl_xor(s1, 32); s2 += __shfl_xor(s2, 16); s2 += __shfl_xor(s2, 32);
                    if (fq == 0) *(f32x2*)((float*)(ws + WS_SVS) + (size_t)(row0 + ai * 128 + m * 16) * 16 + (u.pn - 8) * 8 + wc * 2) = (f32x2){s1, s2}; } }
    }
};

__device__ __forceinline__ void gla_a_unit(Frame& F, int unit) {
    const int tid = F.tid, lane = F.lane, w = F.wave, fr = lane & 15, fq = lane >> 4;
    const int bh = unit >> 5, n = unit & 31, b = bh >> 2, h = bh & 3;
    const int t0 = b * SEQ + n * 64;
    LAS float* cum = (LAS float*)(F.lds); LAS float* tot = (LAS float*)(F.lds + 16640);
    LAS bf16_t* QIN = (LAS bf16_t*)(F.lds + 18688); LAS bf16_t* KIN = (LAS bf16_t*)(F.lds + 27904); LAS bf16_t* KOT = (LAS bf16_t*)(F.lds + 37120);
    LAS bf16_t* ATT = (LAS bf16_t*)(F.lds + 46336); LAS bf16_t* VT = (LAS bf16_t*)(F.lds + 55552);
    const int c = tid >> 3, d8 = (tid & 7) * 8;
    {
        float g[8]; unpack8(*(const u32x4*)(F.p() + (size_t)(t0 + c) * PN + PC_A + h * 64 + d8), g);
        const f32x4 b0 = *(const f32x4*)(F.A->in[I_BA] + h * 64 + d8), b1 = *(const f32x4*)(F.A->in[I_BA] + h * 64 + d8 + 4);
        const float bb[8] = {b0.x, b0.y, b0.z, b0.w, b1.x, b1.y, b1.z, b1.w};
#pragma unroll
        for (int j = 0; j < 8; ++j) { const float x = g[j] + bb[j]; const float ls = fminf(x, 0.f) - __logf(1.f + __expf(-fabsf(x))); cum[c * 65 + d8 + j] = ls * 0.0625f; }
    }
    __syncthreads();
    { const int d = tid & 63, seg = tid >> 6; float run = 0.f;
#pragma unroll
        for (int i = 0; i < 8; ++i) { run += cum[(seg * 8 + i) * 65 + d]; cum[(seg * 8 + i) * 65 + d] = run; }
        tot[seg * 64 + d] = run; }
    __syncthreads();
    { const int d = tid & 63, seg = tid >> 6; float off = 0.f;
#pragma unroll
        for (int s = 0; s < 7; ++s) if (s < seg) off += tot[s * 64 + d];
#pragma unroll
        for (int i = 0; i < 8; ++i) cum[(seg * 8 + i) * 65 + d] += off; }
    __syncthreads();
    {
        float qv[8], kv[8], qi[8], ki[8];
        unpack8(*(const u32x4*)(F.p() + (size_t)(t0 + c) * PN + PC_Q + h * 64 + d8), qv);
        unpack8(*(const u32x4*)(F.p() + (size_t)(t0 + c) * PN + PC_K + h * 64 + d8), kv);
#pragma unroll
        for (int j = 0; j < 8; ++j) { const float cm = cum[c * 65 + d8 + j], cl = cum[63 * 65 + d8 + j];
            qi[j] = qv[j] * 0.125f * __expf(cm); ki[j] = kv[j] * __expf(-cm);
            KOT[(d8 + j) * 72 + c] = f2bf(kv[j] * __expf(cl - cm));
            if (c == 63) F.decay()[unit * 64 + d8 + j] = __expf(cl); }
        const u32x4 qp = pack8(qi), kp = pack8(ki);
        *(LAS u32x4*)(QIN + c * 72 + d8) = qp; *(LAS u32x4*)(KIN + c * 72 + d8) = kp;
        *(u32x4*)(F.qin() + (size_t)(t0 + c) * 256 + h * 64 + d8) = qp;
        const int e16 = (tid & 7) * 16;
#pragma unroll
        for (int hh = 0; hh < 2; ++hh) { const u32x4 vv = *(const u32x4*)(F.p() + (size_t)(t0 + c) * PN + PC_V + h * 128 + e16 + 8 * hh);
            const unsigned ww[4] = {vv.x, vv.y, vv.z, vv.w};
#pragma unroll
            for (int j = 0; j < 4; ++j) { VT[(e16 + 8 * hh + 2 * j) * 72 + c] = (bf16_t)(ww[j] & 0xffffu); VT[(e16 + 8 * hh + 2 * j + 1) * 72 + c] = (bf16_t)(ww[j] >> 16); } }
    }
    __syncthreads();
    {
        const int mt = w >> 1;
        bf16x8 a[2];
#pragma unroll
        for (int ks = 0; ks < 2; ++ks) a[ks] = *(const LAS bf16x8*)(QIN + (16 * mt + fr) * 72 + 32 * ks + 8 * fq);
#pragma unroll
        for (int q = 0; q < 2; ++q) { const int nt = (w & 1) * 2 + q; f32x4 s = {0.f, 0.f, 0.f, 0.f};
#pragma unroll
            for (int ks = 0; ks < 2; ++ks) s = mma16(a[ks], *(const LAS bf16x8*)(KIN + (16 * nt + fr) * 72 + 32 * ks + 8 * fq), s);
#pragma unroll
            for (int r = 0; r < 4; ++r) { const int cc = 16 * mt + 4 * fq + r, ss = 16 * nt + fr; ATT[cc * 72 + ss] = f2bf(ss <= cc ? s[r] : 0.f); } }
    }
    __syncthreads();
    {
        const int mt = w >> 1, nt0 = (w & 1) * 4;
        bf16x8 aa[2], ak[2];
#pragma unroll
        for (int ks = 0; ks < 2; ++ks) { aa[ks] = *(const LAS bf16x8*)(ATT + (16 * mt + fr) * 72 + 32 * ks + 8 * fq); ak[ks] = *(const LAS bf16x8*)(KOT + (16 * mt + fr) * 72 + 32 * ks + 8 * fq); }
#pragma unroll
        for (int q = 0; q < 4; ++q) { const int nt = nt0 + q; f32x4 o = {0.f, 0.f, 0.f, 0.f}, kvv = {0.f, 0.f, 0.f, 0.f};
#pragma unroll
            for (int ks = 0; ks < 2; ++ks) { const bf16x8 bv = *(const LAS bf16x8*)(VT + (16 * nt + fr) * 72 + 32 * ks + 8 * fq); o = mma16(bv, aa[ks], o); kvv = mma16(ak[ks], bv, kvv); }
            *(u32x2*)(F.ointra() + (size_t)(t0 + 16 * mt + fr) * 512 + h * 128 + 16 * nt + 4 * fq) = (u32x2){cvt_pk_bf16(o[0], o[1]), cvt_pk_bf16(o[2], o[3])};
            *(u32x2*)(F.kvT() + ((size_t)unit * 128 + 16 * nt + fr) * 64 + 16 * mt + 4 * fq) = (u32x2){cvt_pk_bf16(kvv[0], kvv[1]), cvt_pk_bf16(kvv[2], kvv[3])}; }
    }
    __syncthreads();
}

__device__ __forceinline__ void gla_sscan_item(Frame& F, int item) {
    const int lane = F.lane, idx = item * 64 + lane, d4 = idx & 15, e = (idx >> 4) & 127, bh = idx >> 11;
    const bf16_t* kvp = F.kvT() + ((size_t)(bh * 32) * 128 + e) * 64 + d4 * 4; const float* dcp = F.decay() + (size_t)(bh * 32) * 64 + d4 * 4;
    bf16_t* sp = F.spT() + ((size_t)(bh * 32) * 128 + e) * 64 + d4 * 4;
    f32x4 S = {0.f, 0.f, 0.f, 0.f};
    for (int n0 = 0; n0 < 32; n0 += 8) { f32x4 kv[8], dc[8];
#pragma unroll
        for (int i = 0; i < 8; ++i) { const u32x2 kw = *(const u32x2*)(kvp + (size_t)(n0 + i) * 128 * 64); kv[i] = (f32x4){bflo(kw.x), bfhi(kw.x), bflo(kw.y), bfhi(kw.y)}; dc[i] = *(const f32x4*)(dcp + (size_t)(n0 + i) * 64); }
#pragma unroll
        for (int i = 0; i < 8; ++i) { u32x2 o; o.x = cvt_pk_bf16(S.x, S.y); o.y = cvt_pk_bf16(S.z, S.w); *(u32x2*)(sp + (size_t)(n0 + i) * 128 * 64) = o; S = dc[i] * S + kv[i]; } }
}
__device__ __forceinline__ void sgu_unit(Frame& F, int unit) {
    const int tid = F.tid, w = F.wave, lane = F.lane, fr = lane & 15, fq = lane >> 4, ch = unit >> 2, g = unit & 3, t0 = ch * 128;
    LAS f32x2* stat = (LAS f32x2*)F.lds; LAS bf16_t* vnT = (LAS bf16_t*)(F.lds + 1024);
    if (tid < 128) { const float* sp = (const float*)(F.A->ws + WS_SVS) + (size_t)(t0 + tid) * 16;
        const f32x4 a = *(const f32x4*)sp, b = *(const f32x4*)(sp + 4), c4 = *(const f32x4*)(sp + 8), d = *(const f32x4*)(sp + 12);
        const float s = (a.x + a.z) + (b.x + b.z) + (c4.x + c4.z) + (d.x + d.z), s2 = (a.y + a.w) + (b.y + b.w) + (c4.y + c4.w) + (d.y + d.w);
        const float mean = s * (1.f / 512.f), var = fmaxf(s2 * (1.f / 512.f) - mean * mean, 0.f);
        stat[tid] = (f32x2){mean, rsqrtf(var + EPS)}; }
    __syncthreads();
    { const int s = tid >> 2, c32 = (tid & 3) * 32; const f32x2 ms = stat[s];
#pragma unroll
        for (int q = 0; q < 4; ++q) { float v[8]; unpack8(*(const u32x4*)(F.p() + (size_t)(t0 + s) * PN + PC_SV + g * 128 + c32 + 8 * q), v);
#pragma unroll
            for (int j = 0; j < 8; ++j) { const int cidx = g * 128 + c32 + 8 * q + j; vnT[(c32 + 8 * q + j) * 136 + s] = f2bf((v[j] - ms.x) * ms.y * F.A->in[I_SNG][cidx] + F.A->in[I_SNB][cidx]); } } }
    __syncthreads();
    f32x4 acc[8];
#pragma unroll
    for (int ct = 0; ct < 8; ++ct) acc[ct] = (f32x4){0.f, 0.f, 0.f, 0.f};
    const int nks = (16 * w + 15) / 32 + 1;
    for (int ks = 0; ks < nks; ++ks) { const bf16x8 bw = *(const bf16x8*)(F.sguw() + (size_t)(g * 128 + 16 * w + fr) * 128 + 32 * ks + 8 * fq);
#pragma unroll
        for (int ct = 0; ct < 8; ++ct) acc[ct] = mma16(*(const LAS bf16x8*)(vnT + (16 * ct + fr) * 136 + 32 * ks + 8 * fq), bw, acc[ct]); }
    {
        const int t = 16 * w + fr; const float bias = F.A->in[I_SB][g * 128 + t];
        u32x2 uv[8];
#pragma unroll
        for (int ct = 0; ct < 8; ++ct) uv[ct] = *(const u32x2*)(F.p() + (size_t)(t0 + t) * PN + PC_U + g * 128 + 16 * ct + 4 * fq);
#pragma unroll
        for (int ct = 0; ct < 8; ++ct) { const int cidx = g * 128 + 16 * ct + 4 * fq; const u32x2 uu = uv[ct];
            u32x2 o; o.x = cvt_pk_bf16(bflo(uu.x) * (acc[ct][0] + bias), bfhi(uu.x) * (acc[ct][1] + bias)); o.y = cvt_pk_bf16(bflo(uu.y) * (acc[ct][2] + bias), bfhi(uu.y) * (acc[ct][3] + bias));
            *(u32x2*)(F.oab() + (size_t)(t0 + t) * D + 512 + cidx) = o; } }
    __syncthreads();
}
__device__ __forceinline__ void gla_out_item(Frame& F, int item) {
    const int lane = F.lane, fr = lane & 15, fq = lane >> 4, unit = item >> 2, mt = item & 3;
    const int bh = unit >> 5, n = unit & 31, b = bh >> 2, h = bh & 3; const size_t t = (size_t)b * SEQ + n * 64 + 16 * mt + fr;
    bf16x8 qf[2];
#pragma unroll
    for (int ks = 0; ks < 2; ++ks) qf[ks] = *(const bf16x8*)(F.qin() + t * 256 + h * 64 + 32 * ks + 8 * fq);
    const bf16_t* sp = F.spT() + (size_t)unit * 128 * 64;
    f32x4 o[8]; float ss = 0.f;
#pragma unroll
    for (int et = 0; et < 8; ++et) { const u32x2 ow = *(const u32x2*)(F.ointra() + t * 512 + h * 128 + 16 * et + 4 * fq); f32x4 acc = {bflo(ow.x), bfhi(ow.x), bflo(ow.y), bfhi(ow.y)};
#pragma unroll
        for (int ks = 0; ks < 2; ++ks) acc = mma16(*(const bf16x8*)(sp + (size_t)(16 * et + fr) * 64 + 32 * ks + 8 * fq), qf[ks], acc);
        o[et] = acc; ss += (acc[0] * acc[0] + acc[1] * acc[1]) + (acc[2] * acc[2] + acc[3] * acc[3]); }
    ss += __shfl_xor(ss, 16); ss += __shfl_xor(ss, 32);
    const float rstd = rsqrtf(ss * (1.f / 128.f) + EPS);
    f32x4 gv[8]; u32x2 rv[8];
#pragma unroll
    for (int et = 0; et < 8; ++et) { const int e = h * 128 + 16 * et + 4 * fq; gv[et] = *(const f32x4*)(F.A->in[I_GOUTG] + e); rv[et] = *(const u32x2*)(F.p() + t * PN + PC_R + e); }
#pragma unroll
    for (int et = 0; et < 8; ++et) { const int e = h * 128 + 16 * et + 4 * fq; const f32x4 g = gv[et];
        const u32x2 rr = rv[et]; const float r0 = bflo(rr.x), r1 = bfhi(rr.x), r2 = bflo(rr.y), r3 = bfhi(rr.y);
        u32x2 ov; ov.x = cvt_pk_bf16(o[et][0] * rstd * g.x * r0 * sigmoidf_(r0), o[et][1] * rstd * g.y * r1 * sigmoidf_(r1));
        ov.y = cvt_pk_bf16(o[et][2] * rstd * g.z * r2 * sigmoidf_(r2), o[et][3] * rstd * g.w * r3 * sigmoidf_(r3));
        *(u32x2*)(F.oab() + t * D + e) = ov; }
}

struct ProbSeg {
    static constexpr bool GATHER = false, FP8 = false; static constexpr int WSCALE = FP8_WSCALE;
    int K, lda, ldb, G, c; const bf16_t *oab, *Wpab_t;
    __device__ __forceinline__ bool next(int i, Unit& u) const { const int L = (i >> 1) * G + c; if (L >= 256) return false; pg8::map_tile(L, 64, 4, u.pm, u.pn); u.aux = i & 1; return true; }
    __device__ __forceinline__ const char* a_base(const Unit& u) const { return (const char*)(oab + (size_t)u.pm * 256 * D + u.aux * 512); }
    __device__ __forceinline__ const char* b_base(const Unit& u) const { return (const char*)(Wpab_t + (size_t)u.pn * 256 * D + u.aux * 512); }
    __device__ __forceinline__ unsigned a_off(const Unit&, int row, int C) const { return (unsigned)(row * D + C) * 2u; }
};
struct EpiMix {
    static constexpr bool MID = false, STAGE = false;
    const bf16_t* p; bf16_t* mix;
    __device__ __forceinline__ void operator()(const f32x4 (&acc)[2][2][4][2], const Unit& u, int wr, int wc, int fr, int fq) const {
        asm volatile("" : "+v"(fr), "+v"(fq));
        const int row0 = u.pm * 256 + wr * 64 + fr, col0 = u.pn * 256 + wc * 32 + 8 * fq, gc = u.aux ? PC_GB : PC_GA;
#pragma unroll
        for (int ai = 0; ai < 2; ++ai) {
            u32x4 gw[4][2], pw[4][2];
#pragma unroll
            for (int m = 0; m < 4; ++m)
#pragma unroll
                for (int bj = 0; bj < 2; ++bj) { const size_t row = (size_t)(row0 + ai * 128 + m * 16);
                    gw[m][bj] = *(const u32x4*)(p + row * PN + gc + col0 + bj * 128);
                    pw[m][bj] = u.aux ? *(const u32x4*)(mix + row * D + col0 + bj * 128) : (u32x4){0u, 0u, 0u, 0u}; }
#pragma unroll
            for (int m = 0; m < 4; ++m)
#pragma unroll
                for (int bj = 0; bj < 2; ++bj) { const size_t row = (size_t)(row0 + ai * 128 + m * 16); float g[8], pv[8], v[8]; unpack8(gw[m][bj], g); unpack8(pw[m][bj], pv);
#pragma unroll
                    for (int j = 0; j < 4; ++j) { v[j] = acc[ai][bj][m][0][j] * g[j] + pv[j]; v[4 + j] = acc[ai][bj][m][1][j] * g[4 + j] + pv[4 + j]; }
                    *(u32x4*)(mix + row * D + col0 + bj * 128) = pack8(v); } }
    }
};

struct EpiMix2 {
    static constexpr bool MID = true, STAGE = false;
    const bf16_t* p; bf16_t* mix;
    __device__ __forceinline__ void mid(f32x4 (&acc)[2][2][4][2], const Unit& u, int wr, int wc, int fr, int fq) const {
        asm volatile("" : "+v"(fr), "+v"(fq));
        const int row0 = u.pm * 256 + wr * 64 + fr, col0 = u.pn * 256 + wc * 32 + 8 * fq;
#pragma unroll
        for (int ai = 0; ai < 2; ++ai) { u32x4 ga[4][2], gb[4][2];
#pragma unroll
            for (int m = 0; m < 4; ++m)
#pragma unroll
                for (int bj = 0; bj < 2; ++bj) { const size_t row = (size_t)(row0 + ai * 128 + m * 16); ga[m][bj] = *(const u32x4*)(p + row * PN + PC_GA + col0 + bj * 128); gb[m][bj] = *(const u32x4*)(p + row * PN + PC_GB + col0 + bj * 128); }
#pragma unroll
            for (int m = 0; m < 4; ++m)
#pragma unroll
                for (int bj = 0; bj < 2; ++bj) { float a[8], b[8]; unpack8(ga[m][bj], a); unpack8(gb[m][bj], b);
#pragma unroll
                    for (int j = 0; j < 4; ++j) { acc[ai][bj][m][0][j] *= a[j] * __builtin_amdgcn_rcpf(fmaxf(b[j], 1e-20f)); acc[ai][bj][m][1][j] *= a[4 + j] * __builtin_amdgcn_rcpf(fmaxf(b[4 + j], 1e-20f)); } } }
    }
    __device__ __forceinline__ void operator()(const f32x4 (&acc)[2][2][4][2], const Unit& u, int wr, int wc, int fr, int fq) const {
        asm volatile("" : "+v"(fr), "+v"(fq));
        const int row0 = u.pm * 256 + wr * 64 + fr, col0 = u.pn * 256 + wc * 32 + 8 * fq;
#pragma unroll
        for (int ai = 0; ai < 2; ++ai) { u32x4 gb[4][2];
#pragma unroll
            for (int m = 0; m < 4; ++m)
#pragma unroll
                for (int bj = 0; bj < 2; ++bj) gb[m][bj] = *(const u32x4*)(p + (size_t)(row0 + ai * 128 + m * 16) * PN + PC_GB + col0 + bj * 128);
#pragma unroll
            for (int m = 0; m < 4; ++m)
#pragma unroll
                for (int bj = 0; bj < 2; ++bj) { float b[8], v[8]; unpack8(gb[m][bj], b);
#pragma unroll
                    for (int j = 0; j < 4; ++j) { v[j] = acc[ai][bj][m][0][j] * fmaxf(b[j], 1e-20f); v[4 + j] = acc[ai][bj][m][1][j] * fmaxf(b[4 + j], 1e-20f); }
                    *(u32x4*)(mix + (size_t)(row0 + ai * 128 + m * 16) * D + col0 + bj * 128) = pack8(v); } }
    }
};

template <bool Q8 = false, int WS_ = FP8_WSCALE> struct ProbStdT {
    static constexpr bool GATHER = false, FP8 = Q8; static constexpr int WSCALE = WS_, EB = Q8 ? 1 : 2;
    int K, lda, ldb, G, c; const void *A, *Bt;
    __device__ __forceinline__ bool next(int i, Unit& u) const { const int L = i * G + c; if (L >= 256) return false; pg8::map_tile(L, 64, 4, u.pm, u.pn); u.aux = 0; return true; }
    __device__ __forceinline__ const char* a_base(const Unit& u) const { return (const char*)A + (size_t)u.pm * 256 * D * EB; }
    __device__ __forceinline__ const char* b_base(const Unit& u) const { return (const char*)Bt + (size_t)u.pn * 256 * D * EB; }
    __device__ __forceinline__ unsigned a_off(const Unit&, int row, int C) const { return (unsigned)(row * D * EB + C * 2); }
};
typedef ProbStdT<false> ProbStd;
template <bool RESF32> struct EpiRes {
    static constexpr bool MID = false, STAGE = false;
    const void* res; bf16_t* outb; float* ssq; unsigned char* outq; const float* qgain;
    __device__ __forceinline__ void operator()(const f32x4 (&acc)[2][2][4][2], const Unit& u, int wr, int wc, int fr, int fq) const {
        asm volatile("" : "+v"(fr), "+v"(fq));
        const int row0 = u.pm * 256 + wr * 64 + fr, col0 = u.pn * 256 + wc * 32 + 8 * fq;
#pragma unroll
        for (int ai = 0; ai < 2; ++ai) {
            f32x4 rf[4][2][2]; u32x4 rb[4][2];
#pragma unroll
            for (int m = 0; m < 4; ++m)
#pragma unroll
                for (int bj = 0; bj < 2; ++bj) { const size_t off = (size_t)(row0 + ai * 128 + m * 16) * D + col0 + bj * 128;
                    if (RESF32) { rf[m][bj][0] = *(const f32x4*)((const float*)res + off); rf[m][bj][1] = *(const f32x4*)((const float*)res + off + 4); }
                    else rb[m][bj] = *(const u32x4*)((const bf16_t*)res + off); }
#pragma unroll
            for (int m = 0; m < 4; ++m) { const size_t row = (size_t)(row0 + ai * 128 + m * 16); float sq = 0.f;
#pragma unroll
                for (int bj = 0; bj < 2; ++bj) { float r[8], v[8];
                    if (RESF32) { r[0] = rf[m][bj][0].x; r[1] = rf[m][bj][0].y; r[2] = rf[m][bj][0].z; r[3] = rf[m][bj][0].w; r[4] = rf[m][bj][1].x; r[5] = rf[m][bj][1].y; r[6] = rf[m][bj][1].z; r[7] = rf[m][bj][1].w; }
                    else unpack8(rb[m][bj], r);
#pragma unroll
                    for (int j = 0; j < 4; ++j) { v[j] = acc[ai][bj][m][0][j] + r[j]; v[4 + j] = acc[ai][bj][m][1][j] + r[4 + j]; }
#pragma unroll
                    for (int j = 0; j < 8; ++j) sq += v[j] * v[j];
                    *(u32x4*)(outb + row * D + col0 + bj * 128) = pack8(v);
                    if (outq) *(u32x2*)(outq + row * D + col0 + bj * 128) = pack8_fp8(v); }
                sq += __shfl_xor(sq, 16); sq += __shfl_xor(sq, 32);
                if (fq == 0) ssq[row * 16 + u.pn * 4 + wc] = sq; } }
    }
};
__device__ __forceinline__ float row_rs(const float* ssq, size_t row) {
    const f32x4 a = *(const f32x4*)(ssq + row * 16), b = *(const f32x4*)(ssq + row * 16 + 4), c = *(const f32x4*)(ssq + row * 16 + 8), d = *(const f32x4*)(ssq + row * 16 + 12);
    const float s = ((a.x + a.y) + (a.z + a.w)) + ((b.x + b.y) + (b.z + b.w)) + ((c.x + c.y) + (c.z + c.w)) + ((d.x + d.y) + (d.z + d.w));
    return rsqrtf(s * (1.f / D) + EPS);
}
struct EpiScale {
    static constexpr bool MID = false, STAGE = false;
    const float* ssq; bf16_t* outb;
    __device__ __forceinline__ void operator()(const f32x4 (&acc)[2][2][4][2], const Unit& u, int wr, int wc, int fr, int fq) const {
        asm volatile("" : "+v"(fr), "+v"(fq));
        const int row0 = u.pm * 256 + wr * 64 + fr, col0 = u.pn * 256 + wc * 32 + 8 * fq;
        float rs[2][4];
#pragma unroll
        for (int ai = 0; ai < 2; ++ai)
#pragma unroll
            for (int m = 0; m < 4; ++m) rs[ai][m] = row_rs(ssq, (size_t)(row0 + ai * 128 + m * 16));
#pragma unroll
        for (int ai = 0; ai < 2; ++ai)
#pragma unroll
            for (int m = 0; m < 4; ++m) { const size_t row = (size_t)(row0 + ai * 128 + m * 16);
#pragma unroll
                for (int bj = 0; bj < 2; ++bj) { float v[8];
#pragma unroll
                    for (int j = 0; j < 4; ++j) { v[j] = acc[ai][bj][m][0][j] * rs[ai][m]; v[4 + j] = acc[ai][bj][m][1][j] * rs[ai][m]; }
                    *(u32x4*)(outb + row * D + col0 + bj * 128) = pack8(v); } }
    }
};

__device__ __forceinline__ void attn_unit(Frame& F, int unit) {
    const int tid = F.tid, w = F.wave, lane = F.lane, fr = lane & 15, fq = lane >> 4;
    const int b = unit >> 5, h = (unit >> 3) & 3, qb = unit & 7;
    const size_t tq = (size_t)b * SEQ + qb * 256 + 32 * w;
    LAS unsigned char* const bufs[2] = {F.lds, F.lds + 36864};
    const bf16_t* kg = F.kmem() + (size_t)(b * 256 + (tid >> 1)) * D + h * 256 + (tid & 1) * 32;
    const int kls = (tid >> 1) * 144 + (tid & 1) * 64;
    const bf16_t* vg = F.vt() + (size_t)(h * 256 + (tid >> 3)) * TM + b * 256 + (tid & 7) * 32;
    const int vls = (tid >> 3) * 528 + (tid & 7) * 64;
    u32x4 st[4];
#pragma unroll
    for (int i = 0; i < 4; ++i) st[i] = *(const u32x4*)(kg + 8 * i);
#pragma unroll
    for (int i = 0; i < 4; ++i) *(LAS u32x4*)(bufs[0] + kls + 16 * i) = st[i];
    __syncthreads();
    f32x4 s[16][2];
#pragma unroll
    for (int nt = 0; nt < 16; ++nt) { s[nt][0] = (f32x4){0.f, 0.f, 0.f, 0.f}; s[nt][1] = (f32x4){0.f, 0.f, 0.f, 0.f}; }
#pragma unroll
    for (int c = 0; c < 4; ++c) {
        if (c < 3) {
#pragma unroll
            for (int i = 0; i < 4; ++i) st[i] = *(const u32x4*)(kg + 64 * (c + 1) + 8 * i); }
        else {
#pragma unroll
            for (int i = 0; i < 4; ++i) st[i] = *(const u32x4*)(vg + 8 * i); }
        LAS unsigned char* kb = bufs[c & 1];
        bf16x8 qf[2][2];
#pragma unroll
        for (int qt = 0; qt < 2; ++qt)
#pragma unroll
            for (int ks = 0; ks < 2; ++ks) qf[qt][ks] = *(const bf16x8*)(F.q() + (tq + 16 * qt + fr) * D + h * 256 + 64 * c + 32 * ks + 8 * fq);
#pragma unroll
        for (int nt = 0; nt < 16; ++nt)
#pragma unroll
            for (int ks = 0; ks < 2; ++ks) { const bf16x8 a = *(const LAS bf16x8*)(kb + (16 * nt + fr) * 144 + (32 * ks + 8 * fq) * 2);
                s[nt][0] = mma16(a, qf[0][ks], s[nt][0]); s[nt][1] = mma16(a, qf[1][ks], s[nt][1]); }
        if (c < 3) {
#pragma unroll
            for (int i = 0; i < 4; ++i) *(LAS u32x4*)(bufs[(c + 1) & 1] + kls + 16 * i) = st[i]; }
        __syncthreads();
    }
#pragma unroll
    for (int i = 0; i < 4; ++i) *(LAS u32x4*)(bufs[0] + vls + 16 * i) = st[i];
    float inv[2]; bf16x8 pb[2][8];
#pragma unroll
    for (int qt = 0; qt < 2; ++qt) { float mx = s[0][qt][0];
#pragma unroll
        for (int nt = 0; nt < 16; ++nt)
#pragma unroll
            for (int r = 0; r < 4; ++r) mx = fmaxf(mx, s[nt][qt][r]);
        mx = fmaxf(mx, __shfl_xor(mx, 16)); mx = fmaxf(mx, __shfl_xor(mx, 32));
        float sum = 0.f;
#pragma unroll
        for (int nt = 0; nt < 16; ++nt)
#pragma unroll
            for (int r = 0; r < 4; ++r) { const float e = __expf(s[nt][qt][r] - mx); s[nt][qt][r] = e; sum += e; }
        sum += __shfl_xor(sum, 16); sum += __shfl_xor(sum, 32);
        inv[qt] = __builtin_amdgcn_rcpf(sum);
#pragma unroll
        for (int sk = 0; sk < 8; ++sk) { const float pv[8] = {s[2 * sk][qt][0], s[2 * sk][qt][1], s[2 * sk][qt][2], s[2 * sk][qt][3], s[2 * sk + 1][qt][0], s[2 * sk + 1][qt][1], s[2 * sk + 1][qt][2], s[2 * sk + 1][qt][3]};
            const u32x4 pk = pack8(pv); pb[qt][sk] = __builtin_bit_cast(bf16x8, pk); } }
    __syncthreads();
#pragma unroll
    for (int c = 0; c < 4; ++c) {
        if (c < 3) {
#pragma unroll
            for (int i = 0; i < 4; ++i) st[i] = *(const u32x4*)(vg + (size_t)64 * (c + 1) * TM + 8 * i); }
        LAS unsigned char* vb = bufs[c & 1];
#pragma unroll
        for (int dt = 0; dt < 4; ++dt) { f32x4 o0 = {0.f, 0.f, 0.f, 0.f}, o1 = {0.f, 0.f, 0.f, 0.f};
#pragma unroll
            for (int sk = 0; sk < 8; ++sk) { const LAS unsigned char* vp = vb + (16 * dt + fr) * 528 + (32 * sk + 4 * fq) * 2;
                const u32x2 lo = *(const LAS u32x2*)vp, hi = *(const LAS u32x2*)(vp + 32);
                const u32x4 av = {lo.x, lo.y, hi.x, hi.y}; const bf16x8 a = __builtin_bit_cast(bf16x8, av);
                o0 = mma16(a, pb[0][sk], o0); o1 = mma16(a, pb[1][sk], o1); }
            const int col = h * 256 + 64 * c + 16 * dt + 4 * fq;
            int w0 = 0, w1 = 0;
            w0 = __builtin_amdgcn_cvt_pk_fp8_f32(o0[0] * inv[0], o0[1] * inv[0], w0, false); w0 = __builtin_amdgcn_cvt_pk_fp8_f32(o0[2] * inv[0], o0[3] * inv[0], w0, true);
            w1 = __builtin_amdgcn_cvt_pk_fp8_f32(o1[0] * inv[1], o1[1] * inv[1], w1, false); w1 = __builtin_amdgcn_cvt_pk_fp8_f32(o1[2] * inv[1], o1[3] * inv[1], w1, true);
            *(int*)((unsigned char*)F.ao() + (tq + fr) * D + col) = w0; *(int*)((unsigned char*)F.ao() + (tq + 16 + fr) * D + col) = w1; }
        if (c < 3) {
#pragma unroll
            for (int i = 0; i < 4; ++i) *(LAS u32x4*)(bufs[(c + 1) & 1] + vls + 16 * i) = st[i]; }
        __syncthreads();
    }
}

__device__ __forceinline__ void router_item(Frame& F, int item) {
    const int w = F.wave, lane = F.lane, fr = lane & 15, fq = lane >> 4;
    const size_t t0 = (size_t)item * 16;
    LAS float* lg = (LAS float*)(F.lds + ROUTER_OFF) + w * (16 * 33 + 64);
    LAS int* ex = (LAS int*)(lg + 16 * 33);
    f32x4 acc[2] = {{0.f, 0.f, 0.f, 0.f}, {0.f, 0.f, 0.f, 0.f}};
    const float rsl = row_rs(F.ssq2(), t0 + fr);
    for (int k0 = 0; k0 < 32; k0 += 8) { bf16x8 a[8], b0[8], b1[8];
#pragma unroll
        for (int i = 0; i < 8; ++i) { a[i] = *(const bf16x8*)(F.x2b() + (t0 + fr) * D + 32 * (k0 + i) + 8 * fq);
            b0[i] = *(const bf16x8*)(F.Wr_t() + (size_t)fr * D + 32 * (k0 + i) + 8 * fq); b1[i] = *(const bf16x8*)(F.Wr_t() + (size_t)(16 + fr) * D + 32 * (k0 + i) + 8 * fq); }
#pragma unroll
        for (int i = 0; i < 8; ++i) { acc[0] = mma16(a[i], b0[i], acc[0]); acc[1] = mma16(a[i], b1[i], acc[1]);
            const int col = 32 * (k0 + i) + 8 * fq; const f32x4 g0 = *(const f32x4*)(F.A->in[I_NFFNG] + col), g1 = *(const f32x4*)(F.A->in[I_NFFNG] + col + 4);
            float xv[8]; unpack8(__builtin_bit_cast(u32x4, a[i]), xv);
            xv[0] *= rsl * g0.x; xv[1] *= rsl * g0.y; xv[2] *= rsl * g0.z; xv[3] *= rsl * g0.w; xv[4] *= rsl * g1.x; xv[5] *= rsl * g1.y; xv[6] *= rsl * g1.z; xv[7] *= rsl * g1.w;
            *(u32x2*)(F.x2q() + (t0 + fr) * D + col) = pack8_fp8(xv); } }
#pragma unroll
    for (int r = 0; r < 4; ++r)
#pragma unroll
        for (int nt = 0; nt < 2; ++nt) lg[(4 * fq + r) * 33 + 16 * nt + fr] = acc[nt][r];
    LDS_WAIT();
    float rs = 0.f, gk[4] = {0.f, 0.f, 0.f, 0.f};
    if (lane < 16) { const size_t t = t0 + lane; rs = row_rs(F.ssq2(), t);
        float v[32];
#pragma unroll
        for (int e = 0; e < 32; ++e) v[e] = lg[lane * 33 + e] * rs + F.A->in[I_BR][e];
        unsigned taken = 0u; float tv[4];
#pragma unroll
        for (int k = 0; k < 4; ++k) { float best = -INFINITY; int bi = 0;
#pragma unroll
            for (int e = 0; e < 32; ++e) { const bool ok = !((taken >> e) & 1u) && (v[e] > best); best = ok ? v[e] : best; bi = ok ? e : bi; }
            taken |= 1u << bi; tv[k] = best; ex[lane * 4 + k] = bi; }
        float sum = 0.f;
#pragma unroll
        for (int k = 0; k < 4; ++k) { gk[k] = __expf(tv[k] - tv[0]); sum += gk[k]; }
        const float inv = 1.f / sum;
        *(f32x4*)(F.gates() + t * 4) = (f32x4){gk[0] * inv, gk[1] * inv, gk[2] * inv, gk[3] * inv}; }
    LDS_WAIT();
    const int me = ex[lane]; const float my_rs = __shfl(rs, lane >> 2);
    int rank = 0, mytot = 0;
#pragma unroll
    for (int e = 0; e < 32; ++e) { const unsigned long long m = __ballot(me == e); const int below = __builtin_popcountll(m & ((1ull << lane) - 1ull));
        rank = (me == e) ? below : rank; mytot = (lane == e) ? __builtin_popcountll(m) : mytot; }
    unsigned base = 0u;
    if (lane < 32 && mytot > 0) base = atomicAdd(F.ctl + CW_CNT + lane, (unsigned)mytot);
    const unsigned slot = (unsigned)__shfl((int)base, me) + (unsigned)rank;
    F.list()[me * ECAP + slot] = (int)(t0 * 4 + lane); (void)my_rs;
    LDS_WAIT();
}

__device__ __forceinline__ void expert_tables(Frame& F) {
    LAS int* tab = (LAS int*)(F.lds + TAB_OFF);
    if (F.tid < 32) tab[F.tid] = (int)__hip_atomic_load(F.ctl + CW_CNT + F.tid, __ATOMIC_RELAXED, __HIP_MEMORY_SCOPE_AGENT);
    __syncthreads();
    if (F.tid == 0) { int s = 0; for (int e = 0; e < 32; ++e) { tab[32 + e] = s; s += (tab[e] + 255) >> 8; } tab[64] = s; }
    __syncthreads();
}
template <int NTN, bool GATH> struct ProbExp {
    static constexpr bool GATHER = GATH, gather = GATH, FP8 = true; static constexpr int WSCALE = FP8_WSCALE;
    int K, lda, ldb, G, c; const LAS int* tab; const unsigned char* A; const unsigned char* Bt; const int* list; mutable int ehint;
    __device__ __forceinline__ bool next(int i, Unit& u) const {
        const int L = i * G + c; if (L >= NTN * tab[64]) return false;
        int e = ehint;
#pragma unroll 1
        while (e < 31 && L >= NTN * tab[32 + e + 1]) ++e;
        ehint = e;
        const int r = L - NTN * tab[32 + e], mte = tab[32 + e + 1] - tab[32 + e];
        u.aux = e; u.pn = r / mte; u.pm = r % mte; return true;
    }
    __device__ __forceinline__ const char* a_base(const Unit& u) const { return gather ? (const char*)A : (const char*)(A + (size_t)(tab[32 + u.aux] + u.pm) * 256 * D); }
    __device__ __forceinline__ const char* b_base(const Unit& u) const { return (const char*)(Bt + ((size_t)u.aux * NTN + u.pn) * 256 * D); }
    __device__ __forceinline__ unsigned a_off(const Unit& u, int row, int C) const {
        if (!gather) return (unsigned)(row * D + C * 2);
        const int slot = u.pm * 256 + row; const int av = list[u.aux * ECAP + slot];
        const int a = slot < tab[u.aux] ? av : 0;
        return (unsigned)((a >> 2) * D + C * 2);
    }
};
struct EpiE1 {
    static constexpr bool MID = false, STAGE = true;
    const LAS int* tab; const float* lscale; const float* b1; unsigned char* act;
    __device__ __forceinline__ void stage(const Unit& u, int wid, int lane, LAS unsigned char* lds) const {
        if (wid < 4) { const float* src = b1 + (size_t)u.aux * 2048 + ((wid & 2) ? 1024 : 0) + u.pn * 128 + (wid & 1) * 64 + lane;
            __builtin_amdgcn_global_load_lds((const unsigned*)src, (LAS unsigned*)(lds + EPI_OFF + wid * 256), 4, 0, 0); }
    }
    __device__ __forceinline__ void operator()(const f32x4 (&acc)[2][2][4][2], const Unit& u, int wr, int wc, int fr, int fq) const {
        asm volatile("" : "+v"(fr), "+v"(fq));
        const int e = u.aux; const size_t rbase = (size_t)(tab[32 + e] + u.pm) * 256;
        const int j0 = u.pn * 128 + wc * 32 + 8 * fq;
        const LAS float* bp = (const LAS float*)((const LAS unsigned char*)tab - TAB_OFF + EPI_OFF) + wc * 32 + 8 * fq;
        const f32x4 bg0 = *(const LAS f32x4*)bp, bg1 = *(const LAS f32x4*)(bp + 4), bl0 = *(const LAS f32x4*)(bp + 128), bl1 = *(const LAS f32x4*)(bp + 132);
        const float bg[8] = {bg0.x, bg0.y, bg0.z, bg0.w, bg1.x, bg1.y, bg1.z, bg1.w}, bl[8] = {bl0.x, bl0.y, bl0.z, bl0.w, bl1.x, bl1.y, bl1.z, bl1.w};
#pragma unroll
        for (int ai = 0; ai < 2; ++ai)
#pragma unroll
            for (int m = 0; m < 4; ++m) { const int rt = ai * 128 + wr * 64 + m * 16 + fr; float v[8];
#pragma unroll
                for (int jp = 0; jp < 4; ++jp) {
                    const f32x2 ag = {acc[ai][0][m][jp >> 1][2 * (jp & 1)], acc[ai][0][m][jp >> 1][2 * (jp & 1) + 1]}, al = {acc[ai][1][m][jp >> 1][2 * (jp & 1)], acc[ai][1][m][jp >> 1][2 * (jp & 1) + 1]};
                    const f32x2 bg2 = {bg[2 * jp], bg[2 * jp + 1]}, bl2 = {bl[2 * jp], bl[2 * jp + 1]};
                    const f32x2 ga = ag + bg2, la = al + bl2;
                    const f32x2 glu = {fminf(ga.x, 7.0f), fminf(ga.y, 7.0f)}, lin = {fminf(fmaxf(la.x, -7.0f), 7.0f), fminf(fmaxf(la.y, -7.0f), 7.0f)};
                    const f32x2 t = glu * (-1.702f * 1.4426950408889634f);
                    const f32x2 d = (f32x2){__builtin_amdgcn_exp2f(t.x), __builtin_amdgcn_exp2f(t.y)} + 1.0f;
                    const f32x2 r = {__builtin_amdgcn_rcpf(d.x), __builtin_amdgcn_rcpf(d.y)};
                    const f32x2 o = ((lin + 1.0f) * glu) * r;
                    v[2 * jp] = o.x; v[2 * jp + 1] = o.y; }
                *(u32x2*)(act + (rbase + rt) * D + j0) = pack8_fp8(v); }
    }
};
struct EpiE2 {
    static constexpr bool MID = false, STAGE = true;
    const LAS int* tab; const int* list; const float* b2; unsigned char* yb; unsigned char* dummy;
    __device__ __forceinline__ void stage(const Unit& u, int wid, int lane, LAS unsigned char* lds) const {
        const unsigned* src = (wid < 4) ? (const unsigned*)(b2 + (size_t)u.aux * D + u.pn * 256 + wid * 64 + lane) : (const unsigned*)(list + u.aux * ECAP + u.pm * 256 + (wid - 4) * 64 + lane);
        __builtin_amdgcn_global_load_lds(src, (LAS unsigned*)(lds + EPI_OFF + wid * 256), 4, 0, 0);
    }
    __device__ __forceinline__ void operator()(const f32x4 (&acc)[2][2][4][2], const Unit& u, int wr, int wc, int fr, int fq) const {
        asm volatile("" : "+v"(fr), "+v"(fq));
        const int e = u.aux, cnt = tab[e]; const int col0 = u.pn * 256 + wc * 32 + 8 * fq;
        const LAS float* sb = (const LAS float*)((const LAS unsigned char*)tab - TAB_OFF + EPI_OFF); const LAS int* sl = (const LAS int*)(sb + 256);
        float bb[2][8];
#pragma unroll
        for (int bj = 0; bj < 2; ++bj) { const f32x4 x0 = *(const LAS f32x4*)(sb + bj * 128 + wc * 32 + 8 * fq), x1 = *(const LAS f32x4*)(sb + bj * 128 + wc * 32 + 8 * fq + 4);
            bb[bj][0] = x0.x; bb[bj][1] = x0.y; bb[bj][2] = x0.z; bb[bj][3] = x0.w; bb[bj][4] = x1.x; bb[bj][5] = x1.y; bb[bj][6] = x1.z; bb[bj][7] = x1.w; }
        int aidx[2][4];
#pragma unroll
        for (int ai = 0; ai < 2; ++ai)
#pragma unroll
            for (int m = 0; m < 4; ++m) aidx[ai][m] = sl[ai * 128 + wr * 64 + m * 16 + fr];
#pragma unroll
        for (int ai = 0; ai < 2; ++ai)
#pragma unroll
            for (int m = 0; m < 4; ++m) { const int slot = u.pm * 256 + ai * 128 + wr * 64 + m * 16 + fr;
                unsigned char* rowp = (slot < cnt) ? yb + (size_t)aidx[ai][m] * D : dummy;
#pragma unroll
                for (int bj = 0; bj < 2; ++bj) { float v[8];
#pragma unroll
                    for (int j = 0; j < 4; ++j) { v[j] = acc[ai][bj][m][0][j] + bb[bj][j]; v[4 + j] = acc[ai][bj][m][1][j] + bb[bj][4 + j]; }
                    *(u32x2*)(rowp + col0 + bj * 128) = pack8_fp8(v); } }
    }
};

struct CombTok { u32x4 x[2]; u32x2 y[2][4]; f32x4 g; };
__device__ __forceinline__ void comb_load(Frame& F, int t, int lane, CombTok& c) {
    c.g = *(const f32x4*)(F.gates() + (size_t)t * 4);
#pragma unroll
    for (int hf = 0; hf < 2; ++hf) { const int col = hf * 512 + lane * 8; c.x[hf] = *(const u32x4*)(F.x2b() + (size_t)t * D + col);
#pragma unroll
        for (int k = 0; k < 4; ++k) c.y[hf][k] = *(const u32x2*)((const unsigned char*)F.yb() + ((size_t)t * 4 + k) * D + col); }
}
__device__ __forceinline__ void comb_finish(Frame& F, int t, int lane, const CombTok& c) {
    const float gk[4] = {c.g.x, c.g.y, c.g.z, c.g.w}; float x[2][8]; float ss = 0.f;
#pragma unroll
    for (int hf = 0; hf < 2; ++hf) { unpack8(c.x[hf], x[hf]);
#pragma unroll
        for (int k = 0; k < 4; ++k) { float y[8]; unpack8_fp8(c.y[hf][k], y);
#pragma unroll
            for (int j = 0; j < 8; ++j) x[hf][j] += gk[k] * y[j]; }
#pragma unroll
        for (int j = 0; j < 8; ++j) ss += x[hf][j] * x[hf][j]; }
    const float rs = rsqrtf(wave_sum(ss) * (1.f / D) + EPS);
#pragma unroll
    for (int hf = 0; hf < 2; ++hf) { const int col = hf * 512 + lane * 8; const f32x4 g0 = *(const f32x4*)(F.A->in[I_NFING] + col), g1 = *(const f32x4*)(F.A->in[I_NFING] + col + 4);
        *(f32x4*)(F.A->out + (size_t)t * D + col) = (f32x4){x[hf][0] * rs * g0.x, x[hf][1] * rs * g0.y, x[hf][2] * rs * g0.z, x[hf][3] * rs * g0.w};
        *(f32x4*)(F.A->out + (size_t)t * D + col + 4) = (f32x4){x[hf][4] * rs * g1.x, x[hf][5] * rs * g1.y, x[hf][6] * rs * g1.z, x[hf][7] * rs * g1.w}; }
}
__device__ __forceinline__ void combine_rows(Frame& F) {
    const int gw = F.vcu * 8 + F.wave, NGW = F.G * 8, lane = F.lane;
    if (gw >= T) return;
    CombTok ca, cb; comb_load(F, gw, lane, ca);
    for (int t = gw;;) {
        const bool hb = t + NGW < T; if (hb) comb_load(F, t + NGW, lane, cb);
        comb_finish(F, t, lane, ca); if (!hb) break;
        const bool ha = t + 2 * NGW < T; if (ha) comb_load(F, t + 2 * NGW, lane, ca);
        comb_finish(F, t + NGW, lane, cb); if (!ha) break;
        t += 2 * NGW; }
}

#ifndef DBG_OUT
#define DBG_OUT 0
#endif
#if DBG_OUT
__device__ __forceinline__ void dbg_rows(Frame& F) {
    const int gw = F.vcu * 8 + F.wave, NGW = F.G * 8, lane = F.lane;
    for (int t = gw; t < T; t += NGW) {
#pragma unroll
        for (int hf = 0; hf < 2; ++hf) { const int col = hf * 512 + lane * 8; float x[8];
#pragma unroll
            for (int j = 0; j < 8; ++j) x[j] = 0.f;
            if (DBG_OUT == 1) { for (int m = 0; m < 5; ++m) { if (col + 1024 * m < PN) { float y[8]; unpack8(*(const u32x4*)(F.p() + (size_t)t * PN + col + 1024 * m), y);
#pragma unroll
                for (int j = 0; j < 8; ++j) x[j] += y[j]; } } }
            else if (DBG_OUT == 8) { for (int k = 0; k < 4; ++k) { float y[8]; unpack8_fp8(*(const u32x2*)((const unsigned char*)F.yb() + ((size_t)t * 4 + k) * D + col), y); const float g = F.gates()[t * 4 + k];
#pragma unroll
                for (int j = 0; j < 8; ++j) x[j] += g * y[j]; } }
            else { const bf16_t* B = DBG_OUT == 2 ? F.oab() : DBG_OUT == 3 ? F.mix() : DBG_OUT == 4 ? F.x1b() : DBG_OUT == 5 ? F.q() : DBG_OUT == 6 ? F.ao() : F.x2b();
                unpack8(*(const u32x4*)(B + (size_t)t * D + col), x); }
#pragma unroll
            for (int j = 0; j < 8; ++j) if (!(fabsf(x[j]) < 1e30f)) x[j] = 1e6f;
            *(f32x4*)(F.A->out + (size_t)t * D + col) = (f32x4){x[0], x[1], x[2], x[3]};
            *(f32x4*)(F.A->out + (size_t)t * D + col + 4) = (f32x4){x[4], x[5], x[6], x[7]}; }
    }
}
#endif

__global__ void __launch_bounds__(512, 2) fwd_kernel(Args args) {
    extern __shared__ __attribute__((aligned(16))) unsigned char lds[];
    Frame F;
    F.lds = (LAS unsigned char*)lds; F.MISC = (volatile LAS unsigned*)(F.lds + MISC_OFF);
    F.tid = threadIdx.x; F.lane = F.tid & 63; F.wave = __builtin_amdgcn_readfirstlane(F.tid >> 6);
    F.G = gridDim.x; { const int bx = blockIdx.x; F.vcu = (F.G % 8 == 0) ? (bx % 8) * (F.G / 8) + bx / 8 : bx; }
    F.ctl = (unsigned*)(args.ws + WS_CTL);
    F.A = &args;
    for (int u = F.tid; u < 64; u += 512) ((LAS unsigned*)(F.lds + MISC_OFF))[u] = 0u;
    __syncthreads();
    XcdBarrier bar; bar.bar = F.ctl + CW_BAR; bar.x = 0; bar.st = nullptr;
    if (!MK_PER_PHASE) bar = xcd_barrier_post(F.ctl + CW_BAR, F.MISC + 8);
    const int lo = args.ph_lo, hi = args.ph_hi;
#ifndef PH_MASK
#define PH_MASK 0x3fff
#endif
#define IN(k) (((PH_MASK >> (k)) & 1) && lo <= (k) && (k) < hi)
#ifndef DOUBLE_MASK
#define DOUBLE_MASK 0
#endif
#define REP(k) for (int _rep = 0; _rep < ((((DOUBLE_MASK) >> (k)) & 1) ? 2 : 1); ++_rep, ((((DOUBLE_MASK) >> (k)) & 1) && _rep == 1 ? xcd_barrier(bar) : (void)0))
#define SEAM(k) do { if (IN(k) && IN((k) + 1)) xcd_barrier(bar); } while (0)
    const int c = (int)blockIdx.x;

    if (IN(0)) REP(0) { p0_prologue(F); } SEAM(0);
    if (IN(1)) REP(1) { ProbP1 P{D, D, ProbP1::EB * D, F.G, c, args.ws}; EpiP1 E{args.ws}; pg8::gemm_phase(F.lds, P, E); } SEAM(1);
    if (IN(2)) REP(2) { for (int u = F.vcu; u < 1024; u += F.G) gla_a_unit(F, u); } SEAM(2);
    if (IN(3)) REP(3) { cvt_range(F, CVT_LATE, CVT_EXPERT);
                        if (F.wave < 4) for (int it = F.vcu * 4 + F.wave; it < 1024; it += F.G * 4) gla_sscan_item(F, it);
                        for (int u = F.vcu; u < 512; u += F.G) sgu_unit(F, u); } SEAM(3);
    if (IN(4)) REP(4) { for (int it = F.vcu * 8 + F.wave; it < 4096; it += F.G * 8) gla_out_item(F, it); } SEAM(4);
    if (IN(5)) REP(5) { ProbStd P{D, D, 2 * D, F.G, c, F.oab(), F.Wpab_t()}; EpiMix2 E{F.p(), F.mix()}; pg8::gemm_phase(F.lds, P, E); } SEAM(5);
    if (IN(6)) REP(6) { ProbStd P{D, D, 2 * D, F.G, c, F.mix(), F.Wmo_t()}; EpiRes<true> E{(const void*)F.A->in[I_X], F.x1b(), F.ssq1(), F.x1q(), nullptr}; pg8::gemm_phase(F.lds, P, E); } SEAM(6);
    if (IN(7)) REP(7) { ProbStdT<true, 0x75757575> P{D, D, D, F.G, c, F.x1q(), F.Wq_t()}; EpiScale E{F.ssq1(), F.q()};     pg8::gemm_phase(F.lds, P, E); } SEAM(7);
    if (IN(8)) REP(8) { for (int u = F.vcu; u < 256; u += F.G) attn_unit(F, u); } SEAM(8);
    if (IN(9)) REP(9) { ProbStdT<true> P{D, D, D, F.G, c, F.ao(), F.Wo_t()}; EpiRes<false> E{(const void*)F.x1b(), F.x2b(), F.ssq2(), nullptr, nullptr}; pg8::gemm_phase(F.lds, P, E); } SEAM(9);
    if (IN(10)) REP(10) { for (int it = F.wave * F.G + F.vcu; it < 1024; it += 8 * F.G) router_item(F, it); cvt_expert_dma(F, 0, CVT_I1, F.vcu, F.G); }        SEAM(10);
    if (IN(11)) REP(11) { expert_tables(F); const LAS int* tab = (const LAS int*)(F.lds + TAB_OFF);
        ProbExp<8, true> P{D, D, D, F.G, F.vcu, tab, F.x2q(), (const unsigned char*)F.W1_t(), F.list(), 0}; EpiE1 E{tab, F.lscale(), F.A->in[I_BE1], (unsigned char*)F.act()}; pg8::gemm_phase(F.lds, P, E);
        { const int rem = (8 * tab[64]) % F.G;
          if (F.vcu >= rem) cvt_expert_dma(F, CVT_I1, CVT_I1 + CVT_I2, F.vcu - rem, F.G - rem); } } SEAM(11);
    if (IN(12)) REP(12) { expert_tables(F); const LAS int* tab = (const LAS int*)(F.lds + TAB_OFF);
        ProbExp<4, false> P{D, D, D, F.G, F.vcu, tab, (const unsigned char*)F.act(), (const unsigned char*)F.W2_t(), F.list(), 0}; EpiE2 E{tab, F.list(), F.A->in[I_BE2], (unsigned char*)F.yb(), (unsigned char*)(args.ws + WS_CTL + 512 * 1024)}; pg8::gemm_phase(F.lds, P, E); } SEAM(12);
#if DBG_OUT
    if (lo <= 13 && 13 < hi) { dbg_rows(F); }
#else
    if (IN(13)) REP(13) { combine_rows(F); }
#endif
#undef IN
#undef SEAM
}

extern "C" void kernel_launch(void* const* d_in, const int* in_sizes, int n_in, void* d_out, int out_size, void* d_ws, size_t ws_size, hipStream_t stream) {
    static int grid = 0;
    if (grid == 0) {
        if (n_in != 28 || in_sizes[0] != T * D || out_size != T * D || ws_size < WS_END) { fprintf(stderr, "kernel_launch: unexpected problem (n_in %d, in0 %d, out %d, ws %zu); nothing launched\n", n_in, n_in > 0 ? in_sizes[0] : -1, out_size, ws_size); grid = -1; return; }
        int dev = 0, cus = 0, per_cu = 0;
        if (hipGetDevice(&dev) != hipSuccess || hipDeviceGetAttribute(&cus, hipDeviceAttributeMultiprocessorCount, dev) != hipSuccess) { grid = -1; return; }
        if (hipFuncSetAttribute((const void*)fwd_kernel, hipFuncAttributeMaxDynamicSharedMemorySize, LDS_BYTES) != hipSuccess) { fprintf(stderr, "kernel_launch: hipFuncSetAttribute failed\n"); grid = -1; return; }
        if (hipOccupancyMaxActiveBlocksPerMultiprocessor(&per_cu, (const void*)fwd_kernel, 512, LDS_BYTES) != hipSuccess || per_cu < 1) fprintf(stderr, "kernel_launch: occupancy query reports %d blocks per CU\n", per_cu);
        (void)hipGetLastError();
        grid = cus;
    }
    if (grid < 0) return;
    if (hipMemsetAsync((char*)d_ws + WS_CTL, 0, CTL_ZERO_BYTES, stream) != hipSuccess) { fprintf(stderr, "kernel_launch: memset failed\n"); return; }
    Args a{};
    for (int i = 0; i < 28; ++i) a.in[i] = (const float*)d_in[i];
    a.out = (float*)d_out; a.ws = (unsigned char*)d_ws;
#if MK_PER_PHASE
    for (int ph = 0; ph < NPHASE; ++ph) { a.ph_lo = ph; a.ph_hi = ph + 1; hipLaunchKernelGGL(fwd_kernel, dim3(grid), dim3(512), LDS_BYTES, stream, a); }
#else
    a.ph_lo = 0; a.ph_hi = NPHASE;
    hipLaunchKernelGGL(fwd_kernel, dim3(grid), dim3(512), LDS_BYTES, stream, a);
#endif
}
```

```cpp
#include <hip/hip_runtime.h>
#include <cstdio>
#include <cstdint>

#ifndef P1_FP8
#define P1_FP8 0
#endif
#ifndef MK_PER_PHASE
#define MK_PER_PHASE 0
#endif

#define LAS __attribute__((address_space(3)))
#define GAS __attribute__((address_space(1)))
typedef unsigned short bf16_t;
typedef short bf16x8 __attribute__((ext_vector_type(8)));
typedef float f32x4 __attribute__((ext_vector_type(4)));
typedef float f32x2 __attribute__((ext_vector_type(2)));
typedef unsigned u32x4 __attribute__((ext_vector_type(4)));
typedef unsigned u32x2 __attribute__((ext_vector_type(2)));
typedef int i32x4 __attribute__((ext_vector_type(4)));
typedef int i32x8 __attribute__((ext_vector_type(8)));
#define FP8_WSCALE 0x79797979
constexpr float FP8_WMUL = 64.0f;
typedef GAS unsigned gu32;

constexpr int T = 16384, D = 1024, NBATCH = 8, SEQ = 2048, MEMLEN = 256, TM = NBATCH * MEMLEN;
constexpr int INC = 4624;
constexpr int PN = 4864;
constexpr int PC_Q = 0, PC_K = 256, PC_V = 512, PC_R = 1024, PC_U = 1536, PC_SV = 2048, PC_GA = 2560, PC_GB = 3584, PC_A = 4608;
constexpr int OFF_A = 1536;
constexpr int NE = 32, NASG = T * 4, ECAP = 16384;
constexpr float EPS = 1e-5f;
constexpr int NPHASE = 14;

constexpr size_t MiB = 1u << 20;
constexpr size_t WS_CTL = 0, CTL_ZERO_BYTES = 1 * MiB;
constexpr size_t WS_WR = 1 * MiB, WS_SGUW = 1 * MiB + 256 * 1024, WS_DECAY = 1 * MiB + 512 * 1024;
constexpr size_t WS_WIN = 2 * MiB, WS_WK = 12 * MiB, WS_WV = 14 * MiB, WS_WPAB = 16 * MiB, WS_WMO = 18 * MiB, WS_WQ = 20 * MiB, WS_WO = 22 * MiB;
constexpr size_t WS_SSQ1 = 24 * MiB, WS_SSQ2 = 25 * MiB, WS_LIST = 26 * MiB, WS_LSCALE = 28 * MiB, WS_GATES = 30 * MiB;
constexpr size_t WS_W1 = 32 * MiB, WS_W2 = 160 * MiB, WS_H = 224 * MiB, WS_MEMN = 256 * MiB, WS_KMEM = 260 * MiB, WS_VT = 264 * MiB, WS_QIN = 268 * MiB;
constexpr size_t WS_OINTRA = 276 * MiB, WS_KVT = 308 * MiB, WS_OAB = 340 * MiB, WS_MIX = 372 * MiB, WS_X1B = 404 * MiB, WS_Q = 436 * MiB, WS_AO = 468 * MiB, WS_X2B = 500 * MiB;
constexpr size_t WS_P = 532 * MiB, WS_ACT = 684 * MiB, WS_YB = 828 * MiB, WS_SPT = 956 * MiB, WS_X2Q = 972 * MiB, WS_X1Q = 988 * MiB, WS_SVS = 1004 * MiB, WS_END = 1005 * MiB;
static_assert(WS_P + (size_t)T * PN * 2 <= WS_ACT && WS_ACT + (size_t)(NASG + NE * 256) * 1024 * 2 <= WS_YB && WS_YB + (size_t)NASG * 1024 * 2 <= WS_END, "ws map");
constexpr int CW_CNT = 64;
constexpr int CW_BAR = 4096;

constexpr int RING_BYTES = 131072;
constexpr int TAB_OFF = 139264, MISC_OFF = 141312, ROUTER_OFF = 147456, EPI_OFF = 147456, LDS_BYTES = 157696;

typedef __bf16 bf16x2_t __attribute__((ext_vector_type(2)));
__device__ __forceinline__ unsigned cvt_pk_bf16(float lo, float hi) { const f32x2 v = {lo, hi}; const bf16x2_t b = __builtin_convertvector(v, bf16x2_t); return __builtin_bit_cast(unsigned, b); }
__device__ __forceinline__ bf16_t f2bf(float f) { return (bf16_t)(cvt_pk_bf16(f, 0.f) & 0xffffu); }
__device__ __forceinline__ float bflo(unsigned w) { return __uint_as_float(w << 16); }
__device__ __forceinline__ float bfhi(unsigned w) { return __uint_as_float(w & 0xffff0000u); }
__device__ __forceinline__ float bf2f(bf16_t v) { return __uint_as_float((unsigned)v << 16); }
__device__ __forceinline__ void unpack8(const u32x4 w, float (&f)[8]) { f[0] = bflo(w.x); f[1] = bfhi(w.x); f[2] = bflo(w.y); f[3] = bfhi(w.y); f[4] = bflo(w.z); f[5] = bfhi(w.z); f[6] = bflo(w.w); f[7] = bfhi(w.w); }
__device__ __forceinline__ u32x4 pack8(const float (&f)[8]) { u32x4 w; w.x = cvt_pk_bf16(f[0], f[1]); w.y = cvt_pk_bf16(f[2], f[3]); w.z = cvt_pk_bf16(f[4], f[5]); w.w = cvt_pk_bf16(f[6], f[7]); return w; }
__device__ __forceinline__ u32x2 pack8_fp8(const float (&f)[8]) { int a = 0, b = 0;
    a = __builtin_amdgcn_cvt_pk_fp8_f32(f[0], f[1], a, false); a = __builtin_amdgcn_cvt_pk_fp8_f32(f[2], f[3], a, true);
    b = __builtin_amdgcn_cvt_pk_fp8_f32(f[4], f[5], b, false); b = __builtin_amdgcn_cvt_pk_fp8_f32(f[6], f[7], b, true);
    return (u32x2){(unsigned)a, (unsigned)b}; }
__device__ __forceinline__ void unpack8_fp8(const u32x2 w, float (&f)[8]) {
    const f32x2 a = __builtin_amdgcn_cvt_pk_f32_fp8((int)w.x, false), b = __builtin_amdgcn_cvt_pk_f32_fp8((int)w.x, true), c = __builtin_amdgcn_cvt_pk_f32_fp8((int)w.y, false), d = __builtin_amdgcn_cvt_pk_f32_fp8((int)w.y, true);
    f[0] = a.x; f[1] = a.y; f[2] = b.x; f[3] = b.y; f[4] = c.x; f[5] = c.y; f[6] = d.x; f[7] = d.y; }
__device__ __forceinline__ f32x4 mma16(bf16x8 a, bf16x8 b, f32x4 c) { return __builtin_amdgcn_mfma_f32_16x16x32_bf16(a, b, c, 0, 0, 0); }
__device__ __forceinline__ float wave_sum(float v) {
#pragma unroll
    for (int o = 1; o < 64; o <<= 1) v += __shfl_xor(v, o);
    return v;
}
__device__ __forceinline__ float sigmoidf_(float x) { return __builtin_amdgcn_rcpf(1.0f + __expf(-x)); }
__device__ __forceinline__ float gelu_erf(float v) {
    const float av = fabsf(v), t = __builtin_amdgcn_rcpf(av * 0.2316418882f + 1.0f);
    float q = t * 0.5307027145f + (-0.7265760135f); q = q * t + 0.7107068705f; q = q * t + (-0.142248368f); q = q * t + 0.127414796f; q = q * t;
    const float e = __builtin_amdgcn_exp2f((v * v) * (-0.72134752044f));
    const float m = v * (q * e);
    return v < 0.f ? m : v - m;
}
__device__ __forceinline__ f32x2 gelu_pk(f32x2 v) {
    const f32x2 av = __builtin_elementwise_abs(v), d = av * 0.2316418882f + 1.0f;
    f32x2 t; t.x = __builtin_amdgcn_rcpf(d.x); t.y = __builtin_amdgcn_rcpf(d.y);
    f32x2 q = t * 0.5307027145f + (-0.7265760135f); q = q * t + 0.7107068705f; q = q * t + (-0.142248368f); q = q * t + 0.127414796f; q = q * t;
    const f32x2 s = (v * v) * (-0.72134752044f);
    f32x2 e; e.x = __builtin_amdgcn_exp2f(s.x); e.y = __builtin_amdgcn_exp2f(s.y);
    const f32x2 m = v * (q * e), r = v - m;
    f32x2 o; o.x = v.x < 0.f ? m.x : r.x; o.y = v.y < 0.f ? m.y : r.y; return o;
}
__device__ __forceinline__ f32x2 sigmoid_pk(f32x2 v) {
    const f32x2 t = v * (-1.4426950408889634f); const f32x2 d = (f32x2){__builtin_amdgcn_exp2f(t.x), __builtin_amdgcn_exp2f(t.y)} + 1.0f;
    return (f32x2){__builtin_amdgcn_rcpf(d.x), __builtin_amdgcn_rcpf(d.y)};
}
#define LDS_WAIT() asm volatile("s_waitcnt lgkmcnt(0)" ::: "memory")
#define VM_WAIT() asm volatile("s_waitcnt vmcnt(0)" ::: "memory")

#define XB_TMO      128
#define XB_XCNT(j)  (256  + 64 * (j))
#define XB_XSUB(j)  (1280 + 64 * (j))
#define XB_XGEN(j)  (2304 + 64 * (j))
#define XB_TOP      3328
#define XB_TOPGEN   3392
#define XCD_BAR_WORDS 3456
#define XB_SPIN_CAP (1u << 22)
__device__ __forceinline__ unsigned xb_ld(unsigned* p)              { return __hip_atomic_load(p, __ATOMIC_RELAXED, __HIP_MEMORY_SCOPE_AGENT); }
__device__ __forceinline__ unsigned xb_add(unsigned* p, unsigned v) { return __hip_atomic_fetch_add(p, v, __ATOMIC_RELAXED, __HIP_MEMORY_SCOPE_AGENT); }
__device__ __forceinline__ unsigned xb_xcc_id() { return (unsigned)__builtin_amdgcn_s_getreg((3 << 11) | 20) & 0xFu; }
#define XB_SPIN(cond, bar) do { unsigned _sp = 0; while (cond) { __builtin_amdgcn_s_sleep(1); \
    if ((++_sp & 255u) == 0u) { if (xb_ld(&(bar)[XB_TMO])) break; if (_sp > XB_SPIN_CAP) { atomicAdd(&(bar)[XB_TMO], 1u); break; } } } } while (0)
struct XcdBarrier { unsigned* bar; unsigned x; volatile LAS unsigned* st; };
__device__ __forceinline__ XcdBarrier xcd_barrier_post(unsigned* bar, volatile LAS unsigned* st) {
    XcdBarrier b; b.bar = bar; b.x = xb_xcc_id(); b.st = st;
    if (threadIdx.x == 0) (void)xb_add(&bar[XB_XCNT(b.x)], 1u);
    return b;
}
__device__ __forceinline__ void xcd_barrier_complete(unsigned* bar, unsigned x, unsigned& nloc, unsigned& nx) {
    const unsigned G = gridDim.x * gridDim.y * gridDim.z;
    unsigned sum, cnt, mine, sp = 0u;
    for (;;) {
        sum = 0u; cnt = 0u; mine = 0u;
#pragma unroll
        for (unsigned j = 0; j < 16; ++j) { const unsigned c = xb_ld(&bar[XB_XCNT(j)]); sum += c; cnt += (c > 0u) ? 1u : 0u; mine = (j == x) ? c : mine; }
        if (sum == G) break;
        __builtin_amdgcn_s_sleep(1);
        if ((++sp & 255u) == 0u) { if (xb_ld(&bar[XB_TMO])) break; if (sp > XB_SPIN_CAP) { atomicAdd(&bar[XB_TMO], 1u); break; } }
    }
    nloc = mine > 0u ? mine : 1u; nx = cnt > 0u ? cnt : 1u;
}
__device__ __forceinline__ void xcd_barrier(const XcdBarrier& b) {
    asm volatile("s_waitcnt vmcnt(0)" ::: "memory");
    __syncthreads();
    if (threadIdx.x == 0) {
        unsigned* bar = b.bar;
        __builtin_amdgcn_s_waitcnt(0);
        unsigned nloc = b.st[0], nx = b.st[1];
        if (nloc == 0u) { xcd_barrier_complete(bar, b.x, nloc, nx); b.st[0] = nloc; b.st[1] = nx; }
        const unsigned old = xb_add(&bar[XB_XSUB(b.x)], 1u);
        const unsigned gen = old / nloc;
        if (old + 1u == (gen + 1u) * nloc) {
            __builtin_amdgcn_fence(__ATOMIC_RELEASE, "agent");
            asm volatile("s_waitcnt vmcnt(0)" ::: "memory");
            const unsigned og = xb_add(&bar[XB_TOP], 1u);
            const unsigned tg = og / nx;
            if (og + 1u == (tg + 1u) * nx) xb_add(&bar[XB_TOPGEN], 1u);
            else XB_SPIN(xb_ld(&bar[XB_TOPGEN]) == tg, bar);
            __builtin_amdgcn_fence(__ATOMIC_ACQUIRE, "agent");
            xb_add(&bar[XB_XGEN(b.x)], 1u);
            asm volatile("s_waitcnt vmcnt(0)" ::: "memory");
        } else {
            __builtin_amdgcn_fence(__ATOMIC_ACQUIRE, "agent");
            XB_SPIN(xb_ld(&bar[XB_XGEN(b.x)]) == gen, bar);
            asm volatile("s_waitcnt vmcnt(0)" ::: "memory");
        }
    }
    __syncthreads();
}

namespace pg8 {
constexpr int BM = 256, BK = 64, HALF = 128, HTB = HALF * BK * 2, NXCD = 8, WGM = 8;
__host__ __device__ __forceinline__ int lds_byte(int r, int c) { const int st = (r >> 4) * 2 + (c >> 5), rr = r & 15, cc = c & 31, ob = rr * 64 + cc * 2; return st * 1024 + (ob ^ (((ob >> 9) & 1) << 5)); }
__host__ __device__ __forceinline__ void stage_rc(int b, int& R, int& C) { const int st = b / 1024, sb = b % 1024, swz = sb ^ (((sb >> 9) & 1) << 5); R = (st >> 1) * 16 + swz / 64; C = (st & 1) * 32 + (swz % 64) / 2; }
__host__ __device__ __forceinline__ int perm32(int rho) { const int n = rho >> 4, i = rho & 15; return 8 * (i >> 2) + 4 * n + (i & 3); }
struct Unit { int pm, pn, aux; };
__device__ __forceinline__ void map_tile(int L, int nM, int nN, int& pm, int& pn) {
    const int nwg = nM * nN; int wgid = L;
    { const int q = nwg / NXCD, r = nwg % NXCD, xcd = wgid % NXCD, off = wgid / NXCD; wgid = (xcd < r ? xcd * (q + 1) : r * (q + 1) + (xcd - r) * q) + off; }
    const int nig = WGM * nN, gid = wgid / nig, fm = gid * WGM, gsz = (nM - fm) < WGM ? (nM - fm) : WGM;
    pm = fm + ((wgid % nig) % gsz); pn = (wgid % nig) / gsz;
}
template <class Epi, class Prob>
__device__ __forceinline__ void gemm_phase(LAS unsigned char* lds, const Prob& P, const Epi& E) {
    const int tid = threadIdx.x, wid = __builtin_amdgcn_readfirstlane(tid >> 6), lane = tid & 63, wr = wid >> 2, wc = wid & 3, fr = lane & 15, fq = lane >> 4;
    const int nt = P.K / (Prob::FP8 ? 128 : BK);
    unsigned voffB[2];
#pragma unroll
    for (int i = 0; i < 2; ++i) { int R_, C_; stage_rc(tid * 16 + i * 8192, R_, C_); const int Rb = (R_ & ~31) + perm32(R_ & 31); voffB[i] = (unsigned)(Rb * P.ldb + C_ * 2); }
#define PG8_AOFF(dst0, dst1, unit) do { _Pragma("unroll") for (int _i = 0; _i < 2; ++_i) { int R_, C_; stage_rc(tid * 16 + _i * 8192, R_, C_); dst0[_i] = P.a_off(unit, R_, C_); dst1[_i] = P.a_off(unit, R_ + HALF, C_); } } while (0)
    const size_t kstep = (size_t)(BK * 2);
    const size_t hstepB = (size_t)HALF * P.ldb;
    const unsigned ldsw = (unsigned)wid * 1024u;
    const int aoff = lds_byte(wr * 64 + fr, fq * 8), boff = lds_byte(wc * 32 + fr, fq * 8);
#define PG8_SA(b, h) (((b) * 2 + (h)) * HTB)
#define PG8_SB(b, h) ((4 + (b) * 2 + (h)) * HTB)
#define PG8_STAGE(bufoff, gbase, voff) do { _Pragma("unroll") for (int _i = 0; _i < 2; ++_i) \
        __builtin_amdgcn_global_load_lds((const unsigned*)((const char*)(gbase) + (voff)[_i]), (LAS unsigned*)(lds + (bufoff) + ldsw + _i * 8192), 16, 0, 0); } while (0)
#define PG8_LD8(addr) __builtin_shufflevector(*(const LAS i32x4*)(addr), *(const LAS i32x4*)((addr) + 1024), 0, 1, 2, 3, 4, 5, 6, 7)
#define PG8_LDA(dst, b, h) do { _Pragma("unroll") for (int m = 0; m < 4; ++m) dst[m] = PG8_LD8(lds + PG8_SA(b, h) + aoff + m * 2048); } while (0)
#define PG8_LDB(dst, b, h) do { _Pragma("unroll") for (int n = 0; n < 2; ++n) dst[n] = PG8_LD8(lds + PG8_SB(b, h) + boff + n * 2048); } while (0)
#define PG8_LO(x) __builtin_bit_cast(bf16x8, __builtin_shufflevector(x, x, 0, 1, 2, 3))
#define PG8_HI(x) __builtin_bit_cast(bf16x8, __builtin_shufflevector(x, x, 4, 5, 6, 7))
#define PG8_MMA(ai, bj, At, Bt) do { __builtin_amdgcn_s_setprio(1); _Pragma("unroll") for (int m = 0; m < 4; ++m) _Pragma("unroll") for (int n = 0; n < 2; ++n) { \
        if constexpr (Prob::FP8) asm volatile("v_mfma_scale_f32_16x16x128_f8f6f4 %0, %1, %2, %0, %3, %4 op_sel_hi:[0,0,0]" : "+v"(acc[ai][bj][m][n]) : "v"(Bt[n]), "v"(At[m]), "v"(scl_w), "v"(scl_1)); \
        else { acc[ai][bj][m][n] = __builtin_amdgcn_mfma_f32_16x16x32_bf16(PG8_LO(Bt[n]), PG8_LO(At[m]), acc[ai][bj][m][n], 0, 0, 0); \
               acc[ai][bj][m][n] = __builtin_amdgcn_mfma_f32_16x16x32_bf16(PG8_HI(Bt[n]), PG8_HI(At[m]), acc[ai][bj][m][n], 0, 0, 0); } } \
        __builtin_amdgcn_s_setprio(0); } while (0)
#define PG8_WAIT_V(n) asm volatile("s_waitcnt vmcnt(" #n ")" ::: "memory")
#define PG8_WAIT_L(n) asm volatile("s_waitcnt lgkmcnt(" #n ")" ::: "memory")
#define PG8_BAR __builtin_amdgcn_s_barrier()
#define PG8_SCHED __builtin_amdgcn_sched_barrier(0)
    Unit cur, nxt; int ui = 0;
    if (!P.next(0, cur)) return;
    f32x4 acc[2][2][4][2];
#pragma unroll
    for (int a = 0; a < 2; ++a)
#pragma unroll
        for (int b = 0; b < 2; ++b)
#pragma unroll
            for (int m = 0; m < 4; ++m)
#pragma unroll
                for (int n = 0; n < 2; ++n) acc[a][b][m][n] = (f32x4){0.f, 0.f, 0.f, 0.f};
    i32x8 At[4], B0[2], B1[2];
    int scl_w = Prob::WSCALE, scl_1 = 0x7f7f7f7f; asm volatile("" : "+v"(scl_w), "+v"(scl_1));
    unsigned cO0[2], cO1[2], nO0[2], nO1[2];
    PG8_AOFF(cO0, cO1, cur);
    const char* cA = P.a_base(cur); const char* cB = P.b_base(cur);
    PG8_STAGE(PG8_SB(0, 0), cB, voffB); PG8_STAGE(PG8_SB(0, 1), cB + hstepB, voffB); PG8_STAGE(PG8_SA(0, 0), cA, cO0); PG8_STAGE(PG8_SA(0, 1), cA, cO1);
    if (wr == 1) PG8_BAR;
    PG8_WAIT_V(2); PG8_BAR;
    PG8_STAGE(PG8_SB(1, 0), cB + kstep, voffB); PG8_STAGE(PG8_SA(1, 0), cA + kstep, cO0); PG8_STAGE(PG8_SB(1, 1), cB + hstepB + kstep, voffB);
    PG8_WAIT_V(6); PG8_BAR;
    for (;;) {
        const bool has_next = P.next(ui + 1, nxt);
        const char* nA = cA; const char* nB = cB;
        if constexpr (Prob::GATHER) {
#pragma unroll
            for (int i = 0; i < 2; ++i) { nO0[i] = cO0[i]; nO1[i] = cO1[i]; } }
        if (has_next) { nA = P.a_base(nxt); nB = P.b_base(nxt); if constexpr (Prob::GATHER) PG8_AOFF(nO0, nO1, nxt); }
        for (int t = 0; t < nt; t += 2) {
            const bool last = (t == nt - 2);
            const char* a1 = cA + (size_t)(t + 1) * kstep;
            const char* a2 = last ? nA : cA + (size_t)(t + 2) * kstep; const char* b2 = last ? nB : cB + (size_t)(t + 2) * kstep;
            const char* a3 = a2 + kstep; const char* b3 = b2 + kstep;
            unsigned o20[2], o21[2];
#pragma unroll
            for (int i = 0; i < 2; ++i) { if constexpr (Prob::GATHER) { o20[i] = last ? nO0[i] : cO0[i]; o21[i] = last ? nO1[i] : cO1[i]; } else { o20[i] = cO0[i]; o21[i] = cO1[i]; } }
            const bool fin = last && !has_next;
            PG8_LDB(B0, 0, 0); PG8_LDB(B1, 0, 1); PG8_SCHED; PG8_LDA(At, 0, 0); PG8_STAGE(PG8_SA(1, 1), a1, cO1);
            PG8_WAIT_V(8); PG8_WAIT_L(0); PG8_BAR; PG8_MMA(0, 0, At, B0); PG8_MMA(0, 1, At, B1); PG8_BAR; PG8_SCHED;
            PG8_LDA(At, 0, 1);
            if (!fin) { PG8_STAGE(PG8_SB(0, 0), b2, voffB); PG8_STAGE(PG8_SB(0, 1), b2 + hstepB, voffB); PG8_STAGE(PG8_SA(0, 0), a2, o20); PG8_WAIT_V(8); }
            else PG8_WAIT_V(2);
            PG8_WAIT_L(0); PG8_BAR; PG8_MMA(1, 0, At, B0); PG8_MMA(1, 1, At, B1); PG8_BAR; PG8_SCHED;
            if constexpr (Epi::STAGE) { if (last) E.stage(cur, wid, lane, lds); }
            PG8_LDB(B0, 1, 0); PG8_LDB(B1, 1, 1); PG8_SCHED; PG8_LDA(At, 1, 0);
            if (!fin) { PG8_STAGE(PG8_SA(0, 1), a2, o21); PG8_WAIT_V(8); }
            else PG8_WAIT_V(0);
            PG8_WAIT_L(0); PG8_BAR; PG8_MMA(0, 0, At, B0); PG8_MMA(0, 1, At, B1); PG8_BAR; PG8_SCHED;
            PG8_LDA(At, 1, 1);
            if (!fin) { PG8_STAGE(PG8_SB(1, 0), b3, voffB); PG8_STAGE(PG8_SB(1, 1), b3 + hstepB, voffB); PG8_STAGE(PG8_SA(1, 0), a3, o20); PG8_WAIT_V(8); }
            PG8_WAIT_L(0); PG8_BAR; PG8_MMA(1, 0, At, B0); PG8_MMA(1, 1, At, B1); PG8_BAR; PG8_SCHED;
            if constexpr (Epi::MID) { if (t + 2 == nt / 2) E.mid(acc, cur, wr, wc, fr, fq); }
        }
        if (wr == 0) PG8_BAR;
        if constexpr (Prob::FP8) asm volatile("s_nop 15\n\ts_nop 15" ::: "memory");
        E(acc, cur, wr, wc, fr, fq);
        if (!has_next) break;
#pragma unroll
        for (int a = 0; a < 2; ++a)
#pragma unroll
            for (int b = 0; b < 2; ++b)
#pragma unroll
                for (int m = 0; m < 4; ++m)
#pragma unroll
                    for (int n = 0; n < 2; ++n) acc[a][b][m][n] = (f32x4){0.f, 0.f, 0.f, 0.f};
        cur = nxt; cA = nA; cB = nB; ++ui;
        if constexpr (Prob::GATHER) {
#pragma unroll
            for (int i = 0; i < 2; ++i) { cO0[i] = nO0[i]; cO1[i] = nO1[i]; } }
        if (wr == 1) PG8_BAR;
    }
    PG8_WAIT_V(0);
    PG8_BAR;
#undef PG8_AOFF
#undef PG8_SA
#undef PG8_SB
#undef PG8_STAGE
#undef PG8_LDA
#undef PG8_LD8
#undef PG8_LO
#undef PG8_HI
#undef PG8_LDB
#undef PG8_MMA
#undef PG8_WAIT_V
#undef PG8_WAIT_L
#undef PG8_BAR
#undef PG8_SCHED
}
}
using pg8::Unit;

struct Args { const float* in[28]; float* out; unsigned char* ws; int ph_lo, ph_hi; };
struct Frame {
    LAS unsigned char* lds;
    volatile LAS unsigned* MISC;
    unsigned* ctl;
    int tid, lane, wave, vcu, G;
    const Args* A;
    __device__ __forceinline__ bf16_t* Win_t() const { return (bf16_t*)(A->ws + WS_WIN); }
    __device__ __forceinline__ bf16_t* Wk_t() const { return (bf16_t*)(A->ws + WS_WK); }
    __device__ __forceinline__ bf16_t* Wv_t() const { return (bf16_t*)(A->ws + WS_WV); }
    __device__ __forceinline__ bf16_t* Wpab_t() const { return (bf16_t*)(A->ws + WS_WPAB); }
    __device__ __forceinline__ bf16_t* Wmo_t() const { return (bf16_t*)(A->ws + WS_WMO); }
    __device__ __forceinline__ bf16_t* Wq_t() const { return (bf16_t*)(A->ws + WS_WQ); }
    __device__ __forceinline__ bf16_t* Wo_t() const { return (bf16_t*)(A->ws + WS_WO); }
    __device__ __forceinline__ bf16_t* Wr_t() const { return (bf16_t*)(A->ws + WS_WR); }
    __device__ __forceinline__ bf16_t* W1_t() const { return (bf16_t*)(A->ws + WS_W1); }
    __device__ __forceinline__ bf16_t* W2_t() const { return (bf16_t*)(A->ws + WS_W2); }
    __device__ __forceinline__ bf16_t* sguw() const { return (bf16_t*)(A->ws + WS_SGUW); }
    __device__ __forceinline__ bf16_t* h() const { return (bf16_t*)(A->ws + WS_H); }
    __device__ __forceinline__ bf16_t* memn() const { return (bf16_t*)(A->ws + WS_MEMN); }
    __device__ __forceinline__ bf16_t* kmem() const { return (bf16_t*)(A->ws + WS_KMEM); }
    __device__ __forceinline__ bf16_t* vt() const { return (bf16_t*)(A->ws + WS_VT); }
    __device__ __forceinline__ bf16_t* qin() const { return (bf16_t*)(A->ws + WS_QIN); }
    __device__ __forceinline__ bf16_t* oab() const { return (bf16_t*)(A->ws + WS_OAB); }
    __device__ __forceinline__ bf16_t* mix() const { return (bf16_t*)(A->ws + WS_MIX); }
    __device__ __forceinline__ bf16_t* x1b() const { return (bf16_t*)(A->ws + WS_X1B); }
    __device__ __forceinline__ bf16_t* q() const { return (bf16_t*)(A->ws + WS_Q); }
    __device__ __forceinline__ bf16_t* ao() const { return (bf16_t*)(A->ws + WS_AO); }
    __device__ __forceinline__ bf16_t* x2b() const { return (bf16_t*)(A->ws + WS_X2B); }
    __device__ __forceinline__ bf16_t* p() const { return (bf16_t*)(A->ws + WS_P); }
    __device__ __forceinline__ bf16_t* act() const { return (bf16_t*)(A->ws + WS_ACT); }
    __device__ __forceinline__ bf16_t* yb() const { return (bf16_t*)(A->ws + WS_YB); }
    __device__ __forceinline__ bf16_t* ointra() const { return (bf16_t*)(A->ws + WS_OINTRA); }
    __device__ __forceinline__ bf16_t* kvT() const { return (bf16_t*)(A->ws + WS_KVT); }
    __device__ __forceinline__ float* decay() const { return (float*)(A->ws + WS_DECAY); }
    __device__ __forceinline__ float* ssq1() const { return (float*)(A->ws + WS_SSQ1); }
    __device__ __forceinline__ float* ssq2() const { return (float*)(A->ws + WS_SSQ2); }
    __device__ __forceinline__ float* lscale() const { return (float*)(A->ws + WS_LSCALE); }
    __device__ __forceinline__ float* gates() const { return (float*)(A->ws + WS_GATES); }
    __device__ __forceinline__ int* list() const { return (int*)(A->ws + WS_LIST); }
    __device__ __forceinline__ bf16_t* spT() const { return (bf16_t*)(A->ws + WS_SPT); }
    __device__ __forceinline__ unsigned char* x2q() const { return (unsigned char*)(A->ws + WS_X2Q); }
    __device__ __forceinline__ unsigned char* x1q() const { return (unsigned char*)(A->ws + WS_X1Q); }
};
enum { I_X = 0, I_MEM, I_NMIXG, I_WIN, I_WA2, I_BA, I_GOUTG, I_SNG, I_SNB, I_SW, I_SB, I_WPA, I_WPB, I_WMO, I_NXG, I_NMEMG, I_WXQ, I_WXK, I_WXV, I_WXO, I_NFFNG, I_WR, I_BR, I_WE1, I_BE1, I_WE2, I_BE2, I_NFING };

struct CvtItem { const float* src; size_t ldw; unsigned char* dst; const float* kscale; float mul; int fp8; };
__device__ __forceinline__ void cvt_load(const CvtItem& c, float (&v)[64]) {
#pragma unroll
    for (int i = 0; i < 64; ++i) v[i] = __builtin_nontemporal_load(c.src + (size_t)i * c.ldw);
}
__device__ __forceinline__ void cvt_finish(const CvtItem& c, float (&v)[64]) {
    if (c.kscale) {
#pragma unroll
        for (int i = 0; i < 64; ++i) v[i] *= c.kscale[i] * c.mul; }
    else {
#pragma unroll
        for (int i = 0; i < 64; ++i) v[i] *= c.mul; }
    if (c.fp8) {
#pragma unroll
        for (int q = 0; q < 4; ++q) { const float f0[8] = {v[16 * q], v[16 * q + 1], v[16 * q + 2], v[16 * q + 3], v[16 * q + 4], v[16 * q + 5], v[16 * q + 6], v[16 * q + 7]};
            const float f1[8] = {v[16 * q + 8], v[16 * q + 9], v[16 * q + 10], v[16 * q + 11], v[16 * q + 12], v[16 * q + 13], v[16 * q + 14], v[16 * q + 15]};
            const u32x2 lo = pack8_fp8(f0), hi = pack8_fp8(f1); *(u32x4*)(c.dst + 16 * q) = (u32x4){lo.x, lo.y, hi.x, hi.y}; } }
    else {
#pragma unroll
        for (int q = 0; q < 8; ++q) { const float f[8] = {v[8 * q], v[8 * q + 1], v[8 * q + 2], v[8 * q + 3], v[8 * q + 4], v[8 * q + 5], v[8 * q + 6], v[8 * q + 7]}; *(u32x4*)(c.dst + 16 * q) = pack8(f); } }
}
__device__ __forceinline__ CvtItem cvt_desc(const float* W, int ldw, int src_col0, int k0, void* WT, int ldt, int dst_row0, int dst_k0, const float* kscale, float mul, int fp8, int lane) {
    CvtItem c; const int eb = fp8 ? 1 : 2;
    c.src = W + (size_t)k0 * ldw + src_col0 + lane; c.ldw = (size_t)ldw; c.dst = (unsigned char*)WT + ((size_t)(dst_row0 + lane) * ldt + dst_k0 + k0) * eb;
    c.kscale = kscale ? kscale + k0 : nullptr; c.mul = mul; c.fp8 = fp8; return c;
}
__device__ __forceinline__ void cvt_expert128(Frame& F) {
    const int gw = F.vcu * 8 + F.wave, NGW = F.G * 8, lane = F.lane;
    constexpr int I1 = NE * 8 * 32, I2 = NE * 8 * 16;
    for (int it = gw; it < I1 + I2; it += NGW) {
        const float* src; size_t ldw; unsigned char* dst; const float* ks; (void)ks;
        if (it < I1) { const int e = it >> 8, q = it & 255, kb = q >> 5, nb = q & 31, nd = nb * 64; const int sc = ((nd & 128) ? 1024 : 0) + 128 * (nd >> 8) + (nd & 127);
            src = F.A->in[I_WE1] + (size_t)e * D * 2048 + (size_t)(kb * 128) * 2048 + sc + lane; ldw = 2048;
            dst = (unsigned char*)F.W1_t() + (size_t)e * 2048 * D + (size_t)(nd + lane) * D + kb * 128; ks = nullptr; }
        else { const int r = it - I1, e = r >> 7, q = r & 127, kb = q >> 4, nb = q & 15;
            src = F.A->in[I_WE2] + (size_t)e * D * D + (size_t)(kb * 128) * D + nb * 64 + lane; ldw = D;
            dst = (unsigned char*)F.W2_t() + (size_t)e * D * D + (size_t)(nb * 64 + lane) * D + kb * 128; ks = nullptr; }
        float v[128]; const float* pp = src;
#pragma unroll
        for (int i = 0; i < 128; ++i) { v[i] = __builtin_nontemporal_load(pp); pp += ldw; asm volatile("" : "+v"(pp)); }
#pragma unroll
        for (int i = 0; i < 128; ++i) v[i] *= FP8_WMUL;
#pragma unroll
        for (int q = 0; q < 8; ++q) { const float f0[8] = {v[16 * q], v[16 * q + 1], v[16 * q + 2], v[16 * q + 3], v[16 * q + 4], v[16 * q + 5], v[16 * q + 6], v[16 * q + 7]};
            const float f1[8] = {v[16 * q + 8], v[16 * q + 9], v[16 * q + 10], v[16 * q + 11], v[16 * q + 12], v[16 * q + 13], v[16 * q + 14], v[16 * q + 15]};
            const u32x2 lo = pack8_fp8(f0), hi = pack8_fp8(f1); *(u32x4*)(dst + 16 * q) = (u32x4){lo.x, lo.y, hi.x, hi.y}; }
    }
}
constexpr int CVT_SLOT = 16 * 1040, CVT_I1 = NE * 8 * 64, CVT_I2 = NE * 8 * 32, CVT_TAIL = CVT_I2 * 3 / 8;
struct CvtDma { const float* src; unsigned ldw; unsigned char* dst; };
__device__ __forceinline__ CvtDma cvt_dma_desc(const Frame& F, int it) {
    constexpr int I1 = NE * 8 * 64; CvtDma c;
    if (it < I1) { const int e = it >> 9, q = it & 511, kb = q >> 6, nb = q & 63, nd = nb * 32; const int sc = ((nd & 128) ? 1024 : 0) + 128 * (nd >> 8) + (nd & 127);
        c.src = F.A->in[I_WE1] + (size_t)e * D * 2048 + (size_t)(kb * 128) * 2048 + sc; c.ldw = 2048;
        c.dst = (unsigned char*)F.W1_t() + (size_t)e * 2048 * D + (size_t)nd * D + kb * 128; }
    else { const int r = it - I1, e = r >> 8, q = r & 255, kb = q >> 5, nb = q & 31;
        c.src = F.A->in[I_WE2] + (size_t)e * D * D + (size_t)(kb * 128) * D + nb * 32; c.ldw = D;
        c.dst = (unsigned char*)F.W2_t() + (size_t)e * D * D + (size_t)(nb * 32) * D + kb * 128; }
    return c;
}
__device__ __forceinline__ void cvt_dma_issue(const CvtDma& c, LAS unsigned char* slot, int lane) {
    const float* p = c.src + (size_t)(lane >> 3) * c.ldw + (lane & 7) * 4;
#pragma unroll
    for (int i = 0; i < 16; ++i) { __builtin_amdgcn_global_load_lds((const unsigned*)p, (LAS unsigned*)(slot + i * 1040), 16, 0, 2); p += (size_t)8 * c.ldw; }
}
__device__ __forceinline__ void cvt_expert_dma(Frame& F, int ibeg, int iend, int part, int nparts) {
    if (F.wave < 4) return;
    const int cw = ibeg + part * 4 + (F.wave - 4), NCW = nparts * 4, lane = F.lane;
    const int ITEMS = iend;
    const int n = cw < ITEMS ? (ITEMS - cw + NCW - 1) / NCW : 0;
    LAS unsigned char* slot0 = F.lds + (F.wave - 4) * (2 * CVT_SLOT);
    const int rdo = (lane & 7) * 2080 + (lane >> 3) * 4;
    CvtDma d0 = cvt_dma_desc(F, n > 0 ? cw : 0), d1 = cvt_dma_desc(F, n > 1 ? cw + NCW : 0);
    if (n > 0) cvt_dma_issue(d0, slot0, lane);
    if (n > 1) cvt_dma_issue(d1, slot0 + CVT_SLOT, lane);
    for (int j = 0; j < n; ++j) {
        if (j + 1 >= n) asm volatile("s_waitcnt vmcnt(0)" ::: "memory");
        else if (j == 0) asm volatile("s_waitcnt vmcnt(16)" ::: "memory");
        else asm volatile("s_waitcnt vmcnt(20)" ::: "memory");
        LAS unsigned char* slot = slot0 + (j & 1) * CVT_SLOT;
        const LAS unsigned char* rd = slot + rdo;
        float v[4][16];
        const unsigned rda = (unsigned)(size_t)rd;
#pragma unroll
        for (int q = 0; q < 4; ++q)
#pragma unroll
            for (int jj = 0; jj < 16; ++jj) asm volatile("ds_read_b32 %0, %1 offset:%2" : "=v"(v[q][jj]) : "v"(rda), "n"(q * 32 + (jj >> 3) * 1040 + (jj & 7) * 128));
        asm volatile("s_waitcnt lgkmcnt(0)" ::: "memory");
#pragma unroll
        for (int q = 0; q < 4; ++q) asm volatile("" : "+v"(v[q][0]), "+v"(v[q][1]), "+v"(v[q][2]), "+v"(v[q][3]), "+v"(v[q][4]), "+v"(v[q][5]), "+v"(v[q][6]), "+v"(v[q][7]),
                                                     "+v"(v[q][8]), "+v"(v[q][9]), "+v"(v[q][10]), "+v"(v[q][11]), "+v"(v[q][12]), "+v"(v[q][13]), "+v"(v[q][14]), "+v"(v[q][15]));
        unsigned char* dst = d0.dst + (size_t)(lane >> 3) * D + (lane & 7) * 16;
        d0 = d1;
        if (j + 2 < n) { d1 = cvt_dma_desc(F, cw + (j + 2) * NCW); cvt_dma_issue(d1, slot, lane); }
#pragma unroll
        for (int q = 0; q < 4; ++q) {
            float f0[8], f1[8];
#pragma unroll
            for (int jj = 0; jj < 8; ++jj) { f0[jj] = v[q][jj] * FP8_WMUL; f1[jj] = v[q][8 + jj] * FP8_WMUL; }
            const u32x2 lo = pack8_fp8(f0), hi = pack8_fp8(f1);
            *(u32x4*)(dst + (size_t)(8 * q) * D) = (u32x4){lo.x, lo.y, hi.x, hi.y}; }
    }
    asm volatile("s_waitcnt vmcnt(0)" ::: "memory");
}
template <bool Q8>
__device__ __forceinline__ void rms_row_to_bf16(const float* xrow, const float* g, bf16_t* orow, int lane) {
    f32x4 v[4]; float s = 0.f;
#pragma unroll
    for (int j = 0; j < 4; ++j) { v[j] = *(const f32x4*)(xrow + 256 * j + 4 * lane); s += (v[j].x * v[j].x + v[j].y * v[j].y) + (v[j].z * v[j].z + v[j].w * v[j].w); }
    const float rs = rsqrtf(wave_sum(s) * (1.f / D) + EPS);
#pragma unroll
    for (int j = 0; j < 4; ++j) { const f32x4 gg = *(const f32x4*)(g + 256 * j + 4 * lane);
        if constexpr (Q8) { int w = 0; w = __builtin_amdgcn_cvt_pk_fp8_f32(v[j].x * rs * gg.x, v[j].y * rs * gg.y, w, false); w = __builtin_amdgcn_cvt_pk_fp8_f32(v[j].z * rs * gg.z, v[j].w * rs * gg.w, w, true);
            *(int*)((unsigned char*)orow + 256 * j + 4 * lane) = w; }
        else { u32x2 o; o.x = cvt_pk_bf16(v[j].x * rs * gg.x, v[j].y * rs * gg.y); o.y = cvt_pk_bf16(v[j].z * rs * gg.z, v[j].w * rs * gg.w);
            *(u32x2*)(orow + 256 * j + 4 * lane) = o; } }
}
__device__ __forceinline__ void cvt_range(Frame& F, int ibeg, int iend) {
    const int gw = F.vcu * 8 + F.wave, NGW = F.G * 8, lane = F.lane;
    constexpr int N_WIN = 16 * 72, N_SQ = 256, N_PA = 8 * 16, N_E1 = 512, N_E2 = 256;
    constexpr int S_WIN = 0, S_WK = S_WIN + N_WIN, S_WV = S_WK + N_SQ, S_PA = S_WV + N_SQ, S_PB = S_PA + N_PA, S_MO = S_PB + N_PA, S_Q = S_MO + N_SQ, S_O = S_Q + N_SQ, S_E1 = S_O + N_SQ, S_E2 = S_E1 + NE * N_E1, S_END = S_E2 + NE * N_E2;
    static_assert(S_E1 == 16 * 72 + 256 * 2 + 8 * 16 * 2 + 256 * 3 && S_END == S_E1 + NE * 512 + NE * 256, "item ranges");
    const int IEND = iend < S_END ? iend : S_END;
    auto desc = [&](int it) -> CvtItem {
        if (it < S_WK) { const int r = it - S_WIN, kb = r / 72, nb = r % 72, n0 = nb * 64; return cvt_desc(F.A->in[I_WIN], INC, n0 < 1536 ? n0 : n0 + 16, kb * 64, F.Win_t(), D, n0, 0, nullptr, P1_FP8 ? FP8_WMUL : 1.f, P1_FP8, lane); }
        if (it < S_WV) { const int r = it - S_WK; return cvt_desc(F.A->in[I_WXK], D, (r & 15) * 64, (r >> 4) * 64, F.Wk_t(), D, (r & 15) * 64, 0, nullptr, P1_FP8 ? FP8_WMUL : 1.f, P1_FP8, lane); }
        if (it < S_PA) { const int r = it - S_WV; return cvt_desc(F.A->in[I_WXV], D, (r & 15) * 64, (r >> 4) * 64, F.Wv_t(), D, (r & 15) * 64, 0, nullptr, P1_FP8 ? FP8_WMUL : 1.f, P1_FP8, lane); }
        if (it < S_PB) { const int r = it - S_PA; return cvt_desc(F.A->in[I_WPA], D, (r & 15) * 64, (r >> 4) * 64, F.Wpab_t(), D, (r & 15) * 64, 0, nullptr, 1.f, 0, lane); }
        if (it < S_MO) { const int r = it - S_PB; return cvt_desc(F.A->in[I_WPB], D, (r & 15) * 64, (r >> 4) * 64, F.Wpab_t(), D, (r & 15) * 64, 512, nullptr, 1.f, 0, lane); }
        if (it < S_Q)  { const int r = it - S_MO; return cvt_desc(F.A->in[I_WMO], D, (r & 15) * 64, (r >> 4) * 64, F.Wmo_t(), D, (r & 15) * 64, 0, nullptr, 1.f, 0, lane); }
        if (it < S_O)  { const int r = it - S_Q;  return cvt_desc(F.A->in[I_WXQ], D, (r & 15) * 64, (r >> 4) * 64, F.Wq_t(), D, (r & 15) * 64, 0, F.A->in[I_NXG], FP8_WMUL, 1, lane); }
        if (it < S_E1) { const int r = it - S_O;  return cvt_desc(F.A->in[I_WXO], D, (r & 15) * 64, (r >> 4) * 64, F.Wo_t(), D, (r & 15) * 64, 0, nullptr, FP8_WMUL, 1, lane); }
        if (it < S_E2) { const int r = it - S_E1, e = r / N_E1, q = r % N_E1, kb = q >> 5, nb = q & 31, nd = nb * 64;
            const int src = ((nd & 128) ? 1024 : 0) + 128 * (nd >> 8) + (nd & 127);
            return cvt_desc(F.A->in[I_WE1] + (size_t)e * D * 2048, 2048, src, kb * 64, (unsigned char*)F.W1_t() + (size_t)e * 2048 * D, D, nd, 0, F.A->in[I_NFFNG], FP8_WMUL, 1, lane); }
        const int r = it - S_E2, e = r / N_E2, q = r % N_E2;
        return cvt_desc(F.A->in[I_WE2] + (size_t)e * D * D, D, (q & 15) * 64, (q >> 4) * 64, (unsigned char*)F.W2_t() + (size_t)e * D * D, D, (q & 15) * 64, 0, nullptr, FP8_WMUL, 1, lane); };
    if (ibeg + gw < IEND) {
        float va[64], vb[64]; CvtItem ca = desc(ibeg + gw), cb = ca; cvt_load(ca, va);
        for (int it = ibeg + gw;;) {
            const bool hb = it + NGW < IEND; if (hb) { cb = desc(it + NGW); cvt_load(cb, vb); }
            cvt_finish(ca, va); if (!hb) break;
            const bool ha = it + 2 * NGW < IEND; if (ha) { ca = desc(it + 2 * NGW); cvt_load(ca, va); }
            cvt_finish(cb, vb); if (!ha) break;
            it += 2 * NGW; }
    }
}
constexpr int CVT_LATE = 16 * 72 + 256 * 2, CVT_EXPERT = 16 * 72 + 256 * 2 + 8 * 16 * 2 + 256 * 3, CVT_END = CVT_EXPERT + NE * 512 + NE * 256;
__device__ __forceinline__ void p0_prologue(Frame& F) {
    const int gw = F.vcu * 8 + F.wave, NGW = F.G * 8, lane = F.lane;
    cvt_range(F, 0, CVT_LATE);
    for (int m = gw; m < T; m += NGW) rms_row_to_bf16<P1_FP8 != 0>(F.A->in[I_X] + (size_t)m * D, F.A->in[I_NMIXG], (bf16_t*)((unsigned char*)F.h() + (size_t)m * D * (P1_FP8 ? 1 : 2)), lane);
    for (int m = gw; m < TM; m += NGW) rms_row_to_bf16<P1_FP8 != 0>(F.A->in[I_MEM] + (size_t)m * D, F.A->in[I_NMEMG], (bf16_t*)((unsigned char*)F.memn() + (size_t)m * D * (P1_FP8 ? 1 : 2)), lane);
    const int gt = F.vcu * 512 + F.tid, NGT = F.G * 512;
    for (int i = gt; i < 256 * D; i += NGT) { const int j = i >> 10, k = i & 1023; const float* wr_ = F.A->in[I_WIN] + (size_t)k * INC + OFF_A; float s = 0.f;
#pragma unroll
        for (int r = 0; r < 16; ++r) s += wr_[r] * F.A->in[I_WA2][r * 256 + j];
        if (P1_FP8) { int w = __builtin_amdgcn_cvt_pk_fp8_f32(s * FP8_WMUL, 0.f, 0, false); ((unsigned char*)F.Win_t())[(size_t)(PC_A + j) * D + k] = (unsigned char)(w & 0xff); }
        else F.Win_t()[(size_t)(PC_A + j) * D + k] = f2bf(s); }
    for (int i = gt; i < NE * D; i += NGT) { const int e = i >> 10, k = i & 1023; F.Wr_t()[i] = f2bf(F.A->in[I_WR][k * NE + e] * F.A->in[I_NFFNG][k]); }
    for (int i = gt; i < 4 * 128 * 128; i += NGT) { const int t = (i >> 7) & 127, s = i & 127; F.sguw()[i] = f2bf(s <= t ? F.A->in[I_SW][i] : 0.f); }
}

struct ProbP1 {
    static constexpr bool GATHER = false, FP8 = (P1_FP8 != 0); static constexpr int EB = P1_FP8 ? 1 : 2, WSCALE = FP8_WSCALE;
    int K, lda, ldb, G, c; const unsigned char* ws;
    __device__ __forceinline__ bool next(int i, Unit& u) const {
        const int L = i * G + c;
        if (L < 1216) { u.aux = 0; pg8::map_tile(L, 64, 19, u.pm, u.pn); return true; }
        if (L < 1248) { u.aux = 1; u.pm = (L - 1216) >> 2; u.pn = (L - 1216) & 3; return true; }
        if (L < 1280) { u.aux = 2; u.pm = (L - 1248) >> 3; u.pn = (L - 1248) & 7; return true; }
        return false;
    }
    __device__ __forceinline__ const char* a_base(const Unit& u) const { const size_t o = u.aux == 0 ? WS_H : (u.aux == 1 ? WS_MEMN : WS_WV); return (const char*)(ws + o + (size_t)u.pm * 256 * D * EB); }
    __device__ __forceinline__ const char* b_base(const Unit& u) const { const size_t o = u.aux == 0 ? WS_WIN : (u.aux == 1 ? WS_WK : WS_MEMN); return (const char*)(ws + o + (size_t)u.pn * 256 * D * EB); }
    __device__ __forceinline__ unsigned a_off(const Unit&, int row, int C) const { return (unsigned)(row * D * EB + C * 2); }
};
struct EpiP1 {
    static constexpr bool MID = false, STAGE = false;
    unsigned char* ws;
    __device__ __forceinline__ void operator()(const f32x4 (&acc)[2][2][4][2], const Unit& u, int wr, int wc, int fr, int fq) const {
        asm volatile("" : "+v"(fr), "+v"(fq));
        const size_t oo = u.aux == 0 ? WS_P : (u.aux == 1 ? WS_KMEM : WS_VT);
        bf16_t* O = (bf16_t*)(ws + oo); const int ldc = u.aux == 0 ? PN : (u.aux == 1 ? D : TM);
        const int act = (u.aux == 0) ? ((u.pn >= 6 && u.pn < 10) ? 1 : ((u.pn >= 10 && u.pn < 18) ? 2 : 0)) : 0;
        const int row0 = u.pm * 256 + wr * 64 + fr, col0 = u.pn * 256 + wc * 32 + 8 * fq; const bool svstat = (u.aux == 0) && (u.pn == 8 || u.pn == 9);
#pragma unroll
        for (int ai = 0; ai < 2; ++ai)
#pragma unroll
            for (int m = 0; m < 4; ++m) { bf16_t* rowp = O + (size_t)(row0 + ai * 128 + m * 16) * ldc + col0; float s1 = 0.f, s2 = 0.f;
#pragma unroll
                for (int bj = 0; bj < 2; ++bj) { float v[8];
#pragma unroll
                    for (int j = 0; j < 4; ++j) { v[j] = acc[ai][bj][m][0][j]; v[4 + j] = acc[ai][bj][m][1][j]; }
                    if (act == 1) {
#pragma unroll
                        for (int j = 0; j < 8; j += 2) { const f32x2 o = gelu_pk((f32x2){v[j], v[j + 1]}); v[j] = o.x; v[j + 1] = o.y; }
#pragma unroll
                        for (int j = 0; j < 8; ++j) { s1 += v[j]; s2 += v[j] * v[j]; } }
                    else if (act == 2) {
#pragma unroll
                        for (int j = 0; j < 8; j += 2) { const f32x2 o = sigmoid_pk((f32x2){v[j], v[j + 1]}); v[j] = o.x; v[j + 1] = o.y; } }
                    *(u32x4*)(rowp + bj * 128) = pack8(v); }
                if (svstat) {
                    s1 += __shfl_xor(s1, 16); s1 += __shfl_xor(s1, 32); s2 += __shfl_xor(s2, 16); s2 += __shfl_xor(s2, 32);
                    if (fq == 0) *(f32x2*)((float*)(ws + WS_SVS) + (size_t)(row0 + ai * 128 + m * 16) * 16 + (u.pn - 8) * 8 + wc * 2) = (f32x2){s1, s2}; } }
    }
};

__device__ __forceinline__ void gla_a_unit(Frame& F, int unit) {
    const int tid = F.tid, lane = F.lane, w = F.wave, fr = lane & 15, fq = lane >> 4;
    const int bh = unit >> 5, n = unit & 31, b = bh >> 2, h = bh & 3;
    const int t0 = b * SEQ + n * 64;
    LAS float* cum = (LAS float*)(F.lds); LAS float* tot = (LAS float*)(F.lds + 16640);
    LAS bf16_t* QIN = (LAS bf16_t*)(F.lds + 18688); LAS bf16_t* KIN = (LAS bf16_t*)(F.lds + 27904); LAS bf16_t* KOT = (LAS bf16_t*)(F.lds + 37120);
    LAS bf16_t* ATT = (LAS bf16_t*)(F.lds + 46336); LAS bf16_t* VT = (LAS bf16_t*)(F.lds + 55552);
    const int c = tid >> 3, d8 = (tid & 7) * 8;
    {
        float g[8]; unpack8(*(const u32x4*)(F.p() + (size_t)(t0 + c) * PN + PC_A + h * 64 + d8), g);
        const f32x4 b0 = *(const f32x4*)(F.A->in[I_BA] + h * 64 + d8), b1 = *(const f32x4*)(F.A->in[I_BA] + h * 64 + d8 + 4);
        const float bb[8] = {b0.x, b0.y, b0.z, b0.w, b1.x, b1.y, b1.z, b1.w};
#pragma unroll
        for (int j = 0; j < 8; ++j) { const float x = g[j] + bb[j]; const float ls = fminf(x, 0.f) - __logf(1.f + __expf(-fabsf(x))); cum[c * 65 + d8 + j] = ls * 0.0625f; }
    }
    __syncthreads();
    { const int d = tid & 63, seg = tid >> 6; float run = 0.f;
#pragma unroll
        for (int i = 0; i < 8; ++i) { run += cum[(seg * 8 + i) * 65 + d]; cum[(seg * 8 + i) * 65 + d] = run; }
        tot[seg * 64 + d] = run; }
    __syncthreads();
    { const int d = tid & 63, seg = tid >> 6; float off = 0.f;
#pragma unroll
        for (int s = 0; s < 7; ++s) if (s < seg) off += tot[s * 64 + d];
#pragma unroll
        for (int i = 0; i < 8; ++i) cum[(seg * 8 + i) * 65 + d] += off; }
    __syncthreads();
    {
        float qv[8], kv[8], qi[8], ki[8];
        unpack8(*(const u32x4*)(F.p() + (size_t)(t0 + c) * PN + PC_Q + h * 64 + d8), qv);
        unpack8(*(const u32x4*)(F.p() + (size_t)(t0 + c) * PN + PC_K + h * 64 + d8), kv);
#pragma unroll
        for (int j = 0; j < 8; ++j) { const float cm = cum[c * 65 + d8 + j], cl = cum[63 * 65 + d8 + j];
            qi[j] = qv[j] * 0.125f * __expf(cm); ki[j] = kv[j] * __expf(-cm);
            KOT[(d8 + j) * 72 + c] = f2bf(kv[j] * __expf(cl - cm));
            if (c == 63) F.decay()[unit * 64 + d8 + j] = __expf(cl); }
        const u32x4 qp = pack8(qi), kp = pack8(ki);
        *(LAS u32x4*)(QIN + c * 72 + d8) = qp; *(LAS u32x4*)(KIN + c * 72 + d8) = kp;
        *(u32x4*)(F.qin() + (size_t)(t0 + c) * 256 + h * 64 + d8) = qp;
        const int e16 = (tid & 7) * 16;
#pragma unroll
        for (int hh = 0; hh < 2; ++hh) { const u32x4 vv = *(const u32x4*)(F.p() + (size_t)(t0 + c) * PN + PC_V + h * 128 + e16 + 8 * hh);
            const unsigned ww[4] = {vv.x, vv.y, vv.z, vv.w};
#pragma unroll
            for (int j = 0; j < 4; ++j) { VT[(e16 + 8 * hh + 2 * j) * 72 + c] = (bf16_t)(ww[j] & 0xffffu); VT[(e16 + 8 * hh + 2 * j + 1) * 72 + c] = (bf16_t)(ww[j] >> 16); } }
    }
    __syncthreads();
    {
        const int mt = w >> 1;
        bf16x8 a[2];
#pragma unroll
        for (int ks = 0; ks < 2; ++ks) a[ks] = *(const LAS bf16x8*)(QIN + (16 * mt + fr) * 72 + 32 * ks + 8 * fq);
#pragma unroll
        for (int q = 0; q < 2; ++q) { const int nt = (w & 1) * 2 + q; f32x4 s = {0.f, 0.f, 0.f, 0.f};
#pragma unroll
            for (int ks = 0; ks < 2; ++ks) s = mma16(a[ks], *(const LAS bf16x8*)(KIN + (16 * nt + fr) * 72 + 32 * ks + 8 * fq), s);
#pragma unroll
            for (int r = 0; r < 4; ++r) { const int cc = 16 * mt + 4 * fq + r, ss = 16 * nt + fr; ATT[cc * 72 + ss] = f2bf(ss <= cc ? s[r] : 0.f); } }
    }
    __syncthreads();
    {
        const int mt = w >> 1, nt0 = (w & 1) * 4;
        bf16x8 aa[2], ak[2];
#pragma unroll
        for (int ks = 0; ks < 2; ++ks) { aa[ks] = *(const LAS bf16x8*)(ATT + (16 * mt + fr) * 72 + 32 * ks + 8 * fq); ak[ks] = *(const LAS bf16x8*)(KOT + (16 * mt + fr) * 72 + 32 * ks + 8 * fq); }
#pragma unroll
        for (int q = 0; q < 4; ++q) { const int nt = nt0 + q; f32x4 o = {0.f, 0.f, 0.f, 0.f}, kvv = {0.f, 0.f, 0.f, 0.f};
#pragma unroll
            for (int ks = 0; ks < 2; ++ks) { const bf16x8 bv = *(const LAS bf16x8*)(VT + (16 * nt + fr) * 72 + 32 * ks + 8 * fq); o = mma16(bv, aa[ks], o); kvv = mma16(ak[ks], bv, kvv); }
            *(u32x2*)(F.ointra() + (size_t)(t0 + 16 * mt + fr) * 512 + h * 128 + 16 * nt + 4 * fq) = (u32x2){cvt_pk_bf16(o[0], o[1]), cvt_pk_bf16(o[2], o[3])};
            *(u32x2*)(F.kvT() + ((size_t)unit * 128 + 16 * nt + fr) * 64 + 16 * mt + 4 * fq) = (u32x2){cvt_pk_bf16(kvv[0], kvv[1]), cvt_pk_bf16(kvv[2], kvv[3])}; }
    }
    __syncthreads();
}

__device__ __forceinline__ void gla_sscan_item(Frame& F, int item) {
    const int lane = F.lane, idx = item * 64 + lane, d4 = idx & 15, e = (idx >> 4) & 127, bh = idx >> 11;
    const bf16_t* kvp = F.kvT() + ((size_t)(bh * 32) * 128 + e) * 64 + d4 * 4; const float* dcp = F.decay() + (size_t)(bh * 32) * 64 + d4 * 4;
    bf16_t* sp = F.spT() + ((size_t)(bh * 32) * 128 + e) * 64 + d4 * 4;
    f32x4 S = {0.f, 0.f, 0.f, 0.f};
    for (int n0 = 0; n0 < 32; n0 += 8) { f32x4 kv[8], dc[8];
#pragma unroll
        for (int i = 0; i < 8; ++i) { const u32x2 kw = *(const u32x2*)(kvp + (size_t)(n0 + i) * 128 * 64); kv[i] = (f32x4){bflo(kw.x), bfhi(kw.x), bflo(kw.y), bfhi(kw.y)}; dc[i] = *(const f32x4*)(dcp + (size_t)(n0 + i) * 64); }
#pragma unroll
        for (int i = 0; i < 8; ++i) { u32x2 o; o.x = cvt_pk_bf16(S.x, S.y); o.y = cvt_pk_bf16(S.z, S.w); *(u32x2*)(sp + (size_t)(n0 + i) * 128 * 64) = o; S = dc[i] * S + kv[i]; } }
}
__device__ __forceinline__ void sgu_unit(Frame& F, int unit) {
    const int tid = F.tid, w = F.wave, lane = F.lane, fr = lane & 15, fq = lane >> 4, ch = unit >> 2, g = unit & 3, t0 = ch * 128;
    LAS f32x2* stat = (LAS f32x2*)F.lds; LAS bf16_t* vnT = (LAS bf16_t*)(F.lds + 1024);
    if (tid < 128) { const float* sp = (const float*)(F.A->ws + WS_SVS) + (size_t)(t0 + tid) * 16;
        const f32x4 a = *(const f32x4*)sp, b = *(const f32x4*)(sp + 4), c4 = *(const f32x4*)(sp + 8), d = *(const f32x4*)(sp + 12);
        const float s = (a.x + a.z) + (b.x + b.z) + (c4.x + c4.z) + (d.x + d.z), s2 = (a.y + a.w) + (b.y + b.w) + (c4.y + c4.w) + (d.y + d.w);
        const float mean = s * (1.f / 512.f), var = fmaxf(s2 * (1.f / 512.f) - mean * mean, 0.f);
        stat[tid] = (f32x2){mean, rsqrtf(var + EPS)}; }
    __syncthreads();
    { const int s = tid >> 2, c32 = (tid & 3) * 32; const f32x2 ms = stat[s];
#pragma unroll
        for (int q = 0; q < 4; ++q) { float v[8]; unpack8(*(const u32x4*)(F.p() + (size_t)(t0 + s) * PN + PC_SV + g * 128 + c32 + 8 * q), v);
#pragma unroll
            for (int j = 0; j < 8; ++j) { const int cidx = g * 128 + c32 + 8 * q + j; vnT[(c32 + 8 * q + j) * 136 + s] = f2bf((v[j] - ms.x) * ms.y * F.A->in[I_SNG][cidx] + F.A->in[I_SNB][cidx]); } } }
    __syncthreads();
    f32x4 acc[8];
#pragma unroll
    for (int ct = 0; ct < 8; ++ct) acc[ct] = (f32x4){0.f, 0.f, 0.f, 0.f};
    const int nks = (16 * w + 15) / 32 + 1;
    for (int ks = 0; ks < nks; ++ks) { const bf16x8 bw = *(const bf16x8*)(F.sguw() + (size_t)(g * 128 + 16 * w + fr) * 128 + 32 * ks + 8 * fq);
#pragma unroll
        for (int ct = 0; ct < 8; ++ct) acc[ct] = mma16(*(const LAS bf16x8*)(vnT + (16 * ct + fr) * 136 + 32 * ks + 8 * fq), bw, acc[ct]); }
    {
        const int t = 16 * w + fr; const float bias = F.A->in[I_SB][g * 128 + t];
        u32x2 uv[8];
#pragma unroll
        for (int ct = 0; ct < 8; ++ct) uv[ct] = *(const u32x2*)(F.p() + (size_t)(t0 + t) * PN + PC_U + g * 128 + 16 * ct + 4 * fq);
#pragma unroll
        for (int ct = 0; ct < 8; ++ct) { const int cidx = g * 128 + 16 * ct + 4 * fq; const u32x2 uu = uv[ct];
            u32x2 o; o.x = cvt_pk_bf16(bflo(uu.x) * (acc[ct][0] + bias), bfhi(uu.x) * (acc[ct][1] + bias)); o.y = cvt_pk_bf16(bflo(uu.y) * (acc[ct][2] + bias), bfhi(uu.y) * (acc[ct][3] + bias));
            *(u32x2*)(F.oab() + (size_t)(t0 + t) * D + 512 + cidx) = o; } }
    __syncthreads();
}
__device__ __forceinline__ void gla_out_item(Frame& F, int item) {
    const int lane = F.lane, fr = lane & 15, fq = lane >> 4, unit = item >> 2, mt = item & 3;
    const int bh = unit >> 5, n = unit & 31, b = bh >> 2, h = bh & 3; const size_t t = (size_t)b * SEQ + n * 64 + 16 * mt + fr;
    bf16x8 qf[2];
#pragma unroll
    for (int ks = 0; ks < 2; ++ks) qf[ks] = *(const bf16x8*)(F.qin() + t * 256 + h * 64 + 32 * ks + 8 * fq);
    const bf16_t* sp = F.spT() + (size_t)unit * 128 * 64;
    f32x4 o[8]; float ss = 0.f;
#pragma unroll
    for (int et = 0; et < 8; ++et) { const u32x2 ow = *(const u32x2*)(F.ointra() + t * 512 + h * 128 + 16 * et + 4 * fq); f32x4 acc = {bflo(ow.x), bfhi(ow.x), bflo(ow.y), bfhi(ow.y)};
#pragma unroll
        for (int ks = 0; ks < 2; ++ks) acc = mma16(*(const bf16x8*)(sp + (size_t)(16 * et + fr) * 64 + 32 * ks + 8 * fq), qf[ks], acc);
        o[et] = acc; ss += (acc[0] * acc[0] + acc[1] * acc[1]) + (acc[2] * acc[2] + acc[3] * acc[3]); }
    ss += __shfl_xor(ss, 16); ss += __shfl_xor(ss, 32);
    const float rstd = rsqrtf(ss * (1.f / 128.f) + EPS);
    f32x4 gv[8]; u32x2 rv[8];
#pragma unroll
    for (int et = 0; et < 8; ++et) { const int e = h * 128 + 16 * et + 4 * fq; gv[et] = *(const f32x4*)(F.A->in[I_GOUTG] + e); rv[et] = *(const u32x2*)(F.p() + t * PN + PC_R + e); }
#pragma unroll
    for (int et = 0; et < 8; ++et) { const int e = h * 128 + 16 * et + 4 * fq; const f32x4 g = gv[et];
        const u32x2 rr = rv[et]; const float r0 = bflo(rr.x), r1 = bfhi(rr.x), r2 = bflo(rr.y), r3 = bfhi(rr.y);
        u32x2 ov; ov.x = cvt_pk_bf16(o[et][0] * rstd * g.x * r0 * sigmoidf_(r0), o[et][1] * rstd * g.y * r1 * sigmoidf_(r1));
        ov.y = cvt_pk_bf16(o[et][2] * rstd * g.z * r2 * sigmoidf_(r2), o[et][3] * rstd * g.w * r3 * sigmoidf_(r3));
        *(u32x2*)(F.oab() + t * D + e) = ov; }
}

struct ProbSeg {
    static constexpr bool GATHER = false, FP8 = false; static constexpr int WSCALE = FP8_WSCALE;
    int K, lda, ldb, G, c; const bf16_t *oab, *Wpab_t;
    __device__ __forceinline__ bool next(int i, Unit& u) const { const int L = (i >> 1) * G + c; if (L >= 256) return false; pg8::map_tile(L, 64, 4, u.pm, u.pn); u.aux = i & 1; return true; }
    __device__ __forceinline__ const char* a_base(const Unit& u) const { return (const char*)(oab + (size_t)u.pm * 256 * D + u.aux * 512); }
    __device__ __forceinline__ const char* b_base(const Unit& u) const { return (const char*)(Wpab_t + (size_t)u.pn * 256 * D + u.aux * 512); }
    __device__ __forceinline__ unsigned a_off(const Unit&, int row, int C) const { return (unsigned)(row * D + C) * 2u; }
};
struct EpiMix {
    static constexpr bool MID = false, STAGE = false;
    const bf16_t* p; bf16_t* mix;
    __device__ __forceinline__ void operator()(const f32x4 (&acc)[2][2][4][2], const Unit& u, int wr, int wc, int fr, int fq) const {
        asm volatile("" : "+v"(fr), "+v"(fq));
        const int row0 = u.pm * 256 + wr * 64 + fr, col0 = u.pn * 256 + wc * 32 + 8 * fq, gc = u.aux ? PC_GB : PC_GA;
#pragma unroll
        for (int ai = 0; ai < 2; ++ai) {
            u32x4 gw[4][2], pw[4][2];
#pragma unroll
            for (int m = 0; m < 4; ++m)
#pragma unroll
                for (int bj = 0; bj < 2; ++bj) { const size_t row = (size_t)(row0 + ai * 128 + m * 16);
                    gw[m][bj] = *(const u32x4*)(p + row * PN + gc + col0 + bj * 128);
                    pw[m][bj] = u.aux ? *(const u32x4*)(mix + row * D + col0 + bj * 128) : (u32x4){0u, 0u, 0u, 0u}; }
#pragma unroll
            for (int m = 0; m < 4; ++m)
#pragma unroll
                for (int bj = 0; bj < 2; ++bj) { const size_t row = (size_t)(row0 + ai * 128 + m * 16); float g[8], pv[8], v[8]; unpack8(gw[m][bj], g); unpack8(pw[m][bj], pv);
#pragma unroll
                    for (int j = 0; j < 4; ++j) { v[j] = acc[ai][bj][m][0][j] * g[j] + pv[j]; v[4 + j] = acc[ai][bj][m][1][j] * g[4 + j] + pv[4 + j]; }
                    *(u32x4*)(mix + row * D + col0 + bj * 128) = pack8(v); } }
    }
};

struct EpiMix2 {
    static constexpr bool MID = true, STAGE = false;
    const bf16_t* p; bf16_t* mix;
    __device__ __forceinline__ void mid(f32x4 (&acc)[2][2][4][2], const Unit& u, int wr, int wc, int fr, int fq) const {
        asm volatile("" : "+v"(fr), "+v"(fq));
        const int row0 = u.pm * 256 + wr * 64 + fr, col0 = u.pn * 256 + wc * 32 + 8 * fq;
#pragma unroll
        for (int ai = 0; ai < 2; ++ai) { u32x4 ga[4][2], gb[4][2];
#pragma unroll
            for (int m = 0; m < 4; ++m)
#pragma unroll
                for (int bj = 0; bj < 2; ++bj) { const size_t row = (size_t)(row0 + ai * 128 + m * 16); ga[m][bj] = *(const u32x4*)(p + row * PN + PC_GA + col0 + bj * 128); gb[m][bj] = *(const u32x4*)(p + row * PN + PC_GB + col0 + bj * 128); }
#pragma unroll
            for (int m = 0; m < 4; ++m)
#pragma unroll
                for (int bj = 0; bj < 2; ++bj) { float a[8], b[8]; unpack8(ga[m][bj], a); unpack8(gb[m][bj], b);
#pragma unroll
                    for (int j = 0; j < 4; ++j) { acc[ai][bj][m][0][j] *= a[j] * __builtin_amdgcn_rcpf(fmaxf(b[j], 1e-20f)); acc[ai][bj][m][1][j] *= a[4 + j] * __builtin_amdgcn_rcpf(fmaxf(b[4 + j], 1e-20f)); } } }
    }
    __device__ __forceinline__ void operator()(const f32x4 (&acc)[2][2][4][2], const Unit& u, int wr, int wc, int fr, int fq) const {
        asm volatile("" : "+v"(fr), "+v"(fq));
        const int row0 = u.pm * 256 + wr * 64 + fr, col0 = u.pn * 256 + wc * 32 + 8 * fq;
#pragma unroll
        for (int ai = 0; ai < 2; ++ai) { u32x4 gb[4][2];
#pragma unroll
            for (int m = 0; m < 4; ++m)
#pragma unroll
                for (int bj = 0; bj < 2; ++bj) gb[m][bj] = *(const u32x4*)(p + (size_t)(row0 + ai * 128 + m * 16) * PN + PC_GB + col0 + bj * 128);
#pragma unroll
            for (int m = 0; m < 4; ++m)
#pragma unroll
                for (int bj = 0; bj < 2; ++bj) { float b[8], v[8]; unpack8(gb[m][bj], b);
#pragma unroll
                    for (int j = 0; j < 4; ++j) { v[j] = acc[ai][bj][m][0][j] * fmaxf(b[j], 1e-20f); v[4 + j] = acc[ai][bj][m][1][j] * fmaxf(b[4 + j], 1e-20f); }
                    *(u32x4*)(mix + (size_t)(row0 + ai * 128 + m * 16) * D + col0 + bj * 128) = pack8(v); } }
    }
};

template <bool Q8 = false, int WS_ = FP8_WSCALE> struct ProbStdT {
    static constexpr bool GATHER = false, FP8 = Q8; static constexpr int WSCALE = WS_, EB = Q8 ? 1 : 2;
    int K, lda, ldb, G, c; const void *A, *Bt;
    __device__ __forceinline__ bool next(int i, Unit& u) const { const int L = i * G + c; if (L >= 256) return false; pg8::map_tile(L, 64, 4, u.pm, u.pn); u.aux = 0; return true; }
    __device__ __forceinline__ const char* a_base(const Unit& u) const { return (const char*)A + (size_t)u.pm * 256 * D * EB; }
    __device__ __forceinline__ const char* b_base(const Unit& u) const { return (const char*)Bt + (size_t)u.pn * 256 * D * EB; }
    __device__ __forceinline__ unsigned a_off(const Unit&, int row, int C) const { return (unsigned)(row * D * EB + C * 2); }
};
typedef ProbStdT<false> ProbStd;
template <bool RESF32> struct EpiRes {
    static constexpr bool MID = false, STAGE = false;
    const void* res; bf16_t* outb; float* ssq; unsigned char* outq; const float* qgain;
    __device__ __forceinline__ void operator()(const f32x4 (&acc)[2][2][4][2], const Unit& u, int wr, int wc, int fr, int fq) const {
        asm volatile("" : "+v"(fr), "+v"(fq));
        const int row0 = u.pm * 256 + wr * 64 + fr, col0 = u.pn * 256 + wc * 32 + 8 * fq;
#pragma unroll
        for (int ai = 0; ai < 2; ++ai) {
            f32x4 rf[4][2][2]; u32x4 rb[4][2];
#pragma unroll
            for (int m = 0; m < 4; ++m)
#pragma unroll
                for (int bj = 0; bj < 2; ++bj) { const size_t off = (size_t)(row0 + ai * 128 + m * 16) * D + col0 + bj * 128;
                    if (RESF32) { rf[m][bj][0] = *(const f32x4*)((const float*)res + off); rf[m][bj][1] = *(const f32x4*)((const float*)res + off + 4); }
                    else rb[m][bj] = *(const u32x4*)((const bf16_t*)res + off); }
#pragma unroll
            for (int m = 0; m < 4; ++m) { const size_t row = (size_t)(row0 + ai * 128 + m * 16); float sq = 0.f;
#pragma unroll
                for (int bj = 0; bj < 2; ++bj) { float r[8], v[8];
                    if (RESF32) { r[0] = rf[m][bj][0].x; r[1] = rf[m][bj][0].y; r[2] = rf[m][bj][0].z; r[3] = rf[m][bj][0].w; r[4] = rf[m][bj][1].x; r[5] = rf[m][bj][1].y; r[6] = rf[m][bj][1].z; r[7] = rf[m][bj][1].w; }
                    else unpack8(rb[m][bj], r);
#pragma unroll
                    for (int j = 0; j < 4; ++j) { v[j] = acc[ai][bj][m][0][j] + r[j]; v[4 + j] = acc[ai][bj][m][1][j] + r[4 + j]; }
#pragma unroll
                    for (int j = 0; j < 8; ++j) sq += v[j] * v[j];
                    *(u32x4*)(outb + row * D + col0 + bj * 128) = pack8(v);
                    if (outq) *(u32x2*)(outq + row * D + col0 + bj * 128) = pack8_fp8(v); }
                sq += __shfl_xor(sq, 16); sq += __shfl_xor(sq, 32);
                if (fq == 0) ssq[row * 16 + u.pn * 4 + wc] = sq; } }
    }
};
__device__ __forceinline__ float row_rs(const float* ssq, size_t row) {
    const f32x4 a = *(const f32x4*)(ssq + row * 16), b = *(const f32x4*)(ssq + row * 16 + 4), c = *(const f32x4*)(ssq + row * 16 + 8), d = *(const f32x4*)(ssq + row * 16 + 12);
    const float s = ((a.x + a.y) + (a.z + a.w)) + ((b.x + b.y) + (b.z + b.w)) + ((c.x + c.y) + (c.z + c.w)) + ((d.x + d.y) + (d.z + d.w));
    return rsqrtf(s * (1.f / D) + EPS);
}
struct EpiScale {
    static constexpr bool MID = false, STAGE = false;
    const float* ssq; bf16_t* outb;
    __device__ __forceinline__ void operator()(const f32x4 (&acc)[2][2][4][2], const Unit& u, int wr, int wc, int fr, int fq) const {
        asm volatile("" : "+v"(fr), "+v"(fq));
        const int row0 = u.pm * 256 + wr * 64 + fr, col0 = u.pn * 256 + wc * 32 + 8 * fq;
        float rs[2][4];
#pragma unroll
        for (int ai = 0; ai < 2; ++ai)
#pragma unroll
            for (int m = 0; m < 4; ++m) rs[ai][m] = row_rs(ssq, (size_t)(row0 + ai * 128 + m * 16));
#pragma unroll
        for (int ai = 0; ai < 2; ++ai)
#pragma unroll
            for (int m = 0; m < 4; ++m) { const size_t row = (size_t)(row0 + ai * 128 + m * 16);
#pragma unroll
                for (int bj = 0; bj < 2; ++bj) { float v[8];
#pragma unroll
                    for (int j = 0; j < 4; ++j) { v[j] = acc[ai][bj][m][0][j] * rs[ai][m]; v[4 + j] = acc[ai][bj][m][1][j] * rs[ai][m]; }
                    *(u32x4*)(outb + row * D + col0 + bj * 128) = pack8(v); } }
    }
};

__device__ __forceinline__ void attn_unit(Frame& F, int unit) {
    const int tid = F.tid, w = F.wave, lane = F.lane, fr = lane & 15, fq = lane >> 4;
    const int b = unit >> 5, h = (unit >> 3) & 3, qb = unit & 7;
    const size_t tq = (size_t)b * SEQ + qb * 256 + 32 * w;
    LAS unsigned char* const bufs[2] = {F.lds, F.lds + 36864};
    const bf16_t* kg = F.kmem() + (size_t)(b * 256 + (tid >> 1)) * D + h * 256 + (tid & 1) * 32;
    const int kls = (tid >> 1) * 144 + (tid & 1) * 64;
    const bf16_t* vg = F.vt() + (size_t)(h * 256 + (tid >> 3)) * TM + b * 256 + (tid & 7) * 32;
    const int vls = (tid >> 3) * 528 + (tid & 7) * 64;
    u32x4 st[4];
#pragma unroll
    for (int i = 0; i < 4; ++i) st[i] = *(const u32x4*)(kg + 8 * i);
#pragma unroll
    for (int i = 0; i < 4; ++i) *(LAS u32x4*)(bufs[0] + kls + 16 * i) = st[i];
    __syncthreads();
    f32x4 s[16][2];
#pragma unroll
    for (int nt = 0; nt < 16; ++nt) { s[nt][0] = (f32x4){0.f, 0.f, 0.f, 0.f}; s[nt][1] = (f32x4){0.f, 0.f, 0.f, 0.f}; }
#pragma unroll
    for (int c = 0; c < 4; ++c) {
        if (c < 3) {
#pragma unroll
            for (int i = 0; i < 4; ++i) st[i] = *(const u32x4*)(kg + 64 * (c + 1) + 8 * i); }
        else {
#pragma unroll
            for (int i = 0; i < 4; ++i) st[i] = *(const u32x4*)(vg + 8 * i); }
        LAS unsigned char* kb = bufs[c & 1];
        bf16x8 qf[2][2];
#pragma unroll
        for (int qt = 0; qt < 2; ++qt)
#pragma unroll
            for (int ks = 0; ks < 2; ++ks) qf[qt][ks] = *(const bf16x8*)(F.q() + (tq + 16 * qt + fr) * D + h * 256 + 64 * c + 32 * ks + 8 * fq);
#pragma unroll
        for (int nt = 0; nt < 16; ++nt)
#pragma unroll
            for (int ks = 0; ks < 2; ++ks) { const bf16x8 a = *(const LAS bf16x8*)(kb + (16 * nt + fr) * 144 + (32 * ks + 8 * fq) * 2);
                s[nt][0] = mma16(a, qf[0][ks], s[nt][0]); s[nt][1] = mma16(a, qf[1][ks], s[nt][1]); }
        if (c < 3) {
#pragma unroll
            for (int i = 0; i < 4; ++i) *(LAS u32x4*)(bufs[(c + 1) & 1] + kls + 16 * i) = st[i]; }
        __syncthreads();
    }
#pragma unroll
    for (int i = 0; i < 4; ++i) *(LAS u32x4*)(bufs[0] + vls + 16 * i) = st[i];
    float inv[2]; bf16x8 pb[2][8];
#pragma unroll
    for (int qt = 0; qt < 2; ++qt) { float mx = s[0][qt][0];
#pragma unroll
        for (int nt = 0; nt < 16; ++nt)
#pragma unroll
            for (int r = 0; r < 4; ++r) mx = fmaxf(mx, s[nt][qt][r]);
        mx = fmaxf(mx, __shfl_xor(mx, 16)); mx = fmaxf(mx, __shfl_xor(mx, 32));
        float sum = 0.f;
#pragma unroll
        for (int nt = 0; nt < 16; ++nt)
#pragma unroll
            for (int r = 0; r < 4; ++r) { const float e = __expf(s[nt][qt][r] - mx); s[nt][qt][r] = e; sum += e; }
        sum += __shfl_xor(sum, 16); sum += __shfl_xor(sum, 32);
        inv[qt] = __builtin_amdgcn_rcpf(sum);
#pragma unroll
        for (int sk = 0; sk < 8; ++sk) { const float pv[8] = {s[2 * sk][qt][0], s[2 * sk][qt][1], s[2 * sk][qt][2], s[2 * sk][qt][3], s[2 * sk + 1][qt][0], s[2 * sk + 1][qt][1], s[2 * sk + 1][qt][2], s[2 * sk + 1][qt][3]};
            const u32x4 pk = pack8(pv); pb[qt][sk] = __builtin_bit_cast(bf16x8, pk); } }
    __syncthreads();
#pragma unroll
    for (int c = 0; c < 4; ++c) {
        if (c < 3) {
#pragma unroll
            for (int i = 0; i < 4; ++i) st[i] = *(const u32x4*)(vg + (size_t)64 * (c + 1) * TM + 8 * i); }
        LAS unsigned char* vb = bufs[c & 1];
#pragma unroll
        for (int dt = 0; dt < 4; ++dt) { f32x4 o0 = {0.f, 0.f, 0.f, 0.f}, o1 = {0.f, 0.f, 0.f, 0.f};
#pragma unroll
            for (int sk = 0; sk < 8; ++sk) { const LAS unsigned char* vp = vb + (16 * dt + fr) * 528 + (32 * sk + 4 * fq) * 2;
                const u32x2 lo = *(const LAS u32x2*)vp, hi = *(const LAS u32x2*)(vp + 32);
                const u32x4 av = {lo.x, lo.y, hi.x, hi.y}; const bf16x8 a = __builtin_bit_cast(bf16x8, av);
                o0 = mma16(a, pb[0][sk], o0); o1 = mma16(a, pb[1][sk], o1); }
            const int col = h * 256 + 64 * c + 16 * dt + 4 * fq;
            int w0 = 0, w1 = 0;
            w0 = __builtin_amdgcn_cvt_pk_fp8_f32(o0[0] * inv[0], o0[1] * inv[0], w0, false); w0 = __builtin_amdgcn_cvt_pk_fp8_f32(o0[2] * inv[0], o0[3] * inv[0], w0, true);
            w1 = __builtin_amdgcn_cvt_pk_fp8_f32(o1[0] * inv[1], o1[1] * inv[1], w1, false); w1 = __builtin_amdgcn_cvt_pk_fp8_f32(o1[2] * inv[1], o1[3] * inv[1], w1, true);
            *(int*)((unsigned char*)F.ao() + (tq + fr) * D + col) = w0; *(int*)((unsigned char*)F.ao() + (tq + 16 + fr) * D + col) = w1; }
        if (c < 3) {
#pragma unroll
            for (int i = 0; i < 4; ++i) *(LAS u32x4*)(bufs[(c + 1) & 1] + vls + 16 * i) = st[i]; }
        __syncthreads();
    }
}

__device__ __forceinline__ void router_item(Frame& F, int item) {
    const int w = F.wave, lane = F.lane, fr = lane & 15, fq = lane >> 4;
    const size_t t0 = (size_t)item * 16;
    LAS float* lg = (LAS float*)(F.lds + ROUTER_OFF) + w * (16 * 33 + 64);
    LAS int* ex = (LAS int*)(lg + 16 * 33);
    f32x4 acc[2] = {{0.f, 0.f, 0.f, 0.f}, {0.f, 0.f, 0.f, 0.f}};
    const float rsl = row_rs(F.ssq2(), t0 + fr);
    for (int k0 = 0; k0 < 32; k0 += 8) { bf16x8 a[8], b0[8], b1[8];
#pragma unroll
        for (int i = 0; i < 8; ++i) { a[i] = *(const bf16x8*)(F.x2b() + (t0 + fr) * D + 32 * (k0 + i) + 8 * fq);
            b0[i] = *(const bf16x8*)(F.Wr_t() + (size_t)fr * D + 32 * (k0 + i) + 8 * fq); b1[i] = *(const bf16x8*)(F.Wr_t() + (size_t)(16 + fr) * D + 32 * (k0 + i) + 8 * fq); }
#pragma unroll
        for (int i = 0; i < 8; ++i) { acc[0] = mma16(a[i], b0[i], acc[0]); acc[1] = mma16(a[i], b1[i], acc[1]);
            const int col = 32 * (k0 + i) + 8 * fq; const f32x4 g0 = *(const f32x4*)(F.A->in[I_NFFNG] + col), g1 = *(const f32x4*)(F.A->in[I_NFFNG] + col + 4);
            float xv[8]; unpack8(__builtin_bit_cast(u32x4, a[i]), xv);
            xv[0] *= rsl * g0.x; xv[1] *= rsl * g0.y; xv[2] *= rsl * g0.z; xv[3] *= rsl * g0.w; xv[4] *= rsl * g1.x; xv[5] *= rsl * g1.y; xv[6] *= rsl * g1.z; xv[7] *= rsl * g1.w;
            *(u32x2*)(F.x2q() + (t0 + fr) * D + col) = pack8_fp8(xv); } }
#pragma unroll
    for (int r = 0; r < 4; ++r)
#pragma unroll
        for (int nt = 0; nt < 2; ++nt) lg[(4 * fq + r) * 33 + 16 * nt + fr] = acc[nt][r];
    LDS_WAIT();
    float rs = 0.f, gk[4] = {0.f, 0.f, 0.f, 0.f};
    if (lane < 16) { const size_t t = t0 + lane; rs = row_rs(F.ssq2(), t);
        float v[32];
#pragma unroll
        for (int e = 0; e < 32; ++e) v[e] = lg[lane * 33 + e] * rs + F.A->in[I_BR][e];
        unsigned taken = 0u; float tv[4];
#pragma unroll
        for (int k = 0; k < 4; ++k) { float best = -INFINITY; int bi = 0;
#pragma unroll
            for (int e = 0; e < 32; ++e) { const bool ok = !((taken >> e) & 1u) && (v[e] > best); best = ok ? v[e] : best; bi = ok ? e : bi; }
            taken |= 1u << bi; tv[k] = best; ex[lane * 4 + k] = bi; }
        float sum = 0.f;
#pragma unroll
        for (int k = 0; k < 4; ++k) { gk[k] = __expf(tv[k] - tv[0]); sum += gk[k]; }
        const float inv = 1.f / sum;
        *(f32x4*)(F.gates() + t * 4) = (f32x4){gk[0] * inv, gk[1] * inv, gk[2] * inv, gk[3] * inv}; }
    LDS_WAIT();
    const int me = ex[lane]; const float my_rs = __shfl(rs, lane >> 2);
    int rank = 0, mytot = 0;
#pragma unroll
    for (int e = 0; e < 32; ++e) { const unsigned long long m = __ballot(me == e); const int below = __builtin_popcountll(m & ((1ull << lane) - 1ull));
        rank = (me == e) ? below : rank; mytot = (lane == e) ? __builtin_popcountll(m) : mytot; }
    unsigned base = 0u;
    if (lane < 32 && mytot > 0) base = atomicAdd(F.ctl + CW_CNT + lane, (unsigned)mytot);
    const unsigned slot = (unsigned)__shfl((int)base, me) + (unsigned)rank;
    F.list()[me * ECAP + slot] = (int)(t0 * 4 + lane); (void)my_rs;
    LDS_WAIT();
}

__device__ __forceinline__ void expert_tables(Frame& F) {
    LAS int* tab = (LAS int*)(F.lds + TAB_OFF);
    if (F.tid < 32) tab[F.tid] = (int)__hip_atomic_load(F.ctl + CW_CNT + F.tid, __ATOMIC_RELAXED, __HIP_MEMORY_SCOPE_AGENT);
    __syncthreads();
    if (F.tid == 0) { int s = 0; for (int e = 0; e < 32; ++e) { tab[32 + e] = s; s += (tab[e] + 255) >> 8; } tab[64] = s; }
    __syncthreads();
}
template <int NTN, bool GATH> struct ProbExp {
    static constexpr bool GATHER = GATH, gather = GATH, FP8 = true; static constexpr int WSCALE = FP8_WSCALE;
    int K, lda, ldb, G, c; const LAS int* tab; const unsigned char* A; const unsigned char* Bt; const int* list; mutable int ehint;
    __device__ __forceinline__ bool next(int i, Unit& u) const {
        const int L = i * G + c; if (L >= NTN * tab[64]) return false;
        int e = ehint;
#pragma unroll 1
        while (e < 31 && L >= NTN * tab[32 + e + 1]) ++e;
        ehint = e;
        const int r = L - NTN * tab[32 + e], mte = tab[32 + e + 1] - tab[32 + e];
        u.aux = e; u.pn = r / mte; u.pm = r % mte; return true;
    }
    __device__ __forceinline__ const char* a_base(const Unit& u) const { return gather ? (const char*)A : (const char*)(A + (size_t)(tab[32 + u.aux] + u.pm) * 256 * D); }
    __device__ __forceinline__ const char* b_base(const Unit& u) const { return (const char*)(Bt + ((size_t)u.aux * NTN + u.pn) * 256 * D); }
    __device__ __forceinline__ unsigned a_off(const Unit& u, int row, int C) const {
        if (!gather) return (unsigned)(row * D + C * 2);
        const int slot = u.pm * 256 + row; const int av = list[u.aux * ECAP + slot];
        const int a = slot < tab[u.aux] ? av : 0;
        return (unsigned)((a >> 2) * D + C * 2);
    }
};
struct EpiE1 {
    static constexpr bool MID = false, STAGE = true;
    const LAS int* tab; const float* lscale; const float* b1; unsigned char* act;
    __device__ __forceinline__ void stage(const Unit& u, int wid, int lane, LAS unsigned char* lds) const {
        if (wid < 4) { const float* src = b1 + (size_t)u.aux * 2048 + ((wid & 2) ? 1024 : 0) + u.pn * 128 + (wid & 1) * 64 + lane;
            __builtin_amdgcn_global_load_lds((const unsigned*)src, (LAS unsigned*)(lds + EPI_OFF + wid * 256), 4, 0, 0); }
    }
    __device__ __forceinline__ void operator()(const f32x4 (&acc)[2][2][4][2], const Unit& u, int wr, int wc, int fr, int fq) const {
        asm volatile("" : "+v"(fr), "+v"(fq));
        const int e = u.aux; const size_t rbase = (size_t)(tab[32 + e] + u.pm) * 256;
        const int j0 = u.pn * 128 + wc * 32 + 8 * fq;
        const LAS float* bp = (const LAS float*)((const LAS unsigned char*)tab - TAB_OFF + EPI_OFF) + wc * 32 + 8 * fq;
        const f32x4 bg0 = *(const LAS f32x4*)bp, bg1 = *(const LAS f32x4*)(bp + 4), bl0 = *(const LAS f32x4*)(bp + 128), bl1 = *(const LAS f32x4*)(bp + 132);
        const float bg[8] = {bg0.x, bg0.y, bg0.z, bg0.w, bg1.x, bg1.y, bg1.z, bg1.w}, bl[8] = {bl0.x, bl0.y, bl0.z, bl0.w, bl1.x, bl1.y, bl1.z, bl1.w};
#pragma unroll
        for (int ai = 0; ai < 2; ++ai)
#pragma unroll
            for (int m = 0; m < 4; ++m) { const int rt = ai * 128 + wr * 64 + m * 16 + fr; float v[8];
#pragma unroll
                for (int jp = 0; jp < 4; ++jp) {
                    const f32x2 ag = {acc[ai][0][m][jp >> 1][2 * (jp & 1)], acc[ai][0][m][jp >> 1][2 * (jp & 1) + 1]}, al = {acc[ai][1][m][jp >> 1][2 * (jp & 1)], acc[ai][1][m][jp >> 1][2 * (jp & 1) + 1]};
                    const f32x2 bg2 = {bg[2 * jp], bg[2 * jp + 1]}, bl2 = {bl[2 * jp], bl[2 * jp + 1]};
                    const f32x2 ga = ag + bg2, la = al + bl2;
                    const f32x2 glu = {fminf(ga.x, 7.0f), fminf(ga.y, 7.0f)}, lin = {fminf(fmaxf(la.x, -7.0f), 7.0f), fminf(fmaxf(la.y, -7.0f), 7.0f)};
                    const f32x2 t = glu * (-1.702f * 1.4426950408889634f);
                    const f32x2 d = (f32x2){__builtin_amdgcn_exp2f(t.x), __builtin_amdgcn_exp2f(t.y)} + 1.0f;
                    const f32x2 r = {__builtin_amdgcn_rcpf(d.x), __builtin_amdgcn_rcpf(d.y)};
                    const f32x2 o = ((lin + 1.0f) * glu) * r;
                    v[2 * jp] = o.x; v[2 * jp + 1] = o.y; }
                *(u32x2*)(act + (rbase + rt) * D + j0) = pack8_fp8(v); }
    }
};
struct EpiE2 {
    static constexpr bool MID = false, STAGE = true;
    const LAS int* tab; const int* list; const float* b2; unsigned char* yb; unsigned char* dummy;
    __device__ __forceinline__ void stage(const Unit& u, int wid, int lane, LAS unsigned char* lds) const {
        const unsigned* src = (wid < 4) ? (const unsigned*)(b2 + (size_t)u.aux * D + u.pn * 256 + wid * 64 + lane) : (const unsigned*)(list + u.aux * ECAP + u.pm * 256 + (wid - 4) * 64 + lane);
        __builtin_amdgcn_global_load_lds(src, (LAS unsigned*)(lds + EPI_OFF + wid * 256), 4, 0, 0);
    }
    __device__ __forceinline__ void operator()(const f32x4 (&acc)[2][2][4][2], const Unit& u, int wr, int wc, int fr, int fq) const {
        asm volatile("" : "+v"(fr), "+v"(fq));
        const int e = u.aux, cnt = tab[e]; const int col0 = u.pn * 256 + wc * 32 + 8 * fq;
        const LAS float* sb = (const LAS float*)((const LAS unsigned char*)tab - TAB_OFF + EPI_OFF); const LAS int* sl = (const LAS int*)(sb + 256);
        float bb[2][8];
#pragma unroll
        for (int bj = 0; bj < 2; ++bj) { const f32x4 x0 = *(const LAS f32x4*)(sb + bj * 128 + wc * 32 + 8 * fq), x1 = *(const LAS f32x4*)(sb + bj * 128 + wc * 32 + 8 * fq + 4);
            bb[bj][0] = x0.x; bb[bj][1] = x0.y; bb[bj][2] = x0.z; bb[bj][3] = x0.w; bb[bj][4] = x1.x; bb[bj][5] = x1.y; bb[bj][6] = x1.z; bb[bj][7] = x1.w; }
        int aidx[2][4];
#pragma unroll
        for (int ai = 0; ai < 2; ++ai)
#pragma unroll
            for (int m = 0; m < 4; ++m) aidx[ai][m] = sl[ai * 128 + wr * 64 + m * 16 + fr];
#pragma unroll
        for (int ai = 0; ai < 2; ++ai)
#pragma unroll
            for (int m = 0; m < 4; ++m) { const int slot = u.pm * 256 + ai * 128 + wr * 64 + m * 16 + fr;
                unsigned char* rowp = (slot < cnt) ? yb + (size_t)aidx[ai][m] * D : dummy;
#pragma unroll
                for (int bj = 0; bj < 2; ++bj) { float v[8];
#pragma unroll
                    for (int j = 0; j < 4; ++j) { v[j] = acc[ai][bj][m][0][j] + bb[bj][j]; v[4 + j] = acc[ai][bj][m][1][j] + bb[bj][4 + j]; }
                    *(u32x2*)(rowp + col0 + bj * 128) = pack8_fp8(v); } }
    }
};

struct CombTok { u32x4 x[2]; u32x2 y[2][4]; f32x4 g; };
__device__ __forceinline__ void comb_load(Frame& F, int t, int lane, CombTok& c) {
    c.g = *(const f32x4*)(F.gates() + (size_t)t * 4);
#pragma unroll
    for (int hf = 0; hf < 2; ++hf) { const int col = hf * 512 + lane * 8; c.x[hf] = *(const u32x4*)(F.x2b() + (size_t)t * D + col);
#pragma unroll
        for (int k = 0; k < 4; ++k) c.y[hf][k] = *(const u32x2*)((const unsigned char*)F.yb() + ((size_t)t * 4 + k) * D + col); }
}
__device__ __forceinline__ void comb_finish(Frame& F, int t, int lane, const CombTok& c) {
    const float gk[4] = {c.g.x, c.g.y, c.g.z, c.g.w}; float x[2][8]; float ss = 0.f;
#pragma unroll
    for (int hf = 0; hf < 2; ++hf) { unpack8(c.x[hf], x[hf]);
#pragma unroll
        for (int k = 0; k < 4; ++k) { float y[8]; unpack8_fp8(c.y[hf][k], y);
#pragma unroll
            for (int j = 0; j < 8; ++j) x[hf][j] += gk[k] * y[j]; }
#pragma unroll
        for (int j = 0; j < 8; ++j) ss += x[hf][j] * x[hf][j]; }
    const float rs = rsqrtf(wave_sum(ss) * (1.f / D) + EPS);
#pragma unroll
    for (int hf = 0; hf < 2; ++hf) { const int col = hf * 512 + lane * 8; const f32x4 g0 = *(const f32x4*)(F.A->in[I_NFING] + col), g1 = *(const f32x4*)(F.A->in[I_NFING] + col + 4);
        *(f32x4*)(F.A->out + (size_t)t * D + col) = (f32x4){x[hf][0] * rs * g0.x, x[hf][1] * rs * g0.y, x[hf][2] * rs * g0.z, x[hf][3] * rs * g0.w};
        *(f32x4*)(F.A->out + (size_t)t * D + col + 4) = (f32x4){x[hf][4] * rs * g1.x, x[hf][5] * rs * g1.y, x[hf][6] * rs * g1.z, x[hf][7] * rs * g1.w}; }
}
__device__ __forceinline__ void combine_rows(Frame& F) {
    const int gw = F.vcu * 8 + F.wave, NGW = F.G * 8, lane = F.lane;
    if (gw >= T) return;
    CombTok ca, cb; comb_load(F, gw, lane, ca);
    for (int t = gw;;) {
        const bool hb = t + NGW < T; if (hb) comb_load(F, t + NGW, lane, cb);
        comb_finish(F, t, lane, ca); if (!hb) break;
        const bool ha = t + 2 * NGW < T; if (ha) comb_load(F, t + 2 * NGW, lane, ca);
        comb_finish(F, t + NGW, lane, cb); if (!ha) break;
        t += 2 * NGW; }
}

#ifndef DBG_OUT
#define DBG_OUT 0
#endif
#if DBG_OUT
__device__ __forceinline__ void dbg_rows(Frame& F) {
    const int gw = F.vcu * 8 + F.wave, NGW = F.G * 8, lane = F.lane;
    for (int t = gw; t < T; t += NGW) {
#pragma unroll
        for (int hf = 0; hf < 2; ++hf) { const int col = hf * 512 + lane * 8; float x[8];
#pragma unroll
            for (int j = 0; j < 8; ++j) x[j] = 0.f;
            if (DBG_OUT == 1) { for (int m = 0; m < 5; ++m) { if (col + 1024 * m < PN) { float y[8]; unpack8(*(const u32x4*)(F.p() + (size_t)t * PN + col + 1024 * m), y);
#pragma unroll
                for (int j = 0; j < 8; ++j) x[j] += y[j]; } } }
            else if (DBG_OUT == 8) { for (int k = 0; k < 4; ++k) { float y[8]; unpack8_fp8(*(const u32x2*)((const unsigned char*)F.yb() + ((size_t)t * 4 + k) * D + col), y); const float g = F.gates()[t * 4 + k];
#pragma unroll
                for (int j = 0; j < 8; ++j) x[j] += g * y[j]; } }
            else { const bf16_t* B = DBG_OUT == 2 ? F.oab() : DBG_OUT == 3 ? F.mix() : DBG_OUT == 4 ? F.x1b() : DBG_OUT == 5 ? F.q() : DBG_OUT == 6 ? F.ao() : F.x2b();
                unpack8(*(const u32x4*)(B + (size_t)t * D + col), x); }
#pragma unroll
            for (int j = 0; j < 8; ++j) if (!(fabsf(x[j]) < 1e30f)) x[j] = 1e6f;
            *(f32x4*)(F.A->out + (size_t)t * D + col) = (f32x4){x[0], x[1], x[2], x[3]};
            *(f32x4*)(F.A->out + (size_t)t * D + col + 4) = (f32x4){x[4], x[5], x[6], x[7]}; }
    }
}
#endif

__global__ void __launch_bounds__(512, 2) fwd_kernel(Args args) {
    extern __shared__ __attribute__((aligned(16))) unsigned char lds[];
    Frame F;
    F.lds = (LAS unsigned char*)lds; F.MISC = (volatile LAS unsigned*)(F.lds + MISC_OFF);
    F.tid = threadIdx.x; F.lane = F.tid & 63; F.wave = __builtin_amdgcn_readfirstlane(F.tid >> 6);
    F.G = gridDim.x; { const int bx = blockIdx.x; F.vcu = (F.G % 8 == 0) ? (bx % 8) * (F.G / 8) + bx / 8 : bx; }
    F.ctl = (unsigned*)(args.ws + WS_CTL);
    F.A = &args;
    for (int u = F.tid; u < 64; u += 512) ((LAS unsigned*)(F.lds + MISC_OFF))[u] = 0u;
    __syncthreads();
    XcdBarrier bar; bar.bar = F.ctl + CW_BAR; bar.x = 0; bar.st = nullptr;
    if (!MK_PER_PHASE) bar = xcd_barrier_post(F.ctl + CW_BAR, F.MISC + 8);
    const int lo = args.ph_lo, hi = args.ph_hi;
#ifndef PH_MASK
#define PH_MASK 0x3fff
#endif
#define IN(k) (((PH_MASK >> (k)) & 1) && lo <= (k) && (k) < hi)
#ifndef DOUBLE_MASK
#define DOUBLE_MASK 0
#endif
#define REP(k) for (int _rep = 0; _rep < ((((DOUBLE_MASK) >> (k)) & 1) ? 2 : 1); ++_rep, ((((DOUBLE_MASK) >> (k)) & 1) && _rep == 1 ? xcd_barrier(bar) : (void)0))
#define SEAM(k) do { if (IN(k) && IN((k) + 1)) xcd_barrier(bar); } while (0)
    const int c = (int)blockIdx.x;

    if (IN(0)) REP(0) { p0_prologue(F); } SEAM(0);
    if (IN(1)) REP(1) { ProbP1 P{D, D, ProbP1::EB * D, F.G, c, args.ws}; EpiP1 E{args.ws}; pg8::gemm_phase(F.lds, P, E); } SEAM(1);
    if (IN(2)) REP(2) { for (int u = F.vcu; u < 1024; u += F.G) gla_a_unit(F, u); } SEAM(2);
    if (IN(3)) REP(3) { cvt_range(F, CVT_LATE, CVT_EXPERT);
                        if (F.wave < 4) for (int it = F.vcu * 4 + F.wave; it < 1024; it += F.G * 4) gla_sscan_item(F, it);
                        for (int u = F.vcu; u < 512; u += F.G) sgu_unit(F, u); } SEAM(3);
    if (IN(4)) REP(4) { for (int it = F.vcu * 8 + F.wave; it < 4096; it += F.G * 8) gla_out_item(F, it); } SEAM(4);
    if (IN(5)) REP(5) { ProbStd P{D, D, 2 * D, F.G, c, F.oab(), F.Wpab_t()}; EpiMix2 E{F.p(), F.mix()}; pg8::gemm_phase(F.lds, P, E); } SEAM(5);
    if (IN(6)) REP(6) { ProbStd P{D, D, 2 * D, F.G, c, F.mix(), F.Wmo_t()}; EpiRes<true> E{(const void*)F.A->in[I_X], F.x1b(), F.ssq1(), F.x1q(), nullptr}; pg8::gemm_phase(F.lds, P, E); } SEAM(6);
    if (IN(7)) REP(7) { ProbStdT<true, 0x75757575> P{D, D, D, F.G, c, F.x1q(), F.Wq_t()}; EpiScale E{F.ssq1(), F.q()};     pg8::gemm_phase(F.lds, P, E); } SEAM(7);
    if (IN(8)) REP(8) { for (int u = F.vcu; u < 256; u += F.G) attn_unit(F, u); } SEAM(8);
    if (IN(9)) REP(9) { ProbStdT<true> P{D, D, D, F.G, c, F.ao(), F.Wo_t()}; EpiRes<false> E{(const void*)F.x1b(), F.x2b(), F.ssq2(), nullptr, nullptr}; pg8::gemm_phase(F.lds, P, E); } SEAM(9);
    if (IN(10)) REP(10) { for (int it = F.wave * F.G + F.vcu; it < 1024; it += 8 * F.G) router_item(F, it); cvt_expert_dma(F, 0, CVT_I1 + CVT_I2 - CVT_TAIL, F.vcu, F.G); }        SEAM(10);
    if (IN(11)) REP(11) { expert_tables(F); const LAS int* tab = (const LAS int*)(F.lds + TAB_OFF);
        ProbExp<8, true> P{D, D, D, F.G, F.vcu, tab, F.x2q(), (const unsigned char*)F.W1_t(), F.list(), 0}; EpiE1 E{tab, F.lscale(), F.A->in[I_BE1], (unsigned char*)F.act()}; pg8::gemm_phase(F.lds, P, E);
        { const int rem = (8 * tab[64]) % F.G;
          if (F.vcu >= rem) cvt_expert_dma(F, CVT_I1 + CVT_I2 - CVT_TAIL, CVT_I1 + CVT_I2, F.vcu - rem, F.G - rem); } } SEAM(11);
    if (IN(12)) REP(12) { expert_tables(F); const LAS int* tab = (const LAS int*)(F.lds + TAB_OFF);
        ProbExp<4, false> P{D, D, D, F.G, F.vcu, tab, (const unsigned char*)F.act(), (const unsigned char*)F.W2_t(), F.list(), 0}; EpiE2 E{tab, F.list(), F.A->in[I_BE2], (unsigned char*)F.yb(), (unsigned char*)(args.ws + WS_CTL + 512 * 1024)}; pg8::gemm_phase(F.lds, P, E); } SEAM(12);
#if DBG_OUT
    if (lo <= 13 && 13 < hi) { dbg_rows(F); }
#else
    if (IN(13)) REP(13) { combine_rows(F); }
#endif
#undef IN
#undef SEAM
}

extern "C" void kernel_launch(void* const* d_in, const int* in_sizes, int n_in, void* d_out, int out_size, void* d_ws, size_t ws_size, hipStream_t stream) {
    static int grid = 0;
    if (grid == 0) {
        if (n_in != 28 || in_sizes[0] != T * D || out_size != T * D || ws_size < WS_END) { fprintf(stderr, "kernel_launch: unexpected problem (n_in %d, in0 %d, out %d, ws %zu); nothing launched\n", n_in, n_in > 0 ? in_sizes[0] : -1, out_size, ws_size); grid = -1; return; }
        int dev = 0, cus = 0, per_cu = 0;
        if (hipGetDevice(&dev) != hipSuccess || hipDeviceGetAttribute(&cus, hipDeviceAttributeMultiprocessorCount, dev) != hipSuccess) { grid = -1; return; }
        if (hipFuncSetAttribute((const void*)fwd_kernel, hipFuncAttributeMaxDynamicSharedMemorySize, LDS_BYTES) != hipSuccess) { fprintf(stderr, "kernel_launch: hipFuncSetAttribute failed\n"); grid = -1; return; }
        if (hipOccupancyMaxActiveBlocksPerMultiprocessor(&per_cu, (const void*)fwd_kernel, 512, LDS_BYTES) != hipSuccess || per_cu < 1) fprintf(stderr, "kernel_launch: occupancy query reports %d blocks per CU\n", per_cu);
        (void)hipGetLastError();
        grid = cus;
    }
    if (grid < 0) return;
    if (hipMemsetAsync((char*)d_ws + WS_CTL, 0, CTL_ZERO_BYTES, stream) != hipSuccess) { fprintf(stderr, "kernel_launch: memset failed\n"); return; }
    Args a{};
    for (int i = 0; i < 28; ++i) a.in[i] = (const float*)d_in[i];
    a.out = (float*)d_out; a.ws = (unsigned char*)d_ws;
#if MK_PER_PHASE
    for (int ph = 0; ph < NPHASE; ++ph) { a.ph_lo = ph; a.ph_hi = ph + 1; hipLaunchKernelGGL(fwd_kernel, dim3(grid), dim3(512), LDS_BYTES, stream, a); }
#else
    a.ph_lo = 0; a.ph_hi = NPHASE;
    hipLaunchKernelGGL(fwd_kernel, dim3(grid), dim3(512), LDS_BYTES, stream, a);
#endif
}
```

```cpp
#include <hip/hip_runtime.h>
#include <cstdio>
#include <cstdint>

#ifndef P1_FP8
#define P1_FP8 0
#endif
#ifndef P1_GATES_FP8
#define P1_GATES_FP8 1
#endif
#ifndef MK_PER_PHASE
#define MK_PER_PHASE 0
#endif

#define LAS __attribute__((address_space(3)))
#define GAS __attribute__((address_space(1)))
typedef unsigned short bf16_t;
typedef short bf16x8 __attribute__((ext_vector_type(8)));
typedef float f32x4 __attribute__((ext_vector_type(4)));
typedef float f32x2 __attribute__((ext_vector_type(2)));
typedef unsigned u32x4 __attribute__((ext_vector_type(4)));
typedef unsigned u32x2 __attribute__((ext_vector_type(2)));
typedef int i32x4 __attribute__((ext_vector_type(4)));
typedef int i32x8 __attribute__((ext_vector_type(8)));
#define FP8_WSCALE 0x79797979
constexpr float FP8_WMUL = 64.0f;
typedef GAS unsigned gu32;

constexpr int T = 16384, D = 1024, NBATCH = 8, SEQ = 2048, MEMLEN = 256, TM = NBATCH * MEMLEN;
constexpr int INC = 4624;
constexpr int PN = 4864;
constexpr int PC_Q = 0, PC_K = 256, PC_V = 512, PC_R = 1024, PC_U = 1536, PC_SV = 2048, PC_GA = 2560, PC_GB = 3584, PC_A = 4608;
constexpr int OFF_A = 1536;
constexpr int NE = 32, NASG = T * 4, ECAP = 16384;
constexpr float EPS = 1e-5f;
constexpr int NPHASE = 14;

constexpr size_t MiB = 1u << 20;
constexpr size_t WS_CTL = 0, CTL_ZERO_BYTES = 1 * MiB;
constexpr size_t WS_WR = 1 * MiB, WS_SGUW = 1 * MiB + 256 * 1024, WS_DECAY = 1 * MiB + 512 * 1024;
constexpr size_t WS_WIN = 716 * MiB, WS_WK = 728 * MiB, WS_WV = 730 * MiB,        WS_WPAB = 16 * MiB, WS_WMO = 18 * MiB, WS_WQ = 20 * MiB, WS_WO = 22 * MiB;
constexpr size_t WS_SSQ1 = 24 * MiB, WS_SSQ2 = 25 * MiB, WS_LIST = 26 * MiB, WS_LSCALE = 28 * MiB, WS_GATES = 30 * MiB;
constexpr size_t WS_W1 = 32 * MiB, WS_W2 = 160 * MiB, WS_H = 796 * MiB  , WS_MEMN = 732 * MiB, WS_KMEM = 736 * MiB, WS_VT = 740 * MiB, WS_QIN = 268 * MiB;
constexpr size_t WS_OINTRA = 276 * MiB, WS_KVT = 308 * MiB, WS_OAB = 340 * MiB, WS_MIX = 372 * MiB, WS_X1B = 404 * MiB, WS_Q = 436 * MiB, WS_AO = 468 * MiB, WS_X2B = 500 * MiB;
constexpr size_t WS_P = 828 * MiB, WS_ACT = 684 * MiB, WS_YB = 532 * MiB, WS_SPT = 660 * MiB,        WS_X2Q = 972 * MiB, WS_X1Q = 988 * MiB, WS_SVS = 1004 * MiB, WS_END = 1005 * MiB;
constexpr size_t WS_G8 = 764 * MiB; static_assert(WS_WIN >= WS_ACT + 32 * MiB && WS_VT + 4 * MiB <= WS_G8 && WS_G8 >= WS_ACT && WS_G8 + 32 * MiB <= WS_H && WS_H + 32 * MiB <= WS_P, "aliases of the act region");
constexpr size_t WS_HQ = WS_X1Q;
constexpr size_t WS_WINQ = 1005 * MiB, WS_END2 = 1007 * MiB;
static_assert(WS_P + (size_t)T * PN * 2 <= WS_X1Q && WS_ACT + (size_t)(NASG + NE * 256) * 1024 * 2 <= WS_P && WS_YB + (size_t)NASG * 1024 * 2 <= WS_SPT && WS_SPT + 16 * MiB <= WS_ACT, "ws map");
constexpr int CW_CNT = 64;
constexpr int CW_BAR = 4096;

constexpr int RING_BYTES = 131072;
constexpr int TAB_OFF = 139264, MISC_OFF = 141312, ROUTER_OFF = 147456, EPI_OFF = 147456, LDS_BYTES = 163840;

typedef __bf16 bf16x2_t __attribute__((ext_vector_type(2)));
__device__ __forceinline__ unsigned cvt_pk_bf16(float lo, float hi) { const f32x2 v = {lo, hi}; const bf16x2_t b = __builtin_convertvector(v, bf16x2_t); return __builtin_bit_cast(unsigned, b); }
__device__ __forceinline__ bf16_t f2bf(float f) { return (bf16_t)(cvt_pk_bf16(f, 0.f) & 0xffffu); }
__device__ __forceinline__ float bflo(unsigned w) { return __uint_as_float(w << 16); }
__device__ __forceinline__ float bfhi(unsigned w) { return __uint_as_float(w & 0xffff0000u); }
__device__ __forceinline__ float bf2f(bf16_t v) { return __uint_as_float((unsigned)v << 16); }
__device__ __forceinline__ void unpack8(const u32x4 w, float (&f)[8]) { f[0] = bflo(w.x); f[1] = bfhi(w.x); f[2] = bflo(w.y); f[3] = bfhi(w.y); f[4] = bflo(w.z); f[5] = bfhi(w.z); f[6] = bflo(w.w); f[7] = bfhi(w.w); }
__device__ __forceinline__ u32x4 pack8(const float (&f)[8]) { u32x4 w; w.x = cvt_pk_bf16(f[0], f[1]); w.y = cvt_pk_bf16(f[2], f[3]); w.z = cvt_pk_bf16(f[4], f[5]); w.w = cvt_pk_bf16(f[6], f[7]); return w; }
__device__ __forceinline__ u32x2 pack8_fp8(const float (&f)[8]) { int a = 0, b = 0;
    a = __builtin_amdgcn_cvt_pk_fp8_f32(f[0], f[1], a, false); a = __builtin_amdgcn_cvt_pk_fp8_f32(f[2], f[3], a, true);
    b = __builtin_amdgcn_cvt_pk_fp8_f32(f[4], f[5], b, false); b = __builtin_amdgcn_cvt_pk_fp8_f32(f[6], f[7], b, true);
    return (u32x2){(unsigned)a, (unsigned)b}; }
__device__ __forceinline__ void unpack8_fp8(const u32x2 w, float (&f)[8]) {
    const f32x2 a = __builtin_amdgcn_cvt_pk_f32_fp8((int)w.x, false), b = __builtin_amdgcn_cvt_pk_f32_fp8((int)w.x, true), c = __builtin_amdgcn_cvt_pk_f32_fp8((int)w.y, false), d = __builtin_amdgcn_cvt_pk_f32_fp8((int)w.y, true);
    f[0] = a.x; f[1] = a.y; f[2] = b.x; f[3] = b.y; f[4] = c.x; f[5] = c.y; f[6] = d.x; f[7] = d.y; }
__device__ __forceinline__ f32x4 mma16(bf16x8 a, bf16x8 b, f32x4 c) { return __builtin_amdgcn_mfma_f32_16x16x32_bf16(a, b, c, 0, 0, 0); }
__device__ __forceinline__ float wave_sum(float v) {
#pragma unroll
    for (int o = 1; o < 64; o <<= 1) v += __shfl_xor(v, o);
    return v;
}
__device__ __forceinline__ float sigmoidf_(float x) { return __builtin_amdgcn_rcpf(1.0f + __expf(-x)); }
__device__ __forceinline__ float gelu_erf(float v) {
    const float av = fabsf(v), t = __builtin_amdgcn_rcpf(av * 0.2316418882f + 1.0f);
    float q = t * 0.5307027145f + (-0.7265760135f); q = q * t + 0.7107068705f; q = q * t + (-0.142248368f); q = q * t + 0.127414796f; q = q * t;
    const float e = __builtin_amdgcn_exp2f((v * v) * (-0.72134752044f));
    const float m = v * (q * e);
    return v < 0.f ? m : v - m;
}
__device__ __forceinline__ f32x2 gelu_pk(f32x2 v) {
    const f32x2 av = __builtin_elementwise_abs(v), d = av * 0.2316418882f + 1.0f;
    f32x2 t; t.x = __builtin_amdgcn_rcpf(d.x); t.y = __builtin_amdgcn_rcpf(d.y);
    f32x2 q = t * 0.5307027145f + (-0.7265760135f); q = q * t + 0.7107068705f; q = q * t + (-0.142248368f); q = q * t + 0.127414796f; q = q * t;
    const f32x2 s = (v * v) * (-0.72134752044f);
    f32x2 e; e.x = __builtin_amdgcn_exp2f(s.x); e.y = __builtin_amdgcn_exp2f(s.y);
    const f32x2 m = v * (q * e), r = v - m;
    f32x2 o; o.x = v.x < 0.f ? m.x : r.x; o.y = v.y < 0.f ? m.y : r.y; return o;
}
__device__ __forceinline__ f32x2 sigmoid_pk(f32x2 v) {
    const f32x2 t = v * (-1.4426950408889634f); const f32x2 d = (f32x2){__builtin_amdgcn_exp2f(t.x), __builtin_amdgcn_exp2f(t.y)} + 1.0f;
    return (f32x2){__builtin_amdgcn_rcpf(d.x), __builtin_amdgcn_rcpf(d.y)};
}
#define LDS_WAIT() asm volatile("s_waitcnt lgkmcnt(0)" ::: "memory")
#define VM_WAIT() asm volatile("s_waitcnt vmcnt(0)" ::: "memory")

#define XB_TMO      128
#define XB_XCNT(j)  (256  + 64 * (j))
#define XB_XSUB(j)  (1280 + 64 * (j))
#define XB_XGEN(j)  (2304 + 64 * (j))
#define XB_TOP      3328
#define XB_TOPGEN   3392
#define XCD_BAR_WORDS 3456
#define XB_SPIN_CAP (1u << 22)
__device__ __forceinline__ unsigned xb_ld(unsigned* p)              { return __hip_atomic_load(p, __ATOMIC_RELAXED, __HIP_MEMORY_SCOPE_AGENT); }
__device__ __forceinline__ unsigned xb_add(unsigned* p, unsigned v) { return __hip_atomic_fetch_add(p, v, __ATOMIC_RELAXED, __HIP_MEMORY_SCOPE_AGENT); }
__device__ __forceinline__ unsigned xb_xcc_id() { return (unsigned)__builtin_amdgcn_s_getreg((3 << 11) | 20) & 0xFu; }
#define XB_SPIN(cond, bar) do { unsigned _sp = 0; while (cond) { __builtin_amdgcn_s_sleep(1); \
    if ((++_sp & 255u) == 0u) { if (xb_ld(&(bar)[XB_TMO])) break; if (_sp > XB_SPIN_CAP) { atomicAdd(&(bar)[XB_TMO], 1u); break; } } } } while (0)
struct XcdBarrier { unsigned* bar; unsigned x; volatile LAS unsigned* st; };
__device__ __forceinline__ XcdBarrier xcd_barrier_post(unsigned* bar, volatile LAS unsigned* st) {
    XcdBarrier b; b.bar = bar; b.x = xb_xcc_id(); b.st = st;
    if (threadIdx.x == 0) (void)xb_add(&bar[XB_XCNT(b.x)], 1u);
    return b;
}
__device__ __forceinline__ void xcd_barrier_complete(unsigned* bar, unsigned x, unsigned& nloc, unsigned& nx) {
    const unsigned G = gridDim.x * gridDim.y * gridDim.z;
    unsigned sum, cnt, mine, sp = 0u;
    for (;;) {
        sum = 0u; cnt = 0u; mine = 0u;
#pragma unroll
        for (unsigned j = 0; j < 16; ++j) { const unsigned c = xb_ld(&bar[XB_XCNT(j)]); sum += c; cnt += (c > 0u) ? 1u : 0u; mine = (j == x) ? c : mine; }
        if (sum == G) break;
        __builtin_amdgcn_s_sleep(1);
        if ((++sp & 255u) == 0u) { if (xb_ld(&bar[XB_TMO])) break; if (sp > XB_SPIN_CAP) { atomicAdd(&bar[XB_TMO], 1u); break; } }
    }
    nloc = mine > 0u ? mine : 1u; nx = cnt > 0u ? cnt : 1u;
}
__device__ __forceinline__ void xcd_barrier(const XcdBarrier& b) {
    asm volatile("s_waitcnt vmcnt(0)" ::: "memory");
    __syncthreads();
    if (threadIdx.x == 0) {
        unsigned* bar = b.bar;
        __builtin_amdgcn_s_waitcnt(0);
        unsigned nloc = b.st[0], nx = b.st[1];
        if (nloc == 0u) { xcd_barrier_complete(bar, b.x, nloc, nx); b.st[0] = nloc; b.st[1] = nx; }
        const unsigned old = xb_add(&bar[XB_XSUB(b.x)], 1u);
        const unsigned gen = old / nloc;
        if (old + 1u == (gen + 1u) * nloc) {
            __builtin_amdgcn_fence(__ATOMIC_RELEASE, "agent");
            asm volatile("s_waitcnt vmcnt(0)" ::: "memory");
            const unsigned og = xb_add(&bar[XB_TOP], 1u);
            const unsigned tg = og / nx;
            if (og + 1u == (tg + 1u) * nx) xb_add(&bar[XB_TOPGEN], 1u);
            else XB_SPIN(xb_ld(&bar[XB_TOPGEN]) == tg, bar);
            __builtin_amdgcn_fence(__ATOMIC_ACQUIRE, "agent");
            xb_add(&bar[XB_XGEN(b.x)], 1u);
            asm volatile("s_waitcnt vmcnt(0)" ::: "memory");
        } else {
            __builtin_amdgcn_fence(__ATOMIC_ACQUIRE, "agent");
            XB_SPIN(xb_ld(&bar[XB_XGEN(b.x)]) == gen, bar);
            asm volatile("s_waitcnt vmcnt(0)" ::: "memory");
        }
    }
    __syncthreads();
}

namespace pg8 {
constexpr int BM = 256, BK = 64, HALF = 128, HTB = HALF * BK * 2, NXCD = 8, WGM = 8;
__host__ __device__ __forceinline__ int lds_byte(int r, int c) { const int st = (r >> 4) * 2 + (c >> 5), rr = r & 15, cc = c & 31, ob = rr * 64 + cc * 2; return st * 1024 + (ob ^ (((ob >> 9) & 1) << 5)); }
__host__ __device__ __forceinline__ void stage_rc(int b, int& R, int& C) { const int st = b / 1024, sb = b % 1024, swz = sb ^ (((sb >> 9) & 1) << 5); R = (st >> 1) * 16 + swz / 64; C = (st & 1) * 32 + (swz % 64) / 2; }
__host__ __device__ __forceinline__ int perm32(int rho) { const int n = rho >> 4, i = rho & 15; return 8 * (i >> 2) + 4 * n + (i & 3); }
struct Unit { int pm, pn, aux; };
__device__ __forceinline__ void map_tile(int L, int nM, int nN, int& pm, int& pn) {
    const int nwg = nM * nN; int wgid = L;
    { const int q = nwg / NXCD, r = nwg % NXCD, xcd = wgid % NXCD, off = wgid / NXCD; wgid = (xcd < r ? xcd * (q + 1) : r * (q + 1) + (xcd - r) * q) + off; }
    const int nig = WGM * nN, gid = wgid / nig, fm = gid * WGM, gsz = (nM - fm) < WGM ? (nM - fm) : WGM;
    pm = fm + ((wgid % nig) % gsz); pn = (wgid % nig) / gsz;
}
template <class P> constexpr auto pg8_btiled(int) -> decltype(P::BTILED) { return P::BTILED; }
template <class P> constexpr bool pg8_btiled(long) { return false; }
template <class Epi, class Prob>
__device__ __forceinline__ void gemm_phase(LAS unsigned char* lds, const Prob& P, const Epi& E) {
    const int tid = threadIdx.x, wid = __builtin_amdgcn_readfirstlane(tid >> 6), lane = tid & 63, wr = wid >> 2, wc = wid & 3, fr = lane & 15, fq = lane >> 4;
    const int nt = P.K / (Prob::FP8 ? 128 : BK);
    unsigned voffB[2];
#pragma unroll
    for (int i = 0; i < 2; ++i) { int R_, C_; stage_rc(tid * 16 + i * 8192, R_, C_); const int Rb = (R_ & ~31) + perm32(R_ & 31); voffB[i] = (unsigned)(Rb * P.ldb + C_ * 2); }
#define PG8_AOFF_LDS(dst0, dst1, unit) do { _Pragma("unroll") for (int _i = 0; _i < 2; ++_i) { int R_, C_; stage_rc(tid * 16 + _i * 8192, R_, C_); dst0[_i] = P.a_off_lds(unit, R_, C_, lds); dst1[_i] = P.a_off_lds(unit, R_ + HALF, C_, lds); } } while (0)
#define PG8_AOFF(dst0, dst1, unit) do { _Pragma("unroll") for (int _i = 0; _i < 2; ++_i) { int R_, C_; stage_rc(tid * 16 + _i * 8192, R_, C_); dst0[_i] = P.a_off(unit, R_, C_); dst1[_i] = P.a_off(unit, R_ + HALF, C_); } } while (0)
    const size_t kstep = (size_t)(BK * 2);
    const size_t kstepB = pg8_btiled<Prob>(0) ? (size_t)(256 * 128) : kstep;
    const size_t hstepB = (size_t)HALF * P.ldb;
    const unsigned ldsw = (unsigned)wid * 1024u;
    const int aoff = lds_byte(wr * 64 + fr, fq * 8), boff = lds_byte(wc * 32 + fr, fq * 8);
#define PG8_SA(b, h) (((b) * 2 + (h)) * HTB)
#define PG8_SB(b, h) ((4 + (b) * 2 + (h)) * HTB)
#define PG8_STAGE(bufoff, gbase, voff) do { _Pragma("unroll") for (int _i = 0; _i < 2; ++_i) \
        __builtin_amdgcn_global_load_lds((const unsigned*)((const char*)(gbase) + (voff)[_i]), (LAS unsigned*)(lds + (bufoff) + ldsw + _i * 8192), 16, 0, 0); } while (0)
#define PG8_LD8(addr) __builtin_shufflevector(*(const LAS i32x4*)(addr), *(const LAS i32x4*)((addr) + 1024), 0, 1, 2, 3, 4, 5, 6, 7)
#define PG8_LDA(dst, b, h) do { _Pragma("unroll") for (int m = 0; m < 4; ++m) dst[m] = PG8_LD8(lds + PG8_SA(b, h) + aoff + m * 2048); } while (0)
#define PG8_LDB(dst, b, h) do { _Pragma("unroll") for (int n = 0; n < 2; ++n) dst[n] = PG8_LD8(lds + PG8_SB(b, h) + boff + n * 2048); } while (0)
#define PG8_LO(x) __builtin_bit_cast(bf16x8, __builtin_shufflevector(x, x, 0, 1, 2, 3))
#define PG8_HI(x) __builtin_bit_cast(bf16x8, __builtin_shufflevector(x, x, 4, 5, 6, 7))
#define PG8_MMA(ai, bj, At, Bt) do { __builtin_amdgcn_s_setprio(1); _Pragma("unroll") for (int m = 0; m < 4; ++m) _Pragma("unroll") for (int n = 0; n < 2; ++n) { \
        if constexpr (Prob::FP8) asm volatile("v_mfma_scale_f32_16x16x128_f8f6f4 %0, %1, %2, %0, %3, %4 op_sel_hi:[0,0,0]" : "+v"(acc[ai][bj][m][n]) : "v"(Bt[n]), "v"(At[m]), "v"(scl_w), "v"(scl_1)); \
        else { acc[ai][bj][m][n] = __builtin_amdgcn_mfma_f32_16x16x32_bf16(PG8_LO(Bt[n]), PG8_LO(At[m]), acc[ai][bj][m][n], 0, 0, 0); \
               acc[ai][bj][m][n] = __builtin_amdgcn_mfma_f32_16x16x32_bf16(PG8_HI(Bt[n]), PG8_HI(At[m]), acc[ai][bj][m][n], 0, 0, 0); } } \
        __builtin_amdgcn_s_setprio(0); } while (0)
#define PG8_WAIT_V(n) asm volatile("s_waitcnt vmcnt(" #n ")" ::: "memory")
#define PG8_WAIT_L(n) asm volatile("s_waitcnt lgkmcnt(" #n ")" ::: "memory")
#define PG8_BAR __builtin_amdgcn_s_barrier()
#define PG8_SCHED __builtin_amdgcn_sched_barrier(0)
    Unit cur, nxt; int ui = 0;
    if (!P.next(0, cur)) return;
    f32x4 acc[2][2][4][2];
#pragma unroll
    for (int a = 0; a < 2; ++a)
#pragma unroll
        for (int b = 0; b < 2; ++b)
#pragma unroll
            for (int m = 0; m < 4; ++m)
#pragma unroll
                for (int n = 0; n < 2; ++n) acc[a][b][m][n] = (f32x4){0.f, 0.f, 0.f, 0.f};
    i32x8 At[4], B0[2], B1[2];
    int scl_w = Prob::WSCALE, scl_1 = 0x7f7f7f7f; asm volatile("" : "+v"(scl_w), "+v"(scl_1));
    unsigned cO0[2], cO1[2], nO0[2], nO1[2];
    PG8_AOFF(cO0, cO1, cur);
    const char* cA = P.a_base(cur); const char* cB = P.b_base(cur);
    PG8_STAGE(PG8_SB(0, 0), cB, voffB); PG8_STAGE(PG8_SB(0, 1), cB + hstepB, voffB); PG8_STAGE(PG8_SA(0, 0), cA, cO0); PG8_STAGE(PG8_SA(0, 1), cA, cO1);
    if (wr == 1) PG8_BAR;
    PG8_WAIT_V(2); PG8_BAR;
    PG8_STAGE(PG8_SB(1, 0), cB + kstepB, voffB); PG8_STAGE(PG8_SA(1, 0), cA + kstep, cO0); PG8_STAGE(PG8_SB(1, 1), cB + hstepB + kstepB, voffB);
    PG8_WAIT_V(6); PG8_BAR;
    for (;;) {
        const bool has_next = P.next(ui + 1, nxt);
        const char* nA = cA; const char* nB = cB;
        if constexpr (Prob::GATHER) {
#pragma unroll
            for (int i = 0; i < 2; ++i) { nO0[i] = cO0[i]; nO1[i] = cO1[i]; } }
        if (has_next) { nA = P.a_base(nxt); nB = P.b_base(nxt); if constexpr (Prob::GATHER) P.stage_next(nxt, wid, lane, lds); }
        for (int t = 0; t < nt; t += 2) {
            const bool last = (t == nt - 2);
            const char* a1 = cA + (size_t)(t + 1) * kstep;
            const char* a2 = last ? nA : cA + (size_t)(t + 2) * kstep; const char* b2 = last ? nB : cB + (size_t)(t + 2) * kstepB;
            const char* a3 = a2 + kstep; const char* b3 = b2 + kstepB;
            unsigned o20[2], o21[2];
            if constexpr (Prob::GATHER) { if (last && has_next) PG8_AOFF_LDS(nO0, nO1, nxt); }
#pragma unroll
            for (int i = 0; i < 2; ++i) { if constexpr (Prob::GATHER) { o20[i] = last ? nO0[i] : cO0[i]; o21[i] = last ? nO1[i] : cO1[i]; } else { o20[i] = cO0[i]; o21[i] = cO1[i]; } }
            const bool fin = last && !has_next;
            const bool relax = Epi::NSTORE > 0 && ui > 0 && t == 0;
            PG8_LDB(B0, 0, 0); PG8_LDB(B1, 0, 1); PG8_SCHED; PG8_LDA(At, 0, 0); PG8_STAGE(PG8_SA(1, 1), a1, cO1);
            if (relax) { if constexpr (Epi::NSTORE == 16) PG8_WAIT_V(24); else PG8_WAIT_V(16); } else PG8_WAIT_V(8);
            PG8_WAIT_L(0); PG8_BAR; PG8_MMA(0, 0, At, B0); PG8_MMA(0, 1, At, B1); PG8_BAR; PG8_SCHED;
            PG8_LDA(At, 0, 1);
            if (!fin) { PG8_STAGE(PG8_SB(0, 0), b2, voffB); PG8_STAGE(PG8_SB(0, 1), b2 + hstepB, voffB); PG8_STAGE(PG8_SA(0, 0), a2, o20);
                if (relax) { if constexpr (Epi::NSTORE == 16) PG8_WAIT_V(24); else PG8_WAIT_V(16); } else PG8_WAIT_V(8); }
            else PG8_WAIT_V(2);
            PG8_WAIT_L(0); PG8_BAR; PG8_MMA(1, 0, At, B0); PG8_MMA(1, 1, At, B1); PG8_BAR; PG8_SCHED;
            if constexpr (Epi::STAGE) { if (last) E.stage(cur, wid, lane, lds); }
            PG8_LDB(B0, 1, 0); PG8_LDB(B1, 1, 1); PG8_SCHED; PG8_LDA(At, 1, 0);
            if (!fin) { PG8_STAGE(PG8_SA(0, 1), a2, o21); PG8_WAIT_V(8); }
            else PG8_WAIT_V(0);
            PG8_WAIT_L(0); PG8_BAR; PG8_MMA(0, 0, At, B0); PG8_MMA(0, 1, At, B1); PG8_BAR; PG8_SCHED;
            PG8_LDA(At, 1, 1);
            if (!fin) { PG8_STAGE(PG8_SB(1, 0), b3, voffB); PG8_STAGE(PG8_SB(1, 1), b3 + hstepB, voffB); PG8_STAGE(PG8_SA(1, 0), a3, o20); PG8_WAIT_V(8); }
            PG8_WAIT_L(0); PG8_BAR; PG8_MMA(1, 0, At, B0); PG8_MMA(1, 1, At, B1); PG8_BAR; PG8_SCHED;
            if constexpr (Epi::MID) { if (t + 2 == nt / 2) E.mid(acc, cur, wr, wc, fr, fq); }
        }
        if (wr == 0) PG8_BAR;
        if constexpr (Prob::FP8) asm volatile("s_nop 15\n\ts_nop 15" ::: "memory");
        E(acc, cur, wr, wc, fr, fq);
        if (!has_next) break;
#pragma unroll
        for (int a = 0; a < 2; ++a)
#pragma unroll
            for (int b = 0; b < 2; ++b)
#pragma unroll
                for (int m = 0; m < 4; ++m)
#pragma unroll
                    for (int n = 0; n < 2; ++n) acc[a][b][m][n] = (f32x4){0.f, 0.f, 0.f, 0.f};
        cur = nxt; cA = nA; cB = nB; ++ui;
        if constexpr (Prob::GATHER) {
#pragma unroll
            for (int i = 0; i < 2; ++i) { cO0[i] = nO0[i]; cO1[i] = nO1[i]; } }
        if (wr == 1) PG8_BAR;
    }
    PG8_WAIT_V(0);
    PG8_BAR;
#undef PG8_AOFF
#undef PG8_AOFF_LDS
#undef PG8_SA
#undef PG8_SB
#undef PG8_STAGE
#undef PG8_LDA
#undef PG8_LD8
#undef PG8_LO
#undef PG8_HI
#undef PG8_LDB
#undef PG8_MMA
#undef PG8_WAIT_V
#undef PG8_WAIT_L
#undef PG8_BAR
#undef PG8_SCHED
}
}
using pg8::Unit;

struct Args { const float* in[28]; float* out; unsigned char* ws; int ph_lo, ph_hi; };
struct Frame {
    LAS unsigned char* lds;
    volatile LAS unsigned* MISC;
    unsigned* ctl;
    int tid, lane, wave, vcu, G;
    const Args* A;
    __device__ __forceinline__ bf16_t* Win_t() const { return (bf16_t*)(A->ws + WS_WIN); }
    __device__ __forceinline__ bf16_t* Wk_t() const { return (bf16_t*)(A->ws + WS_WK); }
    __device__ __forceinline__ bf16_t* Wv_t() const { return (bf16_t*)(A->ws + WS_WV); }
    __device__ __forceinline__ bf16_t* Wpab_t() const { return (bf16_t*)(A->ws + WS_WPAB); }
    __device__ __forceinline__ bf16_t* Wmo_t() const { return (bf16_t*)(A->ws + WS_WMO); }
    __device__ __forceinline__ bf16_t* Wq_t() const { return (bf16_t*)(A->ws + WS_WQ); }
    __device__ __forceinline__ bf16_t* Wo_t() const { return (bf16_t*)(A->ws + WS_WO); }
    __device__ __forceinline__ bf16_t* Wr_t() const { return (bf16_t*)(A->ws + WS_WR); }
    __device__ __forceinline__ bf16_t* W1_t() const { return (bf16_t*)(A->ws + WS_W1); }
    __device__ __forceinline__ bf16_t* W2_t() const { return (bf16_t*)(A->ws + WS_W2); }
    __device__ __forceinline__ bf16_t* sguw() const { return (bf16_t*)(A->ws + WS_SGUW); }
    __device__ __forceinline__ bf16_t* h() const { return (bf16_t*)(A->ws + WS_H); }
    __device__ __forceinline__ bf16_t* memn() const { return (bf16_t*)(A->ws + WS_MEMN); }
    __device__ __forceinline__ bf16_t* kmem() const { return (bf16_t*)(A->ws + WS_KMEM); }
    __device__ __forceinline__ bf16_t* vt() const { return (bf16_t*)(A->ws + WS_VT); }
    __device__ __forceinline__ bf16_t* qin() const { return (bf16_t*)(A->ws + WS_QIN); }
    __device__ __forceinline__ bf16_t* oab() const { return (bf16_t*)(A->ws + WS_OAB); }
    __device__ __forceinline__ bf16_t* mix() const { return (bf16_t*)(A->ws + WS_MIX); }
    __device__ __forceinline__ bf16_t* x1b() const { return (bf16_t*)(A->ws + WS_X1B); }
    __device__ __forceinline__ bf16_t* q() const { return (bf16_t*)(A->ws + WS_Q); }
    __device__ __forceinline__ bf16_t* ao() const { return (bf16_t*)(A->ws + WS_AO); }
    __device__ __forceinline__ bf16_t* x2b() const { return (bf16_t*)(A->ws + WS_X2B); }
    __device__ __forceinline__ bf16_t* p() const { return (bf16_t*)(A->ws + WS_P); }
    __device__ __forceinline__ bf16_t* act() const { return (bf16_t*)(A->ws + WS_ACT); }
    __device__ __forceinline__ bf16_t* yb() const { return (bf16_t*)(A->ws + WS_YB); }
    __device__ __forceinline__ bf16_t* ointra() const { return (bf16_t*)(A->ws + WS_OINTRA); }
    __device__ __forceinline__ bf16_t* kvT() const { return (bf16_t*)(A->ws + WS_KVT); }
    __device__ __forceinline__ float* decay() const { return (float*)(A->ws + WS_DECAY); }
    __device__ __forceinline__ float* ssq1() const { return (float*)(A->ws + WS_SSQ1); }
    __device__ __forceinline__ float* ssq2() const { return (float*)(A->ws + WS_SSQ2); }
    __device__ __forceinline__ float* lscale() const { return (float*)(A->ws + WS_LSCALE); }
    __device__ __forceinline__ float* gates() const { return (float*)(A->ws + WS_GATES); }
    __device__ __forceinline__ int* list() const { return (int*)(A->ws + WS_LIST); }
    __device__ __forceinline__ bf16_t* spT() const { return (bf16_t*)(A->ws + WS_SPT); }
    __device__ __forceinline__ unsigned char* x2q() const { return (unsigned char*)(A->ws + WS_X2Q); }
    __device__ __forceinline__ unsigned char* x1q() const { return (unsigned char*)(A->ws + WS_X1Q); }
    __device__ __forceinline__ unsigned char* hq() const { return (unsigned char*)(A->ws + WS_HQ); }
    __device__ __forceinline__ unsigned char* winq() const { return (unsigned char*)(A->ws + WS_WINQ); }
};
enum { I_X = 0, I_MEM, I_NMIXG, I_WIN, I_WA2, I_BA, I_GOUTG, I_SNG, I_SNB, I_SW, I_SB, I_WPA, I_WPB, I_WMO, I_NXG, I_NMEMG, I_WXQ, I_WXK, I_WXV, I_WXO, I_NFFNG, I_WR, I_BR, I_WE1, I_BE1, I_WE2, I_BE2, I_NFING };

struct CvtItem { const float* src; size_t ldw; unsigned char* dst; const float* kscale; float mul; int fp8; };
__device__ __forceinline__ void cvt_load(const CvtItem& c, float (&v)[64]) {
#pragma unroll
    for (int i = 0; i < 64; ++i) v[i] = __builtin_nontemporal_load(c.src + (size_t)i * c.ldw);
}
__device__ __forceinline__ void cvt_finish(const CvtItem& c, float (&v)[64]) {
    if (c.kscale) {
#pragma unroll
        for (int i = 0; i < 64; ++i) v[i] *= c.kscale[i] * c.mul; }
    else {
#pragma unroll
        for (int i = 0; i < 64; ++i) v[i] *= c.mul; }
    if (c.fp8) {
#pragma unroll
        for (int q = 0; q < 4; ++q) { const float f0[8] = {v[16 * q], v[16 * q + 1], v[16 * q + 2], v[16 * q + 3], v[16 * q + 4], v[16 * q + 5], v[16 * q + 6], v[16 * q + 7]};
            const float f1[8] = {v[16 * q + 8], v[16 * q + 9], v[16 * q + 10], v[16 * q + 11], v[16 * q + 12], v[16 * q + 13], v[16 * q + 14], v[16 * q + 15]};
            const u32x2 lo = pack8_fp8(f0), hi = pack8_fp8(f1); *(u32x4*)(c.dst + 16 * q) = (u32x4){lo.x, lo.y, hi.x, hi.y}; } }
    else {
#pragma unroll
        for (int q = 0; q < 8; ++q) { const float f[8] = {v[8 * q], v[8 * q + 1], v[8 * q + 2], v[8 * q + 3], v[8 * q + 4], v[8 * q + 5], v[8 * q + 6], v[8 * q + 7]}; *(u32x4*)(c.dst + 16 * q) = pack8(f); } }
}
__device__ __forceinline__ CvtItem cvt_desc(const float* W, int ldw, int src_col0, int k0, void* WT, int ldt, int dst_row0, int dst_k0, const float* kscale, float mul, int fp8, int lane) {
    CvtItem c; const int eb = fp8 ? 1 : 2;
    c.src = W + (size_t)k0 * ldw + src_col0 + lane; c.ldw = (size_t)ldw; c.dst = (unsigned char*)WT + ((size_t)(dst_row0 + lane) * ldt + dst_k0 + k0) * eb;
    c.kscale = kscale ? kscale + k0 : nullptr; c.mul = mul; c.fp8 = fp8; return c;
}
__device__ __forceinline__ void cvt_expert128(Frame& F) {
    const int gw = F.vcu * 8 + F.wave, NGW = F.G * 8, lane = F.lane;
    constexpr int I1 = NE * 8 * 32, I2 = NE * 8 * 16;
    for (int it = gw; it < I1 + I2; it += NGW) {
        const float* src; size_t ldw; unsigned char* dst; const float* ks; (void)ks;
        if (it < I1) { const int e = it >> 8, q = it & 255, kb = q >> 5, nb = q & 31, nd = nb * 64; const int sc = ((nd & 128) ? 1024 : 0) + 128 * (nd >> 8) + (nd & 127);
            src = F.A->in[I_WE1] + (size_t)e * D * 2048 + (size_t)(kb * 128) * 2048 + sc + lane; ldw = 2048;
            dst = (unsigned char*)F.W1_t() + (size_t)e * 2048 * D + (size_t)(nd + lane) * D + kb * 128; ks = nullptr; }
        else { const int r = it - I1, e = r >> 7, q = r & 127, kb = q >> 4, nb = q & 15;
            src = F.A->in[I_WE2] + (size_t)e * D * D + (size_t)(kb * 128) * D + nb * 64 + lane; ldw = D;
            dst = (unsigned char*)F.W2_t() + (size_t)e * D * D + (size_t)(nb * 64 + lane) * D + kb * 128; ks = nullptr; }
        float v[128]; const float* pp = src;
#pragma unroll
        for (int i = 0; i < 128; ++i) { v[i] = __builtin_nontemporal_load(pp); pp += ldw; asm volatile("" : "+v"(pp)); }
#pragma unroll
        for (int i = 0; i < 128; ++i) v[i] *= FP8_WMUL;
#pragma unroll
        for (int q = 0; q < 8; ++q) { const float f0[8] = {v[16 * q], v[16 * q + 1], v[16 * q + 2], v[16 * q + 3], v[16 * q + 4], v[16 * q + 5], v[16 * q + 6], v[16 * q + 7]};
            const float f1[8] = {v[16 * q + 8], v[16 * q + 9], v[16 * q + 10], v[16 * q + 11], v[16 * q + 12], v[16 * q + 13], v[16 * q + 14], v[16 * q + 15]};
            const u32x2 lo = pack8_fp8(f0), hi = pack8_fp8(f1); *(u32x4*)(dst + 16 * q) = (u32x4){lo.x, lo.y, hi.x, hi.y}; }
    }
}
constexpr int CVT_SLOT = 16 * 1040, CVT_I1 = NE * 8 * 64, CVT_I2 = NE * 8 * 32, CVT_TAIL = CVT_I2 * 3 / 8;
struct CvtDma { const float* src; unsigned ldw; unsigned char* dst; };
__device__ __forceinline__ CvtDma cvt_dma_desc(const Frame& F, int it) {
    constexpr int I1 = NE * 8 * 64; CvtDma c;
    if (it < I1) { const int e = it >> 9, q = it & 511, kb = q >> 6, nb = q & 63, nd = nb * 32; const int sc = ((nd & 128) ? 1024 : 0) + 128 * (nd >> 8) + (nd & 127);
        c.src = F.A->in[I_WE1] + (size_t)e * D * 2048 + (size_t)(kb * 128) * 2048 + sc; c.ldw = 2048;
        c.dst = (unsigned char*)F.W1_t() + (size_t)e * 2048 * D + (size_t)(nd >> 8) * (256 * D) + (size_t)kb * (256 * 128) + (nd & 255) * 128; }
    else { const int r = it - I1, e = r >> 8, q = r & 255, kb = q >> 5, nb = q & 31;
        c.src = F.A->in[I_WE2] + (size_t)e * D * D + (size_t)(kb * 128) * D + nb * 32; c.ldw = D;
        c.dst = (unsigned char*)F.W2_t() + (size_t)e * D * D + (size_t)((nb * 32) >> 8) * (256 * D) + (size_t)kb * (256 * 128) + ((nb * 32) & 255) * 128; }
    return c;
}
__device__ __forceinline__ void cvt_dma_issue(const CvtDma& c, LAS unsigned char* slot, int lane) {
    const float* p = c.src + (size_t)(lane >> 3) * c.ldw + (lane & 7) * 4;
#pragma unroll
    for (int i = 0; i < 16; ++i) { __builtin_amdgcn_global_load_lds((const unsigned*)p, (LAS unsigned*)(slot + i * 1040), 16, 0, 2); p += (size_t)8 * c.ldw; }
}
__device__ __forceinline__ void cvt_expert_dma(Frame& F, int ibeg, int iend, int part, int nparts) {
    if (F.wave < 4) return;
    const int cw = ibeg + part * 4 + (F.wave - 4), NCW = nparts * 4, lane = F.lane;
    const int ITEMS = iend;
    const int n = cw < ITEMS ? (ITEMS - cw + NCW - 1) / NCW : 0;
    LAS unsigned char* slot0 = F.lds + (F.wave - 4) * (2 * CVT_SLOT);
    const int rdo = (lane & 7) * 2080 + (lane >> 3) * 4;
    CvtDma d0 = cvt_dma_desc(F, n > 0 ? cw : 0), d1 = cvt_dma_desc(F, n > 1 ? cw + NCW : 0);
    if (n > 0) cvt_dma_issue(d0, slot0, lane);
    if (n > 1) cvt_dma_issue(d1, slot0 + CVT_SLOT, lane);
    for (int j = 0; j < n; ++j) {
        if (j + 1 >= n) asm volatile("s_waitcnt vmcnt(0)" ::: "memory");
        else if (j == 0) asm volatile("s_waitcnt vmcnt(16)" ::: "memory");
        else asm volatile("s_waitcnt vmcnt(20)" ::: "memory");
        LAS unsigned char* slot = slot0 + (j & 1) * CVT_SLOT;
        const LAS unsigned char* rd = slot + rdo;
        float v[4][16];
        const unsigned rda = (unsigned)(size_t)rd;
#pragma unroll
        for (int q = 0; q < 4; ++q)
#pragma unroll
            for (int jj = 0; jj < 16; ++jj) asm volatile("ds_read_b32 %0, %1 offset:%2" : "=v"(v[q][jj]) : "v"(rda), "n"(q * 32 + (jj >> 3) * 1040 + (jj & 7) * 128));
        asm volatile("s_waitcnt lgkmcnt(0)" ::: "memory");
#pragma unroll
        for (int q = 0; q < 4; ++q) asm volatile("" : "+v"(v[q][0]), "+v"(v[q][1]), "+v"(v[q][2]), "+v"(v[q][3]), "+v"(v[q][4]), "+v"(v[q][5]), "+v"(v[q][6]), "+v"(v[q][7]),
                                                     "+v"(v[q][8]), "+v"(v[q][9]), "+v"(v[q][10]), "+v"(v[q][11]), "+v"(v[q][12]), "+v"(v[q][13]), "+v"(v[q][14]), "+v"(v[q][15]));
        unsigned char* dst = d0.dst + (size_t)(lane >> 3) * 128 + (lane & 7) * 16;
        d0 = d1;
        if (j + 2 < n) { d1 = cvt_dma_desc(F, cw + (j + 2) * NCW); cvt_dma_issue(d1, slot, lane); }
#pragma unroll
        for (int q = 0; q < 4; ++q) {
            float f0[8], f1[8];
#pragma unroll
            for (int jj = 0; jj < 8; ++jj) { f0[jj] = v[q][jj] * FP8_WMUL; f1[jj] = v[q][8 + jj] * FP8_WMUL; }
            const u32x2 lo = pack8_fp8(f0), hi = pack8_fp8(f1);
            *(u32x4*)(dst + (size_t)(8 * q) * 128) = (u32x4){lo.x, lo.y, hi.x, hi.y}; }
    }
    asm volatile("s_waitcnt vmcnt(0)" ::: "memory");
}
template <bool Q8, bool BOTH = false>
__device__ __forceinline__ void rms_row_to_bf16(const float* xrow, const float* g, bf16_t* orow, int lane, unsigned char* qrow = nullptr) {
    f32x4 v[4]; float s = 0.f;
#pragma unroll
    for (int j = 0; j < 4; ++j) { v[j] = __builtin_nontemporal_load((const f32x4*)(xrow + 256 * j + 4 * lane)); s += (v[j].x * v[j].x + v[j].y * v[j].y) + (v[j].z * v[j].z + v[j].w * v[j].w); }
    const float rs = rsqrtf(wave_sum(s) * (1.f / D) + EPS);
#pragma unroll
    for (int j = 0; j < 4; ++j) { const f32x4 gg = *(const f32x4*)(g + 256 * j + 4 * lane);
        if constexpr (Q8) { int w = 0; w = __builtin_amdgcn_cvt_pk_fp8_f32(v[j].x * rs * gg.x, v[j].y * rs * gg.y, w, false); w = __builtin_amdgcn_cvt_pk_fp8_f32(v[j].z * rs * gg.z, v[j].w * rs * gg.w, w, true);
            *(int*)((unsigned char*)orow + 256 * j + 4 * lane) = w; }
        else { u32x2 o; o.x = cvt_pk_bf16(v[j].x * rs * gg.x, v[j].y * rs * gg.y); o.y = cvt_pk_bf16(v[j].z * rs * gg.z, v[j].w * rs * gg.w);
            *(u32x2*)(orow + 256 * j + 4 * lane) = o; }
        if constexpr (BOTH) { int w = 0; w = __builtin_amdgcn_cvt_pk_fp8_f32(v[j].x * rs * gg.x, v[j].y * rs * gg.y, w, false); w = __builtin_amdgcn_cvt_pk_fp8_f32(v[j].z * rs * gg.z, v[j].w * rs * gg.w, w, true);
            *(int*)(qrow + 256 * j + 4 * lane) = w; } }
}
struct CvtNoMid { __device__ __forceinline__ void operator()() const {} };
template <class Mid = CvtNoMid>
__device__ __forceinline__ void cvt_range(Frame& F, int ibeg, int iend, int wlo = 0, Mid mid = Mid()) {
    if (F.wave < wlo) { mid(); return; }
    const int gw = F.vcu * (8 - wlo) + (F.wave - wlo), NGW = F.G * (8 - wlo), lane = F.lane;
    constexpr int N_WIN = 16 * 72, N_SQ = 256, N_PA = 8 * 16, N_E1 = 512, N_E2 = 256;
    constexpr int S_WIN = 0, S_WK = S_WIN + N_WIN, S_WV = S_WK + N_SQ, S_PA = S_WV + N_SQ, S_PB = S_PA + N_PA, S_MO = S_PB + N_PA, S_Q = S_MO + N_SQ, S_O = S_Q + N_SQ, S_E1 = S_O + N_SQ, S_E2 = S_E1 + NE * N_E1, S_END = S_E2 + NE * N_E2;
    static_assert(S_E1 == 16 * 72 + 256 * 2 + 8 * 16 * 2 + 256 * 3 && S_END == S_E1 + NE * 512 + NE * 256, "item ranges");
    const int IEND = iend < S_END ? iend : S_END;
    auto desc = [&](int it) -> CvtItem {
        if (P1_GATES_FP8 && it < S_WK && (it - S_WIN) % 72 >= PC_GA / 64) { const int r = it - S_WIN, kb = r / 72, n0 = (r % 72) * 64; return cvt_desc(F.A->in[I_WIN], INC, n0 + 16, kb * 64, F.winq(), D, n0 - PC_GA, 0, nullptr, FP8_WMUL, 1, lane); }
        if (it < S_WK) { const int r = it - S_WIN, kb = r / 72, nb = r % 72, n0 = nb * 64; return cvt_desc(F.A->in[I_WIN], INC, n0 < 1536 ? n0 : n0 + 16, kb * 64, F.Win_t(), D, n0, 0, nullptr, P1_FP8 ? FP8_WMUL : 1.f, P1_FP8, lane); }
        if (it < S_WV) { const int r = it - S_WK; return cvt_desc(F.A->in[I_WXK], D, (r & 15) * 64, (r >> 4) * 64, F.Wk_t(), D, (r & 15) * 64, 0, nullptr, P1_FP8 ? FP8_WMUL : 1.f, P1_FP8, lane); }
        if (it < S_PA) { const int r = it - S_WV; return cvt_desc(F.A->in[I_WXV], D, (r & 15) * 64, (r >> 4) * 64, F.Wv_t(), D, (r & 15) * 64, 0, nullptr, P1_FP8 ? FP8_WMUL : 1.f, P1_FP8, lane); }
        if (it < S_PB) { const int r = it - S_PA; return cvt_desc(F.A->in[I_WPA], D, (r & 15) * 64, (r >> 4) * 64, F.Wpab_t(), D, (r & 15) * 64, 0, nullptr, 1.f, 0, lane); }
        if (it < S_MO) { const int r = it - S_PB; return cvt_desc(F.A->in[I_WPB], D, (r & 15) * 64, (r >> 4) * 64, F.Wpab_t(), D, (r & 15) * 64, 512, nullptr, 1.f, 0, lane); }
        if (it < S_Q)  { const int r = it - S_MO; return cvt_desc(F.A->in[I_WMO], D, (r & 15) * 64, (r >> 4) * 64, F.Wmo_t(), D, (r & 15) * 64, 0, nullptr, 1.f, 0, lane); }
        if (it < S_O)  { const int r = it - S_Q;  return cvt_desc(F.A->in[I_WXQ], D, (r & 15) * 64, (r >> 4) * 64, F.Wq_t(), D, (r & 15) * 64, 0, F.A->in[I_NXG], FP8_WMUL, 1, lane); }
        if (it < S_E1) { const int r = it - S_O;  return cvt_desc(F.A->in[I_WXO], D, (r & 15) * 64, (r >> 4) * 64, F.Wo_t(), D, (r & 15) * 64, 0, nullptr, FP8_WMUL, 1, lane); }
        if (it < S_E2) { const int r = it - S_E1, e = r / N_E1, q = r % N_E1, kb = q >> 5, nb = q & 31, nd = nb * 64;
            const int src = ((nd & 128) ? 1024 : 0) + 128 * (nd >> 8) + (nd & 127);
            return cvt_desc(F.A->in[I_WE1] + (size_t)e * D * 2048, 2048, src, kb * 64, (unsigned char*)F.W1_t() + (size_t)e * 2048 * D, D, nd, 0, F.A->in[I_NFFNG], FP8_WMUL, 1, lane); }
        const int r = it - S_E2, e = r / N_E2, q = r % N_E2;
        return cvt_desc(F.A->in[I_WE2] + (size_t)e * D * D, D, (q & 15) * 64, (q >> 4) * 64, (unsigned char*)F.W2_t() + (size_t)e * D * D, D, (q & 15) * 64, 0, nullptr, FP8_WMUL, 1, lane); };
    const bool has = ibeg + gw < IEND;
    float va[64], vb[64]; CvtItem ca = desc(has ? ibeg + gw : ibeg), cb = ca;
    if (has) cvt_load(ca, va);
    mid();
    if (has) {
        for (int it = ibeg + gw;;) {
            const bool hb = it + NGW < IEND; if (hb) { cb = desc(it + NGW); cvt_load(cb, vb); }
            cvt_finish(ca, va); if (!hb) break;
            const bool ha = it + 2 * NGW < IEND; if (ha) { ca = desc(it + 2 * NGW); cvt_load(ca, va); }
            cvt_finish(cb, vb); if (!ha) break;
            it += 2 * NGW; }
    }
}
constexpr int CVT_LATE = 16 * 72 + 256 * 2, CVT_EXPERT = 16 * 72 + 256 * 2 + 8 * 16 * 2 + 256 * 3, CVT_END = CVT_EXPERT + NE * 512 + NE * 256;
__device__ __forceinline__ void p0_prologue(Frame& F) {
    const int gw = F.vcu * 8 + F.wave, NGW = F.G * 8, lane = F.lane;
    auto rows = [&]() {
    { const f32x4 g0 = *(const f32x4*)(F.A->in[I_NMIXG] + 4 * lane), g1 = *(const f32x4*)(F.A->in[I_NMIXG] + 256 + 4 * lane), g2 = *(const f32x4*)(F.A->in[I_NMIXG] + 512 + 4 * lane), g3 = *(const f32x4*)(F.A->in[I_NMIXG] + 768 + 4 * lane);
      f32x4 va[2][4], vb[2][4];
      auto ld = [&](int m0, f32x4 (&v)[2][4]) {
#pragma unroll
          for (int r = 0; r < 2; ++r) { const int m = min(m0 + r * NGW, T - 1);
#pragma unroll
              for (int j = 0; j < 4; ++j) v[r][j] = __builtin_nontemporal_load((const f32x4*)(F.A->in[I_X] + (size_t)m * D + 256 * j + 4 * lane)); } };
      auto fin = [&](int m0, const f32x4 (&v)[2][4]) {
#pragma unroll
          for (int r = 0; r < 2; ++r) { const int m = m0 + r * NGW; float sq = 0.f;
#pragma unroll
              for (int j = 0; j < 4; ++j) sq += (v[r][j].x * v[r][j].x + v[r][j].y * v[r][j].y) + (v[r][j].z * v[r][j].z + v[r][j].w * v[r][j].w);
              const float rs = rsqrtf(wave_sum(sq) * (1.f / D) + EPS);
              if (m < T) { bf16_t* orow = F.h() + (size_t)m * D; unsigned char* qrow = F.hq() + (size_t)m * D;
#pragma unroll
                  for (int j = 0; j < 4; ++j) { const f32x4 gg = j == 0 ? g0 : (j == 1 ? g1 : (j == 2 ? g2 : g3));
                      const float y0 = v[r][j].x * rs * gg.x, y1 = v[r][j].y * rs * gg.y, y2 = v[r][j].z * rs * gg.z, y3 = v[r][j].w * rs * gg.w;
                      u32x2 o; o.x = cvt_pk_bf16(y0, y1); o.y = cvt_pk_bf16(y2, y3); *(u32x2*)(orow + 256 * j + 4 * lane) = o;
                      if (P1_GATES_FP8) { int w = 0; w = __builtin_amdgcn_cvt_pk_fp8_f32(y0, y1, w, false); w = __builtin_amdgcn_cvt_pk_fp8_f32(y2, y3, w, true); *(int*)(qrow + 256 * j + 4 * lane) = w; } } } } };
      if (gw < T) { ld(gw, va);
          for (int m0 = gw;;) {
              const bool hb = m0 + 2 * NGW < T; if (hb) ld(m0 + 2 * NGW, vb);
              fin(m0, va); if (!hb) break;
              const bool ha = m0 + 4 * NGW < T; if (ha) ld(m0 + 4 * NGW, va);
              fin(m0 + 2 * NGW, vb); if (!ha) break;
              m0 += 4 * NGW; } } }
    };
    cvt_range(F, 0, CVT_LATE, 0, rows);
    for (int m = gw; m < TM; m += NGW) rms_row_to_bf16<P1_FP8 != 0>(F.A->in[I_MEM] + (size_t)m * D, F.A->in[I_NMEMG], (bf16_t*)((unsigned char*)F.memn() + (size_t)m * D * (P1_FP8 ? 1 : 2)), lane);
    const int gt = F.vcu * 512 + F.tid, NGT = F.G * 512;
    for (int i = gt; i < 256 * D; i += NGT) { const int j = i >> 10, k = i & 1023; const float* wr_ = F.A->in[I_WIN] + (size_t)k * INC + OFF_A; float s = 0.f;
#pragma unroll
        for (int r = 0; r < 16; ++r) s += wr_[r] * F.A->in[I_WA2][r * 256 + j];
        if (P1_FP8) { int w = __builtin_amdgcn_cvt_pk_fp8_f32(s * FP8_WMUL, 0.f, 0, false); ((unsigned char*)F.Win_t())[(size_t)(PC_A + j) * D + k] = (unsigned char)(w & 0xff); }
        else F.Win_t()[(size_t)(PC_A + j) * D + k] = f2bf(s); }
    for (int i = gt; i < NE * D; i += NGT) { const int e = i >> 10, k = i & 1023; F.Wr_t()[i] = f2bf(F.A->in[I_WR][k * NE + e] * F.A->in[I_NFFNG][k]); }
    for (int i = gt; i < 4 * 128 * 128; i += NGT) { const int t = (i >> 7) & 127, s = i & 127; F.sguw()[i] = f2bf(s <= t ? F.A->in[I_SW][i] : 0.f); }
}

struct ProbP1 {
    static constexpr bool GATHER = false, FP8 = (P1_FP8 != 0); static constexpr int EB = P1_FP8 ? 1 : 2, WSCALE = FP8_WSCALE;
    int K, lda, ldb, G, c; const unsigned char* ws;
    __device__ __forceinline__ bool next(int i, Unit& u) const {
        const int L = i * G + c;
#if P1_GATES_FP8
        if (L < 704) { u.aux = 0; int pn; pg8::map_tile(L, 64, 11, u.pm, pn); u.pn = pn < 10 ? pn : 18; return true; }
        if (L < 736) { u.aux = 1; u.pm = (L - 704) >> 2; u.pn = (L - 704) & 3; return true; }
        if (L < 768) { u.aux = 2; u.pm = (L - 736) >> 3; u.pn = (L - 736) & 7; return true; }
#else
        if (L < 1216) { u.aux = 0; pg8::map_tile(L, 64, 19, u.pm, u.pn); return true; }
        if (L < 1248) { u.aux = 1; u.pm = (L - 1216) >> 2; u.pn = (L - 1216) & 3; return true; }
        if (L < 1280) { u.aux = 2; u.pm = (L - 1248) >> 3; u.pn = (L - 1248) & 7; return true; }
#endif
        return false;
    }
    __device__ __forceinline__ const char* a_base(const Unit& u) const { const size_t o = u.aux == 0 ? WS_H : (u.aux == 1 ? WS_MEMN : WS_WV); return (const char*)(ws + o + (size_t)u.pm * 256 * D * EB); }
    __device__ __forceinline__ const char* b_base(const Unit& u) const { const size_t o = u.aux == 0 ? WS_WIN : (u.aux == 1 ? WS_WK : WS_MEMN); return (const char*)(ws + o + (size_t)u.pn * 256 * D * EB); }
    __device__ __forceinline__ unsigned a_off(const Unit&, int row, int C) const { return (unsigned)(row * D * EB + C * 2); }
};
struct ProbP1Q {
    static constexpr bool GATHER = false, FP8 = true; static constexpr int WSCALE = FP8_WSCALE;
    int K, lda, ldb, G, c; const unsigned char* ws;
    __device__ __forceinline__ bool next(int i, Unit& u) const { const int L = i * G + c; if (L >= 512) return false; int pn; pg8::map_tile(L, 64, 8, u.pm, pn); u.pn = 10 + pn; u.aux = 0; return true; }
    __device__ __forceinline__ const char* a_base(const Unit& u) const { return (const char*)(ws + WS_HQ + (size_t)u.pm * 256 * D); }
    __device__ __forceinline__ const char* b_base(const Unit& u) const { return (const char*)(ws + WS_WINQ + (size_t)(u.pn - 10) * 256 * D); }
    __device__ __forceinline__ unsigned a_off(const Unit&, int row, int C) const { return (unsigned)(row * D + C * 2); }
};
struct EpiP1 {
    static constexpr bool MID = false, STAGE = false; static constexpr int NSTORE = 0;
    unsigned char* ws;
    __device__ __forceinline__ void operator()(const f32x4 (&acc)[2][2][4][2], const Unit& u, int wr, int wc, int fr, int fq) const {
        asm volatile("" : "+v"(fr), "+v"(fq));
        const size_t oo = u.aux == 0 ? WS_P : (u.aux == 1 ? WS_KMEM : WS_VT);
        bf16_t* O = (bf16_t*)(ws + oo); const int ldc = u.aux == 0 ? PN : (u.aux == 1 ? D : TM);
        const int act = (u.aux == 0) ? ((u.pn >= 6 && u.pn < 10) ? 1 : ((u.pn >= 10 && u.pn < 18) ? 2 : 0)) : 0;
        const int row0 = u.pm * 256 + wr * 64 + fr, col0 = u.pn * 256 + wc * 32 + 8 * fq; const bool svstat = (u.aux == 0) && (u.pn == 8 || u.pn == 9);
#pragma unroll
        for (int ai = 0; ai < 2; ++ai)
#pragma unroll
            for (int m = 0; m < 4; ++m) { bf16_t* rowp = O + (size_t)(row0 + ai * 128 + m * 16) * ldc + col0; float s1 = 0.f, s2 = 0.f;
#pragma unroll
                for (int bj = 0; bj < 2; ++bj) { float v[8];
#pragma unroll
                    for (int j = 0; j < 4; ++j) { v[j] = acc[ai][bj][m][0][j]; v[4 + j] = acc[ai][bj][m][1][j]; }
                    if (act == 1) {
#pragma unroll
                        for (int j = 0; j < 8; j += 2) { const f32x2 o = gelu_pk((f32x2){v[j], v[j + 1]}); v[j] = o.x; v[j + 1] = o.y; }
#pragma unroll
                        for (int j = 0; j < 8; ++j) { s1 += v[j]; s2 += v[j] * v[j]; } }
                    else if (act == 2) {
#pragma unroll
                        for (int j = 0; j < 8; j += 2) { const f32x2 o = sigmoid_pk((f32x2){v[j], v[j + 1]}); v[j] = o.x; v[j + 1] = o.y; }
                        unsigned q[8];
#pragma unroll
                        for (int j = 0; j < 8; ++j) q[j] = (unsigned)fmaxf(v[j] * 255.f + 0.5f, 1.f);
                        const u32x2 o8 = {(q[0] | (q[1] << 8)) | ((q[2] | (q[3] << 8)) << 16), (q[4] | (q[5] << 8)) | ((q[6] | (q[7] << 8)) << 16)};
                        *(u32x2*)(ws + WS_G8 + (size_t)(row0 + ai * 128 + m * 16) * 2048 + (u.pn - 10) * 256 + wc * 32 + 8 * fq + bj * 128) = o8; continue; }
                    *(u32x4*)(rowp + bj * 128) = pack8(v); }
                if (svstat) {
                    s1 += __shfl_xor(s1, 16); s1 += __shfl_xor(s1, 32); s2 += __shfl_xor(s2, 16); s2 += __shfl_xor(s2, 32);
                    if (fq == 0) *(f32x2*)((float*)(ws + WS_SVS) + (size_t)(row0 + ai * 128 + m * 16) * 16 + (u.pn - 8) * 8 + wc * 2) = (f32x2){s1, s2}; } }
    }
};

__device__ __forceinline__ void gla_a_unit(Frame& F, int unit) {
    const int tid = F.tid, lane = F.lane, w = F.wave, fr = lane & 15, fq = lane >> 4;
    const int bh = unit >> 5, n = unit & 31, b = bh >> 2, h = bh & 3;
    const int t0 = b * SEQ + n * 64;
    LAS float* cum = (LAS float*)(F.lds); LAS float* tot = (LAS float*)(F.lds + 16640);
    LAS bf16_t* QIN = (LAS bf16_t*)(F.lds + 18688); LAS bf16_t* KIN = (LAS bf16_t*)(F.lds + 27904); LAS bf16_t* KOT = (LAS bf16_t*)(F.lds + 37120);
    LAS bf16_t* ATT = (LAS bf16_t*)(F.lds + 46336); LAS bf16_t* VT = (LAS bf16_t*)(F.lds + 55552);
    const int c = tid >> 3, d8 = (tid & 7) * 8;
    const u32x4 graw = *(const u32x4*)(F.p() + (size_t)(t0 + c) * PN + PC_A + h * 64 + d8);
    const u32x4 qraw = *(const u32x4*)(F.p() + (size_t)(t0 + c) * PN + PC_Q + h * 64 + d8), kraw = *(const u32x4*)(F.p() + (size_t)(t0 + c) * PN + PC_K + h * 64 + d8);
    const u32x4 vraw0 = *(const u32x4*)(F.p() + (size_t)(t0 + c) * PN + PC_V + h * 128 + (tid & 7) * 16), vraw1 = *(const u32x4*)(F.p() + (size_t)(t0 + c) * PN + PC_V + h * 128 + (tid & 7) * 16 + 8);
    {
        float g[8]; unpack8(graw, g);
        const f32x4 b0 = *(const f32x4*)(F.A->in[I_BA] + h * 64 + d8), b1 = *(const f32x4*)(F.A->in[I_BA] + h * 64 + d8 + 4);
        const float bb[8] = {b0.x, b0.y, b0.z, b0.w, b1.x, b1.y, b1.z, b1.w};
#pragma unroll
        for (int j = 0; j < 8; ++j) { const float x = g[j] + bb[j]; const float ls = fminf(x, 0.f) - __logf(1.f + __expf(-fabsf(x))); cum[c * 65 + d8 + j] = ls * 0.0625f; }
    }
    __syncthreads();
    { const int d = tid & 63, seg = tid >> 6; float run = 0.f;
#pragma unroll
        for (int i = 0; i < 8; ++i) { run += cum[(seg * 8 + i) * 65 + d]; cum[(seg * 8 + i) * 65 + d] = run; }
        tot[seg * 64 + d] = run; }
    __syncthreads();
    { const int d = tid & 63, seg = tid >> 6; float off = 0.f;
#pragma unroll
        for (int s = 0; s < 7; ++s) if (s < seg) off += tot[s * 64 + d];
#pragma unroll
        for (int i = 0; i < 8; ++i) cum[(seg * 8 + i) * 65 + d] += off; }
    __syncthreads();
    {
        float qv[8], kv[8], qi[8], ki[8];
        unpack8(qraw, qv);
        unpack8(kraw, kv);
#pragma unroll
        for (int j = 0; j < 8; ++j) { const float cm = cum[c * 65 + d8 + j], cl = cum[63 * 65 + d8 + j];
            qi[j] = qv[j] * 0.125f * __expf(cm); ki[j] = kv[j] * __expf(-cm);
            KOT[(d8 + j) * 72 + c] = f2bf(kv[j] * __expf(cl - cm));
            if (c == 63) F.decay()[unit * 64 + d8 + j] = __expf(cl); }
        const u32x4 qp = pack8(qi), kp = pack8(ki);
        *(LAS u32x4*)(QIN + c * 72 + d8) = qp; *(LAS u32x4*)(KIN + c * 72 + d8) = kp;
        *(u32x4*)(F.qin() + (size_t)(t0 + c) * 256 + h * 64 + d8) = qp;
        const int e16 = (tid & 7) * 16;
#pragma unroll
        for (int hh = 0; hh < 2; ++hh) { const u32x4 vv = hh ? vraw1 : vraw0;
            const unsigned ww[4] = {vv.x, vv.y, vv.z, vv.w};
#pragma unroll
            for (int j = 0; j < 4; ++j) { VT[(e16 + 8 * hh + 2 * j) * 72 + c] = (bf16_t)(ww[j] & 0xffffu); VT[(e16 + 8 * hh + 2 * j + 1) * 72 + c] = (bf16_t)(ww[j] >> 16); } }
    }
    __syncthreads();
    {
        const int mt = w >> 1;
        bf16x8 a[2];
#pragma unroll
        for (int ks = 0; ks < 2; ++ks) a[ks] = *(const LAS bf16x8*)(QIN + (16 * mt + fr) * 72 + 32 * ks + 8 * fq);
#pragma unroll
        for (int q = 0; q < 2; ++q) { const int nt = (w & 1) * 2 + q; f32x4 s = {0.f, 0.f, 0.f, 0.f};
#pragma unroll
            for (int ks = 0; ks < 2; ++ks) s = mma16(a[ks], *(const LAS bf16x8*)(KIN + (16 * nt + fr) * 72 + 32 * ks + 8 * fq), s);
#pragma unroll
            for (int r = 0; r < 4; ++r) { const int cc = 16 * mt + 4 * fq + r, ss = 16 * nt + fr; ATT[cc * 72 + ss] = f2bf(ss <= cc ? s[r] : 0.f); } }
    }
    __syncthreads();
    {
        const int mt = w >> 1, nt0 = (w & 1) * 4;
        bf16x8 aa[2], ak[2];
#pragma unroll
        for (int ks = 0; ks < 2; ++ks) { aa[ks] = *(const LAS bf16x8*)(ATT + (16 * mt + fr) * 72 + 32 * ks + 8 * fq); ak[ks] = *(const LAS bf16x8*)(KOT + (16 * mt + fr) * 72 + 32 * ks + 8 * fq); }
#pragma unroll
        for (int q = 0; q < 4; ++q) { const int nt = nt0 + q; f32x4 o = {0.f, 0.f, 0.f, 0.f}, kvv = {0.f, 0.f, 0.f, 0.f};
#pragma unroll
            for (int ks = 0; ks < 2; ++ks) { const bf16x8 bv = *(const LAS bf16x8*)(VT + (16 * nt + fr) * 72 + 32 * ks + 8 * fq); o = mma16(bv, aa[ks], o); kvv = mma16(ak[ks], bv, kvv); }
            *(u32x2*)(F.ointra() + (size_t)(t0 + 16 * mt + fr) * 512 + h * 128 + 16 * nt + 4 * fq) = (u32x2){cvt_pk_bf16(o[0], o[1]), cvt_pk_bf16(o[2], o[3])};
            *(u32x2*)(F.kvT() + ((size_t)unit * 128 + 16 * nt + fr) * 64 + 16 * mt + 4 * fq) = (u32x2){cvt_pk_bf16(kvv[0], kvv[1]), cvt_pk_bf16(kvv[2], kvv[3])}; }
    }
    __syncthreads();
}

__device__ __forceinline__ void gla_sscan_item(Frame& F, int item) {
    const int lane = F.lane, idx = item * 64 + lane, d4 = idx & 15, e = (idx >> 4) & 127, bh = idx >> 11;
    const bf16_t* kvp = F.kvT() + ((size_t)(bh * 32) * 128 + e) * 64 + d4 * 4; const float* dcp = F.decay() + (size_t)(bh * 32) * 64 + d4 * 4;
    bf16_t* sp = F.spT() + ((size_t)(bh * 32) * 128 + e) * 64 + d4 * 4;
    f32x4 S = {0.f, 0.f, 0.f, 0.f};
    u32x2 kwa[8], kwb[8]; f32x4 dca[8], dcb[8];
    auto ld = [&](int n0, u32x2 (&kw)[8], f32x4 (&dc)[8]) {
#pragma unroll
        for (int i = 0; i < 8; ++i) { kw[i] = *(const u32x2*)(kvp + (size_t)(n0 + i) * 128 * 64); dc[i] = *(const f32x4*)(dcp + (size_t)(n0 + i) * 64); } };
    auto run = [&](int n0, const u32x2 (&kw)[8], const f32x4 (&dc)[8]) {
#pragma unroll
        for (int i = 0; i < 8; ++i) { u32x2 o; o.x = cvt_pk_bf16(S.x, S.y); o.y = cvt_pk_bf16(S.z, S.w); *(u32x2*)(sp + (size_t)(n0 + i) * 128 * 64) = o;
            S = dc[i] * S + (f32x4){bflo(kw[i].x), bfhi(kw[i].x), bflo(kw[i].y), bfhi(kw[i].y)}; } };
    ld(0, kwa, dca); ld(8, kwb, dcb); run(0, kwa, dca); ld(16, kwa, dca); run(8, kwb, dcb); ld(24, kwb, dcb); run(16, kwa, dca); run(24, kwb, dcb);
}
struct SguIn { f32x4 sa, sb, sc, sd; u32x4 vv[4]; u32x2 uv[8]; };
__device__ __forceinline__ void sgu_load(Frame& F, int unit, SguIn& in) {
    const int tid = F.tid, w = F.wave, lane = F.lane, fr = lane & 15, fq = lane >> 4, ch = unit >> 2, g = unit & 3, t0 = ch * 128;
    const int s = tid >> 2, c32 = (tid & 3) * 32, t = 16 * w + fr;
    const float* sp = (const float*)(F.A->ws + WS_SVS) + (size_t)(t0 + s) * 16;
    in.sa = *(const f32x4*)sp; in.sb = *(const f32x4*)(sp + 4); in.sc = *(const f32x4*)(sp + 8); in.sd = *(const f32x4*)(sp + 12);
#pragma unroll
    for (int q = 0; q < 4; ++q) in.vv[q] = *(const u32x4*)(F.p() + (size_t)(t0 + s) * PN + PC_SV + g * 128 + c32 + 8 * q);
#pragma unroll
    for (int ct = 0; ct < 8; ++ct) in.uv[ct] = *(const u32x2*)(F.p() + (size_t)(t0 + t) * PN + PC_U + g * 128 + 16 * ct + 4 * fq);
}
__device__ __forceinline__ void sgu_units(Frame& F) {
    const int tid = F.tid, w = F.wave, lane = F.lane, fr = lane & 15, fq = lane >> 4;
    LAS bf16_t* vnT = (LAS bf16_t*)(F.lds + 1024);
    const int s = tid >> 2, c32 = (tid & 3) * 32, t = 16 * w + fr;
    if (F.vcu >= 512) return;
    SguIn cur; sgu_load(F, F.vcu, cur);
    int gl = -1; f32x4 gn[4][2], bn[4][2]; bf16x8 bw[4]; float bias = 0.f;
    for (int unit = F.vcu; unit < 512; unit += F.G) {
        const int ch = unit >> 2, g = unit & 3, t0 = ch * 128;
        if (g != gl) { gl = g;
#pragma unroll
            for (int q = 0; q < 4; ++q) { gn[q][0] = *(const f32x4*)(F.A->in[I_SNG] + g * 128 + c32 + 8 * q); gn[q][1] = *(const f32x4*)(F.A->in[I_SNG] + g * 128 + c32 + 8 * q + 4);
                bn[q][0] = *(const f32x4*)(F.A->in[I_SNB] + g * 128 + c32 + 8 * q); bn[q][1] = *(const f32x4*)(F.A->in[I_SNB] + g * 128 + c32 + 8 * q + 4); }
#pragma unroll
            for (int ks = 0; ks < 4; ++ks) bw[ks] = *(const bf16x8*)(F.sguw() + (size_t)(g * 128 + 16 * w + fr) * 128 + 32 * ks + 8 * fq);
            bias = F.A->in[I_SB][g * 128 + t]; }
        SguIn nxt; const bool hn = unit + F.G < 512; sgu_load(F, hn ? unit + F.G : unit, nxt);
        {   const float s1 = (cur.sa.x + cur.sa.z) + (cur.sb.x + cur.sb.z) + (cur.sc.x + cur.sc.z) + (cur.sd.x + cur.sd.z), s2 = (cur.sa.y + cur.sa.w) + (cur.sb.y + cur.sb.w) + (cur.sc.y + cur.sc.w) + (cur.sd.y + cur.sd.w);
            const float mean = s1 * (1.f / 512.f), var = fmaxf(s2 * (1.f / 512.f) - mean * mean, 0.f), rstd = rsqrtf(var + EPS);
#pragma unroll
            for (int q = 0; q < 4; ++q) { float v[8]; unpack8(cur.vv[q], v);
                const float gg[8] = {gn[q][0].x, gn[q][0].y, gn[q][0].z, gn[q][0].w, gn[q][1].x, gn[q][1].y, gn[q][1].z, gn[q][1].w}, bb[8] = {bn[q][0].x, bn[q][0].y, bn[q][0].z, bn[q][0].w, bn[q][1].x, bn[q][1].y, bn[q][1].z, bn[q][1].w};
#pragma unroll
                for (int j = 0; j < 8; ++j) vnT[(c32 + 8 * q + j) * 136 + s] = f2bf((v[j] - mean) * rstd * gg[j] + bb[j]); } }
        __syncthreads();
        f32x4 acc[8];
#pragma unroll
        for (int ct = 0; ct < 8; ++ct) acc[ct] = (f32x4){0.f, 0.f, 0.f, 0.f};
        const int nks = (16 * w + 15) / 32 + 1;
#pragma unroll
        for (int ks = 0; ks < 4; ++ks) if (ks < nks) {
#pragma unroll
            for (int ct = 0; ct < 8; ++ct) acc[ct] = mma16(*(const LAS bf16x8*)(vnT + (16 * ct + fr) * 136 + 32 * ks + 8 * fq), bw[ks], acc[ct]); }
        {
#pragma unroll
            for (int ct = 0; ct < 8; ++ct) { const int cidx = g * 128 + 16 * ct + 4 * fq; const u32x2 uu = cur.uv[ct];
                u32x2 o; o.x = cvt_pk_bf16(bflo(uu.x) * (acc[ct][0] + bias), bfhi(uu.x) * (acc[ct][1] + bias)); o.y = cvt_pk_bf16(bflo(uu.y) * (acc[ct][2] + bias), bfhi(uu.y) * (acc[ct][3] + bias));
                *(u32x2*)(F.oab() + (size_t)(t0 + t) * D + 512 + cidx) = o; } }
        __syncthreads();
        cur = nxt;
    }
}
__device__ __forceinline__ void gla_out_pair(Frame& F, int item0, int item1) {
    const int lane = F.lane, fr = lane & 15, fq = lane >> 4; const bool two = item1 >= 0; const int items[2] = {item0, two ? item1 : item0};
    size_t tt[2]; int hh[2]; const bf16_t* spp[2]; bf16x8 qf[2][2]; f32x4 o[2][8]; float rstd[2];
#pragma unroll
    for (int i = 0; i < 2; ++i) { const int unit = items[i] >> 2, mt = items[i] & 3, bh = unit >> 5, n = unit & 31, b = bh >> 2; hh[i] = bh & 3; tt[i] = (size_t)b * SEQ + n * 64 + 16 * mt + fr; spp[i] = F.spT() + (size_t)unit * 128 * 64;
#pragma unroll
        for (int ks = 0; ks < 2; ++ks) qf[i][ks] = *(const bf16x8*)(F.qin() + tt[i] * 256 + hh[i] * 64 + 32 * ks + 8 * fq);
#pragma unroll
        for (int et = 0; et < 8; ++et) { const u32x2 ow = *(const u32x2*)(F.ointra() + tt[i] * 512 + hh[i] * 128 + 16 * et + 4 * fq); o[i][et] = (f32x4){bflo(ow.x), bfhi(ow.x), bflo(ow.y), bfhi(ow.y)}; } }
    f32x4 gv[2][8]; u32x2 rv[2][8];
#pragma unroll
    for (int i = 0; i < 2; ++i)
#pragma unroll
        for (int et = 0; et < 8; ++et) { const int e = hh[i] * 128 + 16 * et + 4 * fq; gv[i][et] = *(const f32x4*)(F.A->in[I_GOUTG] + e); rv[i][et] = *(const u32x2*)(F.p() + tt[i] * PN + PC_R + e); }
#pragma unroll
    for (int i = 0; i < 2; ++i) { float ss = 0.f;
#pragma unroll
        for (int et = 0; et < 8; ++et) { f32x4 acc = o[i][et];
#pragma unroll
            for (int ks = 0; ks < 2; ++ks) acc = mma16(*(const bf16x8*)(spp[i] + (size_t)(16 * et + fr) * 64 + 32 * ks + 8 * fq), qf[i][ks], acc);
            o[i][et] = acc; ss += (acc[0] * acc[0] + acc[1] * acc[1]) + (acc[2] * acc[2] + acc[3] * acc[3]); }
        ss += __shfl_xor(ss, 16); ss += __shfl_xor(ss, 32);
        rstd[i] = rsqrtf(ss * (1.f / 128.f) + EPS); }
#pragma unroll
    for (int i = 0; i < 2; ++i) if (i == 0 || two) {
#pragma unroll
        for (int et = 0; et < 8; ++et) { const int e = hh[i] * 128 + 16 * et + 4 * fq; const f32x4 g = gv[i][et];
            const u32x2 rr = rv[i][et]; const float r0 = bflo(rr.x), r1 = bfhi(rr.x), r2 = bflo(rr.y), r3 = bfhi(rr.y);
            u32x2 ov; ov.x = cvt_pk_bf16(o[i][et][0] * rstd[i] * g.x * r0 * sigmoidf_(r0), o[i][et][1] * rstd[i] * g.y * r1 * sigmoidf_(r1));
            ov.y = cvt_pk_bf16(o[i][et][2] * rstd[i] * g.z * r2 * sigmoidf_(r2), o[i][et][3] * rstd[i] * g.w * r3 * sigmoidf_(r3));
            *(u32x2*)(F.oab() + tt[i] * D + e) = ov; } }
}

struct ProbSeg {
    static constexpr bool GATHER = false, FP8 = false; static constexpr int WSCALE = FP8_WSCALE;
    int K, lda, ldb, G, c; const bf16_t *oab, *Wpab_t;
    __device__ __forceinline__ bool next(int i, Unit& u) const { const int L = (i >> 1) * G + c; if (L >= 256) return false; pg8::map_tile(L, 64, 4, u.pm, u.pn); u.aux = i & 1; return true; }
    __device__ __forceinline__ const char* a_base(const Unit& u) const { return (const char*)(oab + (size_t)u.pm * 256 * D + u.aux * 512); }
    __device__ __forceinline__ const char* b_base(const Unit& u) const { return (const char*)(Wpab_t + (size_t)u.pn * 256 * D + u.aux * 512); }
    __device__ __forceinline__ unsigned a_off(const Unit&, int row, int C) const { return (unsigned)(row * D + C) * 2u; }
};
struct EpiMix {
    static constexpr bool MID = false, STAGE = false; static constexpr int NSTORE = 0;
    const bf16_t* p; bf16_t* mix;
    __device__ __forceinline__ void operator()(const f32x4 (&acc)[2][2][4][2], const Unit& u, int wr, int wc, int fr, int fq) const {
        asm volatile("" : "+v"(fr), "+v"(fq));
        const int row0 = u.pm * 256 + wr * 64 + fr, col0 = u.pn * 256 + wc * 32 + 8 * fq, gc = u.aux ? PC_GB : PC_GA;
#pragma unroll
        for (int ai = 0; ai < 2; ++ai) {
            u32x4 gw[4][2], pw[4][2];
#pragma unroll
            for (int m = 0; m < 4; ++m)
#pragma unroll
                for (int bj = 0; bj < 2; ++bj) { const size_t row = (size_t)(row0 + ai * 128 + m * 16);
                    gw[m][bj] = *(const u32x4*)(p + row * PN + gc + col0 + bj * 128);
                    pw[m][bj] = u.aux ? *(const u32x4*)(mix + row * D + col0 + bj * 128) : (u32x4){0u, 0u, 0u, 0u}; }
#pragma unroll
            for (int m = 0; m < 4; ++m)
#pragma unroll
                for (int bj = 0; bj < 2; ++bj) { const size_t row = (size_t)(row0 + ai * 128 + m * 16); float g[8], pv[8], v[8]; unpack8(gw[m][bj], g); unpack8(pw[m][bj], pv);
#pragma unroll
                    for (int j = 0; j < 4; ++j) { v[j] = acc[ai][bj][m][0][j] * g[j] + pv[j]; v[4 + j] = acc[ai][bj][m][1][j] * g[4 + j] + pv[4 + j]; }
                    *(u32x4*)(mix + row * D + col0 + bj * 128) = pack8(v); } }
    }
};

struct EpiMix2 {
    static constexpr bool MID = true, STAGE = false; static constexpr int NSTORE = 0;
    const unsigned char* g8; bf16_t* mix;
    static __device__ __forceinline__ void unpack_u8(const u32x2 w, float (&f)[8]) {
        f[0] = (float)(w.x & 255u); f[1] = (float)((w.x >> 8) & 255u); f[2] = (float)((w.x >> 16) & 255u); f[3] = (float)(w.x >> 24);
        f[4] = (float)(w.y & 255u); f[5] = (float)((w.y >> 8) & 255u); f[6] = (float)((w.y >> 16) & 255u); f[7] = (float)(w.y >> 24); }
    __device__ __forceinline__ void mid(f32x4 (&acc)[2][2][4][2], const Unit& u, int wr, int wc, int fr, int fq) const {
        asm volatile("" : "+v"(fr), "+v"(fq));
        const int row0 = u.pm * 256 + wr * 64 + fr, col0 = u.pn * 256 + wc * 32 + 8 * fq;
#pragma unroll
        for (int ai = 0; ai < 2; ++ai) { u32x2 ga[4][2], gb[4][2];
#pragma unroll
            for (int m = 0; m < 4; ++m)
#pragma unroll
                for (int bj = 0; bj < 2; ++bj) { const unsigned char* gp = g8 + (size_t)(row0 + ai * 128 + m * 16) * 2048 + col0 + bj * 128; ga[m][bj] = *(const u32x2*)gp; gb[m][bj] = *(const u32x2*)(gp + 1024); }
#pragma unroll
            for (int m = 0; m < 4; ++m)
#pragma unroll
                for (int bj = 0; bj < 2; ++bj) { float a[8], b[8]; unpack_u8(ga[m][bj], a); unpack_u8(gb[m][bj], b);
#pragma unroll
                    for (int j = 0; j < 4; ++j) { acc[ai][bj][m][0][j] *= a[j] * __builtin_amdgcn_rcpf(b[j]); acc[ai][bj][m][1][j] *= a[4 + j] * __builtin_amdgcn_rcpf(b[4 + j]); } } }
    }
    __device__ __forceinline__ void operator()(const f32x4 (&acc)[2][2][4][2], const Unit& u, int wr, int wc, int fr, int fq) const {
        asm volatile("" : "+v"(fr), "+v"(fq));
        const int row0 = u.pm * 256 + wr * 64 + fr, col0 = u.pn * 256 + wc * 32 + 8 * fq;
#pragma unroll
        for (int ai = 0; ai < 2; ++ai) { u32x2 gb[4][2];
#pragma unroll
            for (int m = 0; m < 4; ++m)
#pragma unroll
                for (int bj = 0; bj < 2; ++bj) gb[m][bj] = *(const u32x2*)(g8 + (size_t)(row0 + ai * 128 + m * 16) * 2048 + 1024 + col0 + bj * 128);
#pragma unroll
            for (int m = 0; m < 4; ++m)
#pragma unroll
                for (int bj = 0; bj < 2; ++bj) { float b[8], v[8]; unpack_u8(gb[m][bj], b);
#pragma unroll
                    for (int j = 0; j < 4; ++j) { v[j] = acc[ai][bj][m][0][j] * (b[j] * (1.f / 255.f)); v[4 + j] = acc[ai][bj][m][1][j] * (b[4 + j] * (1.f / 255.f)); }
                    *(u32x4*)(mix + (size_t)(row0 + ai * 128 + m * 16) * D + col0 + bj * 128) = pack8(v); } }
    }
};

template <bool Q8 = false, int WS_ = FP8_WSCALE> struct ProbStdT {
    static constexpr bool GATHER = false, FP8 = Q8; static constexpr int WSCALE = WS_, EB = Q8 ? 1 : 2;
    int K, lda, ldb, G, c; const void *A, *Bt;
    __device__ __forceinline__ bool next(int i, Unit& u) const { const int L = i * G + c; if (L >= 256) return false; pg8::map_tile(L, 64, 4, u.pm, u.pn); u.aux = 0; return true; }
    __device__ __forceinline__ const char* a_base(const Unit& u) const { return (const char*)A + (size_t)u.pm * 256 * D * EB; }
    __device__ __forceinline__ const char* b_base(const Unit& u) const { return (const char*)Bt + (size_t)u.pn * 256 * D * EB; }
    __device__ __forceinline__ unsigned a_off(const Unit&, int row, int C) const { return (unsigned)(row * D * EB + C * 2); }
};
typedef ProbStdT<false> ProbStd;
template <bool RESF32> struct EpiRes {
    static constexpr bool MID = false, STAGE = false; static constexpr int NSTORE = 0;
    const void* res; bf16_t* outb; float* ssq; unsigned char* outq; const float* qgain;
    struct Chunk { f32x4 rf[2][2][2]; u32x4 rb[2][2]; };
    __device__ __forceinline__ void load(Chunk& c, int row0, int col0, int ch) const {
        const int ai = ch >> 1, mp = ch & 1;
#pragma unroll
        for (int mm = 0; mm < 2; ++mm)
#pragma unroll
            for (int bj = 0; bj < 2; ++bj) { const size_t off = (size_t)(row0 + ai * 128 + (2 * mp + mm) * 16) * D + col0 + bj * 128;
                if (RESF32) { c.rf[mm][bj][0] = *(const f32x4*)((const float*)res + off); c.rf[mm][bj][1] = *(const f32x4*)((const float*)res + off + 4); }
                else c.rb[mm][bj] = *(const u32x4*)((const bf16_t*)res + off); }
    }
    __device__ __forceinline__ void finish(const Chunk& c, const f32x4 (&acc)[2][2][4][2], const Unit& u, int row0, int col0, int wc, int fq, int ch) const {
        const int ai = ch >> 1, mp = ch & 1;
#pragma unroll
        for (int mm = 0; mm < 2; ++mm) { const int m = 2 * mp + mm; const size_t row = (size_t)(row0 + ai * 128 + m * 16); float sq = 0.f;
#pragma unroll
            for (int bj = 0; bj < 2; ++bj) { float r[8], v[8];
                if (RESF32) { r[0] = c.rf[mm][bj][0].x; r[1] = c.rf[mm][bj][0].y; r[2] = c.rf[mm][bj][0].z; r[3] = c.rf[mm][bj][0].w; r[4] = c.rf[mm][bj][1].x; r[5] = c.rf[mm][bj][1].y; r[6] = c.rf[mm][bj][1].z; r[7] = c.rf[mm][bj][1].w; }
                else unpack8(c.rb[mm][bj], r);
#pragma unroll
                for (int j = 0; j < 4; ++j) { v[j] = acc[ai][bj][m][0][j] + r[j]; v[4 + j] = acc[ai][bj][m][1][j] + r[4 + j]; }
#pragma unroll
                for (int j = 0; j < 8; ++j) sq += v[j] * v[j];
                *(u32x4*)(outb + row * D + col0 + bj * 128) = pack8(v);
                if (outq) *(u32x2*)(outq + row * D + col0 + bj * 128) = pack8_fp8(v); }
            sq += __shfl_xor(sq, 16); sq += __shfl_xor(sq, 32);
            if (fq == 0) ssq[row * 16 + u.pn * 4 + wc] = sq; }
    }
    __device__ __forceinline__ void operator()(const f32x4 (&acc)[2][2][4][2], const Unit& u, int wr, int wc, int fr, int fq) const {
        asm volatile("" : "+v"(fr), "+v"(fq));
        const int row0 = u.pm * 256 + wr * 64 + fr, col0 = u.pn * 256 + wc * 32 + 8 * fq;
        Chunk ca, cb; load(ca, row0, col0, 0);
        load(cb, row0, col0, 1); finish(ca, acc, u, row0, col0, wc, fq, 0);
        load(ca, row0, col0, 2); finish(cb, acc, u, row0, col0, wc, fq, 1);
        load(cb, row0, col0, 3); finish(ca, acc, u, row0, col0, wc, fq, 2);
        finish(cb, acc, u, row0, col0, wc, fq, 3);
    }
};
__device__ __forceinline__ float row_rs(const float* ssq, size_t row) {
    const f32x4 a = *(const f32x4*)(ssq + row * 16), b = *(const f32x4*)(ssq + row * 16 + 4), c = *(const f32x4*)(ssq + row * 16 + 8), d = *(const f32x4*)(ssq + row * 16 + 12);
    const float s = ((a.x + a.y) + (a.z + a.w)) + ((b.x + b.y) + (b.z + b.w)) + ((c.x + c.y) + (c.z + c.w)) + ((d.x + d.y) + (d.z + d.w));
    return rsqrtf(s * (1.f / D) + EPS);
}
struct EpiScale {
    static constexpr bool MID = false, STAGE = true; static constexpr int NSTORE = 0;
    const float* ssq; bf16_t* outb; const LAS unsigned char* ldsb;
    __device__ __forceinline__ void stage(const Unit& u, int wid, int lane, LAS unsigned char* lds) const {
#pragma unroll
        for (int i = 0; i < 2; ++i) __builtin_amdgcn_global_load_lds((const unsigned*)(ssq + (size_t)(u.pm * 256 + wid * 32 + i * 16 + (lane >> 2)) * 16 + (lane & 3) * 4), (LAS unsigned*)(lds + EPI_OFF + wid * 2048 + i * 1024), 16, 0, 0);
    }
    __device__ __forceinline__ void operator()(const f32x4 (&acc)[2][2][4][2], const Unit& u, int wr, int wc, int fr, int fq) const {
        asm volatile("" : "+v"(fr), "+v"(fq));
        const int row0 = u.pm * 256 + wr * 64 + fr, col0 = u.pn * 256 + wc * 32 + 8 * fq;
        float rs[2][4];
#pragma unroll
        for (int ai = 0; ai < 2; ++ai)
#pragma unroll
            for (int m = 0; m < 4; ++m) { const LAS f32x4* sp = (const LAS f32x4*)(ldsb + EPI_OFF + (wr * 64 + fr + ai * 128 + m * 16) * 64); const f32x4 a = sp[0], b = sp[1], c = sp[2], d = sp[3];
                const float s = ((a.x + a.y) + (a.z + a.w)) + ((b.x + b.y) + (b.z + b.w)) + ((c.x + c.y) + (c.z + c.w)) + ((d.x + d.y) + (d.z + d.w));
                rs[ai][m] = rsqrtf(s * (1.f / D) + EPS); }
#pragma unroll
        for (int ai = 0; ai < 2; ++ai)
#pragma unroll
            for (int m = 0; m < 4; ++m) { const size_t row = (size_t)(row0 + ai * 128 + m * 16);
#pragma unroll
                for (int bj = 0; bj < 2; ++bj) { float v[8];
#pragma unroll
                    for (int j = 0; j < 4; ++j) { v[j] = acc[ai][bj][m][0][j] * rs[ai][m]; v[4 + j] = acc[ai][bj][m][1][j] * rs[ai][m]; }
                    *(u32x4*)(outb + row * D + col0 + bj * 128) = pack8(v); } }
    }
};

__device__ __forceinline__ void attn_unit(Frame& F, int unit) {
    const int tid = F.tid, w = F.wave, lane = F.lane, fr = lane & 15, fq = lane >> 4;
    const int b = unit >> 5, h = (unit >> 3) & 3, qb = unit & 7;
    const size_t tq = (size_t)b * SEQ + qb * 256 + 32 * w;
    LAS unsigned char* const bufs[2] = {F.lds, F.lds + 36864};
    const bf16_t* kg = F.kmem() + (size_t)(b * 256 + (tid >> 1)) * D + h * 256 + (tid & 1) * 32;
    const int kls = (tid >> 1) * 144 + (tid & 1) * 64;
    const bf16_t* vg = F.vt() + (size_t)(h * 256 + (tid >> 3)) * TM + b * 256 + (tid & 7) * 32;
    const int vls = (tid >> 3) * 528 + (tid & 7) * 64;
    u32x4 st[4];
#pragma unroll
    for (int i = 0; i < 4; ++i) st[i] = *(const u32x4*)(kg + 8 * i);
#pragma unroll
    for (int i = 0; i < 4; ++i) *(LAS u32x4*)(bufs[0] + kls + 16 * i) = st[i];
    __syncthreads();
    f32x4 s[16][2];
#pragma unroll
    for (int nt = 0; nt < 16; ++nt) { s[nt][0] = (f32x4){0.f, 0.f, 0.f, 0.f}; s[nt][1] = (f32x4){0.f, 0.f, 0.f, 0.f}; }
#pragma unroll
    for (int c = 0; c < 4; ++c) {
        if (c < 3) {
#pragma unroll
            for (int i = 0; i < 4; ++i) st[i] = *(const u32x4*)(kg + 64 * (c + 1) + 8 * i); }
        else {
#pragma unroll
            for (int i = 0; i < 4; ++i) st[i] = *(const u32x4*)(vg + 8 * i); }
        LAS unsigned char* kb = bufs[c & 1];
        bf16x8 qf[2][2];
#pragma unroll
        for (int qt = 0; qt < 2; ++qt)
#pragma unroll
            for (int ks = 0; ks < 2; ++ks) qf[qt][ks] = *(const bf16x8*)(F.q() + (tq + 16 * qt + fr) * D + h * 256 + 64 * c + 32 * ks + 8 * fq);
#pragma unroll
        for (int nt = 0; nt < 16; ++nt)
#pragma unroll
            for (int ks = 0; ks < 2; ++ks) { const bf16x8 a = *(const LAS bf16x8*)(kb + (16 * nt + fr) * 144 + (32 * ks + 8 * fq) * 2);
                s[nt][0] = mma16(a, qf[0][ks], s[nt][0]); s[nt][1] = mma16(a, qf[1][ks], s[nt][1]); }
        if (c < 3) {
#pragma unroll
            for (int i = 0; i < 4; ++i) *(LAS u32x4*)(bufs[(c + 1) & 1] + kls + 16 * i) = st[i]; }
        __syncthreads();
    }
#pragma unroll
    for (int i = 0; i < 4; ++i) *(LAS u32x4*)(bufs[0] + vls + 16 * i) = st[i];
    float inv[2]; bf16x8 pb[2][8];
#pragma unroll
    for (int qt = 0; qt < 2; ++qt) { float mx = s[0][qt][0];
#pragma unroll
        for (int nt = 0; nt < 16; ++nt)
#pragma unroll
            for (int r = 0; r < 4; ++r) mx = fmaxf(mx, s[nt][qt][r]);
        mx = fmaxf(mx, __shfl_xor(mx, 16)); mx = fmaxf(mx, __shfl_xor(mx, 32));
        float sum = 0.f;
#pragma unroll
        for (int nt = 0; nt < 16; ++nt)
#pragma unroll
            for (int r = 0; r < 4; ++r) { const float e = __expf(s[nt][qt][r] - mx); s[nt][qt][r] = e; sum += e; }
        sum += __shfl_xor(sum, 16); sum += __shfl_xor(sum, 32);
        inv[qt] = __builtin_amdgcn_rcpf(sum);
#pragma unroll
        for (int sk = 0; sk < 8; ++sk) { const float pv[8] = {s[2 * sk][qt][0], s[2 * sk][qt][1], s[2 * sk][qt][2], s[2 * sk][qt][3], s[2 * sk + 1][qt][0], s[2 * sk + 1][qt][1], s[2 * sk + 1][qt][2], s[2 * sk + 1][qt][3]};
            const u32x4 pk = pack8(pv); pb[qt][sk] = __builtin_bit_cast(bf16x8, pk); } }
    __syncthreads();
#pragma unroll
    for (int c = 0; c < 4; ++c) {
        if (c < 3) {
#pragma unroll
            for (int i = 0; i < 4; ++i) st[i] = *(const u32x4*)(vg + (size_t)64 * (c + 1) * TM + 8 * i); }
        LAS unsigned char* vb = bufs[c & 1];
#pragma unroll
        for (int dt = 0; dt < 4; ++dt) { f32x4 o0 = {0.f, 0.f, 0.f, 0.f}, o1 = {0.f, 0.f, 0.f, 0.f};
#pragma unroll
            for (int sk = 0; sk < 8; ++sk) { const LAS unsigned char* vp = vb + (16 * dt + fr) * 528 + (32 * sk + 4 * fq) * 2;
                const u32x2 lo = *(const LAS u32x2*)vp, hi = *(const LAS u32x2*)(vp + 32);
                const u32x4 av = {lo.x, lo.y, hi.x, hi.y}; const bf16x8 a = __builtin_bit_cast(bf16x8, av);
                o0 = mma16(a, pb[0][sk], o0); o1 = mma16(a, pb[1][sk], o1); }
            const int col = h * 256 + 64 * c + 16 * dt + 4 * fq;
            int w0 = 0, w1 = 0;
            w0 = __builtin_amdgcn_cvt_pk_fp8_f32(o0[0] * inv[0], o0[1] * inv[0], w0, false); w0 = __builtin_amdgcn_cvt_pk_fp8_f32(o0[2] * inv[0], o0[3] * inv[0], w0, true);
            w1 = __builtin_amdgcn_cvt_pk_fp8_f32(o1[0] * inv[1], o1[1] * inv[1], w1, false); w1 = __builtin_amdgcn_cvt_pk_fp8_f32(o1[2] * inv[1], o1[3] * inv[1], w1, true);
            *(int*)((unsigned char*)F.ao() + (tq + fr) * D + col) = w0; *(int*)((unsigned char*)F.ao() + (tq + 16 + fr) * D + col) = w1; }
        if (c < 3) {
#pragma unroll
            for (int i = 0; i < 4; ++i) *(LAS u32x4*)(bufs[(c + 1) & 1] + vls + 16 * i) = st[i]; }
        __syncthreads();
    }
}

__device__ __forceinline__ void router_item(Frame& F, int item) {
    const int w = F.wave, lane = F.lane, fr = lane & 15, fq = lane >> 4;
    const size_t t0 = (size_t)item * 16;
    LAS float* lg = (LAS float*)(F.lds + ROUTER_OFF) + w * (16 * 33 + 64);
    LAS int* ex = (LAS int*)(lg + 16 * 33);
    f32x4 acc[2] = {{0.f, 0.f, 0.f, 0.f}, {0.f, 0.f, 0.f, 0.f}};
    const float rsl = row_rs(F.ssq2(), t0 + fr);
    for (int k0 = 0; k0 < 32; k0 += 8) { bf16x8 a[8], b0[8], b1[8];
#pragma unroll
        for (int i = 0; i < 8; ++i) { a[i] = *(const bf16x8*)(F.x2b() + (t0 + fr) * D + 32 * (k0 + i) + 8 * fq);
            b0[i] = *(const bf16x8*)(F.Wr_t() + (size_t)fr * D + 32 * (k0 + i) + 8 * fq); b1[i] = *(const bf16x8*)(F.Wr_t() + (size_t)(16 + fr) * D + 32 * (k0 + i) + 8 * fq); }
#pragma unroll
        for (int i = 0; i < 8; ++i) { acc[0] = mma16(a[i], b0[i], acc[0]); acc[1] = mma16(a[i], b1[i], acc[1]);
            const int col = 32 * (k0 + i) + 8 * fq; const f32x4 g0 = *(const f32x4*)(F.A->in[I_NFFNG] + col), g1 = *(const f32x4*)(F.A->in[I_NFFNG] + col + 4);
            float xv[8]; unpack8(__builtin_bit_cast(u32x4, a[i]), xv);
            xv[0] *= rsl * g0.x; xv[1] *= rsl * g0.y; xv[2] *= rsl * g0.z; xv[3] *= rsl * g0.w; xv[4] *= rsl * g1.x; xv[5] *= rsl * g1.y; xv[6] *= rsl * g1.z; xv[7] *= rsl * g1.w;
            *(u32x2*)(F.x2q() + (t0 + fr) * D + col) = pack8_fp8(xv); } }
#pragma unroll
    for (int r = 0; r < 4; ++r)
#pragma unroll
        for (int nt = 0; nt < 2; ++nt) lg[(4 * fq + r) * 33 + 16 * nt + fr] = acc[nt][r];
    LDS_WAIT();
    float rs = 0.f, gk[4] = {0.f, 0.f, 0.f, 0.f};
    if (lane < 16) { const size_t t = t0 + lane; rs = row_rs(F.ssq2(), t);
        float v[32];
#pragma unroll
        for (int e = 0; e < 32; ++e) v[e] = lg[lane * 33 + e] * rs + F.A->in[I_BR][e];
        unsigned taken = 0u; float tv[4];
#pragma unroll
        for (int k = 0; k < 4; ++k) { float best = -INFINITY; int bi = 0;
#pragma unroll
            for (int e = 0; e < 32; ++e) { const bool ok = !((taken >> e) & 1u) && (v[e] > best); best = ok ? v[e] : best; bi = ok ? e : bi; }
            taken |= 1u << bi; tv[k] = best; ex[lane * 4 + k] = bi; }
        float sum = 0.f;
#pragma unroll
        for (int k = 0; k < 4; ++k) { gk[k] = __expf(tv[k] - tv[0]); sum += gk[k]; }
        const float inv = 1.f / sum;
        *(f32x4*)(F.gates() + t * 4) = (f32x4){gk[0] * inv, gk[1] * inv, gk[2] * inv, gk[3] * inv}; }
    LDS_WAIT();
    const int me = ex[lane]; const float my_rs = __shfl(rs, lane >> 2);
    int rank = 0, mytot = 0;
#pragma unroll
    for (int e = 0; e < 32; ++e) { const unsigned long long m = __ballot(me == e); const int below = __builtin_popcountll(m & ((1ull << lane) - 1ull));
        rank = (me == e) ? below : rank; mytot = (lane == e) ? __builtin_popcountll(m) : mytot; }
    unsigned base = 0u;
    if (lane < 32 && mytot > 0) base = atomicAdd(F.ctl + CW_CNT + lane, (unsigned)mytot);
    const unsigned slot = (unsigned)__shfl((int)base, me) + (unsigned)rank;
    F.list()[me * ECAP + slot] = (int)(t0 * 4 + lane); (void)my_rs;
    LDS_WAIT();
}

__device__ __forceinline__ void expert_tables(Frame& F) {
    LAS int* tab = (LAS int*)(F.lds + TAB_OFF);
    if (F.tid < 64) {
        const int lane = F.tid, cnt = lane < 32 ? (int)__hip_atomic_load(F.ctl + CW_CNT + lane, __ATOMIC_RELAXED, __HIP_MEMORY_SCOPE_AGENT) : 0;
        const int tiles = (cnt + 255) >> 8; int incl = tiles;
#pragma unroll
        for (int d = 1; d < 32; d <<= 1) { const int up = __shfl_up(incl, d); if (lane >= d) incl += up; }
        if (lane < 32) { tab[lane] = cnt; tab[32 + lane] = incl - tiles; }
        if (lane == 31) tab[64] = incl; }
    __syncthreads();
}
template <int NTN, bool GATH> struct ProbExp {
    static constexpr bool GATHER = GATH, gather = GATH, FP8 = true, BTILED = true; static constexpr int WSCALE = FP8_WSCALE;
    int K, lda, ldb, G, c; const LAS int* tab; const unsigned char* A; const unsigned char* Bt; const int* list; mutable int ehint;
    __device__ __forceinline__ bool next(int i, Unit& u) const {
        const int L = i * G + c; if (L >= NTN * tab[64]) return false;
        int e = ehint;
#pragma unroll 1
        while (e < 31 && L >= NTN * tab[32 + e + 1]) ++e;
        ehint = e;
        const int r = L - NTN * tab[32 + e], mte = tab[32 + e + 1] - tab[32 + e];
        u.aux = e; u.pn = r / mte; u.pm = r % mte; return true;
    }
    __device__ __forceinline__ const char* a_base(const Unit& u) const { return gather ? (const char*)A : (const char*)(A + (size_t)(tab[32 + u.aux] + u.pm) * 256 * D); }
    __device__ __forceinline__ const char* b_base(const Unit& u) const { return (const char*)(Bt + ((size_t)u.aux * NTN + u.pn) * 256 * D); }
    __device__ __forceinline__ unsigned a_off(const Unit& u, int row, int C) const {
        if (!gather) return (unsigned)(row * D + C * 2);
        const int slot = u.pm * 256 + row; const int av = list[u.aux * ECAP + slot];
        const int a = slot < tab[u.aux] ? av : 0;
        return (unsigned)((a >> 2) * D + C * 2);
    }
    __device__ __forceinline__ void stage_next(const Unit& u, int wid, int lane, LAS unsigned char* lds) const {
        if (wid < 4) __builtin_amdgcn_global_load_lds((const unsigned*)(list + u.aux * ECAP + u.pm * 256 + wid * 64 + lane), (LAS unsigned*)(lds + EPI_OFF + 2048 + wid * 256), 4, 0, 0);
    }
    __device__ __forceinline__ unsigned a_off_lds(const Unit& u, int row, int C, const LAS unsigned char* lds) const {
        const int av = *(const LAS int*)(lds + EPI_OFF + 2048 + row * 4); const int slot = u.pm * 256 + row;
        const int a = slot < tab[u.aux] ? av : 0;
        return (unsigned)((a >> 2) * D + C * 2);
    }
};
struct EpiE1 {
    static constexpr bool MID = false, STAGE = true; static constexpr int NSTORE = 8;
    const LAS int* tab; const float* lscale; const float* b1; unsigned char* act;
    __device__ __forceinline__ void stage(const Unit& u, int wid, int lane, LAS unsigned char* lds) const {
        if (wid < 4) { const float* src = b1 + (size_t)u.aux * 2048 + ((wid & 2) ? 1024 : 0) + u.pn * 128 + (wid & 1) * 64 + lane;
            __builtin_amdgcn_global_load_lds((const unsigned*)src, (LAS unsigned*)(lds + EPI_OFF + wid * 256), 4, 0, 0); }
    }
    __device__ __forceinline__ void operator()(const f32x4 (&acc)[2][2][4][2], const Unit& u, int wr, int wc, int fr, int fq) const {
        asm volatile("" : "+v"(fr), "+v"(fq));
        const int e = u.aux; const size_t rbase = (size_t)(tab[32 + e] + u.pm) * 256;
        const int j0 = u.pn * 128 + wc * 32 + 8 * fq;
        const LAS float* bp = (const LAS float*)((const LAS unsigned char*)tab - TAB_OFF + EPI_OFF) + wc * 32 + 8 * fq;
        const f32x4 bg0 = *(const LAS f32x4*)bp, bg1 = *(const LAS f32x4*)(bp + 4), bl0 = *(const LAS f32x4*)(bp + 128), bl1 = *(const LAS f32x4*)(bp + 132);
        const float bg[8] = {bg0.x, bg0.y, bg0.z, bg0.w, bg1.x, bg1.y, bg1.z, bg1.w}, bl[8] = {bl0.x, bl0.y, bl0.z, bl0.w, bl1.x, bl1.y, bl1.z, bl1.w};
#pragma unroll
        for (int ai = 0; ai < 2; ++ai)
#pragma unroll
            for (int m = 0; m < 4; ++m) { const int rt = ai * 128 + wr * 64 + m * 16 + fr; float v[8];
#pragma unroll
                for (int jp = 0; jp < 4; ++jp) {
                    const f32x2 ag = {acc[ai][0][m][jp >> 1][2 * (jp & 1)], acc[ai][0][m][jp >> 1][2 * (jp & 1) + 1]}, al = {acc[ai][1][m][jp >> 1][2 * (jp & 1)], acc[ai][1][m][jp >> 1][2 * (jp & 1) + 1]};
                    const f32x2 bg2 = {bg[2 * jp], bg[2 * jp + 1]}, bl2 = {bl[2 * jp], bl[2 * jp + 1]};
                    const f32x2 ga = ag + bg2, la = al + bl2;
                    const f32x2 glu = {fminf(ga.x, 7.0f), fminf(ga.y, 7.0f)}, lin = {fminf(fmaxf(la.x, -7.0f), 7.0f), fminf(fmaxf(la.y, -7.0f), 7.0f)};
                    const f32x2 t = glu * (-1.702f * 1.4426950408889634f);
                    const f32x2 d = (f32x2){__builtin_amdgcn_exp2f(t.x), __builtin_amdgcn_exp2f(t.y)} + 1.0f;
                    const f32x2 r = {__builtin_amdgcn_rcpf(d.x), __builtin_amdgcn_rcpf(d.y)};
                    const f32x2 o = ((lin + 1.0f) * glu) * r;
                    v[2 * jp] = o.x; v[2 * jp + 1] = o.y; }
                *(u32x2*)(act + (rbase + rt) * D + j0) = pack8_fp8(v); }
    }
};
struct EpiE2 {
    static constexpr bool MID = false, STAGE = true; static constexpr int NSTORE = 16;
    const LAS int* tab; const int* list; const float* b2; unsigned char* yb; unsigned char* dummy;
    __device__ __forceinline__ void stage(const Unit& u, int wid, int lane, LAS unsigned char* lds) const {
        const unsigned* src = (wid < 4) ? (const unsigned*)(b2 + (size_t)u.aux * D + u.pn * 256 + wid * 64 + lane) : (const unsigned*)(list + u.aux * ECAP + u.pm * 256 + (wid - 4) * 64 + lane);
        __builtin_amdgcn_global_load_lds(src, (LAS unsigned*)(lds + EPI_OFF + wid * 256), 4, 0, 0);
    }
    __device__ __forceinline__ void operator()(const f32x4 (&acc)[2][2][4][2], const Unit& u, int wr, int wc, int fr, int fq) const {
        asm volatile("" : "+v"(fr), "+v"(fq));
        const int e = u.aux, cnt = tab[e]; const int col0 = u.pn * 256 + wc * 32 + 8 * fq;
        const LAS float* sb = (const LAS float*)((const LAS unsigned char*)tab - TAB_OFF + EPI_OFF); const LAS int* sl = (const LAS int*)(sb + 256);
        float bb[2][8];
#pragma unroll
        for (int bj = 0; bj < 2; ++bj) { const f32x4 x0 = *(const LAS f32x4*)(sb + bj * 128 + wc * 32 + 8 * fq), x1 = *(const LAS f32x4*)(sb + bj * 128 + wc * 32 + 8 * fq + 4);
            bb[bj][0] = x0.x; bb[bj][1] = x0.y; bb[bj][2] = x0.z; bb[bj][3] = x0.w; bb[bj][4] = x1.x; bb[bj][5] = x1.y; bb[bj][6] = x1.z; bb[bj][7] = x1.w; }
        int aidx[2][4];
#pragma unroll
        for (int ai = 0; ai < 2; ++ai)
#pragma unroll
            for (int m = 0; m < 4; ++m) aidx[ai][m] = sl[ai * 128 + wr * 64 + m * 16 + fr];
#pragma unroll
        for (int ai = 0; ai < 2; ++ai)
#pragma unroll
            for (int m = 0; m < 4; ++m) { const int slot = u.pm * 256 + ai * 128 + wr * 64 + m * 16 + fr;
                unsigned char* rowp = (slot < cnt) ? yb + (size_t)aidx[ai][m] * D : dummy;
#pragma unroll
                for (int bj = 0; bj < 2; ++bj) { float v[8];
#pragma unroll
                    for (int j = 0; j < 4; ++j) { v[j] = acc[ai][bj][m][0][j] + bb[bj][j]; v[4 + j] = acc[ai][bj][m][1][j] + bb[bj][4 + j]; }
                    *(u32x2*)(rowp + col0 + bj * 128) = pack8_fp8(v); } }
    }
};

struct CombTok { u32x4 x[2]; u32x2 y[2][4]; f32x4 g; };
__device__ __forceinline__ void comb_load(Frame& F, int t, int lane, CombTok& c) {
    c.g = *(const f32x4*)(F.gates() + (size_t)t * 4);
#pragma unroll
    for (int hf = 0; hf < 2; ++hf) { const int col = hf * 512 + lane * 8; c.x[hf] = *(const u32x4*)(F.x2b() + (size_t)t * D + col);
#pragma unroll
        for (int k = 0; k < 4; ++k) c.y[hf][k] = *(const u32x2*)((const unsigned char*)F.yb() + ((size_t)t * 4 + k) * D + col); }
}
__device__ __forceinline__ void comb_finish(Frame& F, int t, int lane, const CombTok& c) {
    const float gk[4] = {c.g.x, c.g.y, c.g.z, c.g.w}; float x[2][8]; float ss = 0.f;
#pragma unroll
    for (int hf = 0; hf < 2; ++hf) { unpack8(c.x[hf], x[hf]);
#pragma unroll
        for (int k = 0; k < 4; ++k) { float y[8]; unpack8_fp8(c.y[hf][k], y);
#pragma unroll
            for (int j = 0; j < 8; ++j) x[hf][j] += gk[k] * y[j]; }
#pragma unroll
        for (int j = 0; j < 8; ++j) ss += x[hf][j] * x[hf][j]; }
    const float rs = rsqrtf(wave_sum(ss) * (1.f / D) + EPS);
#pragma unroll
    for (int hf = 0; hf < 2; ++hf) { const int col = hf * 512 + lane * 8; const f32x4 g0 = *(const f32x4*)(F.A->in[I_NFING] + col), g1 = *(const f32x4*)(F.A->in[I_NFING] + col + 4);
        *(f32x4*)(F.A->out + (size_t)t * D + col) = (f32x4){x[hf][0] * rs * g0.x, x[hf][1] * rs * g0.y, x[hf][2] * rs * g0.z, x[hf][3] * rs * g0.w};
        *(f32x4*)(F.A->out + (size_t)t * D + col + 4) = (f32x4){x[hf][4] * rs * g1.x, x[hf][5] * rs * g1.y, x[hf][6] * rs * g1.z, x[hf][7] * rs * g1.w}; }
}
__device__ __forceinline__ void combine_rows(Frame& F) {
    const int gw = F.vcu * 8 + F.wave, NGW = F.G * 8, lane = F.lane;
    if (gw >= T) return;
    CombTok ca, cb, cc; comb_load(F, gw, lane, ca); if (gw + NGW < T) comb_load(F, gw + NGW, lane, cb);
    for (int t = gw;;) {
        if (t + 2 * NGW < T) comb_load(F, t + 2 * NGW, lane, cc);
        comb_finish(F, t, lane, ca); if (t + NGW >= T) break;
        if (t + 3 * NGW < T) comb_load(F, t + 3 * NGW, lane, ca);
        comb_finish(F, t + NGW, lane, cb); if (t + 2 * NGW >= T) break;
        if (t + 4 * NGW < T) comb_load(F, t + 4 * NGW, lane, cb);
        comb_finish(F, t + 2 * NGW, lane, cc); if (t + 3 * NGW >= T) break;
        t += 3 * NGW; }
}

#ifndef DBG_OUT
#define DBG_OUT 0
#endif
#if DBG_OUT
__device__ __forceinline__ void dbg_rows(Frame& F) {
    const int gw = F.vcu * 8 + F.wave, NGW = F.G * 8, lane = F.lane;
    for (int t = gw; t < T; t += NGW) {
#pragma unroll
        for (int hf = 0; hf < 2; ++hf) { const int col = hf * 512 + lane * 8; float x[8];
#pragma unroll
            for (int j = 0; j < 8; ++j) x[j] = 0.f;
            if (DBG_OUT == 1) { for (int m = 0; m < 5; ++m) { if (col + 1024 * m < PN) { float y[8]; unpack8(*(const u32x4*)(F.p() + (size_t)t * PN + col + 1024 * m), y);
#pragma unroll
                for (int j = 0; j < 8; ++j) x[j] += y[j]; } } }
            else if (DBG_OUT == 8) { for (int k = 0; k < 4; ++k) { float y[8]; unpack8_fp8(*(const u32x2*)((const unsigned char*)F.yb() + ((size_t)t * 4 + k) * D + col), y); const float g = F.gates()[t * 4 + k];
#pragma unroll
                for (int j = 0; j < 8; ++j) x[j] += g * y[j]; } }
            else { const bf16_t* B = DBG_OUT == 2 ? F.oab() : DBG_OUT == 3 ? F.mix() : DBG_OUT == 4 ? F.x1b() : DBG_OUT == 5 ? F.q() : DBG_OUT == 6 ? F.ao() : F.x2b();
                unpack8(*(const u32x4*)(B + (size_t)t * D + col), x); }
#pragma unroll
            for (int j = 0; j < 8; ++j) if (!(fabsf(x[j]) < 1e30f)) x[j] = 1e6f;
            *(f32x4*)(F.A->out + (size_t)t * D + col) = (f32x4){x[0], x[1], x[2], x[3]};
            *(f32x4*)(F.A->out + (size_t)t * D + col + 4) = (f32x4){x[4], x[5], x[6], x[7]}; }
    }
}
#endif

__global__ void __launch_bounds__(512, 2) fwd_kernel(Args args) {
    extern __shared__ __attribute__((aligned(16))) unsigned char lds[];
    Frame F;
    F.lds = (LAS unsigned char*)lds; F.MISC = (volatile LAS unsigned*)(F.lds + MISC_OFF);
    F.tid = threadIdx.x; F.lane = F.tid & 63; F.wave = __builtin_amdgcn_readfirstlane(F.tid >> 6);
    F.G = gridDim.x; { const int bx = blockIdx.x; F.vcu = (F.G % 8 == 0) ? (bx % 8) * (F.G / 8) + bx / 8 : bx; }
    F.ctl = (unsigned*)(args.ws + WS_CTL);
    F.A = &args;
    for (int u = F.tid; u < 64; u += 512) ((LAS unsigned*)(F.lds + MISC_OFF))[u] = 0u;
    __syncthreads();
    XcdBarrier bar; bar.bar = F.ctl + CW_BAR; bar.x = 0; bar.st = nullptr;
    if (!MK_PER_PHASE) bar = xcd_barrier_post(F.ctl + CW_BAR, F.MISC + 8);
    const int lo = args.ph_lo, hi = args.ph_hi;
#ifndef PH_MASK
#define PH_MASK 0x3fff
#endif
#define IN(k) (((PH_MASK >> (k)) & 1) && lo <= (k) && (k) < hi)
#ifndef DOUBLE_MASK
#define DOUBLE_MASK 0
#endif
#define REP(k) for (int _rep = 0; _rep < ((((DOUBLE_MASK) >> (k)) & 1) ? 2 : 1); ++_rep, ((((DOUBLE_MASK) >> (k)) & 1) && _rep == 1 ? xcd_barrier(bar) : (void)0))
#define SEAM(k) do { if (IN(k) && IN((k) + 1)) xcd_barrier(bar); } while (0)
    const int c = (int)blockIdx.x;

#ifdef PROBE_PHASE
    unsigned long long tp0 = 0, tp1 = 0;
#define TS0(k) do { if ((k) == PROBE_PHASE) tp0 = __builtin_amdgcn_s_memrealtime(); } while (0)
#define TS1(k) do { if ((k) == PROBE_PHASE) tp1 = __builtin_amdgcn_s_memrealtime(); } while (0)
#else
#define TS0(k) do { } while (0)
#define TS1(k) do { } while (0)
#endif
    TS0(0); if (IN(0)) REP(0) { p0_prologue(F); } SEAM(0); TS1(0);
    TS0(1); if (IN(1)) REP(1) { EpiP1 E{args.ws};
        { ProbP1 P{D, D, ProbP1::EB * D, F.G, c, args.ws}; pg8::gemm_phase(F.lds, P, E); }
        if (P1_GATES_FP8) { ProbP1Q Q{D, D, D, F.G, c, args.ws}; pg8::gemm_phase(F.lds, Q, E); } } SEAM(1); TS1(1);
    TS0(2); if (IN(2)) REP(2) { for (int u = F.vcu; u < 1024; u += F.G) gla_a_unit(F, u); } SEAM(2); TS1(2);
    TS0(3); if (IN(3)) REP(3) { cvt_range(F, CVT_LATE, CVT_EXPERT, 4);
                        if (F.wave < 4) for (int it = F.vcu * 4 + F.wave; it < 1024; it += F.G * 4) gla_sscan_item(F, it);
                        sgu_units(F); } SEAM(3); TS1(3);
    TS0(4); if (IN(4)) REP(4) { for (int it = F.vcu * 8 + F.wave; it < 4096; it += 2 * F.G * 8) gla_out_pair(F, it, it + F.G * 8 < 4096 ? it + F.G * 8 : -1); } SEAM(4); TS1(4);
    TS0(5); if (IN(5)) REP(5) { ProbStd P{D, D, 2 * D, F.G, c, F.oab(), F.Wpab_t()}; EpiMix2 E{(const unsigned char*)(args.ws + WS_G8), F.mix()}; pg8::gemm_phase(F.lds, P, E); } SEAM(5); TS1(5);
    TS0(6); if (IN(6)) REP(6) { ProbStd P{D, D, 2 * D, F.G, c, F.mix(), F.Wmo_t()}; EpiRes<true> E{(const void*)F.A->in[I_X], F.x1b(), F.ssq1(), F.x1q(), nullptr}; pg8::gemm_phase(F.lds, P, E); } SEAM(6); TS1(6);
    TS0(7); if (IN(7)) REP(7) { ProbStdT<true, 0x75757575> P{D, D, D, F.G, c, F.x1q(), F.Wq_t()}; EpiScale E{F.ssq1(), F.q(), F.lds};     pg8::gemm_phase(F.lds, P, E); } SEAM(7); TS1(7);
    TS0(8); if (IN(8)) REP(8) { for (int u = F.vcu; u < 256; u += F.G) attn_unit(F, u); } SEAM(8); TS1(8);
    TS0(9); if (IN(9)) REP(9) { ProbStdT<true> P{D, D, D, F.G, c, F.ao(), F.Wo_t()}; EpiRes<false> E{(const void*)F.x1b(), F.x2b(), F.ssq2(), nullptr, nullptr}; pg8::gemm_phase(F.lds, P, E); } SEAM(9); TS1(9);
    TS0(10); if (IN(10)) REP(10) { for (int it = F.wave * F.G + F.vcu; it < 1024; it += 8 * F.G) router_item(F, it); cvt_expert_dma(F, 0, CVT_I1 + CVT_I2 - CVT_TAIL, F.vcu, F.G); }        SEAM(10); TS1(10);
    TS0(11); if (IN(11)) REP(11) { expert_tables(F); const LAS int* tab = (const LAS int*)(F.lds + TAB_OFF);
        ProbExp<8, true> P{D, D, 128, F.G, F.vcu, tab, F.x2q(), (const unsigned char*)F.W1_t(), F.list(), 0}; EpiE1 E{tab, F.lscale(), F.A->in[I_BE1], (unsigned char*)F.act()}; pg8::gemm_phase(F.lds, P, E);
        { const int rem = (8 * tab[64]) % F.G;
          if (F.vcu >= rem) cvt_expert_dma(F, CVT_I1 + CVT_I2 - CVT_TAIL, CVT_I1 + CVT_I2, F.vcu - rem, F.G - rem); } } SEAM(11); TS1(11);
    TS0(12); if (IN(12)) REP(12) { if (MK_PER_PHASE) expert_tables(F);        const LAS int* tab = (const LAS int*)(F.lds + TAB_OFF);
        ProbExp<4, false> P{D, D, 128, F.G, F.vcu, tab, (const unsigned char*)F.act(), (const unsigned char*)F.W2_t(), F.list(), 0}; EpiE2 E{tab, F.list(), F.A->in[I_BE2], (unsigned char*)F.yb(), (unsigned char*)(args.ws + WS_CTL + 512 * 1024)}; pg8::gemm_phase(F.lds, P, E); } SEAM(12); TS1(12);
#if DBG_OUT
    if (lo <= 13 && 13 < hi) { dbg_rows(F); }
#else
    TS0(13); if (IN(13)) REP(13) { combine_rows(F); } TS1(13);
#endif
#ifdef PROBE_PHASE
    if (blockIdx.x == 0) { const unsigned long long tend = __builtin_amdgcn_s_memrealtime(), extra = 4ull * (tp1 - tp0);
        while (__builtin_amdgcn_s_memrealtime() - tend < extra) __builtin_amdgcn_s_sleep(8); }
#endif
#undef IN
#undef SEAM
}

extern "C" void kernel_launch(void* const* d_in, const int* in_sizes, int n_in, void* d_out, int out_size, void* d_ws, size_t ws_size, hipStream_t stream) {
    static int grid = 0;
    if (grid == 0) {
        if (n_in != 28 || in_sizes[0] != T * D || out_size != T * D || ws_size < WS_END2) { fprintf(stderr, "kernel_launch: unexpected problem (n_in %d, in0 %d, out %d, ws %zu); nothing launched\n", n_in, n_in > 0 ? in_sizes[0] : -1, out_size, ws_size); grid = -1; return; }
        int dev = 0, cus = 0, per_cu = 0;
        if (hipGetDevice(&dev) != hipSuccess || hipDeviceGetAttribute(&cus, hipDeviceAttributeMultiprocessorCount, dev) != hipSuccess) { grid = -1; return; }
        if (hipFuncSetAttribute((const void*)fwd_kernel, hipFuncAttributeMaxDynamicSharedMemorySize, LDS_BYTES) != hipSuccess) { fprintf(stderr, "kernel_launch: hipFuncSetAttribute failed\n"); grid = -1; return; }
        if (hipOccupancyMaxActiveBlocksPerMultiprocessor(&per_cu, (const void*)fwd_kernel, 512, LDS_BYTES) != hipSuccess || per_cu < 1) fprintf(stderr, "kernel_launch: occupancy query reports %d blocks per CU\n", per_cu);
        (void)hipGetLastError();
        grid = cus;
    }
    if (grid < 0) return;
    if (hipMemsetAsync((char*)d_ws + WS_CTL, 0, CTL_ZERO_BYTES, stream) != hipSuccess) { fprintf(stderr, "kernel_launch: memset failed\n"); return; }
    Args a{};
    for (int i = 0; i < 28; ++i) a.in[i] = (const float*)d_in[i];
    a.out = (float*)d_out; a.ws = (unsigned char*)d_ws;
#if MK_PER_PHASE
    for (int ph = 0; ph < NPHASE; ++ph) { a.ph_lo = ph; a.ph_hi = ph + 1; hipLaunchKernelGGL(fwd_kernel, dim3(grid), dim3(512), LDS_BYTES, stream, a); }
#else
    a.ph_lo = 0; a.ph_hi = NPHASE;
    hipLaunchKernelGGL(fwd_kernel, dim3(grid), dim3(512), LDS_BYTES, stream, a);
#endif
}
```
